# Optimizing an MI355X kernel written in HIP

```python
import math
import jax, jax.numpy as jnp
from jax import lax
import numpy as np

D_MODEL = 2048
BATCH = 4
SEQ = 4096
DEPTH = 1

CHUNK = 64
NORM_EPS = 1e-6
N_BRANCH = 2
GDN_QK_HEADS = 4
GDN_V_HEADS = 8
GDN_HEAD_K = 128
GDN_HEAD_V = 128
GDN_KEY_DIM = GDN_QK_HEADS * GDN_HEAD_K
GDN_VAL_DIM = GDN_V_HEADS * GDN_HEAD_V
GDN_CONV = 4
RWKV_HEAD = 64
RWKV_HEADS = 16
RWKV_DIM = RWKV_HEADS * RWKV_HEAD
RWKV_DECAY_RANK = 96
RWKV_AAA_RANK = 96
RWKV_GATE_RANK = 256
RWKV_LN_EPS = 64e-5
N_EXPERTS = 32
TOP_K = 4
D_FF_EXPERT = D_MODEL
SWIGLU_ALPHA = 1.702
SWIGLU_LIMIT = 7.0
EXPERT_BLOCK = 256
COL_K = GDN_KEY_DIM
COL_V = 2 * GDN_KEY_DIM
COL_Z = COL_V + GDN_VAL_DIM
COL_B = COL_Z + GDN_VAL_DIM
COL_A = COL_B + GDN_V_HEADS
COL_GATE = COL_A + GDN_V_HEADS
COL_R = COL_GATE + N_BRANCH * D_MODEL
COL_RK = COL_R + RWKV_DIM
COL_RV = COL_RK + RWKV_DIM
N_IN = COL_RV + RWKV_DIM

kernel_name = "chunk_causal_gdn_rwkv7_gated_merge_moe_block"


def rms_norm(x, w, eps=NORM_EPS):
    xf = x.astype(jnp.float32)
    y = xf * lax.rsqrt(jnp.mean(xf * xf, axis=-1, keepdims=True) + eps)
    return (y * w.astype(jnp.float32)).astype(x.dtype)


def l2_normalize(x, eps=1e-6):
    xf = x.astype(jnp.float32)
    return xf * lax.rsqrt(jnp.sum(xf * xf, axis=-1, keepdims=True) + eps)


def token_shift(x):
    return jnp.pad(x, ((0, 0), (1, 0), (0, 0)))[:, :-1]


def causal_depthwise_conv(x, w):
    K, C = w.shape
    xp = jnp.pad(x, ((0, 0), (K - 1, 0), (0, 0)))
    return lax.conv_general_dilated(xp, w[:, None, :].astype(x.dtype), window_strides=(1,), padding='VALID',
                                    dimension_numbers=('NWC', 'WIO', 'NWC'), feature_group_count=C)


def gated_delta_rule(q, k, v, g, beta):
    B, S, H, dk = q.shape
    dv = v.shape[-1]
    n = S // CHUNK

    def chunks(t):
        return t.astype(jnp.float32).reshape(B, n, CHUNK, H, -1).transpose(1, 0, 3, 2, 4)

    q, k, v = chunks(q), chunks(k), chunks(v)
    g = jnp.cumsum(chunks(g[..., None])[..., 0], axis=-1)
    beta = chunks(beta[..., None])[..., 0]
    incl = jnp.tril(jnp.ones((CHUNK, CHUNK), dtype=bool))
    strict = jnp.tril(jnp.ones((CHUNK, CHUNK), dtype=bool), k=-1)
    diff = g[..., :, None] - g[..., None, :]
    decay = jnp.where(incl, jnp.exp(jnp.where(incl, diff, 0.0)), 0.0)
    kb = k * beta[..., None]
    lower = jnp.where(strict, jnp.einsum('nbhid,nbhjd->nbhij', kb, k) * decay, 0.0)
    rhs = jnp.concatenate([v * beta[..., None], kb * jnp.exp(g)[..., None]], axis=-1)
    sol = lax.linalg.triangular_solve(lower, rhs, left_side=True, lower=True, unit_diagonal=True)
    u, w = sol[..., :dv], sol[..., dv:]
    intra = jnp.where(incl, jnp.einsum('nbhid,nbhjd->nbhij', q, k) * decay, 0.0)

    def step(state, xs):
        q_c, k_c, u_c, w_c, g_c, a_c = xs
        v_new = u_c - jnp.einsum('bhck,bhkv->bhcv', w_c, state)
        o = (jnp.einsum('bhck,bhkv->bhcv', q_c * jnp.exp(g_c)[..., None], state)
             + jnp.einsum('bhij,bhjv->bhiv', a_c, v_new))
        g_last = g_c[..., -1:]
        k_dec = k_c * jnp.exp(g_last - g_c)[..., None]
        state = state * jnp.exp(g_last)[..., None] + jnp.einsum('bhck,bhcv->bhkv', k_dec, v_new)
        return state, o

    state0 = jnp.zeros((B, H, dk, dv), jnp.float32)
    _, o = lax.scan(step, state0, (q, k, u, w, g, intra))
    return o.transpose(1, 0, 3, 2, 4).reshape(B, S, H, dv)


def rwkv7_recurrence(r, w, k, v, a, b):
    B, S, H, N = r.shape
    xs = tuple(t.astype(jnp.float32).transpose(1, 0, 2, 3) for t in (r, w, k, v, a, b))

    def step(state, inp):
        r_t, w_t, k_t, v_t, a_t, b_t = inp
        sa = jnp.einsum('bhvk,bhk->bhv', state, a_t)
        state = (state * w_t[:, :, None, :] + sa[..., None] * b_t[:, :, None, :]
                 + v_t[..., None] * k_t[:, :, None, :])
        return state, jnp.einsum('bhvk,bhk->bhv', state, r_t)

    _, y = lax.scan(step, jnp.zeros((B, H, N, N), jnp.float32), xs)
    return y.transpose(1, 0, 2, 3)


def hybrid_mixer(h, w_in, gdn_conv, gdn_A_log, gdn_dt_bias, gdn_norm, rwkv_mix, rwkv_w0, rwkv_w1, rwkv_w2,
                 rwkv_a0, rwkv_a1, rwkv_a2, rwkv_g1, rwkv_g2, rwkv_k_k, rwkv_k_a, rwkv_r_k, rwkv_ln_w,
                 rwkv_ln_b, w_up_gdn, w_up_rwkv, w_out):
    B, S, D = h.shape
    f32 = jnp.float32
    ph = h @ w_in[:, :COL_R]
    dx = token_shift(h) - h
    xr, xw, xk, xv, xa, xg = [h + dx * rwkv_mix[i] for i in range(6)]
    r = xr @ w_in[:, COL_R:COL_RK]
    k_r = xk @ w_in[:, COL_RK:COL_RV]
    v_r = xv @ w_in[:, COL_RV:N_IN]

    qkv = jax.nn.silu(causal_depthwise_conv(ph[..., :COL_Z], gdn_conv))
    q = qkv[..., :COL_K].reshape(B, S, GDN_QK_HEADS, GDN_HEAD_K)
    k = qkv[..., COL_K:COL_V].reshape(B, S, GDN_QK_HEADS, GDN_HEAD_K)
    v = qkv[..., COL_V:COL_Z].reshape(B, S, GDN_V_HEADS, GDN_HEAD_V)
    q = l2_normalize(q) * (GDN_HEAD_K ** -0.5)
    k = l2_normalize(k)
    rep = GDN_V_HEADS // GDN_QK_HEADS
    q = jnp.repeat(q, rep, axis=2)
    k = jnp.repeat(k, rep, axis=2)
    z = ph[..., COL_Z:COL_B].reshape(B, S, GDN_V_HEADS, GDN_HEAD_V)
    beta = jax.nn.sigmoid(ph[..., COL_B:COL_A].astype(f32))
    g = -jnp.exp(gdn_A_log.astype(f32)) * jax.nn.softplus(ph[..., COL_A:COL_GATE].astype(f32)
                                                          + gdn_dt_bias.astype(f32))
    o = gated_delta_rule(q, k, v, g, beta)
    o = rms_norm(o, gdn_norm) * jax.nn.silu(z.astype(f32))
    y_gdn = o.reshape(B, S, GDN_VAL_DIM).astype(h.dtype)

    w_log = -jax.nn.softplus(-(rwkv_w0 + jnp.tanh(xw @ rwkv_w1) @ rwkv_w2).astype(f32)) - 0.5
    w_dec = jnp.exp(-jnp.exp(w_log))
    a = jax.nn.sigmoid((rwkv_a0 + (xa @ rwkv_a1) @ rwkv_a2).astype(f32))
    gate = jax.nn.sigmoid(xg @ rwkv_g1) @ rwkv_g2
    hs = lambda t: t.reshape(B, S, RWKV_HEADS, RWKV_HEAD)
    kk = l2_normalize(hs(k_r * rwkv_k_k))
    k_mod = k_r.astype(f32) * (1.0 + (a - 1.0) * rwkv_k_a.astype(f32))
    a_h = hs(a)
    y = rwkv7_recurrence(hs(r), hs(w_dec), hs(k_mod), hs(v_r), -kk, kk * a_h)
    mu = jnp.mean(y, axis=-1, keepdims=True)
    var = jnp.mean(jnp.square(y - mu), axis=-1, keepdims=True)
    y = (y - mu) * lax.rsqrt(var + RWKV_LN_EPS)
    y = y.reshape(B, S, RWKV_DIM) * rwkv_ln_w.astype(f32) + rwkv_ln_b.astype(f32)
    bonus = jnp.sum(hs(r).astype(f32) * hs(k_mod) * rwkv_r_k.astype(f32), axis=-1, keepdims=True) * hs(v_r).astype(f32)
    y = y + bonus.reshape(B, S, RWKV_DIM)
    y_rwkv = (y * gate.astype(f32)).astype(h.dtype)

    sg = jax.nn.sigmoid(ph[..., COL_GATE:COL_R].astype(f32)).astype(h.dtype).reshape(B, S, N_BRANCH, D)
    merged = sg[:, :, 0] * (y_gdn @ w_up_gdn) + sg[:, :, 1] * (y_rwkv @ w_up_rwkv)
    return merged @ w_out


def moe_ffn(h, router_w, router_b, w_gu, b_gu, w_down, b_down):
    B, S, D = h.shape
    T = B * S
    A = T * TOP_K
    F = D_FF_EXPERT
    ht = h.reshape(T, D)
    logits = (ht @ router_w + router_b).astype(jnp.float32)
    top_val, top_idx = lax.top_k(logits, TOP_K)
    probs = jax.nn.softmax(top_val, axis=-1)
    e_flat = top_idx.reshape(A).astype(jnp.int32)
    tok_flat = (jnp.arange(A, dtype=jnp.int32) // TOP_K)
    w_flat = probs.reshape(A)
    order = jnp.argsort(e_flat)
    e_sorted = e_flat[order]
    counts = jnp.bincount(e_flat, length=N_EXPERTS).astype(jnp.int32)
    start = jnp.cumsum(counts) - counts
    padded = (counts + EXPERT_BLOCK - 1) // EXPERT_BLOCK * EXPERT_BLOCK
    pad_end = jnp.cumsum(padded)
    pad_start = pad_end - padded
    pos = pad_start[e_sorted] + jnp.arange(A, dtype=jnp.int32) - start[e_sorted]
    P = A + N_EXPERTS * EXPERT_BLOCK
    NB = P // EXPERT_BLOCK
    buf_tok = jnp.full((P,), T, jnp.int32).at[pos].set(tok_flat[order])
    buf_w = jnp.zeros((P,), jnp.float32).at[pos].set(w_flat[order])
    block_start = jnp.arange(NB, dtype=jnp.int32) * EXPERT_BLOCK
    block_e = jnp.minimum(jnp.sum(pad_end[None, :] <= block_start[:, None], axis=1), N_EXPERTS - 1).astype(jnp.int32)
    h_pad = jnp.concatenate([ht, jnp.zeros((1, D), ht.dtype)], axis=0)

    def expert_block(args):
        tok, e = args
        xb = h_pad[tok]
        gu = xb @ w_gu[e] + b_gu[e]
        gl = jnp.minimum(gu[:, :F], SWIGLU_LIMIT)
        up = jnp.clip(gu[:, F:], -SWIGLU_LIMIT, SWIGLU_LIMIT)
        act = gl * jax.nn.sigmoid(SWIGLU_ALPHA * gl) * (up + 1.0)
        return act @ w_down[e] + b_down[e]

    yb = lax.map(expert_block, (buf_tok.reshape(NB, EXPERT_BLOCK), block_e))
    yb = yb.reshape(P, D) * buf_w[:, None].astype(h.dtype)
    y = jax.ops.segment_sum(yb, buf_tok, num_segments=T + 1)[:T]
    return y.reshape(B, S, D)


def setup_inputs(seed: int = 0) -> dict:
    key = jax.random.key(seed)
    ks = iter(list(jax.random.split(key, 48)))
    L, D, F, E = DEPTH, D_MODEL, D_FF_EXPERT, N_EXPERTS

    def nrm(shape, scale):
        return jax.random.normal(next(ks), shape, jnp.float32) * scale

    def gain(shape):
        return 1.0 + nrm(shape, 0.05)

    def unif(shape, lo, hi):
        return jax.random.uniform(next(ks), shape, jnp.float32, minval=lo, maxval=hi)

    x = nrm((BATCH, SEQ, D), 1.0)
    c = nrm((BATCH, D), 1.0)
    ada_w = nrm((L, D, 6 * D), D ** -0.5)
    ada_b = nrm((L, 6 * D), 0.02)
    norm_mix_pre = gain((L, D))
    norm_mix_post = gain((L, D))
    norm_ffn_pre = gain((L, D))
    norm_ffn_post = gain((L, D))
    w_in = nrm((L, D, N_IN), D ** -0.5)
    gdn_conv = nrm((L, GDN_CONV, COL_Z), GDN_CONV ** -0.5)
    gdn_A_log = jnp.log(unif((L, GDN_V_HEADS), 1.0, 16.0))
    dt = jnp.exp(unif((L, GDN_V_HEADS), math.log(1e-3), math.log(1e-1)))
    gdn_dt_bias = dt + jnp.log(-jnp.expm1(-dt))
    gdn_norm = gain((L, GDN_HEAD_V))
    rwkv_mix = unif((L, 6, D), 0.0, 1.0)
    rwkv_w0 = unif((L, RWKV_DIM), -6.0, 0.0)
    rwkv_w1 = nrm((L, D, RWKV_DECAY_RANK), D ** -0.5)
    rwkv_w2 = nrm((L, RWKV_DECAY_RANK, RWKV_DIM), 0.5 * RWKV_DECAY_RANK ** -0.5)
    rwkv_a0 = nrm((L, RWKV_DIM), 0.1)
    rwkv_a1 = nrm((L, D, RWKV_AAA_RANK), D ** -0.5)
    rwkv_a2 = nrm((L, RWKV_AAA_RANK, RWKV_DIM), RWKV_AAA_RANK ** -0.5)
    rwkv_g1 = nrm((L, D, RWKV_GATE_RANK), D ** -0.5)
    rwkv_g2 = nrm((L, RWKV_GATE_RANK, RWKV_DIM), RWKV_GATE_RANK ** -0.5)
    rwkv_k_k = 0.85 + nrm((L, RWKV_DIM), 0.05)
    rwkv_k_a = gain((L, RWKV_DIM))
    rwkv_r_k = nrm((L, RWKV_HEADS, RWKV_HEAD), 0.1)
    rwkv_ln_w = gain((L, RWKV_DIM))
    rwkv_ln_b = nrm((L, RWKV_DIM), 0.02)
    w_up_gdn = nrm((L, GDN_VAL_DIM, D), GDN_VAL_DIM ** -0.5)
    w_up_rwkv = nrm((L, RWKV_DIM, D), RWKV_DIM ** -0.5)
    w_out = nrm((L, D, D), D ** -0.5)
    router_w = nrm((L, D, E), D ** -0.5)
    router_b = nrm((L, E), 0.01)
    exp_w_gu = nrm((L, E, D, 2 * F), D ** -0.5)
    exp_b_gu = nrm((L, E, 2 * F), 0.02)
    exp_w_down = nrm((L, E, F, D), F ** -0.5)
    exp_b_down = nrm((L, E, D), 0.02)
    return {"x": x, "c": c, "ada_w": ada_w, "ada_b": ada_b,
            "norm_mix_pre": norm_mix_pre, "norm_mix_post": norm_mix_post,
            "norm_ffn_pre": norm_ffn_pre, "norm_ffn_post": norm_ffn_post,
            "w_in": w_in, "gdn_conv": gdn_conv, "gdn_A_log": gdn_A_log, "gdn_dt_bias": gdn_dt_bias,
            "gdn_norm": gdn_norm, "rwkv_mix": rwkv_mix, "rwkv_w0": rwkv_w0, "rwkv_w1": rwkv_w1,
            "rwkv_w2": rwkv_w2, "rwkv_a0": rwkv_a0, "rwkv_a1": rwkv_a1, "rwkv_a2": rwkv_a2,
            "rwkv_g1": rwkv_g1, "rwkv_g2": rwkv_g2, "rwkv_k_k": rwkv_k_k, "rwkv_k_a": rwkv_k_a,
            "rwkv_r_k": rwkv_r_k, "rwkv_ln_w": rwkv_ln_w, "rwkv_ln_b": rwkv_ln_b,
            "w_up_gdn": w_up_gdn, "w_up_rwkv": w_up_rwkv, "w_out": w_out,
            "router_w": router_w, "router_b": router_b, "exp_w_gu": exp_w_gu, "exp_b_gu": exp_b_gu,
            "exp_w_down": exp_w_down, "exp_b_down": exp_b_down}


def reference(x, c, ada_w, ada_b, norm_mix_pre, norm_mix_post, norm_ffn_pre, norm_ffn_post, w_in, gdn_conv,
              gdn_A_log, gdn_dt_bias, gdn_norm, rwkv_mix, rwkv_w0, rwkv_w1, rwkv_w2, rwkv_a0, rwkv_a1, rwkv_a2,
              rwkv_g1, rwkv_g2, rwkv_k_k, rwkv_k_a, rwkv_r_k, rwkv_ln_w, rwkv_ln_b, w_up_gdn, w_up_rwkv, w_out,
              router_w, router_b, exp_w_gu, exp_b_gu, exp_w_down, exp_b_down):
    for l in range(DEPTH):
        mod = jax.nn.silu(c) @ ada_w[l] + ada_b[l]
        sh1, sc1, gt1, sh2, sc2, gt2 = [m[:, None, :] for m in jnp.split(mod, 6, axis=-1)]
        h = rms_norm(x, norm_mix_pre[l]) * (1.0 + sc1) + sh1
        y = hybrid_mixer(h, w_in[l], gdn_conv[l], gdn_A_log[l], gdn_dt_bias[l], gdn_norm[l], rwkv_mix[l],
                         rwkv_w0[l], rwkv_w1[l], rwkv_w2[l], rwkv_a0[l], rwkv_a1[l], rwkv_a2[l], rwkv_g1[l],
                         rwkv_g2[l], rwkv_k_k[l], rwkv_k_a[l], rwkv_r_k[l], rwkv_ln_w[l], rwkv_ln_b[l],
                         w_up_gdn[l], w_up_rwkv[l], w_out[l])
        x = x + gt1 * rms_norm(y, norm_mix_post[l])
        h = rms_norm(x, norm_ffn_pre[l]) * (1.0 + sc2) + sh2
        y = moe_ffn(h, router_w[l], router_b[l], exp_w_gu[l], exp_b_gu[l], exp_w_down[l], exp_b_down[l])
        x = x + gt2 * rms_norm(y, norm_ffn_post[l])
    return x
```

```cpp
#include <hip/hip_runtime.h>
#include <cstdio>
#include <cstdint>

constexpr int D = 2048, NB = 4, SEQ = 4096, T = NB * SEQ;
constexpr int COL_K = 512, COL_V = 1024, COL_Z = 2048, COL_B = 3072, COL_A = 3080, COL_GATE = 3088, COL_R = 7184, COL_RK = 8208, COL_RV = 9232, N_IN = 10256;
constexpr int NE = 32, TOPK = 4, FF = 2048, NA = T * TOPK;
constexpr int RW = 1024;
constexpr float EPS = 1e-6f;
constexpr int NTHREADS = 512;
constexpr int LDS_BYTES = 64 * 1024;

#define XB_TMO      128
#define XB_XCNT(j)  (256  + 64 * (j))
#define XB_XSUB(j)  (1280 + 64 * (j))
#define XB_XGEN(j)  (2304 + 64 * (j))
#define XB_TOP      3328
#define XB_TOPGEN   3392
#define XCD_BAR_WORDS 3456
#define XB_SPIN_CAP (1u << 22)
#define LAS __attribute__((address_space(3)))
__device__ __forceinline__ unsigned xb_ld(unsigned* p)              { return __hip_atomic_load(p, __ATOMIC_RELAXED, __HIP_MEMORY_SCOPE_AGENT); }
__device__ __forceinline__ unsigned xb_add(unsigned* p, unsigned v) { return __hip_atomic_fetch_add(p, v, __ATOMIC_RELAXED, __HIP_MEMORY_SCOPE_AGENT); }
__device__ __forceinline__ unsigned xb_xcc_id() { return (unsigned)__builtin_amdgcn_s_getreg((3 << 11) | 20) & 0xFu; }
#define XB_SPIN(cond, bar) do { unsigned _sp = 0; while (cond) { __builtin_amdgcn_s_sleep(1); \
    if ((++_sp & 255u) == 0u) { if (xb_ld(&(bar)[XB_TMO])) break; if (_sp > XB_SPIN_CAP) { atomicAdd(&(bar)[XB_TMO], 1u); break; } } } } while (0)
struct XcdBarrier { unsigned* bar; unsigned x; volatile LAS unsigned* st; };
__device__ __forceinline__ XcdBarrier xcd_barrier_post(unsigned* bar, volatile LAS unsigned* st) {
    XcdBarrier b; b.bar = bar; b.x = xb_xcc_id(); b.st = st;
    if (threadIdx.x == 0) (void)xb_add(&bar[XB_XCNT(b.x)], 1u);
    return b;
}
__device__ __forceinline__ void xcd_barrier_complete(unsigned* bar, unsigned x, unsigned& nloc, unsigned& nx) {
    const unsigned G = gridDim.x * gridDim.y * gridDim.z;
    unsigned sum, cnt, mine, sp = 0u;
    for (;;) {
        sum = 0u; cnt = 0u; mine = 0u;
#pragma unroll
        for (unsigned j = 0; j < 16; ++j) { const unsigned c = xb_ld(&bar[XB_XCNT(j)]); sum += c; cnt += (c > 0u) ? 1u : 0u; mine = (j == x) ? c : mine; }
        if (sum == G) break;
        __builtin_amdgcn_s_sleep(1);
        if ((++sp & 255u) == 0u) { if (xb_ld(&bar[XB_TMO])) break; if (sp > XB_SPIN_CAP) { atomicAdd(&bar[XB_TMO], 1u); break; } }
    }
    nloc = mine > 0u ? mine : 1u; nx = cnt > 0u ? cnt : 1u;
}
__device__ __forceinline__ void xcd_barrier(const XcdBarrier& b) {
    asm volatile("s_waitcnt vmcnt(0)" ::: "memory");
    __syncthreads();
    if (threadIdx.x == 0) {
        unsigned* bar = b.bar;
        __builtin_amdgcn_s_waitcnt(0);
        unsigned nloc = b.st[0], nx = b.st[1];
        if (nloc == 0u) { xcd_barrier_complete(bar, b.x, nloc, nx); b.st[0] = nloc; b.st[1] = nx; }
        const unsigned old = xb_add(&bar[XB_XSUB(b.x)], 1u);
        const unsigned gen = old / nloc;
        if (old + 1u == (gen + 1u) * nloc) {
            __builtin_amdgcn_fence(__ATOMIC_RELEASE, "agent");
            asm volatile("s_waitcnt vmcnt(0)" ::: "memory");
            const unsigned og = xb_add(&bar[XB_TOP], 1u);
            const unsigned tg = og / nx;
            if (og + 1u == (tg + 1u) * nx) xb_add(&bar[XB_TOPGEN], 1u);
            else XB_SPIN(xb_ld(&bar[XB_TOPGEN]) == tg, bar);
            __builtin_amdgcn_fence(__ATOMIC_ACQUIRE, "agent");
            xb_add(&bar[XB_XGEN(b.x)], 1u);
            asm volatile("s_waitcnt vmcnt(0)" ::: "memory");
        } else {
            XB_SPIN(xb_ld(&bar[XB_XGEN(b.x)]) == gen, bar);
            __builtin_amdgcn_fence(__ATOMIC_ACQUIRE, "agent");
            asm volatile("s_waitcnt vmcnt(0)" ::: "memory");
        }
    }
    __syncthreads();
}

constexpr size_t al256(size_t x) { return (x + 255) & ~(size_t)255; }
constexpr size_t WS_CTL   = 0;
constexpr size_t CTL_BYTES = 32768;
constexpr size_t CW_CNT   = XCD_BAR_WORDS + 64;
constexpr size_t WS_MOD   = WS_CTL + CTL_BYTES;
constexpr size_t WS_H     = al256(WS_MOD + (size_t)NB * 6 * D * 4);
constexpr size_t WS_PH    = al256(WS_H + (size_t)T * D * 4);
constexpr size_t WS_LW    = al256(WS_PH + (size_t)T * N_IN * 4);
constexpr size_t WS_LA    = al256(WS_LW + (size_t)T * 96 * 4);
constexpr size_t WS_LG    = al256(WS_LA + (size_t)T * 96 * 4);
constexpr size_t WS_WPRE  = al256(WS_LG + (size_t)T * 256 * 4);
constexpr size_t WS_APRE  = al256(WS_WPRE + (size_t)T * RW * 4);
constexpr size_t WS_GATE  = al256(WS_APRE + (size_t)T * RW * 4);
constexpr size_t WS_QN    = al256(WS_GATE + (size_t)T * RW * 4);
constexpr size_t WS_KN    = al256(WS_QN + (size_t)T * 512 * 4);
constexpr size_t WS_VC    = al256(WS_KN + (size_t)T * 512 * 4);
constexpr size_t WS_BETA  = al256(WS_VC + (size_t)T * RW * 4);
constexpr size_t WS_GG    = al256(WS_BETA + (size_t)T * 8 * 4);
constexpr size_t WS_WD    = al256(WS_GG + (size_t)T * 8 * 4);
constexpr size_t WS_AA    = al256(WS_WD + (size_t)T * RW * 4);
constexpr size_t WS_BB    = al256(WS_AA + (size_t)T * RW * 4);
constexpr size_t WS_KM    = al256(WS_BB + (size_t)T * RW * 4);
constexpr size_t WS_OG    = al256(WS_KM + (size_t)T * RW * 4);
constexpr size_t WS_YR    = al256(WS_OG + (size_t)T * RW * 4);
constexpr size_t WS_YG    = al256(WS_YR + (size_t)T * RW * 4);
constexpr size_t WS_YRW   = al256(WS_YG + (size_t)T * RW * 4);
constexpr size_t WS_MERGED= al256(WS_YRW + (size_t)T * RW * 4);
constexpr size_t WS_Y     = al256(WS_MERGED + (size_t)T * D * 4);
constexpr size_t WS_XMID  = al256(WS_Y + (size_t)T * D * 4);
constexpr size_t WS_H2    = al256(WS_XMID + (size_t)T * D * 4);
constexpr size_t WS_TOPP  = al256(WS_H2 + (size_t)T * D * 4);
constexpr size_t WS_LIST  = al256(WS_TOPP + (size_t)NA * 4);
constexpr size_t WS_ACT   = al256(WS_LIST + (size_t)NE * T * 4);
constexpr size_t WS_YB    = al256(WS_ACT + (size_t)NA * FF * 4);
constexpr size_t WS_END   = al256(WS_YB + (size_t)NA * D * 4);

struct Args {
    const float* in[36];
    float* out;
    unsigned char* ws;
    int ph_lo, ph_hi;
};

__device__ __forceinline__ float sigmoidf_(float x) { return 1.0f / (1.0f + expf(-x)); }
__device__ __forceinline__ float siluf_(float x) { return x * sigmoidf_(x); }
__device__ __forceinline__ float softplusf_(float x) { return fmaxf(x, 0.0f) + log1pf(expf(-fabsf(x))); }
__device__ __forceinline__ float rl(float x, int k) { return __int_as_float(__builtin_amdgcn_readlane(__float_as_int(x), k)); }
__device__ __forceinline__ float wave_sum(float v) {
#pragma unroll
    for (int o = 32; o > 0; o >>= 1) v += __shfl_xor(v, o);
    return v;
}
__device__ __forceinline__ float half_sum(float v) {
#pragma unroll
    for (int o = 16; o > 0; o >>= 1) v += __shfl_xor(v, o);
    return v;
}
__device__ __forceinline__ float block_sum(float v, float* red) {
    v = wave_sum(v);
    __syncthreads();
    if ((threadIdx.x & 63) == 0) red[threadIdx.x >> 6] = v;
    __syncthreads();
    float t = 0.f;
#pragma unroll
    for (int w = 0; w < NTHREADS / 64; ++w) t += red[w];
    return t;
}

constexpr int GBM = 128, GBN = 64, GBK = 16;
template <bool DUAL, class AL, class EP>
__device__ __forceinline__ void gemm_naive(float* sm, int M, int N, int K, const AL& al, const float* __restrict__ W, int ldw, int dual_off, const EP& ep) {
    float* As = sm;
    float* Bs = sm + GBK * (GBM + 4);
    float* Bs2 = Bs + GBK * (GBN + 4);
    const int tid = threadIdx.x, tx = tid & 15, ty = tid >> 4;
    const int ntm = (M + GBM - 1) / GBM, ntn = (N + GBN - 1) / GBN;
    for (int tile = blockIdx.x; tile < ntm * ntn; tile += gridDim.x) {
        const int tm = tile / ntn, tn = tile % ntn;
        const int m0 = tm * GBM, n0 = tn * GBN;
        float acc[4][4], acc2[4][4];
#pragma unroll
        for (int i = 0; i < 4; ++i)
#pragma unroll
            for (int j = 0; j < 4; ++j) { acc[i][j] = 0.f; acc2[i][j] = 0.f; }
        for (int k0 = 0; k0 < K; k0 += GBK) {
#pragma unroll
            for (int i = 0; i < 4; ++i) { const int idx = tid + i * NTHREADS, r = idx >> 4, kk = idx & 15; As[kk * (GBM + 4) + r] = al(m0 + r, k0 + kk); }
#pragma unroll
            for (int i = 0; i < 2; ++i) { const int idx = tid + i * NTHREADS, kk = idx >> 6, c = idx & 63, n = n0 + c;
                Bs[kk * (GBN + 4) + c] = (n < N) ? W[(size_t)(k0 + kk) * ldw + n] : 0.f;
                if (DUAL) Bs2[kk * (GBN + 4) + c] = (n < N) ? W[(size_t)(k0 + kk) * ldw + n + dual_off] : 0.f; }
            __syncthreads();
#pragma unroll
            for (int kk = 0; kk < GBK; ++kk) {
                float a[4], b[4], b2[4];
#pragma unroll
                for (int i = 0; i < 4; ++i) a[i] = As[kk * (GBM + 4) + ty * 4 + i];
#pragma unroll
                for (int j = 0; j < 4; ++j) { b[j] = Bs[kk * (GBN + 4) + tx * 4 + j]; b2[j] = DUAL ? Bs2[kk * (GBN + 4) + tx * 4 + j] : 0.f; }
#pragma unroll
                for (int i = 0; i < 4; ++i)
#pragma unroll
                    for (int j = 0; j < 4; ++j) { acc[i][j] = fmaf(a[i], b[j], acc[i][j]); if (DUAL) acc2[i][j] = fmaf(a[i], b2[j], acc2[i][j]); }
            }
            __syncthreads();
        }
#pragma unroll
        for (int i = 0; i < 4; ++i)
#pragma unroll
            for (int j = 0; j < 4; ++j) { const int m = m0 + ty * 4 + i, n = n0 + tx * 4 + j; if (m < M && n < N) ep(m, n, acc[i][j], acc2[i][j]); }
    }
}

struct ALPlain { const float* A; int lda; __device__ __forceinline__ float operator()(int m, int k) const { return A[(size_t)m * lda + k]; } };
struct ALMix {
    const float* H; const float* mix;
    __device__ __forceinline__ float operator()(int m, int k) const {
        const float h = H[(size_t)m * D + k];
        const float hp = ((m % SEQ) == 0) ? 0.f : H[(size_t)(m - 1) * D + k];
        return h + (hp - h) * mix[k];
    }
};
struct ALGatherTok { const float* H2; const int* list; int cnt; __device__ __forceinline__ float operator()(int m, int k) const { return (m < cnt) ? H2[(size_t)(list[m] >> 2) * D + k] : 0.f; } };
struct ALGatherAsg { const float* ACT; const int* list; int cnt; __device__ __forceinline__ float operator()(int m, int k) const { return (m < cnt) ? ACT[(size_t)list[m] * FF + k] : 0.f; } };

__global__ void __launch_bounds__(NTHREADS, 2) fwd(Args a) {
    extern __shared__ __attribute__((aligned(16))) unsigned char lds_raw[];
    float* sm = (float*)lds_raw;
    const int tid = threadIdx.x, lane = tid & 63, wave = tid >> 6;
    unsigned char* ws = a.ws;
    unsigned* ctl = (unsigned*)(ws + WS_CTL);
    volatile LAS unsigned* xbw = (volatile LAS unsigned*)(LAS unsigned char*)(lds_raw + LDS_BYTES - 16);
    if (tid == 0) { xbw[0] = 0u; xbw[1] = 0u; xbw[2] = 0u; xbw[3] = 0u; }
    __syncthreads();
    const int lo = a.ph_lo, hi = a.ph_hi;
    XcdBarrier bar; bar.bar = ctl; bar.x = 0; bar.st = xbw;
    if (hi - lo > 1) bar = xcd_barrier_post(ctl, xbw);
#define IN(k) (lo <= (k) && (k) < hi)
#define SEAM(k) do { if (IN(k) && IN((k) + 1)) xcd_barrier(bar); } while (0)

    const float* x = a.in[0]; const float* c = a.in[1]; const float* ada_w = a.in[2]; const float* ada_b = a.in[3];
    const float* norm_mix_pre = a.in[4]; const float* norm_mix_post = a.in[5]; const float* norm_ffn_pre = a.in[6]; const float* norm_ffn_post = a.in[7];
    const float* w_in = a.in[8]; const float* gdn_conv = a.in[9]; const float* gdn_A_log = a.in[10]; const float* gdn_dt_bias = a.in[11]; const float* gdn_norm = a.in[12];
    const float* rwkv_mix = a.in[13]; const float* rwkv_w0 = a.in[14]; const float* rwkv_w1 = a.in[15]; const float* rwkv_w2 = a.in[16];
    const float* rwkv_a0 = a.in[17]; const float* rwkv_a1 = a.in[18]; const float* rwkv_a2 = a.in[19]; const float* rwkv_g1 = a.in[20]; const float* rwkv_g2 = a.in[21];
    const float* rwkv_k_k = a.in[22]; const float* rwkv_k_a = a.in[23]; const float* rwkv_r_k = a.in[24]; const float* rwkv_ln_w = a.in[25]; const float* rwkv_ln_b = a.in[26];
    const float* w_up_gdn = a.in[27]; const float* w_up_rwkv = a.in[28]; const float* w_out = a.in[29]; const float* router_w = a.in[30]; const float* router_b = a.in[31];
    const float* exp_w_gu = a.in[32]; const float* exp_b_gu = a.in[33]; const float* exp_w_down = a.in[34]; const float* exp_b_down = a.in[35];

    float* MOD = (float*)(ws + WS_MOD); float* H = (float*)(ws + WS_H); float* PH = (float*)(ws + WS_PH);
    float* LW = (float*)(ws + WS_LW); float* LA = (float*)(ws + WS_LA); float* LG = (float*)(ws + WS_LG);
    float* WPRE = (float*)(ws + WS_WPRE); float* APRE = (float*)(ws + WS_APRE); float* GATE = (float*)(ws + WS_GATE);
    float* QN = (float*)(ws + WS_QN); float* KN = (float*)(ws + WS_KN); float* VC = (float*)(ws + WS_VC); float* BETA = (float*)(ws + WS_BETA); float* GG = (float*)(ws + WS_GG);
    float* WD = (float*)(ws + WS_WD); float* AA = (float*)(ws + WS_AA); float* BB = (float*)(ws + WS_BB); float* KM = (float*)(ws + WS_KM);
    float* OG = (float*)(ws + WS_OG); float* YR = (float*)(ws + WS_YR); float* YG = (float*)(ws + WS_YG); float* YRW = (float*)(ws + WS_YRW);
    float* MERGED = (float*)(ws + WS_MERGED); float* Y = (float*)(ws + WS_Y); float* XMID = (float*)(ws + WS_XMID); float* H2 = (float*)(ws + WS_H2);
    float* TOPP = (float*)(ws + WS_TOPP); int* LIST = (int*)(ws + WS_LIST); float* ACT = (float*)(ws + WS_ACT); float* YB = (float*)(ws + WS_YB);
    unsigned* CNT = ctl + CW_CNT;

    if (IN(0)) {
        float* sc = sm;
        for (int i = tid; i < NB * D; i += NTHREADS) sc[i] = siluf_(c[i]);
        __syncthreads();
        const int j = blockIdx.x * NTHREADS + tid;
        if (j < 6 * D) {
            float acc0 = 0.f, acc1 = 0.f, acc2 = 0.f, acc3 = 0.f;
            for (int i = 0; i < D; ++i) {
                const float w = ada_w[(size_t)i * (6 * D) + j];
                acc0 = fmaf(sc[i], w, acc0); acc1 = fmaf(sc[D + i], w, acc1); acc2 = fmaf(sc[2 * D + i], w, acc2); acc3 = fmaf(sc[3 * D + i], w, acc3);
            }
            const float bb = ada_b[j];
            MOD[j] = acc0 + bb; MOD[6 * D + j] = acc1 + bb; MOD[12 * D + j] = acc2 + bb; MOD[18 * D + j] = acc3 + bb;
        }
        __syncthreads();
    }
    SEAM(0);

    if (IN(1)) {
        for (int row = blockIdx.x; row < T; row += gridDim.x) {
            const int b = row / SEQ; const float* mod = MOD + (size_t)b * 6 * D;
            const float4 v = *(const float4*)(x + (size_t)row * D + tid * 4);
            const float ss = block_sum(v.x * v.x + v.y * v.y + v.z * v.z + v.w * v.w, sm);
            const float inv = rsqrtf(ss / D + EPS);
            const int d0 = tid * 4; float o[4]; const float vv[4] = {v.x, v.y, v.z, v.w};
#pragma unroll
            for (int i = 0; i < 4; ++i) { const int d = d0 + i; o[i] = vv[i] * inv * norm_mix_pre[d] * (1.0f + mod[D + d]) + mod[d]; }
            *(float4*)(H + (size_t)row * D + d0) = make_float4(o[0], o[1], o[2], o[3]);
        }
    }
    SEAM(1);

    if (IN(2)) {
        { ALPlain al{H, D}; auto ep = [=](int m, int n, float v, float) { PH[(size_t)m * N_IN + n] = v; };
          gemm_naive<false>(sm, T, COL_R, D, al, w_in, N_IN, 0, ep); }
        { ALMix al{H, rwkv_mix + 0 * D}; auto ep = [=](int m, int n, float v, float) { PH[(size_t)m * N_IN + COL_R + n] = v; };
          gemm_naive<false>(sm, T, RW, D, al, w_in + COL_R, N_IN, 0, ep); }
        { ALMix al{H, rwkv_mix + 2 * D}; auto ep = [=](int m, int n, float v, float) { PH[(size_t)m * N_IN + COL_RK + n] = v; };
          gemm_naive<false>(sm, T, RW, D, al, w_in + COL_RK, N_IN, 0, ep); }
        { ALMix al{H, rwkv_mix + 3 * D}; auto ep = [=](int m, int n, float v, float) { PH[(size_t)m * N_IN + COL_RV + n] = v; };
          gemm_naive<false>(sm, T, RW, D, al, w_in + COL_RV, N_IN, 0, ep); }
        { ALMix al{H, rwkv_mix + 1 * D}; auto ep = [=](int m, int n, float v, float) { LW[(size_t)m * 96 + n] = tanhf(v); };
          gemm_naive<false>(sm, T, 96, D, al, rwkv_w1, 96, 0, ep); }
        { ALMix al{H, rwkv_mix + 4 * D}; auto ep = [=](int m, int n, float v, float) { LA[(size_t)m * 96 + n] = v; };
          gemm_naive<false>(sm, T, 96, D, al, rwkv_a1, 96, 0, ep); }
        { ALMix al{H, rwkv_mix + 5 * D}; auto ep = [=](int m, int n, float v, float) { LG[(size_t)m * 256 + n] = sigmoidf_(v); };
          gemm_naive<false>(sm, T, 256, D, al, rwkv_g1, 256, 0, ep); }
    }
    SEAM(2);

    if (IN(3)) {
        { ALPlain al{LW, 96}; auto ep = [=](int m, int n, float v, float) { WPRE[(size_t)m * RW + n] = rwkv_w0[n] + v; };
          gemm_naive<false>(sm, T, RW, 96, al, rwkv_w2, RW, 0, ep); }
        { ALPlain al{LA, 96}; auto ep = [=](int m, int n, float v, float) { APRE[(size_t)m * RW + n] = rwkv_a0[n] + v; };
          gemm_naive<false>(sm, T, RW, 96, al, rwkv_a2, RW, 0, ep); }
        { ALPlain al{LG, 256}; auto ep = [=](int m, int n, float v, float) { GATE[(size_t)m * RW + n] = v; };
          gemm_naive<false>(sm, T, RW, 256, al, rwkv_g2, RW, 0, ep); }
        for (int row = blockIdx.x; row < T; row += gridDim.x) {
            const int s = row % SEQ; const int c0 = tid * 4;
            float v[4];
#pragma unroll
            for (int i = 0; i < 4; ++i) {
                const int ch = c0 + i; float acc = 0.f;
#pragma unroll
                for (int j = 0; j < 4; ++j) { const int sj = s - 3 + j; if (sj >= 0) acc = fmaf(gdn_conv[j * 2048 + ch], PH[(size_t)(row - 3 + j) * N_IN + ch], acc); }
                v[i] = siluf_(acc);
            }
            if (tid < 256) {
                float ss = v[0] * v[0] + v[1] * v[1] + v[2] * v[2] + v[3] * v[3];
                ss = half_sum(ss);
                float sc = rsqrtf(ss + 1e-6f);
                if (tid < 128) sc *= 0.08838834764831845f;
                float* dst = (tid < 128) ? (QN + (size_t)row * 512 + c0) : (KN + (size_t)row * 512 + (c0 - 512));
                *(float4*)dst = make_float4(v[0] * sc, v[1] * sc, v[2] * sc, v[3] * sc);
            } else {
                *(float4*)(VC + (size_t)row * RW + (c0 - 1024)) = make_float4(v[0], v[1], v[2], v[3]);
            }
            if (tid < 8) {
                BETA[(size_t)row * 8 + tid] = sigmoidf_(PH[(size_t)row * N_IN + COL_B + tid]);
                GG[(size_t)row * 8 + tid] = -expf(gdn_A_log[tid]) * softplusf_(PH[(size_t)row * N_IN + COL_A + tid] + gdn_dt_bias[tid]);
            }
        }
    }
    SEAM(3);

    if (IN(4)) {
        for (int row = blockIdx.x; row < T; row += gridDim.x) {
#pragma unroll
            for (int i = 0; i < 2; ++i) {
                const int ch = tid + i * NTHREADS;
                const float wp = WPRE[(size_t)row * RW + ch], ap = APRE[(size_t)row * RW + ch];
                const float wlog = -softplusf_(-wp) - 0.5f;
                const float wdec = expf(-expf(wlog));
                const float av = sigmoidf_(ap);
                const float kr = PH[(size_t)row * N_IN + COL_RK + ch];
                const float kkv = kr * rwkv_k_k[ch];
                const float ss = wave_sum(kkv * kkv);
                const float kk = kkv * rsqrtf(ss + 1e-6f);
                WD[(size_t)row * RW + ch] = wdec;
                AA[(size_t)row * RW + ch] = -kk;
                BB[(size_t)row * RW + ch] = kk * av;
                KM[(size_t)row * RW + ch] = kr * (1.0f + (av - 1.0f) * rwkv_k_a[ch]);
            }
        }
    }
    SEAM(4);

    if (IN(5)) {
        for (int item = blockIdx.x + gridDim.x * wave; item < 128; item += gridDim.x * (NTHREADS / 64)) {
            const int it = __builtin_amdgcn_readfirstlane(item);
            if (it < 64) {
                const int seq = it >> 1, half = it & 1, b = seq >> 3, hv = seq & 7, qh = hv >> 1;
                const int col = hv * 128 + half * 64 + lane;
                float S[128];
#pragma unroll
                for (int k = 0; k < 128; ++k) S[k] = 0.f;
                const size_t t0 = (size_t)b * SEQ;
                float k0n = KN[t0 * 512 + qh * 128 + lane], k1n = KN[t0 * 512 + qh * 128 + 64 + lane];
                float q0n = QN[t0 * 512 + qh * 128 + lane], q1n = QN[t0 * 512 + qh * 128 + 64 + lane];
                float vn_ = VC[t0 * RW + col], bn = BETA[t0 * 8 + hv], gn = GG[t0 * 8 + hv];
                for (int s = 0; s < SEQ; ++s) {
                    const size_t t = t0 + s;
                    const float k0 = k0n, k1 = k1n, q0 = q0n, q1 = q1n, vv = vn_, beta = bn, g = gn;
                    if (s + 1 < SEQ) {
                        const size_t tn = t + 1;
                        k0n = KN[tn * 512 + qh * 128 + lane]; k1n = KN[tn * 512 + qh * 128 + 64 + lane];
                        q0n = QN[tn * 512 + qh * 128 + lane]; q1n = QN[tn * 512 + qh * 128 + 64 + lane];
                        vn_ = VC[tn * RW + col]; bn = BETA[tn * 8 + hv]; gn = GG[tn * 8 + hv];
                    }
                    const float alpha = expf(g);
                    float dot = 0.f;
#pragma unroll
                    for (int k = 0; k < 64; ++k) { dot = fmaf(rl(k0, k), S[k], dot); dot = fmaf(rl(k1, k), S[64 + k], dot); }
                    const float vnew = beta * (vv - alpha * dot);
                    float o = 0.f;
#pragma unroll
                    for (int k = 0; k < 64; ++k) {
                        S[k] = fmaf(rl(k0, k), vnew, alpha * S[k]); o = fmaf(rl(q0, k), S[k], o);
                        S[64 + k] = fmaf(rl(k1, k), vnew, alpha * S[64 + k]); o = fmaf(rl(q1, k), S[64 + k], o);
                    }
                    OG[t * RW + col] = o;
                }
            } else {
                const int seq = it - 64, b = seq >> 4, h = seq & 15;
                const int ch = h * 64 + lane;
                float S[64];
#pragma unroll
                for (int k = 0; k < 64; ++k) S[k] = 0.f;
                const size_t t0 = (size_t)b * SEQ;
                float wn = WD[t0 * RW + ch], an = AA[t0 * RW + ch], bn = BB[t0 * RW + ch], kn = KM[t0 * RW + ch];
                float rn = PH[t0 * N_IN + COL_R + ch], vn_ = PH[t0 * N_IN + COL_RV + ch];
                for (int s = 0; s < SEQ; ++s) {
                    const size_t t = t0 + s;
                    const float w = wn, av = an, bv = bn, kv = kn, rv = rn, vv = vn_;
                    if (s + 1 < SEQ) {
                        const size_t tn = t + 1;
                        wn = WD[tn * RW + ch]; an = AA[tn * RW + ch]; bn = BB[tn * RW + ch]; kn = KM[tn * RW + ch];
                        rn = PH[tn * N_IN + COL_R + ch]; vn_ = PH[tn * N_IN + COL_RV + ch];
                    }
                    float sa = 0.f;
#pragma unroll
                    for (int k = 0; k < 64; ++k) sa = fmaf(S[k], rl(av, k), sa);
                    float y = 0.f;
#pragma unroll
                    for (int k = 0; k < 64; ++k) {
                        S[k] = fmaf(S[k], rl(w, k), fmaf(sa, rl(bv, k), vv * rl(kv, k)));
                        y = fmaf(S[k], rl(rv, k), y);
                    }
                    YR[t * RW + ch] = y;
                }
            }
        }
    }
    SEAM(5);

    if (IN(6)) {
        for (int row = blockIdx.x; row < T; row += gridDim.x) {
            {
                const int c0 = tid * 2;
                const float o0 = OG[(size_t)row * RW + c0], o1 = OG[(size_t)row * RW + c0 + 1];
                const float ss = wave_sum(o0 * o0 + o1 * o1);
                const float inv = rsqrtf(ss / 128.0f + EPS);
                const float z0 = PH[(size_t)row * N_IN + COL_Z + c0], z1 = PH[(size_t)row * N_IN + COL_Z + c0 + 1];
                YG[(size_t)row * RW + c0] = o0 * inv * gdn_norm[c0 & 127] * siluf_(z0);
                YG[(size_t)row * RW + c0 + 1] = o1 * inv * gdn_norm[(c0 + 1) & 127] * siluf_(z1);
            }
#pragma unroll
            for (int i = 0; i < 2; ++i) {
                const int ch = tid + i * NTHREADS;
                const float y = YR[(size_t)row * RW + ch];
                const float mu = wave_sum(y) * (1.0f / 64.0f);
                const float dlt = y - mu;
                const float var = wave_sum(dlt * dlt) * (1.0f / 64.0f);
                float yn = dlt * rsqrtf(var + 64e-5f) * rwkv_ln_w[ch] + rwkv_ln_b[ch];
                const float r = PH[(size_t)row * N_IN + COL_R + ch], km = KM[(size_t)row * RW + ch], vv = PH[(size_t)row * N_IN + COL_RV + ch];
                const float bsum = wave_sum(r * km * rwkv_r_k[ch]);
                yn += bsum * vv;
                YRW[(size_t)row * RW + ch] = yn * GATE[(size_t)row * RW + ch];
            }
        }
    }
    SEAM(6);

    if (IN(7)) {
        { ALPlain al{YG, RW}; auto ep = [=](int m, int n, float v, float) { MERGED[(size_t)m * D + n] = sigmoidf_(PH[(size_t)m * N_IN + COL_GATE + n]) * v; };
          gemm_naive<false>(sm, T, D, RW, al, w_up_gdn, D, 0, ep); }
        { ALPlain al{YRW, RW}; auto ep = [=](int m, int n, float v, float) { MERGED[(size_t)m * D + n] += sigmoidf_(PH[(size_t)m * N_IN + COL_GATE + D + n]) * v; };
          gemm_naive<false>(sm, T, D, RW, al, w_up_rwkv, D, 0, ep); }
    }
    SEAM(7);

    if (IN(8)) {
        ALPlain al{MERGED, D}; auto ep = [=](int m, int n, float v, float) { Y[(size_t)m * D + n] = v; };
        gemm_naive<false>(sm, T, D, D, al, w_out, D, 0, ep);
    }
    SEAM(8);

    if (IN(9)) {
        float* red = sm;
        float* h2s = sm + 64;
        float* part = sm + 64 + 2048;
        float* lg = part + 512;
        for (int row = blockIdx.x; row < T; row += gridDim.x) {
            const int b = row / SEQ; const float* mod = MOD + (size_t)b * 6 * D; const int d0 = tid * 4;
            const float4 yv = *(const float4*)(Y + (size_t)row * D + d0);
            const float4 xv = *(const float4*)(x + (size_t)row * D + d0);
            const float ss = block_sum(yv.x * yv.x + yv.y * yv.y + yv.z * yv.z + yv.w * yv.w, red);
            const float inv = rsqrtf(ss / D + EPS);
            const float ya[4] = {yv.x, yv.y, yv.z, yv.w}, xa[4] = {xv.x, xv.y, xv.z, xv.w};
            float xm[4]; float ss2 = 0.f;
#pragma unroll
            for (int i = 0; i < 4; ++i) { const int d = d0 + i; xm[i] = xa[i] + mod[2 * D + d] * (ya[i] * inv * norm_mix_post[d]); ss2 += xm[i] * xm[i]; }
            *(float4*)(XMID + (size_t)row * D + d0) = make_float4(xm[0], xm[1], xm[2], xm[3]);
            const float tot2 = block_sum(ss2, red);
            const float inv2 = rsqrtf(tot2 / D + EPS);
            float h2[4];
#pragma unroll
            for (int i = 0; i < 4; ++i) { const int d = d0 + i; h2[i] = xm[i] * inv2 * norm_ffn_pre[d] * (1.0f + mod[4 * D + d]) + mod[3 * D + d]; h2s[d] = h2[i]; }
            *(float4*)(H2 + (size_t)row * D + d0) = make_float4(h2[0], h2[1], h2[2], h2[3]);
            __syncthreads();
            { const int e = tid & 31, p = tid >> 5; float acc = 0.f;
              for (int d = p * 128; d < p * 128 + 128; ++d) acc = fmaf(h2s[d], router_w[(size_t)d * NE + e], acc);
              part[p * 32 + e] = acc; }
            __syncthreads();
            if (tid < 32) { float acc = router_b[tid];
#pragma unroll
                for (int p = 0; p < 16; ++p) acc += part[p * 32 + tid];
                lg[tid] = acc; }
            __syncthreads();
            if (tid == 0) {
                float l[NE];
#pragma unroll
                for (int e = 0; e < NE; ++e) l[e] = lg[e];
                int idx[TOPK]; float val[TOPK];
#pragma unroll
                for (int k = 0; k < TOPK; ++k) {
                    int bi = 0; float bv = -3.0e38f;
#pragma unroll
                    for (int e = 0; e < NE; ++e) if (l[e] > bv) { bv = l[e]; bi = e; }
                    idx[k] = bi; val[k] = bv;
#pragma unroll
                    for (int e = 0; e < NE; ++e) if (e == bi) l[e] = -3.0e38f;
                }
                float pe[TOPK], psum = 0.f;
#pragma unroll
                for (int k = 0; k < TOPK; ++k) { pe[k] = expf(val[k] - val[0]); psum += pe[k]; }
#pragma unroll
                for (int k = 0; k < TOPK; ++k) {
                    const int asg = row * TOPK + k;
                    TOPP[asg] = pe[k] / psum;
                    const unsigned pos = atomicAdd(&CNT[idx[k]], 1u);
                    LIST[(size_t)idx[k] * T + pos] = asg;
                }
            }
            __syncthreads();
        }
    }
    SEAM(9);

    if (IN(10)) {
        for (int e = 0; e < NE; ++e) {
            const int cnt = (int)__hip_atomic_load(&CNT[e], __ATOMIC_RELAXED, __HIP_MEMORY_SCOPE_AGENT);
            const int* list = LIST + (size_t)e * T;
            ALGatherTok al{H2, list, cnt};
            const float* bgu = exp_b_gu + (size_t)e * 2 * FF;
            auto ep = [=](int m, int n, float g, float u) {
                g += bgu[n]; u += bgu[FF + n];
                const float gl = fminf(g, 7.0f); const float up = fminf(fmaxf(u, -7.0f), 7.0f);
                ACT[(size_t)list[m] * FF + n] = gl * sigmoidf_(1.702f * gl) * (up + 1.0f);
            };
            gemm_naive<true>(sm, cnt, FF, D, al, exp_w_gu + (size_t)e * D * 2 * FF, 2 * FF, FF, ep);
        }
    }
    SEAM(10);

    if (IN(11)) {
        for (int e = 0; e < NE; ++e) {
            const int cnt = (int)__hip_atomic_load(&CNT[e], __ATOMIC_RELAXED, __HIP_MEMORY_SCOPE_AGENT);
            const int* list = LIST + (size_t)e * T;
            ALGatherAsg al{ACT, list, cnt};
            const float* bd = exp_b_down + (size_t)e * D;
            auto ep = [=](int m, int n, float v, float) { YB[(size_t)list[m] * D + n] = v + bd[n]; };
            gemm_naive<false>(sm, cnt, D, FF, al, exp_w_down + (size_t)e * FF * D, D, 0, ep);
        }
    }
    SEAM(11);

    if (IN(12)) {
        for (int row = blockIdx.x; row < T; row += gridDim.x) {
            const int b = row / SEQ; const float* mod = MOD + (size_t)b * 6 * D; const int d0 = tid * 4;
            float ym[4] = {0.f, 0.f, 0.f, 0.f};
#pragma unroll
            for (int k = 0; k < TOPK; ++k) {
                const int asg = row * TOPK + k; const float p = TOPP[asg];
                const float4 v = *(const float4*)(YB + (size_t)asg * D + d0);
                ym[0] = fmaf(p, v.x, ym[0]); ym[1] = fmaf(p, v.y, ym[1]); ym[2] = fmaf(p, v.z, ym[2]); ym[3] = fmaf(p, v.w, ym[3]);
            }
            const float ss = block_sum(ym[0] * ym[0] + ym[1] * ym[1] + ym[2] * ym[2] + ym[3] * ym[3], sm);
            const float inv = rsqrtf(ss / D + EPS);
            const float4 xm = *(const float4*)(XMID + (size_t)row * D + d0);
            const float xa[4] = {xm.x, xm.y, xm.z, xm.w}; float o[4];
#pragma unroll
            for (int i = 0; i < 4; ++i) { const int d = d0 + i; o[i] = xa[i] + mod[5 * D + d] * (ym[i] * inv * norm_ffn_post[d]); }
            *(float4*)(a.out + (size_t)row * D + d0) = make_float4(o[0], o[1], o[2], o[3]);
        }
    }
#undef IN
#undef SEAM
}

constexpr int NPHASES = 13;
#ifndef MK_ONE_LAUNCH
#define MK_ONE_LAUNCH 1
#endif

extern "C" void kernel_launch(void* const* d_in, const int* in_sizes, int n_in, void* d_out, int out_size, void* d_ws, size_t ws_size, hipStream_t stream) {
    static int grid = 0;
    if (grid == 0) {
        if (n_in != 36 || out_size != T * D || ws_size < WS_END) { fprintf(stderr, "kernel_launch: unexpected shapes n_in %d out %d ws %zu (need %zu)\n", n_in, out_size, ws_size, (size_t)WS_END); grid = -1; return; }
        int dev = 0, cus = 0, per_cu = 0;
        if (hipGetDevice(&dev) != hipSuccess || hipDeviceGetAttribute(&cus, hipDeviceAttributeMultiprocessorCount, dev) != hipSuccess) { grid = -1; return; }
        if (hipFuncSetAttribute((const void*)fwd, hipFuncAttributeMaxDynamicSharedMemorySize, LDS_BYTES) != hipSuccess) { fprintf(stderr, "kernel_launch: hipFuncSetAttribute failed\n"); grid = -1; return; }
        if (hipOccupancyMaxActiveBlocksPerMultiprocessor(&per_cu, (const void*)fwd, NTHREADS, LDS_BYTES) != hipSuccess || per_cu < 1) { fprintf(stderr, "kernel_launch: occupancy query says %d\n", per_cu); }
        (void)hipGetLastError();
        grid = cus;
    }
    if (grid < 0) return;
    (void)hipMemsetAsync((char*)d_ws + WS_CTL, 0, CTL_BYTES, stream);
    Args a{};
    for (int i = 0; i < 36; ++i) a.in[i] = (const float*)d_in[i];
    a.out = (float*)d_out; a.ws = (unsigned char*)d_ws;
#if MK_ONE_LAUNCH
    a.ph_lo = 0; a.ph_hi = NPHASES;
    hipLaunchKernelGGL(fwd, dim3(grid), dim3(NTHREADS), LDS_BYTES, stream, a);
#else
    for (int p = 0; p < NPHASES; ++p) {
        a.ph_lo = p; a.ph_hi = p + 1;
        hipLaunchKernelGGL(fwd, dim3(grid), dim3(NTHREADS), LDS_BYTES, stream, a);
    }
#endif
}
```

```cpp
#include <hip/hip_runtime.h>
#include <cstdio>
#include <cstdint>

constexpr int D = 2048, NB = 4, SEQ = 4096, T = NB * SEQ;
constexpr int COL_K = 512, COL_V = 1024, COL_Z = 2048, COL_B = 3072, COL_A = 3080, COL_GATE = 3088, COL_R = 7184, COL_RK = 8208, COL_RV = 9232, N_IN = 10256;
constexpr int NE = 32, TOPK = 4, FF = 2048, NA = T * TOPK;
constexpr int RW = 1024;
constexpr float EPS = 1e-6f;
constexpr int NTHREADS = 512;
constexpr int LDS_BYTES = 128 * 1024 + 4096;

#define XB_TMO      128
#define XB_XCNT(j)  (256  + 64 * (j))
#define XB_XSUB(j)  (1280 + 64 * (j))
#define XB_XGEN(j)  (2304 + 64 * (j))
#define XB_TOP      3328
#define XB_TOPGEN   3392
#define XCD_BAR_WORDS 3456
#define XB_SPIN_CAP (1u << 22)
#define LAS __attribute__((address_space(3)))
__device__ __forceinline__ unsigned xb_ld(unsigned* p)              { return __hip_atomic_load(p, __ATOMIC_RELAXED, __HIP_MEMORY_SCOPE_AGENT); }
__device__ __forceinline__ unsigned xb_add(unsigned* p, unsigned v) { return __hip_atomic_fetch_add(p, v, __ATOMIC_RELAXED, __HIP_MEMORY_SCOPE_AGENT); }
__device__ __forceinline__ unsigned xb_xcc_id() { return (unsigned)__builtin_amdgcn_s_getreg((3 << 11) | 20) & 0xFu; }
#define XB_SPIN(cond, bar) do { unsigned _sp = 0; while (cond) { __builtin_amdgcn_s_sleep(1); \
    if ((++_sp & 255u) == 0u) { if (xb_ld(&(bar)[XB_TMO])) break; if (_sp > XB_SPIN_CAP) { atomicAdd(&(bar)[XB_TMO], 1u); break; } } } } while (0)
struct XcdBarrier { unsigned* bar; unsigned x; volatile LAS unsigned* st; };
__device__ __forceinline__ XcdBarrier xcd_barrier_post(unsigned* bar, volatile LAS unsigned* st) {
    XcdBarrier b; b.bar = bar; b.x = xb_xcc_id(); b.st = st;
    if (threadIdx.x == 0) (void)xb_add(&bar[XB_XCNT(b.x)], 1u);
    return b;
}
__device__ __forceinline__ void xcd_barrier_complete(unsigned* bar, unsigned x, unsigned& nloc, unsigned& nx) {
    const unsigned G = gridDim.x * gridDim.y * gridDim.z;
    unsigned sum, cnt, mine, sp = 0u;
    for (;;) {
        sum = 0u; cnt = 0u; mine = 0u;
#pragma unroll
        for (unsigned j = 0; j < 16; ++j) { const unsigned c = xb_ld(&bar[XB_XCNT(j)]); sum += c; cnt += (c > 0u) ? 1u : 0u; mine = (j == x) ? c : mine; }
        if (sum == G) break;
        __builtin_amdgcn_s_sleep(1);
        if ((++sp & 255u) == 0u) { if (xb_ld(&bar[XB_TMO])) break; if (sp > XB_SPIN_CAP) { atomicAdd(&bar[XB_TMO], 1u); break; } }
    }
    nloc = mine > 0u ? mine : 1u; nx = cnt > 0u ? cnt : 1u;
}
__device__ __forceinline__ void xcd_barrier(const XcdBarrier& b) {
    asm volatile("s_waitcnt vmcnt(0)" ::: "memory");
    __syncthreads();
    if (threadIdx.x == 0) {
        unsigned* bar = b.bar;
        __builtin_amdgcn_s_waitcnt(0);
        unsigned nloc = b.st[0], nx = b.st[1];
        if (nloc == 0u) { xcd_barrier_complete(bar, b.x, nloc, nx); b.st[0] = nloc; b.st[1] = nx; }
        const unsigned old = xb_add(&bar[XB_XSUB(b.x)], 1u);
        const unsigned gen = old / nloc;
        if (old + 1u == (gen + 1u) * nloc) {
            __builtin_amdgcn_fence(__ATOMIC_RELEASE, "agent");
            asm volatile("s_waitcnt vmcnt(0)" ::: "memory");
            const unsigned og = xb_add(&bar[XB_TOP], 1u);
            const unsigned tg = og / nx;
            if (og + 1u == (tg + 1u) * nx) xb_add(&bar[XB_TOPGEN], 1u);
            else XB_SPIN(xb_ld(&bar[XB_TOPGEN]) == tg, bar);
            __builtin_amdgcn_fence(__ATOMIC_ACQUIRE, "agent");
            xb_add(&bar[XB_XGEN(b.x)], 1u);
            asm volatile("s_waitcnt vmcnt(0)" ::: "memory");
        } else {
            XB_SPIN(xb_ld(&bar[XB_XGEN(b.x)]) == gen, bar);
            __builtin_amdgcn_fence(__ATOMIC_ACQUIRE, "agent");
            asm volatile("s_waitcnt vmcnt(0)" ::: "memory");
        }
    }
    __syncthreads();
}

constexpr size_t al256(size_t x) { return (x + 255) & ~(size_t)255; }
constexpr size_t WS_CTL   = 0;
constexpr size_t CTL_BYTES = 32768;
constexpr size_t CW_CNT   = XCD_BAR_WORDS + 64;
constexpr size_t WS_MOD   = WS_CTL + CTL_BYTES;
constexpr size_t WS_H     = al256(WS_MOD + (size_t)NB * 6 * D * 4);
constexpr size_t WS_WINT  = al256(WS_H + (size_t)7 * T * D * 2);
constexpr int NT_IN = 44;
constexpr size_t WS_PH    = al256(WS_WINT + (size_t)NT_IN * 256 * D * 2);
constexpr size_t WS_LWA   = al256(WS_PH + (size_t)T * N_IN * 4);
constexpr size_t WS_LGB   = al256(WS_LWA + (size_t)T * 256 * 2);
constexpr size_t WS_L2T   = al256(WS_LGB + (size_t)T * 256 * 2);
constexpr size_t WS_WPRE  = al256(WS_L2T + (size_t)3 * RW * 256 * 2);
constexpr size_t WS_APRE  = al256(WS_WPRE + (size_t)T * RW * 4);
constexpr size_t WS_GATE  = al256(WS_APRE + (size_t)T * RW * 4);
constexpr size_t WS_WD    = al256(WS_GATE + (size_t)T * RW * 4);
constexpr size_t WS_AA    = al256(WS_WD + (size_t)T * RW * 4);
constexpr size_t WS_BB    = al256(WS_AA + (size_t)T * RW * 4);
constexpr size_t WS_KM    = al256(WS_BB + (size_t)T * RW * 4);
constexpr size_t WS_OG    = al256(WS_KM + (size_t)T * RW * 4);
constexpr size_t WS_YR    = al256(WS_OG + (size_t)T * RW * 4);
constexpr size_t WS_MERGED= al256(WS_YR + (size_t)T * RW * 4);
constexpr size_t WS_Y     = al256(WS_MERGED + (size_t)T * D * 4);
constexpr size_t WS_XMID  = al256(WS_Y + (size_t)T * D * 4);
constexpr size_t WS_H2B   = al256(WS_XMID + (size_t)T * D * 4);
constexpr size_t WS_TOPP  = al256(WS_H2B + (size_t)T * D * 2);
constexpr size_t WS_LIST  = al256(WS_TOPP + (size_t)NA * 4);
constexpr int ACT_ROWS = NA + NE * 256;
constexpr size_t WS_ACT   = al256(WS_LIST + (size_t)NE * T * 4);
constexpr size_t WS_YB    = al256(WS_ACT + (size_t)ACT_ROWS * FF * 2);
constexpr size_t WS_WGU   = al256(WS_YB + (size_t)NA * D * 2);
constexpr size_t WS_WDN   = al256(WS_WGU + (size_t)NE * 2 * FF * D * 2);
constexpr size_t WS_YGB   = al256(WS_WDN + (size_t)NE * D * FF * 2);
constexpr size_t WS_YRWB  = al256(WS_YGB + (size_t)T * RW * 2);
constexpr size_t WS_WUPG  = al256(WS_YRWB + (size_t)T * RW * 2);
constexpr size_t WS_WUPR  = al256(WS_WUPG + (size_t)D * RW * 2);
constexpr size_t WS_WOUT  = al256(WS_WUPR + (size_t)D * RW * 2);
constexpr size_t WS_MRGB  = al256(WS_WOUT + (size_t)D * D * 2);
constexpr size_t WS_GREC  = al256(WS_MRGB + (size_t)T * D * 2);
constexpr size_t WS_END   = al256(WS_GREC + (size_t)2048 * 90368);

struct Args {
    const float* in[36];
    float* out;
    unsigned char* ws;
    int ph_lo, ph_hi;
};

__device__ __forceinline__ float sigmoidf_(float x) { return 1.0f / (1.0f + expf(-x)); }
__device__ __forceinline__ float siluf_(float x) { return x * sigmoidf_(x); }
__device__ __forceinline__ float softplusf_(float x) { return fmaxf(x, 0.0f) + log1pf(expf(-fabsf(x))); }
__device__ __forceinline__ float rl(float x, int k) { return __int_as_float(__builtin_amdgcn_readlane(__float_as_int(x), k)); }
__device__ __forceinline__ float wave_sum(float v) {
#pragma unroll
    for (int o = 32; o > 0; o >>= 1) v += __shfl_xor(v, o);
    return v;
}
__device__ __forceinline__ float half_sum(float v) {
#pragma unroll
    for (int o = 16; o > 0; o >>= 1) v += __shfl_xor(v, o);
    return v;
}
__device__ __forceinline__ float block_sum(float v, float* red) {
    v = wave_sum(v);
    __syncthreads();
    if ((threadIdx.x & 63) == 0) red[threadIdx.x >> 6] = v;
    __syncthreads();
    float t = 0.f;
#pragma unroll
    for (int w = 0; w < NTHREADS / 64; ++w) t += red[w];
    return t;
}

constexpr int GBM = 128, GBN = 64, GBK = 16;
template <bool DUAL, class AL, class EP>
__device__ __forceinline__ void gemm_naive(float* sm, int M, int N, int K, const AL& al, const float* __restrict__ W, int ldw, int dual_off, const EP& ep) {
    float* As = sm;
    float* Bs = sm + GBK * (GBM + 4);
    float* Bs2 = Bs + GBK * (GBN + 4);
    const int tid = threadIdx.x, tx = tid & 15, ty = tid >> 4;
    const int ntm = (M + GBM - 1) / GBM, ntn = (N + GBN - 1) / GBN;
    for (int tile = blockIdx.x; tile < ntm * ntn; tile += gridDim.x) {
        const int tm = tile / ntn, tn = tile % ntn;
        const int m0 = tm * GBM, n0 = tn * GBN;
        float acc[4][4], acc2[4][4];
#pragma unroll
        for (int i = 0; i < 4; ++i)
#pragma unroll
            for (int j = 0; j < 4; ++j) { acc[i][j] = 0.f; acc2[i][j] = 0.f; }
        for (int k0 = 0; k0 < K; k0 += GBK) {
#pragma unroll
            for (int i = 0; i < 4; ++i) { const int idx = tid + i * NTHREADS, r = idx >> 4, kk = idx & 15; As[kk * (GBM + 4) + r] = al(m0 + r, k0 + kk); }
#pragma unroll
            for (int i = 0; i < 2; ++i) { const int idx = tid + i * NTHREADS, kk = idx >> 6, c = idx & 63, n = n0 + c;
                Bs[kk * (GBN + 4) + c] = (n < N) ? W[(size_t)(k0 + kk) * ldw + n] : 0.f;
                if (DUAL) Bs2[kk * (GBN + 4) + c] = (n < N) ? W[(size_t)(k0 + kk) * ldw + n + dual_off] : 0.f; }
            __syncthreads();
#pragma unroll
            for (int kk = 0; kk < GBK; ++kk) {
                float a[4], b[4], b2[4];
#pragma unroll
                for (int i = 0; i < 4; ++i) a[i] = As[kk * (GBM + 4) + ty * 4 + i];
#pragma unroll
                for (int j = 0; j < 4; ++j) { b[j] = Bs[kk * (GBN + 4) + tx * 4 + j]; b2[j] = DUAL ? Bs2[kk * (GBN + 4) + tx * 4 + j] : 0.f; }
#pragma unroll
                for (int i = 0; i < 4; ++i)
#pragma unroll
                    for (int j = 0; j < 4; ++j) { acc[i][j] = fmaf(a[i], b[j], acc[i][j]); if (DUAL) acc2[i][j] = fmaf(a[i], b2[j], acc2[i][j]); }
            }
            __syncthreads();
        }
#pragma unroll
        for (int i = 0; i < 4; ++i)
#pragma unroll
            for (int j = 0; j < 4; ++j) { const int m = m0 + ty * 4 + i, n = n0 + tx * 4 + j; if (m < M && n < N) ep(m, n, acc[i][j], acc2[i][j]); }
    }
}

struct ALPlain { const float* A; int lda; __device__ __forceinline__ float operator()(int m, int k) const { return A[(size_t)m * lda + k]; } };
struct ALMix {
    const float* H; const float* mix;
    __device__ __forceinline__ float operator()(int m, int k) const {
        const float h = H[(size_t)m * D + k];
        const float hp = ((m % SEQ) == 0) ? 0.f : H[(size_t)(m - 1) * D + k];
        return h + (hp - h) * mix[k];
    }
};
struct ALGatherTok { const float* H2; const int* list; int cnt; __device__ __forceinline__ float operator()(int m, int k) const { return (m < cnt) ? H2[(size_t)(list[m] >> 2) * D + k] : 0.f; } };
struct ALGatherAsg { const float* ACT; const int* list; int cnt; __device__ __forceinline__ float operator()(int m, int k) const { return (m < cnt) ? ACT[(size_t)list[m] * FF + k] : 0.f; } };

namespace pg8 {
#define PG8_LAS __attribute__((address_space(3)))
typedef unsigned short bf16_t;
typedef short bf16x8 __attribute__((ext_vector_type(8)));
typedef float f32x4 __attribute__((ext_vector_type(4)));
typedef unsigned u32x4 __attribute__((ext_vector_type(4)));
typedef unsigned u32x2 __attribute__((ext_vector_type(2)));
constexpr int BM = 256, BK = 64, HALF = 128, HTB = HALF * BK * 2, STAGE_BYTES = 8 * HTB, NXCD = 8, WGM = 8;
__host__ __device__ __forceinline__ int lds_byte(int r, int c) { const int st = (r >> 4) * 2 + (c >> 5), rr = r & 15, cc = c & 31, ob = rr * 64 + cc * 2; return st * 1024 + (ob ^ (((ob >> 9) & 1) << 5)); }
__host__ __device__ __forceinline__ void stage_rc(int b, int& R, int& C) { const int st = b / 1024, sb = b % 1024, swz = sb ^ (((sb >> 9) & 1) << 5); R = (st >> 1) * 16 + swz / 64; C = (st & 1) * 32 + (swz % 64) / 2; }
__host__ __device__ __forceinline__ int perm32(int rho) { const int n = rho >> 4, i = rho & 15; return 8 * (i >> 2) + 4 * n + (i & 3); }
struct Unit { int pm, pn; const char* A; const char* B; const int* list; int cnt, e, prow; };
typedef __bf16 bf16x2_t __attribute__((ext_vector_type(2)));
__device__ __forceinline__ unsigned cvt_pk_bf16(float lo, float hi) { bf16x2_t v; v.x = (__bf16)lo; v.y = (__bf16)hi; return __builtin_bit_cast(unsigned, v); }
__device__ __forceinline__ bool static_order(int nM, int nN, int G, int c, int i, int& pm, int& pn) {
    const int nwg = nM * nN; const long L = (long)i * G + c; if (L >= nwg) return false;
    int wgid = (int)L; { const int q = nwg / NXCD, r = nwg % NXCD, xcd = wgid % NXCD, off = wgid / NXCD; wgid = (xcd < r ? xcd * (q + 1) : r * (q + 1) + (xcd - r) * q) + off; }
    const int nig = WGM * nN, gid = wgid / nig, fm = gid * WGM, gsz = (nM - fm) < WGM ? (nM - fm) : WGM;
    pm = fm + ((wgid % nig) % gsz); pn = (wgid % nig) / gsz; return true;
}
template <class Epi, class Sched, bool ALIGN_EPI = true, bool GATHER = false>
__device__ __forceinline__ void gemm_phase(PG8_LAS unsigned char* lds, const int K_, const Sched& S, const Epi& E) {
    const int tid = threadIdx.x, wid = __builtin_amdgcn_readfirstlane(tid >> 6), lane = tid & 63, wr = wid >> 2, wc = wid & 3, fr = lane & 15, fq = lane >> 4;
    const int K = K_, nt = K / BK;
    unsigned voffA[2], voffB[2];
#pragma unroll
    for (int i = 0; i < 2; ++i) { int R, C; stage_rc(tid * 16 + i * 8192, R, C); const int Rb = Epi::PERM ? ((R & ~31) + perm32(R & 31)) : R;
        voffA[i] = (unsigned)(R * K + C) * 2u; voffB[i] = (unsigned)(Rb * K + C) * 2u; }
    const size_t kstep = (size_t)(BK * 2);
    const size_t hstep = (size_t)HALF * K * 2;
    const size_t tstep = 2 * hstep; (void)tstep;
    const unsigned ldsw = (unsigned)wid * 1024u;
    const int aoff = lds_byte(wr * 64 + fr, fq * 8), boff = lds_byte(wc * 32 + fr, fq * 8);
    constexpr bool SP2 = true;
    unsigned vA_c[2][2];
    PG8_LAS unsigned* gtab = (PG8_LAS unsigned*)(lds + STAGE_BYTES + 1024);
#define PG8_FILLTAB(u) do { if (tid < 256) { const int _m = (u).pm * 256 + tid; const int _tok = (_m < (u).cnt) ? ((u).list[_m] >> 2) : 0; gtab[tid] = (unsigned)_tok * (unsigned)(K * 2); } } while (0)
#define PG8_SETVA(v, u) do { _Pragma("unroll") for (int _h = 0; _h < 2; ++_h) _Pragma("unroll") for (int _i = 0; _i < 2; ++_i) { \
        if constexpr (GATHER) { int _R, _C; stage_rc(tid * 16 + _i * 8192, _R, _C); (v)[_h][_i] = gtab[_h * 128 + _R] + (unsigned)(_C * 2); } \
        else (v)[_h][_i] = voffA[_i] + (unsigned)(_h * hstep); } } while (0)
#define PG8_STAGE_A(bufoff, gbase, h, nx) do { _Pragma("unroll") for (int _i = 0; _i < 2; ++_i) { \
        __builtin_amdgcn_global_load_lds((const unsigned*)((const char*)(gbase) + vA_c[h][_i]), (PG8_LAS unsigned*)(lds + (bufoff) + ldsw + _i * 8192), 16, 0, 0); } } while (0)
#define PG8_SA(b, h) (((b) * 2 + (h)) * HTB)
#define PG8_SB(b, h) ((4 + (b) * 2 + (h)) * HTB)
#define PG8_STAGE(bufoff, gbase, voff) do { _Pragma("unroll") for (int _i = 0; _i < 2; ++_i) \
        __builtin_amdgcn_global_load_lds((const unsigned*)((const char*)(gbase) + (voff)[_i]), (PG8_LAS unsigned*)(lds + (bufoff) + ldsw + _i * 8192), 16, 0, 0); } while (0)
#define PG8_LDA(dst, b, h) do { _Pragma("unroll") for (int m = 0; m < 4; ++m) _Pragma("unroll") for (int k = 0; k < 2; ++k) dst[m][k] = *(const PG8_LAS bf16x8*)(lds + PG8_SA(b, h) + aoff + m * 2048 + k * 1024); } while (0)
#define PG8_LDB(dst, b, h) do { _Pragma("unroll") for (int n = 0; n < 2; ++n) _Pragma("unroll") for (int k = 0; k < 2; ++k) dst[n][k] = *(const PG8_LAS bf16x8*)(lds + PG8_SB(b, h) + boff + n * 2048 + k * 1024); } while (0)
#define PG8_MMA(ai, bj, At, Bt) do { __builtin_amdgcn_s_setprio(1); _Pragma("unroll") for (int m = 0; m < 4; ++m) _Pragma("unroll") for (int n = 0; n < 2; ++n) _Pragma("unroll") for (int k = 0; k < 2; ++k) \
        acc[ai][bj][m][n] = __builtin_amdgcn_mfma_f32_16x16x32_bf16(Bt[n][k], At[m][k], acc[ai][bj][m][n], 0, 0, 0); __builtin_amdgcn_s_setprio(0); } while (0)
#define PG8_WAIT_V(n) asm volatile("s_waitcnt vmcnt(" #n ")" ::: "memory")
#define PG8_WAIT_L(n) asm volatile("s_waitcnt lgkmcnt(" #n ")" ::: "memory")
#define PG8_BAR __builtin_amdgcn_s_barrier()
#define PG8_SCHED __builtin_amdgcn_sched_barrier(0)
    Unit cur, nxt; int ui = 0;
    if (!S.next(0, cur)) return;
    f32x4 acc[2][2][4][2];
#pragma unroll
    for (int a = 0; a < 2; ++a)
#pragma unroll
        for (int b = 0; b < 2; ++b)
#pragma unroll
            for (int m = 0; m < 4; ++m)
#pragma unroll
                for (int n = 0; n < 2; ++n) acc[a][b][m][n] = (f32x4){0.f, 0.f, 0.f, 0.f};
    bf16x8 At[4][2], B0[2][2], B1[2][2];
    const char* cA = cur.A; const char* cB = cur.B;
    S.a_ready(cur);
    if constexpr (GATHER) { PG8_FILLTAB(cur); __syncthreads(); }
    PG8_SETVA(vA_c, cur);
    if constexpr (GATHER) __syncthreads();
    if constexpr (SP2) {
        PG8_STAGE(PG8_SB(0, 0), cB, voffB); PG8_STAGE(PG8_SB(0, 1), cB + hstep, voffB); PG8_STAGE_A(PG8_SA(0, 0), cA, 0, false); PG8_STAGE_A(PG8_SA(0, 1), cA, 1, false);
        if (wr == 1) PG8_BAR;
        PG8_WAIT_V(2); PG8_BAR;
        PG8_STAGE(PG8_SB(1, 0), cB + kstep, voffB); PG8_STAGE_A(PG8_SA(1, 0), cA + kstep, 0, false); PG8_STAGE(PG8_SB(1, 1), cB + hstep + kstep, voffB);
        PG8_WAIT_V(6); PG8_BAR;
    }
    for (;;) {
        const bool has_next = S.next(ui + 1, nxt);
        const char* nA = has_next ? nxt.A : cA; const char* nB = has_next ? nxt.B : cB;
        if constexpr (GATHER) { if (has_next) PG8_FILLTAB(nxt); }
        for (int t = 0; t < nt; t += 2) {
            const bool last = (t == nt - 2); const bool lastn = last && has_next; (void)lastn;
            const char* a1 = cA + (size_t)(t + 1) * kstep;
            const char* a2 = last ? nA : cA + (size_t)(t + 2) * kstep; const char* b2 = last ? nB : cB + (size_t)(t + 2) * kstep;
            const char* a3 = a2 + kstep; const char* b3 = b2 + kstep;
            if (last && has_next) S.a_ready(nxt);
            if constexpr (SP2) {
            PG8_LDB(B0, 0, 0); PG8_LDB(B1, 0, 1); PG8_SCHED; PG8_LDA(At, 0, 0); PG8_STAGE_A(PG8_SA(1, 1), a1, 1, false);
            PG8_WAIT_V(8); PG8_WAIT_L(0); PG8_BAR; PG8_MMA(0, 0, At, B0); PG8_MMA(0, 1, At, B1); PG8_BAR; PG8_SCHED;
            if constexpr (GATHER) { if (lastn) PG8_SETVA(vA_c, nxt); }
            PG8_LDA(At, 0, 1); PG8_STAGE(PG8_SB(0, 0), b2, voffB); PG8_STAGE(PG8_SB(0, 1), b2 + hstep, voffB); PG8_STAGE_A(PG8_SA(0, 0), a2, 0, lastn);
            PG8_WAIT_V(8); PG8_WAIT_L(0); PG8_BAR; PG8_MMA(1, 0, At, B0); PG8_MMA(1, 1, At, B1); PG8_BAR; PG8_SCHED;
            PG8_LDB(B0, 1, 0); PG8_LDB(B1, 1, 1); PG8_SCHED; PG8_LDA(At, 1, 0); PG8_STAGE_A(PG8_SA(0, 1), a2, 1, lastn);
            PG8_WAIT_V(8); PG8_WAIT_L(0); PG8_BAR; PG8_MMA(0, 0, At, B0); PG8_MMA(0, 1, At, B1); PG8_BAR; PG8_SCHED;
            PG8_LDA(At, 1, 1); PG8_STAGE(PG8_SB(1, 0), b3, voffB); PG8_STAGE(PG8_SB(1, 1), b3 + hstep, voffB); PG8_STAGE_A(PG8_SA(1, 0), a3, 0, lastn);
            PG8_WAIT_V(8); PG8_WAIT_L(0); PG8_BAR; PG8_MMA(1, 0, At, B0); PG8_MMA(1, 1, At, B1); PG8_BAR; PG8_SCHED;
            }
        }
        if constexpr (ALIGN_EPI) { if (wr == 0) PG8_BAR; }
        if constexpr (!Epi::AFTER_DRAIN) { E(acc, cur, wr, wc, fr, fq); S.done(cur); }
        if (!has_next) break;
#pragma unroll
        for (int a = 0; a < 2; ++a)
#pragma unroll
            for (int b = 0; b < 2; ++b)
#pragma unroll
                for (int m = 0; m < 4; ++m)
#pragma unroll
                    for (int n = 0; n < 2; ++n) acc[a][b][m][n] = (f32x4){0.f, 0.f, 0.f, 0.f};
        cur = nxt; cA = nA; cB = nB; ++ui;
        if constexpr (ALIGN_EPI) { if (wr == 1) PG8_BAR; }
    }
    PG8_WAIT_V(0);
    if constexpr (!ALIGN_EPI) { if (wr == 0) PG8_BAR; }
    PG8_BAR;
    if constexpr (Epi::AFTER_DRAIN) { E.fused(acc, cur, wr, wc, fr, fq, lds, wid, lane); S.done(cur); }
#undef PG8_SA
#undef PG8_SB
#undef PG8_STAGE
#undef PG8_STAGE_A
#undef PG8_SETVA
#undef PG8_FILLTAB
#undef PG8_LDA
#undef PG8_LDB
#undef PG8_MMA
#undef PG8_WAIT_V
#undef PG8_WAIT_L
#undef PG8_BAR
#undef PG8_SCHED
}
}


typedef float f32x4_t __attribute__((ext_vector_type(4)));
struct SchedInProj {
    int G, c; const char* Abase; const char* Bt;
    __device__ __forceinline__ bool next(int i, pg8::Unit& u) const {
        int pm, pn; if (!pg8::static_order(T / 256, NT_IN, G, c, i, pm, pn)) return false;
        const int ai = pn < 29 ? 0 : pn < 33 ? 1 : pn < 37 ? 3 : pn < 41 ? 4 : pn == 41 ? 2 : pn == 42 ? 5 : 6;
        u.pm = pm; u.pn = pn; u.A = Abase + ((size_t)ai * T + (size_t)pm * 256) * D * 2; u.B = Bt + (size_t)pn * 256 * D * 2; u.list = nullptr; u.cnt = 0; u.e = 0; u.prow = 0; return true;
    }
    __device__ __forceinline__ void a_ready(const pg8::Unit&) const {}
    __device__ __forceinline__ void done(const pg8::Unit&) const {}
};
__device__ __forceinline__ float fast_sigmoid(float x) { return __builtin_amdgcn_rcpf(1.0f + __builtin_amdgcn_exp2f(-1.4426950408889634f * x)); }
__device__ __forceinline__ float fast_tanh(float x) { return 1.0f - 2.0f * __builtin_amdgcn_rcpf(1.0f + __builtin_amdgcn_exp2f(2.8853900817779268f * x)); }
struct EpiInProjF32 {
    static constexpr bool PERM = true, AFTER_DRAIN = false;
    float* PH; unsigned short* LWA; unsigned short* LGB;
    __device__ __forceinline__ void operator()(const pg8::f32x4 (&acc)[2][2][4][2], const pg8::Unit& u, int wr, int wc, int fr, int fq) const {
        const int pn = u.pn; float* base = PH; unsigned short* b16 = LWA; int ncol = 256, act = 0, c16 = 0;
        if (pn < 12) base = PH + pn * 256;
        else if (pn < 28) base = PH + COL_GATE + (pn - 12) * 256;
        else if (pn == 28) { base = PH + COL_B; ncol = 16; }
        else if (pn < 41) base = PH + COL_R + (pn - 29) * 256;
        else if (pn == 41) { act = 1; ncol = 128; }
        else if (pn == 42) { act = 3; ncol = 128; c16 = 128; }
        else { act = 2; b16 = LGB; }
        const unsigned row0 = (unsigned)u.pm * 256u + wr * 64 + fr;
#pragma unroll
        for (int ai = 0; ai < 2; ++ai)
#pragma unroll
            for (int m = 0; m < 4; ++m) {
                const unsigned row = row0 + ai * 128 + m * 16;
#pragma unroll
                for (int bj = 0; bj < 2; ++bj) {
                    const int cl = bj * 128 + wc * 32 + 8 * fq;
                    pg8::f32x4 v0 = acc[ai][bj][m][0], v1 = acc[ai][bj][m][1];
                    if (act == 0) { if (cl < ncol) { float* dst = base + (size_t)(row * (unsigned)N_IN + (unsigned)cl); *(pg8::f32x4*)dst = v0; *(pg8::f32x4*)(dst + 4) = v1; } }
                    else {
                        if (act == 1) {
#pragma unroll
                            for (int j = 0; j < 4; ++j) { v0[j] = fast_tanh(v0[j]); v1[j] = fast_tanh(v1[j]); } }
                        if (act == 2) {
#pragma unroll
                            for (int j = 0; j < 4; ++j) { v0[j] = fast_sigmoid(v0[j]); v1[j] = fast_sigmoid(v1[j]); } }
                        if (act != 2 && cl >= 96) { v0 = (pg8::f32x4){0.f, 0.f, 0.f, 0.f}; v1 = v0; }
                        if (cl < ncol) { pg8::u32x4 w; w.x = pg8::cvt_pk_bf16(v0[0], v0[1]); w.y = pg8::cvt_pk_bf16(v0[2], v0[3]); w.z = pg8::cvt_pk_bf16(v1[0], v1[1]); w.w = pg8::cvt_pk_bf16(v1[2], v1[3]);
                            *(pg8::u32x4*)(b16 + (size_t)row * 256 + c16 + cl) = w; }
                    }
                }
            }
    }
};
struct SchedLora {
    int G, c; const char* LWA; const char* LGB; const char* L2T;
    __device__ __forceinline__ bool next(int i, pg8::Unit& u) const {
        int pm, pn; if (!pg8::static_order(T / 256, 12, G, c, i, pm, pn)) return false;
        const int g = pn >> 2;
        u.pm = pm; u.pn = pn; u.e = g; u.A = (g < 2 ? LWA : LGB) + (size_t)pm * 256 * 256 * 2; u.B = L2T + ((size_t)g * RW + (size_t)(pn & 3) * 256) * 256 * 2; u.list = nullptr; u.cnt = 0; u.prow = 0; return true;
    }
    __device__ __forceinline__ void a_ready(const pg8::Unit&) const {}
    __device__ __forceinline__ void done(const pg8::Unit&) const {}
};
struct EpiLora {
    static constexpr bool PERM = true, AFTER_DRAIN = false;
    float* WPRE; float* APRE; float* GATE; const float* w0; const float* a0;
    __device__ __forceinline__ void operator()(const pg8::f32x4 (&acc)[2][2][4][2], const pg8::Unit& u, int wr, int wc, int fr, int fq) const {
        const int g = u.e; float* C = g == 0 ? WPRE : g == 1 ? APRE : GATE; const float* bias = g == 0 ? w0 : a0;
        const unsigned row0 = (unsigned)u.pm * 256u + wr * 64 + fr; const int col0 = (u.pn & 3) * 256 + wc * 32 + 8 * fq;
        pg8::f32x4 bv[2][2];
#pragma unroll
        for (int bj = 0; bj < 2; ++bj)
#pragma unroll
            for (int n = 0; n < 2; ++n) bv[bj][n] = (g < 2) ? *(const pg8::f32x4*)(bias + col0 + 128 * bj + 4 * n) : (pg8::f32x4){0.f, 0.f, 0.f, 0.f};
#pragma unroll
        for (int ai = 0; ai < 2; ++ai)
#pragma unroll
            for (int m = 0; m < 4; ++m) {
                float* rp = C + (size_t)(row0 + ai * 128 + m * 16) * RW + col0;
#pragma unroll
                for (int bj = 0; bj < 2; ++bj) { *(pg8::f32x4*)(rp + 128 * bj) = acc[ai][bj][m][0] + bv[bj][0]; *(pg8::f32x4*)(rp + 128 * bj + 4) = acc[ai][bj][m][1] + bv[bj][1]; }
            }
    }
};

struct SchedMoE {
    int G, c, nN, nrows; const LAS int* tab; const int* LIST; const char* Abase; const char* W; bool gatherA;
    __device__ __forceinline__ bool next(int i, pg8::Unit& u) const {
        const int L = i * G + c; const int total = __builtin_amdgcn_readfirstlane(tab[32]) * nN; if (L >= total) return false;
        int e = 0;
        for (int k = 1; k < NE; ++k) if (__builtin_amdgcn_readfirstlane(tab[k]) * nN <= L) e = k;
        const int t0 = __builtin_amdgcn_readfirstlane(tab[e]), t1 = __builtin_amdgcn_readfirstlane(tab[e + 1]);
        const int q = L - t0 * nN, mt = t1 - t0;
        u.pm = q % mt; u.pn = q / mt; u.e = e; u.cnt = __builtin_amdgcn_readfirstlane(tab[128 + e]); u.list = LIST + (size_t)e * T; u.prow = t0 * 256 + u.pm * 256;
        u.A = gatherA ? Abase : Abase + (size_t)u.prow * D * 2;
        u.B = W + ((size_t)e * nrows + (size_t)u.pn * 256) * D * 2; return true;
    }
    __device__ __forceinline__ void a_ready(const pg8::Unit&) const {}
    __device__ __forceinline__ void done(const pg8::Unit&) const {}
};
struct EpiGU {
    static constexpr bool PERM = true, AFTER_DRAIN = false;
    unsigned short* ACT; const float* bgu;
    __device__ __forceinline__ void operator()(const pg8::f32x4 (&acc)[2][2][4][2], const pg8::Unit& u, int wr, int wc, int fr, int fq) const {
        const float* bg = bgu + (size_t)u.e * 2 * FF; const int f0 = 128 * u.pn + 16 * wc + 4 * fq;
        pg8::f32x4 bgv[2], buv[2];
#pragma unroll
        for (int bj = 0; bj < 2; ++bj) { bgv[bj] = *(const pg8::f32x4*)(bg + f0 + 64 * bj); buv[bj] = *(const pg8::f32x4*)(bg + FF + f0 + 64 * bj); }
        const unsigned row0 = (unsigned)u.prow + wr * 64 + fr;
#pragma unroll
        for (int ai = 0; ai < 2; ++ai)
#pragma unroll
            for (int m = 0; m < 4; ++m) {
                const unsigned row = row0 + ai * 128 + m * 16;
#pragma unroll
                for (int bj = 0; bj < 2; ++bj) {
                    const pg8::f32x4 g = acc[ai][bj][m][0] + bgv[bj], up = acc[ai][bj][m][1] + buv[bj];
                    float a[4];
#pragma unroll
                    for (int j = 0; j < 4; ++j) { const float gl = fminf(g[j], 7.0f), ul = fminf(fmaxf(up[j], -7.0f), 7.0f); a[j] = gl * fast_sigmoid(1.702f * gl) * (ul + 1.0f); }
                    pg8::u32x2 w; w.x = pg8::cvt_pk_bf16(a[0], a[1]); w.y = pg8::cvt_pk_bf16(a[2], a[3]);
                    *(pg8::u32x2*)(ACT + (size_t)row * FF + f0 + 64 * bj) = w;
                }
            }
    }
};
struct EpiDown {
    static constexpr bool PERM = true, AFTER_DRAIN = false;
    unsigned short* YB; const float* bd;
    __device__ __forceinline__ void operator()(const pg8::f32x4 (&acc)[2][2][4][2], const pg8::Unit& u, int wr, int wc, int fr, int fq) const {
        const float* b = bd + (size_t)u.e * D; const int col0 = u.pn * 256 + wc * 32 + 8 * fq;
        pg8::f32x4 bv[2][2];
#pragma unroll
        for (int bj = 0; bj < 2; ++bj)
#pragma unroll
            for (int n = 0; n < 2; ++n) bv[bj][n] = *(const pg8::f32x4*)(b + col0 + 128 * bj + 4 * n);
        const int ml0 = u.pm * 256 + wr * 64 + fr;
#pragma unroll
        for (int ai = 0; ai < 2; ++ai)
#pragma unroll
            for (int m = 0; m < 4; ++m) {
                const int ml = ml0 + ai * 128 + m * 16;
                if (ml < u.cnt) {
                    const unsigned asg = (unsigned)u.list[ml];
#pragma unroll
                    for (int bj = 0; bj < 2; ++bj) {
                        const pg8::f32x4 v0 = acc[ai][bj][m][0] + bv[bj][0], v1 = acc[ai][bj][m][1] + bv[bj][1];
                        pg8::u32x4 w; w.x = pg8::cvt_pk_bf16(v0[0], v0[1]); w.y = pg8::cvt_pk_bf16(v0[2], v0[3]); w.z = pg8::cvt_pk_bf16(v1[0], v1[1]); w.w = pg8::cvt_pk_bf16(v1[2], v1[3]);
                        *(pg8::u32x4*)(YB + (size_t)asg * D + col0 + 128 * bj) = w;
                    }
                }
            }
    }
};
__device__ __forceinline__ void moe_tables(LAS int* tab, const unsigned* CNT) {
    if (threadIdx.x == 0) {
        int acc = 0;
        for (int e = 0; e < NE; ++e) { const int c = (int)__hip_atomic_load(&CNT[e], __ATOMIC_RELAXED, __HIP_MEMORY_SCOPE_AGENT); tab[e] = acc; tab[64 + e] = acc * 256; tab[128 + e] = c; acc += (c + 255) >> 8; }
        tab[32] = acc; tab[96] = acc * 256;
    }
    __syncthreads();
}
__device__ __forceinline__ float bf2f(unsigned short h) { return __uint_as_float((unsigned)h << 16); }


struct SchedUp {
    int G, c; const char* A0; const char* A1; const char* B0; const char* B1;
    __device__ __forceinline__ bool next(int i, pg8::Unit& u) const {
        int pm, pn; if (!pg8::static_order(T / 256, D / 256, G, c, i >> 1, pm, pn)) return false;
        const int sb = i & 1;
        u.pm = pm; u.pn = pn; u.e = sb; u.A = (sb ? A1 : A0) + (size_t)pm * 256 * RW * 2; u.B = (sb ? B1 : B0) + (size_t)pn * 256 * RW * 2; u.list = nullptr; u.cnt = 0; u.prow = 0; return true;
    }
    __device__ __forceinline__ void a_ready(const pg8::Unit&) const {}
    __device__ __forceinline__ void done(const pg8::Unit&) const {}
};
struct EpiUp {
    static constexpr bool PERM = true, AFTER_DRAIN = false;
    float* M32; unsigned short* MB; const float* PH;
    __device__ __forceinline__ void operator()(const pg8::f32x4 (&acc)[2][2][4][2], const pg8::Unit& u, int wr, int wc, int fr, int fq) const {
        const int sb = u.e; const unsigned row0 = (unsigned)u.pm * 256u + wr * 64 + fr; const int col0 = u.pn * 256 + wc * 32 + 8 * fq;
#pragma unroll
        for (int ai = 0; ai < 2; ++ai)
#pragma unroll
            for (int m = 0; m < 4; ++m) {
                const unsigned row = row0 + ai * 128 + m * 16;
#pragma unroll
                for (int bj = 0; bj < 2; ++bj) {
                    const int col = col0 + 128 * bj;
                    const float* gp = PH + (size_t)row * N_IN + COL_GATE + sb * D + col;
                    const pg8::f32x4 g0 = *(const pg8::f32x4*)gp, g1 = *(const pg8::f32x4*)(gp + 4);
                    pg8::f32x4 v0 = acc[ai][bj][m][0], v1 = acc[ai][bj][m][1];
#pragma unroll
                    for (int j = 0; j < 4; ++j) { v0[j] *= fast_sigmoid(g0[j]); v1[j] *= fast_sigmoid(g1[j]); }
                    float* mp = M32 + (size_t)row * D + col;
                    if (sb == 0) { *(pg8::f32x4*)mp = v0; *(pg8::f32x4*)(mp + 4) = v1; }
                    else {
                        v0 += *(const pg8::f32x4*)mp; v1 += *(const pg8::f32x4*)(mp + 4);
                        pg8::u32x4 w; w.x = pg8::cvt_pk_bf16(v0[0], v0[1]); w.y = pg8::cvt_pk_bf16(v0[2], v0[3]); w.z = pg8::cvt_pk_bf16(v1[0], v1[1]); w.w = pg8::cvt_pk_bf16(v1[2], v1[3]);
                        *(pg8::u32x4*)(MB + (size_t)row * D + col) = w;
                    }
                }
            }
    }
};
struct SchedPlain {
    int G, c, nM, nN, K; const char* A; const char* B;
    __device__ __forceinline__ bool next(int i, pg8::Unit& u) const {
        int pm, pn; if (!pg8::static_order(nM, nN, G, c, i, pm, pn)) return false;
        u.pm = pm; u.pn = pn; u.e = 0; u.A = A + (size_t)pm * 256 * K * 2; u.B = B + (size_t)pn * 256 * K * 2; u.list = nullptr; u.cnt = 0; u.prow = 0; return true;
    }
    __device__ __forceinline__ void a_ready(const pg8::Unit&) const {}
    __device__ __forceinline__ void done(const pg8::Unit&) const {}
};
struct EpiF32 {
    static constexpr bool PERM = true, AFTER_DRAIN = false;
    float* C; int ldc;
    __device__ __forceinline__ void operator()(const pg8::f32x4 (&acc)[2][2][4][2], const pg8::Unit& u, int wr, int wc, int fr, int fq) const {
        const unsigned row0 = (unsigned)u.pm * 256u + wr * 64 + fr; const int col0 = u.pn * 256 + wc * 32 + 8 * fq;
#pragma unroll
        for (int ai = 0; ai < 2; ++ai)
#pragma unroll
            for (int m = 0; m < 4; ++m) {
                float* rp = C + (size_t)(row0 + ai * 128 + m * 16) * ldc + col0;
#pragma unroll
                for (int bj = 0; bj < 2; ++bj) { *(pg8::f32x4*)(rp + 128 * bj) = acc[ai][bj][m][0]; *(pg8::f32x4*)(rp + 128 * bj + 4) = acc[ai][bj][m][1]; }
            }
    }
};

#define LDS_WAIT() asm volatile("s_waitcnt lgkmcnt(0)" ::: "memory")
template <class F, class FK>
__device__ __forceinline__ void cvt_item_k(const float* __restrict__ W, int ldw, int K, const F& srccol, const FK& srcrow, unsigned short* WT, int row0, int kb, LAS float* scr, int lane) {
    const int n = lane & 31, k0 = kb * 64; const int sc = srccol(row0 + n);
#pragma unroll 8
    for (int i = 0; i < 32; ++i) { const int kk = 2 * i + (lane >> 5); const int sr = srcrow(k0 + kk); scr[kk * 33 + n] = (sc >= 0 && sr >= 0) ? W[(size_t)sr * ldw + sc] : 0.f; }
    LDS_WAIT();
    const int c = lane & 7;
#pragma unroll
    for (int j = 0; j < 4; ++j) { const int n2 = (lane >> 3) + 8 * j; const LAS float* sp = scr + (8 * c) * 33 + n2;
        pg8::u32x4 o; o.x = pg8::cvt_pk_bf16(sp[0 * 33], sp[1 * 33]); o.y = pg8::cvt_pk_bf16(sp[2 * 33], sp[3 * 33]); o.z = pg8::cvt_pk_bf16(sp[4 * 33], sp[5 * 33]); o.w = pg8::cvt_pk_bf16(sp[6 * 33], sp[7 * 33]);
        *(pg8::u32x4*)(WT + (size_t)(row0 + n2) * K + k0 + 8 * c) = o; }
    LDS_WAIT();
}
template <class F>
__device__ __forceinline__ void cvt_item(const float* __restrict__ W, int ldw, int K, const F& srccol, unsigned short* WT, int row0, int kb, LAS float* scr, int lane) {
    auto idk = [](int k) { return k; };
    cvt_item_k(W, ldw, K, srccol, idk, WT, row0, kb, scr, lane);
}
template <class FM, class FK>
__device__ __forceinline__ void cvt64(const float* __restrict__ W, int ldw, int K, const FM& map4, const FK& srcrow, unsigned short* __restrict__ WT, int row0, int kb, int lane) {
    const int n4 = lane & 15, kg = lane >> 4, k0 = kb * 64 + 16 * kg;
    int sc, dr; map4(row0, n4, sc, dr);
    f32x4_t v[16];
#pragma unroll
    for (int kk = 0; kk < 16; ++kk) { const int sr = srcrow(k0 + kk); v[kk] = (sc >= 0 && sr >= 0) ? *(const f32x4_t*)(W + (size_t)sr * ldw + sc) : (f32x4_t){0.f, 0.f, 0.f, 0.f}; }
#pragma unroll
    for (int j = 0; j < 4; ++j) {
        pg8::u32x4 o0, o1;
        o0.x = pg8::cvt_pk_bf16(v[0][j], v[1][j]); o0.y = pg8::cvt_pk_bf16(v[2][j], v[3][j]); o0.z = pg8::cvt_pk_bf16(v[4][j], v[5][j]); o0.w = pg8::cvt_pk_bf16(v[6][j], v[7][j]);
        o1.x = pg8::cvt_pk_bf16(v[8][j], v[9][j]); o1.y = pg8::cvt_pk_bf16(v[10][j], v[11][j]); o1.z = pg8::cvt_pk_bf16(v[12][j], v[13][j]); o1.w = pg8::cvt_pk_bf16(v[14][j], v[15][j]);
        unsigned short* dst = WT + (size_t)(dr + j) * K + k0;
        *(pg8::u32x4*)dst = o0; *(pg8::u32x4*)(dst + 8) = o1;
    }
}
__device__ __forceinline__ void inproj_src(int r, int& mat, int& col) {
    mat = 0; col = -1;
    if (r < 3072) col = r;
    else if (r < 7168) col = COL_GATE + (r - 3072);
    else if (r < 7424) { if (r - 7168 < 16) col = COL_B + (r - 7168); }
    else if (r < 10496) col = COL_R + (r - 7424);
    else if (r < 10752) { mat = 1; if (r - 10496 < 96) col = r - 10496; }
    else if (r < 11008) { mat = 2; if (r - 10752 < 96) col = r - 10752; }
    else { mat = 3; col = r - 11008; }
}

typedef short bf16x8_t __attribute__((ext_vector_type(8)));
typedef unsigned short LAS* lds_u16p;
__device__ __forceinline__ f32x4_t mma16(bf16x8_t a, bf16x8_t b, f32x4_t c) { return __builtin_amdgcn_mfma_f32_16x16x32_bf16(a, b, c, 0, 0, 0); }
__device__ __forceinline__ bf16x8_t ldfrag(const LAS unsigned short* M, int ld, int r0, int k0, int lane) { return *(const LAS bf16x8_t*)(M + (r0 + (lane & 15)) * ld + k0 + 8 * (lane >> 4)); }
__device__ __forceinline__ unsigned short f2bf(float x) { return (unsigned short)(pg8::cvt_pk_bf16(x, x) & 0xffffu); }
constexpr int GR_QG = 0, GR_W = 16384, GR_KDT = 32768, GR_AI = 49152, GR_U = 57344, GR_MISC = 90112, GR_BYTES = 90368;
constexpr int GL_KB = 0, GL_QB = 17408, GL_VT = 34816, GL_KST = 53248, GL_KDT = 71680, GL_LM = 90112, GL_TI = 107520, GL_AI = 116736, GL_SM = 125952;

__device__ __forceinline__ void tri_inverse_64(const LAS float* Lm, LAS unsigned short* Ti, int lane) {
    float xcol[64];
#pragma unroll
    for (int i = 0; i < 64; ++i) {
        float s = 0.f;
#pragma unroll
        for (int j4 = 0; j4 < (i + 3) / 4; ++j4) {
            const f32x4_t l4 = *(const LAS f32x4_t*)(Lm + i * 68 + 4 * j4);
#pragma unroll
            for (int jj = 0; jj < 4; ++jj) { const int j = 4 * j4 + jj; if (j < i) s = fmaf(l4[jj], xcol[j], s); }
        }
        xcol[i] = ((lane == i) ? 1.0f : 0.0f) - s;
        Ti[i * 72 + lane] = f2bf(xcol[i]);
    }
}

__device__ __forceinline__ void gdn_prep_item(int item, LAS unsigned char* lds, const float* __restrict__ PH, const float* __restrict__ convw, const float* __restrict__ A_log, const float* __restrict__ dt_bias, unsigned char* __restrict__ recs) {
    int tid_ = threadIdx.x; asm volatile("" : "+v"(tid_));
    const int tid = tid_, lane = tid & 63, wave = __builtin_amdgcn_readfirstlane(tid >> 6);
    const int ch = item & 63, hv = (item >> 6) & 7, b = item >> 9, qh = hv >> 1;
    const int s0 = ch * 64; const size_t t0 = (size_t)b * SEQ + s0;
    unsigned char* rec = recs + (size_t)item * GR_BYTES;
    LAS unsigned short* Kb = (LAS unsigned short*)(lds + GL_KB); LAS unsigned short* Qb = (LAS unsigned short*)(lds + GL_QB);
    LAS unsigned short* VT = (LAS unsigned short*)(lds + GL_VT); LAS unsigned short* KsT = (LAS unsigned short*)(lds + GL_KST); LAS unsigned short* KdT = (LAS unsigned short*)(lds + GL_KDT);
    LAS float* Lm = (LAS float*)(lds + GL_LM); LAS unsigned short* Ti = (LAS unsigned short*)(lds + GL_TI); LAS unsigned short* Ai = (LAS unsigned short*)(lds + GL_AI);
    LAS float* gcs = (LAS float*)(lds + GL_SM); LAS float* betas = gcs + 64;
    if (wave == 0) {
        const float araw = PH[(t0 + lane) * N_IN + COL_A + hv], braw = PH[(t0 + lane) * N_IN + COL_B + hv];
        float g = -expf(A_log[hv]) * softplusf_(araw + dt_bias[hv]);
#pragma unroll
        for (int o = 1; o < 64; o <<= 1) { const float t = __shfl_up(g, o); if (lane >= o) g += t; }
        gcs[lane] = g; betas[lane] = sigmoidf_(braw);
    }
    __syncthreads();
    {
        const int row = tid >> 3, cs = tid & 7, c0 = cs * 16;
        const float gcr = gcs[row], br = betas[row], glast = gcs[63];
        const float eg = expf(gcr), ekd = expf(glast - gcr);
#pragma unroll
        for (int mtx = 0; mtx < 3; ++mtx) {
            const int colbase = (mtx == 0) ? qh * 128 : (mtx == 1) ? COL_K + qh * 128 : COL_V + hv * 128;
            float acc[16];
#pragma unroll
            for (int i = 0; i < 16; ++i) acc[i] = 0.f;
#pragma unroll
            for (int j = 0; j < 4; ++j) {
                if (s0 + row - 3 + j >= 0) {
                    const float* src = PH + (t0 + row - 3 + j) * N_IN + colbase + c0; const float* cw = convw + j * 2048 + colbase + c0;
#pragma unroll
                    for (int i4 = 0; i4 < 4; ++i4) { const float4 xv = *(const float4*)(src + 4 * i4), wv = *(const float4*)(cw + 4 * i4);
                        acc[4 * i4] = fmaf(wv.x, xv.x, acc[4 * i4]); acc[4 * i4 + 1] = fmaf(wv.y, xv.y, acc[4 * i4 + 1]); acc[4 * i4 + 2] = fmaf(wv.z, xv.z, acc[4 * i4 + 2]); acc[4 * i4 + 3] = fmaf(wv.w, xv.w, acc[4 * i4 + 3]); }
                }
            }
            float ss = 0.f;
#pragma unroll
            for (int i = 0; i < 16; ++i) { acc[i] = siluf_(acc[i]); ss = fmaf(acc[i], acc[i], ss); }
            ss += __shfl_xor(ss, 1); ss += __shfl_xor(ss, 2); ss += __shfl_xor(ss, 4);
            const float rn = rsqrtf(ss + 1e-6f);
#pragma unroll
            for (int i = 0; i < 16; ++i) {
                if (mtx == 0) Qb[row * 136 + c0 + i] = f2bf(acc[i] * rn * 0.08838834764831845f);
                else if (mtx == 1) { const float kn = acc[i] * rn; Kb[row * 136 + c0 + i] = f2bf(kn); KsT[(c0 + i) * 72 + row] = f2bf(br * eg * kn); KdT[(c0 + i) * 72 + row] = f2bf(kn * ekd); }
                else VT[(c0 + i) * 72 + row] = f2bf(br * acc[i]);
            }
            asm volatile("" ::: "memory");
        }
    }
    __syncthreads();
    {
        const int mat = wave >> 2, ti = wave & 3, g4 = lane >> 4, n = lane & 15;
        const LAS unsigned short* Am = mat ? Qb : Kb;
#pragma unroll
        for (int tj = 0; tj < 4; ++tj) {
            f32x4_t acc = {0.f, 0.f, 0.f, 0.f};
#pragma unroll
            for (int ks = 0; ks < 4; ++ks) acc = mma16(ldfrag(Am, 136, 16 * ti, 32 * ks, lane), ldfrag(Kb, 136, 16 * tj, 32 * ks, lane), acc);
            const int j = 16 * tj + n; const float gj = gcs[j];
#pragma unroll
            for (int r = 0; r < 4; ++r) {
                const int i = 16 * ti + 4 * g4 + r; const float dec = expf(fminf(gcs[i] - gj, 0.f));
                if (mat == 0) Lm[i * 68 + j] = (j < i) ? betas[i] * acc[r] * dec : 0.f;
                else Ai[i * 72 + j] = f2bf((j <= i) ? acc[r] * dec : 0.f);
            }
        }
    }
    __syncthreads();
    if (wave == 0) tri_inverse_64(Lm, Ti, lane);
    else {
        for (int e = tid - 64; e < 64 * 128; e += NTHREADS - 64) { const int row = e >> 7, c = e & 127; const float qv = bf2f(Qb[row * 136 + c]); Qb[row * 136 + c] = f2bf(qv * expf(gcs[row])); }
    }
    __syncthreads();
    {
        const int g4 = lane >> 4, n = lane & 15;
#pragma unroll
        for (int t2 = 0; t2 < 2; ++t2) {
            const int tn = 2 * wave + t2; const LAS unsigned short* Bt = (tn < 8) ? VT : KsT; const int tb = tn & 7;
#pragma unroll
            for (int ti = 0; ti < 4; ++ti) {
                f32x4_t acc = {0.f, 0.f, 0.f, 0.f};
#pragma unroll
                for (int ks = 0; ks < 2; ++ks) acc = mma16(ldfrag(Ti, 72, 16 * ti, 32 * ks, lane), ldfrag(Bt, 72, 16 * tb, 32 * ks, lane), acc);
                if (tn < 8) *(f32x4_t*)(rec + GR_U + ((size_t)((ti * 8 + tb) * 64 + lane)) * 16) = acc;
                else {
#pragma unroll
                    for (int r = 0; r < 4; ++r) Kb[(16 * ti + 4 * g4 + r) * 136 + 16 * tb + n] = f2bf(acc[r]);
                }
            }
        }
    }
    __syncthreads();
    {
#pragma unroll
        for (int t2 = 0; t2 < 2; ++t2) {
            const int f = 2 * wave + t2;
            { const int ti = f >> 2, ks = f & 3;
              *(bf16x8_t*)(rec + GR_QG + (size_t)(f * 64 + lane) * 16) = ldfrag(Qb, 136, 16 * ti, 32 * ks, lane);
              *(bf16x8_t*)(rec + GR_W + (size_t)(f * 64 + lane) * 16) = ldfrag(Kb, 136, 16 * ti, 32 * ks, lane); }
            { const int td = f >> 1, ks = f & 1;
              *(bf16x8_t*)(rec + GR_KDT + (size_t)(f * 64 + lane) * 16) = ldfrag(KdT, 72, 16 * td, 32 * ks, lane); }
        }
        { const int f = wave, ti = f >> 1, ks = f & 1;
          *(bf16x8_t*)(rec + GR_AI + (size_t)(f * 64 + lane) * 16) = ldfrag(Ai, 72, 16 * ti, 32 * ks, lane); }
        if (tid == 0) *(float*)(rec + GR_MISC) = expf(gcs[63]);
    }
    __syncthreads();
}

__device__ __forceinline__ void gdn_scan_seq(int seq, LAS unsigned char* lds, const unsigned char* __restrict__ recs, float* __restrict__ OG) {
    const int tid = threadIdx.x, lane = tid & 63, wave = __builtin_amdgcn_readfirstlane(tid >> 6), g4 = lane >> 4, n = lane & 15;
    const int b = seq >> 3, hv = seq & 7;
    LAS unsigned short* St = (LAS unsigned short*)lds;
    LAS unsigned short* VnT = (LAS unsigned short*)(lds + 34816);
    for (int e = tid; e < 128 * 136; e += NTHREADS) St[e] = 0;
    f32x4_t S[8];
#pragma unroll
    for (int tv = 0; tv < 8; ++tv) S[tv] = (f32x4_t){0.f, 0.f, 0.f, 0.f};
    __syncthreads();
    const int ti = wave & 3;
    for (int ch = 0; ch < 64; ++ch) {
        const unsigned char* rec = recs + ((size_t)seq * 64 + ch) * GR_BYTES;
        bf16x8_t afr[4];
#pragma unroll
        for (int ks = 0; ks < 4; ++ks) afr[ks] = *(const bf16x8_t*)(rec + (wave < 4 ? GR_QG : GR_W) + (size_t)((ti * 4 + ks) * 64 + lane) * 16);
        bf16x8_t kfr[2], aifr[2];
#pragma unroll
        for (int ks = 0; ks < 2; ++ks) { kfr[ks] = *(const bf16x8_t*)(rec + GR_KDT + (size_t)((wave * 2 + ks) * 64 + lane) * 16);
            aifr[ks] = *(const bf16x8_t*)(rec + GR_AI + (size_t)((ti * 2 + ks) * 64 + lane) * 16); }
        const float eg = *(const float*)(rec + GR_MISC);
        f32x4_t acc1[8];
#pragma unroll
        for (int tv = 0; tv < 8; ++tv) {
            f32x4_t a = {0.f, 0.f, 0.f, 0.f};
#pragma unroll
            for (int ks = 0; ks < 4; ++ks) a = mma16(afr[ks], ldfrag(St, 136, 16 * tv, 32 * ks, lane), a);
            acc1[tv] = a;
        }
        if (wave >= 4) {
#pragma unroll
            for (int tv = 0; tv < 8; ++tv) {
                const f32x4_t u = *(const f32x4_t*)(rec + GR_U + (size_t)((ti * 8 + tv) * 64 + lane) * 16);
                const f32x4_t vn = u - acc1[tv];
                pg8::u32x2 w2; w2.x = pg8::cvt_pk_bf16(vn[0], vn[1]); w2.y = pg8::cvt_pk_bf16(vn[2], vn[3]);
                *(LAS pg8::u32x2*)(VnT + (16 * tv + n) * 72 + 16 * ti + 4 * g4) = w2;
            }
        }
        __syncthreads();
        if (wave < 4) {
#pragma unroll
            for (int tv = 0; tv < 8; ++tv) {
                f32x4_t o = acc1[tv];
#pragma unroll
                for (int ks = 0; ks < 2; ++ks) o = mma16(aifr[ks], ldfrag(VnT, 72, 16 * tv, 32 * ks, lane), o);
#pragma unroll
                for (int r = 0; r < 4; ++r) OG[((size_t)b * SEQ + ch * 64 + 16 * ti + 4 * g4 + r) * RW + hv * 128 + 16 * tv + n] = o[r];
            }
        }
#pragma unroll
        for (int tv = 0; tv < 8; ++tv) {
            f32x4_t s = S[tv] * eg;
#pragma unroll
            for (int ks = 0; ks < 2; ++ks) s = mma16(kfr[ks], ldfrag(VnT, 72, 16 * tv, 32 * ks, lane), s);
            S[tv] = s;
            pg8::u32x2 w2; w2.x = pg8::cvt_pk_bf16(s[0], s[1]); w2.y = pg8::cvt_pk_bf16(s[2], s[3]);
            *(LAS pg8::u32x2*)(St + (16 * tv + n) * 136 + 16 * wave + 4 * g4) = w2;
        }
        __syncthreads();
    }
}

constexpr int RT = 32;
constexpr int RBUF_FLOATS = 5 * RT * 64 + RT * 32 + RT * 2;
__device__ __forceinline__ float dpp_f(float x, const int ctrl_sel) {
    const int xi = __float_as_int(x); int r;
    if (ctrl_sel == 0) r = __builtin_amdgcn_update_dpp(0, xi, 0xB1, 0xF, 0xF, true);
    else if (ctrl_sel == 1) r = __builtin_amdgcn_update_dpp(0, xi, 0x4E, 0xF, 0xF, true);
    else r = __builtin_amdgcn_update_dpp(0, xi, 0x141, 0xF, 0xF, true);
    return __int_as_float(r);
}
__device__ __forceinline__ float sum8(float x) { x += dpp_f(x, 0); x += dpp_f(x, 1); x += dpp_f(x, 2); return x; }
__device__ __forceinline__ void rwkv_scan_block(int sq, int half, LAS float* lds, const float* __restrict__ WD, const float* __restrict__ AA, const float* __restrict__ BB, const float* __restrict__ KM,
                                                const float* __restrict__ PH, float* __restrict__ YR) {
    const int tid = threadIdx.x, lane = tid & 63, wave = __builtin_amdgcn_readfirstlane(tid >> 6);
    const int b = sq >> 4, h = sq & 15, rbase = half * 32;
    const size_t t0 = (size_t)b * SEQ;
    const int lt = tid - 256;
    f32x4_t lw[2], la[2], lb[2], lk[2], lr[2], lv;
    float S[8];
#pragma unroll
    for (int k = 0; k < 8; ++k) S[k] = 0.f;
#define RW_LOAD(c) do { _Pragma("unroll") for (int i = 0; i < 2; ++i) { const int f = lt + 256 * i, st = f >> 4, c4 = f & 15; const size_t t = t0 + (size_t)(c) * RT + st; const int col = h * 64 + c4 * 4; \
        lw[i] = *(const f32x4_t*)(WD + t * RW + col); la[i] = *(const f32x4_t*)(AA + t * RW + col); lb[i] = *(const f32x4_t*)(BB + t * RW + col); lk[i] = *(const f32x4_t*)(KM + t * RW + col); lr[i] = *(const f32x4_t*)(PH + t * N_IN + COL_R + col); } \
        { const int st = lt >> 3, c4 = lt & 7; lv = *(const f32x4_t*)(PH + (t0 + (size_t)(c) * RT + st) * N_IN + COL_RV + h * 64 + rbase + c4 * 4); } } while (0)
#define RW_STORE(bufp) do { LAS float* _b = (bufp); _Pragma("unroll") for (int i = 0; i < 2; ++i) { const int f = lt + 256 * i, st = f >> 4, c4 = f & 15; \
        *(LAS f32x4_t*)(_b + 0 * RT * 64 + st * 64 + c4 * 4) = lw[i]; *(LAS f32x4_t*)(_b + 1 * RT * 64 + st * 64 + c4 * 4) = la[i]; *(LAS f32x4_t*)(_b + 2 * RT * 64 + st * 64 + c4 * 4) = lb[i]; *(LAS f32x4_t*)(_b + 3 * RT * 64 + st * 64 + c4 * 4) = lk[i]; \
        *(LAS f32x4_t*)(_b + 4 * RT * 64 + st * 64 + c4 * 4) = lw[i] * lr[i]; \
        float br = lb[i].x * lr[i].x + lb[i].y * lr[i].y + lb[i].z * lr[i].z + lb[i].w * lr[i].w, kr = lk[i].x * lr[i].x + lk[i].y * lr[i].y + lk[i].z * lr[i].z + lk[i].w * lr[i].w; \
        br += __shfl_xor(br, 1); br += __shfl_xor(br, 2); br += __shfl_xor(br, 4); br += __shfl_xor(br, 8); kr += __shfl_xor(kr, 1); kr += __shfl_xor(kr, 2); kr += __shfl_xor(kr, 4); kr += __shfl_xor(kr, 8); \
        if (c4 == 0) { _b[5 * RT * 64 + RT * 32 + st * 2] = br; _b[5 * RT * 64 + RT * 32 + st * 2 + 1] = kr; } } \
        { const int st = lt >> 3, c4 = lt & 7; *(LAS f32x4_t*)(_b + 5 * RT * 64 + st * 32 + c4 * 4) = lv; } } while (0)
    constexpr int NCH = SEQ / RT;
    if (wave >= 4) { RW_LOAD(0); RW_STORE(lds); RW_LOAD(1); }
    __syncthreads();
    const int rloc = wave * 8 + (lane >> 3), kq = (lane & 7) * 8;
    for (int c = 0; c < NCH; ++c) {
        LAS float* buf = lds + (c & 1) * RBUF_FLOATS;
        if (wave >= 4) {
            if (c + 1 < NCH) { RW_STORE(lds + ((c + 1) & 1) * RBUF_FLOATS); }
            if (c + 2 < NCH) { RW_LOAD(c + 2); }
        } else {
            for (int st = 0; st < RT; ++st) {
                const LAS float* p = buf + st * 64 + kq;
                const f32x4_t w0 = *(const LAS f32x4_t*)(p), w1 = *(const LAS f32x4_t*)(p + 4);
                const f32x4_t a0 = *(const LAS f32x4_t*)(p + RT * 64), a1 = *(const LAS f32x4_t*)(p + RT * 64 + 4);
                const f32x4_t b0 = *(const LAS f32x4_t*)(p + 2 * RT * 64), b1 = *(const LAS f32x4_t*)(p + 2 * RT * 64 + 4);
                const f32x4_t k0 = *(const LAS f32x4_t*)(p + 3 * RT * 64), k1 = *(const LAS f32x4_t*)(p + 3 * RT * 64 + 4);
                const f32x4_t x0 = *(const LAS f32x4_t*)(p + 4 * RT * 64), x1 = *(const LAS f32x4_t*)(p + 4 * RT * 64 + 4);
                const float vv = buf[5 * RT * 64 + st * 32 + rloc];
                const float br = buf[5 * RT * 64 + RT * 32 + st * 2], kr = buf[5 * RT * 64 + RT * 32 + st * 2 + 1];
                float sa = S[0] * a0.x; sa = fmaf(S[1], a0.y, sa); sa = fmaf(S[2], a0.z, sa); sa = fmaf(S[3], a0.w, sa); sa = fmaf(S[4], a1.x, sa); sa = fmaf(S[5], a1.y, sa); sa = fmaf(S[6], a1.z, sa); sa = fmaf(S[7], a1.w, sa);
                float pp = S[0] * x0.x; pp = fmaf(S[1], x0.y, pp); pp = fmaf(S[2], x0.z, pp); pp = fmaf(S[3], x0.w, pp); pp = fmaf(S[4], x1.x, pp); pp = fmaf(S[5], x1.y, pp); pp = fmaf(S[6], x1.z, pp); pp = fmaf(S[7], x1.w, pp);
                sa = sum8(sa); pp = sum8(pp);
                S[0] = fmaf(S[0], w0.x, fmaf(sa, b0.x, vv * k0.x)); S[1] = fmaf(S[1], w0.y, fmaf(sa, b0.y, vv * k0.y)); S[2] = fmaf(S[2], w0.z, fmaf(sa, b0.z, vv * k0.z)); S[3] = fmaf(S[3], w0.w, fmaf(sa, b0.w, vv * k0.w));
                S[4] = fmaf(S[4], w1.x, fmaf(sa, b1.x, vv * k1.x)); S[5] = fmaf(S[5], w1.y, fmaf(sa, b1.y, vv * k1.y)); S[6] = fmaf(S[6], w1.z, fmaf(sa, b1.z, vv * k1.z)); S[7] = fmaf(S[7], w1.w, fmaf(sa, b1.w, vv * k1.w));
                const float y = pp + sa * br + vv * kr;
                if ((lane & 7) == 0) YR[(t0 + (size_t)c * RT + st) * RW + h * 64 + rbase + rloc] = y;
            }
        }
        __syncthreads();
    }
#undef RW_LOAD
#undef RW_STORE
}

__global__ void __launch_bounds__(NTHREADS, 2) fwd(Args a) {
    extern __shared__ __attribute__((aligned(16))) unsigned char lds_raw[];
    float* sm = (float*)lds_raw;
    const int tid = threadIdx.x, lane = tid & 63, wave = tid >> 6;
    unsigned char* ws = a.ws;
    unsigned* ctl = (unsigned*)(ws + WS_CTL);
    volatile LAS unsigned* xbw = (volatile LAS unsigned*)(LAS unsigned char*)(lds_raw + LDS_BYTES - 16);
    if (tid == 0) { xbw[0] = 0u; xbw[1] = 0u; xbw[2] = 0u; xbw[3] = 0u; }
    __syncthreads();
    const int lo = a.ph_lo, hi = a.ph_hi;
    XcdBarrier bar; bar.bar = ctl; bar.x = 0; bar.st = xbw;
    if (hi - lo > 1) bar = xcd_barrier_post(ctl, xbw);
#define IN(k) (lo <= (k) && (k) < hi)
#define SEAM(k) do { if (IN(k) && IN((k) + 1)) xcd_barrier(bar); } while (0)


    if (IN(0)) {
        const float* c = a.in[1];
        const float* ada_w = a.in[2];
        const float* ada_b = a.in[3];
        const float* w_in = a.in[8];
        const float* rwkv_w1 = a.in[15];
        const float* rwkv_a1 = a.in[18];
        const float* rwkv_g1 = a.in[20];
        const float* w_up_gdn = a.in[27];
        const float* w_up_rwkv = a.in[28];
        const float* w_out = a.in[29];
        const float* exp_w_gu = a.in[32];
        const float* exp_w_down = a.in[34];
        float* MOD = (float*)(ws + WS_MOD);
        unsigned short* WINT = (unsigned short*)(ws + WS_WINT);
        unsigned short* WUPG = (unsigned short*)(ws + WS_WUPG);
        unsigned short* WUPR = (unsigned short*)(ws + WS_WUPR);
        unsigned short* WOUT = (unsigned short*)(ws + WS_WOUT);
        unsigned short* WGU = (unsigned short*)(ws + WS_WGU);
        unsigned short* WDN = (unsigned short*)(ws + WS_WDN);
        float* sc = sm;
        float* part = sm + NB * D;
        for (int i = tid; i < NB * D; i += NTHREADS) sc[i] = siluf_(c[i]);
        __syncthreads();
        for (int cb = blockIdx.x; cb < 6 * D / 48; cb += gridDim.x) {
            const int cc = tid % 48, kg = tid / 48, col = cb * 48 + cc;
            if (tid < 480) {
                float acc0 = 0.f, acc1 = 0.f, acc2 = 0.f, acc3 = 0.f;
#pragma unroll 8
                for (int k = kg; k < D; k += 10) {
                    const float w = ada_w[(size_t)k * (6 * D) + col];
                    acc0 = fmaf(sc[k], w, acc0); acc1 = fmaf(sc[D + k], w, acc1); acc2 = fmaf(sc[2 * D + k], w, acc2); acc3 = fmaf(sc[3 * D + k], w, acc3);
                }
                part[(kg * 4 + 0) * 48 + cc] = acc0; part[(kg * 4 + 1) * 48 + cc] = acc1; part[(kg * 4 + 2) * 48 + cc] = acc2; part[(kg * 4 + 3) * 48 + cc] = acc3;
            }
            __syncthreads();
            if (tid < 192) {
                const int bb = tid / 48, c2 = tid % 48; float t = ada_b[cb * 48 + c2];
#pragma unroll
                for (int g = 0; g < 10; ++g) t += part[(g * 4 + bb) * 48 + c2];
                MOD[(size_t)bb * 6 * D + cb * 48 + c2] = t;
            }
            __syncthreads();
        }
        {
            const int gw = blockIdx.x * (NTHREADS / 64) + wave, ngw = gridDim.x * (NTHREADS / 64);
            auto idk = [](int k) { return k; };
            constexpr int N_IP = (NT_IN * 256 / 64) * (D / 64);
            constexpr int N_GU = NE * (2 * FF / 64) * (D / 64), N_DN = NE * (D / 64) * (FF / 64);
            constexpr int N_L2 = 3 * (RW / 64) * (256 / 64), N_UP = (D / 64) * (RW / 64), N_OUT = (D / 64) * (D / 64);
            constexpr int N_ALL = N_IP + N_GU + N_DN + N_L2 + 2 * N_UP + N_OUT;
            for (int it0 = gw; it0 < N_ALL; it0 += ngw) {
                int it = it0;
                if (it < N_GU) {
                    const int e = it / ((2 * FF / 64) * (D / 64)), r = it % ((2 * FF / 64) * (D / 64)), rb = r / (D / 64), kb = r % (D / 64);
                    auto m4 = [](int row0, int n4, int& scol, int& drow) { const int pn = row0 >> 8, cb8 = (row0 & 255) >> 3, ft = 128 * pn + (cb8 + (n4 & 7)) * 4; scol = (n4 < 8) ? ft : FF + ft; drow = row0 + (n4 & 7) * 8 + ((n4 < 8) ? 0 : 4); };
                    cvt64(exp_w_gu + (size_t)e * D * 2 * FF, 2 * FF, D, m4, idk, WGU + (size_t)e * 2 * FF * D, rb * 64, kb, lane); continue; }
                it -= N_GU;
                auto mid = [](int row0, int n4, int& scol, int& drow) { scol = row0 + 4 * n4; drow = scol; };
                if (it < N_DN) {
                    const int e = it / ((D / 64) * (FF / 64)), r = it % ((D / 64) * (FF / 64)), rb = r / (FF / 64), kb = r % (FF / 64);
                    cvt64(exp_w_down + (size_t)e * FF * D, D, FF, mid, idk, WDN + (size_t)e * D * FF, rb * 64, kb, lane); continue; }
                it -= N_DN;
                if (it < N_IP) {
                    const int rb = it / (D / 64), kb = it % (D / 64), row0 = rb * 64;
                    int mat, col0; inproj_src(row0, mat, col0);
                    const float* W = mat == 0 ? w_in : mat == 1 ? rwkv_w1 : mat == 2 ? rwkv_a1 : rwkv_g1;
                    const int ldw = mat == 0 ? N_IN : mat == 3 ? 256 : 96;
                    auto m4 = [](int r0, int n4, int& scol, int& drow) { int m2; drow = r0 + 4 * n4; inproj_src(drow, m2, scol); };
                    cvt64(W, ldw, D, m4, idk, WINT, row0, kb, lane); continue; }
                it -= N_IP;
                if (it < N_L2) {
                    const float* rwkv_w2 = a.in[16]; const float* rwkv_a2 = a.in[19]; const float* rwkv_g2 = a.in[21]; unsigned short* L2T = (unsigned short*)(ws + WS_L2T);
                    constexpr int NL = (RW / 64) * 4; const int g = it / NL, r = it % NL, rb = r / 4, kb = r % 4;
                    if (g == 0) { auto fk = [](int k) { return k < 96 ? k : -1; }; cvt64(rwkv_w2, RW, 256, mid, fk, L2T, rb * 64, kb, lane); }
                    else if (g == 1) { auto fk = [](int k) { return (k >= 128 && k < 224) ? k - 128 : -1; }; cvt64(rwkv_a2, RW, 256, mid, fk, L2T + (size_t)RW * 256, rb * 64, kb, lane); }
                    else cvt64(rwkv_g2, RW, 256, mid, idk, L2T + (size_t)2 * RW * 256, rb * 64, kb, lane);
                    continue; }
                it -= N_L2;
                if (it < N_UP) { cvt64(w_up_gdn, D, RW, mid, idk, WUPG, (it / (RW / 64)) * 64, it % (RW / 64), lane); continue; }
                it -= N_UP;
                if (it < N_UP) { cvt64(w_up_rwkv, D, RW, mid, idk, WUPR, (it / (RW / 64)) * 64, it % (RW / 64), lane); continue; }
                it -= N_UP;
                cvt64(w_out, D, D, mid, idk, WOUT, (it / (D / 64)) * 64, it % (D / 64), lane);
            }
        }
    }
    SEAM(0);

    if (IN(1)) {
        const float* x = a.in[0];
        const float* norm_mix_pre = a.in[4];
        const float* rwkv_mix = a.in[13];
        float* MOD = (float*)(ws + WS_MOD);
        unsigned short* AM = (unsigned short*)(ws + WS_H);
        const int gw = blockIdx.x * (NTHREADS / 64) + wave, ngw = gridDim.x * (NTHREADS / 64);
        for (int r0 = gw * 8; r0 < T; r0 += ngw * 8) {
            const int b = r0 / SEQ; const float* mod = MOD + (size_t)b * 6 * D;
            float inv_prev = 0.f;
            for (int rr = ((r0 % SEQ) == 0 ? 0 : -1); rr < 8; ++rr) {
                const int row = r0 + rr;
                float ss = 0.f;
#pragma unroll
                for (int j = 0; j < 8; ++j) { const float4 t4 = *(const float4*)(x + (size_t)row * D + j * 256 + lane * 4); ss += t4.x * t4.x + t4.y * t4.y + t4.z * t4.z + t4.w * t4.w; }
                ss = wave_sum(ss);
                const float inv = rsqrtf(ss / D + EPS);
                if (rr >= 0) {
                    const bool has_prev = (row % SEQ) != 0;
#pragma unroll 1
                    for (int j = 0; j < 8; ++j) {
                        const int d0 = j * 256 + lane * 4; const size_t o = (size_t)row * D + d0;
                        const float4 xc = *(const float4*)(x + o);
                        float4 xp = make_float4(0.f, 0.f, 0.f, 0.f); if (has_prev) xp = *(const float4*)(x + o - D);
                        const float4 nw = *(const float4*)(norm_mix_pre + d0), sc4 = *(const float4*)(mod + D + d0), sh4 = *(const float4*)(mod + d0);
                        const float g0 = nw.x * (1.0f + sc4.x), g1 = nw.y * (1.0f + sc4.y), g2 = nw.z * (1.0f + sc4.z), g3 = nw.w * (1.0f + sc4.w);
                        const float h0 = xc.x * inv * g0 + sh4.x, h1 = xc.y * inv * g1 + sh4.y, h2 = xc.z * inv * g2 + sh4.z, h3 = xc.w * inv * g3 + sh4.w;
                        float p0 = 0.f, p1 = 0.f, p2 = 0.f, p3 = 0.f;
                        if (has_prev) { p0 = xp.x * inv_prev * g0 + sh4.x; p1 = xp.y * inv_prev * g1 + sh4.y; p2 = xp.z * inv_prev * g2 + sh4.z; p3 = xp.w * inv_prev * g3 + sh4.w; }
                        pg8::u32x2 w; w.x = pg8::cvt_pk_bf16(h0, h1); w.y = pg8::cvt_pk_bf16(h2, h3);
                        *(pg8::u32x2*)(AM + o) = w;
#pragma unroll
                        for (int mi = 0; mi < 6; ++mi) {
                            const float4 mx = *(const float4*)(rwkv_mix + mi * D + d0);
                            pg8::u32x2 w2; w2.x = pg8::cvt_pk_bf16(h0 + (p0 - h0) * mx.x, h1 + (p1 - h1) * mx.y); w2.y = pg8::cvt_pk_bf16(h2 + (p2 - h2) * mx.z, h3 + (p3 - h3) * mx.w);
                            *(pg8::u32x2*)(AM + (size_t)(mi + 1) * T * D + o) = w2;
                        }
                    }
                }
                inv_prev = inv;
            }
        }
    }
    SEAM(1);

    if (IN(2)) {
        unsigned short* AM = (unsigned short*)(ws + WS_H);
        unsigned short* WINT = (unsigned short*)(ws + WS_WINT);
        float* PH = (float*)(ws + WS_PH);
        SchedInProj S{(int)gridDim.x, (int)blockIdx.x, (const char*)AM, (const char*)WINT};
        EpiInProjF32 E{PH, (unsigned short*)(ws + WS_LWA), (unsigned short*)(ws + WS_LGB)};
        pg8::gemm_phase<EpiInProjF32, SchedInProj, true, false>((LAS unsigned char*)lds_raw, D, S, E);
    }
    SEAM(2);

    if (IN(3)) {
        const float* gdn_conv = a.in[9];
        const float* gdn_A_log = a.in[10];
        const float* gdn_dt_bias = a.in[11];
        const float* rwkv_w0 = a.in[14];
        const float* rwkv_w2 = a.in[16];
        const float* rwkv_a0 = a.in[17];
        const float* rwkv_a2 = a.in[19];
        const float* rwkv_g2 = a.in[21];
        float* PH = (float*)(ws + WS_PH);
        float* WPRE = (float*)(ws + WS_WPRE);
        float* APRE = (float*)(ws + WS_APRE);
        float* GATE = (float*)(ws + WS_GATE);
        unsigned char* GREC = ws + WS_GREC;
        {
            SchedLora S{(int)gridDim.x, (int)blockIdx.x, (const char*)(ws + WS_LWA), (const char*)(ws + WS_LGB), (const char*)(ws + WS_L2T)};
            EpiLora E{WPRE, APRE, GATE, rwkv_w0, rwkv_a0};
            int klora = 256; asm volatile("" : "+s"(klora));
            pg8::gemm_phase<EpiLora, SchedLora, true, false>((LAS unsigned char*)lds_raw, klora, S, E);
        }
        __syncthreads();
        for (int item = blockIdx.x; item < 2048; item += gridDim.x) gdn_prep_item(item, (LAS unsigned char*)lds_raw, PH, gdn_conv, gdn_A_log, gdn_dt_bias, GREC);
    }
    SEAM(3);

    if (IN(4)) {
        const float* rwkv_k_k = a.in[22];
        const float* rwkv_k_a = a.in[23];
        float* PH = (float*)(ws + WS_PH);
        float* WPRE = (float*)(ws + WS_WPRE);
        float* APRE = (float*)(ws + WS_APRE);
        float* WD = (float*)(ws + WS_WD);
        float* AA = (float*)(ws + WS_AA);
        float* BB = (float*)(ws + WS_BB);
        float* KM = (float*)(ws + WS_KM);
        for (int row = blockIdx.x; row < T; row += gridDim.x) {
#pragma unroll
            for (int i = 0; i < 2; ++i) {
                const int ch = tid + i * NTHREADS;
                const float wp = WPRE[(size_t)row * RW + ch], ap = APRE[(size_t)row * RW + ch];
                const float wlog = -softplusf_(-wp) - 0.5f;
                const float wdec = expf(-expf(wlog));
                const float av = sigmoidf_(ap);
                const float kr = PH[(size_t)row * N_IN + COL_RK + ch];
                const float kkv = kr * rwkv_k_k[ch];
                const float ss = wave_sum(kkv * kkv);
                const float kk = kkv * rsqrtf(ss + 1e-6f);
                WD[(size_t)row * RW + ch] = wdec;
                AA[(size_t)row * RW + ch] = -kk;
                BB[(size_t)row * RW + ch] = kk * av;
                KM[(size_t)row * RW + ch] = kr * (1.0f + (av - 1.0f) * rwkv_k_a[ch]);
            }
        }
    }
    SEAM(4);

    if (IN(5)) {
        float* PH = (float*)(ws + WS_PH);
        unsigned char* GREC = ws + WS_GREC;
        float* WD = (float*)(ws + WS_WD);
        float* AA = (float*)(ws + WS_AA);
        float* BB = (float*)(ws + WS_BB);
        float* KM = (float*)(ws + WS_KM);
        float* OG = (float*)(ws + WS_OG);
        float* YR = (float*)(ws + WS_YR);
        if (blockIdx.x < 32) gdn_scan_seq((int)blockIdx.x, (LAS unsigned char*)lds_raw, GREC, OG);
        else if (blockIdx.x < 160) rwkv_scan_block(((int)blockIdx.x - 32) >> 1, ((int)blockIdx.x - 32) & 1, (LAS float*)(LAS unsigned char*)lds_raw, WD, AA, BB, KM, PH, YR);
    }
    SEAM(5);

    if (IN(6)) {
        const float* gdn_norm = a.in[12];
        const float* rwkv_r_k = a.in[24];
        const float* rwkv_ln_w = a.in[25];
        const float* rwkv_ln_b = a.in[26];
        float* PH = (float*)(ws + WS_PH);
        float* GATE = (float*)(ws + WS_GATE);
        float* KM = (float*)(ws + WS_KM);
        float* OG = (float*)(ws + WS_OG);
        float* YR = (float*)(ws + WS_YR);
        unsigned short* YGB = (unsigned short*)(ws + WS_YGB);
        unsigned short* YRWB = (unsigned short*)(ws + WS_YRWB);
        for (int row = blockIdx.x; row < T; row += gridDim.x) {
            {
                const int c0 = tid * 2;
                const float o0 = OG[(size_t)row * RW + c0], o1 = OG[(size_t)row * RW + c0 + 1];
                const float ss = wave_sum(o0 * o0 + o1 * o1);
                const float inv = rsqrtf(ss / 128.0f + EPS);
                const float z0 = PH[(size_t)row * N_IN + COL_Z + c0], z1 = PH[(size_t)row * N_IN + COL_Z + c0 + 1];
                *(unsigned*)(YGB + (size_t)row * RW + c0) = pg8::cvt_pk_bf16(o0 * inv * gdn_norm[c0 & 127] * siluf_(z0), o1 * inv * gdn_norm[(c0 + 1) & 127] * siluf_(z1));
            }
#pragma unroll
            for (int i = 0; i < 2; ++i) {
                const int ch = tid + i * NTHREADS;
                const float y = YR[(size_t)row * RW + ch];
                const float mu = wave_sum(y) * (1.0f / 64.0f);
                const float dlt = y - mu;
                const float var = wave_sum(dlt * dlt) * (1.0f / 64.0f);
                float yn = dlt * rsqrtf(var + 64e-5f) * rwkv_ln_w[ch] + rwkv_ln_b[ch];
                const float r = PH[(size_t)row * N_IN + COL_R + ch], km = KM[(size_t)row * RW + ch], vv = PH[(size_t)row * N_IN + COL_RV + ch];
                const float bsum = wave_sum(r * km * rwkv_r_k[ch]);
                yn += bsum * vv;
                { const float yv = yn * GATE[(size_t)row * RW + ch]; const unsigned pk = pg8::cvt_pk_bf16(yv, yv); YRWB[(size_t)row * RW + ch] = (unsigned short)(pk & 0xffffu); }
            }
        }
    }
    SEAM(6);

    if (IN(7)) {
        float* PH = (float*)(ws + WS_PH);
        unsigned short* YGB = (unsigned short*)(ws + WS_YGB);
        unsigned short* YRWB = (unsigned short*)(ws + WS_YRWB);
        unsigned short* WUPG = (unsigned short*)(ws + WS_WUPG);
        unsigned short* WUPR = (unsigned short*)(ws + WS_WUPR);
        unsigned short* MRGB = (unsigned short*)(ws + WS_MRGB);
        float* MERGED = (float*)(ws + WS_MERGED);
        SchedUp S{(int)gridDim.x, (int)blockIdx.x, (const char*)YGB, (const char*)YRWB, (const char*)WUPG, (const char*)WUPR};
        EpiUp E{MERGED, MRGB, PH};
        pg8::gemm_phase<EpiUp, SchedUp, true, false>((LAS unsigned char*)lds_raw, RW, S, E);
    }
    SEAM(7);

    if (IN(8)) {
        unsigned short* WOUT = (unsigned short*)(ws + WS_WOUT);
        unsigned short* MRGB = (unsigned short*)(ws + WS_MRGB);
        float* Y = (float*)(ws + WS_Y);
        SchedPlain S{(int)gridDim.x, (int)blockIdx.x, T / 256, D / 256, D, (const char*)MRGB, (const char*)WOUT};
        EpiF32 E{Y, D};
        pg8::gemm_phase<EpiF32, SchedPlain, true, false>((LAS unsigned char*)lds_raw, D, S, E);
    }
    SEAM(8);

    if (IN(9)) {
        const float* x = a.in[0];
        const float* norm_mix_post = a.in[5];
        const float* norm_ffn_pre = a.in[6];
        const float* router_w = a.in[30];
        const float* router_b = a.in[31];
        float* MOD = (float*)(ws + WS_MOD);
        float* Y = (float*)(ws + WS_Y);
        float* XMID = (float*)(ws + WS_XMID);
        unsigned short* H2B = (unsigned short*)(ws + WS_H2B);
        float* TOPP = (float*)(ws + WS_TOPP);
        int* LIST = (int*)(ws + WS_LIST);
        unsigned* CNT = ctl + CW_CNT;
        LAS float* h2s = (LAS float*)(LAS unsigned char*)lds_raw;
        for (int tile = blockIdx.x; tile < T / 16; tile += gridDim.x) {
            for (int rr = 0; rr < 2; ++rr) {
                const int rl = wave * 2 + rr, row = tile * 16 + rl;
                const int b = row / SEQ; const float* mod = MOD + (size_t)b * 6 * D;
                float xm[32]; float ss = 0.f;
#pragma unroll
                for (int j = 0; j < 8; ++j) { const float4 yv = *(const float4*)(Y + (size_t)row * D + j * 256 + lane * 4); xm[4 * j] = yv.x; xm[4 * j + 1] = yv.y; xm[4 * j + 2] = yv.z; xm[4 * j + 3] = yv.w;
                    ss += yv.x * yv.x + yv.y * yv.y + yv.z * yv.z + yv.w * yv.w; }
                ss = wave_sum(ss);
                const float inv = rsqrtf(ss / D + EPS);
                float ss2 = 0.f;
#pragma unroll
                for (int j = 0; j < 8; ++j) {
                    const int d0 = j * 256 + lane * 4;
                    const float4 xv = *(const float4*)(x + (size_t)row * D + d0), nw = *(const float4*)(norm_mix_post + d0), gt = *(const float4*)(mod + 2 * D + d0);
                    xm[4 * j] = xv.x + gt.x * (xm[4 * j] * inv * nw.x); xm[4 * j + 1] = xv.y + gt.y * (xm[4 * j + 1] * inv * nw.y);
                    xm[4 * j + 2] = xv.z + gt.z * (xm[4 * j + 2] * inv * nw.z); xm[4 * j + 3] = xv.w + gt.w * (xm[4 * j + 3] * inv * nw.w);
                    *(float4*)(XMID + (size_t)row * D + d0) = make_float4(xm[4 * j], xm[4 * j + 1], xm[4 * j + 2], xm[4 * j + 3]);
                    ss2 += xm[4 * j] * xm[4 * j] + xm[4 * j + 1] * xm[4 * j + 1] + xm[4 * j + 2] * xm[4 * j + 2] + xm[4 * j + 3] * xm[4 * j + 3];
                    asm volatile("" ::: "memory");
                }
                ss2 = wave_sum(ss2);
                const float inv2 = rsqrtf(ss2 / D + EPS);
#pragma unroll
                for (int j = 0; j < 8; ++j) {
                    const int d0 = j * 256 + lane * 4;
                    const float4 nw = *(const float4*)(norm_ffn_pre + d0), sc = *(const float4*)(mod + 4 * D + d0), sh = *(const float4*)(mod + 3 * D + d0);
                    f32x4_t hv; hv[0] = xm[4 * j] * inv2 * nw.x * (1.0f + sc.x) + sh.x; hv[1] = xm[4 * j + 1] * inv2 * nw.y * (1.0f + sc.y) + sh.y;
                    hv[2] = xm[4 * j + 2] * inv2 * nw.z * (1.0f + sc.z) + sh.z; hv[3] = xm[4 * j + 3] * inv2 * nw.w * (1.0f + sc.w) + sh.w;
                    pg8::u32x2 w; w.x = pg8::cvt_pk_bf16(hv[0], hv[1]); w.y = pg8::cvt_pk_bf16(hv[2], hv[3]); *(pg8::u32x2*)(H2B + (size_t)row * D + d0) = w;
                    *(LAS f32x4_t*)(h2s + rl * D + d0) = hv;
                    asm volatile("" ::: "memory");
                }
            }
            __syncthreads();
            {
                const int r = tid >> 5, e = tid & 31, row = tile * 16 + r;
                const LAS float* hp = h2s + r * D; float acc = 0.f;
#pragma unroll 4
                for (int d = 0; d < D; d += 4) { const f32x4_t h4 = *(const LAS f32x4_t*)(hp + d);
                    acc = fmaf(h4[0], router_w[(size_t)d * NE + e], acc); acc = fmaf(h4[1], router_w[(size_t)(d + 1) * NE + e], acc);
                    acc = fmaf(h4[2], router_w[(size_t)(d + 2) * NE + e], acc); acc = fmaf(h4[3], router_w[(size_t)(d + 3) * NE + e], acc); }
                float lgt = acc + router_b[e];
                float val[TOPK]; int idx[TOPK];
#pragma unroll
                for (int k = 0; k < TOPK; ++k) {
                    float bv = lgt; int bi = e;
#pragma unroll
                    for (int o = 1; o < 32; o <<= 1) { const float ov = __shfl_xor(bv, o); const int oi = __shfl_xor(bi, o); if (ov > bv || (ov == bv && oi < bi)) { bv = ov; bi = oi; } }
                    val[k] = bv; idx[k] = bi; if (e == bi) lgt = -3.0e38f;
                }
                float pe[TOPK], psum = 0.f;
#pragma unroll
                for (int k = 0; k < TOPK; ++k) { pe[k] = expf(val[k] - val[0]); psum += pe[k]; }
                if (e < TOPK) {
                    const float pk = e == 0 ? pe[0] : e == 1 ? pe[1] : e == 2 ? pe[2] : pe[3]; const int ik = e == 0 ? idx[0] : e == 1 ? idx[1] : e == 2 ? idx[2] : idx[3];
                    const int asg = row * TOPK + e;
                    TOPP[asg] = pk / psum;
                    const unsigned pos = atomicAdd(&CNT[ik], 1u);
                    LIST[(size_t)ik * T + pos] = asg;
                }
            }
            __syncthreads();
        }
    }
    SEAM(9);

    const int vcu = (gridDim.x % 8 == 0) ? (int)((blockIdx.x % 8) * (gridDim.x / 8) + blockIdx.x / 8) : (int)blockIdx.x;
    if (IN(10)) {
        const float* exp_b_gu = a.in[33];
        unsigned short* H2B = (unsigned short*)(ws + WS_H2B);
        int* LIST = (int*)(ws + WS_LIST);
        unsigned short* ACT = (unsigned short*)(ws + WS_ACT);
        unsigned short* WGU = (unsigned short*)(ws + WS_WGU);
        LAS int* mtab = (LAS int*)(LAS unsigned char*)(lds_raw + 131072);
        unsigned* CNT = ctl + CW_CNT;
        moe_tables(mtab, CNT);
        SchedMoE S{(int)gridDim.x, vcu, 2 * FF / 256, 2 * FF, mtab, LIST, (const char*)H2B, (const char*)WGU, true};
        EpiGU E{ACT, exp_b_gu};
        pg8::gemm_phase<EpiGU, SchedMoE, true, true>((LAS unsigned char*)lds_raw, D, S, E);
    }
    SEAM(10);

    if (IN(11)) {
        const float* exp_b_down = a.in[35];
        int* LIST = (int*)(ws + WS_LIST);
        unsigned short* ACT = (unsigned short*)(ws + WS_ACT);
        unsigned short* YB = (unsigned short*)(ws + WS_YB);
        unsigned short* WDN = (unsigned short*)(ws + WS_WDN);
        LAS int* mtab = (LAS int*)(LAS unsigned char*)(lds_raw + 131072);
        unsigned* CNT = ctl + CW_CNT;
        moe_tables(mtab, CNT);
        SchedMoE S{(int)gridDim.x, vcu, D / 256, D, mtab, LIST, (const char*)ACT, (const char*)WDN, false};
        EpiDown E{YB, exp_b_down};
        pg8::gemm_phase<EpiDown, SchedMoE, true, false>((LAS unsigned char*)lds_raw, FF, S, E);
    }
    SEAM(11);

    if (IN(12)) {
        const float* norm_ffn_post = a.in[7];
        float* MOD = (float*)(ws + WS_MOD);
        float* XMID = (float*)(ws + WS_XMID);
        float* TOPP = (float*)(ws + WS_TOPP);
        unsigned short* YB = (unsigned short*)(ws + WS_YB);
        for (int row = blockIdx.x; row < T; row += gridDim.x) {
            const int b = row / SEQ; const float* mod = MOD + (size_t)b * 6 * D; const int d0 = tid * 4;
            float ym[4] = {0.f, 0.f, 0.f, 0.f};
#pragma unroll
            for (int k = 0; k < TOPK; ++k) {
                const int asg = row * TOPK + k; const float p = TOPP[asg];
                const pg8::u32x2 v = *(const pg8::u32x2*)(YB + (size_t)asg * D + d0);
                ym[0] = fmaf(p, __uint_as_float(v.x << 16), ym[0]); ym[1] = fmaf(p, __uint_as_float(v.x & 0xffff0000u), ym[1]); ym[2] = fmaf(p, __uint_as_float(v.y << 16), ym[2]); ym[3] = fmaf(p, __uint_as_float(v.y & 0xffff0000u), ym[3]);
            }
            const float ss = block_sum(ym[0] * ym[0] + ym[1] * ym[1] + ym[2] * ym[2] + ym[3] * ym[3], sm);
            const float inv = rsqrtf(ss / D + EPS);
            const float4 xm = *(const float4*)(XMID + (size_t)row * D + d0);
            const float xa[4] = {xm.x, xm.y, xm.z, xm.w}; float o[4];
#pragma unroll
            for (int i = 0; i < 4; ++i) { const int d = d0 + i; o[i] = xa[i] + mod[5 * D + d] * (ym[i] * inv * norm_ffn_post[d]); }
            *(float4*)(a.out + (size_t)row * D + d0) = make_float4(o[0], o[1], o[2], o[3]);
        }
    }
#undef IN
#undef SEAM
}

constexpr int NPHASES = 13;
#ifndef MK_ONE_LAUNCH
#define MK_ONE_LAUNCH 1
#endif

extern "C" void kernel_launch(void* const* d_in, const int* in_sizes, int n_in, void* d_out, int out_size, void* d_ws, size_t ws_size, hipStream_t stream) {
    static int grid = 0;
    if (grid == 0) {
        if (n_in != 36 || out_size != T * D || ws_size < WS_END) { fprintf(stderr, "kernel_launch: unexpected shapes n_in %d out %d ws %zu (need %zu)\n", n_in, out_size, ws_size, (size_t)WS_END); grid = -1; return; }
        int dev = 0, cus = 0, per_cu = 0;
        if (hipGetDevice(&dev) != hipSuccess || hipDeviceGetAttribute(&cus, hipDeviceAttributeMultiprocessorCount, dev) != hipSuccess) { grid = -1; return; }
        if (hipFuncSetAttribute((const void*)fwd, hipFuncAttributeMaxDynamicSharedMemorySize, LDS_BYTES) != hipSuccess) { fprintf(stderr, "kernel_launch: hipFuncSetAttribute failed\n"); grid = -1; return; }
        if (hipOccupancyMaxActiveBlocksPerMultiprocessor(&per_cu, (const void*)fwd, NTHREADS, LDS_BYTES) != hipSuccess || per_cu < 1) { fprintf(stderr, "kernel_launch: occupancy query says %d\n", per_cu); }
        (void)hipGetLastError();
        grid = cus;
    }
    if (grid < 0) return;
    (void)hipMemsetAsync((char*)d_ws + WS_CTL, 0, CTL_BYTES, stream);
    Args a{};
    for (int i = 0; i < 36; ++i) a.in[i] = (const float*)d_in[i];
    a.out = (float*)d_out; a.ws = (unsigned char*)d_ws;
#if MK_ONE_LAUNCH
    a.ph_lo = 0; a.ph_hi = NPHASES;
    hipLaunchKernelGGL(fwd, dim3(grid), dim3(NTHREADS), LDS_BYTES, stream, a);
#else
    for (int p = 0; p < NPHASES; ++p) {
        a.ph_lo = p; a.ph_hi = p + 1;
        hipLaunchKernelGGL(fwd, dim3(grid), dim3(NTHREADS), LDS_BYTES, stream, a);
    }
#endif
}
```

```cpp
#include <hip/hip_runtime.h>
#include <cstdio>
#include <cstdint>

constexpr int D = 2048, NB = 4, SEQ = 4096, T = NB * SEQ;
constexpr int COL_K = 512, COL_V = 1024, COL_Z = 2048, COL_B = 3072, COL_A = 3080, COL_GATE = 3088, COL_R = 7184, COL_RK = 8208, COL_RV = 9232, N_IN = 10256;
constexpr int NE = 32, TOPK = 4, FF = 2048, NA = T * TOPK;
constexpr int RW = 1024;
constexpr float EPS = 1e-6f;
constexpr int NTHREADS = 512;
constexpr int LDS_BYTES = 128 * 1024 + 4096;

#define XB_TMO      128
#define XB_XCNT(j)  (256  + 64 * (j))
#define XB_XSUB(j)  (1280 + 64 * (j))
#define XB_XGEN(j)  (2304 + 64 * (j))
#define XB_TOP      3328
#define XB_TOPGEN   3392
#define XCD_BAR_WORDS 3456
#define XB_SPIN_CAP (1u << 22)
#define LAS __attribute__((address_space(3)))
__device__ __forceinline__ unsigned xb_ld(unsigned* p)              { return __hip_atomic_load(p, __ATOMIC_RELAXED, __HIP_MEMORY_SCOPE_AGENT); }
__device__ __forceinline__ unsigned xb_add(unsigned* p, unsigned v) { return __hip_atomic_fetch_add(p, v, __ATOMIC_RELAXED, __HIP_MEMORY_SCOPE_AGENT); }
__device__ __forceinline__ unsigned xb_xcc_id() { return (unsigned)__builtin_amdgcn_s_getreg((3 << 11) | 20) & 0xFu; }
#define XB_SPIN(cond, bar) do { unsigned _sp = 0; while (cond) { __builtin_amdgcn_s_sleep(1); \
    if ((++_sp & 255u) == 0u) { if (xb_ld(&(bar)[XB_TMO])) break; if (_sp > XB_SPIN_CAP) { atomicAdd(&(bar)[XB_TMO], 1u); break; } } } } while (0)
struct XcdBarrier { unsigned* bar; unsigned x; volatile LAS unsigned* st; };
__device__ __forceinline__ XcdBarrier xcd_barrier_post(unsigned* bar, volatile LAS unsigned* st) {
    XcdBarrier b; b.bar = bar; b.x = xb_xcc_id(); b.st = st;
    if (threadIdx.x == 0) (void)xb_add(&bar[XB_XCNT(b.x)], 1u);
    return b;
}
__device__ __forceinline__ void xcd_barrier_complete(unsigned* bar, unsigned x, unsigned& nloc, unsigned& nx) {
    const unsigned G = gridDim.x * gridDim.y * gridDim.z;
    unsigned sum, cnt, mine, sp = 0u;
    for (;;) {
        sum = 0u; cnt = 0u; mine = 0u;
#pragma unroll
        for (unsigned j = 0; j < 16; ++j) { const unsigned c = xb_ld(&bar[XB_XCNT(j)]); sum += c; cnt += (c > 0u) ? 1u : 0u; mine = (j == x) ? c : mine; }
        if (sum == G) break;
        __builtin_amdgcn_s_sleep(1);
        if ((++sp & 255u) == 0u) { if (xb_ld(&bar[XB_TMO])) break; if (sp > XB_SPIN_CAP) { atomicAdd(&bar[XB_TMO], 1u); break; } }
    }
    nloc = mine > 0u ? mine : 1u; nx = cnt > 0u ? cnt : 1u;
}
__device__ __forceinline__ void xcd_barrier(const XcdBarrier& b) {
    asm volatile("s_waitcnt vmcnt(0)" ::: "memory");
    __syncthreads();
    if (threadIdx.x == 0) {
        unsigned* bar = b.bar;
        __builtin_amdgcn_s_waitcnt(0);
        unsigned nloc = b.st[0], nx = b.st[1];
        if (nloc == 0u) { xcd_barrier_complete(bar, b.x, nloc, nx); b.st[0] = nloc; b.st[1] = nx; }
        const unsigned old = xb_add(&bar[XB_XSUB(b.x)], 1u);
        const unsigned gen = old / nloc;
        if (old + 1u == (gen + 1u) * nloc) {
            __builtin_amdgcn_fence(__ATOMIC_RELEASE, "agent");
            asm volatile("s_waitcnt vmcnt(0)" ::: "memory");
            const unsigned og = xb_add(&bar[XB_TOP], 1u);
            const unsigned tg = og / nx;
            if (og + 1u == (tg + 1u) * nx) xb_add(&bar[XB_TOPGEN], 1u);
            else XB_SPIN(xb_ld(&bar[XB_TOPGEN]) == tg, bar);
            __builtin_amdgcn_fence(__ATOMIC_ACQUIRE, "agent");
            xb_add(&bar[XB_XGEN(b.x)], 1u);
            asm volatile("s_waitcnt vmcnt(0)" ::: "memory");
        } else {
            XB_SPIN(xb_ld(&bar[XB_XGEN(b.x)]) == gen, bar);
            __builtin_amdgcn_fence(__ATOMIC_ACQUIRE, "agent");
            asm volatile("s_waitcnt vmcnt(0)" ::: "memory");
        }
    }
    __syncthreads();
}

constexpr size_t al256(size_t x) { return (x + 255) & ~(size_t)255; }
constexpr size_t WS_CTL   = 0;
constexpr size_t CTL_BYTES = 32768;
constexpr size_t CW_CNT   = XCD_BAR_WORDS + 64;
constexpr size_t WS_MOD   = WS_CTL + CTL_BYTES;
constexpr size_t WS_H     = al256(WS_MOD + (size_t)NB * 6 * D * 4);
constexpr size_t WS_WINT  = al256(WS_H + (size_t)7 * T * D * 2);
constexpr int NT_IN = 44;
constexpr size_t WS_PH    = al256(WS_WINT + (size_t)NT_IN * 256 * D * 2);
constexpr size_t WS_LWA   = al256(WS_PH + (size_t)T * N_IN * 4);
constexpr size_t WS_LGB   = al256(WS_LWA + (size_t)T * 256 * 2);
constexpr size_t WS_L2T   = al256(WS_LGB + (size_t)T * 256 * 2);
constexpr size_t WS_WPRE  = al256(WS_L2T + (size_t)3 * RW * 256 * 2);
constexpr size_t WS_APRE  = al256(WS_WPRE + (size_t)T * RW * 4);
constexpr size_t WS_GATE  = al256(WS_APRE + (size_t)T * RW * 4);
constexpr size_t WS_WD    = al256(WS_GATE + (size_t)T * RW * 4);
constexpr size_t WS_AA    = al256(WS_WD + (size_t)T * RW * 4);
constexpr size_t WS_BB    = al256(WS_AA + (size_t)T * RW * 4);
constexpr size_t WS_KM    = al256(WS_BB + (size_t)T * RW * 4);
constexpr size_t WS_OG    = al256(WS_KM + (size_t)T * RW * 4);
constexpr size_t WS_YR    = al256(WS_OG + (size_t)T * RW * 4);
constexpr size_t WS_MERGED= al256(WS_YR + (size_t)T * RW * 4);
constexpr size_t WS_Y     = al256(WS_MERGED + (size_t)T * D * 4);
constexpr size_t WS_XMID  = al256(WS_Y + (size_t)T * D * 4);
constexpr size_t WS_H2B   = al256(WS_XMID + (size_t)T * D * 4);
constexpr size_t WS_TOPP  = al256(WS_H2B + (size_t)T * D * 2);
constexpr size_t WS_LIST  = al256(WS_TOPP + (size_t)NA * 4);
constexpr int ACT_ROWS = NA + NE * 256;
constexpr size_t WS_ACT   = al256(WS_LIST + (size_t)NE * T * 4);
constexpr size_t WS_YB    = al256(WS_ACT + (size_t)ACT_ROWS * FF * 2);
constexpr size_t WS_WGU   = al256(WS_YB + (size_t)NA * D * 2);
constexpr size_t WS_WDN   = al256(WS_WGU + (size_t)NE * 2 * FF * D * 2);
constexpr size_t WS_YGB   = al256(WS_WDN + (size_t)NE * D * FF * 2);
constexpr size_t WS_YRWB  = al256(WS_YGB + (size_t)T * RW * 2);
constexpr size_t WS_WUPG  = al256(WS_YRWB + (size_t)T * RW * 2);
constexpr size_t WS_WUPR  = al256(WS_WUPG + (size_t)D * RW * 2);
constexpr size_t WS_WOUT  = al256(WS_WUPR + (size_t)D * RW * 2);
constexpr size_t WS_MRGB  = al256(WS_WOUT + (size_t)D * D * 2);
constexpr size_t WS_GREC  = al256(WS_MRGB + (size_t)T * D * 2);
constexpr size_t WS_END   = al256(WS_GREC + (size_t)2048 * 90368);

struct Args {
    const float* in[36];
    float* out;
    unsigned char* ws;
    int ph_lo, ph_hi;
};

__device__ __forceinline__ float sigmoidf_(float x) { return 1.0f / (1.0f + expf(-x)); }
__device__ __forceinline__ float siluf_(float x) { return x * sigmoidf_(x); }
__device__ __forceinline__ float softplusf_(float x) { return fmaxf(x, 0.0f) + log1pf(expf(-fabsf(x))); }
__device__ __forceinline__ float rl(float x, int k) { return __int_as_float(__builtin_amdgcn_readlane(__float_as_int(x), k)); }
__device__ __forceinline__ float wave_sum(float v) {
#pragma unroll
    for (int o = 32; o > 0; o >>= 1) v += __shfl_xor(v, o);
    return v;
}
__device__ __forceinline__ float half_sum(float v) {
#pragma unroll
    for (int o = 16; o > 0; o >>= 1) v += __shfl_xor(v, o);
    return v;
}
__device__ __forceinline__ float block_sum(float v, float* red) {
    v = wave_sum(v);
    __syncthreads();
    if ((threadIdx.x & 63) == 0) red[threadIdx.x >> 6] = v;
    __syncthreads();
    float t = 0.f;
#pragma unroll
    for (int w = 0; w < NTHREADS / 64; ++w) t += red[w];
    return t;
}

constexpr int GBM = 128, GBN = 64, GBK = 16;
template <bool DUAL, class AL, class EP>
__device__ __forceinline__ void gemm_naive(float* sm, int M, int N, int K, const AL& al, const float* __restrict__ W, int ldw, int dual_off, const EP& ep) {
    float* As = sm;
    float* Bs = sm + GBK * (GBM + 4);
    float* Bs2 = Bs + GBK * (GBN + 4);
    const int tid = threadIdx.x, tx = tid & 15, ty = tid >> 4;
    const int ntm = (M + GBM - 1) / GBM, ntn = (N + GBN - 1) / GBN;
    for (int tile = blockIdx.x; tile < ntm * ntn; tile += gridDim.x) {
        const int tm = tile / ntn, tn = tile % ntn;
        const int m0 = tm * GBM, n0 = tn * GBN;
        float acc[4][4], acc2[4][4];
#pragma unroll
        for (int i = 0; i < 4; ++i)
#pragma unroll
            for (int j = 0; j < 4; ++j) { acc[i][j] = 0.f; acc2[i][j] = 0.f; }
        for (int k0 = 0; k0 < K; k0 += GBK) {
#pragma unroll
            for (int i = 0; i < 4; ++i) { const int idx = tid + i * NTHREADS, r = idx >> 4, kk = idx & 15; As[kk * (GBM + 4) + r] = al(m0 + r, k0 + kk); }
#pragma unroll
            for (int i = 0; i < 2; ++i) { const int idx = tid + i * NTHREADS, kk = idx >> 6, c = idx & 63, n = n0 + c;
                Bs[kk * (GBN + 4) + c] = (n < N) ? W[(size_t)(k0 + kk) * ldw + n] : 0.f;
                if (DUAL) Bs2[kk * (GBN + 4) + c] = (n < N) ? W[(size_t)(k0 + kk) * ldw + n + dual_off] : 0.f; }
            __syncthreads();
#pragma unroll
            for (int kk = 0; kk < GBK; ++kk) {
                float a[4], b[4], b2[4];
#pragma unroll
                for (int i = 0; i < 4; ++i) a[i] = As[kk * (GBM + 4) + ty * 4 + i];
#pragma unroll
                for (int j = 0; j < 4; ++j) { b[j] = Bs[kk * (GBN + 4) + tx * 4 + j]; b2[j] = DUAL ? Bs2[kk * (GBN + 4) + tx * 4 + j] : 0.f; }
#pragma unroll
                for (int i = 0; i < 4; ++i)
#pragma unroll
                    for (int j = 0; j < 4; ++j) { acc[i][j] = fmaf(a[i], b[j], acc[i][j]); if (DUAL) acc2[i][j] = fmaf(a[i], b2[j], acc2[i][j]); }
            }
            __syncthreads();
        }
#pragma unroll
        for (int i = 0; i < 4; ++i)
#pragma unroll
            for (int j = 0; j < 4; ++j) { const int m = m0 + ty * 4 + i, n = n0 + tx * 4 + j; if (m < M && n < N) ep(m, n, acc[i][j], acc2[i][j]); }
    }
}

struct ALPlain { const float* A; int lda; __device__ __forceinline__ float operator()(int m, int k) const { return A[(size_t)m * lda + k]; } };
struct ALMix {
    const float* H; const float* mix;
    __device__ __forceinline__ float operator()(int m, int k) const {
        const float h = H[(size_t)m * D + k];
        const float hp = ((m % SEQ) == 0) ? 0.f : H[(size_t)(m - 1) * D + k];
        return h + (hp - h) * mix[k];
    }
};
struct ALGatherTok { const float* H2; const int* list; int cnt; __device__ __forceinline__ float operator()(int m, int k) const { return (m < cnt) ? H2[(size_t)(list[m] >> 2) * D + k] : 0.f; } };
struct ALGatherAsg { const float* ACT; const int* list; int cnt; __device__ __forceinline__ float operator()(int m, int k) const { return (m < cnt) ? ACT[(size_t)list[m] * FF + k] : 0.f; } };

namespace pg8 {
#define PG8_LAS __attribute__((address_space(3)))
typedef unsigned short bf16_t;
typedef short bf16x8 __attribute__((ext_vector_type(8)));
typedef float f32x4 __attribute__((ext_vector_type(4)));
typedef unsigned u32x4 __attribute__((ext_vector_type(4)));
typedef unsigned u32x2 __attribute__((ext_vector_type(2)));
constexpr int BM = 256, BK = 64, HALF = 128, HTB = HALF * BK * 2, STAGE_BYTES = 8 * HTB, NXCD = 8, WGM = 8;
__host__ __device__ __forceinline__ int lds_byte(int r, int c) { const int st = (r >> 4) * 2 + (c >> 5), rr = r & 15, cc = c & 31, ob = rr * 64 + cc * 2; return st * 1024 + (ob ^ (((ob >> 9) & 1) << 5)); }
__host__ __device__ __forceinline__ void stage_rc(int b, int& R, int& C) { const int st = b / 1024, sb = b % 1024, swz = sb ^ (((sb >> 9) & 1) << 5); R = (st >> 1) * 16 + swz / 64; C = (st & 1) * 32 + (swz % 64) / 2; }
__host__ __device__ __forceinline__ int perm32(int rho) { const int n = rho >> 4, i = rho & 15; return 8 * (i >> 2) + 4 * n + (i & 3); }
struct Unit { int pm, pn; const char* A; const char* B; const int* list; int cnt, e, prow; };
typedef __bf16 bf16x2_t __attribute__((ext_vector_type(2)));
__device__ __forceinline__ unsigned cvt_pk_bf16(float lo, float hi) { bf16x2_t v; v.x = (__bf16)lo; v.y = (__bf16)hi; return __builtin_bit_cast(unsigned, v); }
__device__ __forceinline__ bool static_order(int nM, int nN, int G, int c, int i, int& pm, int& pn) {
    const int nwg = nM * nN; const long L = (long)i * G + c; if (L >= nwg) return false;
    int wgid = (int)L; { const int q = nwg / NXCD, r = nwg % NXCD, xcd = wgid % NXCD, off = wgid / NXCD; wgid = (xcd < r ? xcd * (q + 1) : r * (q + 1) + (xcd - r) * q) + off; }
    const int nig = WGM * nN, gid = wgid / nig, fm = gid * WGM, gsz = (nM - fm) < WGM ? (nM - fm) : WGM;
    pm = fm + ((wgid % nig) % gsz); pn = (wgid % nig) / gsz; return true;
}
template <class Epi, class Sched, bool ALIGN_EPI = true, bool GATHER = false>
__device__ __forceinline__ void gemm_phase(PG8_LAS unsigned char* lds, const int K_, const Sched& S, const Epi& E) {
    const int tid = threadIdx.x, wid = __builtin_amdgcn_readfirstlane(tid >> 6), lane = tid & 63, wr = wid >> 2, wc = wid & 3, fr = lane & 15, fq = lane >> 4;
    const int K = K_, nt = K / BK;
    unsigned voffA[2], voffB[2];
#pragma unroll
    for (int i = 0; i < 2; ++i) { int R, C; stage_rc(tid * 16 + i * 8192, R, C); const int Rb = Epi::PERM ? ((R & ~31) + perm32(R & 31)) : R;
        voffA[i] = (unsigned)(R * K + C) * 2u; voffB[i] = (unsigned)(Rb * K + C) * 2u; }
    const size_t kstep = (size_t)(BK * 2);
    const size_t hstep = (size_t)HALF * K * 2;
    const size_t tstep = 2 * hstep; (void)tstep;
    const unsigned ldsw = (unsigned)wid * 1024u;
    const int aoff = lds_byte(wr * 64 + fr, fq * 8), boff = lds_byte(wc * 32 + fr, fq * 8);
    constexpr bool SP2 = true;
    unsigned vA_c[2][2];
    PG8_LAS unsigned* gtab = (PG8_LAS unsigned*)(lds + STAGE_BYTES + 1024);
#define PG8_FILLTAB(u) do { if (tid < 256) { const int _m = (u).pm * 256 + tid; const int _tok = (_m < (u).cnt) ? ((u).list[_m] >> 2) : 0; gtab[tid] = (unsigned)_tok * (unsigned)(K * 2); } } while (0)
#define PG8_SETVA(v, u) do { _Pragma("unroll") for (int _h = 0; _h < 2; ++_h) _Pragma("unroll") for (int _i = 0; _i < 2; ++_i) { \
        if constexpr (GATHER) { int _R, _C; stage_rc(tid * 16 + _i * 8192, _R, _C); (v)[_h][_i] = gtab[_h * 128 + _R] + (unsigned)(_C * 2); } \
        else (v)[_h][_i] = voffA[_i] + (unsigned)(_h * hstep); } } while (0)
#define PG8_STAGE_A(bufoff, gbase, h, nx) do { _Pragma("unroll") for (int _i = 0; _i < 2; ++_i) { \
        __builtin_amdgcn_global_load_lds((const unsigned*)((const char*)(gbase) + vA_c[h][_i]), (PG8_LAS unsigned*)(lds + (bufoff) + ldsw + _i * 8192), 16, 0, 0); } } while (0)
#define PG8_SA(b, h) (((b) * 2 + (h)) * HTB)
#define PG8_SB(b, h) ((4 + (b) * 2 + (h)) * HTB)
#define PG8_STAGE(bufoff, gbase, voff) do { _Pragma("unroll") for (int _i = 0; _i < 2; ++_i) \
        __builtin_amdgcn_global_load_lds((const unsigned*)((const char*)(gbase) + (voff)[_i]), (PG8_LAS unsigned*)(lds + (bufoff) + ldsw + _i * 8192), 16, 0, 0); } while (0)
#define PG8_LDA(dst, b, h) do { _Pragma("unroll") for (int m = 0; m < 4; ++m) _Pragma("unroll") for (int k = 0; k < 2; ++k) dst[m][k] = *(const PG8_LAS bf16x8*)(lds + PG8_SA(b, h) + aoff + m * 2048 + k * 1024); } while (0)
#define PG8_LDB(dst, b, h) do { _Pragma("unroll") for (int n = 0; n < 2; ++n) _Pragma("unroll") for (int k = 0; k < 2; ++k) dst[n][k] = *(const PG8_LAS bf16x8*)(lds + PG8_SB(b, h) + boff + n * 2048 + k * 1024); } while (0)
#define PG8_MMA(ai, bj, At, Bt) do { __builtin_amdgcn_s_setprio(1); _Pragma("unroll") for (int m = 0; m < 4; ++m) _Pragma("unroll") for (int n = 0; n < 2; ++n) _Pragma("unroll") for (int k = 0; k < 2; ++k) \
        acc[ai][bj][m][n] = __builtin_amdgcn_mfma_f32_16x16x32_bf16(Bt[n][k], At[m][k], acc[ai][bj][m][n], 0, 0, 0); __builtin_amdgcn_s_setprio(0); } while (0)
#define PG8_WAIT_V(n) asm volatile("s_waitcnt vmcnt(" #n ")" ::: "memory")
#define PG8_WAIT_L(n) asm volatile("s_waitcnt lgkmcnt(" #n ")" ::: "memory")
#define PG8_BAR __builtin_amdgcn_s_barrier()
#define PG8_SCHED __builtin_amdgcn_sched_barrier(0)
    Unit cur, nxt; int ui = 0;
    if (!S.next(0, cur)) return;
    f32x4 acc[2][2][4][2];
#pragma unroll
    for (int a = 0; a < 2; ++a)
#pragma unroll
        for (int b = 0; b < 2; ++b)
#pragma unroll
            for (int m = 0; m < 4; ++m)
#pragma unroll
                for (int n = 0; n < 2; ++n) acc[a][b][m][n] = (f32x4){0.f, 0.f, 0.f, 0.f};
    bf16x8 At[4][2], B0[2][2], B1[2][2];
    const char* cA = cur.A; const char* cB = cur.B;
    S.a_ready(cur);
    if constexpr (GATHER) { PG8_FILLTAB(cur); __syncthreads(); }
    PG8_SETVA(vA_c, cur);
    if constexpr (GATHER) __syncthreads();
    if constexpr (SP2) {
        PG8_STAGE(PG8_SB(0, 0), cB, voffB); PG8_STAGE(PG8_SB(0, 1), cB + hstep, voffB); PG8_STAGE_A(PG8_SA(0, 0), cA, 0, false); PG8_STAGE_A(PG8_SA(0, 1), cA, 1, false);
        if (wr == 1) PG8_BAR;
        PG8_WAIT_V(2); PG8_BAR;
        PG8_STAGE(PG8_SB(1, 0), cB + kstep, voffB); PG8_STAGE_A(PG8_SA(1, 0), cA + kstep, 0, false); PG8_STAGE(PG8_SB(1, 1), cB + hstep + kstep, voffB);
        PG8_WAIT_V(6); PG8_BAR;
    }
    for (;;) {
        const bool has_next = S.next(ui + 1, nxt);
        const char* nA = has_next ? nxt.A : cA; const char* nB = has_next ? nxt.B : cB;
        if constexpr (GATHER) { if (has_next) PG8_FILLTAB(nxt); }
        for (int t = 0; t < nt; t += 2) {
            const bool last = (t == nt - 2); const bool lastn = last && has_next; (void)lastn;
            const char* a1 = cA + (size_t)(t + 1) * kstep;
            const char* a2 = last ? nA : cA + (size_t)(t + 2) * kstep; const char* b2 = last ? nB : cB + (size_t)(t + 2) * kstep;
            const char* a3 = a2 + kstep; const char* b3 = b2 + kstep;
            if (last && has_next) S.a_ready(nxt);
            if constexpr (SP2) {
            PG8_LDB(B0, 0, 0); PG8_LDB(B1, 0, 1); PG8_SCHED; PG8_LDA(At, 0, 0); PG8_STAGE_A(PG8_SA(1, 1), a1, 1, false);
            PG8_WAIT_V(8); PG8_WAIT_L(0); PG8_BAR; PG8_MMA(0, 0, At, B0); PG8_MMA(0, 1, At, B1); PG8_BAR; PG8_SCHED;
            if constexpr (GATHER) { if (lastn) PG8_SETVA(vA_c, nxt); }
            PG8_LDA(At, 0, 1); PG8_STAGE(PG8_SB(0, 0), b2, voffB); PG8_STAGE(PG8_SB(0, 1), b2 + hstep, voffB); PG8_STAGE_A(PG8_SA(0, 0), a2, 0, lastn);
            PG8_WAIT_V(8); PG8_WAIT_L(0); PG8_BAR; PG8_MMA(1, 0, At, B0); PG8_MMA(1, 1, At, B1); PG8_BAR; PG8_SCHED;
            PG8_LDB(B0, 1, 0); PG8_LDB(B1, 1, 1); PG8_SCHED; PG8_LDA(At, 1, 0); PG8_STAGE_A(PG8_SA(0, 1), a2, 1, lastn);
            PG8_WAIT_V(8); PG8_WAIT_L(0); PG8_BAR; PG8_MMA(0, 0, At, B0); PG8_MMA(0, 1, At, B1); PG8_BAR; PG8_SCHED;
            PG8_LDA(At, 1, 1); PG8_STAGE(PG8_SB(1, 0), b3, voffB); PG8_STAGE(PG8_SB(1, 1), b3 + hstep, voffB); PG8_STAGE_A(PG8_SA(1, 0), a3, 0, lastn);
            PG8_WAIT_V(8); PG8_WAIT_L(0); PG8_BAR; PG8_MMA(1, 0, At, B0); PG8_MMA(1, 1, At, B1); PG8_BAR; PG8_SCHED;
            }
        }
        if constexpr (ALIGN_EPI) { if (wr == 0) PG8_BAR; }
        if constexpr (!Epi::AFTER_DRAIN) { E(acc, cur, wr, wc, fr, fq); S.done(cur); }
        if (!has_next) break;
#pragma unroll
        for (int a = 0; a < 2; ++a)
#pragma unroll
            for (int b = 0; b < 2; ++b)
#pragma unroll
                for (int m = 0; m < 4; ++m)
#pragma unroll
                    for (int n = 0; n < 2; ++n) acc[a][b][m][n] = (f32x4){0.f, 0.f, 0.f, 0.f};
        cur = nxt; cA = nA; cB = nB; ++ui;
        if constexpr (ALIGN_EPI) { if (wr == 1) PG8_BAR; }
    }
    PG8_WAIT_V(0);
    if constexpr (!ALIGN_EPI) { if (wr == 0) PG8_BAR; }
    PG8_BAR;
    if constexpr (Epi::AFTER_DRAIN) { E.fused(acc, cur, wr, wc, fr, fq, lds, wid, lane); S.done(cur); }
#undef PG8_SA
#undef PG8_SB
#undef PG8_STAGE
#undef PG8_STAGE_A
#undef PG8_SETVA
#undef PG8_FILLTAB
#undef PG8_LDA
#undef PG8_LDB
#undef PG8_MMA
#undef PG8_WAIT_V
#undef PG8_WAIT_L
#undef PG8_BAR
#undef PG8_SCHED
}
}


typedef float f32x4_t __attribute__((ext_vector_type(4)));
struct SchedInProj {
    int G, c; const char* Abase; const char* Bt;
    __device__ __forceinline__ bool next(int i, pg8::Unit& u) const {
        int pm, pn; if (!pg8::static_order(T / 256, NT_IN, G, c, i, pm, pn)) return false;
        const int ai = pn < 29 ? 0 : pn < 33 ? 1 : pn < 37 ? 3 : pn < 41 ? 4 : pn == 41 ? 2 : pn == 42 ? 5 : 6;
        u.pm = pm; u.pn = pn; u.A = Abase + ((size_t)ai * T + (size_t)pm * 256) * D * 2; u.B = Bt + (size_t)pn * 256 * D * 2; u.list = nullptr; u.cnt = 0; u.e = 0; u.prow = 0; return true;
    }
    __device__ __forceinline__ void a_ready(const pg8::Unit&) const {}
    __device__ __forceinline__ void done(const pg8::Unit&) const {}
};
__device__ __forceinline__ float fast_sigmoid(float x) { return __builtin_amdgcn_rcpf(1.0f + __builtin_amdgcn_exp2f(-1.4426950408889634f * x)); }
__device__ __forceinline__ float fast_tanh(float x) { return 1.0f - 2.0f * __builtin_amdgcn_rcpf(1.0f + __builtin_amdgcn_exp2f(2.8853900817779268f * x)); }
struct EpiInProjF32 {
    static constexpr bool PERM = true, AFTER_DRAIN = false;
    float* PH; unsigned short* LWA; unsigned short* LGB;
    __device__ __forceinline__ void operator()(const pg8::f32x4 (&acc)[2][2][4][2], const pg8::Unit& u, int wr, int wc, int fr, int fq) const {
        const int pn = u.pn; float* base = PH; unsigned short* b16 = LWA; int ncol = 256, act = 0, c16 = 0;
        if (pn < 12) base = PH + pn * 256;
        else if (pn < 28) base = PH + COL_GATE + (pn - 12) * 256;
        else if (pn == 28) { base = PH + COL_B; ncol = 16; }
        else if (pn < 41) base = PH + COL_R + (pn - 29) * 256;
        else if (pn == 41) { act = 1; ncol = 128; }
        else if (pn == 42) { act = 3; ncol = 128; c16 = 128; }
        else { act = 2; b16 = LGB; }
        const unsigned row0 = (unsigned)u.pm * 256u + wr * 64 + fr;
#pragma unroll
        for (int ai = 0; ai < 2; ++ai)
#pragma unroll
            for (int m = 0; m < 4; ++m) {
                const unsigned row = row0 + ai * 128 + m * 16;
#pragma unroll
                for (int bj = 0; bj < 2; ++bj) {
                    const int cl = bj * 128 + wc * 32 + 8 * fq;
                    pg8::f32x4 v0 = acc[ai][bj][m][0], v1 = acc[ai][bj][m][1];
                    if (act == 0) { if (cl < ncol) { float* dst = base + (size_t)(row * (unsigned)N_IN + (unsigned)cl); *(pg8::f32x4*)dst = v0; *(pg8::f32x4*)(dst + 4) = v1; } }
                    else {
                        if (act == 1) {
#pragma unroll
                            for (int j = 0; j < 4; ++j) { v0[j] = fast_tanh(v0[j]); v1[j] = fast_tanh(v1[j]); } }
                        if (act == 2) {
#pragma unroll
                            for (int j = 0; j < 4; ++j) { v0[j] = fast_sigmoid(v0[j]); v1[j] = fast_sigmoid(v1[j]); } }
                        if (act != 2 && cl >= 96) { v0 = (pg8::f32x4){0.f, 0.f, 0.f, 0.f}; v1 = v0; }
                        if (cl < ncol) { pg8::u32x4 w; w.x = pg8::cvt_pk_bf16(v0[0], v0[1]); w.y = pg8::cvt_pk_bf16(v0[2], v0[3]); w.z = pg8::cvt_pk_bf16(v1[0], v1[1]); w.w = pg8::cvt_pk_bf16(v1[2], v1[3]);
                            *(pg8::u32x4*)(b16 + (size_t)row * 256 + c16 + cl) = w; }
                    }
                }
            }
    }
};
struct SchedLora {
    int G, c; const char* LWA; const char* LGB; const char* L2T;
    __device__ __forceinline__ bool next(int i, pg8::Unit& u) const {
        int pm, pn; if (!pg8::static_order(T / 256, 12, G, c, i, pm, pn)) return false;
        const int g = pn >> 2;
        u.pm = pm; u.pn = pn; u.e = g; u.A = (g < 2 ? LWA : LGB) + (size_t)pm * 256 * 256 * 2; u.B = L2T + ((size_t)g * RW + (size_t)(pn & 3) * 256) * 256 * 2; u.list = nullptr; u.cnt = 0; u.prow = 0; return true;
    }
    __device__ __forceinline__ void a_ready(const pg8::Unit&) const {}
    __device__ __forceinline__ void done(const pg8::Unit&) const {}
};
struct EpiLora {
    static constexpr bool PERM = true, AFTER_DRAIN = false;
    float* WPRE; float* APRE; float* GATE; const float* w0; const float* a0;
    __device__ __forceinline__ void operator()(const pg8::f32x4 (&acc)[2][2][4][2], const pg8::Unit& u, int wr, int wc, int fr, int fq) const {
        const int g = u.e; float* C = g == 0 ? WPRE : g == 1 ? APRE : GATE; const float* bias = g == 0 ? w0 : a0;
        const unsigned row0 = (unsigned)u.pm * 256u + wr * 64 + fr; const int col0 = (u.pn & 3) * 256 + wc * 32 + 8 * fq;
        pg8::f32x4 bv[2][2];
#pragma unroll
        for (int bj = 0; bj < 2; ++bj)
#pragma unroll
            for (int n = 0; n < 2; ++n) bv[bj][n] = (g < 2) ? *(const pg8::f32x4*)(bias + col0 + 128 * bj + 4 * n) : (pg8::f32x4){0.f, 0.f, 0.f, 0.f};
#pragma unroll
        for (int ai = 0; ai < 2; ++ai)
#pragma unroll
            for (int m = 0; m < 4; ++m) {
                float* rp = C + (size_t)(row0 + ai * 128 + m * 16) * RW + col0;
#pragma unroll
                for (int bj = 0; bj < 2; ++bj) { *(pg8::f32x4*)(rp + 128 * bj) = acc[ai][bj][m][0] + bv[bj][0]; *(pg8::f32x4*)(rp + 128 * bj + 4) = acc[ai][bj][m][1] + bv[bj][1]; }
            }
    }
};

struct SchedMoE {
    int G, c, nN, nrows; const LAS int* tab; const int* LIST; const char* Abase; const char* W; bool gatherA;
    __device__ __forceinline__ bool next(int i, pg8::Unit& u) const {
        const int L = i * G + c; const int total = __builtin_amdgcn_readfirstlane(tab[32]) * nN; if (L >= total) return false;
        int e = 0;
        for (int k = 1; k < NE; ++k) if (__builtin_amdgcn_readfirstlane(tab[k]) * nN <= L) e = k;
        const int t0 = __builtin_amdgcn_readfirstlane(tab[e]), t1 = __builtin_amdgcn_readfirstlane(tab[e + 1]);
        const int q = L - t0 * nN, mt = t1 - t0;
        u.pm = q % mt; u.pn = q / mt; u.e = e; u.cnt = __builtin_amdgcn_readfirstlane(tab[128 + e]); u.list = LIST + (size_t)e * T; u.prow = t0 * 256 + u.pm * 256;
        u.A = gatherA ? Abase : Abase + (size_t)u.prow * D * 2;
        u.B = W + ((size_t)e * nrows + (size_t)u.pn * 256) * D * 2; return true;
    }
    __device__ __forceinline__ void a_ready(const pg8::Unit&) const {}
    __device__ __forceinline__ void done(const pg8::Unit&) const {}
};
struct EpiGU {
    static constexpr bool PERM = true, AFTER_DRAIN = false;
    unsigned short* ACT; const float* bgu;
    __device__ __forceinline__ void operator()(const pg8::f32x4 (&acc)[2][2][4][2], const pg8::Unit& u, int wr, int wc, int fr, int fq) const {
        const float* bg = bgu + (size_t)u.e * 2 * FF; const int f0 = 128 * u.pn + 16 * wc + 4 * fq;
        pg8::f32x4 bgv[2], buv[2];
#pragma unroll
        for (int bj = 0; bj < 2; ++bj) { bgv[bj] = *(const pg8::f32x4*)(bg + f0 + 64 * bj); buv[bj] = *(const pg8::f32x4*)(bg + FF + f0 + 64 * bj); }
        const unsigned row0 = (unsigned)u.prow + wr * 64 + fr;
#pragma unroll
        for (int ai = 0; ai < 2; ++ai)
#pragma unroll
            for (int m = 0; m < 4; ++m) {
                const unsigned row = row0 + ai * 128 + m * 16;
#pragma unroll
                for (int bj = 0; bj < 2; ++bj) {
                    const pg8::f32x4 g = acc[ai][bj][m][0] + bgv[bj], up = acc[ai][bj][m][1] + buv[bj];
                    float a[4];
#pragma unroll
                    for (int j = 0; j < 4; ++j) { const float gl = fminf(g[j], 7.0f), ul = fminf(fmaxf(up[j], -7.0f), 7.0f); a[j] = gl * fast_sigmoid(1.702f * gl) * (ul + 1.0f); }
                    pg8::u32x2 w; w.x = pg8::cvt_pk_bf16(a[0], a[1]); w.y = pg8::cvt_pk_bf16(a[2], a[3]);
                    *(pg8::u32x2*)(ACT + (size_t)row * FF + f0 + 64 * bj) = w;
                }
            }
    }
};
struct EpiDown {
    static constexpr bool PERM = true, AFTER_DRAIN = false;
    unsigned short* YB; const float* bd;
    __device__ __forceinline__ void operator()(const pg8::f32x4 (&acc)[2][2][4][2], const pg8::Unit& u, int wr, int wc, int fr, int fq) const {
        const float* b = bd + (size_t)u.e * D; const int col0 = u.pn * 256 + wc * 32 + 8 * fq;
        pg8::f32x4 bv[2][2];
#pragma unroll
        for (int bj = 0; bj < 2; ++bj)
#pragma unroll
            for (int n = 0; n < 2; ++n) bv[bj][n] = *(const pg8::f32x4*)(b + col0 + 128 * bj + 4 * n);
        const int ml0 = u.pm * 256 + wr * 64 + fr;
#pragma unroll
        for (int ai = 0; ai < 2; ++ai)
#pragma unroll
            for (int m = 0; m < 4; ++m) {
                const int ml = ml0 + ai * 128 + m * 16;
                if (ml < u.cnt) {
                    const unsigned asg = (unsigned)u.list[ml];
#pragma unroll
                    for (int bj = 0; bj < 2; ++bj) {
                        const pg8::f32x4 v0 = acc[ai][bj][m][0] + bv[bj][0], v1 = acc[ai][bj][m][1] + bv[bj][1];
                        pg8::u32x4 w; w.x = pg8::cvt_pk_bf16(v0[0], v0[1]); w.y = pg8::cvt_pk_bf16(v0[2], v0[3]); w.z = pg8::cvt_pk_bf16(v1[0], v1[1]); w.w = pg8::cvt_pk_bf16(v1[2], v1[3]);
                        *(pg8::u32x4*)(YB + (size_t)asg * D + col0 + 128 * bj) = w;
                    }
                }
            }
    }
};
__device__ __forceinline__ void moe_tables(LAS int* tab, const unsigned* CNT) {
    if (threadIdx.x == 0) {
        int acc = 0;
        for (int e = 0; e < NE; ++e) { const int c = (int)__hip_atomic_load(&CNT[e], __ATOMIC_RELAXED, __HIP_MEMORY_SCOPE_AGENT); tab[e] = acc; tab[64 + e] = acc * 256; tab[128 + e] = c; acc += (c + 255) >> 8; }
        tab[32] = acc; tab[96] = acc * 256;
    }
    __syncthreads();
}
__device__ __forceinline__ float bf2f(unsigned short h) { return __uint_as_float((unsigned)h << 16); }


struct SchedUp {
    int G, c; const char* A0; const char* A1; const char* B0; const char* B1;
    __device__ __forceinline__ bool next(int i, pg8::Unit& u) const {
        int pm, pn; if (!pg8::static_order(T / 256, D / 256, G, c, i >> 1, pm, pn)) return false;
        const int sb = i & 1;
        u.pm = pm; u.pn = pn; u.e = sb; u.A = (sb ? A1 : A0) + (size_t)pm * 256 * RW * 2; u.B = (sb ? B1 : B0) + (size_t)pn * 256 * RW * 2; u.list = nullptr; u.cnt = 0; u.prow = 0; return true;
    }
    __device__ __forceinline__ void a_ready(const pg8::Unit&) const {}
    __device__ __forceinline__ void done(const pg8::Unit&) const {}
};
struct EpiUp {
    static constexpr bool PERM = true, AFTER_DRAIN = false;
    float* M32; unsigned short* MB; const float* PH;
    __device__ __forceinline__ void operator()(const pg8::f32x4 (&acc)[2][2][4][2], const pg8::Unit& u, int wr, int wc, int fr, int fq) const {
        const int sb = u.e; const unsigned row0 = (unsigned)u.pm * 256u + wr * 64 + fr; const int col0 = u.pn * 256 + wc * 32 + 8 * fq;
#pragma unroll
        for (int ai = 0; ai < 2; ++ai)
#pragma unroll
            for (int m = 0; m < 4; ++m) {
                const unsigned row = row0 + ai * 128 + m * 16;
#pragma unroll
                for (int bj = 0; bj < 2; ++bj) {
                    const int col = col0 + 128 * bj;
                    const float* gp = PH + (size_t)row * N_IN + COL_GATE + sb * D + col;
                    const pg8::f32x4 g0 = *(const pg8::f32x4*)gp, g1 = *(const pg8::f32x4*)(gp + 4);
                    pg8::f32x4 v0 = acc[ai][bj][m][0], v1 = acc[ai][bj][m][1];
#pragma unroll
                    for (int j = 0; j < 4; ++j) { v0[j] *= fast_sigmoid(g0[j]); v1[j] *= fast_sigmoid(g1[j]); }
                    float* mp = M32 + (size_t)row * D + col;
                    if (sb == 0) { *(pg8::f32x4*)mp = v0; *(pg8::f32x4*)(mp + 4) = v1; }
                    else {
                        v0 += *(const pg8::f32x4*)mp; v1 += *(const pg8::f32x4*)(mp + 4);
                        pg8::u32x4 w; w.x = pg8::cvt_pk_bf16(v0[0], v0[1]); w.y = pg8::cvt_pk_bf16(v0[2], v0[3]); w.z = pg8::cvt_pk_bf16(v1[0], v1[1]); w.w = pg8::cvt_pk_bf16(v1[2], v1[3]);
                        *(pg8::u32x4*)(MB + (size_t)row * D + col) = w;
                    }
                }
            }
    }
};
struct SchedPlain {
    int G, c, nM, nN, K; const char* A; const char* B;
    __device__ __forceinline__ bool next(int i, pg8::Unit& u) const {
        int pm, pn; if (!pg8::static_order(nM, nN, G, c, i, pm, pn)) return false;
        u.pm = pm; u.pn = pn; u.e = 0; u.A = A + (size_t)pm * 256 * K * 2; u.B = B + (size_t)pn * 256 * K * 2; u.list = nullptr; u.cnt = 0; u.prow = 0; return true;
    }
    __device__ __forceinline__ void a_ready(const pg8::Unit&) const {}
    __device__ __forceinline__ void done(const pg8::Unit&) const {}
};
struct EpiF32 {
    static constexpr bool PERM = true, AFTER_DRAIN = false;
    float* C; int ldc;
    __device__ __forceinline__ void operator()(const pg8::f32x4 (&acc)[2][2][4][2], const pg8::Unit& u, int wr, int wc, int fr, int fq) const {
        const unsigned row0 = (unsigned)u.pm * 256u + wr * 64 + fr; const int col0 = u.pn * 256 + wc * 32 + 8 * fq;
#pragma unroll
        for (int ai = 0; ai < 2; ++ai)
#pragma unroll
            for (int m = 0; m < 4; ++m) {
                float* rp = C + (size_t)(row0 + ai * 128 + m * 16) * ldc + col0;
#pragma unroll
                for (int bj = 0; bj < 2; ++bj) { *(pg8::f32x4*)(rp + 128 * bj) = acc[ai][bj][m][0]; *(pg8::f32x4*)(rp + 128 * bj + 4) = acc[ai][bj][m][1]; }
            }
    }
};

#define LDS_WAIT() asm volatile("s_waitcnt lgkmcnt(0)" ::: "memory")
template <class F, class FK>
__device__ __forceinline__ void cvt_item_k(const float* __restrict__ W, int ldw, int K, const F& srccol, const FK& srcrow, unsigned short* WT, int row0, int kb, LAS float* scr, int lane) {
    const int n = lane & 31, k0 = kb * 64; const int sc = srccol(row0 + n);
#pragma unroll 8
    for (int i = 0; i < 32; ++i) { const int kk = 2 * i + (lane >> 5); const int sr = srcrow(k0 + kk); scr[kk * 33 + n] = (sc >= 0 && sr >= 0) ? W[(size_t)sr * ldw + sc] : 0.f; }
    LDS_WAIT();
    const int c = lane & 7;
#pragma unroll
    for (int j = 0; j < 4; ++j) { const int n2 = (lane >> 3) + 8 * j; const LAS float* sp = scr + (8 * c) * 33 + n2;
        pg8::u32x4 o; o.x = pg8::cvt_pk_bf16(sp[0 * 33], sp[1 * 33]); o.y = pg8::cvt_pk_bf16(sp[2 * 33], sp[3 * 33]); o.z = pg8::cvt_pk_bf16(sp[4 * 33], sp[5 * 33]); o.w = pg8::cvt_pk_bf16(sp[6 * 33], sp[7 * 33]);
        *(pg8::u32x4*)(WT + (size_t)(row0 + n2) * K + k0 + 8 * c) = o; }
    LDS_WAIT();
}
template <class F>
__device__ __forceinline__ void cvt_item(const float* __restrict__ W, int ldw, int K, const F& srccol, unsigned short* WT, int row0, int kb, LAS float* scr, int lane) {
    auto idk = [](int k) { return k; };
    cvt_item_k(W, ldw, K, srccol, idk, WT, row0, kb, scr, lane);
}
template <class FM, class FK>
__device__ __forceinline__ void cvt64(const float* __restrict__ W, int ldw, int K, const FM& map4, const FK& srcrow, unsigned short* __restrict__ WT, int row0, int kb, int lane) {
    const int n4 = lane & 15, kg = lane >> 4, k0 = kb * 64 + 16 * kg;
    int sc, dr; map4(row0, n4, sc, dr);
    f32x4_t v[16];
#pragma unroll
    for (int kk = 0; kk < 16; ++kk) { const int sr = srcrow(k0 + kk); v[kk] = (sc >= 0 && sr >= 0) ? *(const f32x4_t*)(W + (size_t)sr * ldw + sc) : (f32x4_t){0.f, 0.f, 0.f, 0.f}; }
#pragma unroll
    for (int j = 0; j < 4; ++j) {
        pg8::u32x4 o0, o1;
        o0.x = pg8::cvt_pk_bf16(v[0][j], v[1][j]); o0.y = pg8::cvt_pk_bf16(v[2][j], v[3][j]); o0.z = pg8::cvt_pk_bf16(v[4][j], v[5][j]); o0.w = pg8::cvt_pk_bf16(v[6][j], v[7][j]);
        o1.x = pg8::cvt_pk_bf16(v[8][j], v[9][j]); o1.y = pg8::cvt_pk_bf16(v[10][j], v[11][j]); o1.z = pg8::cvt_pk_bf16(v[12][j], v[13][j]); o1.w = pg8::cvt_pk_bf16(v[14][j], v[15][j]);
        unsigned short* dst = WT + (size_t)(dr + j) * K + k0;
        *(pg8::u32x4*)dst = o0; *(pg8::u32x4*)(dst + 8) = o1;
    }
}
__device__ __forceinline__ void inproj_src(int r, int& mat, int& col) {
    mat = 0; col = -1;
    if (r < 3072) col = r;
    else if (r < 7168) col = COL_GATE + (r - 3072);
    else if (r < 7424) { if (r - 7168 < 16) col = COL_B + (r - 7168); }
    else if (r < 10496) col = COL_R + (r - 7424);
    else if (r < 10752) { mat = 1; if (r - 10496 < 96) col = r - 10496; }
    else if (r < 11008) { mat = 2; if (r - 10752 < 96) col = r - 10752; }
    else { mat = 3; col = r - 11008; }
}

typedef short bf16x8_t __attribute__((ext_vector_type(8)));
typedef unsigned short LAS* lds_u16p;
__device__ __forceinline__ f32x4_t mma16(bf16x8_t a, bf16x8_t b, f32x4_t c) { return __builtin_amdgcn_mfma_f32_16x16x32_bf16(a, b, c, 0, 0, 0); }
__device__ __forceinline__ bf16x8_t ldfrag(const LAS unsigned short* M, int ld, int r0, int k0, int lane) { return *(const LAS bf16x8_t*)(M + (r0 + (lane & 15)) * ld + k0 + 8 * (lane >> 4)); }
__device__ __forceinline__ unsigned short f2bf(float x) { return (unsigned short)(pg8::cvt_pk_bf16(x, x) & 0xffffu); }
constexpr int GR_QG = 0, GR_W = 16384, GR_KDT = 32768, GR_AI = 49152, GR_U = 57344, GR_MISC = 90112, GR_BYTES = 90368;
constexpr int GL_KB = 0, GL_QB = 17408, GL_VT = 34816, GL_KST = 53248, GL_KDT = 71680, GL_LM = 90112, GL_TI = 107520, GL_AI = 116736, GL_SM = 125952;

__device__ __forceinline__ void tri_inverse_64(const LAS float* Lm, LAS unsigned short* Ti, int lane) {
    float xcol[64];
#pragma unroll
    for (int i = 0; i < 64; ++i) {
        float s0 = 0.f, s1 = 0.f, s2 = 0.f, s3 = 0.f;
#pragma unroll
        for (int j4 = 0; j4 < (i + 3) / 4; ++j4) {
            const f32x4_t l4 = *(const LAS f32x4_t*)(Lm + i * 68 + 4 * j4);
            if (4 * j4 + 0 < i) s0 = fmaf(l4[0], xcol[4 * j4 + 0], s0);
            if (4 * j4 + 1 < i) s1 = fmaf(l4[1], xcol[4 * j4 + 1], s1);
            if (4 * j4 + 2 < i) s2 = fmaf(l4[2], xcol[4 * j4 + 2], s2);
            if (4 * j4 + 3 < i) s3 = fmaf(l4[3], xcol[4 * j4 + 3], s3);
        }
        const float s = (s0 + s1) + (s2 + s3);
        xcol[i] = ((lane == i) ? 1.0f : 0.0f) - s;
        Ti[i * 72 + lane] = f2bf(xcol[i]);
    }
}

__device__ __forceinline__ void gdn_prep_item(int item, LAS unsigned char* lds, const float* __restrict__ PH, const float* __restrict__ convw, const float* __restrict__ A_log, const float* __restrict__ dt_bias, unsigned char* __restrict__ recs) {
    int tid_ = threadIdx.x; asm volatile("" : "+v"(tid_));
    const int tid = tid_, lane = tid & 63, wave = __builtin_amdgcn_readfirstlane(tid >> 6);
    const int ch = item & 63, hv = (item >> 6) & 7, b = item >> 9, qh = hv >> 1;
    const int s0 = ch * 64; const size_t t0 = (size_t)b * SEQ + s0;
    unsigned char* rec = recs + (size_t)item * GR_BYTES;
    LAS unsigned short* Kb = (LAS unsigned short*)(lds + GL_KB); LAS unsigned short* Qb = (LAS unsigned short*)(lds + GL_QB);
    LAS unsigned short* VT = (LAS unsigned short*)(lds + GL_VT); LAS unsigned short* KsT = (LAS unsigned short*)(lds + GL_KST); LAS unsigned short* KdT = (LAS unsigned short*)(lds + GL_KDT);
    LAS float* Lm = (LAS float*)(lds + GL_LM); LAS unsigned short* Ti = (LAS unsigned short*)(lds + GL_TI); LAS unsigned short* Ai = (LAS unsigned short*)(lds + GL_AI);
    LAS float* gcs = (LAS float*)(lds + GL_SM); LAS float* betas = gcs + 64;
    if (wave == 0) {
        const float araw = PH[(t0 + lane) * N_IN + COL_A + hv], braw = PH[(t0 + lane) * N_IN + COL_B + hv];
        float g = -expf(A_log[hv]) * softplusf_(araw + dt_bias[hv]);
#pragma unroll
        for (int o = 1; o < 64; o <<= 1) { const float t = __shfl_up(g, o); if (lane >= o) g += t; }
        gcs[lane] = g; betas[lane] = sigmoidf_(braw);
    }
    __syncthreads();
    {
        const int row = tid >> 3, cs = tid & 7, c0 = cs * 16;
        const float gcr = gcs[row], br = betas[row], glast = gcs[63];
        const float eg = expf(gcr), ekd = expf(glast - gcr);
#pragma unroll
        for (int mtx = 0; mtx < 3; ++mtx) {
            const int colbase = (mtx == 0) ? qh * 128 : (mtx == 1) ? COL_K + qh * 128 : COL_V + hv * 128;
            float acc[16];
#pragma unroll
            for (int i = 0; i < 16; ++i) acc[i] = 0.f;
#pragma unroll
            for (int j = 0; j < 4; ++j) {
                if (s0 + row - 3 + j >= 0) {
                    const float* src = PH + (t0 + row - 3 + j) * N_IN + colbase + c0; const float* cw = convw + j * 2048 + colbase + c0;
#pragma unroll
                    for (int i4 = 0; i4 < 4; ++i4) { const float4 xv = *(const float4*)(src + 4 * i4), wv = *(const float4*)(cw + 4 * i4);
                        acc[4 * i4] = fmaf(wv.x, xv.x, acc[4 * i4]); acc[4 * i4 + 1] = fmaf(wv.y, xv.y, acc[4 * i4 + 1]); acc[4 * i4 + 2] = fmaf(wv.z, xv.z, acc[4 * i4 + 2]); acc[4 * i4 + 3] = fmaf(wv.w, xv.w, acc[4 * i4 + 3]); }
                }
            }
            float ss = 0.f;
#pragma unroll
            for (int i = 0; i < 16; ++i) { acc[i] = siluf_(acc[i]); ss = fmaf(acc[i], acc[i], ss); }
            ss += __shfl_xor(ss, 1); ss += __shfl_xor(ss, 2); ss += __shfl_xor(ss, 4);
            const float rn = rsqrtf(ss + 1e-6f);
#pragma unroll
            for (int i = 0; i < 16; ++i) {
                if (mtx == 0) Qb[row * 136 + c0 + i] = f2bf(acc[i] * rn * 0.08838834764831845f);
                else if (mtx == 1) { const float kn = acc[i] * rn; Kb[row * 136 + c0 + i] = f2bf(kn); KsT[(c0 + i) * 72 + row] = f2bf(br * eg * kn); KdT[(c0 + i) * 72 + row] = f2bf(kn * ekd); }
                else VT[(c0 + i) * 72 + row] = f2bf(br * acc[i]);
            }
            asm volatile("" ::: "memory");
        }
    }
    __syncthreads();
    {
        const int mat = wave >> 2, ti = wave & 3, g4 = lane >> 4, n = lane & 15;
        const LAS unsigned short* Am = mat ? Qb : Kb;
#pragma unroll
        for (int tj = 0; tj < 4; ++tj) {
            f32x4_t acc = {0.f, 0.f, 0.f, 0.f};
#pragma unroll
            for (int ks = 0; ks < 4; ++ks) acc = mma16(ldfrag(Am, 136, 16 * ti, 32 * ks, lane), ldfrag(Kb, 136, 16 * tj, 32 * ks, lane), acc);
            const int j = 16 * tj + n; const float gj = gcs[j];
#pragma unroll
            for (int r = 0; r < 4; ++r) {
                const int i = 16 * ti + 4 * g4 + r; const float dec = expf(fminf(gcs[i] - gj, 0.f));
                if (mat == 0) Lm[i * 68 + j] = (j < i) ? betas[i] * acc[r] * dec : 0.f;
                else Ai[i * 72 + j] = f2bf((j <= i) ? acc[r] * dec : 0.f);
            }
        }
    }
    __syncthreads();
    if (wave == 0) tri_inverse_64(Lm, Ti, lane);
    else {
        for (int e = tid - 64; e < 64 * 128; e += NTHREADS - 64) { const int row = e >> 7, c = e & 127; const float qv = bf2f(Qb[row * 136 + c]); Qb[row * 136 + c] = f2bf(qv * expf(gcs[row])); }
    }
    __syncthreads();
    {
        const int g4 = lane >> 4, n = lane & 15;
#pragma unroll
        for (int t2 = 0; t2 < 2; ++t2) {
            const int tn = 2 * wave + t2; const LAS unsigned short* Bt = (tn < 8) ? VT : KsT; const int tb = tn & 7;
#pragma unroll
            for (int ti = 0; ti < 4; ++ti) {
                f32x4_t acc = {0.f, 0.f, 0.f, 0.f};
#pragma unroll
                for (int ks = 0; ks < 2; ++ks) acc = mma16(ldfrag(Ti, 72, 16 * ti, 32 * ks, lane), ldfrag(Bt, 72, 16 * tb, 32 * ks, lane), acc);
                if (tn < 8) *(f32x4_t*)(rec + GR_U + ((size_t)((ti * 8 + tb) * 64 + lane)) * 16) = acc;
                else {
#pragma unroll
                    for (int r = 0; r < 4; ++r) Kb[(16 * ti + 4 * g4 + r) * 136 + 16 * tb + n] = f2bf(acc[r]);
                }
            }
        }
    }
    __syncthreads();
    {
#pragma unroll
        for (int t2 = 0; t2 < 2; ++t2) {
            const int f = 2 * wave + t2;
            { const int ti = f >> 2, ks = f & 3;
              *(bf16x8_t*)(rec + GR_QG + (size_t)(f * 64 + lane) * 16) = ldfrag(Qb, 136, 16 * ti, 32 * ks, lane);
              *(bf16x8_t*)(rec + GR_W + (size_t)(f * 64 + lane) * 16) = ldfrag(Kb, 136, 16 * ti, 32 * ks, lane); }
            { const int td = f >> 1, ks = f & 1;
              *(bf16x8_t*)(rec + GR_KDT + (size_t)(f * 64 + lane) * 16) = ldfrag(KdT, 72, 16 * td, 32 * ks, lane); }
        }
        { const int f = wave, ti = f >> 1, ks = f & 1;
          *(bf16x8_t*)(rec + GR_AI + (size_t)(f * 64 + lane) * 16) = ldfrag(Ai, 72, 16 * ti, 32 * ks, lane); }
        if (tid == 0) *(float*)(rec + GR_MISC) = expf(gcs[63]);
    }
    __syncthreads();
}

__device__ __forceinline__ void gdn_scan_seq(int seq, LAS unsigned char* lds, const unsigned char* __restrict__ recs, float* __restrict__ OG) {
    const int tid = threadIdx.x, lane = tid & 63, wave = __builtin_amdgcn_readfirstlane(tid >> 6), g4 = lane >> 4, n = lane & 15;
    const int b = seq >> 3, hv = seq & 7;
    LAS unsigned short* St = (LAS unsigned short*)lds;
    LAS unsigned short* VnT = (LAS unsigned short*)(lds + 34816);
    for (int e = tid; e < 128 * 136; e += NTHREADS) St[e] = 0;
    f32x4_t S[8];
#pragma unroll
    for (int tv = 0; tv < 8; ++tv) S[tv] = (f32x4_t){0.f, 0.f, 0.f, 0.f};
    __syncthreads();
    const int ti = wave & 3;
    bf16x8_t nafr[4], nkfr[2], naifr[2]; f32x4_t nu[8]; float neg;
#define GS_LOAD(chv) do { const unsigned char* _r = recs + ((size_t)seq * 64 + (chv)) * GR_BYTES; \
        _Pragma("unroll") for (int ks = 0; ks < 4; ++ks) nafr[ks] = *(const bf16x8_t*)(_r + (wave < 4 ? GR_QG : GR_W) + (size_t)((ti * 4 + ks) * 64 + lane) * 16); \
        _Pragma("unroll") for (int ks = 0; ks < 2; ++ks) { nkfr[ks] = *(const bf16x8_t*)(_r + GR_KDT + (size_t)((wave * 2 + ks) * 64 + lane) * 16); naifr[ks] = *(const bf16x8_t*)(_r + GR_AI + (size_t)((ti * 2 + ks) * 64 + lane) * 16); } \
        if (wave >= 4) { _Pragma("unroll") for (int tv = 0; tv < 8; ++tv) nu[tv] = *(const f32x4_t*)(_r + GR_U + (size_t)((ti * 8 + tv) * 64 + lane) * 16); } \
        neg = *(const float*)(_r + GR_MISC); } while (0)
    GS_LOAD(0);
    for (int ch = 0; ch < 64; ++ch) {
        bf16x8_t afr[4], kfr[2], aifr[2]; f32x4_t ucur[8];
#pragma unroll
        for (int ks = 0; ks < 4; ++ks) afr[ks] = nafr[ks];
#pragma unroll
        for (int ks = 0; ks < 2; ++ks) { kfr[ks] = nkfr[ks]; aifr[ks] = naifr[ks]; }
#pragma unroll
        for (int tv = 0; tv < 8; ++tv) ucur[tv] = nu[tv];
        const float eg = neg;
        if (ch + 1 < 64) GS_LOAD(ch + 1);
        f32x4_t acc1[8];
#pragma unroll
        for (int tv = 0; tv < 8; ++tv) {
            f32x4_t a = {0.f, 0.f, 0.f, 0.f};
#pragma unroll
            for (int ks = 0; ks < 4; ++ks) a = mma16(afr[ks], ldfrag(St, 136, 16 * tv, 32 * ks, lane), a);
            acc1[tv] = a;
        }
        if (wave >= 4) {
#pragma unroll
            for (int tv = 0; tv < 8; ++tv) {
                const f32x4_t vn = ucur[tv] - acc1[tv];
                pg8::u32x2 w2; w2.x = pg8::cvt_pk_bf16(vn[0], vn[1]); w2.y = pg8::cvt_pk_bf16(vn[2], vn[3]);
                *(LAS pg8::u32x2*)(VnT + (16 * tv + n) * 72 + 16 * ti + 4 * g4) = w2;
            }
        }
        __syncthreads();
        if (wave < 4) {
#pragma unroll
            for (int tv = 0; tv < 8; ++tv) {
                f32x4_t o = acc1[tv];
#pragma unroll
                for (int ks = 0; ks < 2; ++ks) o = mma16(aifr[ks], ldfrag(VnT, 72, 16 * tv, 32 * ks, lane), o);
#pragma unroll
                for (int r = 0; r < 4; ++r) OG[((size_t)b * SEQ + ch * 64 + 16 * ti + 4 * g4 + r) * RW + hv * 128 + 16 * tv + n] = o[r];
            }
        }
#pragma unroll
        for (int tv = 0; tv < 8; ++tv) {
            f32x4_t s = S[tv] * eg;
#pragma unroll
            for (int ks = 0; ks < 2; ++ks) s = mma16(kfr[ks], ldfrag(VnT, 72, 16 * tv, 32 * ks, lane), s);
            S[tv] = s;
            pg8::u32x2 w2; w2.x = pg8::cvt_pk_bf16(s[0], s[1]); w2.y = pg8::cvt_pk_bf16(s[2], s[3]);
            *(LAS pg8::u32x2*)(St + (16 * tv + n) * 136 + 16 * wave + 4 * g4) = w2;
        }
        __syncthreads();
    }
#undef GS_LOAD
}

constexpr int RT = 32;
constexpr int RBUF_FLOATS = 5 * RT * 64 + RT * 32 + RT * 2;
typedef float f32x2_t __attribute__((ext_vector_type(2)));
__device__ __forceinline__ float dpp_f(float x, const int ctrl_sel) {
    const int xi = __float_as_int(x); int r;
    if (ctrl_sel == 0) r = __builtin_amdgcn_update_dpp(0, xi, 0xB1, 0xF, 0xF, true);
    else if (ctrl_sel == 1) r = __builtin_amdgcn_update_dpp(0, xi, 0x4E, 0xF, 0xF, true);
    else if (ctrl_sel == 2) r = __builtin_amdgcn_update_dpp(0, xi, 0x141, 0xF, 0xF, true);
    else r = __builtin_amdgcn_update_dpp(0, xi, 0x140, 0xF, 0xF, true);
    return __int_as_float(r);
}
__device__ __forceinline__ float sum8(float x) { x += dpp_f(x, 0); x += dpp_f(x, 1); x += dpp_f(x, 2); return x; }
__device__ __forceinline__ void rwkv_scan_block(int sq, int half, LAS float* lds, const float* __restrict__ WD, const float* __restrict__ AA, const float* __restrict__ BB, const float* __restrict__ KM,
                                                const float* __restrict__ PH, float* __restrict__ YR) {
    const int tid = threadIdx.x, lane = tid & 63, wave = __builtin_amdgcn_readfirstlane(tid >> 6);
    const int b = sq >> 4, h = sq & 15, rbase = half * 32;
    const size_t t0 = (size_t)b * SEQ;
    const int lt = tid - 256;
    f32x4_t s0w[2], s0a[2], s0b[2], s0k[2], s0r[2], s0v, s1w[2], s1a[2], s1b[2], s1k[2], s1r[2], s1v;
    f32x2_t S2[4];
#pragma unroll
    for (int k = 0; k < 4; ++k) S2[k] = (f32x2_t){0.f, 0.f};
#define RW_LOAD(c, P) do { _Pragma("unroll") for (int i = 0; i < 2; ++i) { const int f = lt + 256 * i, st = f >> 4, c4 = f & 15; const size_t t = t0 + (size_t)(c) * RT + st; const int col = h * 64 + c4 * 4; \
        P##w[i] = *(const f32x4_t*)(WD + t * RW + col); P##a[i] = *(const f32x4_t*)(AA + t * RW + col); P##b[i] = *(const f32x4_t*)(BB + t * RW + col); P##k[i] = *(const f32x4_t*)(KM + t * RW + col); P##r[i] = *(const f32x4_t*)(PH + t * N_IN + COL_R + col); } \
        { const int st = lt >> 3, c4 = lt & 7; P##v = *(const f32x4_t*)(PH + (t0 + (size_t)(c) * RT + st) * N_IN + COL_RV + h * 64 + rbase + c4 * 4); } } while (0)
#define RW_STORE(bufp, P) do { LAS float* _b = (bufp); _Pragma("unroll") for (int i = 0; i < 2; ++i) { const int f = lt + 256 * i, st = f >> 4, c4 = f & 15; \
        *(LAS f32x4_t*)(_b + 0 * RT * 64 + st * 64 + c4 * 4) = P##w[i]; *(LAS f32x4_t*)(_b + 1 * RT * 64 + st * 64 + c4 * 4) = P##b[i]; *(LAS f32x4_t*)(_b + 2 * RT * 64 + st * 64 + c4 * 4) = P##k[i]; \
        const f32x4_t _x = P##w[i] * P##r[i]; \
        *(LAS f32x4_t*)(_b + 3 * RT * 64 + st * 128 + c4 * 8) = (f32x4_t){P##a[i][0], _x[0], P##a[i][1], _x[1]}; *(LAS f32x4_t*)(_b + 3 * RT * 64 + st * 128 + c4 * 8 + 4) = (f32x4_t){P##a[i][2], _x[2], P##a[i][3], _x[3]}; \
        float br = P##b[i][0] * P##r[i][0] + P##b[i][1] * P##r[i][1] + P##b[i][2] * P##r[i][2] + P##b[i][3] * P##r[i][3], kr = P##k[i][0] * P##r[i][0] + P##k[i][1] * P##r[i][1] + P##k[i][2] * P##r[i][2] + P##k[i][3] * P##r[i][3]; \
        br += __shfl_xor(br, 1); br += __shfl_xor(br, 2); br += __shfl_xor(br, 4); br += __shfl_xor(br, 8); kr += __shfl_xor(kr, 1); kr += __shfl_xor(kr, 2); kr += __shfl_xor(kr, 4); kr += __shfl_xor(kr, 8); \
        if (c4 == 0) { _b[5 * RT * 64 + RT * 32 + st * 2] = br; _b[5 * RT * 64 + RT * 32 + st * 2 + 1] = kr; } } \
        { const int st = lt >> 3, c4 = lt & 7; *(LAS f32x4_t*)(_b + 5 * RT * 64 + st * 32 + c4 * 4) = P##v; } } while (0)
    constexpr int NCH = SEQ / RT;
    const int rloc = wave * 8 + (lane >> 4) * 2, kq = (lane & 15) * 4;
    LAS float* ybuf = lds + 2 * RBUF_FLOATS;
    f32x2_t T2[4];
#pragma unroll
    for (int k = 0; k < 4; ++k) T2[k] = (f32x2_t){0.f, 0.f};
    f32x4_t Aw, Ab, Ak, Ax0, Ax1, Bw, Bb, Bk, Bx0, Bx1; f32x2_t Av, Bv, Ar, Br;
#define RW_LD(X, buf, st) do { const LAS float* _p = (buf) + (st) * 64 + kq; \
        X##w = *(const LAS f32x4_t*)(_p); X##b = *(const LAS f32x4_t*)(_p + RT * 64); X##k = *(const LAS f32x4_t*)(_p + 2 * RT * 64); \
        const LAS float* _q = (buf) + 3 * RT * 64 + (st) * 128 + kq * 2; X##x0 = *(const LAS f32x4_t*)(_q); X##x1 = *(const LAS f32x4_t*)(_q + 4); \
        X##v = *(const LAS f32x2_t*)((buf) + 5 * RT * 64 + (st) * 32 + rloc); X##r = *(const LAS f32x2_t*)((buf) + 5 * RT * 64 + RT * 32 + (st) * 2); } while (0)
#define RW_SUM16(x) do { x += dpp_f(x, 0); x += dpp_f(x, 1); x += dpp_f(x, 2); x += dpp_f(x, 3); } while (0)
#define RW_STEP(X, yb, st) do { \
        f32x2_t e0 = S2[0][0] * (f32x2_t){X##x0[0], X##x0[1]}, e1 = T2[0][0] * (f32x2_t){X##x0[0], X##x0[1]}; \
        e0 += S2[0][1] * (f32x2_t){X##x0[2], X##x0[3]}; e1 += T2[0][1] * (f32x2_t){X##x0[2], X##x0[3]}; \
        e0 += S2[1][0] * (f32x2_t){X##x1[0], X##x1[1]}; e1 += T2[1][0] * (f32x2_t){X##x1[0], X##x1[1]}; \
        e0 += S2[1][1] * (f32x2_t){X##x1[2], X##x1[3]}; e1 += T2[1][1] * (f32x2_t){X##x1[2], X##x1[3]}; \
        float sa0 = e0[0], pp0 = e0[1], sa1 = e1[0], pp1 = e1[1]; RW_SUM16(sa0); RW_SUM16(sa1); RW_SUM16(pp0); RW_SUM16(pp1); \
        const f32x2_t w01 = (f32x2_t){X##w[0], X##w[1]}, w23 = (f32x2_t){X##w[2], X##w[3]}, b01 = (f32x2_t){X##b[0], X##b[1]}, b23 = (f32x2_t){X##b[2], X##b[3]}, k01 = (f32x2_t){X##k[0], X##k[1]}, k23 = (f32x2_t){X##k[2], X##k[3]}; \
        S2[0] = S2[0] * w01 + (sa0 * b01 + X##v[0] * k01); S2[1] = S2[1] * w23 + (sa0 * b23 + X##v[0] * k23); \
        T2[0] = T2[0] * w01 + (sa1 * b01 + X##v[1] * k01); T2[1] = T2[1] * w23 + (sa1 * b23 + X##v[1] * k23); \
        *(LAS f32x2_t*)((yb) + (st) * 32 + rloc) = (f32x2_t){pp0 + sa0 * X##r[0] + X##v[0] * X##r[1], pp1 + sa1 * X##r[0] + X##v[1] * X##r[1]}; } while (0)
#define RW_COMPUTE(c) do { const LAS float* buf = lds + ((c) & 1) * RBUF_FLOATS; LAS float* yb = ybuf + ((c) & 1) * RT * 32; \
        RW_LD(A, buf, 0); \
        for (int st = 0; st < RT; st += 2) { RW_LD(B, buf, st + 1); RW_STEP(A, yb, st); if (st + 2 < RT) RW_LD(A, buf, st + 2); RW_STEP(B, yb, st + 1); } } while (0)
#define RW_FLUSH(c) do { const int st = lt >> 3, c4 = lt & 7; *(f32x4_t*)(YR + (t0 + (size_t)(c) * RT + st) * RW + h * 64 + rbase + c4 * 4) = *(const LAS f32x4_t*)(ybuf + ((c) & 1) * RT * 32 + st * 32 + c4 * 4); } while (0)
    if (wave >= 4) {
        RW_LOAD(0, s0); RW_STORE(lds, s0); RW_LOAD(1, s0); RW_LOAD(2, s1);
        __syncthreads();
        for (int c = 0; c < NCH; c += 2) {
            RW_STORE(lds + RBUF_FLOATS, s0); if (c + 3 < NCH) RW_LOAD(c + 3, s0); if (c > 0) RW_FLUSH(c - 1);
            __syncthreads();
            if (c + 2 < NCH) { RW_STORE(lds, s1); } if (c + 4 < NCH) RW_LOAD(c + 4, s1); RW_FLUSH(c);
            __syncthreads();
        }
        RW_FLUSH(NCH - 1);
    } else {
        __syncthreads();
        for (int c = 0; c < NCH; c += 2) {
            RW_COMPUTE(c);
            __syncthreads();
            RW_COMPUTE(c + 1);
            __syncthreads();
        }
    }
#undef RW_COMPUTE
#undef RW_FLUSH
#undef RW_LD
#undef RW_STEP
#undef RW_SUM16
#undef RW_LOAD
#undef RW_STORE
}

__global__ void __launch_bounds__(NTHREADS, 2) fwd(Args a) {
    extern __shared__ __attribute__((aligned(16))) unsigned char lds_raw[];
    float* sm = (float*)lds_raw;
    const int tid = threadIdx.x, lane = tid & 63, wave = tid >> 6;
    unsigned char* ws = a.ws;
    unsigned* ctl = (unsigned*)(ws + WS_CTL);
    volatile LAS unsigned* xbw = (volatile LAS unsigned*)(LAS unsigned char*)(lds_raw + LDS_BYTES - 16);
    if (tid == 0) { xbw[0] = 0u; xbw[1] = 0u; xbw[2] = 0u; xbw[3] = 0u; }
    __syncthreads();
    const int lo = a.ph_lo, hi = a.ph_hi;
    XcdBarrier bar; bar.bar = ctl; bar.x = 0; bar.st = xbw;
    if (hi - lo > 1) bar = xcd_barrier_post(ctl, xbw);
#define IN(k) (lo <= (k) && (k) < hi)
#define SEAM(k) do { if (IN(k) && IN((k) + 1)) xcd_barrier(bar); } while (0)


    if (IN(0)) {
        const float* c = a.in[1];
        const float* ada_w = a.in[2];
        const float* ada_b = a.in[3];
        const float* w_in = a.in[8];
        const float* rwkv_w1 = a.in[15];
        const float* rwkv_a1 = a.in[18];
        const float* rwkv_g1 = a.in[20];
        const float* w_up_gdn = a.in[27];
        const float* w_up_rwkv = a.in[28];
        const float* w_out = a.in[29];
        const float* exp_w_gu = a.in[32];
        const float* exp_w_down = a.in[34];
        float* MOD = (float*)(ws + WS_MOD);
        unsigned short* WINT = (unsigned short*)(ws + WS_WINT);
        unsigned short* WUPG = (unsigned short*)(ws + WS_WUPG);
        unsigned short* WUPR = (unsigned short*)(ws + WS_WUPR);
        unsigned short* WOUT = (unsigned short*)(ws + WS_WOUT);
        unsigned short* WGU = (unsigned short*)(ws + WS_WGU);
        unsigned short* WDN = (unsigned short*)(ws + WS_WDN);
        float* sc = sm;
        float* part = sm + NB * D;
        for (int i = tid; i < NB * D; i += NTHREADS) sc[i] = siluf_(c[i]);
        __syncthreads();
        for (int cb = blockIdx.x; cb < 6 * D / 48; cb += gridDim.x) {
            const int cc = tid % 48, kg = tid / 48, col = cb * 48 + cc;
            if (tid < 480) {
                float acc0 = 0.f, acc1 = 0.f, acc2 = 0.f, acc3 = 0.f;
#pragma unroll 8
                for (int k = kg; k < D; k += 10) {
                    const float w = ada_w[(size_t)k * (6 * D) + col];
                    acc0 = fmaf(sc[k], w, acc0); acc1 = fmaf(sc[D + k], w, acc1); acc2 = fmaf(sc[2 * D + k], w, acc2); acc3 = fmaf(sc[3 * D + k], w, acc3);
                }
                part[(kg * 4 + 0) * 48 + cc] = acc0; part[(kg * 4 + 1) * 48 + cc] = acc1; part[(kg * 4 + 2) * 48 + cc] = acc2; part[(kg * 4 + 3) * 48 + cc] = acc3;
            }
            __syncthreads();
            if (tid < 192) {
                const int bb = tid / 48, c2 = tid % 48; float t = ada_b[cb * 48 + c2];
#pragma unroll
                for (int g = 0; g < 10; ++g) t += part[(g * 4 + bb) * 48 + c2];
                MOD[(size_t)bb * 6 * D + cb * 48 + c2] = t;
            }
            __syncthreads();
        }
        {
            const int gw = blockIdx.x * (NTHREADS / 64) + wave, ngw = gridDim.x * (NTHREADS / 64);
            auto idk = [](int k) { return k; };
            constexpr int N_IP = (NT_IN * 256 / 64) * (D / 64);
            constexpr int N_GU = NE * (2 * FF / 64) * (D / 64), N_DN = NE * (D / 64) * (FF / 64);
            constexpr int N_L2 = 3 * (RW / 64) * (256 / 64), N_UP = (D / 64) * (RW / 64), N_OUT = (D / 64) * (D / 64);
            constexpr int N_ALL = N_IP + N_GU + N_DN + N_L2 + 2 * N_UP + N_OUT;
            constexpr int N_P5 = (N_GU + N_DN) * 100 / 100;
            for (int it0 = gw + N_P5; it0 < N_ALL; it0 += ngw) {
                int it = it0;
                if (it < N_GU) {
                    const int e = it / ((2 * FF / 64) * (D / 64)), r = it % ((2 * FF / 64) * (D / 64)), rb = r / (D / 64), kb = r % (D / 64);
                    auto m4 = [](int row0, int n4, int& scol, int& drow) { const int pn = row0 >> 8, cb8 = (row0 & 255) >> 3, ft = 128 * pn + (cb8 + (n4 & 7)) * 4; scol = (n4 < 8) ? ft : FF + ft; drow = row0 + (n4 & 7) * 8 + ((n4 < 8) ? 0 : 4); };
                    cvt64(exp_w_gu + (size_t)e * D * 2 * FF, 2 * FF, D, m4, idk, WGU + (size_t)e * 2 * FF * D, rb * 64, kb, lane); continue; }
                it -= N_GU;
                auto mid = [](int row0, int n4, int& scol, int& drow) { scol = row0 + 4 * n4; drow = scol; };
                if (it < N_DN) {
                    const int e = it / ((D / 64) * (FF / 64)), r = it % ((D / 64) * (FF / 64)), rb = r / (FF / 64), kb = r % (FF / 64);
                    cvt64(exp_w_down + (size_t)e * FF * D, D, FF, mid, idk, WDN + (size_t)e * D * FF, rb * 64, kb, lane); continue; }
                it -= N_DN;
                if (it < N_IP) {
                    const int rb = it / (D / 64), kb = it % (D / 64), row0 = rb * 64;
                    int mat, col0; inproj_src(row0, mat, col0);
                    const float* W = mat == 0 ? w_in : mat == 1 ? rwkv_w1 : mat == 2 ? rwkv_a1 : rwkv_g1;
                    const int ldw = mat == 0 ? N_IN : mat == 3 ? 256 : 96;
                    auto m4 = [](int r0, int n4, int& scol, int& drow) { int m2; drow = r0 + 4 * n4; inproj_src(drow, m2, scol); };
                    cvt64(W, ldw, D, m4, idk, WINT, row0, kb, lane); continue; }
                it -= N_IP;
                if (it < N_L2) {
                    const float* rwkv_w2 = a.in[16]; const float* rwkv_a2 = a.in[19]; const float* rwkv_g2 = a.in[21]; unsigned short* L2T = (unsigned short*)(ws + WS_L2T);
                    constexpr int NL = (RW / 64) * 4; const int g = it / NL, r = it % NL, rb = r / 4, kb = r % 4;
                    if (g == 0) { auto fk = [](int k) { return k < 96 ? k : -1; }; cvt64(rwkv_w2, RW, 256, mid, fk, L2T, rb * 64, kb, lane); }
                    else if (g == 1) { auto fk = [](int k) { return (k >= 128 && k < 224) ? k - 128 : -1; }; cvt64(rwkv_a2, RW, 256, mid, fk, L2T + (size_t)RW * 256, rb * 64, kb, lane); }
                    else cvt64(rwkv_g2, RW, 256, mid, idk, L2T + (size_t)2 * RW * 256, rb * 64, kb, lane);
                    continue; }
                it -= N_L2;
                if (it < N_UP) { cvt64(w_up_gdn, D, RW, mid, idk, WUPG, (it / (RW / 64)) * 64, it % (RW / 64), lane); continue; }
                it -= N_UP;
                if (it < N_UP) { cvt64(w_up_rwkv, D, RW, mid, idk, WUPR, (it / (RW / 64)) * 64, it % (RW / 64), lane); continue; }
                it -= N_UP;
                cvt64(w_out, D, D, mid, idk, WOUT, (it / (D / 64)) * 64, it % (D / 64), lane);
            }
        }
    }
    SEAM(0);

    if (IN(1)) {
        const float* x = a.in[0]; const float* norm_mix_pre = a.in[4]; const float* rwkv_mix = a.in[13];
        float* MOD = (float*)(ws + WS_MOD); unsigned short* AM = (unsigned short*)(ws + WS_H);
        LAS float* invs = (LAS float*)(LAS unsigned char*)lds_raw;
        for (int chunk = blockIdx.x; chunk < T / 64; chunk += gridDim.x) {
            const int r0 = chunk * 64, b = r0 / SEQ; const float* mod = MOD + (size_t)b * 6 * D;
            __syncthreads();
            for (int rr = wave; rr < 65; rr += NTHREADS / 64) {
                const int row = r0 - 1 + rr; float ss = 0.f;
                if (rr > 0 || (r0 % SEQ) != 0) {
#pragma unroll
                    for (int j = 0; j < 8; ++j) { const float4 t4 = *(const float4*)(x + (size_t)row * D + j * 256 + lane * 4); ss += t4.x * t4.x + t4.y * t4.y + t4.z * t4.z + t4.w * t4.w; }
                    ss = wave_sum(ss);
                }
                if (lane == 0) invs[rr] = rsqrtf(ss / D + EPS);
            }
            __syncthreads();
            const int d0 = tid * 4;
            const float4 nw = *(const float4*)(norm_mix_pre + d0), sc4 = *(const float4*)(mod + D + d0), sh4 = *(const float4*)(mod + d0);
            const float g0 = nw.x * (1.0f + sc4.x), g1 = nw.y * (1.0f + sc4.y), g2 = nw.z * (1.0f + sc4.z), g3 = nw.w * (1.0f + sc4.w);
            float4 mx[6];
#pragma unroll
            for (int mi = 0; mi < 6; ++mi) mx[mi] = *(const float4*)(rwkv_mix + mi * D + d0);
            float p0 = 0.f, p1 = 0.f, p2 = 0.f, p3 = 0.f;
            if ((r0 % SEQ) != 0) { const float4 xp = *(const float4*)(x + (size_t)(r0 - 1) * D + d0); const float ip = invs[0];
                p0 = xp.x * ip * g0 + sh4.x; p1 = xp.y * ip * g1 + sh4.y; p2 = xp.z * ip * g2 + sh4.z; p3 = xp.w * ip * g3 + sh4.w; }
#pragma unroll 4
            for (int rr = 0; rr < 64; ++rr) {
                const size_t o = (size_t)(r0 + rr) * D + d0;
                const float4 xc = *(const float4*)(x + o); const float inv = invs[rr + 1];
                const float h0 = xc.x * inv * g0 + sh4.x, h1 = xc.y * inv * g1 + sh4.y, h2 = xc.z * inv * g2 + sh4.z, h3 = xc.w * inv * g3 + sh4.w;
                pg8::u32x2 w; w.x = pg8::cvt_pk_bf16(h0, h1); w.y = pg8::cvt_pk_bf16(h2, h3);
                *(pg8::u32x2*)(AM + o) = w;
#pragma unroll
                for (int mi = 0; mi < 6; ++mi) {
                    pg8::u32x2 w2; w2.x = pg8::cvt_pk_bf16(h0 + (p0 - h0) * mx[mi].x, h1 + (p1 - h1) * mx[mi].y); w2.y = pg8::cvt_pk_bf16(h2 + (p2 - h2) * mx[mi].z, h3 + (p3 - h3) * mx[mi].w);
                    *(pg8::u32x2*)(AM + (size_t)(mi + 1) * T * D + o) = w2;
                }
                p0 = h0; p1 = h1; p2 = h2; p3 = h3;
            }
        }
    }
    SEAM(1);

    if (IN(2)) {
        unsigned short* AM = (unsigned short*)(ws + WS_H);
        unsigned short* WINT = (unsigned short*)(ws + WS_WINT);
        float* PH = (float*)(ws + WS_PH);
        SchedInProj S{(int)gridDim.x, (int)blockIdx.x, (const char*)AM, (const char*)WINT};
        EpiInProjF32 E{PH, (unsigned short*)(ws + WS_LWA), (unsigned short*)(ws + WS_LGB)};
        pg8::gemm_phase<EpiInProjF32, SchedInProj, true, false>((LAS unsigned char*)lds_raw, D, S, E);
    }
    SEAM(2);

    if (IN(3)) {
        const float* gdn_conv = a.in[9];
        const float* gdn_A_log = a.in[10];
        const float* gdn_dt_bias = a.in[11];
        const float* rwkv_w0 = a.in[14];
        const float* rwkv_w2 = a.in[16];
        const float* rwkv_a0 = a.in[17];
        const float* rwkv_a2 = a.in[19];
        const float* rwkv_g2 = a.in[21];
        float* PH = (float*)(ws + WS_PH);
        float* WPRE = (float*)(ws + WS_WPRE);
        float* APRE = (float*)(ws + WS_APRE);
        float* GATE = (float*)(ws + WS_GATE);
        unsigned char* GREC = ws + WS_GREC;
        {
            SchedLora S{(int)gridDim.x, (int)blockIdx.x, (const char*)(ws + WS_LWA), (const char*)(ws + WS_LGB), (const char*)(ws + WS_L2T)};
            EpiLora E{WPRE, APRE, GATE, rwkv_w0, rwkv_a0};
            int klora = 256; asm volatile("" : "+s"(klora));
            pg8::gemm_phase<EpiLora, SchedLora, true, false>((LAS unsigned char*)lds_raw, klora, S, E);
        }
        __syncthreads();
        for (int item = blockIdx.x; item < 2048; item += gridDim.x) gdn_prep_item(item, (LAS unsigned char*)lds_raw, PH, gdn_conv, gdn_A_log, gdn_dt_bias, GREC);
    }
    SEAM(3);

    if (IN(4)) {
        const float* rwkv_k_k = a.in[22];
        const float* rwkv_k_a = a.in[23];
        float* PH = (float*)(ws + WS_PH);
        float* WPRE = (float*)(ws + WS_WPRE);
        float* APRE = (float*)(ws + WS_APRE);
        float* WD = (float*)(ws + WS_WD);
        float* AA = (float*)(ws + WS_AA);
        float* BB = (float*)(ws + WS_BB);
        float* KM = (float*)(ws + WS_KM);
        for (int row = blockIdx.x; row < T; row += gridDim.x) {
#pragma unroll
            for (int i = 0; i < 2; ++i) {
                const int ch = tid + i * NTHREADS;
                const float wp = WPRE[(size_t)row * RW + ch], ap = APRE[(size_t)row * RW + ch];
                const float wlog = -softplusf_(-wp) - 0.5f;
                const float wdec = expf(-expf(wlog));
                const float av = sigmoidf_(ap);
                const float kr = PH[(size_t)row * N_IN + COL_RK + ch];
                const float kkv = kr * rwkv_k_k[ch];
                const float ss = wave_sum(kkv * kkv);
                const float kk = kkv * rsqrtf(ss + 1e-6f);
                WD[(size_t)row * RW + ch] = wdec;
                AA[(size_t)row * RW + ch] = -kk;
                BB[(size_t)row * RW + ch] = kk * av;
                KM[(size_t)row * RW + ch] = kr * (1.0f + (av - 1.0f) * rwkv_k_a[ch]);
            }
        }
    }
    SEAM(4);

    if (IN(5)) {
        float* PH = (float*)(ws + WS_PH);
        unsigned char* GREC = ws + WS_GREC;
        float* WD = (float*)(ws + WS_WD);
        float* AA = (float*)(ws + WS_AA);
        float* BB = (float*)(ws + WS_BB);
        float* KM = (float*)(ws + WS_KM);
        float* OG = (float*)(ws + WS_OG);
        float* YR = (float*)(ws + WS_YR);
        if (blockIdx.x < 32) gdn_scan_seq((int)blockIdx.x, (LAS unsigned char*)lds_raw, GREC, OG);
        else if (blockIdx.x < 160) rwkv_scan_block(((int)blockIdx.x - 32) >> 1, ((int)blockIdx.x - 32) & 1, (LAS float*)(LAS unsigned char*)lds_raw, WD, AA, BB, KM, PH, YR);
        {
            const float* exp_w_gu = a.in[32]; const float* exp_w_down = a.in[34];
            unsigned short* WGU = (unsigned short*)(ws + WS_WGU); unsigned short* WDN = (unsigned short*)(ws + WS_WDN);
            constexpr int N_GU = NE * (2 * FF / 64) * (D / 64), N_DN = NE * (D / 64) * (FF / 64);
            auto idk = [](int k) { return k; };
            constexpr int N_P5 = (N_GU + N_DN) * 100 / 100;
            if (blockIdx.x >= 160) for (int it0 = ((int)blockIdx.x - 160) * (NTHREADS / 64) + wave; it0 < N_P5; it0 += ((int)gridDim.x - 160) * (NTHREADS / 64)) {
                int it = it0;
                if (it < N_GU) {
                    const int e = it / ((2 * FF / 64) * (D / 64)), r = it % ((2 * FF / 64) * (D / 64)), rb = r / (D / 64), kb = r % (D / 64);
                    auto m4 = [](int row0, int n4, int& scol, int& drow) { const int pn = row0 >> 8, cb8 = (row0 & 255) >> 3, ft = 128 * pn + (cb8 + (n4 & 7)) * 4; scol = (n4 < 8) ? ft : FF + ft; drow = row0 + (n4 & 7) * 8 + ((n4 < 8) ? 0 : 4); };
                    cvt64(exp_w_gu + (size_t)e * D * 2 * FF, 2 * FF, D, m4, idk, WGU + (size_t)e * 2 * FF * D, rb * 64, kb, lane);
                } else {
                    it -= N_GU;
                    auto mid = [](int row0, int n4, int& scol, int& drow) { scol = row0 + 4 * n4; drow = scol; };
                    const int e = it / ((D / 64) * (FF / 64)), r = it % ((D / 64) * (FF / 64)), rb = r / (FF / 64), kb = r % (FF / 64);
                    cvt64(exp_w_down + (size_t)e * FF * D, D, FF, mid, idk, WDN + (size_t)e * D * FF, rb * 64, kb, lane);
                }
            }
        }
    }
    SEAM(5);

    if (IN(6)) {
        const float* gdn_norm = a.in[12];
        const float* rwkv_r_k = a.in[24];
        const float* rwkv_ln_w = a.in[25];
        const float* rwkv_ln_b = a.in[26];
        float* PH = (float*)(ws + WS_PH);
        float* GATE = (float*)(ws + WS_GATE);
        float* KM = (float*)(ws + WS_KM);
        float* OG = (float*)(ws + WS_OG);
        float* YR = (float*)(ws + WS_YR);
        unsigned short* YGB = (unsigned short*)(ws + WS_YGB);
        unsigned short* YRWB = (unsigned short*)(ws + WS_YRWB);
        for (int row = blockIdx.x; row < T; row += gridDim.x) {
            {
                const int c0 = tid * 2;
                const float o0 = OG[(size_t)row * RW + c0], o1 = OG[(size_t)row * RW + c0 + 1];
                const float ss = wave_sum(o0 * o0 + o1 * o1);
                const float inv = rsqrtf(ss / 128.0f + EPS);
                const float z0 = PH[(size_t)row * N_IN + COL_Z + c0], z1 = PH[(size_t)row * N_IN + COL_Z + c0 + 1];
                *(unsigned*)(YGB + (size_t)row * RW + c0) = pg8::cvt_pk_bf16(o0 * inv * gdn_norm[c0 & 127] * siluf_(z0), o1 * inv * gdn_norm[(c0 + 1) & 127] * siluf_(z1));
            }
#pragma unroll
            for (int i = 0; i < 2; ++i) {
                const int ch = tid + i * NTHREADS;
                const float y = YR[(size_t)row * RW + ch];
                const float mu = wave_sum(y) * (1.0f / 64.0f);
                const float dlt = y - mu;
                const float var = wave_sum(dlt * dlt) * (1.0f / 64.0f);
                float yn = dlt * rsqrtf(var + 64e-5f) * rwkv_ln_w[ch] + rwkv_ln_b[ch];
                const float r = PH[(size_t)row * N_IN + COL_R + ch], km = KM[(size_t)row * RW + ch], vv = PH[(size_t)row * N_IN + COL_RV + ch];
                const float bsum = wave_sum(r * km * rwkv_r_k[ch]);
                yn += bsum * vv;
                { const float yv = yn * GATE[(size_t)row * RW + ch]; const unsigned pk = pg8::cvt_pk_bf16(yv, yv); YRWB[(size_t)row * RW + ch] = (unsigned short)(pk & 0xffffu); }
            }
        }
    }
    SEAM(6);

    if (IN(7)) {
        float* PH = (float*)(ws + WS_PH);
        unsigned short* YGB = (unsigned short*)(ws + WS_YGB);
        unsigned short* YRWB = (unsigned short*)(ws + WS_YRWB);
        unsigned short* WUPG = (unsigned short*)(ws + WS_WUPG);
        unsigned short* WUPR = (unsigned short*)(ws + WS_WUPR);
        unsigned short* MRGB = (unsigned short*)(ws + WS_MRGB);
        float* MERGED = (float*)(ws + WS_MERGED);
        SchedUp S{(int)gridDim.x, (int)blockIdx.x, (const char*)YGB, (const char*)YRWB, (const char*)WUPG, (const char*)WUPR};
        EpiUp E{MERGED, MRGB, PH};
        pg8::gemm_phase<EpiUp, SchedUp, true, false>((LAS unsigned char*)lds_raw, RW, S, E);
    }
    SEAM(7);

    if (IN(8)) {
        unsigned short* WOUT = (unsigned short*)(ws + WS_WOUT);
        unsigned short* MRGB = (unsigned short*)(ws + WS_MRGB);
        float* Y = (float*)(ws + WS_Y);
        SchedPlain S{(int)gridDim.x, (int)blockIdx.x, T / 256, D / 256, D, (const char*)MRGB, (const char*)WOUT};
        EpiF32 E{Y, D};
        pg8::gemm_phase<EpiF32, SchedPlain, true, false>((LAS unsigned char*)lds_raw, D, S, E);
    }
    SEAM(8);

    if (IN(9)) {
        const float* x = a.in[0];
        const float* norm_mix_post = a.in[5];
        const float* norm_ffn_pre = a.in[6];
        const float* router_w = a.in[30];
        const float* router_b = a.in[31];
        float* MOD = (float*)(ws + WS_MOD);
        float* Y = (float*)(ws + WS_Y);
        float* XMID = (float*)(ws + WS_XMID);
        unsigned short* H2B = (unsigned short*)(ws + WS_H2B);
        float* TOPP = (float*)(ws + WS_TOPP);
        int* LIST = (int*)(ws + WS_LIST);
        unsigned* CNT = ctl + CW_CNT;
        LAS float* h2s = (LAS float*)(LAS unsigned char*)lds_raw;
        for (int tile = blockIdx.x; tile < T / 16; tile += gridDim.x) {
            for (int rr = 0; rr < 2; ++rr) {
                const int rl = wave * 2 + rr, row = tile * 16 + rl;
                const int b = row / SEQ; const float* mod = MOD + (size_t)b * 6 * D;
                float xm[32]; float ss = 0.f;
#pragma unroll
                for (int j = 0; j < 8; ++j) { const float4 yv = *(const float4*)(Y + (size_t)row * D + j * 256 + lane * 4); xm[4 * j] = yv.x; xm[4 * j + 1] = yv.y; xm[4 * j + 2] = yv.z; xm[4 * j + 3] = yv.w;
                    ss += yv.x * yv.x + yv.y * yv.y + yv.z * yv.z + yv.w * yv.w; }
                ss = wave_sum(ss);
                const float inv = rsqrtf(ss / D + EPS);
                float ss2 = 0.f;
#pragma unroll
                for (int j = 0; j < 8; ++j) {
                    const int d0 = j * 256 + lane * 4;
                    const float4 xv = *(const float4*)(x + (size_t)row * D + d0), nw = *(const float4*)(norm_mix_post + d0), gt = *(const float4*)(mod + 2 * D + d0);
                    xm[4 * j] = xv.x + gt.x * (xm[4 * j] * inv * nw.x); xm[4 * j + 1] = xv.y + gt.y * (xm[4 * j + 1] * inv * nw.y);
                    xm[4 * j + 2] = xv.z + gt.z * (xm[4 * j + 2] * inv * nw.z); xm[4 * j + 3] = xv.w + gt.w * (xm[4 * j + 3] * inv * nw.w);
                    *(float4*)(XMID + (size_t)row * D + d0) = make_float4(xm[4 * j], xm[4 * j + 1], xm[4 * j + 2], xm[4 * j + 3]);
                    ss2 += xm[4 * j] * xm[4 * j] + xm[4 * j + 1] * xm[4 * j + 1] + xm[4 * j + 2] * xm[4 * j + 2] + xm[4 * j + 3] * xm[4 * j + 3];
                    asm volatile("" ::: "memory");
                }
                ss2 = wave_sum(ss2);
                const float inv2 = rsqrtf(ss2 / D + EPS);
#pragma unroll
                for (int j = 0; j < 8; ++j) {
                    const int d0 = j * 256 + lane * 4;
                    const float4 nw = *(const float4*)(norm_ffn_pre + d0), sc = *(const float4*)(mod + 4 * D + d0), sh = *(const float4*)(mod + 3 * D + d0);
                    f32x4_t hv; hv[0] = xm[4 * j] * inv2 * nw.x * (1.0f + sc.x) + sh.x; hv[1] = xm[4 * j + 1] * inv2 * nw.y * (1.0f + sc.y) + sh.y;
                    hv[2] = xm[4 * j + 2] * inv2 * nw.z * (1.0f + sc.z) + sh.z; hv[3] = xm[4 * j + 3] * inv2 * nw.w * (1.0f + sc.w) + sh.w;
                    pg8::u32x2 w; w.x = pg8::cvt_pk_bf16(hv[0], hv[1]); w.y = pg8::cvt_pk_bf16(hv[2], hv[3]); *(pg8::u32x2*)(H2B + (size_t)row * D + d0) = w;
                    *(LAS f32x4_t*)(h2s + rl * D + d0) = hv;
                    asm volatile("" ::: "memory");
                }
            }
            __syncthreads();
            {
                const int r = tid >> 5, e = tid & 31, row = tile * 16 + r;
                const LAS float* hp = h2s + r * D; float acc = 0.f;
#pragma unroll 4
                for (int d = 0; d < D; d += 4) { const f32x4_t h4 = *(const LAS f32x4_t*)(hp + d);
                    acc = fmaf(h4[0], router_w[(size_t)d * NE + e], acc); acc = fmaf(h4[1], router_w[(size_t)(d + 1) * NE + e], acc);
                    acc = fmaf(h4[2], router_w[(size_t)(d + 2) * NE + e], acc); acc = fmaf(h4[3], router_w[(size_t)(d + 3) * NE + e], acc); }
                float lgt = acc + router_b[e];
                float val[TOPK]; int idx[TOPK];
#pragma unroll
                for (int k = 0; k < TOPK; ++k) {
                    float bv = lgt; int bi = e;
#pragma unroll
                    for (int o = 1; o < 32; o <<= 1) { const float ov = __shfl_xor(bv, o); const int oi = __shfl_xor(bi, o); if (ov > bv || (ov == bv && oi < bi)) { bv = ov; bi = oi; } }
                    val[k] = bv; idx[k] = bi; if (e == bi) lgt = -3.0e38f;
                }
                float pe[TOPK], psum = 0.f;
#pragma unroll
                for (int k = 0; k < TOPK; ++k) { pe[k] = expf(val[k] - val[0]); psum += pe[k]; }
                if (e < TOPK) {
                    const float pk = e == 0 ? pe[0] : e == 1 ? pe[1] : e == 2 ? pe[2] : pe[3]; const int ik = e == 0 ? idx[0] : e == 1 ? idx[1] : e == 2 ? idx[2] : idx[3];
                    const int asg = row * TOPK + e;
                    TOPP[asg] = pk / psum;
                    const unsigned pos = atomicAdd(&CNT[ik], 1u);
                    LIST[(size_t)ik * T + pos] = asg;
                }
            }
            __syncthreads();
        }
    }
    SEAM(9);

    const int vcu = (gridDim.x % 8 == 0) ? (int)((blockIdx.x % 8) * (gridDim.x / 8) + blockIdx.x / 8) : (int)blockIdx.x;
    if (IN(10)) {
        const float* exp_b_gu = a.in[33];
        unsigned short* H2B = (unsigned short*)(ws + WS_H2B);
        int* LIST = (int*)(ws + WS_LIST);
        unsigned short* ACT = (unsigned short*)(ws + WS_ACT);
        unsigned short* WGU = (unsigned short*)(ws + WS_WGU);
        LAS int* mtab = (LAS int*)(LAS unsigned char*)(lds_raw + 131072);
        unsigned* CNT = ctl + CW_CNT;
        moe_tables(mtab, CNT);
        SchedMoE S{(int)gridDim.x, vcu, 2 * FF / 256, 2 * FF, mtab, LIST, (const char*)H2B, (const char*)WGU, true};
        EpiGU E{ACT, exp_b_gu};
        pg8::gemm_phase<EpiGU, SchedMoE, true, true>((LAS unsigned char*)lds_raw, D, S, E);
    }
    SEAM(10);

    if (IN(11)) {
        const float* exp_b_down = a.in[35];
        int* LIST = (int*)(ws + WS_LIST);
        unsigned short* ACT = (unsigned short*)(ws + WS_ACT);
        unsigned short* YB = (unsigned short*)(ws + WS_YB);
        unsigned short* WDN = (unsigned short*)(ws + WS_WDN);
        LAS int* mtab = (LAS int*)(LAS unsigned char*)(lds_raw + 131072);
        unsigned* CNT = ctl + CW_CNT;
        moe_tables(mtab, CNT);
        SchedMoE S{(int)gridDim.x, vcu, D / 256, D, mtab, LIST, (const char*)ACT, (const char*)WDN, false};
        EpiDown E{YB, exp_b_down};
        pg8::gemm_phase<EpiDown, SchedMoE, true, false>((LAS unsigned char*)lds_raw, FF, S, E);
    }
    SEAM(11);

    if (IN(12)) {
        const float* norm_ffn_post = a.in[7];
        float* MOD = (float*)(ws + WS_MOD);
        float* XMID = (float*)(ws + WS_XMID);
        float* TOPP = (float*)(ws + WS_TOPP);
        unsigned short* YB = (unsigned short*)(ws + WS_YB);
        for (int row = blockIdx.x; row < T; row += gridDim.x) {
            const int b = row / SEQ; const float* mod = MOD + (size_t)b * 6 * D; const int d0 = tid * 4;
            float ym[4] = {0.f, 0.f, 0.f, 0.f};
#pragma unroll
            for (int k = 0; k < TOPK; ++k) {
                const int asg = row * TOPK + k; const float p = TOPP[asg];
                const pg8::u32x2 v = *(const pg8::u32x2*)(YB + (size_t)asg * D + d0);
                ym[0] = fmaf(p, __uint_as_float(v.x << 16), ym[0]); ym[1] = fmaf(p, __uint_as_float(v.x & 0xffff0000u), ym[1]); ym[2] = fmaf(p, __uint_as_float(v.y << 16), ym[2]); ym[3] = fmaf(p, __uint_as_float(v.y & 0xffff0000u), ym[3]);
            }
            const float ss = block_sum(ym[0] * ym[0] + ym[1] * ym[1] + ym[2] * ym[2] + ym[3] * ym[3], sm);
            const float inv = rsqrtf(ss / D + EPS);
            const float4 xm = *(const float4*)(XMID + (size_t)row * D + d0);
            const float xa[4] = {xm.x, xm.y, xm.z, xm.w}; float o[4];
#pragma unroll
            for (int i = 0; i < 4; ++i) { const int d = d0 + i; o[i] = xa[i] + mod[5 * D + d] * (ym[i] * inv * norm_ffn_post[d]); }
            *(float4*)(a.out + (size_t)row * D + d0) = make_float4(o[0], o[1], o[2], o[3]);
        }
    }
#undef IN
#undef SEAM
}

constexpr int NPHASES = 13;
#ifndef MK_ONE_LAUNCH
#define MK_ONE_LAUNCH 1
#endif

extern "C" void kernel_launch(void* const* d_in, const int* in_sizes, int n_in, void* d_out, int out_size, void* d_ws, size_t ws_size, hipStream_t stream) {
    static int grid = 0;
    if (grid == 0) {
        if (n_in != 36 || out_size != T * D || ws_size < WS_END) { fprintf(stderr, "kernel_launch: unexpected shapes n_in %d out %d ws %zu (need %zu)\n", n_in, out_size, ws_size, (size_t)WS_END); grid = -1; return; }
        int dev = 0, cus = 0, per_cu = 0;
        if (hipGetDevice(&dev) != hipSuccess || hipDeviceGetAttribute(&cus, hipDeviceAttributeMultiprocessorCount, dev) != hipSuccess) { grid = -1; return; }
        if (hipFuncSetAttribute((const void*)fwd, hipFuncAttributeMaxDynamicSharedMemorySize, LDS_BYTES) != hipSuccess) { fprintf(stderr, "kernel_launch: hipFuncSetAttribute failed\n"); grid = -1; return; }
        if (hipOccupancyMaxActiveBlocksPerMultiprocessor(&per_cu, (const void*)fwd, NTHREADS, LDS_BYTES) != hipSuccess || per_cu < 1) { fprintf(stderr, "kernel_launch: occupancy query says %d\n", per_cu); }
        (void)hipGetLastError();
        grid = cus;
    }
    if (grid < 0) return;
    (void)hipMemsetAsync((char*)d_ws + WS_CTL, 0, CTL_BYTES, stream);
    Args a{};
    for (int i = 0; i < 36; ++i) a.in[i] = (const float*)d_in[i];
    a.out = (float*)d_out; a.ws = (unsigned char*)d_ws;
#if MK_ONE_LAUNCH
    a.ph_lo = 0; a.ph_hi = NPHASES;
    hipLaunchKernelGGL(fwd, dim3(grid), dim3(NTHREADS), LDS_BYTES, stream, a);
#else
    for (int p = 0; p < NPHASES; ++p) {
        a.ph_lo = p; a.ph_hi = p + 1;
        hipLaunchKernelGGL(fwd, dim3(grid), dim3(NTHREADS), LDS_BYTES, stream, a);
    }
#endif
}
```

```cpp
#include <hip/hip_runtime.h>
#include <cstdio>
#include <cstdint>

constexpr int D = 2048, NB = 4, SEQ = 4096, T = NB * SEQ;
constexpr int COL_K = 512, COL_V = 1024, COL_Z = 2048, COL_B = 3072, COL_A = 3080, COL_GATE = 3088, COL_R = 7184, COL_RK = 8208, COL_RV = 9232, N_IN = 10256;
constexpr int NE = 32, TOPK = 4, FF = 2048, NA = T * TOPK;
constexpr int RW = 1024;
constexpr float EPS = 1e-6f;
constexpr int NTHREADS = 512;
constexpr int LDS_BYTES = 128 * 1024 + 4096;

#define XB_TMO      128
#define XB_XCNT(j)  (256  + 64 * (j))
#define XB_XSUB(j)  (1280 + 64 * (j))
#define XB_XGEN(j)  (2304 + 64 * (j))
#define XB_TOP      3328
#define XB_TOPGEN   3392
#define XCD_BAR_WORDS 3456
#define XB_SPIN_CAP (1u << 22)
#define LAS __attribute__((address_space(3)))
__device__ __forceinline__ unsigned xb_ld(unsigned* p)              { return __hip_atomic_load(p, __ATOMIC_RELAXED, __HIP_MEMORY_SCOPE_AGENT); }
__device__ __forceinline__ unsigned xb_add(unsigned* p, unsigned v) { return __hip_atomic_fetch_add(p, v, __ATOMIC_RELAXED, __HIP_MEMORY_SCOPE_AGENT); }
__device__ __forceinline__ unsigned xb_xcc_id() { return (unsigned)__builtin_amdgcn_s_getreg((3 << 11) | 20) & 0xFu; }
#define XB_SPIN(cond, bar) do { unsigned _sp = 0; while (cond) { __builtin_amdgcn_s_sleep(1); \
    if ((++_sp & 255u) == 0u) { if (xb_ld(&(bar)[XB_TMO])) break; if (_sp > XB_SPIN_CAP) { atomicAdd(&(bar)[XB_TMO], 1u); break; } } } } while (0)
struct XcdBarrier { unsigned* bar; unsigned x; volatile LAS unsigned* st; };
__device__ __forceinline__ XcdBarrier xcd_barrier_post(unsigned* bar, volatile LAS unsigned* st) {
    XcdBarrier b; b.bar = bar; b.x = xb_xcc_id(); b.st = st;
    if (threadIdx.x == 0) (void)xb_add(&bar[XB_XCNT(b.x)], 1u);
    return b;
}
__device__ __forceinline__ void xcd_barrier_complete(unsigned* bar, unsigned x, unsigned& nloc, unsigned& nx) {
    const unsigned G = gridDim.x * gridDim.y * gridDim.z;
    unsigned sum, cnt, mine, sp = 0u;
    for (;;) {
        sum = 0u; cnt = 0u; mine = 0u;
#pragma unroll
        for (unsigned j = 0; j < 16; ++j) { const unsigned c = xb_ld(&bar[XB_XCNT(j)]); sum += c; cnt += (c > 0u) ? 1u : 0u; mine = (j == x) ? c : mine; }
        if (sum == G) break;
        __builtin_amdgcn_s_sleep(1);
        if ((++sp & 255u) == 0u) { if (xb_ld(&bar[XB_TMO])) break; if (sp > XB_SPIN_CAP) { atomicAdd(&bar[XB_TMO], 1u); break; } }
    }
    nloc = mine > 0u ? mine : 1u; nx = cnt > 0u ? cnt : 1u;
}
__device__ __forceinline__ void xcd_barrier(const XcdBarrier& b) {
    asm volatile("s_waitcnt vmcnt(0)" ::: "memory");
    __syncthreads();
    if (threadIdx.x == 0) {
        unsigned* bar = b.bar;
        __builtin_amdgcn_s_waitcnt(0);
        unsigned nloc = b.st[0], nx = b.st[1];
        if (nloc == 0u) { xcd_barrier_complete(bar, b.x, nloc, nx); b.st[0] = nloc; b.st[1] = nx; }
        const unsigned old = xb_add(&bar[XB_XSUB(b.x)], 1u);
        const unsigned gen = old / nloc;
        if (old + 1u == (gen + 1u) * nloc) {
            __builtin_amdgcn_fence(__ATOMIC_RELEASE, "agent");
            asm volatile("s_waitcnt vmcnt(0)" ::: "memory");
            const unsigned og = xb_add(&bar[XB_TOP], 1u);
            const unsigned tg = og / nx;
            if (og + 1u == (tg + 1u) * nx) xb_add(&bar[XB_TOPGEN], 1u);
            else XB_SPIN(xb_ld(&bar[XB_TOPGEN]) == tg, bar);
            __builtin_amdgcn_fence(__ATOMIC_ACQUIRE, "agent");
            xb_add(&bar[XB_XGEN(b.x)], 1u);
            asm volatile("s_waitcnt vmcnt(0)" ::: "memory");
        } else {
            XB_SPIN(xb_ld(&bar[XB_XGEN(b.x)]) == gen, bar);
            __builtin_amdgcn_fence(__ATOMIC_ACQUIRE, "agent");
            asm volatile("s_waitcnt vmcnt(0)" ::: "memory");
        }
    }
    __syncthreads();
}

constexpr size_t al256(size_t x) { return (x + 255) & ~(size_t)255; }
constexpr size_t WS_CTL   = 0;
constexpr size_t CTL_BYTES = 32768;
constexpr size_t CW_CNT   = XCD_BAR_WORDS + 64;
constexpr size_t WS_MOD   = WS_CTL + CTL_BYTES;
constexpr size_t WS_H     = al256(WS_MOD + (size_t)NB * 6 * D * 4);
constexpr size_t WS_WINT  = al256(WS_H + (size_t)7 * T * D * 2);
constexpr int NT_IN = 44;
constexpr size_t WS_PH    = al256(WS_WINT + (size_t)NT_IN * 256 * D * 2);
constexpr size_t WS_BA    = al256(WS_PH + (size_t)T * N_IN * 2);
constexpr size_t WS_LWA   = al256(WS_BA + (size_t)T * 16 * 4);
constexpr size_t WS_LGB   = al256(WS_LWA + (size_t)T * 256 * 2);
constexpr size_t WS_L2T   = al256(WS_LGB + (size_t)T * 256 * 2);
constexpr size_t WS_WPRE  = al256(WS_L2T + (size_t)3 * RW * 256 * 2);
constexpr size_t WS_APRE  = al256(WS_WPRE + (size_t)T * RW * 4);
constexpr size_t WS_GATE  = al256(WS_APRE + (size_t)T * RW * 4);
constexpr size_t WS_WD    = al256(WS_GATE + (size_t)T * RW * 4);
constexpr size_t WS_AA    = al256(WS_WD + (size_t)T * RW * 4);
constexpr size_t WS_BB    = al256(WS_AA + (size_t)T * RW * 4);
constexpr size_t WS_KM    = al256(WS_BB + (size_t)T * RW * 4);
constexpr size_t WS_OG    = al256(WS_KM + (size_t)T * RW * 4);
constexpr size_t WS_YR    = al256(WS_OG + (size_t)T * RW * 4);
constexpr size_t WS_MERGED= al256(WS_YR + (size_t)T * RW * 4);
constexpr size_t WS_Y     = al256(WS_MERGED + (size_t)T * D * 4);
constexpr size_t WS_XMID  = al256(WS_Y + (size_t)T * D * 4);
constexpr size_t WS_H2B   = al256(WS_XMID + (size_t)T * D * 4);
constexpr size_t WS_TOPP  = al256(WS_H2B + (size_t)T * D * 2);
constexpr size_t WS_LIST  = al256(WS_TOPP + (size_t)NA * 4);
constexpr int ACT_ROWS = NA + NE * 256;
constexpr size_t WS_ACT   = al256(WS_LIST + (size_t)NE * T * 4);
constexpr size_t WS_YB    = al256(WS_ACT + (size_t)ACT_ROWS * FF * 2);
constexpr size_t WS_WGU   = al256(WS_YB + (size_t)NA * D * 2);
constexpr size_t WS_WDN   = al256(WS_WGU + (size_t)NE * 2 * FF * D * 2);
constexpr size_t WS_YGB   = al256(WS_WDN + (size_t)NE * D * FF * 2);
constexpr size_t WS_YRWB  = al256(WS_YGB + (size_t)T * RW * 2);
constexpr size_t WS_WUPG  = al256(WS_YRWB + (size_t)T * RW * 2);
constexpr size_t WS_WUPR  = al256(WS_WUPG + (size_t)D * RW * 2);
constexpr size_t WS_WOUT  = al256(WS_WUPR + (size_t)D * RW * 2);
constexpr size_t WS_MRGB  = al256(WS_WOUT + (size_t)D * D * 2);
constexpr size_t WS_GREC  = al256(WS_MRGB + (size_t)T * D * 2);
constexpr size_t WS_END   = al256(WS_GREC + (size_t)2048 * 90368);

struct Args {
    const float* in[36];
    float* out;
    unsigned char* ws;
    int ph_lo, ph_hi;
};

__device__ __forceinline__ float sigmoidf_(float x) { return 1.0f / (1.0f + expf(-x)); }
__device__ __forceinline__ float siluf_(float x) { return x * sigmoidf_(x); }
__device__ __forceinline__ float softplusf_(float x) { return fmaxf(x, 0.0f) + log1pf(expf(-fabsf(x))); }
__device__ __forceinline__ float rl(float x, int k) { return __int_as_float(__builtin_amdgcn_readlane(__float_as_int(x), k)); }
__device__ __forceinline__ float wave_sum(float v) {
#pragma unroll
    for (int o = 32; o > 0; o >>= 1) v += __shfl_xor(v, o);
    return v;
}
__device__ __forceinline__ float half_sum(float v) {
#pragma unroll
    for (int o = 16; o > 0; o >>= 1) v += __shfl_xor(v, o);
    return v;
}
__device__ __forceinline__ float block_sum(float v, float* red) {
    v = wave_sum(v);
    __syncthreads();
    if ((threadIdx.x & 63) == 0) red[threadIdx.x >> 6] = v;
    __syncthreads();
    float t = 0.f;
#pragma unroll
    for (int w = 0; w < NTHREADS / 64; ++w) t += red[w];
    return t;
}

constexpr int GBM = 128, GBN = 64, GBK = 16;
template <bool DUAL, class AL, class EP>
__device__ __forceinline__ void gemm_naive(float* sm, int M, int N, int K, const AL& al, const float* __restrict__ W, int ldw, int dual_off, const EP& ep) {
    float* As = sm;
    float* Bs = sm + GBK * (GBM + 4);
    float* Bs2 = Bs + GBK * (GBN + 4);
    const int tid = threadIdx.x, tx = tid & 15, ty = tid >> 4;
    const int ntm = (M + GBM - 1) / GBM, ntn = (N + GBN - 1) / GBN;
    for (int tile = blockIdx.x; tile < ntm * ntn; tile += gridDim.x) {
        const int tm = tile / ntn, tn = tile % ntn;
        const int m0 = tm * GBM, n0 = tn * GBN;
        float acc[4][4], acc2[4][4];
#pragma unroll
        for (int i = 0; i < 4; ++i)
#pragma unroll
            for (int j = 0; j < 4; ++j) { acc[i][j] = 0.f; acc2[i][j] = 0.f; }
        for (int k0 = 0; k0 < K; k0 += GBK) {
#pragma unroll
            for (int i = 0; i < 4; ++i) { const int idx = tid + i * NTHREADS, r = idx >> 4, kk = idx & 15; As[kk * (GBM + 4) + r] = al(m0 + r, k0 + kk); }
#pragma unroll
            for (int i = 0; i < 2; ++i) { const int idx = tid + i * NTHREADS, kk = idx >> 6, c = idx & 63, n = n0 + c;
                Bs[kk * (GBN + 4) + c] = (n < N) ? W[(size_t)(k0 + kk) * ldw + n] : 0.f;
                if (DUAL) Bs2[kk * (GBN + 4) + c] = (n < N) ? W[(size_t)(k0 + kk) * ldw + n + dual_off] : 0.f; }
            __syncthreads();
#pragma unroll
            for (int kk = 0; kk < GBK; ++kk) {
                float a[4], b[4], b2[4];
#pragma unroll
                for (int i = 0; i < 4; ++i) a[i] = As[kk * (GBM + 4) + ty * 4 + i];
#pragma unroll
                for (int j = 0; j < 4; ++j) { b[j] = Bs[kk * (GBN + 4) + tx * 4 + j]; b2[j] = DUAL ? Bs2[kk * (GBN + 4) + tx * 4 + j] : 0.f; }
#pragma unroll
                for (int i = 0; i < 4; ++i)
#pragma unroll
                    for (int j = 0; j < 4; ++j) { acc[i][j] = fmaf(a[i], b[j], acc[i][j]); if (DUAL) acc2[i][j] = fmaf(a[i], b2[j], acc2[i][j]); }
            }
            __syncthreads();
        }
#pragma unroll
        for (int i = 0; i < 4; ++i)
#pragma unroll
            for (int j = 0; j < 4; ++j) { const int m = m0 + ty * 4 + i, n = n0 + tx * 4 + j; if (m < M && n < N) ep(m, n, acc[i][j], acc2[i][j]); }
    }
}

struct ALPlain { const float* A; int lda; __device__ __forceinline__ float operator()(int m, int k) const { return A[(size_t)m * lda + k]; } };
struct ALMix {
    const float* H; const float* mix;
    __device__ __forceinline__ float operator()(int m, int k) const {
        const float h = H[(size_t)m * D + k];
        const float hp = ((m % SEQ) == 0) ? 0.f : H[(size_t)(m - 1) * D + k];
        return h + (hp - h) * mix[k];
    }
};
struct ALGatherTok { const float* H2; const int* list; int cnt; __device__ __forceinline__ float operator()(int m, int k) const { return (m < cnt) ? H2[(size_t)(list[m] >> 2) * D + k] : 0.f; } };
struct ALGatherAsg { const float* ACT; const int* list; int cnt; __device__ __forceinline__ float operator()(int m, int k) const { return (m < cnt) ? ACT[(size_t)list[m] * FF + k] : 0.f; } };

namespace pg8 {
#define PG8_LAS __attribute__((address_space(3)))
typedef unsigned short bf16_t;
typedef short bf16x8 __attribute__((ext_vector_type(8)));
typedef float f32x4 __attribute__((ext_vector_type(4)));
typedef unsigned u32x4 __attribute__((ext_vector_type(4)));
typedef unsigned u32x2 __attribute__((ext_vector_type(2)));
constexpr int BM = 256, BK = 64, HALF = 128, HTB = HALF * BK * 2, STAGE_BYTES = 8 * HTB, NXCD = 8, WGM = 8;
__host__ __device__ __forceinline__ int lds_byte(int r, int c) { const int st = (r >> 4) * 2 + (c >> 5), rr = r & 15, cc = c & 31, ob = rr * 64 + cc * 2; return st * 1024 + (ob ^ (((ob >> 9) & 1) << 5)); }
__host__ __device__ __forceinline__ void stage_rc(int b, int& R, int& C) { const int st = b / 1024, sb = b % 1024, swz = sb ^ (((sb >> 9) & 1) << 5); R = (st >> 1) * 16 + swz / 64; C = (st & 1) * 32 + (swz % 64) / 2; }
__host__ __device__ __forceinline__ int perm32(int rho) { const int n = rho >> 4, i = rho & 15; return 8 * (i >> 2) + 4 * n + (i & 3); }
struct Unit { int pm, pn; const char* A; const char* B; const int* list; int cnt, e, prow; };
typedef __bf16 bf16x2_t __attribute__((ext_vector_type(2)));
__device__ __forceinline__ unsigned cvt_pk_bf16(float lo, float hi) { bf16x2_t v; v.x = (__bf16)lo; v.y = (__bf16)hi; return __builtin_bit_cast(unsigned, v); }
__device__ __forceinline__ bool static_order(int nM, int nN, int G, int c, int i, int& pm, int& pn) {
    const int nwg = nM * nN; const long L = (long)i * G + c; if (L >= nwg) return false;
    int wgid = (int)L; { const int q = nwg / NXCD, r = nwg % NXCD, xcd = wgid % NXCD, off = wgid / NXCD; wgid = (xcd < r ? xcd * (q + 1) : r * (q + 1) + (xcd - r) * q) + off; }
    const int nig = WGM * nN, gid = wgid / nig, fm = gid * WGM, gsz = (nM - fm) < WGM ? (nM - fm) : WGM;
    pm = fm + ((wgid % nig) % gsz); pn = (wgid % nig) / gsz; return true;
}
template <class Epi, class Sched, bool ALIGN_EPI = true, bool GATHER = false, bool FP8 = false>
__device__ __forceinline__ void gemm_phase(PG8_LAS unsigned char* lds, const int K_, const Sched& S, const Epi& E) {
    const int tid = threadIdx.x, wid = __builtin_amdgcn_readfirstlane(tid >> 6), lane = tid & 63, wr = wid >> 2, wc = wid & 3, fr = lane & 15, fq = lane >> 4;
    const int K = K_, KB = FP8 ? K_ : 2 * K_, nt = KB / 128;
    unsigned voffA0, voffB0;
    { int R, C; stage_rc(tid * 16, R, C); const int Rb = Epi::PERM ? ((R & ~31) + perm32(R & 31)) : R;
      voffA0 = (unsigned)(R * KB + C * 2); voffB0 = (unsigned)(Rb * KB + C * 2); }
    const size_t pstep = (size_t)64 * KB;
    const size_t kstep = (size_t)(BK * 2);
    const size_t hstep = (size_t)HALF * KB;
    const size_t tstep = 2 * hstep; (void)tstep;
    const unsigned ldsw = (unsigned)wid * 1024u;
    const int cole = FP8 ? ((fq >> 1) * 32 + (fq & 1) * 16) : fq * 8;
    const int aoff = lds_byte(wr * 64 + fr, cole), boff = aoff + (wc * 2 - wr * 4) * 2048;
    typedef int _i8 __attribute__((ext_vector_type(8))); typedef _i8 _i8a __attribute__((aligned(16)));
    constexpr bool SP2 = true;
    unsigned vA_c[2][2];
    PG8_LAS unsigned* gtab = (PG8_LAS unsigned*)(lds + STAGE_BYTES + 1024);
#define PG8_FILLTAB(u) do { int _t = threadIdx.x; asm volatile("" : "+v"(_t));   if (_t < 256) { const int _m = (u).pm * 256 + _t; const int _tok = (_m < (u).cnt) ? ((u).list[_m] >> 2) : 0; gtab[_t] = (unsigned)_tok * (unsigned)KB; } } while (0)
#define PG8_SETVA(v, u) do { int _t2 = threadIdx.x; if constexpr (GATHER) asm volatile("" : "+v"(_t2)); _Pragma("unroll") for (int _h = 0; _h < 2; ++_h) _Pragma("unroll") for (int _i = 0; _i < 2; ++_i) { \
        if constexpr (GATHER) { int _R, _C; stage_rc(_t2 * 16 + _i * 8192, _R, _C); (v)[_h][_i] = gtab[_h * 128 + _R] + (unsigned)(_C * 2); } \
        else (v)[_h][_i] = 0u; } } while (0)
#define PG8_STAGE_A(bufoff, gbase, h, nx) do { _Pragma("unroll") for (int _i = 0; _i < 2; ++_i) { \
        const char* _src = GATHER ? (const char*)(gbase) + vA_c[h][_i] : (const char*)(gbase) + (size_t)(h) * hstep + (size_t)_i * pstep + voffA0; \
        __builtin_amdgcn_global_load_lds((const unsigned*)_src, (PG8_LAS unsigned*)(lds + (bufoff) + ldsw + _i * 8192), 16, 0, 0); } } while (0)
#define PG8_SA(b, h) (((b) * 2 + (h)) * HTB)
#define PG8_SB(b, h) ((4 + (b) * 2 + (h)) * HTB)
#define PG8_STAGE(bufoff, gbase, voff) do { _Pragma("unroll") for (int _i = 0; _i < 2; ++_i) \
        __builtin_amdgcn_global_load_lds((const unsigned*)((const char*)(gbase) + (size_t)_i * pstep + voff##0), (PG8_LAS unsigned*)(lds + (bufoff) + ldsw + _i * 8192), 16, 0, 0); } while (0)
#define PG8_LDA(dst, b, h) do { _Pragma("unroll") for (int m = 0; m < 4; ++m) { \
        if constexpr (FP8) { dst##8[m] = *(const PG8_LAS _i8a*)(lds + PG8_SA(b, h) + aoff + m * 2048); } \
        else { _Pragma("unroll") for (int k = 0; k < 2; ++k) dst[m][k] = *(const PG8_LAS bf16x8*)(lds + PG8_SA(b, h) + aoff + m * 2048 + k * 1024); } } } while (0)
#define PG8_LDB(dst, b, h) do { _Pragma("unroll") for (int n = 0; n < 2; ++n) { \
        if constexpr (FP8) { dst##8[n] = *(const PG8_LAS _i8a*)(lds + PG8_SB(b, h) + boff + n * 2048); } \
        else { _Pragma("unroll") for (int k = 0; k < 2; ++k) dst[n][k] = *(const PG8_LAS bf16x8*)(lds + PG8_SB(b, h) + boff + n * 2048 + k * 1024); } } } while (0)
#define PG8_MMA(ai, bj, At, Bt) do { __builtin_amdgcn_s_setprio(1); _Pragma("unroll") for (int m = 0; m < 4; ++m) _Pragma("unroll") for (int n = 0; n < 2; ++n) { \
        if constexpr (FP8) acc[ai][bj][m][n] = __builtin_amdgcn_mfma_scale_f32_16x16x128_f8f6f4(Bt##8[n], At##8[m], acc[ai][bj][m][n], 0, 0, 0, 127, 0, 127); \
        else { _Pragma("unroll") for (int k = 0; k < 2; ++k) acc[ai][bj][m][n] = __builtin_amdgcn_mfma_f32_16x16x32_bf16(Bt[n][k], At[m][k], acc[ai][bj][m][n], 0, 0, 0); } } \
        __builtin_amdgcn_s_setprio(0); } while (0)
#define PG8_WAIT_V(n) asm volatile("s_waitcnt vmcnt(" #n ")" ::: "memory")
#define PG8_WAIT_L(n) asm volatile("s_waitcnt lgkmcnt(" #n ")" ::: "memory")
#define PG8_BAR __builtin_amdgcn_s_barrier()
#define PG8_SCHED __builtin_amdgcn_sched_barrier(0)
    Unit cur, nxt; int ui = 0;
    if (!S.next(0, cur)) return;
    f32x4 acc[2][2][4][2];
#pragma unroll
    for (int a = 0; a < 2; ++a)
#pragma unroll
        for (int b = 0; b < 2; ++b)
#pragma unroll
            for (int m = 0; m < 4; ++m)
#pragma unroll
                for (int n = 0; n < 2; ++n) acc[a][b][m][n] = (f32x4){0.f, 0.f, 0.f, 0.f};
    bf16x8 At[4][2], B0[2][2], B1[2][2]; _i8 At8[4], B08[2], B18[2];
    const char* cA = cur.A; const char* cB = cur.B;
    S.a_ready(cur);
    if constexpr (GATHER) { PG8_FILLTAB(cur); __syncthreads(); }
    PG8_SETVA(vA_c, cur);
    if constexpr (GATHER) __syncthreads();
    if constexpr (SP2) {
        PG8_STAGE(PG8_SB(0, 0), cB, voffB); PG8_STAGE(PG8_SB(0, 1), cB + hstep, voffB); PG8_STAGE_A(PG8_SA(0, 0), cA, 0, false); PG8_STAGE_A(PG8_SA(0, 1), cA, 1, false);
        if (wr == 1) PG8_BAR;
        PG8_WAIT_V(2); PG8_BAR;
        PG8_STAGE(PG8_SB(1, 0), cB + kstep, voffB); PG8_STAGE_A(PG8_SA(1, 0), cA + kstep, 0, false); PG8_STAGE(PG8_SB(1, 1), cB + hstep + kstep, voffB);
        PG8_WAIT_V(6); PG8_BAR;
    }
    for (;;) {
        const bool has_next = S.next(ui + 1, nxt);
        const char* nA = has_next ? nxt.A : cA; const char* nB = has_next ? nxt.B : cB;
        if constexpr (GATHER) { if (has_next) PG8_FILLTAB(nxt); }
        for (int t = 0; t < nt; t += 2) {
            const bool last = (t == nt - 2); const bool lastn = last && has_next; (void)lastn;
            const char* a1 = cA + (size_t)(t + 1) * kstep;
            const char* a2 = last ? nA : cA + (size_t)(t + 2) * kstep; const char* b2 = last ? nB : cB + (size_t)(t + 2) * kstep;
            const char* a3 = a2 + kstep; const char* b3 = b2 + kstep;
            if (last && has_next) S.a_ready(nxt);
            if constexpr (SP2) {
            PG8_LDB(B0, 0, 0); PG8_LDB(B1, 0, 1); PG8_SCHED; PG8_LDA(At, 0, 0); PG8_STAGE_A(PG8_SA(1, 1), a1, 1, false);
            PG8_WAIT_V(8); PG8_WAIT_L(0); PG8_BAR; PG8_MMA(0, 0, At, B0); PG8_MMA(0, 1, At, B1); PG8_BAR; PG8_SCHED;
            if constexpr (GATHER) { if (lastn) PG8_SETVA(vA_c, nxt); }
            PG8_LDA(At, 0, 1); PG8_STAGE(PG8_SB(0, 0), b2, voffB); PG8_STAGE(PG8_SB(0, 1), b2 + hstep, voffB); PG8_STAGE_A(PG8_SA(0, 0), a2, 0, lastn);
            PG8_WAIT_V(8); PG8_WAIT_L(0); PG8_BAR; PG8_MMA(1, 0, At, B0); PG8_MMA(1, 1, At, B1); PG8_BAR; PG8_SCHED;
            PG8_LDB(B0, 1, 0); PG8_LDB(B1, 1, 1); PG8_SCHED; PG8_LDA(At, 1, 0); PG8_STAGE_A(PG8_SA(0, 1), a2, 1, lastn);
            PG8_WAIT_V(8); PG8_WAIT_L(0); PG8_BAR; PG8_MMA(0, 0, At, B0); PG8_MMA(0, 1, At, B1); PG8_BAR; PG8_SCHED;
            PG8_LDA(At, 1, 1); PG8_STAGE(PG8_SB(1, 0), b3, voffB); PG8_STAGE(PG8_SB(1, 1), b3 + hstep, voffB); PG8_STAGE_A(PG8_SA(1, 0), a3, 0, lastn);
            PG8_WAIT_V(8); PG8_WAIT_L(0); PG8_BAR; PG8_MMA(1, 0, At, B0); PG8_MMA(1, 1, At, B1); PG8_BAR; PG8_SCHED;
            }
        }
        if constexpr (ALIGN_EPI) { if (wr == 0) PG8_BAR; }
        asm volatile("" ::: "memory");
        if constexpr (!Epi::AFTER_DRAIN) { E(acc, cur, wr, wc, fr, fq); S.done(cur); }
        if (!has_next) break;
#pragma unroll
        for (int a = 0; a < 2; ++a)
#pragma unroll
            for (int b = 0; b < 2; ++b)
#pragma unroll
                for (int m = 0; m < 4; ++m)
#pragma unroll
                    for (int n = 0; n < 2; ++n) acc[a][b][m][n] = (f32x4){0.f, 0.f, 0.f, 0.f};
        cur = nxt; cA = nA; cB = nB; ++ui;
        if constexpr (ALIGN_EPI) { if (wr == 1) PG8_BAR; }
    }
    PG8_WAIT_V(0);
    if constexpr (!ALIGN_EPI) { if (wr == 0) PG8_BAR; }
    PG8_BAR;
    if constexpr (Epi::AFTER_DRAIN) { E.fused(acc, cur, wr, wc, fr, fq, lds, wid, lane); S.done(cur); }
#undef PG8_SA
#undef PG8_SB
#undef PG8_STAGE
#undef PG8_STAGE_A
#undef PG8_SETVA
#undef PG8_FILLTAB
#undef PG8_LDA
#undef PG8_LDB
#undef PG8_MMA
#undef PG8_WAIT_V
#undef PG8_WAIT_L
#undef PG8_BAR
#undef PG8_SCHED
}
}


typedef float f32x4_t __attribute__((ext_vector_type(4)));
__device__ __forceinline__ f32x4_t ld_bf4(const unsigned short* p) { const pg8::u32x2 v = *(const pg8::u32x2*)p; return (f32x4_t){__uint_as_float(v.x << 16), __uint_as_float(v.x & 0xffff0000u), __uint_as_float(v.y << 16), __uint_as_float(v.y & 0xffff0000u)}; }
__device__ __forceinline__ void ld_bf8(const unsigned short* p, f32x4_t& lo, f32x4_t& hi) { const pg8::u32x4 v = *(const pg8::u32x4*)p;
    lo = (f32x4_t){__uint_as_float(v.x << 16), __uint_as_float(v.x & 0xffff0000u), __uint_as_float(v.y << 16), __uint_as_float(v.y & 0xffff0000u)};
    hi = (f32x4_t){__uint_as_float(v.z << 16), __uint_as_float(v.z & 0xffff0000u), __uint_as_float(v.w << 16), __uint_as_float(v.w & 0xffff0000u)}; }
__device__ __forceinline__ float ld_bf1(const unsigned short* p) { return __uint_as_float((unsigned)(*p) << 16); }
struct SchedInProj {
    int G, c; const char* Abase; const char* Bt;
    __device__ __forceinline__ bool next(int i, pg8::Unit& u) const {
        int pm, pn; if (!pg8::static_order(T / 256, NT_IN, G, c, i, pm, pn)) return false;
        const int ai = pn < 29 ? 0 : pn < 33 ? 1 : pn < 37 ? 3 : pn < 41 ? 4 : pn == 41 ? 2 : pn == 42 ? 5 : 6;
        u.pm = pm; u.pn = pn; u.A = Abase + ((size_t)ai * T + (size_t)pm * 256) * D * 2; u.B = Bt + (size_t)pn * 256 * D * 2; u.list = nullptr; u.cnt = 0; u.e = 0; u.prow = 0; return true;
    }
    __device__ __forceinline__ void a_ready(const pg8::Unit&) const {}
    __device__ __forceinline__ void done(const pg8::Unit&) const {}
};
__device__ __forceinline__ float fast_sigmoid(float x) { return __builtin_amdgcn_rcpf(1.0f + __builtin_amdgcn_exp2f(-1.4426950408889634f * x)); }
__device__ __forceinline__ float fast_tanh(float x) { return 1.0f - 2.0f * __builtin_amdgcn_rcpf(1.0f + __builtin_amdgcn_exp2f(2.8853900817779268f * x)); }
struct EpiInProjF32 {
    static constexpr bool PERM = true, AFTER_DRAIN = false;
    unsigned short* PH; float* BA; unsigned short* LWA; unsigned short* LGB;
    __device__ __forceinline__ void operator()(const pg8::f32x4 (&acc)[2][2][4][2], const pg8::Unit& u, int wr, int wc, int fr, int fq) const {
        const int pn = u.pn; unsigned short* b16 = PH; unsigned ld = N_IN; int ncol = 256, act = 0;
        if (pn < 12) b16 = PH + pn * 256;
        else if (pn < 28) { b16 = PH + COL_GATE + (pn - 12) * 256; act = 2; }
        else if (pn == 28) { act = 4; ncol = 16; }
        else if (pn < 41) b16 = PH + COL_R + (pn - 29) * 256;
        else if (pn == 41) { act = 1; ncol = 128; b16 = LWA; ld = 256; }
        else if (pn == 42) { act = 3; ncol = 128; b16 = LWA + 128; ld = 256; }
        else { act = 2; b16 = LGB; ld = 256; }
        const unsigned row0 = (unsigned)u.pm * 256u + wr * 64 + fr;
#pragma unroll
        for (int ai = 0; ai < 2; ++ai)
#pragma unroll
            for (int m = 0; m < 4; ++m) {
                const unsigned row = row0 + ai * 128 + m * 16;
#pragma unroll
                for (int bj = 0; bj < 2; ++bj) {
                    const int cl = bj * 128 + wc * 32 + 8 * fq;
                    pg8::f32x4 v0 = acc[ai][bj][m][0], v1 = acc[ai][bj][m][1];
                    if (act == 4) { if (cl < ncol) { float* dst = BA + (size_t)row * 16 + cl; *(pg8::f32x4*)dst = v0; *(pg8::f32x4*)(dst + 4) = v1; } }
                    else {
                        if (act == 1) {
#pragma unroll
                            for (int j = 0; j < 4; ++j) { v0[j] = fast_tanh(v0[j]); v1[j] = fast_tanh(v1[j]); } }
                        if (act == 2) {
#pragma unroll
                            for (int j = 0; j < 4; ++j) { v0[j] = fast_sigmoid(v0[j]); v1[j] = fast_sigmoid(v1[j]); } }
                        if ((act == 1 || act == 3) && cl >= 96) { v0 = (pg8::f32x4){0.f, 0.f, 0.f, 0.f}; v1 = v0; }
                        if (cl < ncol) { pg8::u32x4 w; w.x = pg8::cvt_pk_bf16(v0[0], v0[1]); w.y = pg8::cvt_pk_bf16(v0[2], v0[3]); w.z = pg8::cvt_pk_bf16(v1[0], v1[1]); w.w = pg8::cvt_pk_bf16(v1[2], v1[3]);
                            *(pg8::u32x4*)(b16 + (size_t)row * ld + cl) = w; }
                    }
                }
            }
    }
};
struct SchedLora {
    int G, c; const char* LWA; const char* LGB; const char* L2T;
    __device__ __forceinline__ bool next(int i, pg8::Unit& u) const {
        int pm, pn; if (!pg8::static_order(T / 256, 12, G, c, i, pm, pn)) return false;
        const int g = pn >> 2;
        u.pm = pm; u.pn = pn; u.e = g; u.A = (g < 2 ? LWA : LGB) + (size_t)pm * 256 * 256 * 2; u.B = L2T + ((size_t)g * RW + (size_t)(pn & 3) * 256) * 256 * 2; u.list = nullptr; u.cnt = 0; u.prow = 0; return true;
    }
    __device__ __forceinline__ void a_ready(const pg8::Unit&) const {}
    __device__ __forceinline__ void done(const pg8::Unit&) const {}
};
struct EpiLora {
    static constexpr bool PERM = true, AFTER_DRAIN = false;
    float* WPRE; float* APRE; float* GATE; const float* w0; const float* a0;
    __device__ __forceinline__ void operator()(const pg8::f32x4 (&acc)[2][2][4][2], const pg8::Unit& u, int wr, int wc, int fr, int fq) const {
        const int g = u.e; float* C = g == 0 ? WPRE : g == 1 ? APRE : GATE; const float* bias = g == 0 ? w0 : a0;
        const unsigned row0 = (unsigned)u.pm * 256u + wr * 64 + fr; const int col0 = (u.pn & 3) * 256 + wc * 32 + 8 * fq;
        pg8::f32x4 bv[2][2];
#pragma unroll
        for (int bj = 0; bj < 2; ++bj)
#pragma unroll
            for (int n = 0; n < 2; ++n) bv[bj][n] = (g < 2) ? *(const pg8::f32x4*)(bias + col0 + 128 * bj + 4 * n) : (pg8::f32x4){0.f, 0.f, 0.f, 0.f};
#pragma unroll
        for (int ai = 0; ai < 2; ++ai)
#pragma unroll
            for (int m = 0; m < 4; ++m) {
                float* rp = C + (size_t)(row0 + ai * 128 + m * 16) * RW + col0;
#pragma unroll
                for (int bj = 0; bj < 2; ++bj) { *(pg8::f32x4*)(rp + 128 * bj) = acc[ai][bj][m][0] + bv[bj][0]; *(pg8::f32x4*)(rp + 128 * bj + 4) = acc[ai][bj][m][1] + bv[bj][1]; }
            }
    }
};

struct SchedMoE {
    int G, c, nN, nrows; const LAS int* tab; const int* LIST; const char* Abase; const char* W; bool gatherA; int esz;
    __device__ __forceinline__ bool next(int i, pg8::Unit& u) const {
        const int L = i * G + c; const int total = __builtin_amdgcn_readfirstlane(tab[32]) * nN; if (L >= total) return false;
        int e = 0;
        for (int k = 1; k < NE; ++k) if (__builtin_amdgcn_readfirstlane(tab[k]) * nN <= L) e = k;
        const int t0 = __builtin_amdgcn_readfirstlane(tab[e]), t1 = __builtin_amdgcn_readfirstlane(tab[e + 1]);
        const int q = L - t0 * nN, mt = t1 - t0;
        u.pm = q % mt; u.pn = q / mt; u.e = e; u.cnt = __builtin_amdgcn_readfirstlane(tab[128 + e]); u.list = LIST + (size_t)e * T; u.prow = t0 * 256 + u.pm * 256;
        u.A = gatherA ? Abase : Abase + (size_t)u.prow * D * esz;
        u.B = W + ((size_t)e * nrows + (size_t)u.pn * 256) * D * esz; return true;
    }
    __device__ __forceinline__ void a_ready(const pg8::Unit&) const {}
    __device__ __forceinline__ void done(const pg8::Unit&) const {}
};
struct EpiGU {
    static constexpr bool PERM = true, AFTER_DRAIN = false;
    unsigned short* ACT; const float* bgu;
    __device__ __forceinline__ void operator()(const pg8::f32x4 (&acc)[2][2][4][2], const pg8::Unit& u, int wr, int wc, int fr, int fq) const {
        const float* bg = bgu + (size_t)u.e * 2 * FF; const int f0 = 128 * u.pn + 16 * wc + 4 * fq;
        pg8::f32x4 bgv[2], buv[2];
#pragma unroll
        for (int bj = 0; bj < 2; ++bj) { bgv[bj] = *(const pg8::f32x4*)(bg + f0 + 64 * bj); buv[bj] = *(const pg8::f32x4*)(bg + FF + f0 + 64 * bj); }
        const unsigned row0 = (unsigned)u.prow + wr * 64 + fr;
#pragma unroll
        for (int ai = 0; ai < 2; ++ai)
#pragma unroll
            for (int m = 0; m < 4; ++m) {
                const unsigned row = row0 + ai * 128 + m * 16;
#pragma unroll
                for (int bj = 0; bj < 2; ++bj) {
                    const pg8::f32x4 g = acc[ai][bj][m][0] * 0.015625f + bgv[bj], up = acc[ai][bj][m][1] * 0.015625f + buv[bj];
                    float a[4];
#pragma unroll
                    for (int j = 0; j < 4; ++j) { const float gl = fminf(g[j], 7.0f), ul = fminf(fmaxf(up[j], -7.0f), 7.0f); a[j] = gl * fast_sigmoid(1.702f * gl) * (ul + 1.0f); }
                    pg8::u32x2 w; w.x = pg8::cvt_pk_bf16(a[0], a[1]); w.y = pg8::cvt_pk_bf16(a[2], a[3]);
                    *(pg8::u32x2*)(ACT + (size_t)row * FF + f0 + 64 * bj) = w;
                }
            }
    }
};
struct EpiDown {
    static constexpr bool PERM = true, AFTER_DRAIN = false;
    unsigned short* YB; const float* bd;
    __device__ __forceinline__ void operator()(const pg8::f32x4 (&acc)[2][2][4][2], const pg8::Unit& u, int wr, int wc, int fr, int fq) const {
        const float* b = bd + (size_t)u.e * D; const int col0 = u.pn * 256 + wc * 32 + 8 * fq;
        pg8::f32x4 bv[2][2];
#pragma unroll
        for (int bj = 0; bj < 2; ++bj)
#pragma unroll
            for (int n = 0; n < 2; ++n) bv[bj][n] = *(const pg8::f32x4*)(b + col0 + 128 * bj + 4 * n);
        const int ml0 = u.pm * 256 + wr * 64 + fr;
#pragma unroll
        for (int ai = 0; ai < 2; ++ai)
#pragma unroll
            for (int m = 0; m < 4; ++m) {
                const int ml = ml0 + ai * 128 + m * 16;
                if (ml < u.cnt) {
                    const unsigned asg = (unsigned)u.list[ml];
#pragma unroll
                    for (int bj = 0; bj < 2; ++bj) {
                        const pg8::f32x4 v0 = acc[ai][bj][m][0] + bv[bj][0], v1 = acc[ai][bj][m][1] + bv[bj][1];
                        pg8::u32x4 w; w.x = pg8::cvt_pk_bf16(v0[0], v0[1]); w.y = pg8::cvt_pk_bf16(v0[2], v0[3]); w.z = pg8::cvt_pk_bf16(v1[0], v1[1]); w.w = pg8::cvt_pk_bf16(v1[2], v1[3]);
                        *(pg8::u32x4*)(YB + (size_t)asg * D + col0 + 128 * bj) = w;
                    }
                }
            }
    }
};
__device__ __forceinline__ void moe_tables(LAS int* tab, const unsigned* CNT) {
    if (threadIdx.x == 0) {
        int acc = 0;
        for (int e = 0; e < NE; ++e) { const int c = (int)__hip_atomic_load(&CNT[e], __ATOMIC_RELAXED, __HIP_MEMORY_SCOPE_AGENT); tab[e] = acc; tab[64 + e] = acc * 256; tab[128 + e] = c; acc += (c + 255) >> 8; }
        tab[32] = acc; tab[96] = acc * 256;
    }
    __syncthreads();
}
__device__ __forceinline__ float bf2f(unsigned short h) { return __uint_as_float((unsigned)h << 16); }


struct SchedUp {
    int G, c; const char* A0; const char* A1; const char* B0; const char* B1;
    __device__ __forceinline__ bool next(int i, pg8::Unit& u) const {
        int pm, pn; if (!pg8::static_order(T / 256, D / 256, G, c, i >> 1, pm, pn)) return false;
        const int sb = i & 1;
        u.pm = pm; u.pn = pn; u.e = sb; u.A = (sb ? A1 : A0) + (size_t)pm * 256 * RW * 2; u.B = (sb ? B1 : B0) + (size_t)pn * 256 * RW * 2; u.list = nullptr; u.cnt = 0; u.prow = 0; return true;
    }
    __device__ __forceinline__ void a_ready(const pg8::Unit&) const {}
    __device__ __forceinline__ void done(const pg8::Unit&) const {}
};
struct EpiUp {
    static constexpr bool PERM = true, AFTER_DRAIN = false;
    float* M32; unsigned short* MB; const unsigned short* PH;
    __device__ __forceinline__ void operator()(const pg8::f32x4 (&acc)[2][2][4][2], const pg8::Unit& u, int wr, int wc, int fr, int fq) const {
        const int sb = u.e; const unsigned row0 = (unsigned)u.pm * 256u + wr * 64 + fr; const int col0 = u.pn * 256 + wc * 32 + 8 * fq;
#pragma unroll
        for (int ai = 0; ai < 2; ++ai)
#pragma unroll
            for (int m = 0; m < 4; ++m) {
                const unsigned row = row0 + ai * 128 + m * 16;
#pragma unroll
                for (int bj = 0; bj < 2; ++bj) {
                    const int col = col0 + 128 * bj;
                    f32x4_t g0, g1; ld_bf8(PH + (size_t)row * N_IN + COL_GATE + sb * D + col, g0, g1);
                    pg8::f32x4 v0 = acc[ai][bj][m][0], v1 = acc[ai][bj][m][1];
#pragma unroll
                    for (int j = 0; j < 4; ++j) { v0[j] *= g0[j]; v1[j] *= g1[j]; }
                    float* mp = M32 + (size_t)row * D + col;
                    if (sb == 0) { *(pg8::f32x4*)mp = v0; *(pg8::f32x4*)(mp + 4) = v1; }
                    else {
                        v0 += *(const pg8::f32x4*)mp; v1 += *(const pg8::f32x4*)(mp + 4);
                        pg8::u32x4 w; w.x = pg8::cvt_pk_bf16(v0[0], v0[1]); w.y = pg8::cvt_pk_bf16(v0[2], v0[3]); w.z = pg8::cvt_pk_bf16(v1[0], v1[1]); w.w = pg8::cvt_pk_bf16(v1[2], v1[3]);
                        *(pg8::u32x4*)(MB + (size_t)row * D + col) = w;
                    }
                }
            }
    }
};
struct SchedPlain {
    int G, c, nM, nN, K; const char* A; const char* B;
    __device__ __forceinline__ bool next(int i, pg8::Unit& u) const {
        int pm, pn; if (!pg8::static_order(nM, nN, G, c, i, pm, pn)) return false;
        u.pm = pm; u.pn = pn; u.e = 0; u.A = A + (size_t)pm * 256 * K * 2; u.B = B + (size_t)pn * 256 * K * 2; u.list = nullptr; u.cnt = 0; u.prow = 0; return true;
    }
    __device__ __forceinline__ void a_ready(const pg8::Unit&) const {}
    __device__ __forceinline__ void done(const pg8::Unit&) const {}
};
struct EpiF32 {
    static constexpr bool PERM = true, AFTER_DRAIN = false;
    float* C; int ldc;
    __device__ __forceinline__ void operator()(const pg8::f32x4 (&acc)[2][2][4][2], const pg8::Unit& u, int wr, int wc, int fr, int fq) const {
        const unsigned row0 = (unsigned)u.pm * 256u + wr * 64 + fr; const int col0 = u.pn * 256 + wc * 32 + 8 * fq;
#pragma unroll
        for (int ai = 0; ai < 2; ++ai)
#pragma unroll
            for (int m = 0; m < 4; ++m) {
                float* rp = C + (size_t)(row0 + ai * 128 + m * 16) * ldc + col0;
#pragma unroll
                for (int bj = 0; bj < 2; ++bj) { *(pg8::f32x4*)(rp + 128 * bj) = acc[ai][bj][m][0]; *(pg8::f32x4*)(rp + 128 * bj + 4) = acc[ai][bj][m][1]; }
            }
    }
};

#define LDS_WAIT() asm volatile("s_waitcnt lgkmcnt(0)" ::: "memory")
template <class F, class FK>
__device__ __forceinline__ void cvt_item_k(const float* __restrict__ W, int ldw, int K, const F& srccol, const FK& srcrow, unsigned short* WT, int row0, int kb, LAS float* scr, int lane) {
    const int n = lane & 31, k0 = kb * 64; const int sc = srccol(row0 + n);
#pragma unroll 8
    for (int i = 0; i < 32; ++i) { const int kk = 2 * i + (lane >> 5); const int sr = srcrow(k0 + kk); scr[kk * 33 + n] = (sc >= 0 && sr >= 0) ? W[(size_t)sr * ldw + sc] : 0.f; }
    LDS_WAIT();
    const int c = lane & 7;
#pragma unroll
    for (int j = 0; j < 4; ++j) { const int n2 = (lane >> 3) + 8 * j; const LAS float* sp = scr + (8 * c) * 33 + n2;
        pg8::u32x4 o; o.x = pg8::cvt_pk_bf16(sp[0 * 33], sp[1 * 33]); o.y = pg8::cvt_pk_bf16(sp[2 * 33], sp[3 * 33]); o.z = pg8::cvt_pk_bf16(sp[4 * 33], sp[5 * 33]); o.w = pg8::cvt_pk_bf16(sp[6 * 33], sp[7 * 33]);
        *(pg8::u32x4*)(WT + (size_t)(row0 + n2) * K + k0 + 8 * c) = o; }
    LDS_WAIT();
}
template <class F>
__device__ __forceinline__ void cvt_item(const float* __restrict__ W, int ldw, int K, const F& srccol, unsigned short* WT, int row0, int kb, LAS float* scr, int lane) {
    auto idk = [](int k) { return k; };
    cvt_item_k(W, ldw, K, srccol, idk, WT, row0, kb, scr, lane);
}
template <class FM, class FK>
__device__ __forceinline__ void cvt64(const float* __restrict__ W, int ldw, int K, const FM& map4, const FK& srcrow, unsigned short* __restrict__ WT, int row0, int kb, int lane) {
    const int n4 = lane & 15, kg = lane >> 4, k0 = kb * 64 + 16 * kg;
    int sc, dr; map4(row0, n4, sc, dr);
    f32x4_t v[16];
#pragma unroll
    for (int kk = 0; kk < 16; ++kk) { const int sr = srcrow(k0 + kk); v[kk] = (sc >= 0 && sr >= 0) ? *(const f32x4_t*)(W + (size_t)sr * ldw + sc) : (f32x4_t){0.f, 0.f, 0.f, 0.f}; }
#pragma unroll
    for (int j = 0; j < 4; ++j) {
        pg8::u32x4 o0, o1;
        o0.x = pg8::cvt_pk_bf16(v[0][j], v[1][j]); o0.y = pg8::cvt_pk_bf16(v[2][j], v[3][j]); o0.z = pg8::cvt_pk_bf16(v[4][j], v[5][j]); o0.w = pg8::cvt_pk_bf16(v[6][j], v[7][j]);
        o1.x = pg8::cvt_pk_bf16(v[8][j], v[9][j]); o1.y = pg8::cvt_pk_bf16(v[10][j], v[11][j]); o1.z = pg8::cvt_pk_bf16(v[12][j], v[13][j]); o1.w = pg8::cvt_pk_bf16(v[14][j], v[15][j]);
        unsigned short* dst = WT + (size_t)(dr + j) * K + k0;
        *(pg8::u32x4*)dst = o0; *(pg8::u32x4*)(dst + 8) = o1;
    }
}
template <class FM, class FK>
__device__ __forceinline__ void cvt64_f8(const float* __restrict__ W, int ldw, int K, const FM& map4, const FK& srcrow, unsigned char* __restrict__ WT, int row0, int kb, int lane, float scale) {
    const int n4 = lane & 15, kg = lane >> 4, k0 = kb * 64 + 16 * kg;
    int sc, dr; map4(row0, n4, sc, dr);
    f32x4_t v[16];
#pragma unroll
    for (int kk = 0; kk < 16; ++kk) { const int sr = srcrow(k0 + kk); v[kk] = (sc >= 0 && sr >= 0) ? *(const f32x4_t*)(W + (size_t)sr * ldw + sc) * scale : (f32x4_t){0.f, 0.f, 0.f, 0.f}; }
#pragma unroll
    for (int j = 0; j < 4; ++j) {
        pg8::u32x4 o;
#pragma unroll
        for (int q = 0; q < 4; ++q) { int w = __builtin_amdgcn_cvt_pk_fp8_f32(v[4 * q][j], v[4 * q + 1][j], 0, false); w = __builtin_amdgcn_cvt_pk_fp8_f32(v[4 * q + 2][j], v[4 * q + 3][j], w, true); o[q] = (unsigned)w; }
        *(pg8::u32x4*)(WT + (size_t)(dr + j) * K + k0) = o;
    }
}
__device__ __forceinline__ void inproj_src(int r, int& mat, int& col) {
    mat = 0; col = -1;
    if (r < 3072) col = r;
    else if (r < 7168) col = COL_GATE + (r - 3072);
    else if (r < 7424) { if (r - 7168 < 16) col = COL_B + (r - 7168); }
    else if (r < 10496) col = COL_R + (r - 7424);
    else if (r < 10752) { mat = 1; if (r - 10496 < 96) col = r - 10496; }
    else if (r < 11008) { mat = 2; if (r - 10752 < 96) col = r - 10752; }
    else { mat = 3; col = r - 11008; }
}

typedef short bf16x8_t __attribute__((ext_vector_type(8)));
typedef unsigned short LAS* lds_u16p;
__device__ __forceinline__ f32x4_t mma16(bf16x8_t a, bf16x8_t b, f32x4_t c) { return __builtin_amdgcn_mfma_f32_16x16x32_bf16(a, b, c, 0, 0, 0); }
__device__ __forceinline__ bf16x8_t ldfrag(const LAS unsigned short* M, int ld, int r0, int k0, int lane) { return *(const LAS bf16x8_t*)(M + (r0 + (lane & 15)) * ld + k0 + 8 * (lane >> 4)); }
__device__ __forceinline__ unsigned short f2bf(float x) { return (unsigned short)(pg8::cvt_pk_bf16(x, x) & 0xffffu); }
constexpr int GR_QG = 0, GR_W = 16384, GR_KDT = 32768, GR_AI = 49152, GR_U = 57344, GR_MISC = 90112, GR_BYTES = 90368;
constexpr int GL_KB = 0, GL_QB = 17408, GL_VT = 34816, GL_KST = 53248, GL_KDT = 71680, GL_LM = 90112, GL_TI = 107520, GL_AI = 116736, GL_SM = 125952;

__device__ __forceinline__ void tri_inverse_64(const LAS float* Lm, LAS unsigned short* Ti, int lane) {
    float xcol[64];
#pragma unroll
    for (int i = 0; i < 64; ++i) {
        float s0 = 0.f, s1 = 0.f, s2 = 0.f, s3 = 0.f;
#pragma unroll
        for (int j4 = 0; j4 < (i + 3) / 4; ++j4) {
            const f32x4_t l4 = *(const LAS f32x4_t*)(Lm + i * 68 + 4 * j4);
            if (4 * j4 + 0 < i) s0 = fmaf(l4[0], xcol[4 * j4 + 0], s0);
            if (4 * j4 + 1 < i) s1 = fmaf(l4[1], xcol[4 * j4 + 1], s1);
            if (4 * j4 + 2 < i) s2 = fmaf(l4[2], xcol[4 * j4 + 2], s2);
            if (4 * j4 + 3 < i) s3 = fmaf(l4[3], xcol[4 * j4 + 3], s3);
        }
        const float s = (s0 + s1) + (s2 + s3);
        xcol[i] = ((lane == i) ? 1.0f : 0.0f) - s;
        Ti[i * 72 + lane] = f2bf(xcol[i]);
    }
}

__device__ __forceinline__ void gdn_prep_item(int item, LAS unsigned char* lds, const unsigned short* __restrict__ PH, const float* __restrict__ BA, const float* __restrict__ convw, const float* __restrict__ A_log, const float* __restrict__ dt_bias, unsigned char* __restrict__ recs) {
    int tid_ = threadIdx.x; asm volatile("" : "+v"(tid_));
    const int tid = tid_, lane = tid & 63, wave = __builtin_amdgcn_readfirstlane(tid >> 6);
    const int ch = item & 63, hv = (item >> 6) & 7, b = item >> 9, qh = hv >> 1;
    const int s0 = ch * 64; const size_t t0 = (size_t)b * SEQ + s0;
    unsigned char* rec = recs + (size_t)item * GR_BYTES;
    LAS unsigned short* Kb = (LAS unsigned short*)(lds + GL_KB); LAS unsigned short* Qb = (LAS unsigned short*)(lds + GL_QB);
    LAS unsigned short* VT = (LAS unsigned short*)(lds + GL_VT); LAS unsigned short* KsT = (LAS unsigned short*)(lds + GL_KST); LAS unsigned short* KdT = (LAS unsigned short*)(lds + GL_KDT);
    LAS float* Lm = (LAS float*)(lds + GL_LM); LAS unsigned short* Ti = (LAS unsigned short*)(lds + GL_TI); LAS unsigned short* Ai = (LAS unsigned short*)(lds + GL_AI);
    LAS float* gcs = (LAS float*)(lds + GL_SM); LAS float* betas = gcs + 64;
    if (wave == 0) {
        const float araw = BA[(t0 + lane) * 16 + 8 + hv], braw = BA[(t0 + lane) * 16 + hv];
        float g = -expf(A_log[hv]) * softplusf_(araw + dt_bias[hv]);
#pragma unroll
        for (int o = 1; o < 64; o <<= 1) { const float t = __shfl_up(g, o); if (lane >= o) g += t; }
        gcs[lane] = g; betas[lane] = sigmoidf_(braw);
    }
    __syncthreads();
    {
        const int row = tid >> 3, cs = tid & 7, c0 = cs * 16;
        const float gcr = gcs[row], br = betas[row], glast = gcs[63];
        const float eg = expf(gcr), ekd = expf(glast - gcr);
#pragma unroll
        for (int mtx = 0; mtx < 3; ++mtx) {
            const int colbase = (mtx == 0) ? qh * 128 : (mtx == 1) ? COL_K + qh * 128 : COL_V + hv * 128;
            float acc[16];
#pragma unroll
            for (int i = 0; i < 16; ++i) acc[i] = 0.f;
#pragma unroll
            for (int j = 0; j < 4; ++j) {
                if (s0 + row - 3 + j >= 0) {
                    const unsigned short* src = PH + (t0 + row - 3 + j) * N_IN + colbase + c0; const float* cw = convw + j * 2048 + colbase + c0;
                    f32x4_t xq[4]; ld_bf8(src, xq[0], xq[1]); ld_bf8(src + 8, xq[2], xq[3]);
#pragma unroll
                    for (int i4 = 0; i4 < 4; ++i4) { const float4 wv = *(const float4*)(cw + 4 * i4);
                        acc[4 * i4] = fmaf(wv.x, xq[i4][0], acc[4 * i4]); acc[4 * i4 + 1] = fmaf(wv.y, xq[i4][1], acc[4 * i4 + 1]); acc[4 * i4 + 2] = fmaf(wv.z, xq[i4][2], acc[4 * i4 + 2]); acc[4 * i4 + 3] = fmaf(wv.w, xq[i4][3], acc[4 * i4 + 3]); }
                }
            }
            float ss = 0.f;
#pragma unroll
            for (int i = 0; i < 16; ++i) { acc[i] = siluf_(acc[i]); ss = fmaf(acc[i], acc[i], ss); }
            ss += __shfl_xor(ss, 1); ss += __shfl_xor(ss, 2); ss += __shfl_xor(ss, 4);
            const float rn = rsqrtf(ss + 1e-6f);
#pragma unroll
            for (int i = 0; i < 16; ++i) {
                if (mtx == 0) Qb[row * 136 + c0 + i] = f2bf(acc[i] * rn * 0.08838834764831845f);
                else if (mtx == 1) { const float kn = acc[i] * rn; Kb[row * 136 + c0 + i] = f2bf(kn); KsT[(c0 + i) * 72 + row] = f2bf(br * eg * kn); KdT[(c0 + i) * 72 + row] = f2bf(kn * ekd); }
                else VT[(c0 + i) * 72 + row] = f2bf(br * acc[i]);
            }
            asm volatile("" ::: "memory");
        }
    }
    __syncthreads();
    {
        const int mat = wave >> 2, ti = wave & 3, g4 = lane >> 4, n = lane & 15;
        const LAS unsigned short* Am = mat ? Qb : Kb;
#pragma unroll
        for (int tj = 0; tj < 4; ++tj) {
            f32x4_t acc = {0.f, 0.f, 0.f, 0.f};
#pragma unroll
            for (int ks = 0; ks < 4; ++ks) acc = mma16(ldfrag(Am, 136, 16 * ti, 32 * ks, lane), ldfrag(Kb, 136, 16 * tj, 32 * ks, lane), acc);
            const int j = 16 * tj + n; const float gj = gcs[j];
#pragma unroll
            for (int r = 0; r < 4; ++r) {
                const int i = 16 * ti + 4 * g4 + r; const float dec = expf(fminf(gcs[i] - gj, 0.f));
                if (mat == 0) Lm[i * 68 + j] = (j < i) ? betas[i] * acc[r] * dec : 0.f;
                else Ai[i * 72 + j] = f2bf((j <= i) ? acc[r] * dec : 0.f);
            }
        }
    }
    __syncthreads();
    if (wave == 0) tri_inverse_64(Lm, Ti, lane);
    else {
        for (int e = tid - 64; e < 64 * 128; e += NTHREADS - 64) { const int row = e >> 7, c = e & 127; const float qv = bf2f(Qb[row * 136 + c]); Qb[row * 136 + c] = f2bf(qv * expf(gcs[row])); }
    }
    __syncthreads();
    {
        const int g4 = lane >> 4, n = lane & 15;
#pragma unroll
        for (int t2 = 0; t2 < 2; ++t2) {
            const int tn = 2 * wave + t2; const LAS unsigned short* Bt = (tn < 8) ? VT : KsT; const int tb = tn & 7;
#pragma unroll
            for (int ti = 0; ti < 4; ++ti) {
                f32x4_t acc = {0.f, 0.f, 0.f, 0.f};
#pragma unroll
                for (int ks = 0; ks < 2; ++ks) acc = mma16(ldfrag(Ti, 72, 16 * ti, 32 * ks, lane), ldfrag(Bt, 72, 16 * tb, 32 * ks, lane), acc);
                if (tn < 8) *(f32x4_t*)(rec + GR_U + ((size_t)((ti * 8 + tb) * 64 + lane)) * 16) = acc;
                else {
#pragma unroll
                    for (int r = 0; r < 4; ++r) Kb[(16 * ti + 4 * g4 + r) * 136 + 16 * tb + n] = f2bf(acc[r]);
                }
            }
        }
    }
    __syncthreads();
    {
#pragma unroll
        for (int t2 = 0; t2 < 2; ++t2) {
            const int f = 2 * wave + t2;
            { const int ti = f >> 2, ks = f & 3;
              *(bf16x8_t*)(rec + GR_QG + (size_t)(f * 64 + lane) * 16) = ldfrag(Qb, 136, 16 * ti, 32 * ks, lane);
              *(bf16x8_t*)(rec + GR_W + (size_t)(f * 64 + lane) * 16) = ldfrag(Kb, 136, 16 * ti, 32 * ks, lane); }
            { const int td = f >> 1, ks = f & 1;
              *(bf16x8_t*)(rec + GR_KDT + (size_t)(f * 64 + lane) * 16) = ldfrag(KdT, 72, 16 * td, 32 * ks, lane); }
        }
        { const int f = wave, ti = f >> 1, ks = f & 1;
          *(bf16x8_t*)(rec + GR_AI + (size_t)(f * 64 + lane) * 16) = ldfrag(Ai, 72, 16 * ti, 32 * ks, lane); }
        if (tid == 0) *(float*)(rec + GR_MISC) = expf(gcs[63]);
    }
    __syncthreads();
}

__device__ __forceinline__ void gdn_scan_seq(int seq, LAS unsigned char* lds, const unsigned char* __restrict__ recs, float* __restrict__ OG) {
    const int tid = threadIdx.x, lane = tid & 63, wave = __builtin_amdgcn_readfirstlane(tid >> 6), g4 = lane >> 4, n = lane & 15;
    const int b = seq >> 3, hv = seq & 7;
    LAS unsigned short* St = (LAS unsigned short*)lds;
    LAS unsigned short* VnT = (LAS unsigned short*)(lds + 34816);
    for (int e = tid; e < 128 * 136; e += NTHREADS) St[e] = 0;
    f32x4_t S[8];
#pragma unroll
    for (int tv = 0; tv < 8; ++tv) S[tv] = (f32x4_t){0.f, 0.f, 0.f, 0.f};
    __syncthreads();
    const int ti = wave & 3;
    bf16x8_t nafr[4], nkfr[2], naifr[2]; f32x4_t nu[8]; float neg;
#define GS_LOAD(chv) do { const unsigned char* _r = recs + ((size_t)seq * 64 + (chv)) * GR_BYTES; \
        _Pragma("unroll") for (int ks = 0; ks < 4; ++ks) nafr[ks] = *(const bf16x8_t*)(_r + (wave < 4 ? GR_QG : GR_W) + (size_t)((ti * 4 + ks) * 64 + lane) * 16); \
        _Pragma("unroll") for (int ks = 0; ks < 2; ++ks) { nkfr[ks] = *(const bf16x8_t*)(_r + GR_KDT + (size_t)((wave * 2 + ks) * 64 + lane) * 16); naifr[ks] = *(const bf16x8_t*)(_r + GR_AI + (size_t)((ti * 2 + ks) * 64 + lane) * 16); } \
        if (wave >= 4) { _Pragma("unroll") for (int tv = 0; tv < 8; ++tv) nu[tv] = *(const f32x4_t*)(_r + GR_U + (size_t)((ti * 8 + tv) * 64 + lane) * 16); } \
        neg = *(const float*)(_r + GR_MISC); } while (0)
    GS_LOAD(0);
    for (int ch = 0; ch < 64; ++ch) {
        bf16x8_t afr[4], kfr[2], aifr[2]; f32x4_t ucur[8];
#pragma unroll
        for (int ks = 0; ks < 4; ++ks) afr[ks] = nafr[ks];
#pragma unroll
        for (int ks = 0; ks < 2; ++ks) { kfr[ks] = nkfr[ks]; aifr[ks] = naifr[ks]; }
#pragma unroll
        for (int tv = 0; tv < 8; ++tv) ucur[tv] = nu[tv];
        const float eg = neg;
        if (ch + 1 < 64) GS_LOAD(ch + 1);
        f32x4_t acc1[8];
#pragma unroll
        for (int tv = 0; tv < 8; ++tv) {
            f32x4_t a = {0.f, 0.f, 0.f, 0.f};
#pragma unroll
            for (int ks = 0; ks < 4; ++ks) a = mma16(afr[ks], ldfrag(St, 136, 16 * tv, 32 * ks, lane), a);
            acc1[tv] = a;
        }
        if (wave >= 4) {
#pragma unroll
            for (int tv = 0; tv < 8; ++tv) {
                const f32x4_t vn = ucur[tv] - acc1[tv];
                pg8::u32x2 w2; w2.x = pg8::cvt_pk_bf16(vn[0], vn[1]); w2.y = pg8::cvt_pk_bf16(vn[2], vn[3]);
                *(LAS pg8::u32x2*)(VnT + (16 * tv + n) * 72 + 16 * ti + 4 * g4) = w2;
            }
        }
        __syncthreads();
        if (wave < 4) {
#pragma unroll
            for (int tv = 0; tv < 8; ++tv) {
                f32x4_t o = acc1[tv];
#pragma unroll
                for (int ks = 0; ks < 2; ++ks) o = mma16(aifr[ks], ldfrag(VnT, 72, 16 * tv, 32 * ks, lane), o);
#pragma unroll
                for (int r = 0; r < 4; ++r) OG[((size_t)b * SEQ + ch * 64 + 16 * ti + 4 * g4 + r) * RW + hv * 128 + 16 * tv + n] = o[r];
            }
        }
#pragma unroll
        for (int tv = 0; tv < 8; ++tv) {
            f32x4_t s = S[tv] * eg;
#pragma unroll
            for (int ks = 0; ks < 2; ++ks) s = mma16(kfr[ks], ldfrag(VnT, 72, 16 * tv, 32 * ks, lane), s);
            S[tv] = s;
            pg8::u32x2 w2; w2.x = pg8::cvt_pk_bf16(s[0], s[1]); w2.y = pg8::cvt_pk_bf16(s[2], s[3]);
            *(LAS pg8::u32x2*)(St + (16 * tv + n) * 136 + 16 * wave + 4 * g4) = w2;
        }
        __syncthreads();
    }
#undef GS_LOAD
}

constexpr int RT = 32;
constexpr int RBUF_FLOATS = 5 * RT * 64 + RT * 32 + RT * 2;
typedef float f32x2_t __attribute__((ext_vector_type(2)));
__device__ __forceinline__ float dpp_f(float x, const int ctrl_sel) {
    const int xi = __float_as_int(x); int r;
    if (ctrl_sel == 0) r = __builtin_amdgcn_update_dpp(0, xi, 0xB1, 0xF, 0xF, true);
    else if (ctrl_sel == 1) r = __builtin_amdgcn_update_dpp(0, xi, 0x4E, 0xF, 0xF, true);
    else if (ctrl_sel == 2) r = __builtin_amdgcn_update_dpp(0, xi, 0x141, 0xF, 0xF, true);
    else r = __builtin_amdgcn_update_dpp(0, xi, 0x140, 0xF, 0xF, true);
    return __int_as_float(r);
}
__device__ __forceinline__ float sum8(float x) { x += dpp_f(x, 0); x += dpp_f(x, 1); x += dpp_f(x, 2); return x; }
__device__ __forceinline__ float fast_softplus(float x) { return fmaxf(x, 0.0f) + 0.6931471805599453f * __builtin_amdgcn_logf(1.0f + __builtin_amdgcn_exp2f(-1.4426950408889634f * fabsf(x))); }
__device__ __forceinline__ void rwkv_scan_block(int sq, int half, LAS float* lds, const float* __restrict__ WPRE, const float* __restrict__ APRE, const unsigned short* __restrict__ PH,
                                                const float* __restrict__ k_k, const float* __restrict__ k_a, const float* __restrict__ r_k, float* __restrict__ BON, float* __restrict__ YR) {
    const int tid = threadIdx.x, lane = tid & 63, wave = __builtin_amdgcn_readfirstlane(tid >> 6);
    const int b = sq >> 4, h = sq & 15, rbase = half * 32;
    const size_t t0 = (size_t)b * SEQ;
    const int lt = tid - 256;
    f32x4_t s0w[2], s0a[2], s0k[2], s0r[2], s0v, s1w[2], s1a[2], s1k[2], s1r[2], s1v;
    f32x4_t kkc = {0.f, 0.f, 0.f, 0.f}, kac = kkc, rkc = kkc;
    if (lt >= 0) { const int colc = h * 64 + (lt & 15) * 4; kkc = *(const f32x4_t*)(k_k + colc); kac = *(const f32x4_t*)(k_a + colc); rkc = *(const f32x4_t*)(r_k + colc); }
    f32x2_t S2[4];
#pragma unroll
    for (int k = 0; k < 4; ++k) S2[k] = (f32x2_t){0.f, 0.f};
#define RW_LOAD(c, P) do { _Pragma("unroll") for (int i = 0; i < 2; ++i) { const int f = lt + 256 * i, st = f >> 4, c4 = f & 15; const size_t t = t0 + (size_t)(c) * RT + st; const int col = h * 64 + c4 * 4; \
        P##w[i] = *(const f32x4_t*)(WPRE + t * RW + col); P##a[i] = *(const f32x4_t*)(APRE + t * RW + col); P##k[i] = ld_bf4(PH + t * N_IN + COL_RK + col); P##r[i] = ld_bf4(PH + t * N_IN + COL_R + col); } \
        { const int st = lt >> 3, c4 = lt & 7; P##v = ld_bf4(PH + (t0 + (size_t)(c) * RT + st) * N_IN + COL_RV + h * 64 + rbase + c4 * 4); } } while (0)
#define RW_STORE(bufp, P, c) do { LAS float* _b = (bufp); _Pragma("unroll") for (int i = 0; i < 2; ++i) { const int f = lt + 256 * i, st = f >> 4, c4 = f & 15; \
        f32x4_t wd, av, kkv; float ss = 0.f; \
        _Pragma("unroll") for (int j = 0; j < 4; ++j) { const float wlog = -fast_softplus(-P##w[i][j]) - 0.5f; wd[j] = __builtin_amdgcn_exp2f(-1.4426950408889634f * __builtin_amdgcn_exp2f(1.4426950408889634f * wlog)); av[j] = fast_sigmoid(P##a[i][j]); kkv[j] = P##k[i][j] * kkc[j]; ss = fmaf(kkv[j], kkv[j], ss); } \
        ss += __shfl_xor(ss, 1); ss += __shfl_xor(ss, 2); ss += __shfl_xor(ss, 4); ss += __shfl_xor(ss, 8); \
        const float rn = rsqrtf(ss + 1e-6f); f32x4_t aav, bbv, kmv; float br = 0.f, kr = 0.f, bo = 0.f; \
        _Pragma("unroll") for (int j = 0; j < 4; ++j) { const float kk = kkv[j] * rn; aav[j] = -kk; bbv[j] = kk * av[j]; kmv[j] = P##k[i][j] * (1.0f + (av[j] - 1.0f) * kac[j]); \
            br = fmaf(bbv[j], P##r[i][j], br); kr = fmaf(kmv[j], P##r[i][j], kr); bo = fmaf(P##r[i][j] * kmv[j], rkc[j], bo); } \
        *(LAS f32x4_t*)(_b + 0 * RT * 64 + st * 64 + c4 * 4) = wd; *(LAS f32x4_t*)(_b + 1 * RT * 64 + st * 64 + c4 * 4) = bbv; *(LAS f32x4_t*)(_b + 2 * RT * 64 + st * 64 + c4 * 4) = kmv; \
        const f32x4_t _x = wd * P##r[i]; \
        *(LAS f32x4_t*)(_b + 3 * RT * 64 + st * 128 + c4 * 8) = (f32x4_t){aav[0], _x[0], aav[1], _x[1]}; *(LAS f32x4_t*)(_b + 3 * RT * 64 + st * 128 + c4 * 8 + 4) = (f32x4_t){aav[2], _x[2], aav[3], _x[3]}; \
        br += __shfl_xor(br, 1); br += __shfl_xor(br, 2); br += __shfl_xor(br, 4); br += __shfl_xor(br, 8); kr += __shfl_xor(kr, 1); kr += __shfl_xor(kr, 2); kr += __shfl_xor(kr, 4); kr += __shfl_xor(kr, 8); \
        bo += __shfl_xor(bo, 1); bo += __shfl_xor(bo, 2); bo += __shfl_xor(bo, 4); bo += __shfl_xor(bo, 8); \
        if (c4 == 0) { _b[5 * RT * 64 + RT * 32 + st * 2] = br; _b[5 * RT * 64 + RT * 32 + st * 2 + 1] = kr; if (half == 0) BON[(t0 + (size_t)(c) * RT + st) * 16 + h] = bo; } } \
        { const int st = lt >> 3, c4 = lt & 7; *(LAS f32x4_t*)(_b + 5 * RT * 64 + st * 32 + c4 * 4) = P##v; } } while (0)
    constexpr int NCH = SEQ / RT;
    const int rloc = wave * 8 + (lane >> 4) * 2, kq = (lane & 15) * 4;
    LAS float* ybuf = lds + 2 * RBUF_FLOATS;
    f32x2_t T2[4];
#pragma unroll
    for (int k = 0; k < 4; ++k) T2[k] = (f32x2_t){0.f, 0.f};
    f32x4_t Aw, Ab, Ak, Ax0, Ax1, Bw, Bb, Bk, Bx0, Bx1; f32x2_t Av, Bv, Ar, Br;
#define RW_LD(X, buf, st) do { const LAS float* _p = (buf) + (st) * 64 + kq; \
        X##w = *(const LAS f32x4_t*)(_p); X##b = *(const LAS f32x4_t*)(_p + RT * 64); X##k = *(const LAS f32x4_t*)(_p + 2 * RT * 64); \
        const LAS float* _q = (buf) + 3 * RT * 64 + (st) * 128 + kq * 2; X##x0 = *(const LAS f32x4_t*)(_q); X##x1 = *(const LAS f32x4_t*)(_q + 4); \
        X##v = *(const LAS f32x2_t*)((buf) + 5 * RT * 64 + (st) * 32 + rloc); X##r = *(const LAS f32x2_t*)((buf) + 5 * RT * 64 + RT * 32 + (st) * 2); } while (0)
#define RW_SUM16(x) do { x += dpp_f(x, 0); x += dpp_f(x, 1); x += dpp_f(x, 2); x += dpp_f(x, 3); } while (0)
#define RW_STEP(X, yb, st) do { \
        f32x2_t e0 = S2[0][0] * (f32x2_t){X##x0[0], X##x0[1]}, e1 = T2[0][0] * (f32x2_t){X##x0[0], X##x0[1]}; \
        e0 += S2[0][1] * (f32x2_t){X##x0[2], X##x0[3]}; e1 += T2[0][1] * (f32x2_t){X##x0[2], X##x0[3]}; \
        e0 += S2[1][0] * (f32x2_t){X##x1[0], X##x1[1]}; e1 += T2[1][0] * (f32x2_t){X##x1[0], X##x1[1]}; \
        e0 += S2[1][1] * (f32x2_t){X##x1[2], X##x1[3]}; e1 += T2[1][1] * (f32x2_t){X##x1[2], X##x1[3]}; \
        float sa0 = e0[0], pp0 = e0[1], sa1 = e1[0], pp1 = e1[1]; RW_SUM16(sa0); RW_SUM16(sa1); RW_SUM16(pp0); RW_SUM16(pp1); \
        const f32x2_t w01 = (f32x2_t){X##w[0], X##w[1]}, w23 = (f32x2_t){X##w[2], X##w[3]}, b01 = (f32x2_t){X##b[0], X##b[1]}, b23 = (f32x2_t){X##b[2], X##b[3]}, k01 = (f32x2_t){X##k[0], X##k[1]}, k23 = (f32x2_t){X##k[2], X##k[3]}; \
        S2[0] = S2[0] * w01 + (sa0 * b01 + X##v[0] * k01); S2[1] = S2[1] * w23 + (sa0 * b23 + X##v[0] * k23); \
        T2[0] = T2[0] * w01 + (sa1 * b01 + X##v[1] * k01); T2[1] = T2[1] * w23 + (sa1 * b23 + X##v[1] * k23); \
        *(LAS f32x2_t*)((yb) + (st) * 32 + rloc) = (f32x2_t){pp0 + sa0 * X##r[0] + X##v[0] * X##r[1], pp1 + sa1 * X##r[0] + X##v[1] * X##r[1]}; } while (0)
#define RW_COMPUTE(c) do { const LAS float* buf = lds + ((c) & 1) * RBUF_FLOATS; LAS float* yb = ybuf + ((c) & 1) * RT * 32; \
        RW_LD(A, buf, 0); \
        for (int st = 0; st < RT; st += 2) { RW_LD(B, buf, st + 1); RW_STEP(A, yb, st); if (st + 2 < RT) RW_LD(A, buf, st + 2); RW_STEP(B, yb, st + 1); } } while (0)
#define RW_FLUSH(c) do { const int st = lt >> 3, c4 = lt & 7; *(f32x4_t*)(YR + (t0 + (size_t)(c) * RT + st) * RW + h * 64 + rbase + c4 * 4) = *(const LAS f32x4_t*)(ybuf + ((c) & 1) * RT * 32 + st * 32 + c4 * 4); } while (0)
    if (wave >= 4) {
        RW_LOAD(0, s0); RW_STORE(lds, s0, 0); RW_LOAD(1, s0); RW_LOAD(2, s1);
        __syncthreads();
        for (int c = 0; c < NCH; c += 2) {
            RW_STORE(lds + RBUF_FLOATS, s0, c + 1); if (c + 3 < NCH) RW_LOAD(c + 3, s0); if (c > 0) RW_FLUSH(c - 1);
            __syncthreads();
            if (c + 2 < NCH) { RW_STORE(lds, s1, c + 2); } if (c + 4 < NCH) RW_LOAD(c + 4, s1); RW_FLUSH(c);
            __syncthreads();
        }
        RW_FLUSH(NCH - 1);
    } else {
        __syncthreads();
        for (int c = 0; c < NCH; c += 2) {
            RW_COMPUTE(c);
            __syncthreads();
            RW_COMPUTE(c + 1);
            __syncthreads();
        }
    }
#undef RW_COMPUTE
#undef RW_FLUSH
#undef RW_LD
#undef RW_STEP
#undef RW_SUM16
#undef RW_LOAD
#undef RW_STORE
}

__global__ void __launch_bounds__(NTHREADS, 2) fwd(Args a) {
    extern __shared__ __attribute__((aligned(16))) unsigned char lds_raw[];
    float* sm = (float*)lds_raw;
#define PHASE_IDS int tid = threadIdx.x; asm volatile("" : "+v"(tid)); const int lane = tid & 63, wave = tid >> 6; (void)lane; (void)wave;
    unsigned char* ws = a.ws;
    unsigned* ctl = (unsigned*)(ws + WS_CTL);
    volatile LAS unsigned* xbw = (volatile LAS unsigned*)(LAS unsigned char*)(lds_raw + LDS_BYTES - 16);
    if (threadIdx.x == 0) { xbw[0] = 0u; xbw[1] = 0u; xbw[2] = 0u; xbw[3] = 0u; }
    __syncthreads();
    const int lo = a.ph_lo, hi = a.ph_hi;
    XcdBarrier bar; bar.bar = ctl; bar.x = 0; bar.st = xbw;
    if (hi - lo > 1) bar = xcd_barrier_post(ctl, xbw);
#define IN(k) (lo <= (k) && (k) < hi)
#define SEAM(k) do { if (IN(k) && IN((k) + 1)) xcd_barrier(bar); } while (0)


    if (IN(0)) {
        PHASE_IDS
        const float* c = a.in[1];
        const float* ada_w = a.in[2];
        const float* ada_b = a.in[3];
        const float* w_in = a.in[8];
        const float* rwkv_w1 = a.in[15];
        const float* rwkv_a1 = a.in[18];
        const float* rwkv_g1 = a.in[20];
        const float* w_up_gdn = a.in[27];
        const float* w_up_rwkv = a.in[28];
        const float* w_out = a.in[29];
        const float* exp_w_gu = a.in[32];
        const float* exp_w_down = a.in[34];
        float* MOD = (float*)(ws + WS_MOD);
        unsigned short* WINT = (unsigned short*)(ws + WS_WINT);
        unsigned short* WUPG = (unsigned short*)(ws + WS_WUPG);
        unsigned short* WUPR = (unsigned short*)(ws + WS_WUPR);
        unsigned short* WOUT = (unsigned short*)(ws + WS_WOUT);
        unsigned short* WGU = (unsigned short*)(ws + WS_WGU);
        unsigned short* WDN = (unsigned short*)(ws + WS_WDN);
        float* sc = sm;
        float* part = sm + NB * D;
        for (int i = tid; i < NB * D; i += NTHREADS) sc[i] = siluf_(c[i]);
        __syncthreads();
        for (int cb = blockIdx.x; cb < 6 * D / 48; cb += gridDim.x) {
            const int cc = tid % 48, kg = tid / 48, col = cb * 48 + cc;
            if (tid < 480) {
                float acc0 = 0.f, acc1 = 0.f, acc2 = 0.f, acc3 = 0.f;
#pragma unroll 8
                for (int k = kg; k < D; k += 10) {
                    const float w = ada_w[(size_t)k * (6 * D) + col];
                    acc0 = fmaf(sc[k], w, acc0); acc1 = fmaf(sc[D + k], w, acc1); acc2 = fmaf(sc[2 * D + k], w, acc2); acc3 = fmaf(sc[3 * D + k], w, acc3);
                }
                part[(kg * 4 + 0) * 48 + cc] = acc0; part[(kg * 4 + 1) * 48 + cc] = acc1; part[(kg * 4 + 2) * 48 + cc] = acc2; part[(kg * 4 + 3) * 48 + cc] = acc3;
            }
            __syncthreads();
            if (tid < 192) {
                const int bb = tid / 48, c2 = tid % 48; float t = ada_b[cb * 48 + c2];
#pragma unroll
                for (int g = 0; g < 10; ++g) t += part[(g * 4 + bb) * 48 + c2];
                MOD[(size_t)bb * 6 * D + cb * 48 + c2] = t;
            }
            __syncthreads();
        }
        {
            const int gw = blockIdx.x * (NTHREADS / 64) + wave, ngw = gridDim.x * (NTHREADS / 64);
            auto idk = [](int k) { return k; };
            constexpr int N_IP = (NT_IN * 256 / 64) * (D / 64);
            constexpr int N_GU = NE * (2 * FF / 64) * (D / 64), N_DN = NE * (D / 64) * (FF / 64);
            constexpr int N_L2 = 3 * (RW / 64) * (256 / 64), N_UP = (D / 64) * (RW / 64), N_OUT = (D / 64) * (D / 64);
            constexpr int N_ALL = N_IP + N_GU + N_DN + N_L2 + 2 * N_UP + N_OUT;
            constexpr int N_P5 = (N_GU + N_DN) * 100 / 100;
            for (int it0 = gw + N_P5; it0 < N_ALL; it0 += ngw) {
                int it = it0;
                if (it < N_GU) {
                    const int e = it / ((2 * FF / 64) * (D / 64)), r = it % ((2 * FF / 64) * (D / 64)), rb = r / (D / 64), kb = r % (D / 64);
                    auto m4 = [](int row0, int n4, int& scol, int& drow) { const int pn = row0 >> 8, cb8 = (row0 & 255) >> 3, ft = 128 * pn + (cb8 + (n4 & 7)) * 4; scol = (n4 < 8) ? ft : FF + ft; drow = row0 + (n4 & 7) * 8 + ((n4 < 8) ? 0 : 4); };
                    cvt64(exp_w_gu + (size_t)e * D * 2 * FF, 2 * FF, D, m4, idk, WGU + (size_t)e * 2 * FF * D, rb * 64, kb, lane); continue; }
                it -= N_GU;
                auto mid = [](int row0, int n4, int& scol, int& drow) { scol = row0 + 4 * n4; drow = scol; };
                if (it < N_DN) {
                    const int e = it / ((D / 64) * (FF / 64)), r = it % ((D / 64) * (FF / 64)), rb = r / (FF / 64), kb = r % (FF / 64);
                    cvt64(exp_w_down + (size_t)e * FF * D, D, FF, mid, idk, WDN + (size_t)e * D * FF, rb * 64, kb, lane); continue; }
                it -= N_DN;
                if (it < N_IP) {
                    const int rb = it / (D / 64), kb = it % (D / 64), row0 = rb * 64;
                    int mat, col0; inproj_src(row0, mat, col0);
                    const float* W = mat == 0 ? w_in : mat == 1 ? rwkv_w1 : mat == 2 ? rwkv_a1 : rwkv_g1;
                    const int ldw = mat == 0 ? N_IN : mat == 3 ? 256 : 96;
                    auto m4 = [](int r0, int n4, int& scol, int& drow) { int m2; drow = r0 + 4 * n4; inproj_src(drow, m2, scol); };
                    cvt64(W, ldw, D, m4, idk, WINT, row0, kb, lane); continue; }
                it -= N_IP;
                if (it < N_L2) {
                    const float* rwkv_w2 = a.in[16]; const float* rwkv_a2 = a.in[19]; const float* rwkv_g2 = a.in[21]; unsigned short* L2T = (unsigned short*)(ws + WS_L2T);
                    constexpr int NL = (RW / 64) * 4; const int g = it / NL, r = it % NL, rb = r / 4, kb = r % 4;
                    if (g == 0) { auto fk = [](int k) { return k < 96 ? k : -1; }; cvt64(rwkv_w2, RW, 256, mid, fk, L2T, rb * 64, kb, lane); }
                    else if (g == 1) { auto fk = [](int k) { return (k >= 128 && k < 224) ? k - 128 : -1; }; cvt64(rwkv_a2, RW, 256, mid, fk, L2T + (size_t)RW * 256, rb * 64, kb, lane); }
                    else cvt64(rwkv_g2, RW, 256, mid, idk, L2T + (size_t)2 * RW * 256, rb * 64, kb, lane);
                    continue; }
                it -= N_L2;
                if (it < N_UP) { cvt64(w_up_gdn, D, RW, mid, idk, WUPG, (it / (RW / 64)) * 64, it % (RW / 64), lane); continue; }
                it -= N_UP;
                if (it < N_UP) { cvt64(w_up_rwkv, D, RW, mid, idk, WUPR, (it / (RW / 64)) * 64, it % (RW / 64), lane); continue; }
                it -= N_UP;
                cvt64(w_out, D, D, mid, idk, WOUT, (it / (D / 64)) * 64, it % (D / 64), lane);
            }
        }
    }
    SEAM(0);

    if (IN(1)) {
        PHASE_IDS
        const float* x = a.in[0]; const float* norm_mix_pre = a.in[4]; const float* rwkv_mix = a.in[13];
        float* MOD = (float*)(ws + WS_MOD); unsigned short* AM = (unsigned short*)(ws + WS_H);
        LAS float* invs = (LAS float*)(LAS unsigned char*)lds_raw;
        for (int chunk = blockIdx.x; chunk < T / 64; chunk += gridDim.x) {
            const int r0 = chunk * 64, b = r0 / SEQ; const float* mod = MOD + (size_t)b * 6 * D;
            __syncthreads();
            for (int rr = wave; rr < 65; rr += NTHREADS / 64) {
                const int row = r0 - 1 + rr; float ss = 0.f;
                if (rr > 0 || (r0 % SEQ) != 0) {
#pragma unroll
                    for (int j = 0; j < 8; ++j) { const float4 t4 = *(const float4*)(x + (size_t)row * D + j * 256 + lane * 4); ss += t4.x * t4.x + t4.y * t4.y + t4.z * t4.z + t4.w * t4.w; }
                    ss = wave_sum(ss);
                }
                if (lane == 0) invs[rr] = rsqrtf(ss / D + EPS);
            }
            __syncthreads();
            const int d0 = tid * 4;
            const float4 nw = *(const float4*)(norm_mix_pre + d0), sc4 = *(const float4*)(mod + D + d0), sh4 = *(const float4*)(mod + d0);
            const float g0 = nw.x * (1.0f + sc4.x), g1 = nw.y * (1.0f + sc4.y), g2 = nw.z * (1.0f + sc4.z), g3 = nw.w * (1.0f + sc4.w);
            float4 mx[6];
#pragma unroll
            for (int mi = 0; mi < 6; ++mi) mx[mi] = *(const float4*)(rwkv_mix + mi * D + d0);
            float p0 = 0.f, p1 = 0.f, p2 = 0.f, p3 = 0.f;
            if ((r0 % SEQ) != 0) { const float4 xp = *(const float4*)(x + (size_t)(r0 - 1) * D + d0); const float ip = invs[0];
                p0 = xp.x * ip * g0 + sh4.x; p1 = xp.y * ip * g1 + sh4.y; p2 = xp.z * ip * g2 + sh4.z; p3 = xp.w * ip * g3 + sh4.w; }
#pragma unroll 4
            for (int rr = 0; rr < 64; ++rr) {
                const size_t o = (size_t)(r0 + rr) * D + d0;
                const float4 xc = *(const float4*)(x + o); const float inv = invs[rr + 1];
                const float h0 = xc.x * inv * g0 + sh4.x, h1 = xc.y * inv * g1 + sh4.y, h2 = xc.z * inv * g2 + sh4.z, h3 = xc.w * inv * g3 + sh4.w;
                pg8::u32x2 w; w.x = pg8::cvt_pk_bf16(h0, h1); w.y = pg8::cvt_pk_bf16(h2, h3);
                *(pg8::u32x2*)(AM + o) = w;
#pragma unroll
                for (int mi = 0; mi < 6; ++mi) {
                    pg8::u32x2 w2; w2.x = pg8::cvt_pk_bf16(h0 + (p0 - h0) * mx[mi].x, h1 + (p1 - h1) * mx[mi].y); w2.y = pg8::cvt_pk_bf16(h2 + (p2 - h2) * mx[mi].z, h3 + (p3 - h3) * mx[mi].w);
                    *(pg8::u32x2*)(AM + (size_t)(mi + 1) * T * D + o) = w2;
                }
                p0 = h0; p1 = h1; p2 = h2; p3 = h3;
            }
        }
    }
    SEAM(1);

    if (IN(2)) {
        PHASE_IDS
        unsigned short* AM = (unsigned short*)(ws + WS_H);
        unsigned short* WINT = (unsigned short*)(ws + WS_WINT);
        unsigned short* PH = (unsigned short*)(ws + WS_PH);
        SchedInProj S{(int)gridDim.x, (int)blockIdx.x, (const char*)AM, (const char*)WINT};
        EpiInProjF32 E{PH, (float*)(ws + WS_BA), (unsigned short*)(ws + WS_LWA), (unsigned short*)(ws + WS_LGB)};
        pg8::gemm_phase<EpiInProjF32, SchedInProj, true, false>((LAS unsigned char*)lds_raw, D, S, E);
    }
    SEAM(2);

    if (IN(3)) {
        PHASE_IDS
        const float* gdn_conv = a.in[9];
        const float* gdn_A_log = a.in[10];
        const float* gdn_dt_bias = a.in[11];
        const float* rwkv_w0 = a.in[14];
        const float* rwkv_w2 = a.in[16];
        const float* rwkv_a0 = a.in[17];
        const float* rwkv_a2 = a.in[19];
        const float* rwkv_g2 = a.in[21];
        unsigned short* PH = (unsigned short*)(ws + WS_PH);
        float* WPRE = (float*)(ws + WS_WPRE);
        float* APRE = (float*)(ws + WS_APRE);
        float* GATE = (float*)(ws + WS_GATE);
        unsigned char* GREC = ws + WS_GREC;
        {
            SchedLora S{(int)gridDim.x, (int)blockIdx.x, (const char*)(ws + WS_LWA), (const char*)(ws + WS_LGB), (const char*)(ws + WS_L2T)};
            EpiLora E{WPRE, APRE, GATE, rwkv_w0, rwkv_a0};
            int klora = 256; asm volatile("" : "+s"(klora));
            pg8::gemm_phase<EpiLora, SchedLora, true, false>((LAS unsigned char*)lds_raw, klora, S, E);
        }
        __syncthreads();
        for (int item = blockIdx.x; item < 2048; item += gridDim.x) gdn_prep_item(item, (LAS unsigned char*)lds_raw, PH, (const float*)(ws + WS_BA), gdn_conv, gdn_A_log, gdn_dt_bias, GREC);
    }
    SEAM(3);


    if (IN(5)) {
        PHASE_IDS
        unsigned short* PH = (unsigned short*)(ws + WS_PH);
        unsigned char* GREC = ws + WS_GREC;
        float* WD = (float*)(ws + WS_WD);
        float* AA = (float*)(ws + WS_AA);
        float* BB = (float*)(ws + WS_BB);
        float* KM = (float*)(ws + WS_KM);
        float* OG = (float*)(ws + WS_OG);
        float* YR = (float*)(ws + WS_YR);
        if (blockIdx.x < 32) gdn_scan_seq((int)blockIdx.x, (LAS unsigned char*)lds_raw, GREC, OG);
        else if (blockIdx.x < 160) rwkv_scan_block(((int)blockIdx.x - 32) >> 1, ((int)blockIdx.x - 32) & 1, (LAS float*)(LAS unsigned char*)lds_raw, (const float*)(ws + WS_WPRE), (const float*)(ws + WS_APRE), PH, a.in[22], a.in[23], a.in[24], (float*)(ws + WS_WD), YR);
        {
            const float* exp_w_gu = a.in[32]; const float* exp_w_down = a.in[34];
            unsigned char* WGU = ws + WS_WGU; unsigned char* WDN = ws + WS_WDN;
            constexpr int N_GU = NE * (2 * FF / 64) * (D / 64), N_DN = NE * (D / 64) * (FF / 64);
            auto idk = [](int k) { return k; };
            constexpr int N_P5 = N_GU + N_DN;
            for (;;) {
                int base = 0; if (lane == 0) base = (int)atomicAdd(ctl + CW_CNT + 96, 4u);
                base = __builtin_amdgcn_readfirstlane(base);
                if (base >= N_P5) break;
              for (int it0 = base; it0 < base + 4 && it0 < N_P5; ++it0) {
                int it = it0;
                if (it < N_GU) {
                    const int e = it / ((2 * FF / 64) * (D / 64)), r = it % ((2 * FF / 64) * (D / 64)), rb = r / (D / 64), kb = r % (D / 64);
                    auto m4 = [](int row0, int n4, int& scol, int& drow) { const int pn = row0 >> 8, cb8 = (row0 & 255) >> 3, ft = 128 * pn + (cb8 + (n4 & 7)) * 4; scol = (n4 < 8) ? ft : FF + ft; drow = row0 + (n4 & 7) * 8 + ((n4 < 8) ? 0 : 4); };
                    cvt64_f8(exp_w_gu + (size_t)e * D * 2 * FF, 2 * FF, D, m4, idk, WGU + (size_t)e * 2 * FF * D, rb * 64, kb, lane, 64.0f);
                } else {
                    it -= N_GU;
                    auto mid = [](int row0, int n4, int& scol, int& drow) { scol = row0 + 4 * n4; drow = scol; };
                    const int e = it / ((D / 64) * (FF / 64)), r = it % ((D / 64) * (FF / 64)), rb = r / (FF / 64), kb = r % (FF / 64);
                    cvt64(exp_w_down + (size_t)e * FF * D, D, FF, mid, idk, (unsigned short*)WDN + (size_t)e * D * FF, rb * 64, kb, lane);
                }
              }
            }
        }
    }
    SEAM(5);

    if (IN(6)) {
        PHASE_IDS
        const float* gdn_norm = a.in[12];
        const float* rwkv_r_k = a.in[24];
        const float* rwkv_ln_w = a.in[25];
        const float* rwkv_ln_b = a.in[26];
        unsigned short* PH = (unsigned short*)(ws + WS_PH);
        float* GATE = (float*)(ws + WS_GATE);
        float* KM = (float*)(ws + WS_KM);
        float* OG = (float*)(ws + WS_OG);
        float* YR = (float*)(ws + WS_YR);
        unsigned short* YGB = (unsigned short*)(ws + WS_YGB);
        unsigned short* YRWB = (unsigned short*)(ws + WS_YRWB);
        for (int row = blockIdx.x; row < T; row += gridDim.x) {
            {
                const int c0 = tid * 2;
                const float o0 = OG[(size_t)row * RW + c0], o1 = OG[(size_t)row * RW + c0 + 1];
                const float ss = wave_sum(o0 * o0 + o1 * o1);
                const float inv = rsqrtf(ss / 128.0f + EPS);
                const float z0 = ld_bf1(PH + (size_t)row * N_IN + COL_Z + c0), z1 = ld_bf1(PH + (size_t)row * N_IN + COL_Z + c0 + 1);
                *(unsigned*)(YGB + (size_t)row * RW + c0) = pg8::cvt_pk_bf16(o0 * inv * gdn_norm[c0 & 127] * siluf_(z0), o1 * inv * gdn_norm[(c0 + 1) & 127] * siluf_(z1));
            }
#pragma unroll
            for (int i = 0; i < 2; ++i) {
                const int ch = tid + i * NTHREADS;
                const float y = YR[(size_t)row * RW + ch];
                const float mu = wave_sum(y) * (1.0f / 64.0f);
                const float dlt = y - mu;
                const float var = wave_sum(dlt * dlt) * (1.0f / 64.0f);
                float yn = dlt * rsqrtf(var + 64e-5f) * rwkv_ln_w[ch] + rwkv_ln_b[ch];
                const float vv = ld_bf1(PH + (size_t)row * N_IN + COL_RV + ch);
                const float bsum = ((const float*)(ws + WS_WD))[(size_t)row * 16 + (ch >> 6)];
                yn += bsum * vv;
                { const float yv = yn * GATE[(size_t)row * RW + ch]; const unsigned pk = pg8::cvt_pk_bf16(yv, yv); YRWB[(size_t)row * RW + ch] = (unsigned short)(pk & 0xffffu); }
            }
        }
    }
    SEAM(6);

    if (IN(7)) {
        PHASE_IDS
        unsigned short* PH = (unsigned short*)(ws + WS_PH);
        unsigned short* YGB = (unsigned short*)(ws + WS_YGB);
        unsigned short* YRWB = (unsigned short*)(ws + WS_YRWB);
        unsigned short* WUPG = (unsigned short*)(ws + WS_WUPG);
        unsigned short* WUPR = (unsigned short*)(ws + WS_WUPR);
        unsigned short* MRGB = (unsigned short*)(ws + WS_MRGB);
        float* MERGED = (float*)(ws + WS_MERGED);
        SchedUp S{(int)gridDim.x, (int)blockIdx.x, (const char*)YGB, (const char*)YRWB, (const char*)WUPG, (const char*)WUPR};
        EpiUp E{MERGED, MRGB, PH};
        pg8::gemm_phase<EpiUp, SchedUp, true, false>((LAS unsigned char*)lds_raw, RW, S, E);
    }
    SEAM(7);

    if (IN(8)) {
        PHASE_IDS
        unsigned short* WOUT = (unsigned short*)(ws + WS_WOUT);
        unsigned short* MRGB = (unsigned short*)(ws + WS_MRGB);
        float* Y = (float*)(ws + WS_Y);
        SchedPlain S{(int)gridDim.x, (int)blockIdx.x, T / 256, D / 256, D, (const char*)MRGB, (const char*)WOUT};
        EpiF32 E{Y, D};
        pg8::gemm_phase<EpiF32, SchedPlain, true, false>((LAS unsigned char*)lds_raw, D, S, E);
    }
    SEAM(8);

    if (IN(9)) {
        PHASE_IDS
        const float* x = a.in[0];
        const float* norm_mix_post = a.in[5];
        const float* norm_ffn_pre = a.in[6];
        const float* router_w = a.in[30];
        const float* router_b = a.in[31];
        float* MOD = (float*)(ws + WS_MOD);
        float* Y = (float*)(ws + WS_Y);
        float* XMID = (float*)(ws + WS_XMID);
        unsigned short* H2B = (unsigned short*)(ws + WS_H2B);
        float* TOPP = (float*)(ws + WS_TOPP);
        int* LIST = (int*)(ws + WS_LIST);
        unsigned* CNT = ctl + CW_CNT;
        LAS float* h2s = (LAS float*)(LAS unsigned char*)lds_raw;
        for (int tile = blockIdx.x; tile < T / 16; tile += gridDim.x) {
            for (int rr = 0; rr < 2; ++rr) {
                const int rl = wave * 2 + rr, row = tile * 16 + rl;
                const int b = row / SEQ; const float* mod = MOD + (size_t)b * 6 * D;
                float xm[32]; float ss = 0.f;
#pragma unroll
                for (int j = 0; j < 8; ++j) { const float4 yv = *(const float4*)(Y + (size_t)row * D + j * 256 + lane * 4); xm[4 * j] = yv.x; xm[4 * j + 1] = yv.y; xm[4 * j + 2] = yv.z; xm[4 * j + 3] = yv.w;
                    ss += yv.x * yv.x + yv.y * yv.y + yv.z * yv.z + yv.w * yv.w; }
                ss = wave_sum(ss);
                const float inv = rsqrtf(ss / D + EPS);
                float ss2 = 0.f;
#pragma unroll
                for (int j = 0; j < 8; ++j) {
                    const int d0 = j * 256 + lane * 4;
                    const float4 xv = *(const float4*)(x + (size_t)row * D + d0), nw = *(const float4*)(norm_mix_post + d0), gt = *(const float4*)(mod + 2 * D + d0);
                    xm[4 * j] = xv.x + gt.x * (xm[4 * j] * inv * nw.x); xm[4 * j + 1] = xv.y + gt.y * (xm[4 * j + 1] * inv * nw.y);
                    xm[4 * j + 2] = xv.z + gt.z * (xm[4 * j + 2] * inv * nw.z); xm[4 * j + 3] = xv.w + gt.w * (xm[4 * j + 3] * inv * nw.w);
                    *(float4*)(XMID + (size_t)row * D + d0) = make_float4(xm[4 * j], xm[4 * j + 1], xm[4 * j + 2], xm[4 * j + 3]);
                    ss2 += xm[4 * j] * xm[4 * j] + xm[4 * j + 1] * xm[4 * j + 1] + xm[4 * j + 2] * xm[4 * j + 2] + xm[4 * j + 3] * xm[4 * j + 3];
                    asm volatile("" ::: "memory");
                }
                ss2 = wave_sum(ss2);
                const float inv2 = rsqrtf(ss2 / D + EPS);
#pragma unroll
                for (int j = 0; j < 8; ++j) {
                    const int d0 = j * 256 + lane * 4;
                    const float4 nw = *(const float4*)(norm_ffn_pre + d0), sc = *(const float4*)(mod + 4 * D + d0), sh = *(const float4*)(mod + 3 * D + d0);
                    f32x4_t hv; hv[0] = xm[4 * j] * inv2 * nw.x * (1.0f + sc.x) + sh.x; hv[1] = xm[4 * j + 1] * inv2 * nw.y * (1.0f + sc.y) + sh.y;
                    hv[2] = xm[4 * j + 2] * inv2 * nw.z * (1.0f + sc.z) + sh.z; hv[3] = xm[4 * j + 3] * inv2 * nw.w * (1.0f + sc.w) + sh.w;
                    { int w8 = __builtin_amdgcn_cvt_pk_fp8_f32(hv[0], hv[1], 0, false); w8 = __builtin_amdgcn_cvt_pk_fp8_f32(hv[2], hv[3], w8, true); *(int*)((unsigned char*)H2B + (size_t)row * D + d0) = w8; }
                    *(LAS f32x4_t*)(h2s + rl * D + d0) = hv;
                    asm volatile("" ::: "memory");
                }
            }
            __syncthreads();
            {
                const int r = tid >> 5, e = tid & 31, row = tile * 16 + r;
                const LAS float* hp = h2s + r * D; float acc = 0.f;
#pragma unroll 4
                for (int d = 0; d < D; d += 4) { const f32x4_t h4 = *(const LAS f32x4_t*)(hp + d);
                    acc = fmaf(h4[0], router_w[(size_t)d * NE + e], acc); acc = fmaf(h4[1], router_w[(size_t)(d + 1) * NE + e], acc);
                    acc = fmaf(h4[2], router_w[(size_t)(d + 2) * NE + e], acc); acc = fmaf(h4[3], router_w[(size_t)(d + 3) * NE + e], acc); }
                float lgt = acc + router_b[e];
                float val[TOPK]; int idx[TOPK];
#pragma unroll
                for (int k = 0; k < TOPK; ++k) {
                    float bv = lgt; int bi = e;
#pragma unroll
                    for (int o = 1; o < 32; o <<= 1) { const float ov = __shfl_xor(bv, o); const int oi = __shfl_xor(bi, o); if (ov > bv || (ov == bv && oi < bi)) { bv = ov; bi = oi; } }
                    val[k] = bv; idx[k] = bi; if (e == bi) lgt = -3.0e38f;
                }
                float pe[TOPK], psum = 0.f;
#pragma unroll
                for (int k = 0; k < TOPK; ++k) { pe[k] = expf(val[k] - val[0]); psum += pe[k]; }
                if (e < TOPK) {
                    const float pk = e == 0 ? pe[0] : e == 1 ? pe[1] : e == 2 ? pe[2] : pe[3]; const int ik = e == 0 ? idx[0] : e == 1 ? idx[1] : e == 2 ? idx[2] : idx[3];
                    const int asg = row * TOPK + e;
                    TOPP[asg] = pk / psum;
                    const unsigned pos = atomicAdd(&CNT[ik], 1u);
                    LIST[(size_t)ik * T + pos] = asg;
                }
            }
            __syncthreads();
        }
    }
    SEAM(9);

    const int vcu = (gridDim.x % 8 == 0) ? (int)((blockIdx.x % 8) * (gridDim.x / 8) + blockIdx.x / 8) : (int)blockIdx.x;
    if (IN(10)) {
        PHASE_IDS
        const float* exp_b_gu = a.in[33];
        unsigned short* H2B = (unsigned short*)(ws + WS_H2B);
        int* LIST = (int*)(ws + WS_LIST);
        unsigned short* ACT = (unsigned short*)(ws + WS_ACT);
        unsigned short* WGU = (unsigned short*)(ws + WS_WGU);
        LAS int* mtab = (LAS int*)(LAS unsigned char*)(lds_raw + 131072);
        unsigned* CNT = ctl + CW_CNT;
        moe_tables(mtab, CNT);
        SchedMoE S{(int)gridDim.x, vcu, 2 * FF / 256, 2 * FF, mtab, LIST, (const char*)H2B, (const char*)WGU, true, 1};
        EpiGU E{ACT, exp_b_gu};
        pg8::gemm_phase<EpiGU, SchedMoE, true, true, true>((LAS unsigned char*)lds_raw, D, S, E);
    }
    SEAM(10);

    if (IN(11)) {
        PHASE_IDS
        const float* exp_b_down = a.in[35];
        int* LIST = (int*)(ws + WS_LIST);
        unsigned short* ACT = (unsigned short*)(ws + WS_ACT);
        unsigned short* YB = (unsigned short*)(ws + WS_YB);
        unsigned short* WDN = (unsigned short*)(ws + WS_WDN);
        LAS int* mtab = (LAS int*)(LAS unsigned char*)(lds_raw + 131072);
        unsigned* CNT = ctl + CW_CNT;
        moe_tables(mtab, CNT);
        SchedMoE S{(int)gridDim.x, vcu, D / 256, D, mtab, LIST, (const char*)ACT, (const char*)WDN, false, 2};
        EpiDown E{YB, exp_b_down};
        pg8::gemm_phase<EpiDown, SchedMoE, true, false, false>((LAS unsigned char*)lds_raw, FF, S, E);
    }
    SEAM(11);

    if (IN(12)) {
        PHASE_IDS
        const float* norm_ffn_post = a.in[7];
        float* MOD = (float*)(ws + WS_MOD);
        float* XMID = (float*)(ws + WS_XMID);
        float* TOPP = (float*)(ws + WS_TOPP);
        unsigned short* YB = (unsigned short*)(ws + WS_YB);
        for (int row = blockIdx.x; row < T; row += gridDim.x) {
            const int b = row / SEQ; const float* mod = MOD + (size_t)b * 6 * D; const int d0 = tid * 4;
            float ym[4] = {0.f, 0.f, 0.f, 0.f};
#pragma unroll
            for (int k = 0; k < TOPK; ++k) {
                const int asg = row * TOPK + k; const float p = TOPP[asg];
                const pg8::u32x2 v = *(const pg8::u32x2*)(YB + (size_t)asg * D + d0);
                ym[0] = fmaf(p, __uint_as_float(v.x << 16), ym[0]); ym[1] = fmaf(p, __uint_as_float(v.x & 0xffff0000u), ym[1]); ym[2] = fmaf(p, __uint_as_float(v.y << 16), ym[2]); ym[3] = fmaf(p, __uint_as_float(v.y & 0xffff0000u), ym[3]);
            }
            const float ss = block_sum(ym[0] * ym[0] + ym[1] * ym[1] + ym[2] * ym[2] + ym[3] * ym[3], sm);
            const float inv = rsqrtf(ss / D + EPS);
            const float4 xm = *(const float4*)(XMID + (size_t)row * D + d0);
            const float xa[4] = {xm.x, xm.y, xm.z, xm.w}; float o[4];
#pragma unroll
            for (int i = 0; i < 4; ++i) { const int d = d0 + i; o[i] = xa[i] + mod[5 * D + d] * (ym[i] * inv * norm_ffn_post[d]); }
            *(float4*)(a.out + (size_t)row * D + d0) = make_float4(o[0], o[1], o[2], o[3]);
        }
    }
#undef IN
#undef SEAM
}

constexpr int NPHASES = 13;
#ifndef MK_ONE_LAUNCH
#define MK_ONE_LAUNCH 1
#endif

extern "C" void kernel_launch(void* const* d_in, const int* in_sizes, int n_in, void* d_out, int out_size, void* d_ws, size_t ws_size, hipStream_t stream) {
    static int grid = 0;
    if (grid == 0) {
        if (n_in != 36 || out_size != T * D || ws_size < WS_END) { fprintf(stderr, "kernel_launch: unexpected shapes n_in %d out %d ws %zu (need %zu)\n", n_in, out_size, ws_size, (size_t)WS_END); grid = -1; return; }
        int dev = 0, cus = 0, per_cu = 0;
        if (hipGetDevice(&dev) != hipSuccess || hipDeviceGetAttribute(&cus, hipDeviceAttributeMultiprocessorCount, dev) != hipSuccess) { grid = -1; return; }
        if (hipFuncSetAttribute((const void*)fwd, hipFuncAttributeMaxDynamicSharedMemorySize, LDS_BYTES) != hipSuccess) { fprintf(stderr, "kernel_launch: hipFuncSetAttribute failed\n"); grid = -1; return; }
        if (hipOccupancyMaxActiveBlocksPerMultiprocessor(&per_cu, (const void*)fwd, NTHREADS, LDS_BYTES) != hipSuccess || per_cu < 1) { fprintf(stderr, "kernel_launch: occupancy query says %d\n", per_cu); }
        (void)hipGetLastError();
        grid = cus;
    }
    if (grid < 0) return;
    (void)hipMemsetAsync((char*)d_ws + WS_CTL, 0, CTL_BYTES, stream);
    Args a{};
    for (int i = 0; i < 36; ++i) a.in[i] = (const float*)d_in[i];
    a.out = (float*)d_out; a.ws = (unsigned char*)d_ws;
#if MK_ONE_LAUNCH
    a.ph_lo = 0; a.ph_hi = NPHASES;
    hipLaunchKernelGGL(fwd, dim3(grid), dim3(NTHREADS), LDS_BYTES, stream, a);
#else
    for (int p = 0; p < NPHASES; ++p) {
        a.ph_lo = p; a.ph_hi = p + 1;
        hipLaunchKernelGGL(fwd, dim3(grid), dim3(NTHREADS), LDS_BYTES, stream, a);
    }
#endif
}
```

```cpp
#include <hip/hip_runtime.h>
#include <cstdio>
#include <cstdint>

constexpr int D = 2048, NB = 4, SEQ = 4096, T = NB * SEQ;
constexpr int COL_K = 512, COL_V = 1024, COL_Z = 2048, COL_B = 3072, COL_A = 3080, COL_GATE = 3088, COL_R = 7184, COL_RK = 8208, COL_RV = 9232, N_IN = 10256;
constexpr int NE = 32, TOPK = 4, FF = 2048, NA = T * TOPK;
constexpr int RW = 1024;
constexpr float EPS = 1e-6f;
constexpr int NTHREADS = 512;
constexpr int LDS_BYTES = 128 * 1024 + 4096;

#define XB_TMO      128
#define XB_XCNT(j)  (256  + 64 * (j))
#define XB_XSUB(j)  (1280 + 64 * (j))
#define XB_XGEN(j)  (2304 + 64 * (j))
#define XB_TOP      3328
#define XB_TOPGEN   3392
#define XCD_BAR_WORDS 3456
#define XB_SPIN_CAP (1u << 22)
#define LAS __attribute__((address_space(3)))
__device__ __forceinline__ unsigned xb_ld(unsigned* p)              { return __hip_atomic_load(p, __ATOMIC_RELAXED, __HIP_MEMORY_SCOPE_AGENT); }
__device__ __forceinline__ unsigned xb_add(unsigned* p, unsigned v) { return __hip_atomic_fetch_add(p, v, __ATOMIC_RELAXED, __HIP_MEMORY_SCOPE_AGENT); }
__device__ __forceinline__ unsigned xb_xcc_id() { return (unsigned)__builtin_amdgcn_s_getreg((3 << 11) | 20) & 0xFu; }
#define XB_SPIN(cond, bar) do { unsigned _sp = 0; while (cond) { __builtin_amdgcn_s_sleep(1); \
    if ((++_sp & 255u) == 0u) { if (xb_ld(&(bar)[XB_TMO])) break; if (_sp > XB_SPIN_CAP) { atomicAdd(&(bar)[XB_TMO], 1u); break; } } } } while (0)
struct XcdBarrier { unsigned* bar; unsigned x; volatile LAS unsigned* st; };
__device__ __forceinline__ XcdBarrier xcd_barrier_post(unsigned* bar, volatile LAS unsigned* st) {
    XcdBarrier b; b.bar = bar; b.x = xb_xcc_id(); b.st = st;
    if (threadIdx.x == 0) (void)xb_add(&bar[XB_XCNT(b.x)], 1u);
    return b;
}
__device__ __forceinline__ void xcd_barrier_complete(unsigned* bar, unsigned x, unsigned& nloc, unsigned& nx) {
    const unsigned G = gridDim.x * gridDim.y * gridDim.z;
    unsigned sum, cnt, mine, sp = 0u;
    for (;;) {
        sum = 0u; cnt = 0u; mine = 0u;
#pragma unroll
        for (unsigned j = 0; j < 16; ++j) { const unsigned c = xb_ld(&bar[XB_XCNT(j)]); sum += c; cnt += (c > 0u) ? 1u : 0u; mine = (j == x) ? c : mine; }
        if (sum == G) break;
        __builtin_amdgcn_s_sleep(1);
        if ((++sp & 255u) == 0u) { if (xb_ld(&bar[XB_TMO])) break; if (sp > XB_SPIN_CAP) { atomicAdd(&bar[XB_TMO], 1u); break; } }
    }
    nloc = mine > 0u ? mine : 1u; nx = cnt > 0u ? cnt : 1u;
}
__device__ __forceinline__ void xcd_barrier(const XcdBarrier& b) {
    asm volatile("s_waitcnt vmcnt(0)" ::: "memory");
    __syncthreads();
    if (threadIdx.x == 0) {
        unsigned* bar = b.bar;
        __builtin_amdgcn_s_waitcnt(0);
        unsigned nloc = b.st[0], nx = b.st[1];
        if (nloc == 0u) { xcd_barrier_complete(bar, b.x, nloc, nx); b.st[0] = nloc; b.st[1] = nx; }
        const unsigned old = xb_add(&bar[XB_XSUB(b.x)], 1u);
        const unsigned gen = old / nloc;
        if (old + 1u == (gen + 1u) * nloc) {
            __builtin_amdgcn_fence(__ATOMIC_RELEASE, "agent");
            asm volatile("s_waitcnt vmcnt(0)" ::: "memory");
            const unsigned og = xb_add(&bar[XB_TOP], 1u);
            const unsigned tg = og / nx;
            if (og + 1u == (tg + 1u) * nx) xb_add(&bar[XB_TOPGEN], 1u);
            else XB_SPIN(xb_ld(&bar[XB_TOPGEN]) == tg, bar);
            __builtin_amdgcn_fence(__ATOMIC_ACQUIRE, "agent");
            xb_add(&bar[XB_XGEN(b.x)], 1u);
            asm volatile("s_waitcnt vmcnt(0)" ::: "memory");
        } else {
            XB_SPIN(xb_ld(&bar[XB_XGEN(b.x)]) == gen, bar);
            __builtin_amdgcn_fence(__ATOMIC_ACQUIRE, "agent");
            asm volatile("s_waitcnt vmcnt(0)" ::: "memory");
        }
    }
    __syncthreads();
}

constexpr size_t al256(size_t x) { return (x + 255) & ~(size_t)255; }
constexpr size_t WS_CTL   = 0;
constexpr size_t CTL_BYTES = 32768;
constexpr size_t CW_CNT   = XCD_BAR_WORDS + 64;
constexpr size_t WS_MOD   = WS_CTL + CTL_BYTES;
constexpr size_t WS_H     = al256(WS_MOD + (size_t)NB * 6 * D * 4);
constexpr size_t WS_WINT  = al256(WS_H + (size_t)7 * T * D * 2);
constexpr int NT_IN = 44;
constexpr size_t WS_PH    = al256(WS_WINT + (size_t)NT_IN * 256 * D * 2);
constexpr size_t WS_BA    = al256(WS_PH + (size_t)T * N_IN * 2);
constexpr size_t WS_LWA   = al256(WS_BA + (size_t)T * 16 * 4);
constexpr size_t WS_LGB   = al256(WS_LWA + (size_t)T * 256 * 2);
constexpr size_t WS_L2T   = al256(WS_LGB + (size_t)T * 256 * 2);
constexpr size_t WS_WPRE  = al256(WS_L2T + (size_t)3 * RW * 256 * 2);
constexpr size_t WS_APRE  = al256(WS_WPRE + (size_t)T * RW * 4);
constexpr size_t WS_GATE  = al256(WS_APRE + (size_t)T * RW * 4);
constexpr size_t WS_WD    = al256(WS_GATE + (size_t)T * RW * 4);
constexpr size_t WS_AA    = al256(WS_WD + (size_t)T * RW * 4);
constexpr size_t WS_BB    = al256(WS_AA + (size_t)T * RW * 4);
constexpr size_t WS_KM    = al256(WS_BB + (size_t)T * RW * 4);
constexpr size_t WS_OG    = al256(WS_KM + (size_t)T * RW * 4);
constexpr size_t WS_YR    = al256(WS_OG + (size_t)T * RW * 4);
constexpr size_t WS_MERGED= al256(WS_YR + (size_t)T * RW * 4);
constexpr size_t WS_Y     = al256(WS_MERGED + (size_t)T * D * 4);
constexpr size_t WS_XMID  = al256(WS_Y + (size_t)T * D * 4);
constexpr size_t WS_H2B   = al256(WS_XMID + (size_t)T * D * 4);
constexpr size_t WS_TOPP  = al256(WS_H2B + (size_t)T * D * 2);
constexpr size_t WS_LIST  = al256(WS_TOPP + (size_t)NA * 4);
constexpr int ACT_ROWS = NA + NE * 256;
constexpr size_t WS_ACT   = al256(WS_LIST + (size_t)NE * T * 4);
constexpr size_t WS_YB    = al256(WS_ACT + (size_t)ACT_ROWS * FF * 2);
constexpr size_t WS_WGU   = al256(WS_YB + (size_t)NA * D * 2);
constexpr size_t WS_WDN   = al256(WS_WGU + (size_t)NE * 2 * FF * D * 2);
constexpr size_t WS_YGB   = al256(WS_WDN + (size_t)NE * D * FF * 2);
constexpr size_t WS_YRWB  = al256(WS_YGB + (size_t)T * RW * 2);
constexpr size_t WS_WUPG  = al256(WS_YRWB + (size_t)T * RW * 2);
constexpr size_t WS_WUPR  = al256(WS_WUPG + (size_t)D * RW * 2);
constexpr size_t WS_WOUT  = al256(WS_WUPR + (size_t)D * RW * 2);
constexpr size_t WS_MRGB  = al256(WS_WOUT + (size_t)D * D * 2);
constexpr size_t WS_GREC  = al256(WS_MRGB + (size_t)T * D * 2);
constexpr size_t WS_END   = al256(WS_GREC + (size_t)2048 * 90368);

struct Args {
    const float* in[36];
    float* out;
    unsigned char* ws;
    int ph_lo, ph_hi;
};

__device__ __forceinline__ float sigmoidf_(float x) { return 1.0f / (1.0f + expf(-x)); }
__device__ __forceinline__ float siluf_(float x) { return x * sigmoidf_(x); }
__device__ __forceinline__ float softplusf_(float x) { return fmaxf(x, 0.0f) + log1pf(expf(-fabsf(x))); }
__device__ __forceinline__ float rl(float x, int k) { return __int_as_float(__builtin_amdgcn_readlane(__float_as_int(x), k)); }
__device__ __forceinline__ float wave_sum(float v) {
#pragma unroll
    for (int o = 32; o > 0; o >>= 1) v += __shfl_xor(v, o);
    return v;
}
__device__ __forceinline__ float half_sum(float v) {
#pragma unroll
    for (int o = 16; o > 0; o >>= 1) v += __shfl_xor(v, o);
    return v;
}
__device__ __forceinline__ float block_sum(float v, float* red) {
    v = wave_sum(v);
    __syncthreads();
    if ((threadIdx.x & 63) == 0) red[threadIdx.x >> 6] = v;
    __syncthreads();
    float t = 0.f;
#pragma unroll
    for (int w = 0; w < NTHREADS / 64; ++w) t += red[w];
    return t;
}

constexpr int GBM = 128, GBN = 64, GBK = 16;
template <bool DUAL, class AL, class EP>
__device__ __forceinline__ void gemm_naive(float* sm, int M, int N, int K, const AL& al, const float* __restrict__ W, int ldw, int dual_off, const EP& ep) {
    float* As = sm;
    float* Bs = sm + GBK * (GBM + 4);
    float* Bs2 = Bs + GBK * (GBN + 4);
    const int tid = threadIdx.x, tx = tid & 15, ty = tid >> 4;
    const int ntm = (M + GBM - 1) / GBM, ntn = (N + GBN - 1) / GBN;
    for (int tile = blockIdx.x; tile < ntm * ntn; tile += gridDim.x) {
        const int tm = tile / ntn, tn = tile % ntn;
        const int m0 = tm * GBM, n0 = tn * GBN;
        float acc[4][4], acc2[4][4];
#pragma unroll
        for (int i = 0; i < 4; ++i)
#pragma unroll
            for (int j = 0; j < 4; ++j) { acc[i][j] = 0.f; acc2[i][j] = 0.f; }
        for (int k0 = 0; k0 < K; k0 += GBK) {
#pragma unroll
            for (int i = 0; i < 4; ++i) { const int idx = tid + i * NTHREADS, r = idx >> 4, kk = idx & 15; As[kk * (GBM + 4) + r] = al(m0 + r, k0 + kk); }
#pragma unroll
            for (int i = 0; i < 2; ++i) { const int idx = tid + i * NTHREADS, kk = idx >> 6, c = idx & 63, n = n0 + c;
                Bs[kk * (GBN + 4) + c] = (n < N) ? W[(size_t)(k0 + kk) * ldw + n] : 0.f;
                if (DUAL) Bs2[kk * (GBN + 4) + c] = (n < N) ? W[(size_t)(k0 + kk) * ldw + n + dual_off] : 0.f; }
            __syncthreads();
#pragma unroll
            for (int kk = 0; kk < GBK; ++kk) {
                float a[4], b[4], b2[4];
#pragma unroll
                for (int i = 0; i < 4; ++i) a[i] = As[kk * (GBM + 4) + ty * 4 + i];
#pragma unroll
                for (int j = 0; j < 4; ++j) { b[j] = Bs[kk * (GBN + 4) + tx * 4 + j]; b2[j] = DUAL ? Bs2[kk * (GBN + 4) + tx * 4 + j] : 0.f; }
#pragma unroll
                for (int i = 0; i < 4; ++i)
#pragma unroll
                    for (int j = 0; j < 4; ++j) { acc[i][j] = fmaf(a[i], b[j], acc[i][j]); if (DUAL) acc2[i][j] = fmaf(a[i], b2[j], acc2[i][j]); }
            }
            __syncthreads();
        }
#pragma unroll
        for (int i = 0; i < 4; ++i)
#pragma unroll
            for (int j = 0; j < 4; ++j) { const int m = m0 + ty * 4 + i, n = n0 + tx * 4 + j; if (m < M && n < N) ep(m, n, acc[i][j], acc2[i][j]); }
    }
}

struct ALPlain { const float* A; int lda; __device__ __forceinline__ float operator()(int m, int k) const { return A[(size_t)m * lda + k]; } };
struct ALMix {
    const float* H; const float* mix;
    __device__ __forceinline__ float operator()(int m, int k) const {
        const float h = H[(size_t)m * D + k];
        const float hp = ((m % SEQ) == 0) ? 0.f : H[(size_t)(m - 1) * D + k];
        return h + (hp - h) * mix[k];
    }
};
struct ALGatherTok { const float* H2; const int* list; int cnt; __device__ __forceinline__ float operator()(int m, int k) const { return (m < cnt) ? H2[(size_t)(list[m] >> 2) * D + k] : 0.f; } };
struct ALGatherAsg { const float* ACT; const int* list; int cnt; __device__ __forceinline__ float operator()(int m, int k) const { return (m < cnt) ? ACT[(size_t)list[m] * FF + k] : 0.f; } };

namespace pg8 {
#define PG8_LAS __attribute__((address_space(3)))
typedef unsigned short bf16_t;
typedef short bf16x8 __attribute__((ext_vector_type(8)));
typedef float f32x4 __attribute__((ext_vector_type(4)));
typedef unsigned u32x4 __attribute__((ext_vector_type(4)));
typedef unsigned u32x2 __attribute__((ext_vector_type(2)));
constexpr int BM = 256, BK = 64, HALF = 128, HTB = HALF * BK * 2, STAGE_BYTES = 8 * HTB, NXCD = 8, WGM = 8;
__host__ __device__ __forceinline__ int lds_byte(int r, int c) { const int st = (r >> 4) * 2 + (c >> 5), rr = r & 15, cc = c & 31, ob = rr * 64 + cc * 2; return st * 1024 + (ob ^ (((ob >> 9) & 1) << 5)); }
__host__ __device__ __forceinline__ void stage_rc(int b, int& R, int& C) { const int st = b / 1024, sb = b % 1024, swz = sb ^ (((sb >> 9) & 1) << 5); R = (st >> 1) * 16 + swz / 64; C = (st & 1) * 32 + (swz % 64) / 2; }
__host__ __device__ __forceinline__ int perm32(int rho) { const int n = rho >> 4, i = rho & 15; return 8 * (i >> 2) + 4 * n + (i & 3); }
struct Unit { int pm, pn; const char* A; const char* B; const int* list; int cnt, e, prow, gat; };
typedef __bf16 bf16x2_t __attribute__((ext_vector_type(2)));
__device__ __forceinline__ unsigned cvt_pk_bf16(float lo, float hi) { bf16x2_t v; v.x = (__bf16)lo; v.y = (__bf16)hi; return __builtin_bit_cast(unsigned, v); }
__device__ __forceinline__ bool static_order(int nM, int nN, int G, int c, int i, int& pm, int& pn) {
    const int nwg = nM * nN; const long L = (long)i * G + c; if (L >= nwg) return false;
    int wgid = (int)L; { const int q = nwg / NXCD, r = nwg % NXCD, xcd = wgid % NXCD, off = wgid / NXCD; wgid = (xcd < r ? xcd * (q + 1) : r * (q + 1) + (xcd - r) * q) + off; }
    const int nig = WGM * nN, gid = wgid / nig, fm = gid * WGM, gsz = (nM - fm) < WGM ? (nM - fm) : WGM;
    pm = fm + ((wgid % nig) % gsz); pn = (wgid % nig) / gsz; return true;
}
template <class Epi, class Sched, bool ALIGN_EPI = true, bool GATHER = false, bool FP8 = false>
__device__ __forceinline__ void gemm_phase(PG8_LAS unsigned char* lds, const int K_, const Sched& S, const Epi& E) {
    const int tid = threadIdx.x, wid = __builtin_amdgcn_readfirstlane(tid >> 6), lane = tid & 63, wr = wid >> 2, wc = wid & 3, fr = lane & 15, fq = lane >> 4;
    const int K = K_, KB = FP8 ? K_ : 2 * K_, nt = KB / 128;
    unsigned voffA0, voffB0;
    { int R, C; stage_rc(tid * 16, R, C); const int Rb = Epi::PERM ? ((R & ~31) + perm32(R & 31)) : R;
      voffA0 = (unsigned)(R * KB + C * 2); voffB0 = (unsigned)(Rb * KB + C * 2); }
    const size_t pstep = (size_t)64 * KB;
    const size_t kstep = (size_t)(BK * 2);
    const size_t hstep = (size_t)HALF * KB;
    const size_t tstep = 2 * hstep; (void)tstep;
    const unsigned ldsw = (unsigned)wid * 1024u;
    const int cole = FP8 ? ((fq >> 1) * 32 + (fq & 1) * 16) : fq * 8;
    const int aoff = lds_byte(wr * 64 + fr, cole), boff = aoff + (wc * 2 - wr * 4) * 2048;
    typedef int _i8 __attribute__((ext_vector_type(8))); typedef _i8 _i8a __attribute__((aligned(16)));
    constexpr bool SP2 = true;
    unsigned vA_c[2][2];
    PG8_LAS unsigned* gtab = (PG8_LAS unsigned*)(lds + STAGE_BYTES + 1024);
#define PG8_FILLTAB(u) do { int _t = threadIdx.x; asm volatile("" : "+v"(_t));   if (_t < 256) { const int _m = (u).pm * 256 + _t; \
        const int _tok = (u).gat ? ((_m < (u).cnt) ? ((u).list[_m] >> 2) : 0) : _t;     \
        gtab[_t] = (unsigned)_tok * (unsigned)KB; } } while (0)
#define PG8_SETVA(v, u) do { int _t2 = threadIdx.x; if constexpr (GATHER) asm volatile("" : "+v"(_t2)); _Pragma("unroll") for (int _h = 0; _h < 2; ++_h) _Pragma("unroll") for (int _i = 0; _i < 2; ++_i) { \
        if constexpr (GATHER) { int _R, _C; stage_rc(_t2 * 16 + _i * 8192, _R, _C); (v)[_h][_i] = gtab[_h * 128 + _R] + (unsigned)(_C * 2); } \
        else (v)[_h][_i] = 0u; } } while (0)
#define PG8_STAGE_A(bufoff, gbase, h, nx) do { _Pragma("unroll") for (int _i = 0; _i < 2; ++_i) { \
        const char* _src = GATHER ? (const char*)(gbase) + vA_c[h][_i] : (const char*)(gbase) + (size_t)(h) * hstep + (size_t)_i * pstep + voffA0; \
        __builtin_amdgcn_global_load_lds((const unsigned*)_src, (PG8_LAS unsigned*)(lds + (bufoff) + ldsw + _i * 8192), 16, 0, 0); } } while (0)
#define PG8_SA(b, h) (((b) * 2 + (h)) * HTB)
#define PG8_SB(b, h) ((4 + (b) * 2 + (h)) * HTB)
#define PG8_STAGE(bufoff, gbase, voff) do { _Pragma("unroll") for (int _i = 0; _i < 2; ++_i) \
        __builtin_amdgcn_global_load_lds((const unsigned*)((const char*)(gbase) + (size_t)_i * pstep + voff##0), (PG8_LAS unsigned*)(lds + (bufoff) + ldsw + _i * 8192), 16, 0, 0); } while (0)
#define PG8_LDA(dst, b, h) do { _Pragma("unroll") for (int m = 0; m < 4; ++m) { \
        if constexpr (FP8) { dst##8[m] = *(const PG8_LAS _i8a*)(lds + PG8_SA(b, h) + aoff + m * 2048); } \
        else { _Pragma("unroll") for (int k = 0; k < 2; ++k) dst[m][k] = *(const PG8_LAS bf16x8*)(lds + PG8_SA(b, h) + aoff + m * 2048 + k * 1024); } } } while (0)
#define PG8_LDB(dst, b, h) do { _Pragma("unroll") for (int n = 0; n < 2; ++n) { \
        if constexpr (FP8) { dst##8[n] = *(const PG8_LAS _i8a*)(lds + PG8_SB(b, h) + boff + n * 2048); } \
        else { _Pragma("unroll") for (int k = 0; k < 2; ++k) dst[n][k] = *(const PG8_LAS bf16x8*)(lds + PG8_SB(b, h) + boff + n * 2048 + k * 1024); } } } while (0)
#define PG8_MMA(ai, bj, At, Bt) do { __builtin_amdgcn_s_setprio(1); _Pragma("unroll") for (int m = 0; m < 4; ++m) _Pragma("unroll") for (int n = 0; n < 2; ++n) { \
        if constexpr (FP8) acc[ai][bj][m][n] = __builtin_amdgcn_mfma_scale_f32_16x16x128_f8f6f4(Bt##8[n], At##8[m], acc[ai][bj][m][n], 0, 0, 0, 127, 0, 127); \
        else { _Pragma("unroll") for (int k = 0; k < 2; ++k) acc[ai][bj][m][n] = __builtin_amdgcn_mfma_f32_16x16x32_bf16(Bt[n][k], At[m][k], acc[ai][bj][m][n], 0, 0, 0); } } \
        __builtin_amdgcn_s_setprio(0); } while (0)
#define PG8_WAIT_V(n) asm volatile("s_waitcnt vmcnt(" #n ")" ::: "memory")
#define PG8_WAIT_L(n) asm volatile("s_waitcnt lgkmcnt(" #n ")" ::: "memory")
#define PG8_BAR __builtin_amdgcn_s_barrier()
#define PG8_SCHED __builtin_amdgcn_sched_barrier(0)
    Unit cur, nxt; int ui = 0;
    if (!S.next(0, cur)) return;
    f32x4 acc[2][2][4][2];
#pragma unroll
    for (int a = 0; a < 2; ++a)
#pragma unroll
        for (int b = 0; b < 2; ++b)
#pragma unroll
            for (int m = 0; m < 4; ++m)
#pragma unroll
                for (int n = 0; n < 2; ++n) acc[a][b][m][n] = (f32x4){0.f, 0.f, 0.f, 0.f};
    bf16x8 At[4][2], B0[2][2], B1[2][2]; _i8 At8[4], B08[2], B18[2];
    const char* cA = cur.A; const char* cB = cur.B;
    S.a_ready(cur);
    if constexpr (GATHER) { PG8_FILLTAB(cur); __syncthreads(); }
    PG8_SETVA(vA_c, cur);
    if constexpr (GATHER) __syncthreads();
    if constexpr (SP2) {
        PG8_STAGE(PG8_SB(0, 0), cB, voffB); PG8_STAGE(PG8_SB(0, 1), cB + hstep, voffB); PG8_STAGE_A(PG8_SA(0, 0), cA, 0, false); PG8_STAGE_A(PG8_SA(0, 1), cA, 1, false);
        if (wr == 1) PG8_BAR;
        PG8_WAIT_V(2); PG8_BAR;
        PG8_STAGE(PG8_SB(1, 0), cB + kstep, voffB); PG8_STAGE_A(PG8_SA(1, 0), cA + kstep, 0, false); PG8_STAGE(PG8_SB(1, 1), cB + hstep + kstep, voffB);
        PG8_WAIT_V(6); PG8_BAR;
    }
    for (;;) {
        const bool has_next = S.next(ui + 1, nxt);
        const char* nA = has_next ? nxt.A : cA; const char* nB = has_next ? nxt.B : cB;
        if constexpr (GATHER) { if (has_next) PG8_FILLTAB(nxt); }
        for (int t = 0; t < nt; t += 2) {
            const bool last = (t == nt - 2); const bool lastn = last && has_next; (void)lastn;
            const char* a1 = cA + (size_t)(t + 1) * kstep;
            const char* a2 = last ? nA : cA + (size_t)(t + 2) * kstep; const char* b2 = last ? nB : cB + (size_t)(t + 2) * kstep;
            const char* a3 = a2 + kstep; const char* b3 = b2 + kstep;
            if (last && has_next) S.a_ready(nxt);
            if constexpr (SP2) {
            PG8_LDB(B0, 0, 0); PG8_LDB(B1, 0, 1); PG8_SCHED; PG8_LDA(At, 0, 0); PG8_STAGE_A(PG8_SA(1, 1), a1, 1, false);
            PG8_WAIT_V(8); PG8_WAIT_L(0); PG8_BAR; PG8_MMA(0, 0, At, B0); PG8_MMA(0, 1, At, B1); PG8_BAR; PG8_SCHED;
            if constexpr (GATHER) { if (lastn) PG8_SETVA(vA_c, nxt); }
            PG8_LDA(At, 0, 1); PG8_STAGE(PG8_SB(0, 0), b2, voffB); PG8_STAGE(PG8_SB(0, 1), b2 + hstep, voffB); PG8_STAGE_A(PG8_SA(0, 0), a2, 0, lastn);
            PG8_WAIT_V(8); PG8_WAIT_L(0); PG8_BAR; PG8_MMA(1, 0, At, B0); PG8_MMA(1, 1, At, B1); PG8_BAR; PG8_SCHED;
            PG8_LDB(B0, 1, 0); PG8_LDB(B1, 1, 1); PG8_SCHED; PG8_LDA(At, 1, 0); PG8_STAGE_A(PG8_SA(0, 1), a2, 1, lastn);
            PG8_WAIT_V(8); PG8_WAIT_L(0); PG8_BAR; PG8_MMA(0, 0, At, B0); PG8_MMA(0, 1, At, B1); PG8_BAR; PG8_SCHED;
            PG8_LDA(At, 1, 1); PG8_STAGE(PG8_SB(1, 0), b3, voffB); PG8_STAGE(PG8_SB(1, 1), b3 + hstep, voffB); PG8_STAGE_A(PG8_SA(1, 0), a3, 0, lastn);
            PG8_WAIT_V(8); PG8_WAIT_L(0); PG8_BAR; PG8_MMA(1, 0, At, B0); PG8_MMA(1, 1, At, B1); PG8_BAR; PG8_SCHED;
            }
        }
        if constexpr (ALIGN_EPI) { if (wr == 0) PG8_BAR; }
        asm volatile("" ::: "memory");
        if constexpr (!Epi::AFTER_DRAIN) { E(acc, cur, wr, wc, fr, fq); S.done(cur); }
        if (!has_next) break;
#pragma unroll
        for (int a = 0; a < 2; ++a)
#pragma unroll
            for (int b = 0; b < 2; ++b)
#pragma unroll
                for (int m = 0; m < 4; ++m)
#pragma unroll
                    for (int n = 0; n < 2; ++n) acc[a][b][m][n] = (f32x4){0.f, 0.f, 0.f, 0.f};
        cur = nxt; cA = nA; cB = nB; ++ui;
        if constexpr (ALIGN_EPI) { if (wr == 1) PG8_BAR; }
    }
    PG8_WAIT_V(0);
    if constexpr (!ALIGN_EPI) { if (wr == 0) PG8_BAR; }
    PG8_BAR;
    if constexpr (Epi::AFTER_DRAIN) { E.fused(acc, cur, wr, wc, fr, fq, lds, wid, lane); S.done(cur); }
#undef PG8_SA
#undef PG8_SB
#undef PG8_STAGE
#undef PG8_STAGE_A
#undef PG8_SETVA
#undef PG8_FILLTAB
#undef PG8_LDA
#undef PG8_LDB
#undef PG8_MMA
#undef PG8_WAIT_V
#undef PG8_WAIT_L
#undef PG8_BAR
#undef PG8_SCHED
}
}


typedef float f32x4_t __attribute__((ext_vector_type(4)));
__device__ __forceinline__ f32x4_t ld_bf4(const unsigned short* p) { const pg8::u32x2 v = *(const pg8::u32x2*)p; return (f32x4_t){__uint_as_float(v.x << 16), __uint_as_float(v.x & 0xffff0000u), __uint_as_float(v.y << 16), __uint_as_float(v.y & 0xffff0000u)}; }
__device__ __forceinline__ void ld_bf8(const unsigned short* p, f32x4_t& lo, f32x4_t& hi) { const pg8::u32x4 v = *(const pg8::u32x4*)p;
    lo = (f32x4_t){__uint_as_float(v.x << 16), __uint_as_float(v.x & 0xffff0000u), __uint_as_float(v.y << 16), __uint_as_float(v.y & 0xffff0000u)};
    hi = (f32x4_t){__uint_as_float(v.z << 16), __uint_as_float(v.z & 0xffff0000u), __uint_as_float(v.w << 16), __uint_as_float(v.w & 0xffff0000u)}; }
__device__ __forceinline__ float ld_bf1(const unsigned short* p) { return __uint_as_float((unsigned)(*p) << 16); }
struct SchedInProj {
    int G, c; const char* Abase; const char* Bt;
    __device__ __forceinline__ bool next(int i, pg8::Unit& u) const {
        int pm, pn; if (!pg8::static_order(T / 256, NT_IN, G, c, i, pm, pn)) return false;
        const int ai = pn < 29 ? 0 : pn < 33 ? 1 : pn < 37 ? 3 : pn < 41 ? 4 : pn == 41 ? 2 : pn == 42 ? 5 : 6;
        u.pm = pm; u.pn = pn; u.A = Abase + ((size_t)ai * T + (size_t)pm * 256) * D * 2; u.B = Bt + (size_t)pn * 256 * D * 2; u.list = nullptr; u.cnt = 0; u.e = 0; u.prow = 0; u.gat = 0; return true;
    }
    __device__ __forceinline__ void a_ready(const pg8::Unit&) const {}
    __device__ __forceinline__ void done(const pg8::Unit&) const {}
};
__device__ __forceinline__ float fast_sigmoid(float x) { return __builtin_amdgcn_rcpf(1.0f + __builtin_amdgcn_exp2f(-1.4426950408889634f * x)); }
__device__ __forceinline__ float fast_tanh(float x) { return 1.0f - 2.0f * __builtin_amdgcn_rcpf(1.0f + __builtin_amdgcn_exp2f(2.8853900817779268f * x)); }
struct EpiInProjF32 {
    static constexpr bool PERM = true, AFTER_DRAIN = false;
    unsigned short* PH; float* BA; unsigned short* LWA; unsigned short* LGB;
    __device__ __forceinline__ void operator()(const pg8::f32x4 (&acc)[2][2][4][2], const pg8::Unit& u, int wr, int wc, int fr, int fq) const {
        const int pn = u.pn; unsigned short* b16 = PH; unsigned ld = N_IN; int ncol = 256, act = 0;
        if (pn < 12) b16 = PH + pn * 256;
        else if (pn < 28) { b16 = PH + COL_GATE + (pn - 12) * 256; act = 2; }
        else if (pn == 28) { act = 4; ncol = 16; }
        else if (pn < 41) b16 = PH + COL_R + (pn - 29) * 256;
        else if (pn == 41) { act = 1; ncol = 128; b16 = LWA; ld = 256; }
        else if (pn == 42) { act = 3; ncol = 128; b16 = LWA + 128; ld = 256; }
        else { act = 2; b16 = LGB; ld = 256; }
        const unsigned row0 = (unsigned)u.pm * 256u + wr * 64 + fr;
#pragma unroll
        for (int ai = 0; ai < 2; ++ai)
#pragma unroll
            for (int m = 0; m < 4; ++m) {
                const unsigned row = row0 + ai * 128 + m * 16;
#pragma unroll
                for (int bj = 0; bj < 2; ++bj) {
                    const int cl = bj * 128 + wc * 32 + 8 * fq;
                    pg8::f32x4 v0 = acc[ai][bj][m][0], v1 = acc[ai][bj][m][1];
                    if (act == 4) { if (cl < ncol) { float* dst = BA + (size_t)row * 16 + cl; *(pg8::f32x4*)dst = v0; *(pg8::f32x4*)(dst + 4) = v1; } }
                    else {
                        if (act == 1) {
#pragma unroll
                            for (int j = 0; j < 4; ++j) { v0[j] = fast_tanh(v0[j]); v1[j] = fast_tanh(v1[j]); } }
                        if (act == 2) {
#pragma unroll
                            for (int j = 0; j < 4; ++j) { v0[j] = fast_sigmoid(v0[j]); v1[j] = fast_sigmoid(v1[j]); } }
                        if ((act == 1 || act == 3) && cl >= 96) { v0 = (pg8::f32x4){0.f, 0.f, 0.f, 0.f}; v1 = v0; }
                        if (cl < ncol) { pg8::u32x4 w; w.x = pg8::cvt_pk_bf16(v0[0], v0[1]); w.y = pg8::cvt_pk_bf16(v0[2], v0[3]); w.z = pg8::cvt_pk_bf16(v1[0], v1[1]); w.w = pg8::cvt_pk_bf16(v1[2], v1[3]);
                            *(pg8::u32x4*)(b16 + (size_t)row * ld + cl) = w; }
                    }
                }
            }
    }
};
struct SchedLora {
    int G, c; const char* LWA; const char* LGB; const char* L2T;
    __device__ __forceinline__ bool next(int i, pg8::Unit& u) const {
        int pm, pn; if (!pg8::static_order(T / 256, 12, G, c, i, pm, pn)) return false;
        const int g = pn >> 2;
        u.pm = pm; u.pn = pn; u.e = g; u.A = (g < 2 ? LWA : LGB) + (size_t)pm * 256 * 256 * 2; u.B = L2T + ((size_t)g * RW + (size_t)(pn & 3) * 256) * 256 * 2; u.list = nullptr; u.cnt = 0; u.prow = 0; u.gat = 0; return true;
    }
    __device__ __forceinline__ void a_ready(const pg8::Unit&) const {}
    __device__ __forceinline__ void done(const pg8::Unit&) const {}
};
struct EpiLora {
    static constexpr bool PERM = true, AFTER_DRAIN = false;
    float* WPRE; float* APRE; float* GATE; const float* w0; const float* a0;
    __device__ __forceinline__ void operator()(const pg8::f32x4 (&acc)[2][2][4][2], const pg8::Unit& u, int wr, int wc, int fr, int fq) const {
        const int g = u.e; float* C = g == 0 ? WPRE : g == 1 ? APRE : GATE; const float* bias = g == 0 ? w0 : a0;
        const unsigned row0 = (unsigned)u.pm * 256u + wr * 64 + fr; const int col0 = (u.pn & 3) * 256 + wc * 32 + 8 * fq;
        pg8::f32x4 bv[2][2];
#pragma unroll
        for (int bj = 0; bj < 2; ++bj)
#pragma unroll
            for (int n = 0; n < 2; ++n) bv[bj][n] = (g < 2) ? *(const pg8::f32x4*)(bias + col0 + 128 * bj + 4 * n) : (pg8::f32x4){0.f, 0.f, 0.f, 0.f};
#pragma unroll
        for (int ai = 0; ai < 2; ++ai)
#pragma unroll
            for (int m = 0; m < 4; ++m) {
                float* rp = C + (size_t)(row0 + ai * 128 + m * 16) * RW + col0;
#pragma unroll
                for (int bj = 0; bj < 2; ++bj) { *(pg8::f32x4*)(rp + 128 * bj) = acc[ai][bj][m][0] + bv[bj][0]; *(pg8::f32x4*)(rp + 128 * bj + 4) = acc[ai][bj][m][1] + bv[bj][1]; }
            }
    }
};

struct SchedMoE {
    int G, c, nN, nrows; const LAS int* tab; const int* LIST; const char* Abase; const char* W; bool gatherA; int esz;
    __device__ __forceinline__ bool next(int i, pg8::Unit& u) const {
        const int L = i * G + c; const int total = __builtin_amdgcn_readfirstlane(tab[32]) * nN; if (L >= total) return false;
        int e = 0;
        for (int k = 1; k < NE; ++k) if (__builtin_amdgcn_readfirstlane(tab[k]) * nN <= L) e = k;
        const int t0 = __builtin_amdgcn_readfirstlane(tab[e]), t1 = __builtin_amdgcn_readfirstlane(tab[e + 1]);
        const int q = L - t0 * nN, mt = t1 - t0;
        u.pm = q % mt; u.pn = q / mt; u.e = e; u.cnt = __builtin_amdgcn_readfirstlane(tab[128 + e]); u.list = LIST + (size_t)e * T; u.prow = t0 * 256 + u.pm * 256;
        u.gat = gatherA ? 1 : 0; u.A = gatherA ? Abase : Abase + (size_t)u.prow * D * esz;
        u.B = W + ((size_t)e * nrows + (size_t)u.pn * 256) * D * esz; return true;
    }
    __device__ __forceinline__ void a_ready(const pg8::Unit&) const {}
    __device__ __forceinline__ void done(const pg8::Unit&) const {}
};
struct EpiGU {
    static constexpr bool PERM = true, AFTER_DRAIN = false;
    unsigned char* ACT; const float* bgu;
    __device__ __forceinline__ void operator()(const pg8::f32x4 (&acc)[2][2][4][2], const pg8::Unit& u, int wr, int wc, int fr, int fq) const {
        const float* bg = bgu + (size_t)u.e * 2 * FF; const int f0 = 128 * u.pn + 16 * wc + 4 * fq;
        pg8::f32x4 bgv[2], buv[2];
#pragma unroll
        for (int bj = 0; bj < 2; ++bj) { bgv[bj] = *(const pg8::f32x4*)(bg + f0 + 64 * bj); buv[bj] = *(const pg8::f32x4*)(bg + FF + f0 + 64 * bj); }
        const unsigned row0 = (unsigned)u.prow + wr * 64 + fr;
#pragma unroll
        for (int ai = 0; ai < 2; ++ai)
#pragma unroll
            for (int m = 0; m < 4; ++m) {
                const unsigned row = row0 + ai * 128 + m * 16;
#pragma unroll
                for (int bj = 0; bj < 2; ++bj) {
                    const pg8::f32x4 g = acc[ai][bj][m][0] * 0.015625f + bgv[bj], up = acc[ai][bj][m][1] * 0.015625f + buv[bj];
                    float a[4];
#pragma unroll
                    for (int j = 0; j < 4; ++j) { const float gl = fminf(g[j], 7.0f), ul = fminf(fmaxf(up[j], -7.0f), 7.0f); a[j] = gl * fast_sigmoid(1.702f * gl) * (ul + 1.0f); }
                    int w8 = __builtin_amdgcn_cvt_pk_fp8_f32(a[0] * 4.0f, a[1] * 4.0f, 0, false); w8 = __builtin_amdgcn_cvt_pk_fp8_f32(a[2] * 4.0f, a[3] * 4.0f, w8, true);
                    *(int*)(ACT + (size_t)row * FF + f0 + 64 * bj) = w8;
                }
            }
    }
};
struct EpiDown {
    static constexpr bool PERM = true, AFTER_DRAIN = false;
    unsigned short* YB; const float* bd;
    __device__ __forceinline__ void operator()(const pg8::f32x4 (&acc)[2][2][4][2], const pg8::Unit& u, int wr, int wc, int fr, int fq) const {
        const float* b = bd + (size_t)u.e * D; const int col0 = u.pn * 256 + wc * 32 + 8 * fq;
        pg8::f32x4 bv[2][2];
#pragma unroll
        for (int bj = 0; bj < 2; ++bj)
#pragma unroll
            for (int n = 0; n < 2; ++n) bv[bj][n] = *(const pg8::f32x4*)(b + col0 + 128 * bj + 4 * n);
        const int ml0 = u.pm * 256 + wr * 64 + fr;
#pragma unroll
        for (int ai = 0; ai < 2; ++ai)
#pragma unroll
            for (int m = 0; m < 4; ++m) {
                const int ml = ml0 + ai * 128 + m * 16;
                if (ml < u.cnt) {
                    const unsigned asg = (unsigned)u.list[ml];
#pragma unroll
                    for (int bj = 0; bj < 2; ++bj) {
                        const pg8::f32x4 v0 = acc[ai][bj][m][0] * 0.00390625f + bv[bj][0], v1 = acc[ai][bj][m][1] * 0.00390625f + bv[bj][1];
                        pg8::u32x4 w; w.x = pg8::cvt_pk_bf16(v0[0], v0[1]); w.y = pg8::cvt_pk_bf16(v0[2], v0[3]); w.z = pg8::cvt_pk_bf16(v1[0], v1[1]); w.w = pg8::cvt_pk_bf16(v1[2], v1[3]);
                        *(pg8::u32x4*)(YB + (size_t)asg * D + col0 + 128 * bj) = w;
                    }
                }
            }
    }
};
__device__ __forceinline__ void moe_tables(LAS int* tab, const unsigned* CNT) {
    if (threadIdx.x == 0) {
        int acc = 0;
        for (int e = 0; e < NE; ++e) { const int c = (int)__hip_atomic_load(&CNT[e], __ATOMIC_RELAXED, __HIP_MEMORY_SCOPE_AGENT); tab[e] = acc; tab[64 + e] = acc * 256; tab[128 + e] = c; acc += (c + 255) >> 8; }
        tab[32] = acc; tab[96] = acc * 256;
    }
    __syncthreads();
}
__device__ __forceinline__ float bf2f(unsigned short h) { return __uint_as_float((unsigned)h << 16); }


struct SchedUp {
    int G, c; const char* A0; const char* A1; const char* B0; const char* B1;
    __device__ __forceinline__ bool next(int i, pg8::Unit& u) const {
        int pm, pn; if (!pg8::static_order(T / 256, D / 256, G, c, i >> 1, pm, pn)) return false;
        const int sb = i & 1;
        u.pm = pm; u.pn = pn; u.e = sb; u.A = (sb ? A1 : A0) + (size_t)pm * 256 * RW * 2; u.B = (sb ? B1 : B0) + (size_t)pn * 256 * RW * 2; u.list = nullptr; u.cnt = 0; u.prow = 0; u.gat = 0; return true;
    }
    __device__ __forceinline__ void a_ready(const pg8::Unit&) const {}
    __device__ __forceinline__ void done(const pg8::Unit&) const {}
};
struct EpiUp {
    static constexpr bool PERM = true, AFTER_DRAIN = false;
    float* M32; unsigned short* MB; const unsigned short* PH;
    __device__ __forceinline__ void operator()(const pg8::f32x4 (&acc)[2][2][4][2], const pg8::Unit& u, int wr, int wc, int fr, int fq) const {
        const int sb = u.e; const unsigned row0 = (unsigned)u.pm * 256u + wr * 64 + fr; const int col0 = u.pn * 256 + wc * 32 + 8 * fq;
#pragma unroll
        for (int ai = 0; ai < 2; ++ai)
#pragma unroll
            for (int m = 0; m < 4; ++m) {
                const unsigned row = row0 + ai * 128 + m * 16;
#pragma unroll
                for (int bj = 0; bj < 2; ++bj) {
                    const int col = col0 + 128 * bj;
                    f32x4_t g0, g1; ld_bf8(PH + (size_t)row * N_IN + COL_GATE + sb * D + col, g0, g1);
                    pg8::f32x4 v0 = acc[ai][bj][m][0], v1 = acc[ai][bj][m][1];
#pragma unroll
                    for (int j = 0; j < 4; ++j) { v0[j] *= g0[j]; v1[j] *= g1[j]; }
                    float* mp = M32 + (size_t)row * D + col;
                    if (sb == 0) { *(pg8::f32x4*)mp = v0; *(pg8::f32x4*)(mp + 4) = v1; }
                    else {
                        v0 += *(const pg8::f32x4*)mp; v1 += *(const pg8::f32x4*)(mp + 4);
                        pg8::u32x4 w; w.x = pg8::cvt_pk_bf16(v0[0], v0[1]); w.y = pg8::cvt_pk_bf16(v0[2], v0[3]); w.z = pg8::cvt_pk_bf16(v1[0], v1[1]); w.w = pg8::cvt_pk_bf16(v1[2], v1[3]);
                        *(pg8::u32x4*)(MB + (size_t)row * D + col) = w;
                    }
                }
            }
    }
};
struct SchedPlain {
    int G, c, nM, nN, K; const char* A; const char* B;
    __device__ __forceinline__ bool next(int i, pg8::Unit& u) const {
        int pm, pn; if (!pg8::static_order(nM, nN, G, c, i, pm, pn)) return false;
        u.pm = pm; u.pn = pn; u.e = 0; u.A = A + (size_t)pm * 256 * K * 2; u.B = B + (size_t)pn * 256 * K * 2; u.list = nullptr; u.cnt = 0; u.prow = 0; u.gat = 0; return true;
    }
    __device__ __forceinline__ void a_ready(const pg8::Unit&) const {}
    __device__ __forceinline__ void done(const pg8::Unit&) const {}
};
struct EpiF32 {
    static constexpr bool PERM = true, AFTER_DRAIN = false;
    float* C; int ldc;
    __device__ __forceinline__ void operator()(const pg8::f32x4 (&acc)[2][2][4][2], const pg8::Unit& u, int wr, int wc, int fr, int fq) const {
        const unsigned row0 = (unsigned)u.pm * 256u + wr * 64 + fr; const int col0 = u.pn * 256 + wc * 32 + 8 * fq;
#pragma unroll
        for (int ai = 0; ai < 2; ++ai)
#pragma unroll
            for (int m = 0; m < 4; ++m) {
                float* rp = C + (size_t)(row0 + ai * 128 + m * 16) * ldc + col0;
#pragma unroll
                for (int bj = 0; bj < 2; ++bj) { *(pg8::f32x4*)(rp + 128 * bj) = acc[ai][bj][m][0]; *(pg8::f32x4*)(rp + 128 * bj + 4) = acc[ai][bj][m][1]; }
            }
    }
};

#define LDS_WAIT() asm volatile("s_waitcnt lgkmcnt(0)" ::: "memory")
template <class F, class FK>
__device__ __forceinline__ void cvt_item_k(const float* __restrict__ W, int ldw, int K, const F& srccol, const FK& srcrow, unsigned short* WT, int row0, int kb, LAS float* scr, int lane) {
    const int n = lane & 31, k0 = kb * 64; const int sc = srccol(row0 + n);
#pragma unroll 8
    for (int i = 0; i < 32; ++i) { const int kk = 2 * i + (lane >> 5); const int sr = srcrow(k0 + kk); scr[kk * 33 + n] = (sc >= 0 && sr >= 0) ? W[(size_t)sr * ldw + sc] : 0.f; }
    LDS_WAIT();
    const int c = lane & 7;
#pragma unroll
    for (int j = 0; j < 4; ++j) { const int n2 = (lane >> 3) + 8 * j; const LAS float* sp = scr + (8 * c) * 33 + n2;
        pg8::u32x4 o; o.x = pg8::cvt_pk_bf16(sp[0 * 33], sp[1 * 33]); o.y = pg8::cvt_pk_bf16(sp[2 * 33], sp[3 * 33]); o.z = pg8::cvt_pk_bf16(sp[4 * 33], sp[5 * 33]); o.w = pg8::cvt_pk_bf16(sp[6 * 33], sp[7 * 33]);
        *(pg8::u32x4*)(WT + (size_t)(row0 + n2) * K + k0 + 8 * c) = o; }
    LDS_WAIT();
}
template <class F>
__device__ __forceinline__ void cvt_item(const float* __restrict__ W, int ldw, int K, const F& srccol, unsigned short* WT, int row0, int kb, LAS float* scr, int lane) {
    auto idk = [](int k) { return k; };
    cvt_item_k(W, ldw, K, srccol, idk, WT, row0, kb, scr, lane);
}
template <class FM, class FK>
__device__ __forceinline__ void cvt64(const float* __restrict__ W, int ldw, int K, const FM& map4, const FK& srcrow, unsigned short* __restrict__ WT, int row0, int kb, int lane) {
    const int n4 = lane & 15, kg = lane >> 4, k0 = kb * 64 + 16 * kg;
    int sc, dr; map4(row0, n4, sc, dr);
    f32x4_t v[16];
#pragma unroll
    for (int kk = 0; kk < 16; ++kk) { const int sr = srcrow(k0 + kk); v[kk] = (sc >= 0 && sr >= 0) ? *(const f32x4_t*)(W + (size_t)sr * ldw + sc) : (f32x4_t){0.f, 0.f, 0.f, 0.f}; }
#pragma unroll
    for (int j = 0; j < 4; ++j) {
        pg8::u32x4 o0, o1;
        o0.x = pg8::cvt_pk_bf16(v[0][j], v[1][j]); o0.y = pg8::cvt_pk_bf16(v[2][j], v[3][j]); o0.z = pg8::cvt_pk_bf16(v[4][j], v[5][j]); o0.w = pg8::cvt_pk_bf16(v[6][j], v[7][j]);
        o1.x = pg8::cvt_pk_bf16(v[8][j], v[9][j]); o1.y = pg8::cvt_pk_bf16(v[10][j], v[11][j]); o1.z = pg8::cvt_pk_bf16(v[12][j], v[13][j]); o1.w = pg8::cvt_pk_bf16(v[14][j], v[15][j]);
        unsigned short* dst = WT + (size_t)(dr + j) * K + k0;
        *(pg8::u32x4*)dst = o0; *(pg8::u32x4*)(dst + 8) = o1;
    }
}
template <class FM, class FK>
__device__ __forceinline__ void cvt64_f8(const float* __restrict__ W, int ldw, int K, const FM& map4, const FK& srcrow, unsigned char* __restrict__ WT, int row0, int kb, int lane, float scale) {
    const int n4 = lane & 15, kg = lane >> 4, k0 = kb * 64 + 16 * kg;
    int sc, dr; map4(row0, n4, sc, dr);
    f32x4_t v[16];
#pragma unroll
    for (int kk = 0; kk < 16; ++kk) { const int sr = srcrow(k0 + kk); v[kk] = (sc >= 0 && sr >= 0) ? *(const f32x4_t*)(W + (size_t)sr * ldw + sc) * scale : (f32x4_t){0.f, 0.f, 0.f, 0.f}; }
#pragma unroll
    for (int j = 0; j < 4; ++j) {
        pg8::u32x4 o;
#pragma unroll
        for (int q = 0; q < 4; ++q) { int w = __builtin_amdgcn_cvt_pk_fp8_f32(v[4 * q][j], v[4 * q + 1][j], 0, false); w = __builtin_amdgcn_cvt_pk_fp8_f32(v[4 * q + 2][j], v[4 * q + 3][j], w, true); o[q] = (unsigned)w; }
        *(pg8::u32x4*)(WT + (size_t)(dr + j) * K + k0) = o;
    }
}
__device__ __forceinline__ void inproj_src(int r, int& mat, int& col) {
    mat = 0; col = -1;
    if (r < 3072) col = r;
    else if (r < 7168) col = COL_GATE + (r - 3072);
    else if (r < 7424) { if (r - 7168 < 16) col = COL_B + (r - 7168); }
    else if (r < 10496) col = COL_R + (r - 7424);
    else if (r < 10752) { mat = 1; if (r - 10496 < 96) col = r - 10496; }
    else if (r < 11008) { mat = 2; if (r - 10752 < 96) col = r - 10752; }
    else { mat = 3; col = r - 11008; }
}

typedef short bf16x8_t __attribute__((ext_vector_type(8)));
typedef unsigned short LAS* lds_u16p;
__device__ __forceinline__ f32x4_t mma16(bf16x8_t a, bf16x8_t b, f32x4_t c) { return __builtin_amdgcn_mfma_f32_16x16x32_bf16(a, b, c, 0, 0, 0); }
__device__ __forceinline__ bf16x8_t ldfrag(const LAS unsigned short* M, int ld, int r0, int k0, int lane) { return *(const LAS bf16x8_t*)(M + (r0 + (lane & 15)) * ld + k0 + 8 * (lane >> 4)); }
__device__ __forceinline__ unsigned short f2bf(float x) { return (unsigned short)(pg8::cvt_pk_bf16(x, x) & 0xffffu); }
constexpr int GR_QG = 0, GR_W = 16384, GR_KDT = 32768, GR_AI = 49152, GR_U = 57344, GR_MISC = 90112, GR_BYTES = 90368;
constexpr int GL_KB = 0, GL_QB = 17408, GL_VT = 34816, GL_KST = 53248, GL_KDT = 71680, GL_LM = 90112, GL_TI = 107520, GL_AI = 116736, GL_SM = 125952;

__device__ __forceinline__ void tri_inverse_64(const LAS float* Lm, LAS unsigned short* Ti, int lane) {
    float xcol[64];
#pragma unroll
    for (int i = 0; i < 64; ++i) {
        float s0 = 0.f, s1 = 0.f, s2 = 0.f, s3 = 0.f;
#pragma unroll
        for (int j4 = 0; j4 < (i + 3) / 4; ++j4) {
            const f32x4_t l4 = *(const LAS f32x4_t*)(Lm + i * 68 + 4 * j4);
            if (4 * j4 + 0 < i) s0 = fmaf(l4[0], xcol[4 * j4 + 0], s0);
            if (4 * j4 + 1 < i) s1 = fmaf(l4[1], xcol[4 * j4 + 1], s1);
            if (4 * j4 + 2 < i) s2 = fmaf(l4[2], xcol[4 * j4 + 2], s2);
            if (4 * j4 + 3 < i) s3 = fmaf(l4[3], xcol[4 * j4 + 3], s3);
        }
        const float s = (s0 + s1) + (s2 + s3);
        xcol[i] = ((lane == i) ? 1.0f : 0.0f) - s;
        Ti[i * 72 + lane] = f2bf(xcol[i]);
    }
}

__device__ __forceinline__ void gdn_prep_item(int item, LAS unsigned char* lds, const unsigned short* __restrict__ PH, const float* __restrict__ BA, const float* __restrict__ convw, const float* __restrict__ A_log, const float* __restrict__ dt_bias, unsigned char* __restrict__ recs) {
    int tid_ = threadIdx.x; asm volatile("" : "+v"(tid_));
    const int tid = tid_, lane = tid & 63, wave = __builtin_amdgcn_readfirstlane(tid >> 6);
    const int ch = item & 63, hv = (item >> 6) & 7, b = item >> 9, qh = hv >> 1;
    const int s0 = ch * 64; const size_t t0 = (size_t)b * SEQ + s0;
    unsigned char* rec = recs + (size_t)item * GR_BYTES;
    LAS unsigned short* Kb = (LAS unsigned short*)(lds + GL_KB); LAS unsigned short* Qb = (LAS unsigned short*)(lds + GL_QB);
    LAS unsigned short* VT = (LAS unsigned short*)(lds + GL_VT); LAS unsigned short* KsT = (LAS unsigned short*)(lds + GL_KST); LAS unsigned short* KdT = (LAS unsigned short*)(lds + GL_KDT);
    LAS float* Lm = (LAS float*)(lds + GL_LM); LAS unsigned short* Ti = (LAS unsigned short*)(lds + GL_TI); LAS unsigned short* Ai = (LAS unsigned short*)(lds + GL_AI);
    LAS float* gcs = (LAS float*)(lds + GL_SM); LAS float* betas = gcs + 64;
    if (wave == 0) {
        const float araw = BA[(t0 + lane) * 16 + 8 + hv], braw = BA[(t0 + lane) * 16 + hv];
        float g = -expf(A_log[hv]) * softplusf_(araw + dt_bias[hv]);
#pragma unroll
        for (int o = 1; o < 64; o <<= 1) { const float t = __shfl_up(g, o); if (lane >= o) g += t; }
        gcs[lane] = g; betas[lane] = sigmoidf_(braw);
    }
    __syncthreads();
    {
        const int row = tid >> 3, cs = tid & 7, c0 = cs * 16;
        const float gcr = gcs[row], br = betas[row], glast = gcs[63];
        const float eg = expf(gcr), ekd = expf(glast - gcr);
#pragma unroll
        for (int mtx = 0; mtx < 3; ++mtx) {
            const int colbase = (mtx == 0) ? qh * 128 : (mtx == 1) ? COL_K + qh * 128 : COL_V + hv * 128;
            float acc[16];
#pragma unroll
            for (int i = 0; i < 16; ++i) acc[i] = 0.f;
#pragma unroll
            for (int j = 0; j < 4; ++j) {
                if (s0 + row - 3 + j >= 0) {
                    const unsigned short* src = PH + (t0 + row - 3 + j) * N_IN + colbase + c0; const float* cw = convw + j * 2048 + colbase + c0;
                    f32x4_t xq[4]; ld_bf8(src, xq[0], xq[1]); ld_bf8(src + 8, xq[2], xq[3]);
#pragma unroll
                    for (int i4 = 0; i4 < 4; ++i4) { const float4 wv = *(const float4*)(cw + 4 * i4);
                        acc[4 * i4] = fmaf(wv.x, xq[i4][0], acc[4 * i4]); acc[4 * i4 + 1] = fmaf(wv.y, xq[i4][1], acc[4 * i4 + 1]); acc[4 * i4 + 2] = fmaf(wv.z, xq[i4][2], acc[4 * i4 + 2]); acc[4 * i4 + 3] = fmaf(wv.w, xq[i4][3], acc[4 * i4 + 3]); }
                }
            }
            float ss = 0.f;
#pragma unroll
            for (int i = 0; i < 16; ++i) { acc[i] = siluf_(acc[i]); ss = fmaf(acc[i], acc[i], ss); }
            ss += __shfl_xor(ss, 1); ss += __shfl_xor(ss, 2); ss += __shfl_xor(ss, 4);
            const float rn = rsqrtf(ss + 1e-6f);
#pragma unroll
            for (int i = 0; i < 16; ++i) {
                if (mtx == 0) Qb[row * 136 + c0 + i] = f2bf(acc[i] * rn * 0.08838834764831845f);
                else if (mtx == 1) { const float kn = acc[i] * rn; Kb[row * 136 + c0 + i] = f2bf(kn); KsT[(c0 + i) * 72 + row] = f2bf(br * eg * kn); KdT[(c0 + i) * 72 + row] = f2bf(kn * ekd); }
                else VT[(c0 + i) * 72 + row] = f2bf(br * acc[i]);
            }
            asm volatile("" ::: "memory");
        }
    }
    __syncthreads();
    {
        const int mat = wave >> 2, ti = wave & 3, g4 = lane >> 4, n = lane & 15;
        const LAS unsigned short* Am = mat ? Qb : Kb;
#pragma unroll
        for (int tj = 0; tj < 4; ++tj) {
            f32x4_t acc = {0.f, 0.f, 0.f, 0.f};
#pragma unroll
            for (int ks = 0; ks < 4; ++ks) acc = mma16(ldfrag(Am, 136, 16 * ti, 32 * ks, lane), ldfrag(Kb, 136, 16 * tj, 32 * ks, lane), acc);
            const int j = 16 * tj + n; const float gj = gcs[j];
#pragma unroll
            for (int r = 0; r < 4; ++r) {
                const int i = 16 * ti + 4 * g4 + r; const float dec = expf(fminf(gcs[i] - gj, 0.f));
                if (mat == 0) Lm[i * 68 + j] = (j < i) ? betas[i] * acc[r] * dec : 0.f;
                else Ai[i * 72 + j] = f2bf((j <= i) ? acc[r] * dec : 0.f);
            }
        }
    }
    __syncthreads();
    if (wave == 0) tri_inverse_64(Lm, Ti, lane);
    else {
        for (int e = tid - 64; e < 64 * 128; e += NTHREADS - 64) { const int row = e >> 7, c = e & 127; const float qv = bf2f(Qb[row * 136 + c]); Qb[row * 136 + c] = f2bf(qv * expf(gcs[row])); }
    }
    __syncthreads();
    {
        const int g4 = lane >> 4, n = lane & 15;
#pragma unroll
        for (int t2 = 0; t2 < 2; ++t2) {
            const int tn = 2 * wave + t2; const LAS unsigned short* Bt = (tn < 8) ? VT : KsT; const int tb = tn & 7;
#pragma unroll
            for (int ti = 0; ti < 4; ++ti) {
                f32x4_t acc = {0.f, 0.f, 0.f, 0.f};
#pragma unroll
                for (int ks = 0; ks < 2; ++ks) acc = mma16(ldfrag(Ti, 72, 16 * ti, 32 * ks, lane), ldfrag(Bt, 72, 16 * tb, 32 * ks, lane), acc);
                if (tn < 8) *(f32x4_t*)(rec + GR_U + ((size_t)((ti * 8 + tb) * 64 + lane)) * 16) = acc;
                else {
#pragma unroll
                    for (int r = 0; r < 4; ++r) Kb[(16 * ti + 4 * g4 + r) * 136 + 16 * tb + n] = f2bf(acc[r]);
                }
            }
        }
    }
    __syncthreads();
    {
#pragma unroll
        for (int t2 = 0; t2 < 2; ++t2) {
            const int f = 2 * wave + t2;
            { const int ti = f >> 2, ks = f & 3;
              *(bf16x8_t*)(rec + GR_QG + (size_t)(f * 64 + lane) * 16) = ldfrag(Qb, 136, 16 * ti, 32 * ks, lane);
              *(bf16x8_t*)(rec + GR_W + (size_t)(f * 64 + lane) * 16) = ldfrag(Kb, 136, 16 * ti, 32 * ks, lane); }
            { const int td = f >> 1, ks = f & 1;
              *(bf16x8_t*)(rec + GR_KDT + (size_t)(f * 64 + lane) * 16) = ldfrag(KdT, 72, 16 * td, 32 * ks, lane); }
        }
        { const int f = wave, ti = f >> 1, ks = f & 1;
          *(bf16x8_t*)(rec + GR_AI + (size_t)(f * 64 + lane) * 16) = ldfrag(Ai, 72, 16 * ti, 32 * ks, lane); }
        if (tid == 0) *(float*)(rec + GR_MISC) = expf(gcs[63]);
    }
    __syncthreads();
}

__device__ __forceinline__ void gdn_scan_seq(int seq, LAS unsigned char* lds, const unsigned char* __restrict__ recs, float* __restrict__ OG) {
    const int tid = threadIdx.x, lane = tid & 63, wave = __builtin_amdgcn_readfirstlane(tid >> 6), g4 = lane >> 4, n = lane & 15;
    const int b = seq >> 3, hv = seq & 7;
    LAS unsigned short* St = (LAS unsigned short*)lds;
    LAS unsigned short* VnT = (LAS unsigned short*)(lds + 34816);
    for (int e = tid; e < 128 * 136; e += NTHREADS) St[e] = 0;
    f32x4_t S[8];
#pragma unroll
    for (int tv = 0; tv < 8; ++tv) S[tv] = (f32x4_t){0.f, 0.f, 0.f, 0.f};
    __syncthreads();
    const int ti = wave & 3;
    bf16x8_t nafr[4], nkfr[2], naifr[2]; f32x4_t nu[8]; float neg;
#define GS_LOAD(chv) do { const unsigned char* _r = recs + ((size_t)seq * 64 + (chv)) * GR_BYTES; \
        _Pragma("unroll") for (int ks = 0; ks < 4; ++ks) nafr[ks] = *(const bf16x8_t*)(_r + (wave < 4 ? GR_QG : GR_W) + (size_t)((ti * 4 + ks) * 64 + lane) * 16); \
        _Pragma("unroll") for (int ks = 0; ks < 2; ++ks) { nkfr[ks] = *(const bf16x8_t*)(_r + GR_KDT + (size_t)((wave * 2 + ks) * 64 + lane) * 16); naifr[ks] = *(const bf16x8_t*)(_r + GR_AI + (size_t)((ti * 2 + ks) * 64 + lane) * 16); } \
        if (wave >= 4) { _Pragma("unroll") for (int tv = 0; tv < 8; ++tv) nu[tv] = *(const f32x4_t*)(_r + GR_U + (size_t)((ti * 8 + tv) * 64 + lane) * 16); } \
        neg = *(const float*)(_r + GR_MISC); } while (0)
    GS_LOAD(0);
    for (int ch = 0; ch < 64; ++ch) {
        bf16x8_t afr[4], kfr[2], aifr[2]; f32x4_t ucur[8];
#pragma unroll
        for (int ks = 0; ks < 4; ++ks) afr[ks] = nafr[ks];
#pragma unroll
        for (int ks = 0; ks < 2; ++ks) { kfr[ks] = nkfr[ks]; aifr[ks] = naifr[ks]; }
#pragma unroll
        for (int tv = 0; tv < 8; ++tv) ucur[tv] = nu[tv];
        const float eg = neg;
        if (ch + 1 < 64) GS_LOAD(ch + 1);
        f32x4_t acc1[8];
#pragma unroll
        for (int tv = 0; tv < 8; ++tv) {
            f32x4_t a = {0.f, 0.f, 0.f, 0.f};
#pragma unroll
            for (int ks = 0; ks < 4; ++ks) a = mma16(afr[ks], ldfrag(St, 136, 16 * tv, 32 * ks, lane), a);
            acc1[tv] = a;
        }
        if (wave >= 4) {
#pragma unroll
            for (int tv = 0; tv < 8; ++tv) {
                const f32x4_t vn = ucur[tv] - acc1[tv];
                pg8::u32x2 w2; w2.x = pg8::cvt_pk_bf16(vn[0], vn[1]); w2.y = pg8::cvt_pk_bf16(vn[2], vn[3]);
                *(LAS pg8::u32x2*)(VnT + (16 * tv + n) * 72 + 16 * ti + 4 * g4) = w2;
            }
        }
        __syncthreads();
        if (wave < 4) {
#pragma unroll
            for (int tv = 0; tv < 8; ++tv) {
                f32x4_t o = acc1[tv];
#pragma unroll
                for (int ks = 0; ks < 2; ++ks) o = mma16(aifr[ks], ldfrag(VnT, 72, 16 * tv, 32 * ks, lane), o);
#pragma unroll
                for (int r = 0; r < 4; ++r) OG[((size_t)b * SEQ + ch * 64 + 16 * ti + 4 * g4 + r) * RW + hv * 128 + 16 * tv + n] = o[r];
            }
        }
#pragma unroll
        for (int tv = 0; tv < 8; ++tv) {
            f32x4_t s = S[tv] * eg;
#pragma unroll
            for (int ks = 0; ks < 2; ++ks) s = mma16(kfr[ks], ldfrag(VnT, 72, 16 * tv, 32 * ks, lane), s);
            S[tv] = s;
            pg8::u32x2 w2; w2.x = pg8::cvt_pk_bf16(s[0], s[1]); w2.y = pg8::cvt_pk_bf16(s[2], s[3]);
            *(LAS pg8::u32x2*)(St + (16 * tv + n) * 136 + 16 * wave + 4 * g4) = w2;
        }
        __syncthreads();
    }
#undef GS_LOAD
}

constexpr int RT = 32;
constexpr int RBUF_FLOATS = 5 * RT * 64 + RT * 32 + RT * 2;
typedef float f32x2_t __attribute__((ext_vector_type(2)));
__device__ __forceinline__ float dpp_f(float x, const int ctrl_sel) {
    const int xi = __float_as_int(x); int r;
    if (ctrl_sel == 0) r = __builtin_amdgcn_update_dpp(0, xi, 0xB1, 0xF, 0xF, true);
    else if (ctrl_sel == 1) r = __builtin_amdgcn_update_dpp(0, xi, 0x4E, 0xF, 0xF, true);
    else if (ctrl_sel == 2) r = __builtin_amdgcn_update_dpp(0, xi, 0x141, 0xF, 0xF, true);
    else r = __builtin_amdgcn_update_dpp(0, xi, 0x140, 0xF, 0xF, true);
    return __int_as_float(r);
}
__device__ __forceinline__ float sum8(float x) { x += dpp_f(x, 0); x += dpp_f(x, 1); x += dpp_f(x, 2); return x; }
__device__ __forceinline__ float fast_softplus(float x) { return fmaxf(x, 0.0f) + 0.6931471805599453f * __builtin_amdgcn_logf(1.0f + __builtin_amdgcn_exp2f(-1.4426950408889634f * fabsf(x))); }
__device__ __forceinline__ void rwkv_scan_block(int sq, int half, LAS float* lds, const float* __restrict__ WPRE, const float* __restrict__ APRE, const unsigned short* __restrict__ PH,
                                                const float* __restrict__ k_k, const float* __restrict__ k_a, const float* __restrict__ r_k, float* __restrict__ BON, float* __restrict__ YR) {
    const int tid = threadIdx.x, lane = tid & 63, wave = __builtin_amdgcn_readfirstlane(tid >> 6);
    const int b = sq >> 4, h = sq & 15, rbase = half * 32;
    const size_t t0 = (size_t)b * SEQ;
    const int lt = tid - 256;
    f32x4_t s0w[2], s0a[2], s0k[2], s0r[2], s0v, s1w[2], s1a[2], s1k[2], s1r[2], s1v;
    f32x4_t kkc = {0.f, 0.f, 0.f, 0.f}, kac = kkc, rkc = kkc;
    if (lt >= 0) { const int colc = h * 64 + (lt & 15) * 4; kkc = *(const f32x4_t*)(k_k + colc); kac = *(const f32x4_t*)(k_a + colc); rkc = *(const f32x4_t*)(r_k + colc); }
    f32x2_t S2[4];
#pragma unroll
    for (int k = 0; k < 4; ++k) S2[k] = (f32x2_t){0.f, 0.f};
#define RW_LOAD(c, P) do { _Pragma("unroll") for (int i = 0; i < 2; ++i) { const int f = lt + 256 * i, st = f >> 4, c4 = f & 15; const size_t t = t0 + (size_t)(c) * RT + st; const int col = h * 64 + c4 * 4; \
        P##w[i] = *(const f32x4_t*)(WPRE + t * RW + col); P##a[i] = *(const f32x4_t*)(APRE + t * RW + col); P##k[i] = ld_bf4(PH + t * N_IN + COL_RK + col); P##r[i] = ld_bf4(PH + t * N_IN + COL_R + col); } \
        { const int st = lt >> 3, c4 = lt & 7; P##v = ld_bf4(PH + (t0 + (size_t)(c) * RT + st) * N_IN + COL_RV + h * 64 + rbase + c4 * 4); } } while (0)
#define RW_STORE(bufp, P, c) do { LAS float* _b = (bufp); _Pragma("unroll") for (int i = 0; i < 2; ++i) { const int f = lt + 256 * i, st = f >> 4, c4 = f & 15; \
        f32x4_t wd, av, kkv; float ss = 0.f; \
        _Pragma("unroll") for (int j = 0; j < 4; ++j) { const float wlog = -fast_softplus(-P##w[i][j]) - 0.5f; wd[j] = __builtin_amdgcn_exp2f(-1.4426950408889634f * __builtin_amdgcn_exp2f(1.4426950408889634f * wlog)); av[j] = fast_sigmoid(P##a[i][j]); kkv[j] = P##k[i][j] * kkc[j]; ss = fmaf(kkv[j], kkv[j], ss); } \
        ss += __shfl_xor(ss, 1); ss += __shfl_xor(ss, 2); ss += __shfl_xor(ss, 4); ss += __shfl_xor(ss, 8); \
        const float rn = rsqrtf(ss + 1e-6f); f32x4_t aav, bbv, kmv; float br = 0.f, kr = 0.f, bo = 0.f; \
        _Pragma("unroll") for (int j = 0; j < 4; ++j) { const float kk = kkv[j] * rn; aav[j] = -kk; bbv[j] = kk * av[j]; kmv[j] = P##k[i][j] * (1.0f + (av[j] - 1.0f) * kac[j]); \
            br = fmaf(bbv[j], P##r[i][j], br); kr = fmaf(kmv[j], P##r[i][j], kr); bo = fmaf(P##r[i][j] * kmv[j], rkc[j], bo); } \
        *(LAS f32x4_t*)(_b + 0 * RT * 64 + st * 64 + c4 * 4) = wd; *(LAS f32x4_t*)(_b + 1 * RT * 64 + st * 64 + c4 * 4) = bbv; *(LAS f32x4_t*)(_b + 2 * RT * 64 + st * 64 + c4 * 4) = kmv; \
        const f32x4_t _x = wd * P##r[i]; \
        *(LAS f32x4_t*)(_b + 3 * RT * 64 + st * 128 + c4 * 8) = (f32x4_t){aav[0], _x[0], aav[1], _x[1]}; *(LAS f32x4_t*)(_b + 3 * RT * 64 + st * 128 + c4 * 8 + 4) = (f32x4_t){aav[2], _x[2], aav[3], _x[3]}; \
        br += __shfl_xor(br, 1); br += __shfl_xor(br, 2); br += __shfl_xor(br, 4); br += __shfl_xor(br, 8); kr += __shfl_xor(kr, 1); kr += __shfl_xor(kr, 2); kr += __shfl_xor(kr, 4); kr += __shfl_xor(kr, 8); \
        bo += __shfl_xor(bo, 1); bo += __shfl_xor(bo, 2); bo += __shfl_xor(bo, 4); bo += __shfl_xor(bo, 8); \
        if (c4 == 0) { _b[5 * RT * 64 + RT * 32 + st * 2] = br; _b[5 * RT * 64 + RT * 32 + st * 2 + 1] = kr; if (half == 0) BON[(t0 + (size_t)(c) * RT + st) * 16 + h] = bo; } } \
        { const int st = lt >> 3, c4 = lt & 7; *(LAS f32x4_t*)(_b + 5 * RT * 64 + st * 32 + c4 * 4) = P##v; } } while (0)
    constexpr int NCH = SEQ / RT;
    const int rloc = wave * 8 + (lane >> 4) * 2, kq = (lane & 15) * 4;
    LAS float* ybuf = lds + 2 * RBUF_FLOATS;
    f32x2_t T2[4];
#pragma unroll
    for (int k = 0; k < 4; ++k) T2[k] = (f32x2_t){0.f, 0.f};
    f32x4_t Aw, Ab, Ak, Ax0, Ax1, Bw, Bb, Bk, Bx0, Bx1; f32x2_t Av, Bv, Ar, Br;
#define RW_LD(X, buf, st) do { const LAS float* _p = (buf) + (st) * 64 + kq; \
        X##w = *(const LAS f32x4_t*)(_p); X##b = *(const LAS f32x4_t*)(_p + RT * 64); X##k = *(const LAS f32x4_t*)(_p + 2 * RT * 64); \
        const LAS float* _q = (buf) + 3 * RT * 64 + (st) * 128 + kq * 2; X##x0 = *(const LAS f32x4_t*)(_q); X##x1 = *(const LAS f32x4_t*)(_q + 4); \
        X##v = *(const LAS f32x2_t*)((buf) + 5 * RT * 64 + (st) * 32 + rloc); X##r = *(const LAS f32x2_t*)((buf) + 5 * RT * 64 + RT * 32 + (st) * 2); } while (0)
#define RW_SUM16(x) do { x += dpp_f(x, 0); x += dpp_f(x, 1); x += dpp_f(x, 2); x += dpp_f(x, 3); } while (0)
#define RW_STEP(X, yb, st) do { \
        f32x2_t e0 = S2[0][0] * (f32x2_t){X##x0[0], X##x0[1]}, e1 = T2[0][0] * (f32x2_t){X##x0[0], X##x0[1]}; \
        e0 += S2[0][1] * (f32x2_t){X##x0[2], X##x0[3]}; e1 += T2[0][1] * (f32x2_t){X##x0[2], X##x0[3]}; \
        e0 += S2[1][0] * (f32x2_t){X##x1[0], X##x1[1]}; e1 += T2[1][0] * (f32x2_t){X##x1[0], X##x1[1]}; \
        e0 += S2[1][1] * (f32x2_t){X##x1[2], X##x1[3]}; e1 += T2[1][1] * (f32x2_t){X##x1[2], X##x1[3]}; \
        float sa0 = e0[0], pp0 = e0[1], sa1 = e1[0], pp1 = e1[1]; RW_SUM16(sa0); RW_SUM16(sa1); RW_SUM16(pp0); RW_SUM16(pp1); \
        const f32x2_t w01 = (f32x2_t){X##w[0], X##w[1]}, w23 = (f32x2_t){X##w[2], X##w[3]}, b01 = (f32x2_t){X##b[0], X##b[1]}, b23 = (f32x2_t){X##b[2], X##b[3]}, k01 = (f32x2_t){X##k[0], X##k[1]}, k23 = (f32x2_t){X##k[2], X##k[3]}; \
        S2[0] = S2[0] * w01 + (sa0 * b01 + X##v[0] * k01); S2[1] = S2[1] * w23 + (sa0 * b23 + X##v[0] * k23); \
        T2[0] = T2[0] * w01 + (sa1 * b01 + X##v[1] * k01); T2[1] = T2[1] * w23 + (sa1 * b23 + X##v[1] * k23); \
        *(LAS f32x2_t*)((yb) + (st) * 32 + rloc) = (f32x2_t){pp0 + sa0 * X##r[0] + X##v[0] * X##r[1], pp1 + sa1 * X##r[0] + X##v[1] * X##r[1]}; } while (0)
#define RW_COMPUTE(c) do { const LAS float* buf = lds + ((c) & 1) * RBUF_FLOATS; LAS float* yb = ybuf + ((c) & 1) * RT * 32; \
        RW_LD(A, buf, 0); \
        for (int st = 0; st < RT; st += 2) { RW_LD(B, buf, st + 1); RW_STEP(A, yb, st); if (st + 2 < RT) RW_LD(A, buf, st + 2); RW_STEP(B, yb, st + 1); } } while (0)
#define RW_FLUSH(c) do { const int st = lt >> 3, c4 = lt & 7; *(f32x4_t*)(YR + (t0 + (size_t)(c) * RT + st) * RW + h * 64 + rbase + c4 * 4) = *(const LAS f32x4_t*)(ybuf + ((c) & 1) * RT * 32 + st * 32 + c4 * 4); } while (0)
    if (wave >= 4) {
        RW_LOAD(0, s0); RW_STORE(lds, s0, 0); RW_LOAD(1, s0); RW_LOAD(2, s1);
        __syncthreads();
        for (int c = 0; c < NCH; c += 2) {
            RW_STORE(lds + RBUF_FLOATS, s0, c + 1); if (c + 3 < NCH) RW_LOAD(c + 3, s0); if (c > 0) RW_FLUSH(c - 1);
            __syncthreads();
            if (c + 2 < NCH) { RW_STORE(lds, s1, c + 2); } if (c + 4 < NCH) RW_LOAD(c + 4, s1); RW_FLUSH(c);
            __syncthreads();
        }
        RW_FLUSH(NCH - 1);
    } else {
        __syncthreads();
        for (int c = 0; c < NCH; c += 2) {
            RW_COMPUTE(c);
            __syncthreads();
            RW_COMPUTE(c + 1);
            __syncthreads();
        }
    }
#undef RW_COMPUTE
#undef RW_FLUSH
#undef RW_LD
#undef RW_STEP
#undef RW_SUM16
#undef RW_LOAD
#undef RW_STORE
}

__global__ void __launch_bounds__(NTHREADS, 2) fwd(Args a) {
    extern __shared__ __attribute__((aligned(16))) unsigned char lds_raw[];
    float* sm = (float*)lds_raw;
#define PHASE_IDS int tid = threadIdx.x; asm volatile("" : "+v"(tid)); const int lane = tid & 63, wave = tid >> 6; (void)lane; (void)wave;
    unsigned char* ws = a.ws;
    unsigned* ctl = (unsigned*)(ws + WS_CTL);
    volatile LAS unsigned* xbw = (volatile LAS unsigned*)(LAS unsigned char*)(lds_raw + LDS_BYTES - 16);
    if (threadIdx.x == 0) { xbw[0] = 0u; xbw[1] = 0u; xbw[2] = 0u; xbw[3] = 0u; }
    __syncthreads();
    const int lo = a.ph_lo, hi = a.ph_hi;
    XcdBarrier bar; bar.bar = ctl; bar.x = 0; bar.st = xbw;
    if (hi - lo > 1) bar = xcd_barrier_post(ctl, xbw);
#define IN(k) (lo <= (k) && (k) < hi)
#define SEAM(k) do { if (IN(k) && IN((k) + 1)) xcd_barrier(bar); } while (0)


    if (IN(0)) {
        PHASE_IDS
        const float* c = a.in[1];
        const float* ada_w = a.in[2];
        const float* ada_b = a.in[3];
        const float* w_in = a.in[8];
        const float* rwkv_w1 = a.in[15];
        const float* rwkv_a1 = a.in[18];
        const float* rwkv_g1 = a.in[20];
        const float* w_up_gdn = a.in[27];
        const float* w_up_rwkv = a.in[28];
        const float* w_out = a.in[29];
        const float* exp_w_gu = a.in[32];
        const float* exp_w_down = a.in[34];
        float* MOD = (float*)(ws + WS_MOD);
        unsigned short* WINT = (unsigned short*)(ws + WS_WINT);
        unsigned short* WUPG = (unsigned short*)(ws + WS_WUPG);
        unsigned short* WUPR = (unsigned short*)(ws + WS_WUPR);
        unsigned short* WOUT = (unsigned short*)(ws + WS_WOUT);
        unsigned short* WGU = (unsigned short*)(ws + WS_WGU);
        unsigned short* WDN = (unsigned short*)(ws + WS_WDN);
        float* sc = sm;
        float* part = sm + NB * D;
        for (int i = tid; i < NB * D; i += NTHREADS) sc[i] = siluf_(c[i]);
        __syncthreads();
        for (int cb = blockIdx.x; cb < 6 * D / 48; cb += gridDim.x) {
            const int cc = tid % 48, kg = tid / 48, col = cb * 48 + cc;
            if (tid < 480) {
                float acc0 = 0.f, acc1 = 0.f, acc2 = 0.f, acc3 = 0.f;
#pragma unroll 8
                for (int k = kg; k < D; k += 10) {
                    const float w = ada_w[(size_t)k * (6 * D) + col];
                    acc0 = fmaf(sc[k], w, acc0); acc1 = fmaf(sc[D + k], w, acc1); acc2 = fmaf(sc[2 * D + k], w, acc2); acc3 = fmaf(sc[3 * D + k], w, acc3);
                }
                part[(kg * 4 + 0) * 48 + cc] = acc0; part[(kg * 4 + 1) * 48 + cc] = acc1; part[(kg * 4 + 2) * 48 + cc] = acc2; part[(kg * 4 + 3) * 48 + cc] = acc3;
            }
            __syncthreads();
            if (tid < 192) {
                const int bb = tid / 48, c2 = tid % 48; float t = ada_b[cb * 48 + c2];
#pragma unroll
                for (int g = 0; g < 10; ++g) t += part[(g * 4 + bb) * 48 + c2];
                MOD[(size_t)bb * 6 * D + cb * 48 + c2] = t;
            }
            __syncthreads();
        }
        {
            const int gw = blockIdx.x * (NTHREADS / 64) + wave, ngw = gridDim.x * (NTHREADS / 64);
            auto idk = [](int k) { return k; };
            constexpr int N_IP = (NT_IN * 256 / 64) * (D / 64);
            constexpr int N_GU = NE * (2 * FF / 64) * (D / 64), N_DN = NE * (D / 64) * (FF / 64);
            constexpr int N_L2 = 3 * (RW / 64) * (256 / 64), N_UP = (D / 64) * (RW / 64), N_OUT = (D / 64) * (D / 64);
            constexpr int N_ALL = N_IP + N_GU + N_DN + N_L2 + 2 * N_UP + N_OUT;
            constexpr int N_P5 = (N_GU + N_DN) * 100 / 100;
            for (int it0 = gw + N_P5; it0 < N_ALL; it0 += ngw) {
                int it = it0;
                if (it < N_GU) {
                    const int e = it / ((2 * FF / 64) * (D / 64)), r = it % ((2 * FF / 64) * (D / 64)), rb = r / (D / 64), kb = r % (D / 64);
                    auto m4 = [](int row0, int n4, int& scol, int& drow) { const int pn = row0 >> 8, cb8 = (row0 & 255) >> 3, ft = 128 * pn + (cb8 + (n4 & 7)) * 4; scol = (n4 < 8) ? ft : FF + ft; drow = row0 + (n4 & 7) * 8 + ((n4 < 8) ? 0 : 4); };
                    cvt64(exp_w_gu + (size_t)e * D * 2 * FF, 2 * FF, D, m4, idk, WGU + (size_t)e * 2 * FF * D, rb * 64, kb, lane); continue; }
                it -= N_GU;
                auto mid = [](int row0, int n4, int& scol, int& drow) { scol = row0 + 4 * n4; drow = scol; };
                if (it < N_DN) {
                    const int e = it / ((D / 64) * (FF / 64)), r = it % ((D / 64) * (FF / 64)), rb = r / (FF / 64), kb = r % (FF / 64);
                    cvt64(exp_w_down + (size_t)e * FF * D, D, FF, mid, idk, WDN + (size_t)e * D * FF, rb * 64, kb, lane); continue; }
                it -= N_DN;
                if (it < N_IP) {
                    const int rb = it / (D / 64), kb = it % (D / 64), row0 = rb * 64;
                    int mat, col0; inproj_src(row0, mat, col0);
                    const float* W = mat == 0 ? w_in : mat == 1 ? rwkv_w1 : mat == 2 ? rwkv_a1 : rwkv_g1;
                    const int ldw = mat == 0 ? N_IN : mat == 3 ? 256 : 96;
                    auto m4 = [](int r0, int n4, int& scol, int& drow) { int m2; drow = r0 + 4 * n4; inproj_src(drow, m2, scol); };
                    cvt64(W, ldw, D, m4, idk, WINT, row0, kb, lane); continue; }
                it -= N_IP;
                if (it < N_L2) {
                    const float* rwkv_w2 = a.in[16]; const float* rwkv_a2 = a.in[19]; const float* rwkv_g2 = a.in[21]; unsigned short* L2T = (unsigned short*)(ws + WS_L2T);
                    constexpr int NL = (RW / 64) * 4; const int g = it / NL, r = it % NL, rb = r / 4, kb = r % 4;
                    if (g == 0) { auto fk = [](int k) { return k < 96 ? k : -1; }; cvt64(rwkv_w2, RW, 256, mid, fk, L2T, rb * 64, kb, lane); }
                    else if (g == 1) { auto fk = [](int k) { return (k >= 128 && k < 224) ? k - 128 : -1; }; cvt64(rwkv_a2, RW, 256, mid, fk, L2T + (size_t)RW * 256, rb * 64, kb, lane); }
                    else cvt64(rwkv_g2, RW, 256, mid, idk, L2T + (size_t)2 * RW * 256, rb * 64, kb, lane);
                    continue; }
                it -= N_L2;
                if (it < N_UP) { cvt64(w_up_gdn, D, RW, mid, idk, WUPG, (it / (RW / 64)) * 64, it % (RW / 64), lane); continue; }
                it -= N_UP;
                if (it < N_UP) { cvt64(w_up_rwkv, D, RW, mid, idk, WUPR, (it / (RW / 64)) * 64, it % (RW / 64), lane); continue; }
                it -= N_UP;
                cvt64(w_out, D, D, mid, idk, WOUT, (it / (D / 64)) * 64, it % (D / 64), lane);
            }
        }
    }
    SEAM(0);

    if (IN(1)) {
        PHASE_IDS
        const float* x = a.in[0]; const float* norm_mix_pre = a.in[4]; const float* rwkv_mix = a.in[13];
        float* MOD = (float*)(ws + WS_MOD); unsigned short* AM = (unsigned short*)(ws + WS_H);
        LAS float* invs = (LAS float*)(LAS unsigned char*)lds_raw;
        for (int chunk = blockIdx.x; chunk < T / 64; chunk += gridDim.x) {
            const int r0 = chunk * 64, b = r0 / SEQ; const float* mod = MOD + (size_t)b * 6 * D;
            __syncthreads();
            for (int rr = wave; rr < 65; rr += NTHREADS / 64) {
                const int row = r0 - 1 + rr; float ss = 0.f;
                if (rr > 0 || (r0 % SEQ) != 0) {
#pragma unroll
                    for (int j = 0; j < 8; ++j) { const float4 t4 = *(const float4*)(x + (size_t)row * D + j * 256 + lane * 4); ss += t4.x * t4.x + t4.y * t4.y + t4.z * t4.z + t4.w * t4.w; }
                    ss = wave_sum(ss);
                }
                if (lane == 0) invs[rr] = rsqrtf(ss / D + EPS);
            }
            __syncthreads();
            const int d0 = tid * 4;
            const float4 nw = *(const float4*)(norm_mix_pre + d0), sc4 = *(const float4*)(mod + D + d0), sh4 = *(const float4*)(mod + d0);
            const float g0 = nw.x * (1.0f + sc4.x), g1 = nw.y * (1.0f + sc4.y), g2 = nw.z * (1.0f + sc4.z), g3 = nw.w * (1.0f + sc4.w);
            float4 mx[6];
#pragma unroll
            for (int mi = 0; mi < 6; ++mi) mx[mi] = *(const float4*)(rwkv_mix + mi * D + d0);
            float p0 = 0.f, p1 = 0.f, p2 = 0.f, p3 = 0.f;
            if ((r0 % SEQ) != 0) { const float4 xp = *(const float4*)(x + (size_t)(r0 - 1) * D + d0); const float ip = invs[0];
                p0 = xp.x * ip * g0 + sh4.x; p1 = xp.y * ip * g1 + sh4.y; p2 = xp.z * ip * g2 + sh4.z; p3 = xp.w * ip * g3 + sh4.w; }
#pragma unroll 4
            for (int rr = 0; rr < 64; ++rr) {
                const size_t o = (size_t)(r0 + rr) * D + d0;
                const float4 xc = *(const float4*)(x + o); const float inv = invs[rr + 1];
                const float h0 = xc.x * inv * g0 + sh4.x, h1 = xc.y * inv * g1 + sh4.y, h2 = xc.z * inv * g2 + sh4.z, h3 = xc.w * inv * g3 + sh4.w;
                pg8::u32x2 w; w.x = pg8::cvt_pk_bf16(h0, h1); w.y = pg8::cvt_pk_bf16(h2, h3);
                *(pg8::u32x2*)(AM + o) = w;
#pragma unroll
                for (int mi = 0; mi < 6; ++mi) {
                    pg8::u32x2 w2; w2.x = pg8::cvt_pk_bf16(h0 + (p0 - h0) * mx[mi].x, h1 + (p1 - h1) * mx[mi].y); w2.y = pg8::cvt_pk_bf16(h2 + (p2 - h2) * mx[mi].z, h3 + (p3 - h3) * mx[mi].w);
                    *(pg8::u32x2*)(AM + (size_t)(mi + 1) * T * D + o) = w2;
                }
                p0 = h0; p1 = h1; p2 = h2; p3 = h3;
            }
        }
    }
    SEAM(1);

    if (IN(2)) {
        PHASE_IDS
        unsigned short* AM = (unsigned short*)(ws + WS_H);
        unsigned short* WINT = (unsigned short*)(ws + WS_WINT);
        unsigned short* PH = (unsigned short*)(ws + WS_PH);
        SchedInProj S{(int)gridDim.x, (int)blockIdx.x, (const char*)AM, (const char*)WINT};
        EpiInProjF32 E{PH, (float*)(ws + WS_BA), (unsigned short*)(ws + WS_LWA), (unsigned short*)(ws + WS_LGB)};
        pg8::gemm_phase<EpiInProjF32, SchedInProj, true, false>((LAS unsigned char*)lds_raw, D, S, E);
    }
    SEAM(2);

    if (IN(3)) {
        PHASE_IDS
        const float* gdn_conv = a.in[9];
        const float* gdn_A_log = a.in[10];
        const float* gdn_dt_bias = a.in[11];
        const float* rwkv_w0 = a.in[14];
        const float* rwkv_w2 = a.in[16];
        const float* rwkv_a0 = a.in[17];
        const float* rwkv_a2 = a.in[19];
        const float* rwkv_g2 = a.in[21];
        unsigned short* PH = (unsigned short*)(ws + WS_PH);
        float* WPRE = (float*)(ws + WS_WPRE);
        float* APRE = (float*)(ws + WS_APRE);
        float* GATE = (float*)(ws + WS_GATE);
        unsigned char* GREC = ws + WS_GREC;
        {
            SchedLora S{(int)gridDim.x, (int)blockIdx.x, (const char*)(ws + WS_LWA), (const char*)(ws + WS_LGB), (const char*)(ws + WS_L2T)};
            EpiLora E{WPRE, APRE, GATE, rwkv_w0, rwkv_a0};
            int klora = 256; asm volatile("" : "+s"(klora));
            pg8::gemm_phase<EpiLora, SchedLora, true, false>((LAS unsigned char*)lds_raw, klora, S, E);
        }
        __syncthreads();
        for (int item = blockIdx.x; item < 2048; item += gridDim.x) gdn_prep_item(item, (LAS unsigned char*)lds_raw, PH, (const float*)(ws + WS_BA), gdn_conv, gdn_A_log, gdn_dt_bias, GREC);
    }
    SEAM(3);


    if (IN(5)) {
        PHASE_IDS
        unsigned short* PH = (unsigned short*)(ws + WS_PH);
        unsigned char* GREC = ws + WS_GREC;
        float* WD = (float*)(ws + WS_WD);
        float* AA = (float*)(ws + WS_AA);
        float* BB = (float*)(ws + WS_BB);
        float* KM = (float*)(ws + WS_KM);
        float* OG = (float*)(ws + WS_OG);
        float* YR = (float*)(ws + WS_YR);
        if (blockIdx.x < 32) gdn_scan_seq((int)blockIdx.x, (LAS unsigned char*)lds_raw, GREC, OG);
        else if (blockIdx.x < 160) rwkv_scan_block(((int)blockIdx.x - 32) >> 1, ((int)blockIdx.x - 32) & 1, (LAS float*)(LAS unsigned char*)lds_raw, (const float*)(ws + WS_WPRE), (const float*)(ws + WS_APRE), PH, a.in[22], a.in[23], a.in[24], (float*)(ws + WS_WD), YR);
        {
            const float* exp_w_gu = a.in[32]; const float* exp_w_down = a.in[34];
            unsigned char* WGU = ws + WS_WGU; unsigned char* WDN = ws + WS_WDN;
            constexpr int N_GU = NE * (2 * FF / 64) * (D / 64), N_DN = NE * (D / 64) * (FF / 64);
            auto idk = [](int k) { return k; };
            constexpr int N_P5 = N_GU + N_DN;
            for (;;) {
                int base = 0; if (lane == 0) base = (int)atomicAdd(ctl + CW_CNT + 96, 4u);
                base = __builtin_amdgcn_readfirstlane(base);
                if (base >= N_P5) break;
              for (int it0 = base; it0 < base + 4 && it0 < N_P5; ++it0) {
                int it = it0;
                if (it < N_GU) {
                    const int e = it / ((2 * FF / 64) * (D / 64)), r = it % ((2 * FF / 64) * (D / 64)), rb = r / (D / 64), kb = r % (D / 64);
                    auto m4 = [](int row0, int n4, int& scol, int& drow) { const int pn = row0 >> 8, cb8 = (row0 & 255) >> 3, ft = 128 * pn + (cb8 + (n4 & 7)) * 4; scol = (n4 < 8) ? ft : FF + ft; drow = row0 + (n4 & 7) * 8 + ((n4 < 8) ? 0 : 4); };
                    cvt64_f8(exp_w_gu + (size_t)e * D * 2 * FF, 2 * FF, D, m4, idk, WGU + (size_t)e * 2 * FF * D, rb * 64, kb, lane, 64.0f);
                } else {
                    it -= N_GU;
                    auto mid = [](int row0, int n4, int& scol, int& drow) { scol = row0 + 4 * n4; drow = scol; };
                    const int e = it / ((D / 64) * (FF / 64)), r = it % ((D / 64) * (FF / 64)), rb = r / (FF / 64), kb = r % (FF / 64);
                    cvt64_f8(exp_w_down + (size_t)e * FF * D, D, FF, mid, idk, WDN + (size_t)e * D * FF, rb * 64, kb, lane, 64.0f);
                }
              }
            }
        }
    }
    SEAM(5);

    if (IN(6)) {
        PHASE_IDS
        const float* gdn_norm = a.in[12];
        const float* rwkv_r_k = a.in[24];
        const float* rwkv_ln_w = a.in[25];
        const float* rwkv_ln_b = a.in[26];
        unsigned short* PH = (unsigned short*)(ws + WS_PH);
        float* GATE = (float*)(ws + WS_GATE);
        float* KM = (float*)(ws + WS_KM);
        float* OG = (float*)(ws + WS_OG);
        float* YR = (float*)(ws + WS_YR);
        unsigned short* YGB = (unsigned short*)(ws + WS_YGB);
        unsigned short* YRWB = (unsigned short*)(ws + WS_YRWB);
        for (int row = blockIdx.x; row < T; row += gridDim.x) {
            {
                const int c0 = tid * 2;
                const float o0 = OG[(size_t)row * RW + c0], o1 = OG[(size_t)row * RW + c0 + 1];
                const float ss = wave_sum(o0 * o0 + o1 * o1);
                const float inv = rsqrtf(ss / 128.0f + EPS);
                const float z0 = ld_bf1(PH + (size_t)row * N_IN + COL_Z + c0), z1 = ld_bf1(PH + (size_t)row * N_IN + COL_Z + c0 + 1);
                *(unsigned*)(YGB + (size_t)row * RW + c0) = pg8::cvt_pk_bf16(o0 * inv * gdn_norm[c0 & 127] * siluf_(z0), o1 * inv * gdn_norm[(c0 + 1) & 127] * siluf_(z1));
            }
#pragma unroll
            for (int i = 0; i < 2; ++i) {
                const int ch = tid + i * NTHREADS;
                const float y = YR[(size_t)row * RW + ch];
                const float mu = wave_sum(y) * (1.0f / 64.0f);
                const float dlt = y - mu;
                const float var = wave_sum(dlt * dlt) * (1.0f / 64.0f);
                float yn = dlt * rsqrtf(var + 64e-5f) * rwkv_ln_w[ch] + rwkv_ln_b[ch];
                const float vv = ld_bf1(PH + (size_t)row * N_IN + COL_RV + ch);
                const float bsum = ((const float*)(ws + WS_WD))[(size_t)row * 16 + (ch >> 6)];
                yn += bsum * vv;
                { const float yv = yn * GATE[(size_t)row * RW + ch]; const unsigned pk = pg8::cvt_pk_bf16(yv, yv); YRWB[(size_t)row * RW + ch] = (unsigned short)(pk & 0xffffu); }
            }
        }
    }
    SEAM(6);

    if (IN(7)) {
        PHASE_IDS
        unsigned short* PH = (unsigned short*)(ws + WS_PH);
        unsigned short* YGB = (unsigned short*)(ws + WS_YGB);
        unsigned short* YRWB = (unsigned short*)(ws + WS_YRWB);
        unsigned short* WUPG = (unsigned short*)(ws + WS_WUPG);
        unsigned short* WUPR = (unsigned short*)(ws + WS_WUPR);
        unsigned short* MRGB = (unsigned short*)(ws + WS_MRGB);
        float* MERGED = (float*)(ws + WS_MERGED);
        SchedUp S{(int)gridDim.x, (int)blockIdx.x, (const char*)YGB, (const char*)YRWB, (const char*)WUPG, (const char*)WUPR};
        EpiUp E{MERGED, MRGB, PH};
        pg8::gemm_phase<EpiUp, SchedUp, true, false>((LAS unsigned char*)lds_raw, RW, S, E);
    }
    SEAM(7);

    if (IN(8)) {
        PHASE_IDS
        unsigned short* WOUT = (unsigned short*)(ws + WS_WOUT);
        unsigned short* MRGB = (unsigned short*)(ws + WS_MRGB);
        float* Y = (float*)(ws + WS_Y);
        SchedPlain S{(int)gridDim.x, (int)blockIdx.x, T / 256, D / 256, D, (const char*)MRGB, (const char*)WOUT};
        EpiF32 E{Y, D};
        pg8::gemm_phase<EpiF32, SchedPlain, true, false>((LAS unsigned char*)lds_raw, D, S, E);
    }
    SEAM(8);

    if (IN(9)) {
        PHASE_IDS
        const float* x = a.in[0];
        const float* norm_mix_post = a.in[5];
        const float* norm_ffn_pre = a.in[6];
        const float* router_w = a.in[30];
        const float* router_b = a.in[31];
        float* MOD = (float*)(ws + WS_MOD);
        float* Y = (float*)(ws + WS_Y);
        float* XMID = (float*)(ws + WS_XMID);
        unsigned short* H2B = (unsigned short*)(ws + WS_H2B);
        float* TOPP = (float*)(ws + WS_TOPP);
        int* LIST = (int*)(ws + WS_LIST);
        unsigned* CNT = ctl + CW_CNT;
        LAS float* h2s = (LAS float*)(LAS unsigned char*)lds_raw;
        for (int tile = blockIdx.x; tile < T / 16; tile += gridDim.x) {
            for (int rr = 0; rr < 2; ++rr) {
                const int rl = wave * 2 + rr, row = tile * 16 + rl;
                const int b = row / SEQ; const float* mod = MOD + (size_t)b * 6 * D;
                float xm[32]; float ss = 0.f;
#pragma unroll
                for (int j = 0; j < 8; ++j) { const float4 yv = *(const float4*)(Y + (size_t)row * D + j * 256 + lane * 4); xm[4 * j] = yv.x; xm[4 * j + 1] = yv.y; xm[4 * j + 2] = yv.z; xm[4 * j + 3] = yv.w;
                    ss += yv.x * yv.x + yv.y * yv.y + yv.z * yv.z + yv.w * yv.w; }
                ss = wave_sum(ss);
                const float inv = rsqrtf(ss / D + EPS);
                float ss2 = 0.f;
#pragma unroll
                for (int j = 0; j < 8; ++j) {
                    const int d0 = j * 256 + lane * 4;
                    const float4 xv = *(const float4*)(x + (size_t)row * D + d0), nw = *(const float4*)(norm_mix_post + d0), gt = *(const float4*)(mod + 2 * D + d0);
                    xm[4 * j] = xv.x + gt.x * (xm[4 * j] * inv * nw.x); xm[4 * j + 1] = xv.y + gt.y * (xm[4 * j + 1] * inv * nw.y);
                    xm[4 * j + 2] = xv.z + gt.z * (xm[4 * j + 2] * inv * nw.z); xm[4 * j + 3] = xv.w + gt.w * (xm[4 * j + 3] * inv * nw.w);
                    *(float4*)(XMID + (size_t)row * D + d0) = make_float4(xm[4 * j], xm[4 * j + 1], xm[4 * j + 2], xm[4 * j + 3]);
                    ss2 += xm[4 * j] * xm[4 * j] + xm[4 * j + 1] * xm[4 * j + 1] + xm[4 * j + 2] * xm[4 * j + 2] + xm[4 * j + 3] * xm[4 * j + 3];
                    asm volatile("" ::: "memory");
                }
                ss2 = wave_sum(ss2);
                const float inv2 = rsqrtf(ss2 / D + EPS);
#pragma unroll
                for (int j = 0; j < 8; ++j) {
                    const int d0 = j * 256 + lane * 4;
                    const float4 nw = *(const float4*)(norm_ffn_pre + d0), sc = *(const float4*)(mod + 4 * D + d0), sh = *(const float4*)(mod + 3 * D + d0);
                    f32x4_t hv; hv[0] = xm[4 * j] * inv2 * nw.x * (1.0f + sc.x) + sh.x; hv[1] = xm[4 * j + 1] * inv2 * nw.y * (1.0f + sc.y) + sh.y;
                    hv[2] = xm[4 * j + 2] * inv2 * nw.z * (1.0f + sc.z) + sh.z; hv[3] = xm[4 * j + 3] * inv2 * nw.w * (1.0f + sc.w) + sh.w;
                    { int w8 = __builtin_amdgcn_cvt_pk_fp8_f32(hv[0], hv[1], 0, false); w8 = __builtin_amdgcn_cvt_pk_fp8_f32(hv[2], hv[3], w8, true); *(int*)((unsigned char*)H2B + (size_t)row * D + d0) = w8; }
                    *(LAS f32x4_t*)(h2s + rl * D + d0) = hv;
                    asm volatile("" ::: "memory");
                }
            }
            __syncthreads();
            {
                const int r = tid >> 5, e = tid & 31, row = tile * 16 + r;
                const LAS float* hp = h2s + r * D; float acc = 0.f;
#pragma unroll 4
                for (int d = 0; d < D; d += 4) { const f32x4_t h4 = *(const LAS f32x4_t*)(hp + d);
                    acc = fmaf(h4[0], router_w[(size_t)d * NE + e], acc); acc = fmaf(h4[1], router_w[(size_t)(d + 1) * NE + e], acc);
                    acc = fmaf(h4[2], router_w[(size_t)(d + 2) * NE + e], acc); acc = fmaf(h4[3], router_w[(size_t)(d + 3) * NE + e], acc); }
                float lgt = acc + router_b[e];
                float val[TOPK]; int idx[TOPK];
#pragma unroll
                for (int k = 0; k < TOPK; ++k) {
                    float bv = lgt; int bi = e;
#pragma unroll
                    for (int o = 1; o < 32; o <<= 1) { const float ov = __shfl_xor(bv, o); const int oi = __shfl_xor(bi, o); if (ov > bv || (ov == bv && oi < bi)) { bv = ov; bi = oi; } }
                    val[k] = bv; idx[k] = bi; if (e == bi) lgt = -3.0e38f;
                }
                float pe[TOPK], psum = 0.f;
#pragma unroll
                for (int k = 0; k < TOPK; ++k) { pe[k] = expf(val[k] - val[0]); psum += pe[k]; }
                if (e < TOPK) {
                    const float pk = e == 0 ? pe[0] : e == 1 ? pe[1] : e == 2 ? pe[2] : pe[3]; const int ik = e == 0 ? idx[0] : e == 1 ? idx[1] : e == 2 ? idx[2] : idx[3];
                    const int asg = row * TOPK + e;
                    TOPP[asg] = pk / psum;
                    const unsigned pos = atomicAdd(&CNT[ik], 1u);
                    LIST[(size_t)ik * T + pos] = asg;
                }
            }
            __syncthreads();
        }
    }
    SEAM(9);

    const int vcu = (gridDim.x % 8 == 0) ? (int)((blockIdx.x % 8) * (gridDim.x / 8) + blockIdx.x / 8) : (int)blockIdx.x;
    if (IN(10)) {
        PHASE_IDS
        const float* exp_b_gu = a.in[33];
        unsigned short* H2B = (unsigned short*)(ws + WS_H2B);
        int* LIST = (int*)(ws + WS_LIST);
        unsigned short* ACT = (unsigned short*)(ws + WS_ACT);
        unsigned short* WGU = (unsigned short*)(ws + WS_WGU);
        LAS int* mtab = (LAS int*)(LAS unsigned char*)(lds_raw + 131072);
        unsigned* CNT = ctl + CW_CNT;
        moe_tables(mtab, CNT);
        SchedMoE S{(int)gridDim.x, vcu, 2 * FF / 256, 2 * FF, mtab, LIST, (const char*)H2B, (const char*)WGU, true, 1};
        EpiGU E{(unsigned char*)ACT, exp_b_gu};
        pg8::gemm_phase<EpiGU, SchedMoE, true, true, true>((LAS unsigned char*)lds_raw, D, S, E);
    }
    SEAM(10);

    if (IN(11)) {
        PHASE_IDS
        const float* exp_b_down = a.in[35];
        int* LIST = (int*)(ws + WS_LIST);
        unsigned short* ACT = (unsigned short*)(ws + WS_ACT);
        unsigned short* YB = (unsigned short*)(ws + WS_YB);
        unsigned short* WDN = (unsigned short*)(ws + WS_WDN);
        LAS int* mtab = (LAS int*)(LAS unsigned char*)(lds_raw + 131072);
        unsigned* CNT = ctl + CW_CNT;
        moe_tables(mtab, CNT);
        SchedMoE S{(int)gridDim.x, vcu, D / 256, D, mtab, LIST, (const char*)ACT, (const char*)WDN, false, 1};
        EpiDown E{YB, exp_b_down};
        pg8::gemm_phase<EpiDown, SchedMoE, true, true, true>((LAS unsigned char*)lds_raw, FF, S, E);
    }
    SEAM(11);

    if (IN(12)) {
        PHASE_IDS
        const float* norm_ffn_post = a.in[7];
        float* MOD = (float*)(ws + WS_MOD);
        float* XMID = (float*)(ws + WS_XMID);
        float* TOPP = (float*)(ws + WS_TOPP);
        unsigned short* YB = (unsigned short*)(ws + WS_YB);
        for (int row = blockIdx.x; row < T; row += gridDim.x) {
            const int b = row / SEQ; const float* mod = MOD + (size_t)b * 6 * D; const int d0 = tid * 4;
            float ym[4] = {0.f, 0.f, 0.f, 0.f};
#pragma unroll
            for (int k = 0; k < TOPK; ++k) {
                const int asg = row * TOPK + k; const float p = TOPP[asg];
                const pg8::u32x2 v = *(const pg8::u32x2*)(YB + (size_t)asg * D + d0);
                ym[0] = fmaf(p, __uint_as_float(v.x << 16), ym[0]); ym[1] = fmaf(p, __uint_as_float(v.x & 0xffff0000u), ym[1]); ym[2] = fmaf(p, __uint_as_float(v.y << 16), ym[2]); ym[3] = fmaf(p, __uint_as_float(v.y & 0xffff0000u), ym[3]);
            }
            const float ss = block_sum(ym[0] * ym[0] + ym[1] * ym[1] + ym[2] * ym[2] + ym[3] * ym[3], sm);
            const float inv = rsqrtf(ss / D + EPS);
            const float4 xm = *(const float4*)(XMID + (size_t)row * D + d0);
            const float xa[4] = {xm.x, xm.y, xm.z, xm.w}; float o[4];
#pragma unroll
            for (int i = 0; i < 4; ++i) { const int d = d0 + i; o[i] = xa[i] + mod[5 * D + d] * (ym[i] * inv * norm_ffn_post[d]); }
            *(float4*)(a.out + (size_t)row * D + d0) = make_float4(o[0], o[1], o[2], o[3]);
        }
    }
#undef IN
#undef SEAM
}

constexpr int NPHASES = 13;
#ifndef MK_ONE_LAUNCH
#define MK_ONE_LAUNCH 1
#endif

extern "C" void kernel_launch(void* const* d_in, const int* in_sizes, int n_in, void* d_out, int out_size, void* d_ws, size_t ws_size, hipStream_t stream) {
    static int grid = 0;
    if (grid == 0) {
        if (n_in != 36 || out_size != T * D || ws_size < WS_END) { fprintf(stderr, "kernel_launch: unexpected shapes n_in %d out %d ws %zu (need %zu)\n", n_in, out_size, ws_size, (size_t)WS_END); grid = -1; return; }
        int dev = 0, cus = 0, per_cu = 0;
        if (hipGetDevice(&dev) != hipSuccess || hipDeviceGetAttribute(&cus, hipDeviceAttributeMultiprocessorCount, dev) != hipSuccess) { grid = -1; return; }
        if (hipFuncSetAttribute((const void*)fwd, hipFuncAttributeMaxDynamicSharedMemorySize, LDS_BYTES) != hipSuccess) { fprintf(stderr, "kernel_launch: hipFuncSetAttribute failed\n"); grid = -1; return; }
        if (hipOccupancyMaxActiveBlocksPerMultiprocessor(&per_cu, (const void*)fwd, NTHREADS, LDS_BYTES) != hipSuccess || per_cu < 1) { fprintf(stderr, "kernel_launch: occupancy query says %d\n", per_cu); }
        (void)hipGetLastError();
        grid = cus;
    }
    if (grid < 0) return;
    (void)hipMemsetAsync((char*)d_ws + WS_CTL, 0, CTL_BYTES, stream);
    Args a{};
    for (int i = 0; i < 36; ++i) a.in[i] = (const float*)d_in[i];
    a.out = (float*)d_out; a.ws = (unsigned char*)d_ws;
#if MK_ONE_LAUNCH
    a.ph_lo = 0; a.ph_hi = NPHASES;
    hipLaunchKernelGGL(fwd, dim3(grid), dim3(NTHREADS), LDS_BYTES, stream, a);
#else
    for (int p = 0; p < NPHASES; ++p) {
        a.ph_lo = p; a.ph_hi = p + 1;
        hipLaunchKernelGGL(fwd, dim3(grid), dim3(NTHREADS), LDS_BYTES, stream, a);
    }
#endif
}
```

```cpp
#include <hip/hip_runtime.h>
#include <cstdio>
#include <cstdint>

constexpr int D = 2048, NB = 4, SEQ = 4096, T = NB * SEQ;
constexpr int COL_K = 512, COL_V = 1024, COL_Z = 2048, COL_B = 3072, COL_A = 3080, COL_GATE = 3088, COL_R = 7184, COL_RK = 8208, COL_RV = 9232, N_IN = 10256;
constexpr int NE = 32, TOPK = 4, FF = 2048, NA = T * TOPK;
constexpr int RW = 1024;
constexpr float EPS = 1e-6f;
constexpr int NTHREADS = 512;
constexpr int LDS_BYTES = 128 * 1024 + 4096;

#define XB_TMO      128
#define XB_XCNT(j)  (256  + 64 * (j))
#define XB_XSUB(j)  (1280 + 64 * (j))
#define XB_XGEN(j)  (2304 + 64 * (j))
#define XB_TOP      3328
#define XB_TOPGEN   3392
#define XCD_BAR_WORDS 3456
#define XB_SPIN_CAP (1u << 22)
#define LAS __attribute__((address_space(3)))
__device__ __forceinline__ unsigned xb_ld(unsigned* p)              { return __hip_atomic_load(p, __ATOMIC_RELAXED, __HIP_MEMORY_SCOPE_AGENT); }
__device__ __forceinline__ unsigned xb_add(unsigned* p, unsigned v) { return __hip_atomic_fetch_add(p, v, __ATOMIC_RELAXED, __HIP_MEMORY_SCOPE_AGENT); }
__device__ __forceinline__ unsigned xb_xcc_id() { return (unsigned)__builtin_amdgcn_s_getreg((3 << 11) | 20) & 0xFu; }
#define XB_SPIN(cond, bar) do { unsigned _sp = 0; while (cond) { __builtin_amdgcn_s_sleep(1); \
    if ((++_sp & 255u) == 0u) { if (xb_ld(&(bar)[XB_TMO])) break; if (_sp > XB_SPIN_CAP) { atomicAdd(&(bar)[XB_TMO], 1u); break; } } } } while (0)
struct XcdBarrier { unsigned* bar; unsigned x; volatile LAS unsigned* st; };
__device__ __forceinline__ XcdBarrier xcd_barrier_post(unsigned* bar, volatile LAS unsigned* st) {
    XcdBarrier b; b.bar = bar; b.x = xb_xcc_id(); b.st = st;
    if (threadIdx.x == 0) (void)xb_add(&bar[XB_XCNT(b.x)], 1u);
    return b;
}
__device__ __forceinline__ void xcd_barrier_complete(unsigned* bar, unsigned x, unsigned& nloc, unsigned& nx) {
    const unsigned G = gridDim.x * gridDim.y * gridDim.z;
    unsigned sum, cnt, mine, sp = 0u;
    for (;;) {
        sum = 0u; cnt = 0u; mine = 0u;
#pragma unroll
        for (unsigned j = 0; j < 16; ++j) { const unsigned c = xb_ld(&bar[XB_XCNT(j)]); sum += c; cnt += (c > 0u) ? 1u : 0u; mine = (j == x) ? c : mine; }
        if (sum == G) break;
        __builtin_amdgcn_s_sleep(1);
        if ((++sp & 255u) == 0u) { if (xb_ld(&bar[XB_TMO])) break; if (sp > XB_SPIN_CAP) { atomicAdd(&bar[XB_TMO], 1u); break; } }
    }
    nloc = mine > 0u ? mine : 1u; nx = cnt > 0u ? cnt : 1u;
}
__device__ __forceinline__ void xcd_barrier(const XcdBarrier& b) {
    asm volatile("s_waitcnt vmcnt(0)" ::: "memory");
    __syncthreads();
    if (threadIdx.x == 0) {
        unsigned* bar = b.bar;
        __builtin_amdgcn_s_waitcnt(0);
        unsigned nloc = b.st[0], nx = b.st[1];
        if (nloc == 0u) { xcd_barrier_complete(bar, b.x, nloc, nx); b.st[0] = nloc; b.st[1] = nx; }
        const unsigned old = xb_add(&bar[XB_XSUB(b.x)], 1u);
        const unsigned gen = old / nloc;
        if (old + 1u == (gen + 1u) * nloc) {
            __builtin_amdgcn_fence(__ATOMIC_RELEASE, "agent");
            asm volatile("s_waitcnt vmcnt(0)" ::: "memory");
            const unsigned og = xb_add(&bar[XB_TOP], 1u);
            const unsigned tg = og / nx;
            if (og + 1u == (tg + 1u) * nx) xb_add(&bar[XB_TOPGEN], 1u);
            else XB_SPIN(xb_ld(&bar[XB_TOPGEN]) == tg, bar);
            __builtin_amdgcn_fence(__ATOMIC_ACQUIRE, "agent");
            xb_add(&bar[XB_XGEN(b.x)], 1u);
            asm volatile("s_waitcnt vmcnt(0)" ::: "memory");
        } else {
            XB_SPIN(xb_ld(&bar[XB_XGEN(b.x)]) == gen, bar);
            __builtin_amdgcn_fence(__ATOMIC_ACQUIRE, "agent");
            asm volatile("s_waitcnt vmcnt(0)" ::: "memory");
        }
    }
    __syncthreads();
}

constexpr size_t al256(size_t x) { return (x + 255) & ~(size_t)255; }
constexpr size_t WS_CTL   = 0;
constexpr size_t CTL_BYTES = 32768;
constexpr size_t CW_CNT   = XCD_BAR_WORDS + 64;
constexpr size_t WS_MOD   = WS_CTL + CTL_BYTES;
constexpr size_t WS_H     = al256(WS_MOD + (size_t)NB * 6 * D * 4);
constexpr size_t WS_WINT  = al256(WS_H + (size_t)7 * T * D * 2);
constexpr int NT_IN = 44;
constexpr size_t WS_PH    = al256(WS_WINT + (size_t)NT_IN * 256 * D * 2);
constexpr size_t WS_BA    = al256(WS_PH + (size_t)T * N_IN * 2);
constexpr size_t WS_LWA   = al256(WS_BA + (size_t)T * 16 * 4);
constexpr size_t WS_LGB   = al256(WS_LWA + (size_t)T * 256 * 2);
constexpr size_t WS_L2T   = al256(WS_LGB + (size_t)T * 256 * 2);
constexpr size_t WS_WPRE  = al256(WS_L2T + (size_t)3 * RW * 256 * 2);
constexpr size_t WS_APRE  = al256(WS_WPRE + (size_t)T * RW * 4);
constexpr size_t WS_GATE  = al256(WS_APRE + (size_t)T * RW * 4);
constexpr size_t WS_WD    = al256(WS_GATE + (size_t)T * RW * 4);
constexpr size_t WS_AA    = al256(WS_WD + (size_t)T * RW * 4);
constexpr size_t WS_BB    = al256(WS_AA + (size_t)T * RW * 4);
constexpr size_t WS_KM    = al256(WS_BB + (size_t)T * RW * 4);
constexpr size_t WS_OG    = al256(WS_KM + (size_t)T * RW * 4);
constexpr size_t WS_YR    = al256(WS_OG + (size_t)T * RW * 4);
constexpr size_t WS_MERGED= al256(WS_YR + (size_t)T * RW * 4);
constexpr size_t WS_Y     = al256(WS_MERGED + (size_t)T * D * 4);
constexpr size_t WS_XMID  = al256(WS_Y + (size_t)T * D * 4);
constexpr size_t WS_H2B   = al256(WS_XMID + (size_t)T * D * 4);
constexpr size_t WS_TOPP  = al256(WS_H2B + (size_t)T * D * 2);
constexpr size_t WS_LIST  = al256(WS_TOPP + (size_t)NA * 4);
constexpr int ACT_ROWS = NA + NE * 256;
constexpr size_t WS_ACT   = al256(WS_LIST + (size_t)NE * T * 4);
constexpr size_t WS_YB    = al256(WS_ACT + (size_t)ACT_ROWS * FF * 2);
constexpr size_t WS_WGU   = al256(WS_YB + (size_t)NA * D * 2);
constexpr size_t WS_WDN   = al256(WS_WGU + (size_t)NE * 2 * FF * D * 2);
constexpr size_t WS_YGB   = al256(WS_WDN + (size_t)NE * D * FF * 2);
constexpr size_t WS_YRWB  = al256(WS_YGB + (size_t)T * RW * 2);
constexpr size_t WS_WUPG  = al256(WS_YRWB + (size_t)T * RW * 2);
constexpr size_t WS_WUPR  = al256(WS_WUPG + (size_t)D * RW * 2);
constexpr size_t WS_WOUT  = al256(WS_WUPR + (size_t)D * RW * 2);
constexpr size_t WS_MRGB  = al256(WS_WOUT + (size_t)D * D * 2);
constexpr size_t WS_GREC  = al256(WS_MRGB + (size_t)T * D * 2);
constexpr size_t WS_END   = al256(WS_GREC + (size_t)2048 * 90368);

struct Args {
    const float* in[36];
    float* out;
    unsigned char* ws;
    int ph_lo, ph_hi;
};

__device__ __forceinline__ float sigmoidf_(float x) { return 1.0f / (1.0f + expf(-x)); }
__device__ __forceinline__ float siluf_(float x) { return x * sigmoidf_(x); }
__device__ __forceinline__ float softplusf_(float x) { return fmaxf(x, 0.0f) + log1pf(expf(-fabsf(x))); }
__device__ __forceinline__ float rl(float x, int k) { return __int_as_float(__builtin_amdgcn_readlane(__float_as_int(x), k)); }
__device__ __forceinline__ float wave_sum(float v) {
#pragma unroll
    for (int o = 32; o > 0; o >>= 1) v += __shfl_xor(v, o);
    return v;
}
__device__ __forceinline__ float half_sum(float v) {
#pragma unroll
    for (int o = 16; o > 0; o >>= 1) v += __shfl_xor(v, o);
    return v;
}
__device__ __forceinline__ float block_sum(float v, float* red) {
    v = wave_sum(v);
    __syncthreads();
    if ((threadIdx.x & 63) == 0) red[threadIdx.x >> 6] = v;
    __syncthreads();
    float t = 0.f;
#pragma unroll
    for (int w = 0; w < NTHREADS / 64; ++w) t += red[w];
    return t;
}

constexpr int GBM = 128, GBN = 64, GBK = 16;
template <bool DUAL, class AL, class EP>
__device__ __forceinline__ void gemm_naive(float* sm, int M, int N, int K, const AL& al, const float* __restrict__ W, int ldw, int dual_off, const EP& ep) {
    float* As = sm;
    float* Bs = sm + GBK * (GBM + 4);
    float* Bs2 = Bs + GBK * (GBN + 4);
    const int tid = threadIdx.x, tx = tid & 15, ty = tid >> 4;
    const int ntm = (M + GBM - 1) / GBM, ntn = (N + GBN - 1) / GBN;
    for (int tile = blockIdx.x; tile < ntm * ntn; tile += gridDim.x) {
        const int tm = tile / ntn, tn = tile % ntn;
        const int m0 = tm * GBM, n0 = tn * GBN;
        float acc[4][4], acc2[4][4];
#pragma unroll
        for (int i = 0; i < 4; ++i)
#pragma unroll
            for (int j = 0; j < 4; ++j) { acc[i][j] = 0.f; acc2[i][j] = 0.f; }
        for (int k0 = 0; k0 < K; k0 += GBK) {
#pragma unroll
            for (int i = 0; i < 4; ++i) { const int idx = tid + i * NTHREADS, r = idx >> 4, kk = idx & 15; As[kk * (GBM + 4) + r] = al(m0 + r, k0 + kk); }
#pragma unroll
            for (int i = 0; i < 2; ++i) { const int idx = tid + i * NTHREADS, kk = idx >> 6, c = idx & 63, n = n0 + c;
                Bs[kk * (GBN + 4) + c] = (n < N) ? W[(size_t)(k0 + kk) * ldw + n] : 0.f;
                if (DUAL) Bs2[kk * (GBN + 4) + c] = (n < N) ? W[(size_t)(k0 + kk) * ldw + n + dual_off] : 0.f; }
            __syncthreads();
#pragma unroll
            for (int kk = 0; kk < GBK; ++kk) {
                float a[4], b[4], b2[4];
#pragma unroll
                for (int i = 0; i < 4; ++i) a[i] = As[kk * (GBM + 4) + ty * 4 + i];
#pragma unroll
                for (int j = 0; j < 4; ++j) { b[j] = Bs[kk * (GBN + 4) + tx * 4 + j]; b2[j] = DUAL ? Bs2[kk * (GBN + 4) + tx * 4 + j] : 0.f; }
#pragma unroll
                for (int i = 0; i < 4; ++i)
#pragma unroll
                    for (int j = 0; j < 4; ++j) { acc[i][j] = fmaf(a[i], b[j], acc[i][j]); if (DUAL) acc2[i][j] = fmaf(a[i], b2[j], acc2[i][j]); }
            }
            __syncthreads();
        }
#pragma unroll
        for (int i = 0; i < 4; ++i)
#pragma unroll
            for (int j = 0; j < 4; ++j) { const int m = m0 + ty * 4 + i, n = n0 + tx * 4 + j; if (m < M && n < N) ep(m, n, acc[i][j], acc2[i][j]); }
    }
}

struct ALPlain { const float* A; int lda; __device__ __forceinline__ float operator()(int m, int k) const { return A[(size_t)m * lda + k]; } };
struct ALMix {
    const float* H; const float* mix;
    __device__ __forceinline__ float operator()(int m, int k) const {
        const float h = H[(size_t)m * D + k];
        const float hp = ((m % SEQ) == 0) ? 0.f : H[(size_t)(m - 1) * D + k];
        return h + (hp - h) * mix[k];
    }
};
struct ALGatherTok { const float* H2; const int* list; int cnt; __device__ __forceinline__ float operator()(int m, int k) const { return (m < cnt) ? H2[(size_t)(list[m] >> 2) * D + k] : 0.f; } };
struct ALGatherAsg { const float* ACT; const int* list; int cnt; __device__ __forceinline__ float operator()(int m, int k) const { return (m < cnt) ? ACT[(size_t)list[m] * FF + k] : 0.f; } };

namespace pg8 {
#define PG8_LAS __attribute__((address_space(3)))
typedef unsigned short bf16_t;
typedef short bf16x8 __attribute__((ext_vector_type(8)));
typedef float f32x4 __attribute__((ext_vector_type(4)));
typedef unsigned u32x4 __attribute__((ext_vector_type(4)));
typedef unsigned u32x2 __attribute__((ext_vector_type(2)));
constexpr int BM = 256, BK = 64, HALF = 128, HTB = HALF * BK * 2, STAGE_BYTES = 8 * HTB, NXCD = 8, WGM = 2;
__host__ __device__ __forceinline__ int lds_byte(int r, int c) { const int st = (r >> 4) * 2 + (c >> 5), rr = r & 15, cc = c & 31, ob = rr * 64 + cc * 2; return st * 1024 + (ob ^ (((ob >> 9) & 1) << 5)); }
__host__ __device__ __forceinline__ void stage_rc(int b, int& R, int& C) { const int st = b / 1024, sb = b % 1024, swz = sb ^ (((sb >> 9) & 1) << 5); R = (st >> 1) * 16 + swz / 64; C = (st & 1) * 32 + (swz % 64) / 2; }
__host__ __device__ __forceinline__ int perm32(int rho) { const int n = rho >> 4, i = rho & 15; return 8 * (i >> 2) + 4 * n + (i & 3); }
struct Unit { int pm, pn; const char* A; const char* B; const int* list; int cnt, e, prow, gat; };
typedef __bf16 bf16x2_t __attribute__((ext_vector_type(2)));
__device__ __forceinline__ unsigned cvt_pk_bf16(float lo, float hi) { bf16x2_t v; v.x = (__bf16)lo; v.y = (__bf16)hi; return __builtin_bit_cast(unsigned, v); }
__device__ __forceinline__ bool static_order(int nM, int nN, int G, int c, int i, int& pm, int& pn) {
    const int nwg = nM * nN; const long L = (long)i * G + c; if (L >= nwg) return false;
    int wgid = (int)L; { const int q = nwg / NXCD, r = nwg % NXCD, xcd = wgid % NXCD, off = wgid / NXCD; wgid = (xcd < r ? xcd * (q + 1) : r * (q + 1) + (xcd - r) * q) + off; }
    const int nig = WGM * nN, gid = wgid / nig, fm = gid * WGM, gsz = (nM - fm) < WGM ? (nM - fm) : WGM;
    pm = fm + ((wgid % nig) % gsz); pn = (wgid % nig) / gsz; return true;
}
template <class Epi, class Sched, bool ALIGN_EPI = true, bool GATHER = false, bool FP8 = false>
__device__ __forceinline__ void gemm_phase(PG8_LAS unsigned char* lds, const int K_, const Sched& S, const Epi& E) {
    const int tid = threadIdx.x, wid = __builtin_amdgcn_readfirstlane(tid >> 6), lane = tid & 63, wr = wid >> 2, wc = wid & 3, fr = lane & 15, fq = lane >> 4;
    const int K = K_, KB = FP8 ? K_ : 2 * K_, nt = KB / 128;
    unsigned voffA0, voffB0;
    { int R, C; stage_rc(tid * 16, R, C); const int Rb = Epi::PERM ? ((R & ~31) + perm32(R & 31)) : R;
      voffA0 = (unsigned)(R * KB + C * 2); voffB0 = (unsigned)(Rb * KB + C * 2); }
    const size_t pstep = (size_t)64 * KB;
    const size_t kstep = (size_t)(BK * 2);
    const size_t hstep = (size_t)HALF * KB;
    const size_t tstep = 2 * hstep; (void)tstep;
    const unsigned ldsw = (unsigned)wid * 1024u;
    const int cole = FP8 ? ((fq >> 1) * 32 + (fq & 1) * 16) : fq * 8;
    const int aoff = lds_byte(wr * 64 + fr, cole), boff = aoff + (wc * 2 - wr * 4) * 2048;
    typedef int _i8 __attribute__((ext_vector_type(8))); typedef _i8 _i8a __attribute__((aligned(16)));
    constexpr bool SP2 = true;
    unsigned vA_c[2][2];
    PG8_LAS unsigned* gtab = (PG8_LAS unsigned*)(lds + STAGE_BYTES + 1024);
#define PG8_FILLTAB(u) do { int _t = threadIdx.x; asm volatile("" : "+v"(_t));   if (_t < 256) { const int _m = (u).pm * 256 + _t; \
        const int _tok = (u).gat ? ((_m < (u).cnt) ? ((u).list[_m] >> 2) : 0) : _t;     \
        gtab[_t] = (unsigned)_tok * (unsigned)KB; } } while (0)
#define PG8_SETVA(v, u) do { int _t2 = threadIdx.x; if constexpr (GATHER) asm volatile("" : "+v"(_t2)); _Pragma("unroll") for (int _h = 0; _h < 2; ++_h) _Pragma("unroll") for (int _i = 0; _i < 2; ++_i) { \
        if constexpr (GATHER) { int _R, _C; stage_rc(_t2 * 16 + _i * 8192, _R, _C); (v)[_h][_i] = gtab[_h * 128 + _R] + (unsigned)(_C * 2); } \
        else (v)[_h][_i] = 0u; } } while (0)
#define PG8_STAGE_A(bufoff, gbase, h, nx) do { _Pragma("unroll") for (int _i = 0; _i < 2; ++_i) { \
        const char* _src = GATHER ? (const char*)(gbase) + vA_c[h][_i] : (const char*)(gbase) + (size_t)(h) * hstep + (size_t)_i * pstep + voffA0; \
        __builtin_amdgcn_global_load_lds((const unsigned*)_src, (PG8_LAS unsigned*)(lds + (bufoff) + ldsw + _i * 8192), 16, 0, 0); } } while (0)
#define PG8_SA(b, h) (((b) * 2 + (h)) * HTB)
#define PG8_SB(b, h) ((4 + (b) * 2 + (h)) * HTB)
#define PG8_STAGE(bufoff, gbase, voff) do { _Pragma("unroll") for (int _i = 0; _i < 2; ++_i) \
        __builtin_amdgcn_global_load_lds((const unsigned*)((const char*)(gbase) + (size_t)_i * pstep + voff##0), (PG8_LAS unsigned*)(lds + (bufoff) + ldsw + _i * 8192), 16, 0, 0); } while (0)
#define PG8_LDA(dst, b, h) do { _Pragma("unroll") for (int m = 0; m < 4; ++m) { \
        if constexpr (FP8) { dst##8[m] = *(const PG8_LAS _i8a*)(lds + PG8_SA(b, h) + aoff + m * 2048); } \
        else { _Pragma("unroll") for (int k = 0; k < 2; ++k) dst[m][k] = *(const PG8_LAS bf16x8*)(lds + PG8_SA(b, h) + aoff + m * 2048 + k * 1024); } } } while (0)
#define PG8_LDB(dst, b, h) do { _Pragma("unroll") for (int n = 0; n < 2; ++n) { \
        if constexpr (FP8) { dst##8[n] = *(const PG8_LAS _i8a*)(lds + PG8_SB(b, h) + boff + n * 2048); } \
        else { _Pragma("unroll") for (int k = 0; k < 2; ++k) dst[n][k] = *(const PG8_LAS bf16x8*)(lds + PG8_SB(b, h) + boff + n * 2048 + k * 1024); } } } while (0)
#define PG8_MMA(ai, bj, At, Bt) do { __builtin_amdgcn_s_setprio(1); _Pragma("unroll") for (int m = 0; m < 4; ++m) _Pragma("unroll") for (int n = 0; n < 2; ++n) { \
        if constexpr (FP8) acc[ai][bj][m][n] = __builtin_amdgcn_mfma_scale_f32_16x16x128_f8f6f4(Bt##8[n], At##8[m], acc[ai][bj][m][n], 0, 0, 0, 127, 0, 127); \
        else { _Pragma("unroll") for (int k = 0; k < 2; ++k) acc[ai][bj][m][n] = __builtin_amdgcn_mfma_f32_16x16x32_bf16(Bt[n][k], At[m][k], acc[ai][bj][m][n], 0, 0, 0); } } \
        __builtin_amdgcn_s_setprio(0); } while (0)
#define PG8_WAIT_V(n) asm volatile("s_waitcnt vmcnt(" #n ")" ::: "memory")
#define PG8_WAIT_L(n) asm volatile("s_waitcnt lgkmcnt(" #n ")" ::: "memory")
#define PG8_BAR __builtin_amdgcn_s_barrier()
#define PG8_SCHED __builtin_amdgcn_sched_barrier(0)
    Unit cur, nxt; int ui = 0;
    if (!S.next(0, cur)) return;
    f32x4 acc[2][2][4][2];
#pragma unroll
    for (int a = 0; a < 2; ++a)
#pragma unroll
        for (int b = 0; b < 2; ++b)
#pragma unroll
            for (int m = 0; m < 4; ++m)
#pragma unroll
                for (int n = 0; n < 2; ++n) acc[a][b][m][n] = (f32x4){0.f, 0.f, 0.f, 0.f};
    bf16x8 At[4][2], B0[2][2], B1[2][2]; _i8 At8[4], B08[2], B18[2];
    const char* cA = cur.A; const char* cB = cur.B;
    S.a_ready(cur);
    if constexpr (GATHER) { PG8_FILLTAB(cur); __syncthreads(); }
    PG8_SETVA(vA_c, cur);
    if constexpr (GATHER) __syncthreads();
    if constexpr (SP2) {
        PG8_STAGE(PG8_SB(0, 0), cB, voffB); PG8_STAGE(PG8_SB(0, 1), cB + hstep, voffB); PG8_STAGE_A(PG8_SA(0, 0), cA, 0, false); PG8_STAGE_A(PG8_SA(0, 1), cA, 1, false);
        if (wr == 1) PG8_BAR;
        PG8_WAIT_V(2); PG8_BAR;
        PG8_STAGE(PG8_SB(1, 0), cB + kstep, voffB); PG8_STAGE_A(PG8_SA(1, 0), cA + kstep, 0, false); PG8_STAGE(PG8_SB(1, 1), cB + hstep + kstep, voffB);
        PG8_WAIT_V(6); PG8_BAR;
    }
    for (;;) {
        const bool has_next = S.next(ui + 1, nxt);
        const char* nA = has_next ? nxt.A : cA; const char* nB = has_next ? nxt.B : cB;
        if constexpr (GATHER) { if (has_next) PG8_FILLTAB(nxt); }
        for (int t = 0; t < nt; t += 2) {
            const bool last = (t == nt - 2); const bool lastn = last && has_next; (void)lastn;
            const char* a1 = cA + (size_t)(t + 1) * kstep;
            const char* a2 = last ? nA : cA + (size_t)(t + 2) * kstep; const char* b2 = last ? nB : cB + (size_t)(t + 2) * kstep;
            const char* a3 = a2 + kstep; const char* b3 = b2 + kstep;
            if (last && has_next) S.a_ready(nxt);
            if constexpr (SP2) {
            PG8_LDB(B0, 0, 0); PG8_LDB(B1, 0, 1); PG8_SCHED; PG8_LDA(At, 0, 0); PG8_STAGE_A(PG8_SA(1, 1), a1, 1, false);
            PG8_WAIT_V(8); PG8_WAIT_L(0); PG8_BAR; PG8_MMA(0, 0, At, B0); PG8_MMA(0, 1, At, B1); PG8_BAR; PG8_SCHED;
            if constexpr (GATHER) { if (lastn) PG8_SETVA(vA_c, nxt); }
            PG8_LDA(At, 0, 1); PG8_STAGE(PG8_SB(0, 0), b2, voffB); PG8_STAGE(PG8_SB(0, 1), b2 + hstep, voffB); PG8_STAGE_A(PG8_SA(0, 0), a2, 0, lastn);
            PG8_WAIT_V(8); PG8_WAIT_L(0); PG8_BAR; PG8_MMA(1, 0, At, B0); PG8_MMA(1, 1, At, B1); PG8_BAR; PG8_SCHED;
            PG8_LDB(B0, 1, 0); PG8_LDB(B1, 1, 1); PG8_SCHED; PG8_LDA(At, 1, 0); PG8_STAGE_A(PG8_SA(0, 1), a2, 1, lastn);
            PG8_WAIT_V(8); PG8_WAIT_L(0); PG8_BAR; PG8_MMA(0, 0, At, B0); PG8_MMA(0, 1, At, B1); PG8_BAR; PG8_SCHED;
            PG8_LDA(At, 1, 1); PG8_STAGE(PG8_SB(1, 0), b3, voffB); PG8_STAGE(PG8_SB(1, 1), b3 + hstep, voffB); PG8_STAGE_A(PG8_SA(1, 0), a3, 0, lastn);
            PG8_WAIT_V(8); PG8_WAIT_L(0); PG8_BAR; PG8_MMA(1, 0, At, B0); PG8_MMA(1, 1, At, B1); PG8_BAR; PG8_SCHED;
            }
        }
        if constexpr (ALIGN_EPI) { if (wr == 0) PG8_BAR; }
        asm volatile("" ::: "memory");
        bool chained = false;
        if constexpr (!Epi::AFTER_DRAIN) { if constexpr (Epi::CHAIN) { if (cur.e == 0) { E.mid(acc, cur, wr, wc, fr, fq); chained = true; } else E(acc, cur, wr, wc, fr, fq); } else E(acc, cur, wr, wc, fr, fq); S.done(cur); }
        if (!has_next) break;
        if (!chained) {
#pragma unroll
        for (int a = 0; a < 2; ++a)
#pragma unroll
            for (int b = 0; b < 2; ++b)
#pragma unroll
                for (int m = 0; m < 4; ++m)
#pragma unroll
                    for (int n = 0; n < 2; ++n) acc[a][b][m][n] = (f32x4){0.f, 0.f, 0.f, 0.f};
        }
        cur = nxt; cA = nA; cB = nB; ++ui;
        if constexpr (ALIGN_EPI) { if (wr == 1) PG8_BAR; }
    }
    PG8_WAIT_V(0);
    if constexpr (!ALIGN_EPI) { if (wr == 0) PG8_BAR; }
    PG8_BAR;
    if constexpr (Epi::AFTER_DRAIN) { E.fused(acc, cur, wr, wc, fr, fq, lds, wid, lane); S.done(cur); }
#undef PG8_SA
#undef PG8_SB
#undef PG8_STAGE
#undef PG8_STAGE_A
#undef PG8_SETVA
#undef PG8_FILLTAB
#undef PG8_LDA
#undef PG8_LDB
#undef PG8_MMA
#undef PG8_WAIT_V
#undef PG8_WAIT_L
#undef PG8_BAR
#undef PG8_SCHED
}
}


typedef float f32x4_t __attribute__((ext_vector_type(4)));
__device__ __forceinline__ f32x4_t ld_bf4(const unsigned short* p) { const pg8::u32x2 v = *(const pg8::u32x2*)p; return (f32x4_t){__uint_as_float(v.x << 16), __uint_as_float(v.x & 0xffff0000u), __uint_as_float(v.y << 16), __uint_as_float(v.y & 0xffff0000u)}; }
__device__ __forceinline__ void ld_bf8(const unsigned short* p, f32x4_t& lo, f32x4_t& hi) { const pg8::u32x4 v = *(const pg8::u32x4*)p;
    lo = (f32x4_t){__uint_as_float(v.x << 16), __uint_as_float(v.x & 0xffff0000u), __uint_as_float(v.y << 16), __uint_as_float(v.y & 0xffff0000u)};
    hi = (f32x4_t){__uint_as_float(v.z << 16), __uint_as_float(v.z & 0xffff0000u), __uint_as_float(v.w << 16), __uint_as_float(v.w & 0xffff0000u)}; }
__device__ __forceinline__ float ld_bf1(const unsigned short* p) { return __uint_as_float((unsigned)(*p) << 16); }
struct SchedInProj {
    int G, c; const char* Abase; const char* Bt;
    __device__ __forceinline__ bool next(int i, pg8::Unit& u) const {
        int pm, pn; if (!pg8::static_order(T / 256, NT_IN, G, c, i, pm, pn)) return false;
        const int ai = pn < 29 ? 0 : pn < 33 ? 1 : pn < 37 ? 3 : pn < 41 ? 4 : pn == 41 ? 2 : pn == 42 ? 5 : 6;
        u.pm = pm; u.pn = pn; u.A = Abase + ((size_t)ai * T + (size_t)pm * 256) * D * 2; u.B = Bt + (size_t)pn * 256 * D * 2; u.list = nullptr; u.cnt = 0; u.e = 0; u.prow = 0; u.gat = 0; return true;
    }
    __device__ __forceinline__ void a_ready(const pg8::Unit&) const {}
    __device__ __forceinline__ void done(const pg8::Unit&) const {}
};
__device__ __forceinline__ float fast_sigmoid(float x) { return __builtin_amdgcn_rcpf(1.0f + __builtin_amdgcn_exp2f(-1.4426950408889634f * x)); }
__device__ __forceinline__ float fast_tanh(float x) { return 1.0f - 2.0f * __builtin_amdgcn_rcpf(1.0f + __builtin_amdgcn_exp2f(2.8853900817779268f * x)); }
struct EpiInProjF32 {
    static constexpr bool PERM = true, AFTER_DRAIN = false, CHAIN = false;
    unsigned short* PH; float* BA; unsigned short* LWA; unsigned short* LGB;
    __device__ __forceinline__ void operator()(const pg8::f32x4 (&acc)[2][2][4][2], const pg8::Unit& u, int wr, int wc, int fr, int fq) const {
        const int pn = u.pn; unsigned short* b16 = PH; unsigned ld = N_IN; int ncol = 256, act = 0;
        if (pn < 12) b16 = PH + pn * 256;
        else if (pn < 28) { b16 = PH + COL_GATE + (pn - 12) * 256; act = 2; }
        else if (pn == 28) { act = 4; ncol = 16; }
        else if (pn < 41) b16 = PH + COL_R + (pn - 29) * 256;
        else if (pn == 41) { act = 1; ncol = 128; b16 = LWA; ld = 256; }
        else if (pn == 42) { act = 3; ncol = 128; b16 = LWA + 128; ld = 256; }
        else { act = 2; b16 = LGB; ld = 256; }
        const unsigned row0 = (unsigned)u.pm * 256u + wr * 64 + fr;
#pragma unroll
        for (int ai = 0; ai < 2; ++ai)
#pragma unroll
            for (int m = 0; m < 4; ++m) {
                const unsigned row = row0 + ai * 128 + m * 16;
#pragma unroll
                for (int bj = 0; bj < 2; ++bj) {
                    const int cl = bj * 128 + wc * 32 + 8 * fq;
                    pg8::f32x4 v0 = acc[ai][bj][m][0], v1 = acc[ai][bj][m][1];
                    if (act == 4) { if (cl < ncol) { float* dst = BA + (size_t)row * 16 + cl; *(pg8::f32x4*)dst = v0; *(pg8::f32x4*)(dst + 4) = v1; } }
                    else {
                        if (act == 1) {
#pragma unroll
                            for (int j = 0; j < 4; ++j) { v0[j] = fast_tanh(v0[j]); v1[j] = fast_tanh(v1[j]); } }
                        if (act == 2) {
#pragma unroll
                            for (int j = 0; j < 4; ++j) { v0[j] = fast_sigmoid(v0[j]); v1[j] = fast_sigmoid(v1[j]); } }
                        if ((act == 1 || act == 3) && cl >= 96) { v0 = (pg8::f32x4){0.f, 0.f, 0.f, 0.f}; v1 = v0; }
                        if (cl < ncol) { pg8::u32x4 w; w.x = pg8::cvt_pk_bf16(v0[0], v0[1]); w.y = pg8::cvt_pk_bf16(v0[2], v0[3]); w.z = pg8::cvt_pk_bf16(v1[0], v1[1]); w.w = pg8::cvt_pk_bf16(v1[2], v1[3]);
                            *(pg8::u32x4*)(b16 + (size_t)row * ld + cl) = w; }
                    }
                }
            }
    }
};
struct SchedLora {
    int G, c; const char* LWA; const char* LGB; const char* L2T;
    __device__ __forceinline__ bool next(int i, pg8::Unit& u) const {
        int pm, pn; if (!pg8::static_order(T / 256, 12, G, c, i, pm, pn)) return false;
        const int g = pn >> 2;
        u.pm = pm; u.pn = pn; u.e = g; u.A = (g < 2 ? LWA : LGB) + (size_t)pm * 256 * 256 * 2; u.B = L2T + ((size_t)g * RW + (size_t)(pn & 3) * 256) * 256 * 2; u.list = nullptr; u.cnt = 0; u.prow = 0; u.gat = 0; return true;
    }
    __device__ __forceinline__ void a_ready(const pg8::Unit&) const {}
    __device__ __forceinline__ void done(const pg8::Unit&) const {}
};
struct EpiLora {
    static constexpr bool PERM = true, AFTER_DRAIN = false, CHAIN = false;
    float* WPRE; float* APRE; float* GATE; const float* w0; const float* a0;
    __device__ __forceinline__ void operator()(const pg8::f32x4 (&acc)[2][2][4][2], const pg8::Unit& u, int wr, int wc, int fr, int fq) const {
        const int g = u.e; float* C = g == 0 ? WPRE : g == 1 ? APRE : GATE; const float* bias = g == 0 ? w0 : a0;
        const unsigned row0 = (unsigned)u.pm * 256u + wr * 64 + fr; const int col0 = (u.pn & 3) * 256 + wc * 32 + 8 * fq;
        pg8::f32x4 bv[2][2];
#pragma unroll
        for (int bj = 0; bj < 2; ++bj)
#pragma unroll
            for (int n = 0; n < 2; ++n) bv[bj][n] = (g < 2) ? *(const pg8::f32x4*)(bias + col0 + 128 * bj + 4 * n) : (pg8::f32x4){0.f, 0.f, 0.f, 0.f};
#pragma unroll
        for (int ai = 0; ai < 2; ++ai)
#pragma unroll
            for (int m = 0; m < 4; ++m) {
                float* rp = C + (size_t)(row0 + ai * 128 + m * 16) * RW + col0;
#pragma unroll
                for (int bj = 0; bj < 2; ++bj) { *(pg8::f32x4*)(rp + 128 * bj) = acc[ai][bj][m][0] + bv[bj][0]; *(pg8::f32x4*)(rp + 128 * bj + 4) = acc[ai][bj][m][1] + bv[bj][1]; }
            }
    }
};

struct SchedMoE {
    int G, c, nN, nrows; const LAS int* tab; const int* LIST; const char* Abase; const char* W; bool gatherA; int esz;
    __device__ __forceinline__ bool next(int i, pg8::Unit& u) const {
        const int L = i * G + c; const int total = __builtin_amdgcn_readfirstlane(tab[32]) * nN; if (L >= total) return false;
        int e = 0;
        for (int k = 1; k < NE; ++k) if (__builtin_amdgcn_readfirstlane(tab[k]) * nN <= L) e = k;
        const int t0 = __builtin_amdgcn_readfirstlane(tab[e]), t1 = __builtin_amdgcn_readfirstlane(tab[e + 1]);
        const int q = L - t0 * nN, mt = t1 - t0;
        u.pm = q % mt; u.pn = q / mt; u.e = e; u.cnt = __builtin_amdgcn_readfirstlane(tab[128 + e]); u.list = LIST + (size_t)e * T; u.prow = t0 * 256 + u.pm * 256;
        u.gat = gatherA ? 1 : 0; u.A = gatherA ? Abase : Abase + (size_t)u.prow * D * esz;
        u.B = W + ((size_t)e * nrows + (size_t)u.pn * 256) * D * esz; return true;
    }
    __device__ __forceinline__ void a_ready(const pg8::Unit&) const {}
    __device__ __forceinline__ void done(const pg8::Unit&) const {}
};
struct EpiGU {
    static constexpr bool PERM = true, AFTER_DRAIN = false, CHAIN = false;
    unsigned char* ACT; const float* bgu;
    __device__ __forceinline__ void operator()(const pg8::f32x4 (&acc)[2][2][4][2], const pg8::Unit& u, int wr, int wc, int fr, int fq) const {
        const float* bg = bgu + (size_t)u.e * 2 * FF; const int f0 = 128 * u.pn + 16 * wc + 4 * fq;
        pg8::f32x4 bgv[2], buv[2];
#pragma unroll
        for (int bj = 0; bj < 2; ++bj) { bgv[bj] = *(const pg8::f32x4*)(bg + f0 + 64 * bj); buv[bj] = *(const pg8::f32x4*)(bg + FF + f0 + 64 * bj); }
        const unsigned row0 = (unsigned)u.prow + wr * 64 + fr;
#pragma unroll
        for (int ai = 0; ai < 2; ++ai)
#pragma unroll
            for (int m = 0; m < 4; ++m) {
                const unsigned row = row0 + ai * 128 + m * 16;
#pragma unroll
                for (int bj = 0; bj < 2; ++bj) {
                    const pg8::f32x4 g = acc[ai][bj][m][0] * 0.015625f + bgv[bj], up = acc[ai][bj][m][1] * 0.015625f + buv[bj];
                    float a[4];
#pragma unroll
                    for (int j = 0; j < 4; ++j) { const float gl = fminf(g[j], 7.0f), ul = fminf(fmaxf(up[j], -7.0f), 7.0f); a[j] = gl * fast_sigmoid(1.702f * gl) * (ul + 1.0f); }
                    int w8 = __builtin_amdgcn_cvt_pk_fp8_f32(a[0] * 4.0f, a[1] * 4.0f, 0, false); w8 = __builtin_amdgcn_cvt_pk_fp8_f32(a[2] * 4.0f, a[3] * 4.0f, w8, true);
                    *(int*)(ACT + (size_t)row * FF + f0 + 64 * bj) = w8;
                }
            }
    }
};
struct EpiDown {
    static constexpr bool PERM = true, AFTER_DRAIN = false, CHAIN = false;
    unsigned short* YB; const float* bd;
    __device__ __forceinline__ void operator()(const pg8::f32x4 (&acc)[2][2][4][2], const pg8::Unit& u, int wr, int wc, int fr, int fq) const {
        const float* b = bd + (size_t)u.e * D; const int col0 = u.pn * 256 + wc * 32 + 8 * fq;
        pg8::f32x4 bv[2][2];
#pragma unroll
        for (int bj = 0; bj < 2; ++bj)
#pragma unroll
            for (int n = 0; n < 2; ++n) bv[bj][n] = *(const pg8::f32x4*)(b + col0 + 128 * bj + 4 * n);
        const int ml0 = u.pm * 256 + wr * 64 + fr;
#pragma unroll
        for (int ai = 0; ai < 2; ++ai)
#pragma unroll
            for (int m = 0; m < 4; ++m) {
                const int ml = ml0 + ai * 128 + m * 16;
                if (ml < u.cnt) {
                    const unsigned asg = (unsigned)u.list[ml];
#pragma unroll
                    for (int bj = 0; bj < 2; ++bj) {
                        const pg8::f32x4 v0 = acc[ai][bj][m][0] * 0.00390625f + bv[bj][0], v1 = acc[ai][bj][m][1] * 0.00390625f + bv[bj][1];
                        pg8::u32x4 w; w.x = pg8::cvt_pk_bf16(v0[0], v0[1]); w.y = pg8::cvt_pk_bf16(v0[2], v0[3]); w.z = pg8::cvt_pk_bf16(v1[0], v1[1]); w.w = pg8::cvt_pk_bf16(v1[2], v1[3]);
                        *(pg8::u32x4*)(YB + (size_t)asg * D + col0 + 128 * bj) = w;
                    }
                }
            }
    }
};
__device__ __forceinline__ void moe_tables(LAS int* tab, const unsigned* CNT) {
    if (threadIdx.x == 0) {
        int acc = 0;
        for (int e = 0; e < NE; ++e) { const int c = (int)__hip_atomic_load(&CNT[e], __ATOMIC_RELAXED, __HIP_MEMORY_SCOPE_AGENT); tab[e] = acc; tab[64 + e] = acc * 256; tab[128 + e] = c; acc += (c + 255) >> 8; }
        tab[32] = acc; tab[96] = acc * 256;
    }
    __syncthreads();
}
__device__ __forceinline__ float bf2f(unsigned short h) { return __uint_as_float((unsigned)h << 16); }


__device__ __forceinline__ f32x4_t fmaxf_v(f32x4_t v) { return (f32x4_t){fmaxf(v[0], 1e-30f), fmaxf(v[1], 1e-30f), fmaxf(v[2], 1e-30f), fmaxf(v[3], 1e-30f)}; }
struct SchedUp {
    int G, c; const char* A0; const char* A1; const char* B0; const char* B1;
    __device__ __forceinline__ bool next(int i, pg8::Unit& u) const {
        int pm, pn; if (!pg8::static_order(T / 256, D / 256, G, c, i >> 1, pm, pn)) return false;
        const int sb = i & 1;
        u.pm = pm; u.pn = pn; u.e = sb; u.A = (sb ? A1 : A0) + (size_t)pm * 256 * RW * 2; u.B = (sb ? B1 : B0) + (size_t)pn * 256 * RW * 2; u.list = nullptr; u.cnt = 0; u.prow = 0; u.gat = 0; return true;
    }
    __device__ __forceinline__ void a_ready(const pg8::Unit&) const {}
    __device__ __forceinline__ void done(const pg8::Unit&) const {}
};
struct EpiUp {
    static constexpr bool PERM = true, AFTER_DRAIN = false, CHAIN = true;
    unsigned short* MB; const unsigned short* PH;
    __device__ __forceinline__ void mid(pg8::f32x4 (&acc)[2][2][4][2], const pg8::Unit& u, int wr, int wc, int fr, int fq) const {
        const unsigned row0 = (unsigned)u.pm * 256u + wr * 64 + fr; const int col0 = u.pn * 256 + wc * 32 + 8 * fq;
#pragma unroll
        for (int ai = 0; ai < 2; ++ai)
#pragma unroll
            for (int m = 0; m < 4; ++m) {
                const unsigned row = row0 + ai * 128 + m * 16;
#pragma unroll
                for (int bj = 0; bj < 2; ++bj) {
                    const int col = col0 + 128 * bj;
                    f32x4_t a0, a1, b0, b1; ld_bf8(PH + (size_t)row * N_IN + COL_GATE + col, a0, a1); ld_bf8(PH + (size_t)row * N_IN + COL_GATE + D + col, b0, b1);
#pragma unroll
                    for (int j = 0; j < 4; ++j) { acc[ai][bj][m][0][j] *= a0[j] * __builtin_amdgcn_rcpf(fmaxf(b0[j], 1e-30f)); acc[ai][bj][m][1][j] *= a1[j] * __builtin_amdgcn_rcpf(fmaxf(b1[j], 1e-30f)); }
                }
            }
    }
    __device__ __forceinline__ void operator()(const pg8::f32x4 (&acc)[2][2][4][2], const pg8::Unit& u, int wr, int wc, int fr, int fq) const {
        const unsigned row0 = (unsigned)u.pm * 256u + wr * 64 + fr; const int col0 = u.pn * 256 + wc * 32 + 8 * fq;
#pragma unroll
        for (int ai = 0; ai < 2; ++ai)
#pragma unroll
            for (int m = 0; m < 4; ++m) {
                const unsigned row = row0 + ai * 128 + m * 16;
#pragma unroll
                for (int bj = 0; bj < 2; ++bj) {
                    const int col = col0 + 128 * bj;
                    f32x4_t b0, b1; ld_bf8(PH + (size_t)row * N_IN + COL_GATE + D + col, b0, b1);
                    const pg8::f32x4 v0 = acc[ai][bj][m][0] * fmaxf_v(b0), v1 = acc[ai][bj][m][1] * fmaxf_v(b1);
                    pg8::u32x4 w; w.x = pg8::cvt_pk_bf16(v0[0], v0[1]); w.y = pg8::cvt_pk_bf16(v0[2], v0[3]); w.z = pg8::cvt_pk_bf16(v1[0], v1[1]); w.w = pg8::cvt_pk_bf16(v1[2], v1[3]);
                    *(pg8::u32x4*)(MB + (size_t)row * D + col) = w;
                }
            }
    }
};
struct SchedPlain {
    int G, c, nM, nN, K; const char* A; const char* B;
    __device__ __forceinline__ bool next(int i, pg8::Unit& u) const {
        int pm, pn; if (!pg8::static_order(nM, nN, G, c, i, pm, pn)) return false;
        u.pm = pm; u.pn = pn; u.e = 0; u.A = A + (size_t)pm * 256 * K * 2; u.B = B + (size_t)pn * 256 * K * 2; u.list = nullptr; u.cnt = 0; u.prow = 0; u.gat = 0; return true;
    }
    __device__ __forceinline__ void a_ready(const pg8::Unit&) const {}
    __device__ __forceinline__ void done(const pg8::Unit&) const {}
};
struct EpiF32 {
    static constexpr bool PERM = true, AFTER_DRAIN = false, CHAIN = false;
    unsigned short* C; int ldc;
    __device__ __forceinline__ void operator()(const pg8::f32x4 (&acc)[2][2][4][2], const pg8::Unit& u, int wr, int wc, int fr, int fq) const {
        const unsigned row0 = (unsigned)u.pm * 256u + wr * 64 + fr; const int col0 = u.pn * 256 + wc * 32 + 8 * fq;
#pragma unroll
        for (int ai = 0; ai < 2; ++ai)
#pragma unroll
            for (int m = 0; m < 4; ++m) {
                unsigned short* rp = C + (size_t)(row0 + ai * 128 + m * 16) * ldc + col0;
#pragma unroll
                for (int bj = 0; bj < 2; ++bj) { const pg8::f32x4 v0 = acc[ai][bj][m][0], v1 = acc[ai][bj][m][1];
                    pg8::u32x4 w; w.x = pg8::cvt_pk_bf16(v0[0], v0[1]); w.y = pg8::cvt_pk_bf16(v0[2], v0[3]); w.z = pg8::cvt_pk_bf16(v1[0], v1[1]); w.w = pg8::cvt_pk_bf16(v1[2], v1[3]);
                    *(pg8::u32x4*)(rp + 128 * bj) = w; }
            }
    }
};

#define LDS_WAIT() asm volatile("s_waitcnt lgkmcnt(0)" ::: "memory")
template <class F, class FK>
__device__ __forceinline__ void cvt_item_k(const float* __restrict__ W, int ldw, int K, const F& srccol, const FK& srcrow, unsigned short* WT, int row0, int kb, LAS float* scr, int lane) {
    const int n = lane & 31, k0 = kb * 64; const int sc = srccol(row0 + n);
#pragma unroll 8
    for (int i = 0; i < 32; ++i) { const int kk = 2 * i + (lane >> 5); const int sr = srcrow(k0 + kk); scr[kk * 33 + n] = (sc >= 0 && sr >= 0) ? W[(size_t)sr * ldw + sc] : 0.f; }
    LDS_WAIT();
    const int c = lane & 7;
#pragma unroll
    for (int j = 0; j < 4; ++j) { const int n2 = (lane >> 3) + 8 * j; const LAS float* sp = scr + (8 * c) * 33 + n2;
        pg8::u32x4 o; o.x = pg8::cvt_pk_bf16(sp[0 * 33], sp[1 * 33]); o.y = pg8::cvt_pk_bf16(sp[2 * 33], sp[3 * 33]); o.z = pg8::cvt_pk_bf16(sp[4 * 33], sp[5 * 33]); o.w = pg8::cvt_pk_bf16(sp[6 * 33], sp[7 * 33]);
        *(pg8::u32x4*)(WT + (size_t)(row0 + n2) * K + k0 + 8 * c) = o; }
    LDS_WAIT();
}
template <class F>
__device__ __forceinline__ void cvt_item(const float* __restrict__ W, int ldw, int K, const F& srccol, unsigned short* WT, int row0, int kb, LAS float* scr, int lane) {
    auto idk = [](int k) { return k; };
    cvt_item_k(W, ldw, K, srccol, idk, WT, row0, kb, scr, lane);
}
template <class FM, class FK>
__device__ __forceinline__ void cvt64(const float* __restrict__ W, int ldw, int K, const FM& map4, const FK& srcrow, unsigned short* __restrict__ WT, int row0, int kb, int lane) {
    const int n4 = lane & 15, kg = lane >> 4, k0 = kb * 64 + 16 * kg;
    int sc, dr; map4(row0, n4, sc, dr);
    f32x4_t v[16];
#pragma unroll
    for (int kk = 0; kk < 16; ++kk) { const int sr = srcrow(k0 + kk); v[kk] = (sc >= 0 && sr >= 0) ? *(const f32x4_t*)(W + (size_t)sr * ldw + sc) : (f32x4_t){0.f, 0.f, 0.f, 0.f}; }
#pragma unroll
    for (int j = 0; j < 4; ++j) {
        pg8::u32x4 o0, o1;
        o0.x = pg8::cvt_pk_bf16(v[0][j], v[1][j]); o0.y = pg8::cvt_pk_bf16(v[2][j], v[3][j]); o0.z = pg8::cvt_pk_bf16(v[4][j], v[5][j]); o0.w = pg8::cvt_pk_bf16(v[6][j], v[7][j]);
        o1.x = pg8::cvt_pk_bf16(v[8][j], v[9][j]); o1.y = pg8::cvt_pk_bf16(v[10][j], v[11][j]); o1.z = pg8::cvt_pk_bf16(v[12][j], v[13][j]); o1.w = pg8::cvt_pk_bf16(v[14][j], v[15][j]);
        unsigned short* dst = WT + (size_t)(dr + j) * K + k0;
        *(pg8::u32x4*)dst = o0; *(pg8::u32x4*)(dst + 8) = o1;
    }
}
template <class FM, class FK>
__device__ __forceinline__ void cvt64_f8(const float* __restrict__ W, int ldw, int K, const FM& map4, const FK& srcrow, unsigned char* __restrict__ WT, int row0, int kb, int lane, float scale) {
    const int n4 = lane & 15, kg = lane >> 4, k0 = kb * 64 + 16 * kg;
    int sc, dr; map4(row0, n4, sc, dr);
    f32x4_t v[16];
#pragma unroll
    for (int kk = 0; kk < 16; ++kk) { const int sr = srcrow(k0 + kk); v[kk] = (sc >= 0 && sr >= 0) ? *(const f32x4_t*)(W + (size_t)sr * ldw + sc) * scale : (f32x4_t){0.f, 0.f, 0.f, 0.f}; }
#pragma unroll
    for (int j = 0; j < 4; ++j) {
        pg8::u32x4 o;
#pragma unroll
        for (int q = 0; q < 4; ++q) { int w = __builtin_amdgcn_cvt_pk_fp8_f32(v[4 * q][j], v[4 * q + 1][j], 0, false); w = __builtin_amdgcn_cvt_pk_fp8_f32(v[4 * q + 2][j], v[4 * q + 3][j], w, true); o[q] = (unsigned)w; }
        *(pg8::u32x4*)(WT + (size_t)(dr + j) * K + k0) = o;
    }
}
__device__ __forceinline__ void inproj_src(int r, int& mat, int& col) {
    mat = 0; col = -1;
    if (r < 3072) col = r;
    else if (r < 7168) col = COL_GATE + (r - 3072);
    else if (r < 7424) { if (r - 7168 < 16) col = COL_B + (r - 7168); }
    else if (r < 10496) col = COL_R + (r - 7424);
    else if (r < 10752) { mat = 1; if (r - 10496 < 96) col = r - 10496; }
    else if (r < 11008) { mat = 2; if (r - 10752 < 96) col = r - 10752; }
    else { mat = 3; col = r - 11008; }
}

typedef short bf16x8_t __attribute__((ext_vector_type(8)));
typedef unsigned short LAS* lds_u16p;
__device__ __forceinline__ f32x4_t mma16(bf16x8_t a, bf16x8_t b, f32x4_t c) { return __builtin_amdgcn_mfma_f32_16x16x32_bf16(a, b, c, 0, 0, 0); }
__device__ __forceinline__ bf16x8_t ldfrag(const LAS unsigned short* M, int ld, int r0, int k0, int lane) { return *(const LAS bf16x8_t*)(M + (r0 + (lane & 15)) * ld + k0 + 8 * (lane >> 4)); }
__device__ __forceinline__ unsigned short f2bf(float x) { return (unsigned short)(pg8::cvt_pk_bf16(x, x) & 0xffffu); }
constexpr int GR_QG = 0, GR_W = 16384, GR_KDT = 32768, GR_AI = 49152, GR_U = 57344, GR_MISC = 90112, GR_BYTES = 90368;
constexpr int GL_KB = 0, GL_QB = 17408, GL_VT = 34816, GL_KST = 53248, GL_KDT = 71680, GL_LM = 90112, GL_TI = 107520, GL_AI = 116736, GL_SM = 125952;

__device__ __forceinline__ void tri_inverse_64(const LAS float* Lm, LAS unsigned short* Ti, int lane) {
    float xcol[64];
#pragma unroll
    for (int i = 0; i < 64; ++i) {
        float s0 = 0.f, s1 = 0.f, s2 = 0.f, s3 = 0.f;
#pragma unroll
        for (int j4 = 0; j4 < (i + 3) / 4; ++j4) {
            const f32x4_t l4 = *(const LAS f32x4_t*)(Lm + i * 68 + 4 * j4);
            if (4 * j4 + 0 < i) s0 = fmaf(l4[0], xcol[4 * j4 + 0], s0);
            if (4 * j4 + 1 < i) s1 = fmaf(l4[1], xcol[4 * j4 + 1], s1);
            if (4 * j4 + 2 < i) s2 = fmaf(l4[2], xcol[4 * j4 + 2], s2);
            if (4 * j4 + 3 < i) s3 = fmaf(l4[3], xcol[4 * j4 + 3], s3);
        }
        const float s = (s0 + s1) + (s2 + s3);
        xcol[i] = ((lane == i) ? 1.0f : 0.0f) - s;
        Ti[i * 72 + lane] = f2bf(xcol[i]);
    }
}

__device__ __forceinline__ void gdn_prep_item(int item, LAS unsigned char* lds, const unsigned short* __restrict__ PH, const float* __restrict__ BA, const float* __restrict__ convw, const float* __restrict__ A_log, const float* __restrict__ dt_bias, unsigned char* __restrict__ recs) {
    int tid_ = threadIdx.x; asm volatile("" : "+v"(tid_));
    const int tid = tid_, lane = tid & 63, wave = __builtin_amdgcn_readfirstlane(tid >> 6);
    const int ch = item & 63, hv = (item >> 6) & 7, b = item >> 9, qh = hv >> 1;
    const int s0 = ch * 64; const size_t t0 = (size_t)b * SEQ + s0;
    unsigned char* rec = recs + (size_t)item * GR_BYTES;
    LAS unsigned short* Kb = (LAS unsigned short*)(lds + GL_KB); LAS unsigned short* Qb = (LAS unsigned short*)(lds + GL_QB);
    LAS unsigned short* VT = (LAS unsigned short*)(lds + GL_VT); LAS unsigned short* KsT = (LAS unsigned short*)(lds + GL_KST); LAS unsigned short* KdT = (LAS unsigned short*)(lds + GL_KDT);
    LAS float* Lm = (LAS float*)(lds + GL_LM); LAS unsigned short* Ti = (LAS unsigned short*)(lds + GL_TI); LAS unsigned short* Ai = (LAS unsigned short*)(lds + GL_AI);
    LAS float* gcs = (LAS float*)(lds + GL_SM); LAS float* betas = gcs + 64;
    if (wave == 0) {
        const float araw = BA[(t0 + lane) * 16 + 8 + hv], braw = BA[(t0 + lane) * 16 + hv];
        float g = -expf(A_log[hv]) * softplusf_(araw + dt_bias[hv]);
#pragma unroll
        for (int o = 1; o < 64; o <<= 1) { const float t = __shfl_up(g, o); if (lane >= o) g += t; }
        gcs[lane] = g; betas[lane] = sigmoidf_(braw);
    }
    __syncthreads();
    {
        const int row = tid >> 3, cs = tid & 7, c0 = cs * 16;
        const float gcr = gcs[row], br = betas[row], glast = gcs[63];
        const float eg = expf(gcr), ekd = expf(glast - gcr);
#pragma unroll
        for (int mtx = 0; mtx < 3; ++mtx) {
            const int colbase = (mtx == 0) ? qh * 128 : (mtx == 1) ? COL_K + qh * 128 : COL_V + hv * 128;
            float acc[16];
#pragma unroll
            for (int i = 0; i < 16; ++i) acc[i] = 0.f;
#pragma unroll
            for (int j = 0; j < 4; ++j) {
                if (s0 + row - 3 + j >= 0) {
                    const unsigned short* src = PH + (t0 + row - 3 + j) * N_IN + colbase + c0; const float* cw = convw + j * 2048 + colbase + c0;
                    f32x4_t xq[4]; ld_bf8(src, xq[0], xq[1]); ld_bf8(src + 8, xq[2], xq[3]);
#pragma unroll
                    for (int i4 = 0; i4 < 4; ++i4) { const float4 wv = *(const float4*)(cw + 4 * i4);
                        acc[4 * i4] = fmaf(wv.x, xq[i4][0], acc[4 * i4]); acc[4 * i4 + 1] = fmaf(wv.y, xq[i4][1], acc[4 * i4 + 1]); acc[4 * i4 + 2] = fmaf(wv.z, xq[i4][2], acc[4 * i4 + 2]); acc[4 * i4 + 3] = fmaf(wv.w, xq[i4][3], acc[4 * i4 + 3]); }
                }
            }
            float ss = 0.f;
#pragma unroll
            for (int i = 0; i < 16; ++i) { acc[i] = acc[i] * fast_sigmoid(acc[i]); ss = fmaf(acc[i], acc[i], ss); }
            ss += __shfl_xor(ss, 1); ss += __shfl_xor(ss, 2); ss += __shfl_xor(ss, 4);
            const float rn = rsqrtf(ss + 1e-6f);
#pragma unroll
            for (int i = 0; i < 16; ++i) {
                if (mtx == 0) Qb[row * 136 + c0 + i] = f2bf(acc[i] * rn * 0.08838834764831845f);
                else if (mtx == 1) { const float kn = acc[i] * rn; Kb[row * 136 + c0 + i] = f2bf(kn); KsT[(c0 + i) * 72 + row] = f2bf(br * eg * kn); KdT[(c0 + i) * 72 + row] = f2bf(kn * ekd); }
                else VT[(c0 + i) * 72 + row] = f2bf(br * acc[i]);
            }
            asm volatile("" ::: "memory");
        }
    }
    __syncthreads();
    {
        const int mat = wave >> 2, ti = wave & 3, g4 = lane >> 4, n = lane & 15;
        const LAS unsigned short* Am = mat ? Qb : Kb;
#pragma unroll
        for (int tj = 0; tj < 4; ++tj) {
            f32x4_t acc = {0.f, 0.f, 0.f, 0.f};
#pragma unroll
            for (int ks = 0; ks < 4; ++ks) acc = mma16(ldfrag(Am, 136, 16 * ti, 32 * ks, lane), ldfrag(Kb, 136, 16 * tj, 32 * ks, lane), acc);
            const int j = 16 * tj + n; const float gj = gcs[j];
#pragma unroll
            for (int r = 0; r < 4; ++r) {
                const int i = 16 * ti + 4 * g4 + r; const float dec = __builtin_amdgcn_exp2f(1.4426950408889634f * fminf(gcs[i] - gj, 0.f));
                if (mat == 0) Lm[i * 68 + j] = (j < i) ? betas[i] * acc[r] * dec : 0.f;
                else Ai[i * 72 + j] = f2bf((j <= i) ? acc[r] * dec : 0.f);
            }
        }
    }
    __syncthreads();
    if (wave == 0) tri_inverse_64(Lm, Ti, lane);
    else {
        for (int e = tid - 64; e < 64 * 128; e += NTHREADS - 64) { const int row = e >> 7, c = e & 127; const float qv = bf2f(Qb[row * 136 + c]); Qb[row * 136 + c] = f2bf(qv * __builtin_amdgcn_exp2f(1.4426950408889634f * gcs[row])); }
    }
    __syncthreads();
    {
        const int g4 = lane >> 4, n = lane & 15;
#pragma unroll
        for (int t2 = 0; t2 < 2; ++t2) {
            const int tn = 2 * wave + t2; const LAS unsigned short* Bt = (tn < 8) ? VT : KsT; const int tb = tn & 7;
#pragma unroll
            for (int ti = 0; ti < 4; ++ti) {
                f32x4_t acc = {0.f, 0.f, 0.f, 0.f};
#pragma unroll
                for (int ks = 0; ks < 2; ++ks) acc = mma16(ldfrag(Ti, 72, 16 * ti, 32 * ks, lane), ldfrag(Bt, 72, 16 * tb, 32 * ks, lane), acc);
                if (tn < 8) *(f32x4_t*)(rec + GR_U + ((size_t)((ti * 8 + tb) * 64 + lane)) * 16) = acc;
                else {
#pragma unroll
                    for (int r = 0; r < 4; ++r) Kb[(16 * ti + 4 * g4 + r) * 136 + 16 * tb + n] = f2bf(acc[r]);
                }
            }
        }
    }
    __syncthreads();
    {
#pragma unroll
        for (int t2 = 0; t2 < 2; ++t2) {
            const int f = 2 * wave + t2;
            { const int ti = f >> 2, ks = f & 3;
              *(bf16x8_t*)(rec + GR_QG + (size_t)(f * 64 + lane) * 16) = ldfrag(Qb, 136, 16 * ti, 32 * ks, lane);
              *(bf16x8_t*)(rec + GR_W + (size_t)(f * 64 + lane) * 16) = ldfrag(Kb, 136, 16 * ti, 32 * ks, lane); }
            { const int td = f >> 1, ks = f & 1;
              *(bf16x8_t*)(rec + GR_KDT + (size_t)(f * 64 + lane) * 16) = ldfrag(KdT, 72, 16 * td, 32 * ks, lane); }
        }
        { const int f = wave, ti = f >> 1, ks = f & 1;
          *(bf16x8_t*)(rec + GR_AI + (size_t)(f * 64 + lane) * 16) = ldfrag(Ai, 72, 16 * ti, 32 * ks, lane); }
        if (tid == 0) *(float*)(rec + GR_MISC) = expf(gcs[63]);
    }
    __syncthreads();
}

__device__ __forceinline__ void gdn_scan_seq(int seq, LAS unsigned char* lds, const unsigned char* __restrict__ recs, float* __restrict__ OG) {
    const int tid = threadIdx.x, lane = tid & 63, wave = __builtin_amdgcn_readfirstlane(tid >> 6), g4 = lane >> 4, n = lane & 15;
    const int b = seq >> 3, hv = seq & 7;
    LAS unsigned short* St = (LAS unsigned short*)lds;
    LAS unsigned short* VnT = (LAS unsigned short*)(lds + 34816);
    for (int e = tid; e < 128 * 136; e += NTHREADS) St[e] = 0;
    f32x4_t S[8];
#pragma unroll
    for (int tv = 0; tv < 8; ++tv) S[tv] = (f32x4_t){0.f, 0.f, 0.f, 0.f};
    __syncthreads();
    const int ti = wave & 3;
    bf16x8_t nafr[4], nkfr[2], naifr[2]; f32x4_t nu[8]; float neg;
#define GS_LOAD(chv) do { const unsigned char* _r = recs + ((size_t)seq * 64 + (chv)) * GR_BYTES; \
        _Pragma("unroll") for (int ks = 0; ks < 4; ++ks) nafr[ks] = *(const bf16x8_t*)(_r + (wave < 4 ? GR_QG : GR_W) + (size_t)((ti * 4 + ks) * 64 + lane) * 16); \
        _Pragma("unroll") for (int ks = 0; ks < 2; ++ks) { nkfr[ks] = *(const bf16x8_t*)(_r + GR_KDT + (size_t)((wave * 2 + ks) * 64 + lane) * 16); naifr[ks] = *(const bf16x8_t*)(_r + GR_AI + (size_t)((ti * 2 + ks) * 64 + lane) * 16); } \
        if (wave >= 4) { _Pragma("unroll") for (int tv = 0; tv < 8; ++tv) nu[tv] = *(const f32x4_t*)(_r + GR_U + (size_t)((ti * 8 + tv) * 64 + lane) * 16); } \
        neg = *(const float*)(_r + GR_MISC); } while (0)
    GS_LOAD(0);
    for (int ch = 0; ch < 64; ++ch) {
        bf16x8_t afr[4], kfr[2], aifr[2]; f32x4_t ucur[8];
#pragma unroll
        for (int ks = 0; ks < 4; ++ks) afr[ks] = nafr[ks];
#pragma unroll
        for (int ks = 0; ks < 2; ++ks) { kfr[ks] = nkfr[ks]; aifr[ks] = naifr[ks]; }
#pragma unroll
        for (int tv = 0; tv < 8; ++tv) ucur[tv] = nu[tv];
        const float eg = neg;
        if (ch + 1 < 64) GS_LOAD(ch + 1);
        f32x4_t acc1[8];
#pragma unroll
        for (int tv = 0; tv < 8; ++tv) {
            f32x4_t a = {0.f, 0.f, 0.f, 0.f};
#pragma unroll
            for (int ks = 0; ks < 4; ++ks) a = mma16(afr[ks], ldfrag(St, 136, 16 * tv, 32 * ks, lane), a);
            acc1[tv] = a;
        }
        if (wave >= 4) {
#pragma unroll
            for (int tv = 0; tv < 8; ++tv) {
                const f32x4_t vn = ucur[tv] - acc1[tv];
                pg8::u32x2 w2; w2.x = pg8::cvt_pk_bf16(vn[0], vn[1]); w2.y = pg8::cvt_pk_bf16(vn[2], vn[3]);
                *(LAS pg8::u32x2*)(VnT + (16 * tv + n) * 72 + 16 * ti + 4 * g4) = w2;
            }
        }
        __syncthreads();
        if (wave < 4) {
#pragma unroll
            for (int tv = 0; tv < 8; ++tv) {
                f32x4_t o = acc1[tv];
#pragma unroll
                for (int ks = 0; ks < 2; ++ks) o = mma16(aifr[ks], ldfrag(VnT, 72, 16 * tv, 32 * ks, lane), o);
#pragma unroll
                for (int r = 0; r < 4; ++r) OG[((size_t)b * SEQ + ch * 64 + 16 * ti + 4 * g4 + r) * RW + hv * 128 + 16 * tv + n] = o[r];
            }
        }
#pragma unroll
        for (int tv = 0; tv < 8; ++tv) {
            f32x4_t s = S[tv] * eg;
#pragma unroll
            for (int ks = 0; ks < 2; ++ks) s = mma16(kfr[ks], ldfrag(VnT, 72, 16 * tv, 32 * ks, lane), s);
            S[tv] = s;
            pg8::u32x2 w2; w2.x = pg8::cvt_pk_bf16(s[0], s[1]); w2.y = pg8::cvt_pk_bf16(s[2], s[3]);
            *(LAS pg8::u32x2*)(St + (16 * tv + n) * 136 + 16 * wave + 4 * g4) = w2;
        }
        __syncthreads();
    }
#undef GS_LOAD
}

constexpr int RT = 32;
constexpr int RBUF_FLOATS = 5 * RT * 64 + RT * 32 + RT * 2;
typedef float f32x2_t __attribute__((ext_vector_type(2)));
__device__ __forceinline__ float dpp_f(float x, const int ctrl_sel) {
    const int xi = __float_as_int(x); int r;
    if (ctrl_sel == 0) r = __builtin_amdgcn_update_dpp(0, xi, 0xB1, 0xF, 0xF, true);
    else if (ctrl_sel == 1) r = __builtin_amdgcn_update_dpp(0, xi, 0x4E, 0xF, 0xF, true);
    else if (ctrl_sel == 2) r = __builtin_amdgcn_update_dpp(0, xi, 0x141, 0xF, 0xF, true);
    else r = __builtin_amdgcn_update_dpp(0, xi, 0x140, 0xF, 0xF, true);
    return __int_as_float(r);
}
__device__ __forceinline__ float sum8(float x) { x += dpp_f(x, 0); x += dpp_f(x, 1); x += dpp_f(x, 2); return x; }
__device__ __forceinline__ float fast_softplus(float x) { return fmaxf(x, 0.0f) + 0.6931471805599453f * __builtin_amdgcn_logf(1.0f + __builtin_amdgcn_exp2f(-1.4426950408889634f * fabsf(x))); }
__device__ __forceinline__ void rwkv_scan_block(int sq, int half, LAS float* lds, const float* __restrict__ WPRE, const float* __restrict__ APRE, const unsigned short* __restrict__ PH,
                                                const float* __restrict__ k_k, const float* __restrict__ k_a, const float* __restrict__ r_k, float* __restrict__ BON, float* __restrict__ YR) {
    const int tid = threadIdx.x, lane = tid & 63, wave = __builtin_amdgcn_readfirstlane(tid >> 6);
    const int b = sq >> 4, h = sq & 15, rbase = half * 32;
    const size_t t0 = (size_t)b * SEQ;
    const int lt = tid - 256;
    f32x4_t s0w[2], s0a[2], s0k[2], s0r[2], s0v, s1w[2], s1a[2], s1k[2], s1r[2], s1v;
    f32x4_t kkc = {0.f, 0.f, 0.f, 0.f}, kac = kkc, rkc = kkc;
    if (lt >= 0) { const int colc = h * 64 + (lt & 15) * 4; kkc = *(const f32x4_t*)(k_k + colc); kac = *(const f32x4_t*)(k_a + colc); rkc = *(const f32x4_t*)(r_k + colc); }
    f32x2_t S2[4];
#pragma unroll
    for (int k = 0; k < 4; ++k) S2[k] = (f32x2_t){0.f, 0.f};
#define RW_LOAD(c, P) do { _Pragma("unroll") for (int i = 0; i < 2; ++i) { const int f = lt + 256 * i, st = f >> 4, c4 = f & 15; const size_t t = t0 + (size_t)(c) * RT + st; const int col = h * 64 + c4 * 4; \
        P##w[i] = *(const f32x4_t*)(WPRE + t * RW + col); P##a[i] = *(const f32x4_t*)(APRE + t * RW + col); P##k[i] = ld_bf4(PH + t * N_IN + COL_RK + col); P##r[i] = ld_bf4(PH + t * N_IN + COL_R + col); } \
        { const int st = lt >> 3, c4 = lt & 7; P##v = ld_bf4(PH + (t0 + (size_t)(c) * RT + st) * N_IN + COL_RV + h * 64 + rbase + c4 * 4); } } while (0)
#define RW_STORE(bufp, P, c) do { LAS float* _b = (bufp); _Pragma("unroll") for (int i = 0; i < 2; ++i) { const int f = lt + 256 * i, st = f >> 4, c4 = f & 15; \
        f32x4_t wd, av, kkv; float ss = 0.f; \
        _Pragma("unroll") for (int j = 0; j < 4; ++j) { const float wlog = -fast_softplus(-P##w[i][j]) - 0.5f; wd[j] = __builtin_amdgcn_exp2f(-1.4426950408889634f * __builtin_amdgcn_exp2f(1.4426950408889634f * wlog)); av[j] = fast_sigmoid(P##a[i][j]); kkv[j] = P##k[i][j] * kkc[j]; ss = fmaf(kkv[j], kkv[j], ss); } \
        ss += __shfl_xor(ss, 1); ss += __shfl_xor(ss, 2); ss += __shfl_xor(ss, 4); ss += __shfl_xor(ss, 8); \
        const float rn = rsqrtf(ss + 1e-6f); f32x4_t aav, bbv, kmv; float br = 0.f, kr = 0.f, bo = 0.f; \
        _Pragma("unroll") for (int j = 0; j < 4; ++j) { const float kk = kkv[j] * rn; aav[j] = -kk; bbv[j] = kk * av[j]; kmv[j] = P##k[i][j] * (1.0f + (av[j] - 1.0f) * kac[j]); \
            br = fmaf(bbv[j], P##r[i][j], br); kr = fmaf(kmv[j], P##r[i][j], kr); bo = fmaf(P##r[i][j] * kmv[j], rkc[j], bo); } \
        *(LAS f32x4_t*)(_b + 0 * RT * 64 + st * 64 + c4 * 4) = wd; *(LAS f32x4_t*)(_b + 1 * RT * 64 + st * 64 + c4 * 4) = bbv; *(LAS f32x4_t*)(_b + 2 * RT * 64 + st * 64 + c4 * 4) = kmv; \
        const f32x4_t _x = wd * P##r[i]; \
        *(LAS f32x4_t*)(_b + 3 * RT * 64 + st * 128 + c4 * 8) = (f32x4_t){aav[0], _x[0], aav[1], _x[1]}; *(LAS f32x4_t*)(_b + 3 * RT * 64 + st * 128 + c4 * 8 + 4) = (f32x4_t){aav[2], _x[2], aav[3], _x[3]}; \
        br += __shfl_xor(br, 1); br += __shfl_xor(br, 2); br += __shfl_xor(br, 4); br += __shfl_xor(br, 8); kr += __shfl_xor(kr, 1); kr += __shfl_xor(kr, 2); kr += __shfl_xor(kr, 4); kr += __shfl_xor(kr, 8); \
        bo += __shfl_xor(bo, 1); bo += __shfl_xor(bo, 2); bo += __shfl_xor(bo, 4); bo += __shfl_xor(bo, 8); \
        if (c4 == 0) { _b[5 * RT * 64 + RT * 32 + st * 2] = br; _b[5 * RT * 64 + RT * 32 + st * 2 + 1] = kr; if (half == 0) BON[(t0 + (size_t)(c) * RT + st) * 16 + h] = bo; } } \
        { const int st = lt >> 3, c4 = lt & 7; *(LAS f32x4_t*)(_b + 5 * RT * 64 + st * 32 + c4 * 4) = P##v; } } while (0)
    constexpr int NCH = SEQ / RT;
    const int rloc = wave * 8 + (lane >> 4) * 2, kq = (lane & 15) * 4;
    LAS float* ybuf = lds + 2 * RBUF_FLOATS;
    f32x2_t T2[4];
#pragma unroll
    for (int k = 0; k < 4; ++k) T2[k] = (f32x2_t){0.f, 0.f};
    f32x4_t Aw, Ab, Ak, Ax0, Ax1, Bw, Bb, Bk, Bx0, Bx1; f32x2_t Av, Bv, Ar, Br;
#define RW_LD(X, buf, st) do { const LAS float* _p = (buf) + (st) * 64 + kq; \
        X##w = *(const LAS f32x4_t*)(_p); X##b = *(const LAS f32x4_t*)(_p + RT * 64); X##k = *(const LAS f32x4_t*)(_p + 2 * RT * 64); \
        const LAS float* _q = (buf) + 3 * RT * 64 + (st) * 128 + kq * 2; X##x0 = *(const LAS f32x4_t*)(_q); X##x1 = *(const LAS f32x4_t*)(_q + 4); \
        X##v = *(const LAS f32x2_t*)((buf) + 5 * RT * 64 + (st) * 32 + rloc); X##r = *(const LAS f32x2_t*)((buf) + 5 * RT * 64 + RT * 32 + (st) * 2); } while (0)
#define RW_SUM16(x) do { x += dpp_f(x, 0); x += dpp_f(x, 1); x += dpp_f(x, 2); x += dpp_f(x, 3); } while (0)
#define RW_STEP(X, yb, st) do { \
        f32x2_t e0 = S2[0][0] * (f32x2_t){X##x0[0], X##x0[1]}, e1 = T2[0][0] * (f32x2_t){X##x0[0], X##x0[1]}; \
        e0 += S2[0][1] * (f32x2_t){X##x0[2], X##x0[3]}; e1 += T2[0][1] * (f32x2_t){X##x0[2], X##x0[3]}; \
        e0 += S2[1][0] * (f32x2_t){X##x1[0], X##x1[1]}; e1 += T2[1][0] * (f32x2_t){X##x1[0], X##x1[1]}; \
        e0 += S2[1][1] * (f32x2_t){X##x1[2], X##x1[3]}; e1 += T2[1][1] * (f32x2_t){X##x1[2], X##x1[3]}; \
        float sa0 = e0[0], pp0 = e0[1], sa1 = e1[0], pp1 = e1[1]; RW_SUM16(sa0); RW_SUM16(sa1); RW_SUM16(pp0); RW_SUM16(pp1); \
        const f32x2_t w01 = (f32x2_t){X##w[0], X##w[1]}, w23 = (f32x2_t){X##w[2], X##w[3]}, b01 = (f32x2_t){X##b[0], X##b[1]}, b23 = (f32x2_t){X##b[2], X##b[3]}, k01 = (f32x2_t){X##k[0], X##k[1]}, k23 = (f32x2_t){X##k[2], X##k[3]}; \
        S2[0] = S2[0] * w01 + (sa0 * b01 + X##v[0] * k01); S2[1] = S2[1] * w23 + (sa0 * b23 + X##v[0] * k23); \
        T2[0] = T2[0] * w01 + (sa1 * b01 + X##v[1] * k01); T2[1] = T2[1] * w23 + (sa1 * b23 + X##v[1] * k23); \
        *(LAS f32x2_t*)((yb) + (st) * 32 + rloc) = (f32x2_t){pp0 + sa0 * X##r[0] + X##v[0] * X##r[1], pp1 + sa1 * X##r[0] + X##v[1] * X##r[1]}; } while (0)
#define RW_COMPUTE(c) do { const LAS float* buf = lds + ((c) & 1) * RBUF_FLOATS; LAS float* yb = ybuf + ((c) & 1) * RT * 32; \
        RW_LD(A, buf, 0); \
        for (int st = 0; st < RT; st += 2) { RW_LD(B, buf, st + 1); RW_STEP(A, yb, st); if (st + 2 < RT) RW_LD(A, buf, st + 2); RW_STEP(B, yb, st + 1); } } while (0)
#define RW_FLUSH(c) do { const int st = lt >> 3, c4 = lt & 7; *(f32x4_t*)(YR + (t0 + (size_t)(c) * RT + st) * RW + h * 64 + rbase + c4 * 4) = *(const LAS f32x4_t*)(ybuf + ((c) & 1) * RT * 32 + st * 32 + c4 * 4); } while (0)
    if (wave >= 4) {
        RW_LOAD(0, s0); RW_STORE(lds, s0, 0); RW_LOAD(1, s0); RW_LOAD(2, s1);
        __syncthreads();
        for (int c = 0; c < NCH; c += 2) {
            RW_STORE(lds + RBUF_FLOATS, s0, c + 1); if (c + 3 < NCH) RW_LOAD(c + 3, s0); if (c > 0) RW_FLUSH(c - 1);
            __syncthreads();
            if (c + 2 < NCH) { RW_STORE(lds, s1, c + 2); } if (c + 4 < NCH) RW_LOAD(c + 4, s1); RW_FLUSH(c);
            __syncthreads();
        }
        RW_FLUSH(NCH - 1);
    } else {
        __syncthreads();
        for (int c = 0; c < NCH; c += 2) {
            RW_COMPUTE(c);
            __syncthreads();
            RW_COMPUTE(c + 1);
            __syncthreads();
        }
    }
#undef RW_COMPUTE
#undef RW_FLUSH
#undef RW_LD
#undef RW_STEP
#undef RW_SUM16
#undef RW_LOAD
#undef RW_STORE
}

__global__ void __launch_bounds__(NTHREADS, 2) fwd(Args a) {
    extern __shared__ __attribute__((aligned(16))) unsigned char lds_raw[];
    float* sm = (float*)lds_raw;
#define PHASE_IDS int tid = threadIdx.x; asm volatile("" : "+v"(tid)); const int lane = tid & 63, wave = tid >> 6; (void)lane; (void)wave;
    unsigned char* ws = a.ws;
    unsigned* ctl = (unsigned*)(ws + WS_CTL);
    volatile LAS unsigned* xbw = (volatile LAS unsigned*)(LAS unsigned char*)(lds_raw + LDS_BYTES - 16);
    if (threadIdx.x == 0) { xbw[0] = 0u; xbw[1] = 0u; xbw[2] = 0u; xbw[3] = 0u; }
    __syncthreads();
    const int lo = a.ph_lo, hi = a.ph_hi;
    XcdBarrier bar; bar.bar = ctl; bar.x = 0; bar.st = xbw;
    if (hi - lo > 1) bar = xcd_barrier_post(ctl, xbw);
#define IN(k) (lo <= (k) && (k) < hi)
#define SEAM(k) do { if (IN(k) && IN((k) + 1)) xcd_barrier(bar); } while (0)


    if (IN(0)) {
        PHASE_IDS
        const float* c = a.in[1];
        const float* ada_w = a.in[2];
        const float* ada_b = a.in[3];
        const float* w_in = a.in[8];
        const float* rwkv_w1 = a.in[15];
        const float* rwkv_a1 = a.in[18];
        const float* rwkv_g1 = a.in[20];
        const float* w_up_gdn = a.in[27];
        const float* w_up_rwkv = a.in[28];
        const float* w_out = a.in[29];
        const float* exp_w_gu = a.in[32];
        const float* exp_w_down = a.in[34];
        float* MOD = (float*)(ws + WS_MOD);
        unsigned short* WINT = (unsigned short*)(ws + WS_WINT);
        unsigned short* WUPG = (unsigned short*)(ws + WS_WUPG);
        unsigned short* WUPR = (unsigned short*)(ws + WS_WUPR);
        unsigned short* WOUT = (unsigned short*)(ws + WS_WOUT);
        unsigned short* WGU = (unsigned short*)(ws + WS_WGU);
        unsigned short* WDN = (unsigned short*)(ws + WS_WDN);
        float* sc = sm;
        float* part = sm + NB * D;
        for (int i = tid; i < NB * D; i += NTHREADS) sc[i] = siluf_(c[i]);
        __syncthreads();
        for (int cb = blockIdx.x; cb < 6 * D / 48; cb += gridDim.x) {
            const int cc = tid % 48, kg = tid / 48, col = cb * 48 + cc;
            if (tid < 480) {
                float acc0 = 0.f, acc1 = 0.f, acc2 = 0.f, acc3 = 0.f;
#pragma unroll 8
                for (int k = kg; k < D; k += 10) {
                    const float w = ada_w[(size_t)k * (6 * D) + col];
                    acc0 = fmaf(sc[k], w, acc0); acc1 = fmaf(sc[D + k], w, acc1); acc2 = fmaf(sc[2 * D + k], w, acc2); acc3 = fmaf(sc[3 * D + k], w, acc3);
                }
                part[(kg * 4 + 0) * 48 + cc] = acc0; part[(kg * 4 + 1) * 48 + cc] = acc1; part[(kg * 4 + 2) * 48 + cc] = acc2; part[(kg * 4 + 3) * 48 + cc] = acc3;
            }
            __syncthreads();
            if (tid < 192) {
                const int bb = tid / 48, c2 = tid % 48; float t = ada_b[cb * 48 + c2];
#pragma unroll
                for (int g = 0; g < 10; ++g) t += part[(g * 4 + bb) * 48 + c2];
                MOD[(size_t)bb * 6 * D + cb * 48 + c2] = t;
            }
            __syncthreads();
        }
        {
            const int gw = blockIdx.x * (NTHREADS / 64) + wave, ngw = gridDim.x * (NTHREADS / 64);
            auto idk = [](int k) { return k; };
            constexpr int N_IP = (NT_IN * 256 / 64) * (D / 64);
            constexpr int N_GU = NE * (2 * FF / 64) * (D / 64), N_DN = NE * (D / 64) * (FF / 64);
            constexpr int N_L2 = 3 * (RW / 64) * (256 / 64), N_UP = (D / 64) * (RW / 64), N_OUT = (D / 64) * (D / 64);
            constexpr int N_ALL = N_IP + N_GU + N_DN + N_L2 + 2 * N_UP + N_OUT;
            constexpr int N_P5 = (N_GU + N_DN) * 100 / 100;
            for (int it0 = gw + N_P5; it0 < N_ALL; it0 += ngw) {
                int it = it0;
                if (it < N_GU) {
                    const int e = it / ((2 * FF / 64) * (D / 64)), r = it % ((2 * FF / 64) * (D / 64)), rb = r / (D / 64), kb = r % (D / 64);
                    auto m4 = [](int row0, int n4, int& scol, int& drow) { const int pn = row0 >> 8, cb8 = (row0 & 255) >> 3, ft = 128 * pn + (cb8 + (n4 & 7)) * 4; scol = (n4 < 8) ? ft : FF + ft; drow = row0 + (n4 & 7) * 8 + ((n4 < 8) ? 0 : 4); };
                    cvt64(exp_w_gu + (size_t)e * D * 2 * FF, 2 * FF, D, m4, idk, WGU + (size_t)e * 2 * FF * D, rb * 64, kb, lane); continue; }
                it -= N_GU;
                auto mid = [](int row0, int n4, int& scol, int& drow) { scol = row0 + 4 * n4; drow = scol; };
                if (it < N_DN) {
                    const int e = it / ((D / 64) * (FF / 64)), r = it % ((D / 64) * (FF / 64)), rb = r / (FF / 64), kb = r % (FF / 64);
                    cvt64(exp_w_down + (size_t)e * FF * D, D, FF, mid, idk, WDN + (size_t)e * D * FF, rb * 64, kb, lane); continue; }
                it -= N_DN;
                if (it < N_IP) {
                    const int rb = it / (D / 64), kb = it % (D / 64), row0 = rb * 64;
                    int mat, col0; inproj_src(row0, mat, col0);
                    const float* W = mat == 0 ? w_in : mat == 1 ? rwkv_w1 : mat == 2 ? rwkv_a1 : rwkv_g1;
                    const int ldw = mat == 0 ? N_IN : mat == 3 ? 256 : 96;
                    auto m4 = [](int r0, int n4, int& scol, int& drow) { int m2; drow = r0 + 4 * n4; inproj_src(drow, m2, scol); };
                    cvt64(W, ldw, D, m4, idk, WINT, row0, kb, lane); continue; }
                it -= N_IP;
                if (it < N_L2) {
                    const float* rwkv_w2 = a.in[16]; const float* rwkv_a2 = a.in[19]; const float* rwkv_g2 = a.in[21]; unsigned short* L2T = (unsigned short*)(ws + WS_L2T);
                    constexpr int NL = (RW / 64) * 4; const int g = it / NL, r = it % NL, rb = r / 4, kb = r % 4;
                    if (g == 0) { auto fk = [](int k) { return k < 96 ? k : -1; }; cvt64(rwkv_w2, RW, 256, mid, fk, L2T, rb * 64, kb, lane); }
                    else if (g == 1) { auto fk = [](int k) { return (k >= 128 && k < 224) ? k - 128 : -1; }; cvt64(rwkv_a2, RW, 256, mid, fk, L2T + (size_t)RW * 256, rb * 64, kb, lane); }
                    else cvt64(rwkv_g2, RW, 256, mid, idk, L2T + (size_t)2 * RW * 256, rb * 64, kb, lane);
                    continue; }
                it -= N_L2;
                if (it < N_UP) { cvt64(w_up_gdn, D, RW, mid, idk, WUPG, (it / (RW / 64)) * 64, it % (RW / 64), lane); continue; }
                it -= N_UP;
                if (it < N_UP) { cvt64(w_up_rwkv, D, RW, mid, idk, WUPR, (it / (RW / 64)) * 64, it % (RW / 64), lane); continue; }
                it -= N_UP;
                cvt64(w_out, D, D, mid, idk, WOUT, (it / (D / 64)) * 64, it % (D / 64), lane);
            }
        }
    }
    SEAM(0);

    if (IN(1)) {
        PHASE_IDS
        const float* x = a.in[0]; const float* norm_mix_pre = a.in[4]; const float* rwkv_mix = a.in[13];
        float* MOD = (float*)(ws + WS_MOD); unsigned short* AM = (unsigned short*)(ws + WS_H);
        LAS float* invs = (LAS float*)(LAS unsigned char*)lds_raw;
        for (int chunk = blockIdx.x; chunk < T / 64; chunk += gridDim.x) {
            const int r0 = chunk * 64, b = r0 / SEQ; const float* mod = MOD + (size_t)b * 6 * D;
            __syncthreads();
            for (int rr = wave; rr < 65; rr += NTHREADS / 64) {
                const int row = r0 - 1 + rr; float ss = 0.f;
                if (rr > 0 || (r0 % SEQ) != 0) {
#pragma unroll
                    for (int j = 0; j < 8; ++j) { const float4 t4 = *(const float4*)(x + (size_t)row * D + j * 256 + lane * 4); ss += t4.x * t4.x + t4.y * t4.y + t4.z * t4.z + t4.w * t4.w; }
                    ss = wave_sum(ss);
                }
                if (lane == 0) invs[rr] = rsqrtf(ss / D + EPS);
            }
            __syncthreads();
            const int d0 = tid * 4;
            const float4 nw = *(const float4*)(norm_mix_pre + d0), sc4 = *(const float4*)(mod + D + d0), sh4 = *(const float4*)(mod + d0);
            const float g0 = nw.x * (1.0f + sc4.x), g1 = nw.y * (1.0f + sc4.y), g2 = nw.z * (1.0f + sc4.z), g3 = nw.w * (1.0f + sc4.w);
            float4 mx[6];
#pragma unroll
            for (int mi = 0; mi < 6; ++mi) mx[mi] = *(const float4*)(rwkv_mix + mi * D + d0);
            float p0 = 0.f, p1 = 0.f, p2 = 0.f, p3 = 0.f;
            if ((r0 % SEQ) != 0) { const float4 xp = *(const float4*)(x + (size_t)(r0 - 1) * D + d0); const float ip = invs[0];
                p0 = xp.x * ip * g0 + sh4.x; p1 = xp.y * ip * g1 + sh4.y; p2 = xp.z * ip * g2 + sh4.z; p3 = xp.w * ip * g3 + sh4.w; }
#pragma unroll 4
            for (int rr = 0; rr < 64; ++rr) {
                const size_t o = (size_t)(r0 + rr) * D + d0;
                const float4 xc = *(const float4*)(x + o); const float inv = invs[rr + 1];
                const float h0 = xc.x * inv * g0 + sh4.x, h1 = xc.y * inv * g1 + sh4.y, h2 = xc.z * inv * g2 + sh4.z, h3 = xc.w * inv * g3 + sh4.w;
                pg8::u32x2 w; w.x = pg8::cvt_pk_bf16(h0, h1); w.y = pg8::cvt_pk_bf16(h2, h3);
                *(pg8::u32x2*)(AM + o) = w;
#pragma unroll
                for (int mi = 0; mi < 6; ++mi) {
                    pg8::u32x2 w2; w2.x = pg8::cvt_pk_bf16(h0 + (p0 - h0) * mx[mi].x, h1 + (p1 - h1) * mx[mi].y); w2.y = pg8::cvt_pk_bf16(h2 + (p2 - h2) * mx[mi].z, h3 + (p3 - h3) * mx[mi].w);
                    *(pg8::u32x2*)(AM + (size_t)(mi + 1) * T * D + o) = w2;
                }
                p0 = h0; p1 = h1; p2 = h2; p3 = h3;
            }
        }
    }
    SEAM(1);

    if (IN(2)) {
        PHASE_IDS
        unsigned short* AM = (unsigned short*)(ws + WS_H);
        unsigned short* WINT = (unsigned short*)(ws + WS_WINT);
        unsigned short* PH = (unsigned short*)(ws + WS_PH);
        SchedInProj S{(int)gridDim.x, (int)blockIdx.x, (const char*)AM, (const char*)WINT};
        EpiInProjF32 E{PH, (float*)(ws + WS_BA), (unsigned short*)(ws + WS_LWA), (unsigned short*)(ws + WS_LGB)};
        pg8::gemm_phase<EpiInProjF32, SchedInProj, true, false>((LAS unsigned char*)lds_raw, D, S, E);
    }
    SEAM(2);

    if (IN(3)) {
        PHASE_IDS
        const float* gdn_conv = a.in[9];
        const float* gdn_A_log = a.in[10];
        const float* gdn_dt_bias = a.in[11];
        const float* rwkv_w0 = a.in[14];
        const float* rwkv_w2 = a.in[16];
        const float* rwkv_a0 = a.in[17];
        const float* rwkv_a2 = a.in[19];
        const float* rwkv_g2 = a.in[21];
        unsigned short* PH = (unsigned short*)(ws + WS_PH);
        float* WPRE = (float*)(ws + WS_WPRE);
        float* APRE = (float*)(ws + WS_APRE);
        float* GATE = (float*)(ws + WS_GATE);
        unsigned char* GREC = ws + WS_GREC;
        {
            SchedLora S{(int)gridDim.x, (int)blockIdx.x, (const char*)(ws + WS_LWA), (const char*)(ws + WS_LGB), (const char*)(ws + WS_L2T)};
            EpiLora E{WPRE, APRE, GATE, rwkv_w0, rwkv_a0};
            int klora = 256; asm volatile("" : "+s"(klora));
            pg8::gemm_phase<EpiLora, SchedLora, true, false>((LAS unsigned char*)lds_raw, klora, S, E);
        }
        __syncthreads();
        for (int item = blockIdx.x; item < 2048; item += gridDim.x) gdn_prep_item(item, (LAS unsigned char*)lds_raw, PH, (const float*)(ws + WS_BA), gdn_conv, gdn_A_log, gdn_dt_bias, GREC);
    }
    SEAM(3);


    if (IN(5)) {
        PHASE_IDS
        unsigned short* PH = (unsigned short*)(ws + WS_PH);
        unsigned char* GREC = ws + WS_GREC;
        float* WD = (float*)(ws + WS_WD);
        float* AA = (float*)(ws + WS_AA);
        float* BB = (float*)(ws + WS_BB);
        float* KM = (float*)(ws + WS_KM);
        float* OG = (float*)(ws + WS_OG);
        float* YR = (float*)(ws + WS_YR);
        if (blockIdx.x < 32) gdn_scan_seq((int)blockIdx.x, (LAS unsigned char*)lds_raw, GREC, OG);
        else if (blockIdx.x < 160) rwkv_scan_block(((int)blockIdx.x - 32) >> 1, ((int)blockIdx.x - 32) & 1, (LAS float*)(LAS unsigned char*)lds_raw, (const float*)(ws + WS_WPRE), (const float*)(ws + WS_APRE), PH, a.in[22], a.in[23], a.in[24], (float*)(ws + WS_WD), YR);
        {
            const float* exp_w_gu = a.in[32]; const float* exp_w_down = a.in[34];
            unsigned char* WGU = ws + WS_WGU; unsigned char* WDN = ws + WS_WDN;
            constexpr int N_GU = NE * (2 * FF / 64) * (D / 64), N_DN = NE * (D / 64) * (FF / 64);
            auto idk = [](int k) { return k; };
            constexpr int N_P5 = N_GU + N_DN;
            for (;;) {
                int base = 0; if (lane == 0) base = (int)atomicAdd(ctl + CW_CNT + 96, 4u);
                base = __builtin_amdgcn_readfirstlane(base);
                if (base >= N_P5) break;
              for (int it0 = base; it0 < base + 4 && it0 < N_P5; ++it0) {
                int it = it0;
                if (it < N_GU) {
                    const int e = it / ((2 * FF / 64) * (D / 64)), r = it % ((2 * FF / 64) * (D / 64)), rb = r / (D / 64), kb = r % (D / 64);
                    auto m4 = [](int row0, int n4, int& scol, int& drow) { const int pn = row0 >> 8, cb8 = (row0 & 255) >> 3, ft = 128 * pn + (cb8 + (n4 & 7)) * 4; scol = (n4 < 8) ? ft : FF + ft; drow = row0 + (n4 & 7) * 8 + ((n4 < 8) ? 0 : 4); };
                    cvt64_f8(exp_w_gu + (size_t)e * D * 2 * FF, 2 * FF, D, m4, idk, WGU + (size_t)e * 2 * FF * D, rb * 64, kb, lane, 64.0f);
                } else {
                    it -= N_GU;
                    auto mid = [](int row0, int n4, int& scol, int& drow) { scol = row0 + 4 * n4; drow = scol; };
                    const int e = it / ((D / 64) * (FF / 64)), r = it % ((D / 64) * (FF / 64)), rb = r / (FF / 64), kb = r % (FF / 64);
                    cvt64_f8(exp_w_down + (size_t)e * FF * D, D, FF, mid, idk, WDN + (size_t)e * D * FF, rb * 64, kb, lane, 64.0f);
                }
              }
            }
        }
    }
    SEAM(5);

    if (IN(6)) {
        PHASE_IDS
        const float* gdn_norm = a.in[12];
        const float* rwkv_r_k = a.in[24];
        const float* rwkv_ln_w = a.in[25];
        const float* rwkv_ln_b = a.in[26];
        unsigned short* PH = (unsigned short*)(ws + WS_PH);
        float* GATE = (float*)(ws + WS_GATE);
        float* KM = (float*)(ws + WS_KM);
        float* OG = (float*)(ws + WS_OG);
        float* YR = (float*)(ws + WS_YR);
        unsigned short* YGB = (unsigned short*)(ws + WS_YGB);
        unsigned short* YRWB = (unsigned short*)(ws + WS_YRWB);
        for (int rp = blockIdx.x; rp < T / 2; rp += gridDim.x) {
            const int row = rp * 2 + (tid >> 8), c0 = (tid & 255) * 4;
            {
                const f32x4_t o = *(const f32x4_t*)(OG + (size_t)row * RW + c0);
                const float ss = half_sum(o[0] * o[0] + o[1] * o[1] + o[2] * o[2] + o[3] * o[3]);
                const float inv = rsqrtf(ss / 128.0f + EPS);
                const f32x4_t z = ld_bf4(PH + (size_t)row * N_IN + COL_Z + c0), gn = *(const f32x4_t*)(gdn_norm + (c0 & 127));
                pg8::u32x2 w; w.x = pg8::cvt_pk_bf16(o[0] * inv * gn[0] * z[0] * fast_sigmoid(z[0]), o[1] * inv * gn[1] * z[1] * fast_sigmoid(z[1]));
                w.y = pg8::cvt_pk_bf16(o[2] * inv * gn[2] * z[2] * fast_sigmoid(z[2]), o[3] * inv * gn[3] * z[3] * fast_sigmoid(z[3]));
                *(pg8::u32x2*)(YGB + (size_t)row * RW + c0) = w;
            }
            {
                const f32x4_t y = *(const f32x4_t*)(YR + (size_t)row * RW + c0);
                float sm1 = (y[0] + y[1]) + (y[2] + y[3]);
                sm1 += __shfl_xor(sm1, 1); sm1 += __shfl_xor(sm1, 2); sm1 += __shfl_xor(sm1, 4); sm1 += __shfl_xor(sm1, 8);
                const float mu = sm1 * (1.0f / 64.0f);
                const f32x4_t dl = y - mu;
                float sv = (dl[0] * dl[0] + dl[1] * dl[1]) + (dl[2] * dl[2] + dl[3] * dl[3]);
                sv += __shfl_xor(sv, 1); sv += __shfl_xor(sv, 2); sv += __shfl_xor(sv, 4); sv += __shfl_xor(sv, 8);
                const float rs = rsqrtf(sv * (1.0f / 64.0f) + 64e-5f);
                const f32x4_t lw = *(const f32x4_t*)(rwkv_ln_w + c0), lb = *(const f32x4_t*)(rwkv_ln_b + c0), vv = ld_bf4(PH + (size_t)row * N_IN + COL_RV + c0), gt = *(const f32x4_t*)(GATE + (size_t)row * RW + c0);
                const float bsum = ((const float*)(ws + WS_WD))[(size_t)row * 16 + (c0 >> 6)];
                const f32x4_t yo = (dl * rs * lw + lb + bsum * vv) * gt;
                pg8::u32x2 w; w.x = pg8::cvt_pk_bf16(yo[0], yo[1]); w.y = pg8::cvt_pk_bf16(yo[2], yo[3]);
                *(pg8::u32x2*)(YRWB + (size_t)row * RW + c0) = w;
            }
        }
    }
    SEAM(6);

    if (IN(7)) {
        PHASE_IDS
        unsigned short* PH = (unsigned short*)(ws + WS_PH);
        unsigned short* YGB = (unsigned short*)(ws + WS_YGB);
        unsigned short* YRWB = (unsigned short*)(ws + WS_YRWB);
        unsigned short* WUPG = (unsigned short*)(ws + WS_WUPG);
        unsigned short* WUPR = (unsigned short*)(ws + WS_WUPR);
        unsigned short* MRGB = (unsigned short*)(ws + WS_MRGB);
        float* MERGED = (float*)(ws + WS_MERGED);
        SchedUp S{(int)gridDim.x, (int)blockIdx.x, (const char*)YGB, (const char*)YRWB, (const char*)WUPG, (const char*)WUPR};
        EpiUp E{MRGB, PH};
        pg8::gemm_phase<EpiUp, SchedUp, true, false>((LAS unsigned char*)lds_raw, RW, S, E);
    }
    SEAM(7);

    if (IN(8)) {
        PHASE_IDS
        unsigned short* WOUT = (unsigned short*)(ws + WS_WOUT);
        unsigned short* MRGB = (unsigned short*)(ws + WS_MRGB);
        float* Y = (float*)(ws + WS_Y);
        SchedPlain S{(int)gridDim.x, (int)blockIdx.x, T / 256, D / 256, D, (const char*)MRGB, (const char*)WOUT};
        EpiF32 E{(unsigned short*)Y, D};
        pg8::gemm_phase<EpiF32, SchedPlain, true, false>((LAS unsigned char*)lds_raw, D, S, E);
    }
    SEAM(8);

    if (IN(9)) {
        PHASE_IDS
        const float* x = a.in[0];
        const float* norm_mix_post = a.in[5];
        const float* norm_ffn_pre = a.in[6];
        const float* router_w = a.in[30];
        const float* router_b = a.in[31];
        float* MOD = (float*)(ws + WS_MOD);
        float* Y = (float*)(ws + WS_Y);
        float* XMID = (float*)(ws + WS_XMID);
        unsigned short* H2B = (unsigned short*)(ws + WS_H2B);
        float* TOPP = (float*)(ws + WS_TOPP);
        int* LIST = (int*)(ws + WS_LIST);
        unsigned* CNT = ctl + CW_CNT;
        LAS float* h2s = (LAS float*)(LAS unsigned char*)lds_raw;
        for (int tile = blockIdx.x; tile < T / 16; tile += gridDim.x) {
            for (int rr = 0; rr < 2; ++rr) {
                const int rl = wave * 2 + rr, row = tile * 16 + rl;
                const int b = row / SEQ; const float* mod = MOD + (size_t)b * 6 * D;
                float xm[32]; float ss = 0.f;
#pragma unroll
                for (int j = 0; j < 8; ++j) { const f32x4_t yv = ld_bf4((const unsigned short*)Y + (size_t)row * D + j * 256 + lane * 4); xm[4 * j] = yv[0]; xm[4 * j + 1] = yv[1]; xm[4 * j + 2] = yv[2]; xm[4 * j + 3] = yv[3];
                    ss += yv[0] * yv[0] + yv[1] * yv[1] + yv[2] * yv[2] + yv[3] * yv[3]; }
                ss = wave_sum(ss);
                const float inv = rsqrtf(ss / D + EPS);
                float ss2 = 0.f;
#pragma unroll
                for (int j = 0; j < 8; ++j) {
                    const int d0 = j * 256 + lane * 4;
                    const float4 xv = *(const float4*)(x + (size_t)row * D + d0), nw = *(const float4*)(norm_mix_post + d0), gt = *(const float4*)(mod + 2 * D + d0);
                    xm[4 * j] = xv.x + gt.x * (xm[4 * j] * inv * nw.x); xm[4 * j + 1] = xv.y + gt.y * (xm[4 * j + 1] * inv * nw.y);
                    xm[4 * j + 2] = xv.z + gt.z * (xm[4 * j + 2] * inv * nw.z); xm[4 * j + 3] = xv.w + gt.w * (xm[4 * j + 3] * inv * nw.w);
                    *(float4*)(XMID + (size_t)row * D + d0) = make_float4(xm[4 * j], xm[4 * j + 1], xm[4 * j + 2], xm[4 * j + 3]);
                    ss2 += xm[4 * j] * xm[4 * j] + xm[4 * j + 1] * xm[4 * j + 1] + xm[4 * j + 2] * xm[4 * j + 2] + xm[4 * j + 3] * xm[4 * j + 3];
                    asm volatile("" ::: "memory");
                }
                ss2 = wave_sum(ss2);
                const float inv2 = rsqrtf(ss2 / D + EPS);
#pragma unroll
                for (int j = 0; j < 8; ++j) {
                    const int d0 = j * 256 + lane * 4;
                    const float4 nw = *(const float4*)(norm_ffn_pre + d0), sc = *(const float4*)(mod + 4 * D + d0), sh = *(const float4*)(mod + 3 * D + d0);
                    f32x4_t hv; hv[0] = xm[4 * j] * inv2 * nw.x * (1.0f + sc.x) + sh.x; hv[1] = xm[4 * j + 1] * inv2 * nw.y * (1.0f + sc.y) + sh.y;
                    hv[2] = xm[4 * j + 2] * inv2 * nw.z * (1.0f + sc.z) + sh.z; hv[3] = xm[4 * j + 3] * inv2 * nw.w * (1.0f + sc.w) + sh.w;
                    { int w8 = __builtin_amdgcn_cvt_pk_fp8_f32(hv[0], hv[1], 0, false); w8 = __builtin_amdgcn_cvt_pk_fp8_f32(hv[2], hv[3], w8, true); *(int*)((unsigned char*)H2B + (size_t)row * D + d0) = w8; }
                    *(LAS f32x4_t*)(h2s + rl * D + d0) = hv;
                    asm volatile("" ::: "memory");
                }
            }
            __syncthreads();
            {
                const int r = tid >> 5, e = tid & 31, row = tile * 16 + r;
                const LAS float* hp = h2s + r * D; float acc = 0.f;
#pragma unroll 4
                for (int d = 0; d < D; d += 4) { const f32x4_t h4 = *(const LAS f32x4_t*)(hp + d);
                    acc = fmaf(h4[0], router_w[(size_t)d * NE + e], acc); acc = fmaf(h4[1], router_w[(size_t)(d + 1) * NE + e], acc);
                    acc = fmaf(h4[2], router_w[(size_t)(d + 2) * NE + e], acc); acc = fmaf(h4[3], router_w[(size_t)(d + 3) * NE + e], acc); }
                float lgt = acc + router_b[e];
                float val[TOPK]; int idx[TOPK];
#pragma unroll
                for (int k = 0; k < TOPK; ++k) {
                    float bv = lgt; int bi = e;
#pragma unroll
                    for (int o = 1; o < 32; o <<= 1) { const float ov = __shfl_xor(bv, o); const int oi = __shfl_xor(bi, o); if (ov > bv || (ov == bv && oi < bi)) { bv = ov; bi = oi; } }
                    val[k] = bv; idx[k] = bi; if (e == bi) lgt = -3.0e38f;
                }
                float pe[TOPK], psum = 0.f;
#pragma unroll
                for (int k = 0; k < TOPK; ++k) { pe[k] = expf(val[k] - val[0]); psum += pe[k]; }
                if (e < TOPK) {
                    const float pk = e == 0 ? pe[0] : e == 1 ? pe[1] : e == 2 ? pe[2] : pe[3]; const int ik = e == 0 ? idx[0] : e == 1 ? idx[1] : e == 2 ? idx[2] : idx[3];
                    const int asg = row * TOPK + e;
                    TOPP[asg] = pk / psum;
                    const unsigned pos = atomicAdd(&CNT[ik], 1u);
                    LIST[(size_t)ik * T + pos] = asg;
                }
            }
            __syncthreads();
        }
    }
    SEAM(9);

    const int vcu = (gridDim.x % 8 == 0) ? (int)((blockIdx.x % 8) * (gridDim.x / 8) + blockIdx.x / 8) : (int)blockIdx.x;
    if (IN(10)) {
        PHASE_IDS
        const float* exp_b_gu = a.in[33];
        unsigned short* H2B = (unsigned short*)(ws + WS_H2B);
        int* LIST = (int*)(ws + WS_LIST);
        unsigned short* ACT = (unsigned short*)(ws + WS_ACT);
        unsigned short* WGU = (unsigned short*)(ws + WS_WGU);
        LAS int* mtab = (LAS int*)(LAS unsigned char*)(lds_raw + 131072);
        unsigned* CNT = ctl + CW_CNT;
        moe_tables(mtab, CNT);
        SchedMoE S{(int)gridDim.x, vcu, 2 * FF / 256, 2 * FF, mtab, LIST, (const char*)H2B, (const char*)WGU, true, 1};
        EpiGU E{(unsigned char*)ACT, exp_b_gu};
        pg8::gemm_phase<EpiGU, SchedMoE, true, true, true>((LAS unsigned char*)lds_raw, D, S, E);
    }
    SEAM(10);

    if (IN(11)) {
        PHASE_IDS
        const float* exp_b_down = a.in[35];
        int* LIST = (int*)(ws + WS_LIST);
        unsigned short* ACT = (unsigned short*)(ws + WS_ACT);
        unsigned short* YB = (unsigned short*)(ws + WS_YB);
        unsigned short* WDN = (unsigned short*)(ws + WS_WDN);
        LAS int* mtab = (LAS int*)(LAS unsigned char*)(lds_raw + 131072);
        unsigned* CNT = ctl + CW_CNT;
        moe_tables(mtab, CNT);
        SchedMoE S{(int)gridDim.x, vcu, D / 256, D, mtab, LIST, (const char*)ACT, (const char*)WDN, false, 1};
        EpiDown E{YB, exp_b_down};
        pg8::gemm_phase<EpiDown, SchedMoE, true, true, true>((LAS unsigned char*)lds_raw, FF, S, E);
    }
    SEAM(11);

    if (IN(12)) {
        PHASE_IDS
        const float* norm_ffn_post = a.in[7];
        float* MOD = (float*)(ws + WS_MOD);
        float* XMID = (float*)(ws + WS_XMID);
        float* TOPP = (float*)(ws + WS_TOPP);
        unsigned short* YB = (unsigned short*)(ws + WS_YB);
        for (int row = blockIdx.x; row < T; row += gridDim.x) {
            const int b = row / SEQ; const float* mod = MOD + (size_t)b * 6 * D; const int d0 = tid * 4;
            float ym[4] = {0.f, 0.f, 0.f, 0.f};
#pragma unroll
            for (int k = 0; k < TOPK; ++k) {
                const int asg = row * TOPK + k; const float p = TOPP[asg];
                const pg8::u32x2 v = *(const pg8::u32x2*)(YB + (size_t)asg * D + d0);
                ym[0] = fmaf(p, __uint_as_float(v.x << 16), ym[0]); ym[1] = fmaf(p, __uint_as_float(v.x & 0xffff0000u), ym[1]); ym[2] = fmaf(p, __uint_as_float(v.y << 16), ym[2]); ym[3] = fmaf(p, __uint_as_float(v.y & 0xffff0000u), ym[3]);
            }
            const float ss = block_sum(ym[0] * ym[0] + ym[1] * ym[1] + ym[2] * ym[2] + ym[3] * ym[3], sm);
            const float inv = rsqrtf(ss / D + EPS);
            const float4 xm = *(const float4*)(XMID + (size_t)row * D + d0);
            const float xa[4] = {xm.x, xm.y, xm.z, xm.w}; float o[4];
#pragma unroll
            for (int i = 0; i < 4; ++i) { const int d = d0 + i; o[i] = xa[i] + mod[5 * D + d] * (ym[i] * inv * norm_ffn_post[d]); }
            *(float4*)(a.out + (size_t)row * D + d0) = make_float4(o[0], o[1], o[2], o[3]);
        }
    }
#undef IN
#undef SEAM
}

constexpr int NPHASES = 13;
#ifndef MK_ONE_LAUNCH
#define MK_ONE_LAUNCH 1
#endif

extern "C" void kernel_launch(void* const* d_in, const int* in_sizes, int n_in, void* d_out, int out_size, void* d_ws, size_t ws_size, hipStream_t stream) {
    static int grid = 0;
    if (grid == 0) {
        if (n_in != 36 || out_size != T * D || ws_size < WS_END) { fprintf(stderr, "kernel_launch: unexpected shapes n_in %d out %d ws %zu (need %zu)\n", n_in, out_size, ws_size, (size_t)WS_END); grid = -1; return; }
        int dev = 0, cus = 0, per_cu = 0;
        if (hipGetDevice(&dev) != hipSuccess || hipDeviceGetAttribute(&cus, hipDeviceAttributeMultiprocessorCount, dev) != hipSuccess) { grid = -1; return; }
        if (hipFuncSetAttribute((const void*)fwd, hipFuncAttributeMaxDynamicSharedMemorySize, LDS_BYTES) != hipSuccess) { fprintf(stderr, "kernel_launch: hipFuncSetAttribute failed\n"); grid = -1; return; }
        if (hipOccupancyMaxActiveBlocksPerMultiprocessor(&per_cu, (const void*)fwd, NTHREADS, LDS_BYTES) != hipSuccess || per_cu < 1) { fprintf(stderr, "kernel_launch: occupancy query says %d\n", per_cu); }
        (void)hipGetLastError();
        grid = cus;
    }
    if (grid < 0) return;
    (void)hipMemsetAsync((char*)d_ws + WS_CTL, 0, CTL_BYTES, stream);
    Args a{};
    for (int i = 0; i < 36; ++i) a.in[i] = (const float*)d_in[i];
    a.out = (float*)d_out; a.ws = (unsigned char*)d_ws;
#if MK_ONE_LAUNCH
    a.ph_lo = 0; a.ph_hi = NPHASES;
    hipLaunchKernelGGL(fwd, dim3(grid), dim3(NTHREADS), LDS_BYTES, stream, a);
#else
    for (int p = 0; p < NPHASES; ++p) {
        a.ph_lo = p; a.ph_hi = p + 1;
        hipLaunchKernelGGL(fwd, dim3(grid), dim3(NTHREADS), LDS_BYTES, stream, a);
    }
#endif
}
```

```cpp
#include <hip/hip_runtime.h>
#include <cstdio>
#include <cstdint>

constexpr int D = 2048, NB = 4, SEQ = 4096, T = NB * SEQ;
constexpr int COL_K = 512, COL_V = 1024, COL_Z = 2048, COL_B = 3072, COL_A = 3080, COL_GATE = 3088, COL_R = 7184, COL_RK = 8208, COL_RV = 9232, N_IN = 10256;
constexpr int NE = 32, TOPK = 4, FF = 2048, NA = T * TOPK;
constexpr int RW = 1024;
constexpr float EPS = 1e-6f;
constexpr int NTHREADS = 512;
constexpr int LDS_BYTES = 128 * 1024 + 4096;

#define XB_TMO      128
#define XB_XCNT(j)  (256  + 64 * (j))
#define XB_XSUB(j)  (1280 + 64 * (j))
#define XB_XGEN(j)  (2304 + 64 * (j))
#define XB_TOP      3328
#define XB_TOPGEN   3392
#define XCD_BAR_WORDS 3456
#define XB_SPIN_CAP (1u << 22)
#define LAS __attribute__((address_space(3)))
__device__ __forceinline__ unsigned xb_ld(unsigned* p)              { return __hip_atomic_load(p, __ATOMIC_RELAXED, __HIP_MEMORY_SCOPE_AGENT); }
__device__ __forceinline__ unsigned xb_add(unsigned* p, unsigned v) { return __hip_atomic_fetch_add(p, v, __ATOMIC_RELAXED, __HIP_MEMORY_SCOPE_AGENT); }
__device__ __forceinline__ unsigned xb_xcc_id() { return (unsigned)__builtin_amdgcn_s_getreg((3 << 11) | 20) & 0xFu; }
#define XB_SPIN(cond, bar) do { unsigned _sp = 0; while (cond) { __builtin_amdgcn_s_sleep(1); \
    if ((++_sp & 255u) == 0u) { if (xb_ld(&(bar)[XB_TMO])) break; if (_sp > XB_SPIN_CAP) { atomicAdd(&(bar)[XB_TMO], 1u); break; } } } } while (0)
struct XcdBarrier { unsigned* bar; unsigned x; volatile LAS unsigned* st; };
__device__ __forceinline__ XcdBarrier xcd_barrier_post(unsigned* bar, volatile LAS unsigned* st) {
    XcdBarrier b; b.bar = bar; b.x = xb_xcc_id(); b.st = st;
    if (threadIdx.x == 0) (void)xb_add(&bar[XB_XCNT(b.x)], 1u);
    return b;
}
__device__ __forceinline__ void xcd_barrier_complete(unsigned* bar, unsigned x, unsigned& nloc, unsigned& nx) {
    const unsigned G = gridDim.x * gridDim.y * gridDim.z;
    unsigned sum, cnt, mine, sp = 0u;
    for (;;) {
        sum = 0u; cnt = 0u; mine = 0u;
#pragma unroll
        for (unsigned j = 0; j < 16; ++j) { const unsigned c = xb_ld(&bar[XB_XCNT(j)]); sum += c; cnt += (c > 0u) ? 1u : 0u; mine = (j == x) ? c : mine; }
        if (sum == G) break;
        __builtin_amdgcn_s_sleep(1);
        if ((++sp & 255u) == 0u) { if (xb_ld(&bar[XB_TMO])) break; if (sp > XB_SPIN_CAP) { atomicAdd(&bar[XB_TMO], 1u); break; } }
    }
    nloc = mine > 0u ? mine : 1u; nx = cnt > 0u ? cnt : 1u;
}
__device__ __forceinline__ void xcd_barrier(const XcdBarrier& b) {
    asm volatile("s_waitcnt vmcnt(0)" ::: "memory");
    __syncthreads();
    if (threadIdx.x == 0) {
        unsigned* bar = b.bar;
        __builtin_amdgcn_s_waitcnt(0);
        unsigned nloc = b.st[0], nx = b.st[1];
        if (nloc == 0u) { xcd_barrier_complete(bar, b.x, nloc, nx); b.st[0] = nloc; b.st[1] = nx; }
        const unsigned old = xb_add(&bar[XB_XSUB(b.x)], 1u);
        const unsigned gen = old / nloc;
        if (old + 1u == (gen + 1u) * nloc) {
            __builtin_amdgcn_fence(__ATOMIC_RELEASE, "agent");
            asm volatile("s_waitcnt vmcnt(0)" ::: "memory");
            const unsigned og = xb_add(&bar[XB_TOP], 1u);
            const unsigned tg = og / nx;
            if (og + 1u == (tg + 1u) * nx) xb_add(&bar[XB_TOPGEN], 1u);
            else XB_SPIN(xb_ld(&bar[XB_TOPGEN]) == tg, bar);
            __builtin_amdgcn_fence(__ATOMIC_ACQUIRE, "agent");
            xb_add(&bar[XB_XGEN(b.x)], 1u);
            asm volatile("s_waitcnt vmcnt(0)" ::: "memory");
        } else {
            XB_SPIN(xb_ld(&bar[XB_XGEN(b.x)]) == gen, bar);
            __builtin_amdgcn_fence(__ATOMIC_ACQUIRE, "agent");
            asm volatile("s_waitcnt vmcnt(0)" ::: "memory");
        }
    }
    __syncthreads();
}

constexpr size_t al256(size_t x) { return (x + 255) & ~(size_t)255; }
constexpr size_t WS_CTL   = 0;
constexpr size_t CTL_BYTES = 32768;
constexpr size_t CW_CNT   = XCD_BAR_WORDS + 64;
constexpr size_t WS_MOD   = WS_CTL + CTL_BYTES;
constexpr size_t WS_H     = al256(WS_MOD + (size_t)NB * 6 * D * 4);
constexpr size_t WS_WINT  = al256(WS_H + (size_t)7 * T * D * 2);
constexpr int NT_IN = 44;
constexpr size_t WS_PH    = al256(WS_WINT + (size_t)NT_IN * 256 * D * 2);
constexpr size_t WS_BA    = al256(WS_PH + (size_t)T * N_IN * 2);
constexpr size_t WS_LWA   = al256(WS_BA + (size_t)T * 16 * 4);
constexpr size_t WS_LGB   = al256(WS_LWA + (size_t)T * 256 * 2);
constexpr size_t WS_L2T   = al256(WS_LGB + (size_t)T * 256 * 2);
constexpr size_t WS_WPRE  = al256(WS_L2T + (size_t)3 * RW * 256 * 2);
constexpr size_t WS_APRE  = al256(WS_WPRE + (size_t)T * RW * 4);
constexpr size_t WS_GATE  = al256(WS_APRE + (size_t)T * RW * 4);
constexpr size_t WS_WD    = al256(WS_GATE + (size_t)T * RW * 4);
constexpr size_t WS_AA    = al256(WS_WD + (size_t)T * RW * 4);
constexpr size_t WS_BB    = al256(WS_AA + (size_t)T * RW * 4);
constexpr size_t WS_KM    = al256(WS_BB + (size_t)T * RW * 4);
constexpr size_t WS_OG    = al256(WS_KM + (size_t)T * RW * 4);
constexpr size_t WS_YR    = al256(WS_OG + (size_t)T * RW * 4);
constexpr size_t WS_MERGED= al256(WS_YR + (size_t)T * RW * 4);
constexpr size_t WS_Y     = al256(WS_MERGED + (size_t)T * D * 4);
constexpr size_t WS_XMID  = al256(WS_Y + (size_t)T * D * 4);
constexpr size_t WS_H2B   = al256(WS_XMID + (size_t)T * D * 4);
constexpr size_t WS_TOPP  = al256(WS_H2B + (size_t)T * D * 2);
constexpr size_t WS_LIST  = al256(WS_TOPP + (size_t)NA * 4);
constexpr int ACT_ROWS = NA + NE * 256;
constexpr size_t WS_ACT   = al256(WS_LIST + (size_t)NE * T * 4);
constexpr size_t WS_YB    = al256(WS_ACT + (size_t)ACT_ROWS * FF * 2);
constexpr size_t WS_WGU   = al256(WS_YB + (size_t)NA * D * 2);
constexpr size_t WS_WDN   = al256(WS_WGU + (size_t)NE * 2 * FF * D * 2);
constexpr size_t WS_YGB   = al256(WS_WDN + (size_t)NE * D * FF * 2);
constexpr size_t WS_YRWB  = al256(WS_YGB + (size_t)T * RW * 2);
constexpr size_t WS_WUPG  = al256(WS_YRWB + (size_t)T * RW * 2);
constexpr size_t WS_WUPR  = al256(WS_WUPG + (size_t)D * RW * 2);
constexpr size_t WS_WOUT  = al256(WS_WUPR + (size_t)D * RW * 2);
constexpr size_t WS_MRGB  = al256(WS_WOUT + (size_t)D * D * 2);
constexpr size_t WS_GREC  = al256(WS_MRGB + (size_t)T * D * 2);
constexpr size_t WS_END   = al256(WS_GREC + (size_t)2048 * 90368);

struct Args {
    const float* in[36];
    float* out;
    unsigned char* ws;
    int ph_lo, ph_hi;
};

__device__ __forceinline__ float sigmoidf_(float x) { return 1.0f / (1.0f + expf(-x)); }
__device__ __forceinline__ float siluf_(float x) { return x * sigmoidf_(x); }
__device__ __forceinline__ float softplusf_(float x) { return fmaxf(x, 0.0f) + log1pf(expf(-fabsf(x))); }
__device__ __forceinline__ float rl(float x, int k) { return __int_as_float(__builtin_amdgcn_readlane(__float_as_int(x), k)); }
__device__ __forceinline__ float wave_sum(float v) {
#pragma unroll
    for (int o = 32; o > 0; o >>= 1) v += __shfl_xor(v, o);
    return v;
}
__device__ __forceinline__ float half_sum(float v) {
#pragma unroll
    for (int o = 16; o > 0; o >>= 1) v += __shfl_xor(v, o);
    return v;
}
__device__ __forceinline__ float block_sum(float v, float* red) {
    v = wave_sum(v);
    __syncthreads();
    if ((threadIdx.x & 63) == 0) red[threadIdx.x >> 6] = v;
    __syncthreads();
    float t = 0.f;
#pragma unroll
    for (int w = 0; w < NTHREADS / 64; ++w) t += red[w];
    return t;
}

constexpr int GBM = 128, GBN = 64, GBK = 16;
template <bool DUAL, class AL, class EP>
__device__ __forceinline__ void gemm_naive(float* sm, int M, int N, int K, const AL& al, const float* __restrict__ W, int ldw, int dual_off, const EP& ep) {
    float* As = sm;
    float* Bs = sm + GBK * (GBM + 4);
    float* Bs2 = Bs + GBK * (GBN + 4);
    const int tid = threadIdx.x, tx = tid & 15, ty = tid >> 4;
    const int ntm = (M + GBM - 1) / GBM, ntn = (N + GBN - 1) / GBN;
    for (int tile = blockIdx.x; tile < ntm * ntn; tile += gridDim.x) {
        const int tm = tile / ntn, tn = tile % ntn;
        const int m0 = tm * GBM, n0 = tn * GBN;
        float acc[4][4], acc2[4][4];
#pragma unroll
        for (int i = 0; i < 4; ++i)
#pragma unroll
            for (int j = 0; j < 4; ++j) { acc[i][j] = 0.f; acc2[i][j] = 0.f; }
        for (int k0 = 0; k0 < K; k0 += GBK) {
#pragma unroll
            for (int i = 0; i < 4; ++i) { const int idx = tid + i * NTHREADS, r = idx >> 4, kk = idx & 15; As[kk * (GBM + 4) + r] = al(m0 + r, k0 + kk); }
#pragma unroll
            for (int i = 0; i < 2; ++i) { const int idx = tid + i * NTHREADS, kk = idx >> 6, c = idx & 63, n = n0 + c;
                Bs[kk * (GBN + 4) + c] = (n < N) ? W[(size_t)(k0 + kk) * ldw + n] : 0.f;
                if (DUAL) Bs2[kk * (GBN + 4) + c] = (n < N) ? W[(size_t)(k0 + kk) * ldw + n + dual_off] : 0.f; }
            __syncthreads();
#pragma unroll
            for (int kk = 0; kk < GBK; ++kk) {
                float a[4], b[4], b2[4];
#pragma unroll
                for (int i = 0; i < 4; ++i) a[i] = As[kk * (GBM + 4) + ty * 4 + i];
#pragma unroll
                for (int j = 0; j < 4; ++j) { b[j] = Bs[kk * (GBN + 4) + tx * 4 + j]; b2[j] = DUAL ? Bs2[kk * (GBN + 4) + tx * 4 + j] : 0.f; }
#pragma unroll
                for (int i = 0; i < 4; ++i)
#pragma unroll
                    for (int j = 0; j < 4; ++j) { acc[i][j] = fmaf(a[i], b[j], acc[i][j]); if (DUAL) acc2[i][j] = fmaf(a[i], b2[j], acc2[i][j]); }
            }
            __syncthreads();
        }
#pragma unroll
        for (int i = 0; i < 4; ++i)
#pragma unroll
            for (int j = 0; j < 4; ++j) { const int m = m0 + ty * 4 + i, n = n0 + tx * 4 + j; if (m < M && n < N) ep(m, n, acc[i][j], acc2[i][j]); }
    }
}

struct ALPlain { const float* A; int lda; __device__ __forceinline__ float operator()(int m, int k) const { return A[(size_t)m * lda + k]; } };
struct ALMix {
    const float* H; const float* mix;
    __device__ __forceinline__ float operator()(int m, int k) const {
        const float h = H[(size_t)m * D + k];
        const float hp = ((m % SEQ) == 0) ? 0.f : H[(size_t)(m - 1) * D + k];
        return h + (hp - h) * mix[k];
    }
};
struct ALGatherTok { const float* H2; const int* list; int cnt; __device__ __forceinline__ float operator()(int m, int k) const { return (m < cnt) ? H2[(size_t)(list[m] >> 2) * D + k] : 0.f; } };
struct ALGatherAsg { const float* ACT; const int* list; int cnt; __device__ __forceinline__ float operator()(int m, int k) const { return (m < cnt) ? ACT[(size_t)list[m] * FF + k] : 0.f; } };

namespace pg8 {
#define PG8_LAS __attribute__((address_space(3)))
typedef unsigned short bf16_t;
typedef short bf16x8 __attribute__((ext_vector_type(8)));
typedef float f32x4 __attribute__((ext_vector_type(4)));
typedef unsigned u32x4 __attribute__((ext_vector_type(4)));
typedef unsigned u32x2 __attribute__((ext_vector_type(2)));
constexpr int BM = 256, BK = 64, HALF = 128, HTB = HALF * BK * 2, STAGE_BYTES = 8 * HTB, NXCD = 8, WGM = 2;
__host__ __device__ __forceinline__ int lds_byte(int r, int c) { const int st = (r >> 4) * 2 + (c >> 5), rr = r & 15, cc = c & 31, ob = rr * 64 + cc * 2; return st * 1024 + (ob ^ (((ob >> 9) & 1) << 5)); }
__host__ __device__ __forceinline__ void stage_rc(int b, int& R, int& C) { const int st = b / 1024, sb = b % 1024, swz = sb ^ (((sb >> 9) & 1) << 5); R = (st >> 1) * 16 + swz / 64; C = (st & 1) * 32 + (swz % 64) / 2; }
__host__ __device__ __forceinline__ int perm32(int rho) { const int n = rho >> 4, i = rho & 15; return 8 * (i >> 2) + 4 * n + (i & 3); }
struct Unit { int pm, pn; const char* A; const char* B; const int* list; int cnt, e, prow, gat; };
typedef __bf16 bf16x2_t __attribute__((ext_vector_type(2)));
__device__ __forceinline__ unsigned cvt_pk_bf16(float lo, float hi) { bf16x2_t v; v.x = (__bf16)lo; v.y = (__bf16)hi; return __builtin_bit_cast(unsigned, v); }
__device__ __forceinline__ bool static_order(int nM, int nN, int G, int c, int i, int& pm, int& pn) {
    const int nwg = nM * nN; const long L = (long)i * G + c; if (L >= nwg) return false;
    int wgid = (int)L; { const int q = nwg / NXCD, r = nwg % NXCD, xcd = wgid % NXCD, off = wgid / NXCD; wgid = (xcd < r ? xcd * (q + 1) : r * (q + 1) + (xcd - r) * q) + off; }
    const int nig = WGM * nN, gid = wgid / nig, fm = gid * WGM, gsz = (nM - fm) < WGM ? (nM - fm) : WGM;
    pm = fm + ((wgid % nig) % gsz); pn = (wgid % nig) / gsz; return true;
}
template <class Epi, class Sched, bool ALIGN_EPI = true, bool GATHER = false, bool FP8 = false>
__device__ __forceinline__ void gemm_phase(PG8_LAS unsigned char* lds, const int K_, const Sched& S, const Epi& E) {
    const int tid = threadIdx.x, wid = __builtin_amdgcn_readfirstlane(tid >> 6), lane = tid & 63, wr = wid >> 2, wc = wid & 3, fr = lane & 15, fq = lane >> 4;
    const int K = K_, KB = FP8 ? K_ : 2 * K_, nt = KB / 128;
    unsigned voffA0, voffB0;
    { int R, C; stage_rc(tid * 16, R, C); const int Rb = Epi::PERM ? ((R & ~31) + perm32(R & 31)) : R;
      voffA0 = (unsigned)(R * KB + C * 2); voffB0 = (unsigned)(Rb * KB + C * 2); }
    const size_t pstep = (size_t)64 * KB;
    const size_t kstep = (size_t)(BK * 2);
    const size_t hstep = (size_t)HALF * KB;
    const size_t tstep = 2 * hstep; (void)tstep;
    const unsigned ldsw = (unsigned)wid * 1024u;
    const int cole = FP8 ? ((fq >> 1) * 32 + (fq & 1) * 16) : fq * 8;
    const int aoff = lds_byte(wr * 64 + fr, cole), boff = aoff + (wc * 2 - wr * 4) * 2048;
    typedef int _i8 __attribute__((ext_vector_type(8))); typedef _i8 _i8a __attribute__((aligned(16)));
    constexpr bool SP2 = true;
    unsigned vA_c[2][2];
    PG8_LAS unsigned* gtab = (PG8_LAS unsigned*)(lds + STAGE_BYTES + 1024);
#define PG8_FILLTAB(u) do { int _t = threadIdx.x; asm volatile("" : "+v"(_t));   if (_t < 256) { const int _m = (u).pm * 256 + _t; \
        const int _tok = (u).gat ? ((_m < (u).cnt) ? ((u).list[_m] >> 2) : 0) : _t;     \
        gtab[_t] = (unsigned)_tok * (unsigned)KB; } } while (0)
#define PG8_SETVA(v, u) do { int _t2 = threadIdx.x; if constexpr (GATHER) asm volatile("" : "+v"(_t2)); _Pragma("unroll") for (int _h = 0; _h < 2; ++_h) _Pragma("unroll") for (int _i = 0; _i < 2; ++_i) { \
        if constexpr (GATHER) { int _R, _C; stage_rc(_t2 * 16 + _i * 8192, _R, _C); (v)[_h][_i] = gtab[_h * 128 + _R] + (unsigned)(_C * 2); } \
        else (v)[_h][_i] = 0u; } } while (0)
#define PG8_STAGE_A(bufoff, gbase, h, nx) do { _Pragma("unroll") for (int _i = 0; _i < 2; ++_i) { \
        const char* _src = GATHER ? (const char*)(gbase) + vA_c[h][_i] : (const char*)(gbase) + (size_t)(h) * hstep + (size_t)_i * pstep + voffA0; \
        __builtin_amdgcn_global_load_lds((const unsigned*)_src, (PG8_LAS unsigned*)(lds + (bufoff) + ldsw + _i * 8192), 16, 0, 0); } } while (0)
#define PG8_SA(b, h) (((b) * 2 + (h)) * HTB)
#define PG8_SB(b, h) ((4 + (b) * 2 + (h)) * HTB)
#define PG8_STAGE(bufoff, gbase, voff) do { _Pragma("unroll") for (int _i = 0; _i < 2; ++_i) \
        __builtin_amdgcn_global_load_lds((const unsigned*)((const char*)(gbase) + (size_t)_i * pstep + voff##0), (PG8_LAS unsigned*)(lds + (bufoff) + ldsw + _i * 8192), 16, 0, 0); } while (0)
#define PG8_LDA(dst, b, h) do { _Pragma("unroll") for (int m = 0; m < 4; ++m) { \
        if constexpr (FP8) { dst##8[m] = *(const PG8_LAS _i8a*)(lds + PG8_SA(b, h) + aoff + m * 2048); } \
        else { _Pragma("unroll") for (int k = 0; k < 2; ++k) dst[m][k] = *(const PG8_LAS bf16x8*)(lds + PG8_SA(b, h) + aoff + m * 2048 + k * 1024); } } } while (0)
#define PG8_LDB(dst, b, h) do { _Pragma("unroll") for (int n = 0; n < 2; ++n) { \
        if constexpr (FP8) { dst##8[n] = *(const PG8_LAS _i8a*)(lds + PG8_SB(b, h) + boff + n * 2048); } \
        else { _Pragma("unroll") for (int k = 0; k < 2; ++k) dst[n][k] = *(const PG8_LAS bf16x8*)(lds + PG8_SB(b, h) + boff + n * 2048 + k * 1024); } } } while (0)
#define PG8_MMA(ai, bj, At, Bt) do { __builtin_amdgcn_s_setprio(1); _Pragma("unroll") for (int m = 0; m < 4; ++m) _Pragma("unroll") for (int n = 0; n < 2; ++n) { \
        if constexpr (FP8) acc[ai][bj][m][n] = __builtin_amdgcn_mfma_scale_f32_16x16x128_f8f6f4(Bt##8[n], At##8[m], acc[ai][bj][m][n], 0, 0, 0, 127, 0, 127); \
        else { _Pragma("unroll") for (int k = 0; k < 2; ++k) acc[ai][bj][m][n] = __builtin_amdgcn_mfma_f32_16x16x32_bf16(Bt[n][k], At[m][k], acc[ai][bj][m][n], 0, 0, 0); } } \
        __builtin_amdgcn_s_setprio(0); } while (0)
#define PG8_WAIT_V(n) asm volatile("s_waitcnt vmcnt(" #n ")" ::: "memory")
#define PG8_WAIT_L(n) asm volatile("s_waitcnt lgkmcnt(" #n ")" ::: "memory")
#define PG8_BAR __builtin_amdgcn_s_barrier()
#define PG8_SCHED __builtin_amdgcn_sched_barrier(0)
    Unit cur, nxt; int ui = 0;
    if (!S.next(0, cur)) return;
    f32x4 acc[2][2][4][2];
#pragma unroll
    for (int a = 0; a < 2; ++a)
#pragma unroll
        for (int b = 0; b < 2; ++b)
#pragma unroll
            for (int m = 0; m < 4; ++m)
#pragma unroll
                for (int n = 0; n < 2; ++n) acc[a][b][m][n] = (f32x4){0.f, 0.f, 0.f, 0.f};
    bf16x8 At[4][2], B0[2][2], B1[2][2]; _i8 At8[4], B08[2], B18[2];
    const char* cA = cur.A; const char* cB = cur.B;
    S.a_ready(cur);
    if constexpr (GATHER) { PG8_FILLTAB(cur); __syncthreads(); }
    PG8_SETVA(vA_c, cur);
    if constexpr (GATHER) __syncthreads();
    if constexpr (SP2) {
        PG8_STAGE(PG8_SB(0, 0), cB, voffB); PG8_STAGE(PG8_SB(0, 1), cB + hstep, voffB); PG8_STAGE_A(PG8_SA(0, 0), cA, 0, false); PG8_STAGE_A(PG8_SA(0, 1), cA, 1, false);
        if (wr == 1) PG8_BAR;
        PG8_WAIT_V(2); PG8_BAR;
        PG8_STAGE(PG8_SB(1, 0), cB + kstep, voffB); PG8_STAGE_A(PG8_SA(1, 0), cA + kstep, 0, false); PG8_STAGE(PG8_SB(1, 1), cB + hstep + kstep, voffB);
        PG8_WAIT_V(6); PG8_BAR;
    }
    for (;;) {
        const bool has_next = S.next(ui + 1, nxt);
        const char* nA = has_next ? nxt.A : cA; const char* nB = has_next ? nxt.B : cB;
        if constexpr (GATHER) { if (has_next) PG8_FILLTAB(nxt); }
        for (int t = 0; t < nt; t += 2) {
            const bool last = (t == nt - 2); const bool lastn = last && has_next; (void)lastn;
            const char* a1 = cA + (size_t)(t + 1) * kstep;
            const char* a2 = last ? nA : cA + (size_t)(t + 2) * kstep; const char* b2 = last ? nB : cB + (size_t)(t + 2) * kstep;
            const char* a3 = a2 + kstep; const char* b3 = b2 + kstep;
            if (last && has_next) S.a_ready(nxt);
            if constexpr (SP2) {
            PG8_LDB(B0, 0, 0); PG8_LDB(B1, 0, 1); PG8_SCHED; PG8_LDA(At, 0, 0); PG8_STAGE_A(PG8_SA(1, 1), a1, 1, false);
            PG8_WAIT_V(8); PG8_WAIT_L(0); PG8_BAR; PG8_MMA(0, 0, At, B0); PG8_MMA(0, 1, At, B1); PG8_BAR; PG8_SCHED;
            if constexpr (GATHER) { if (lastn) PG8_SETVA(vA_c, nxt); }
            PG8_LDA(At, 0, 1); PG8_STAGE(PG8_SB(0, 0), b2, voffB); PG8_STAGE(PG8_SB(0, 1), b2 + hstep, voffB); PG8_STAGE_A(PG8_SA(0, 0), a2, 0, lastn);
            PG8_WAIT_V(8); PG8_WAIT_L(0); PG8_BAR; PG8_MMA(1, 0, At, B0); PG8_MMA(1, 1, At, B1); PG8_BAR; PG8_SCHED;
            PG8_LDB(B0, 1, 0); PG8_LDB(B1, 1, 1); PG8_SCHED; PG8_LDA(At, 1, 0); PG8_STAGE_A(PG8_SA(0, 1), a2, 1, lastn);
            PG8_WAIT_V(8); PG8_WAIT_L(0); PG8_BAR; PG8_MMA(0, 0, At, B0); PG8_MMA(0, 1, At, B1); PG8_BAR; PG8_SCHED;
            PG8_LDA(At, 1, 1); PG8_STAGE(PG8_SB(1, 0), b3, voffB); PG8_STAGE(PG8_SB(1, 1), b3 + hstep, voffB); PG8_STAGE_A(PG8_SA(1, 0), a3, 0, lastn);
            PG8_WAIT_V(8); PG8_WAIT_L(0); PG8_BAR; PG8_MMA(1, 0, At, B0); PG8_MMA(1, 1, At, B1); PG8_BAR; PG8_SCHED;
            }
        }
        if constexpr (ALIGN_EPI) { if (wr == 0) PG8_BAR; }
        asm volatile("" ::: "memory");
        bool chained = false;
        if constexpr (!Epi::AFTER_DRAIN) { if constexpr (Epi::CHAIN) { if (cur.e == 0) { E.mid(acc, cur, wr, wc, fr, fq); chained = true; } else E(acc, cur, wr, wc, fr, fq); } else E(acc, cur, wr, wc, fr, fq); S.done(cur); }
        if (!has_next) break;
        if (!chained) {
#pragma unroll
        for (int a = 0; a < 2; ++a)
#pragma unroll
            for (int b = 0; b < 2; ++b)
#pragma unroll
                for (int m = 0; m < 4; ++m)
#pragma unroll
                    for (int n = 0; n < 2; ++n) acc[a][b][m][n] = (f32x4){0.f, 0.f, 0.f, 0.f};
        }
        cur = nxt; cA = nA; cB = nB; ++ui;
        if constexpr (ALIGN_EPI) { if (wr == 1) PG8_BAR; }
    }
    PG8_WAIT_V(0);
    if constexpr (!ALIGN_EPI) { if (wr == 0) PG8_BAR; }
    PG8_BAR;
    if constexpr (Epi::AFTER_DRAIN) { E.fused(acc, cur, wr, wc, fr, fq, lds, wid, lane); S.done(cur); }
#undef PG8_SA
#undef PG8_SB
#undef PG8_STAGE
#undef PG8_STAGE_A
#undef PG8_SETVA
#undef PG8_FILLTAB
#undef PG8_LDA
#undef PG8_LDB
#undef PG8_MMA
#undef PG8_WAIT_V
#undef PG8_WAIT_L
#undef PG8_BAR
#undef PG8_SCHED
}
}


typedef float f32x4_t __attribute__((ext_vector_type(4)));
__device__ __forceinline__ f32x4_t ld_bf4(const unsigned short* p) { const pg8::u32x2 v = *(const pg8::u32x2*)p; return (f32x4_t){__uint_as_float(v.x << 16), __uint_as_float(v.x & 0xffff0000u), __uint_as_float(v.y << 16), __uint_as_float(v.y & 0xffff0000u)}; }
__device__ __forceinline__ void ld_bf8(const unsigned short* p, f32x4_t& lo, f32x4_t& hi) { const pg8::u32x4 v = *(const pg8::u32x4*)p;
    lo = (f32x4_t){__uint_as_float(v.x << 16), __uint_as_float(v.x & 0xffff0000u), __uint_as_float(v.y << 16), __uint_as_float(v.y & 0xffff0000u)};
    hi = (f32x4_t){__uint_as_float(v.z << 16), __uint_as_float(v.z & 0xffff0000u), __uint_as_float(v.w << 16), __uint_as_float(v.w & 0xffff0000u)}; }
__device__ __forceinline__ float ld_bf1(const unsigned short* p) { return __uint_as_float((unsigned)(*p) << 16); }
struct SchedInProj {
    int G, c; const char* Abase; const char* Bt;
    __device__ __forceinline__ bool next(int i, pg8::Unit& u) const {
        int pm, pn; if (!pg8::static_order(T / 256, NT_IN, G, c, i, pm, pn)) return false;
        const int ai = pn < 29 ? 0 : pn < 33 ? 1 : pn < 37 ? 3 : pn < 41 ? 4 : pn == 41 ? 2 : pn == 42 ? 5 : 6;
        u.pm = pm; u.pn = pn; u.A = Abase + ((size_t)ai * T + (size_t)pm * 256) * D * 2; u.B = Bt + (size_t)pn * 256 * D * 2; u.list = nullptr; u.cnt = 0; u.e = 0; u.prow = 0; u.gat = 0; return true;
    }
    __device__ __forceinline__ void a_ready(const pg8::Unit&) const {}
    __device__ __forceinline__ void done(const pg8::Unit&) const {}
};
__device__ __forceinline__ float fast_sigmoid(float x) { return __builtin_amdgcn_rcpf(1.0f + __builtin_amdgcn_exp2f(-1.4426950408889634f * x)); }
__device__ __forceinline__ float fast_tanh(float x) { return 1.0f - 2.0f * __builtin_amdgcn_rcpf(1.0f + __builtin_amdgcn_exp2f(2.8853900817779268f * x)); }
struct EpiInProjF32 {
    static constexpr bool PERM = true, AFTER_DRAIN = false, CHAIN = false;
    unsigned short* PH; float* BA; unsigned short* LWA; unsigned short* LGB;
    __device__ __forceinline__ void operator()(const pg8::f32x4 (&acc)[2][2][4][2], const pg8::Unit& u, int wr, int wc, int fr, int fq) const {
        const int pn = u.pn; unsigned short* b16 = PH; unsigned ld = N_IN; int ncol = 256, act = 0;
        if (pn < 12) b16 = PH + pn * 256;
        else if (pn < 28) { b16 = PH + COL_GATE + (pn - 12) * 256; act = 2; }
        else if (pn == 28) { act = 4; ncol = 16; }
        else if (pn < 41) b16 = PH + COL_R + (pn - 29) * 256;
        else if (pn == 41) { act = 1; ncol = 128; b16 = LWA; ld = 256; }
        else if (pn == 42) { act = 3; ncol = 128; b16 = LWA + 128; ld = 256; }
        else { act = 2; b16 = LGB; ld = 256; }
        const unsigned row0 = (unsigned)u.pm * 256u + wr * 64 + fr;
#pragma unroll
        for (int ai = 0; ai < 2; ++ai)
#pragma unroll
            for (int m = 0; m < 4; ++m) {
                const unsigned row = row0 + ai * 128 + m * 16;
#pragma unroll
                for (int bj = 0; bj < 2; ++bj) {
                    const int cl = bj * 128 + wc * 32 + 8 * fq;
                    pg8::f32x4 v0 = acc[ai][bj][m][0], v1 = acc[ai][bj][m][1];
                    if (act == 4) { if (cl < ncol) { float* dst = BA + (size_t)row * 16 + cl; *(pg8::f32x4*)dst = v0; *(pg8::f32x4*)(dst + 4) = v1; } }
                    else {
                        if (act == 1) {
#pragma unroll
                            for (int j = 0; j < 4; ++j) { v0[j] = fast_tanh(v0[j]); v1[j] = fast_tanh(v1[j]); } }
                        if (act == 2) {
#pragma unroll
                            for (int j = 0; j < 4; ++j) { v0[j] = fast_sigmoid(v0[j]); v1[j] = fast_sigmoid(v1[j]); } }
                        if ((act == 1 || act == 3) && cl >= 96) { v0 = (pg8::f32x4){0.f, 0.f, 0.f, 0.f}; v1 = v0; }
                        if (cl < ncol) { pg8::u32x4 w; w.x = pg8::cvt_pk_bf16(v0[0], v0[1]); w.y = pg8::cvt_pk_bf16(v0[2], v0[3]); w.z = pg8::cvt_pk_bf16(v1[0], v1[1]); w.w = pg8::cvt_pk_bf16(v1[2], v1[3]);
                            *(pg8::u32x4*)(b16 + (size_t)row * ld + cl) = w; }
                    }
                }
            }
    }
};
struct SchedLora {
    int G, c; const char* LWA; const char* LGB; const char* L2T;
    __device__ __forceinline__ bool next(int i, pg8::Unit& u) const {
        int pm, pn; if (!pg8::static_order(T / 256, 12, G, c, i, pm, pn)) return false;
        const int g = pn >> 2;
        u.pm = pm; u.pn = pn; u.e = g; u.A = (g < 2 ? LWA : LGB) + (size_t)pm * 256 * 256 * 2; u.B = L2T + ((size_t)g * RW + (size_t)(pn & 3) * 256) * 256 * 2; u.list = nullptr; u.cnt = 0; u.prow = 0; u.gat = 0; return true;
    }
    __device__ __forceinline__ void a_ready(const pg8::Unit&) const {}
    __device__ __forceinline__ void done(const pg8::Unit&) const {}
};
struct EpiLora {
    static constexpr bool PERM = true, AFTER_DRAIN = false, CHAIN = false;
    float* WPRE; float* APRE; float* GATE; const float* w0; const float* a0;
    __device__ __forceinline__ void operator()(const pg8::f32x4 (&acc)[2][2][4][2], const pg8::Unit& u, int wr, int wc, int fr, int fq) const {
        const int g = u.e; float* C = g == 0 ? WPRE : g == 1 ? APRE : GATE; const float* bias = g == 0 ? w0 : a0;
        const unsigned row0 = (unsigned)u.pm * 256u + wr * 64 + fr; const int col0 = (u.pn & 3) * 256 + wc * 32 + 8 * fq;
        pg8::f32x4 bv[2][2];
#pragma unroll
        for (int bj = 0; bj < 2; ++bj)
#pragma unroll
            for (int n = 0; n < 2; ++n) bv[bj][n] = (g < 2) ? *(const pg8::f32x4*)(bias + col0 + 128 * bj + 4 * n) : (pg8::f32x4){0.f, 0.f, 0.f, 0.f};
#pragma unroll
        for (int ai = 0; ai < 2; ++ai)
#pragma unroll
            for (int m = 0; m < 4; ++m) {
                float* rp = C + (size_t)(row0 + ai * 128 + m * 16) * RW + col0;
#pragma unroll
                for (int bj = 0; bj < 2; ++bj) { *(pg8::f32x4*)(rp + 128 * bj) = acc[ai][bj][m][0] + bv[bj][0]; *(pg8::f32x4*)(rp + 128 * bj + 4) = acc[ai][bj][m][1] + bv[bj][1]; }
            }
    }
};

struct SchedMoE {
    int G, c, nN, nrows; const LAS int* tab; const int* LIST; const char* Abase; const char* W; bool gatherA; int esz;
    __device__ __forceinline__ bool next(int i, pg8::Unit& u) const {
        const int L = i * G + c; const int total = __builtin_amdgcn_readfirstlane(tab[32]) * nN; if (L >= total) return false;
        int e = 0;
        for (int k = 1; k < NE; ++k) if (__builtin_amdgcn_readfirstlane(tab[k]) * nN <= L) e = k;
        const int t0 = __builtin_amdgcn_readfirstlane(tab[e]), t1 = __builtin_amdgcn_readfirstlane(tab[e + 1]);
        const int q = L - t0 * nN, mt = t1 - t0;
        u.pm = q % mt; u.pn = q / mt; u.e = e; u.cnt = __builtin_amdgcn_readfirstlane(tab[128 + e]); u.list = LIST + (size_t)e * T; u.prow = t0 * 256 + u.pm * 256;
        u.gat = gatherA ? 1 : 0; u.A = gatherA ? Abase : Abase + (size_t)u.prow * D * esz;
        u.B = W + ((size_t)e * nrows + (size_t)u.pn * 256) * D * esz; return true;
    }
    __device__ __forceinline__ void a_ready(const pg8::Unit&) const {}
    __device__ __forceinline__ void done(const pg8::Unit&) const {}
};
struct EpiGU {
    static constexpr bool PERM = true, AFTER_DRAIN = false, CHAIN = false;
    unsigned char* ACT; const float* bgu;
    __device__ __forceinline__ void operator()(const pg8::f32x4 (&acc)[2][2][4][2], const pg8::Unit& u, int wr, int wc, int fr, int fq) const {
        const float* bg = bgu + (size_t)u.e * 2 * FF; const int f0 = 128 * u.pn + 16 * wc + 4 * fq;
        pg8::f32x4 bgv[2], buv[2];
#pragma unroll
        for (int bj = 0; bj < 2; ++bj) { bgv[bj] = *(const pg8::f32x4*)(bg + f0 + 64 * bj); buv[bj] = *(const pg8::f32x4*)(bg + FF + f0 + 64 * bj); }
        const unsigned row0 = (unsigned)u.prow + wr * 64 + fr;
#pragma unroll
        for (int ai = 0; ai < 2; ++ai)
#pragma unroll
            for (int m = 0; m < 4; ++m) {
                const unsigned row = row0 + ai * 128 + m * 16;
#pragma unroll
                for (int bj = 0; bj < 2; ++bj) {
                    const pg8::f32x4 g = acc[ai][bj][m][0] * 0.015625f + bgv[bj], up = acc[ai][bj][m][1] * 0.015625f + buv[bj];
                    float a[4];
#pragma unroll
                    for (int j = 0; j < 4; ++j) { const float gl = fminf(g[j], 7.0f), ul = fminf(fmaxf(up[j], -7.0f), 7.0f); a[j] = gl * fast_sigmoid(1.702f * gl) * (ul + 1.0f); }
                    int w8 = __builtin_amdgcn_cvt_pk_fp8_f32(a[0] * 4.0f, a[1] * 4.0f, 0, false); w8 = __builtin_amdgcn_cvt_pk_fp8_f32(a[2] * 4.0f, a[3] * 4.0f, w8, true);
                    *(int*)(ACT + (size_t)row * FF + f0 + 64 * bj) = w8;
                }
            }
    }
};
struct EpiDown {
    static constexpr bool PERM = true, AFTER_DRAIN = false, CHAIN = false;
    unsigned short* YB; const float* bd;
    __device__ __forceinline__ void operator()(const pg8::f32x4 (&acc)[2][2][4][2], const pg8::Unit& u, int wr, int wc, int fr, int fq) const {
        const float* b = bd + (size_t)u.e * D; const int col0 = u.pn * 256 + wc * 32 + 8 * fq;
        pg8::f32x4 bv[2][2];
#pragma unroll
        for (int bj = 0; bj < 2; ++bj)
#pragma unroll
            for (int n = 0; n < 2; ++n) bv[bj][n] = *(const pg8::f32x4*)(b + col0 + 128 * bj + 4 * n);
        const int ml0 = u.pm * 256 + wr * 64 + fr;
#pragma unroll
        for (int ai = 0; ai < 2; ++ai)
#pragma unroll
            for (int m = 0; m < 4; ++m) {
                const int ml = ml0 + ai * 128 + m * 16;
                if (ml < u.cnt) {
                    const unsigned asg = (unsigned)u.list[ml];
#pragma unroll
                    for (int bj = 0; bj < 2; ++bj) {
                        const pg8::f32x4 v0 = acc[ai][bj][m][0] * 0.00390625f + bv[bj][0], v1 = acc[ai][bj][m][1] * 0.00390625f + bv[bj][1];
                        pg8::u32x4 w; w.x = pg8::cvt_pk_bf16(v0[0], v0[1]); w.y = pg8::cvt_pk_bf16(v0[2], v0[3]); w.z = pg8::cvt_pk_bf16(v1[0], v1[1]); w.w = pg8::cvt_pk_bf16(v1[2], v1[3]);
                        *(pg8::u32x4*)(YB + (size_t)asg * D + col0 + 128 * bj) = w;
                    }
                }
            }
    }
};
__device__ __forceinline__ void moe_tables(LAS int* tab, const unsigned* CNT) {
    if (threadIdx.x == 0) {
        int acc = 0;
        for (int e = 0; e < NE; ++e) { const int c = (int)__hip_atomic_load(&CNT[e], __ATOMIC_RELAXED, __HIP_MEMORY_SCOPE_AGENT); tab[e] = acc; tab[64 + e] = acc * 256; tab[128 + e] = c; acc += (c + 255) >> 8; }
        tab[32] = acc; tab[96] = acc * 256;
    }
    __syncthreads();
}
__device__ __forceinline__ float bf2f(unsigned short h) { return __uint_as_float((unsigned)h << 16); }


__device__ __forceinline__ f32x4_t fmaxf_v(f32x4_t v) { return (f32x4_t){fmaxf(v[0], 1e-30f), fmaxf(v[1], 1e-30f), fmaxf(v[2], 1e-30f), fmaxf(v[3], 1e-30f)}; }
struct SchedUp {
    int G, c; const char* A0; const char* A1; const char* B0; const char* B1;
    __device__ __forceinline__ bool next(int i, pg8::Unit& u) const {
        int pm, pn; if (!pg8::static_order(T / 256, D / 256, G, c, i >> 1, pm, pn)) return false;
        const int sb = i & 1;
        u.pm = pm; u.pn = pn; u.e = sb; u.A = (sb ? A1 : A0) + (size_t)pm * 256 * RW * 2; u.B = (sb ? B1 : B0) + (size_t)pn * 256 * RW * 2; u.list = nullptr; u.cnt = 0; u.prow = 0; u.gat = 0; return true;
    }
    __device__ __forceinline__ void a_ready(const pg8::Unit&) const {}
    __device__ __forceinline__ void done(const pg8::Unit&) const {}
};
struct EpiUp {
    static constexpr bool PERM = true, AFTER_DRAIN = false, CHAIN = true;
    unsigned short* MB; const unsigned short* PH;
    __device__ __forceinline__ void mid(pg8::f32x4 (&acc)[2][2][4][2], const pg8::Unit& u, int wr, int wc, int fr, int fq) const {
        const unsigned row0 = (unsigned)u.pm * 256u + wr * 64 + fr; const int col0 = u.pn * 256 + wc * 32 + 8 * fq;
#pragma unroll
        for (int ai = 0; ai < 2; ++ai)
#pragma unroll
            for (int m = 0; m < 4; ++m) {
                const unsigned row = row0 + ai * 128 + m * 16;
#pragma unroll
                for (int bj = 0; bj < 2; ++bj) {
                    const int col = col0 + 128 * bj;
                    f32x4_t a0, a1, b0, b1; ld_bf8(PH + (size_t)row * N_IN + COL_GATE + col, a0, a1); ld_bf8(PH + (size_t)row * N_IN + COL_GATE + D + col, b0, b1);
#pragma unroll
                    for (int j = 0; j < 4; ++j) { acc[ai][bj][m][0][j] *= a0[j] * __builtin_amdgcn_rcpf(fmaxf(b0[j], 1e-30f)); acc[ai][bj][m][1][j] *= a1[j] * __builtin_amdgcn_rcpf(fmaxf(b1[j], 1e-30f)); }
                }
            }
    }
    __device__ __forceinline__ void operator()(const pg8::f32x4 (&acc)[2][2][4][2], const pg8::Unit& u, int wr, int wc, int fr, int fq) const {
        const unsigned row0 = (unsigned)u.pm * 256u + wr * 64 + fr; const int col0 = u.pn * 256 + wc * 32 + 8 * fq;
#pragma unroll
        for (int ai = 0; ai < 2; ++ai)
#pragma unroll
            for (int m = 0; m < 4; ++m) {
                const unsigned row = row0 + ai * 128 + m * 16;
#pragma unroll
                for (int bj = 0; bj < 2; ++bj) {
                    const int col = col0 + 128 * bj;
                    f32x4_t b0, b1; ld_bf8(PH + (size_t)row * N_IN + COL_GATE + D + col, b0, b1);
                    const pg8::f32x4 v0 = acc[ai][bj][m][0] * fmaxf_v(b0), v1 = acc[ai][bj][m][1] * fmaxf_v(b1);
                    pg8::u32x4 w; w.x = pg8::cvt_pk_bf16(v0[0], v0[1]); w.y = pg8::cvt_pk_bf16(v0[2], v0[3]); w.z = pg8::cvt_pk_bf16(v1[0], v1[1]); w.w = pg8::cvt_pk_bf16(v1[2], v1[3]);
                    *(pg8::u32x4*)(MB + (size_t)row * D + col) = w;
                }
            }
    }
};
struct SchedPlain {
    int G, c, nM, nN, K; const char* A; const char* B;
    __device__ __forceinline__ bool next(int i, pg8::Unit& u) const {
        int pm, pn; if (!pg8::static_order(nM, nN, G, c, i, pm, pn)) return false;
        u.pm = pm; u.pn = pn; u.e = 0; u.A = A + (size_t)pm * 256 * K * 2; u.B = B + (size_t)pn * 256 * K * 2; u.list = nullptr; u.cnt = 0; u.prow = 0; u.gat = 0; return true;
    }
    __device__ __forceinline__ void a_ready(const pg8::Unit&) const {}
    __device__ __forceinline__ void done(const pg8::Unit&) const {}
};
struct EpiF32 {
    static constexpr bool PERM = true, AFTER_DRAIN = false, CHAIN = false;
    unsigned short* C; int ldc;
    __device__ __forceinline__ void operator()(const pg8::f32x4 (&acc)[2][2][4][2], const pg8::Unit& u, int wr, int wc, int fr, int fq) const {
        const unsigned row0 = (unsigned)u.pm * 256u + wr * 64 + fr; const int col0 = u.pn * 256 + wc * 32 + 8 * fq;
#pragma unroll
        for (int ai = 0; ai < 2; ++ai)
#pragma unroll
            for (int m = 0; m < 4; ++m) {
                unsigned short* rp = C + (size_t)(row0 + ai * 128 + m * 16) * ldc + col0;
#pragma unroll
                for (int bj = 0; bj < 2; ++bj) { const pg8::f32x4 v0 = acc[ai][bj][m][0], v1 = acc[ai][bj][m][1];
                    pg8::u32x4 w; w.x = pg8::cvt_pk_bf16(v0[0], v0[1]); w.y = pg8::cvt_pk_bf16(v0[2], v0[3]); w.z = pg8::cvt_pk_bf16(v1[0], v1[1]); w.w = pg8::cvt_pk_bf16(v1[2], v1[3]);
                    *(pg8::u32x4*)(rp + 128 * bj) = w; }
            }
    }
};

#define LDS_WAIT() asm volatile("s_waitcnt lgkmcnt(0)" ::: "memory")
template <class F, class FK>
__device__ __forceinline__ void cvt_item_k(const float* __restrict__ W, int ldw, int K, const F& srccol, const FK& srcrow, unsigned short* WT, int row0, int kb, LAS float* scr, int lane) {
    const int n = lane & 31, k0 = kb * 64; const int sc = srccol(row0 + n);
#pragma unroll 8
    for (int i = 0; i < 32; ++i) { const int kk = 2 * i + (lane >> 5); const int sr = srcrow(k0 + kk); scr[kk * 33 + n] = (sc >= 0 && sr >= 0) ? W[(size_t)sr * ldw + sc] : 0.f; }
    LDS_WAIT();
    const int c = lane & 7;
#pragma unroll
    for (int j = 0; j < 4; ++j) { const int n2 = (lane >> 3) + 8 * j; const LAS float* sp = scr + (8 * c) * 33 + n2;
        pg8::u32x4 o; o.x = pg8::cvt_pk_bf16(sp[0 * 33], sp[1 * 33]); o.y = pg8::cvt_pk_bf16(sp[2 * 33], sp[3 * 33]); o.z = pg8::cvt_pk_bf16(sp[4 * 33], sp[5 * 33]); o.w = pg8::cvt_pk_bf16(sp[6 * 33], sp[7 * 33]);
        *(pg8::u32x4*)(WT + (size_t)(row0 + n2) * K + k0 + 8 * c) = o; }
    LDS_WAIT();
}
template <class F>
__device__ __forceinline__ void cvt_item(const float* __restrict__ W, int ldw, int K, const F& srccol, unsigned short* WT, int row0, int kb, LAS float* scr, int lane) {
    auto idk = [](int k) { return k; };
    cvt_item_k(W, ldw, K, srccol, idk, WT, row0, kb, scr, lane);
}
template <class FM, class FK>
__device__ __forceinline__ void cvt64(const float* __restrict__ W, int ldw, int K, const FM& map4, const FK& srcrow, unsigned short* __restrict__ WT, int row0, int kb, int lane) {
    const int n4 = lane & 15, kg = lane >> 4, k0 = kb * 64 + 16 * kg;
    int sc, dr; map4(row0, n4, sc, dr);
    f32x4_t v[16];
#pragma unroll
    for (int kk = 0; kk < 16; ++kk) { const int sr = srcrow(k0 + kk); v[kk] = (sc >= 0 && sr >= 0) ? *(const f32x4_t*)(W + (size_t)sr * ldw + sc) : (f32x4_t){0.f, 0.f, 0.f, 0.f}; }
#pragma unroll
    for (int j = 0; j < 4; ++j) {
        pg8::u32x4 o0, o1;
        o0.x = pg8::cvt_pk_bf16(v[0][j], v[1][j]); o0.y = pg8::cvt_pk_bf16(v[2][j], v[3][j]); o0.z = pg8::cvt_pk_bf16(v[4][j], v[5][j]); o0.w = pg8::cvt_pk_bf16(v[6][j], v[7][j]);
        o1.x = pg8::cvt_pk_bf16(v[8][j], v[9][j]); o1.y = pg8::cvt_pk_bf16(v[10][j], v[11][j]); o1.z = pg8::cvt_pk_bf16(v[12][j], v[13][j]); o1.w = pg8::cvt_pk_bf16(v[14][j], v[15][j]);
        unsigned short* dst = WT + (size_t)(dr + j) * K + k0;
        *(pg8::u32x4*)dst = o0; *(pg8::u32x4*)(dst + 8) = o1;
    }
}
template <class FM, class FK>
__device__ __forceinline__ void cvt64_f8(const float* __restrict__ W, int ldw, int K, const FM& map4, const FK& srcrow, unsigned char* __restrict__ WT, int row0, int kb, int lane, float scale) {
    const int n4 = lane & 15, kg = lane >> 4, k0 = kb * 64 + 16 * kg;
    int sc, dr; map4(row0, n4, sc, dr);
    f32x4_t v[16];
#pragma unroll
    for (int kk = 0; kk < 16; ++kk) { const int sr = srcrow(k0 + kk); v[kk] = (sc >= 0 && sr >= 0) ? *(const f32x4_t*)(W + (size_t)sr * ldw + sc) * scale : (f32x4_t){0.f, 0.f, 0.f, 0.f}; }
#pragma unroll
    for (int j = 0; j < 4; ++j) {
        pg8::u32x4 o;
#pragma unroll
        for (int q = 0; q < 4; ++q) { int w = __builtin_amdgcn_cvt_pk_fp8_f32(v[4 * q][j], v[4 * q + 1][j], 0, false); w = __builtin_amdgcn_cvt_pk_fp8_f32(v[4 * q + 2][j], v[4 * q + 3][j], w, true); o[q] = (unsigned)w; }
        *(pg8::u32x4*)(WT + (size_t)(dr + j) * K + k0) = o;
    }
}
__device__ __forceinline__ void inproj_src(int r, int& mat, int& col) {
    mat = 0; col = -1;
    if (r < 3072) col = r;
    else if (r < 7168) col = COL_GATE + (r - 3072);
    else if (r < 7424) { if (r - 7168 < 16) col = COL_B + (r - 7168); }
    else if (r < 10496) col = COL_R + (r - 7424);
    else if (r < 10752) { mat = 1; if (r - 10496 < 96) col = r - 10496; }
    else if (r < 11008) { mat = 2; if (r - 10752 < 96) col = r - 10752; }
    else { mat = 3; col = r - 11008; }
}

typedef short bf16x8_t __attribute__((ext_vector_type(8)));
typedef unsigned short LAS* lds_u16p;
__device__ __forceinline__ f32x4_t mma16(bf16x8_t a, bf16x8_t b, f32x4_t c) { return __builtin_amdgcn_mfma_f32_16x16x32_bf16(a, b, c, 0, 0, 0); }
__device__ __forceinline__ bf16x8_t ldfrag(const LAS unsigned short* M, int ld, int r0, int k0, int lane) { return *(const LAS bf16x8_t*)(M + (r0 + (lane & 15)) * ld + k0 + 8 * (lane >> 4)); }
__device__ __forceinline__ unsigned short f2bf(float x) { return (unsigned short)(pg8::cvt_pk_bf16(x, x) & 0xffffu); }
constexpr int GR_QG = 0, GR_W = 16384, GR_KDT = 32768, GR_AI = 49152, GR_U = 57344, GR_MISC = 90112, GR_BYTES = 90368;
constexpr int GL_KB = 0, GL_QB = 17408, GL_VT = 34816, GL_KST = 53248, GL_KDT = 71680, GL_LM = 90112, GL_TI = 107520, GL_AI = 116736, GL_SM = 125952;

__device__ __forceinline__ void tri_inverse_64(const LAS float* Lm, LAS unsigned short* Ti, int lane) {
    float xcol[64];
#pragma unroll
    for (int i = 0; i < 64; ++i) {
        float s0 = 0.f, s1 = 0.f, s2 = 0.f, s3 = 0.f;
#pragma unroll
        for (int j4 = 0; j4 < (i + 3) / 4; ++j4) {
            const f32x4_t l4 = *(const LAS f32x4_t*)(Lm + i * 68 + 4 * j4);
            if (4 * j4 + 0 < i) s0 = fmaf(l4[0], xcol[4 * j4 + 0], s0);
            if (4 * j4 + 1 < i) s1 = fmaf(l4[1], xcol[4 * j4 + 1], s1);
            if (4 * j4 + 2 < i) s2 = fmaf(l4[2], xcol[4 * j4 + 2], s2);
            if (4 * j4 + 3 < i) s3 = fmaf(l4[3], xcol[4 * j4 + 3], s3);
        }
        const float s = (s0 + s1) + (s2 + s3);
        xcol[i] = ((lane == i) ? 1.0f : 0.0f) - s;
        Ti[i * 72 + lane] = f2bf(xcol[i]);
    }
}

__device__ __forceinline__ void gdn_prep_item(int item, LAS unsigned char* lds, const unsigned short* __restrict__ PH, const float* __restrict__ BA, const float* __restrict__ convw, const float* __restrict__ A_log, const float* __restrict__ dt_bias, unsigned char* __restrict__ recs) {
    int tid_ = threadIdx.x; asm volatile("" : "+v"(tid_));
    const int tid = tid_, lane = tid & 63, wave = __builtin_amdgcn_readfirstlane(tid >> 6);
    const int ch = item & 63, hv = (item >> 6) & 7, b = item >> 9, qh = hv >> 1;
    const int s0 = ch * 64; const size_t t0 = (size_t)b * SEQ + s0;
    unsigned char* rec = recs + (size_t)item * GR_BYTES;
    LAS unsigned short* Kb = (LAS unsigned short*)(lds + GL_KB); LAS unsigned short* Qb = (LAS unsigned short*)(lds + GL_QB);
    LAS unsigned short* VT = (LAS unsigned short*)(lds + GL_VT); LAS unsigned short* KsT = (LAS unsigned short*)(lds + GL_KST); LAS unsigned short* KdT = (LAS unsigned short*)(lds + GL_KDT);
    LAS float* Lm = (LAS float*)(lds + GL_LM); LAS unsigned short* Ti = (LAS unsigned short*)(lds + GL_TI); LAS unsigned short* Ai = (LAS unsigned short*)(lds + GL_AI);
    LAS float* gcs = (LAS float*)(lds + GL_SM); LAS float* betas = gcs + 64;
    if (wave == 0) {
        const float araw = BA[(t0 + lane) * 16 + 8 + hv], braw = BA[(t0 + lane) * 16 + hv];
        float g = -expf(A_log[hv]) * softplusf_(araw + dt_bias[hv]);
#pragma unroll
        for (int o = 1; o < 64; o <<= 1) { const float t = __shfl_up(g, o); if (lane >= o) g += t; }
        gcs[lane] = g; betas[lane] = sigmoidf_(braw);
    }
    __syncthreads();
    {
        const int row = tid >> 3, cs = tid & 7, c0 = cs * 16;
        const float gcr = gcs[row], br = betas[row], glast = gcs[63];
        const float eg = expf(gcr), ekd = expf(glast - gcr);
#pragma unroll
        for (int mtx = 0; mtx < 3; ++mtx) {
            const int colbase = (mtx == 0) ? qh * 128 : (mtx == 1) ? COL_K + qh * 128 : COL_V + hv * 128;
            float acc[16];
#pragma unroll
            for (int i = 0; i < 16; ++i) acc[i] = 0.f;
#pragma unroll
            for (int j = 0; j < 4; ++j) {
                if (s0 + row - 3 + j >= 0) {
                    const unsigned short* src = PH + (t0 + row - 3 + j) * N_IN + colbase + c0; const float* cw = convw + j * 2048 + colbase + c0;
                    f32x4_t xq[4]; ld_bf8(src, xq[0], xq[1]); ld_bf8(src + 8, xq[2], xq[3]);
#pragma unroll
                    for (int i4 = 0; i4 < 4; ++i4) { const float4 wv = *(const float4*)(cw + 4 * i4);
                        acc[4 * i4] = fmaf(wv.x, xq[i4][0], acc[4 * i4]); acc[4 * i4 + 1] = fmaf(wv.y, xq[i4][1], acc[4 * i4 + 1]); acc[4 * i4 + 2] = fmaf(wv.z, xq[i4][2], acc[4 * i4 + 2]); acc[4 * i4 + 3] = fmaf(wv.w, xq[i4][3], acc[4 * i4 + 3]); }
                }
            }
            float ss = 0.f;
#pragma unroll
            for (int i = 0; i < 16; ++i) { acc[i] = acc[i] * fast_sigmoid(acc[i]); ss = fmaf(acc[i], acc[i], ss); }
            ss += __shfl_xor(ss, 1); ss += __shfl_xor(ss, 2); ss += __shfl_xor(ss, 4);
            const float rn = rsqrtf(ss + 1e-6f);
#pragma unroll
            for (int i = 0; i < 16; ++i) {
                if (mtx == 0) Qb[row * 136 + c0 + i] = f2bf(acc[i] * rn * 0.08838834764831845f);
                else if (mtx == 1) { const float kn = acc[i] * rn; Kb[row * 136 + c0 + i] = f2bf(kn); KsT[(c0 + i) * 72 + row] = f2bf(br * eg * kn); KdT[(c0 + i) * 72 + row] = f2bf(kn * ekd); }
                else VT[(c0 + i) * 72 + row] = f2bf(br * acc[i]);
            }
            asm volatile("" ::: "memory");
        }
    }
    __syncthreads();
    {
        const int mat = wave >> 2, ti = wave & 3, g4 = lane >> 4, n = lane & 15;
        const LAS unsigned short* Am = mat ? Qb : Kb;
#pragma unroll
        for (int tj = 0; tj < 4; ++tj) {
            f32x4_t acc = {0.f, 0.f, 0.f, 0.f};
#pragma unroll
            for (int ks = 0; ks < 4; ++ks) acc = mma16(ldfrag(Am, 136, 16 * ti, 32 * ks, lane), ldfrag(Kb, 136, 16 * tj, 32 * ks, lane), acc);
            const int j = 16 * tj + n; const float gj = gcs[j];
#pragma unroll
            for (int r = 0; r < 4; ++r) {
                const int i = 16 * ti + 4 * g4 + r; const float dec = __builtin_amdgcn_exp2f(1.4426950408889634f * fminf(gcs[i] - gj, 0.f));
                if (mat == 0) Lm[i * 68 + j] = (j < i) ? betas[i] * acc[r] * dec : 0.f;
                else Ai[i * 72 + j] = f2bf((j <= i) ? acc[r] * dec : 0.f);
            }
        }
    }
    __syncthreads();
    if (wave == 0) tri_inverse_64(Lm, Ti, lane);
    else {
        for (int e = tid - 64; e < 64 * 128; e += NTHREADS - 64) { const int row = e >> 7, c = e & 127; const float qv = bf2f(Qb[row * 136 + c]); Qb[row * 136 + c] = f2bf(qv * __builtin_amdgcn_exp2f(1.4426950408889634f * gcs[row])); }
    }
    __syncthreads();
    {
        const int g4 = lane >> 4, n = lane & 15;
#pragma unroll
        for (int t2 = 0; t2 < 2; ++t2) {
            const int tn = 2 * wave + t2; const LAS unsigned short* Bt = (tn < 8) ? VT : KsT; const int tb = tn & 7;
#pragma unroll
            for (int ti = 0; ti < 4; ++ti) {
                f32x4_t acc = {0.f, 0.f, 0.f, 0.f};
#pragma unroll
                for (int ks = 0; ks < 2; ++ks) acc = mma16(ldfrag(Ti, 72, 16 * ti, 32 * ks, lane), ldfrag(Bt, 72, 16 * tb, 32 * ks, lane), acc);
                if (tn < 8) *(f32x4_t*)(rec + GR_U + ((size_t)((ti * 8 + tb) * 64 + lane)) * 16) = acc;
                else {
#pragma unroll
                    for (int r = 0; r < 4; ++r) Kb[(16 * ti + 4 * g4 + r) * 136 + 16 * tb + n] = f2bf(acc[r]);
                }
            }
        }
    }
    __syncthreads();
    {
#pragma unroll
        for (int t2 = 0; t2 < 2; ++t2) {
            const int f = 2 * wave + t2;
            { const int ti = f >> 2, ks = f & 3;
              *(bf16x8_t*)(rec + GR_QG + (size_t)(f * 64 + lane) * 16) = ldfrag(Qb, 136, 16 * ti, 32 * ks, lane);
              *(bf16x8_t*)(rec + GR_W + (size_t)(f * 64 + lane) * 16) = ldfrag(Kb, 136, 16 * ti, 32 * ks, lane); }
            { const int td = f >> 1, ks = f & 1;
              *(bf16x8_t*)(rec + GR_KDT + (size_t)(f * 64 + lane) * 16) = ldfrag(KdT, 72, 16 * td, 32 * ks, lane); }
        }
        { const int f = wave, ti = f >> 1, ks = f & 1;
          *(bf16x8_t*)(rec + GR_AI + (size_t)(f * 64 + lane) * 16) = ldfrag(Ai, 72, 16 * ti, 32 * ks, lane); }
        if (tid == 0) *(float*)(rec + GR_MISC) = expf(gcs[63]);
    }
    __syncthreads();
}

__device__ __forceinline__ void gdn_scan_seq(int seq, LAS unsigned char* lds, const unsigned char* __restrict__ recs, float* __restrict__ OG) {
    const int tid = threadIdx.x, lane = tid & 63, wave = __builtin_amdgcn_readfirstlane(tid >> 6), g4 = lane >> 4, n = lane & 15;
    const int b = seq >> 3, hv = seq & 7;
    LAS unsigned short* St = (LAS unsigned short*)lds;
    LAS unsigned short* VnT = (LAS unsigned short*)(lds + 34816);
    for (int e = tid; e < 128 * 136; e += NTHREADS) St[e] = 0;
    f32x4_t S[8];
#pragma unroll
    for (int tv = 0; tv < 8; ++tv) S[tv] = (f32x4_t){0.f, 0.f, 0.f, 0.f};
    __syncthreads();
    const int ti = wave & 3;
    bf16x8_t nafr[4], nkfr[2], naifr[2]; f32x4_t nu[8]; float neg;
#define GS_LOAD(chv) do { const unsigned char* _r = recs + ((size_t)seq * 64 + (chv)) * GR_BYTES; \
        _Pragma("unroll") for (int ks = 0; ks < 4; ++ks) nafr[ks] = *(const bf16x8_t*)(_r + (wave < 4 ? GR_QG : GR_W) + (size_t)((ti * 4 + ks) * 64 + lane) * 16); \
        _Pragma("unroll") for (int ks = 0; ks < 2; ++ks) { nkfr[ks] = *(const bf16x8_t*)(_r + GR_KDT + (size_t)((wave * 2 + ks) * 64 + lane) * 16); naifr[ks] = *(const bf16x8_t*)(_r + GR_AI + (size_t)((ti * 2 + ks) * 64 + lane) * 16); } \
        if (wave >= 4) { _Pragma("unroll") for (int tv = 0; tv < 8; ++tv) nu[tv] = *(const f32x4_t*)(_r + GR_U + (size_t)((ti * 8 + tv) * 64 + lane) * 16); } \
        neg = *(const float*)(_r + GR_MISC); } while (0)
    GS_LOAD(0);
    for (int ch = 0; ch < 64; ++ch) {
        bf16x8_t afr[4], kfr[2], aifr[2]; f32x4_t ucur[8];
#pragma unroll
        for (int ks = 0; ks < 4; ++ks) afr[ks] = nafr[ks];
#pragma unroll
        for (int ks = 0; ks < 2; ++ks) { kfr[ks] = nkfr[ks]; aifr[ks] = naifr[ks]; }
#pragma unroll
        for (int tv = 0; tv < 8; ++tv) ucur[tv] = nu[tv];
        const float eg = neg;
        if (ch + 1 < 64) GS_LOAD(ch + 1);
        f32x4_t acc1[8];
#pragma unroll
        for (int tv = 0; tv < 8; ++tv) {
            f32x4_t a = {0.f, 0.f, 0.f, 0.f};
#pragma unroll
            for (int ks = 0; ks < 4; ++ks) a = mma16(afr[ks], ldfrag(St, 136, 16 * tv, 32 * ks, lane), a);
            acc1[tv] = a;
        }
        if (wave >= 4) {
#pragma unroll
            for (int tv = 0; tv < 8; ++tv) {
                const f32x4_t vn = ucur[tv] - acc1[tv];
                pg8::u32x2 w2; w2.x = pg8::cvt_pk_bf16(vn[0], vn[1]); w2.y = pg8::cvt_pk_bf16(vn[2], vn[3]);
                *(LAS pg8::u32x2*)(VnT + (16 * tv + n) * 72 + 16 * ti + 4 * g4) = w2;
            }
        }
        __syncthreads();
        if (wave < 4) {
#pragma unroll
            for (int tv = 0; tv < 8; ++tv) {
                f32x4_t o = acc1[tv];
#pragma unroll
                for (int ks = 0; ks < 2; ++ks) o = mma16(aifr[ks], ldfrag(VnT, 72, 16 * tv, 32 * ks, lane), o);
#pragma unroll
                for (int r = 0; r < 4; ++r) OG[((size_t)b * SEQ + ch * 64 + 16 * ti + 4 * g4 + r) * RW + hv * 128 + 16 * tv + n] = o[r];
            }
        }
#pragma unroll
        for (int tv = 0; tv < 8; ++tv) {
            f32x4_t s = S[tv] * eg;
#pragma unroll
            for (int ks = 0; ks < 2; ++ks) s = mma16(kfr[ks], ldfrag(VnT, 72, 16 * tv, 32 * ks, lane), s);
            S[tv] = s;
            pg8::u32x2 w2; w2.x = pg8::cvt_pk_bf16(s[0], s[1]); w2.y = pg8::cvt_pk_bf16(s[2], s[3]);
            *(LAS pg8::u32x2*)(St + (16 * tv + n) * 136 + 16 * wave + 4 * g4) = w2;
        }
        __syncthreads();
    }
#undef GS_LOAD
}

constexpr int RT = 32;
constexpr int RBUF_FLOATS = 5 * RT * 64 + RT * 32 + RT * 2;
typedef float f32x2_t __attribute__((ext_vector_type(2)));
__device__ __forceinline__ float dpp_f(float x, const int ctrl_sel) {
    const int xi = __float_as_int(x); int r;
    if (ctrl_sel == 0) r = __builtin_amdgcn_update_dpp(0, xi, 0xB1, 0xF, 0xF, true);
    else if (ctrl_sel == 1) r = __builtin_amdgcn_update_dpp(0, xi, 0x4E, 0xF, 0xF, true);
    else if (ctrl_sel == 2) r = __builtin_amdgcn_update_dpp(0, xi, 0x141, 0xF, 0xF, true);
    else r = __builtin_amdgcn_update_dpp(0, xi, 0x140, 0xF, 0xF, true);
    return __int_as_float(r);
}
__device__ __forceinline__ float sum8(float x) { x += dpp_f(x, 0); x += dpp_f(x, 1); x += dpp_f(x, 2); return x; }
__device__ __forceinline__ float fast_softplus(float x) { return fmaxf(x, 0.0f) + 0.6931471805599453f * __builtin_amdgcn_logf(1.0f + __builtin_amdgcn_exp2f(-1.4426950408889634f * fabsf(x))); }
__device__ __forceinline__ void rwkv_scan_block(int sq, int half, LAS float* lds, const float* __restrict__ WPRE, const float* __restrict__ APRE, const unsigned short* __restrict__ PH,
                                                const float* __restrict__ k_k, const float* __restrict__ k_a, const float* __restrict__ r_k, float* __restrict__ BON, float* __restrict__ YR) {
    const int tid = threadIdx.x, lane = tid & 63, wave = __builtin_amdgcn_readfirstlane(tid >> 6);
    const int b = sq >> 4, h = sq & 15, rbase = half * 32;
    const size_t t0 = (size_t)b * SEQ;
    const int lt = tid - 256;
    f32x4_t s0w[2], s0a[2], s0k[2], s0r[2], s0v, s1w[2], s1a[2], s1k[2], s1r[2], s1v;
    f32x4_t kkc = {0.f, 0.f, 0.f, 0.f}, kac = kkc, rkc = kkc;
    if (lt >= 0) { const int colc = h * 64 + (lt & 15) * 4; kkc = *(const f32x4_t*)(k_k + colc); kac = *(const f32x4_t*)(k_a + colc); rkc = *(const f32x4_t*)(r_k + colc); }
    f32x2_t S2[4];
#pragma unroll
    for (int k = 0; k < 4; ++k) S2[k] = (f32x2_t){0.f, 0.f};
#define RW_LOAD(c, P) do { _Pragma("unroll") for (int i = 0; i < 2; ++i) { const int f = lt + 256 * i, st = f >> 4, c4 = f & 15; const size_t t = t0 + (size_t)(c) * RT + st; const int col = h * 64 + c4 * 4; \
        P##w[i] = *(const f32x4_t*)(WPRE + t * RW + col); P##a[i] = *(const f32x4_t*)(APRE + t * RW + col); P##k[i] = ld_bf4(PH + t * N_IN + COL_RK + col); P##r[i] = ld_bf4(PH + t * N_IN + COL_R + col); } \
        { const int st = lt >> 3, c4 = lt & 7; P##v = ld_bf4(PH + (t0 + (size_t)(c) * RT + st) * N_IN + COL_RV + h * 64 + rbase + c4 * 4); } } while (0)
#define RW_STORE(bufp, P, c) do { LAS float* _b = (bufp); _Pragma("unroll") for (int i = 0; i < 2; ++i) { const int f = lt + 256 * i, st = f >> 4, c4 = f & 15; \
        f32x4_t wd, av, kkv; float ss = 0.f; \
        _Pragma("unroll") for (int j = 0; j < 4; ++j) { const float wlog = -fast_softplus(-P##w[i][j]) - 0.5f; wd[j] = __builtin_amdgcn_exp2f(-1.4426950408889634f * __builtin_amdgcn_exp2f(1.4426950408889634f * wlog)); av[j] = fast_sigmoid(P##a[i][j]); kkv[j] = P##k[i][j] * kkc[j]; ss = fmaf(kkv[j], kkv[j], ss); } \
        ss += __shfl_xor(ss, 1); ss += __shfl_xor(ss, 2); ss += __shfl_xor(ss, 4); ss += __shfl_xor(ss, 8); \
        const float rn = rsqrtf(ss + 1e-6f); f32x4_t aav, bbv, kmv; float br = 0.f, kr = 0.f, bo = 0.f; \
        _Pragma("unroll") for (int j = 0; j < 4; ++j) { const float kk = kkv[j] * rn; aav[j] = -kk; bbv[j] = kk * av[j]; kmv[j] = P##k[i][j] * (1.0f + (av[j] - 1.0f) * kac[j]); \
            br = fmaf(bbv[j], P##r[i][j], br); kr = fmaf(kmv[j], P##r[i][j], kr); bo = fmaf(P##r[i][j] * kmv[j], rkc[j], bo); } \
        *(LAS f32x4_t*)(_b + 0 * RT * 64 + st * 64 + c4 * 4) = wd; *(LAS f32x4_t*)(_b + 1 * RT * 64 + st * 64 + c4 * 4) = bbv; *(LAS f32x4_t*)(_b + 2 * RT * 64 + st * 64 + c4 * 4) = kmv; \
        const f32x4_t _x = wd * P##r[i]; \
        *(LAS f32x4_t*)(_b + 3 * RT * 64 + st * 128 + c4 * 8) = (f32x4_t){aav[0], _x[0], aav[1], _x[1]}; *(LAS f32x4_t*)(_b + 3 * RT * 64 + st * 128 + c4 * 8 + 4) = (f32x4_t){aav[2], _x[2], aav[3], _x[3]}; \
        br += __shfl_xor(br, 1); br += __shfl_xor(br, 2); br += __shfl_xor(br, 4); br += __shfl_xor(br, 8); kr += __shfl_xor(kr, 1); kr += __shfl_xor(kr, 2); kr += __shfl_xor(kr, 4); kr += __shfl_xor(kr, 8); \
        bo += __shfl_xor(bo, 1); bo += __shfl_xor(bo, 2); bo += __shfl_xor(bo, 4); bo += __shfl_xor(bo, 8); \
        if (c4 == 0) { _b[5 * RT * 64 + RT * 32 + st * 2] = br; _b[5 * RT * 64 + RT * 32 + st * 2 + 1] = kr; if (half == 0) BON[(t0 + (size_t)(c) * RT + st) * 16 + h] = bo; } } \
        { const int st = lt >> 3, c4 = lt & 7; *(LAS f32x4_t*)(_b + 5 * RT * 64 + st * 32 + c4 * 4) = P##v; } } while (0)
    constexpr int NCH = SEQ / RT;
    const int rloc = wave * 8 + (lane >> 4) * 2, kq = (lane & 15) * 4;
    LAS float* ybuf = lds + 2 * RBUF_FLOATS;
    f32x2_t T2[4];
#pragma unroll
    for (int k = 0; k < 4; ++k) T2[k] = (f32x2_t){0.f, 0.f};
    f32x4_t Aw, Ab, Ak, Ax0, Ax1, Bw, Bb, Bk, Bx0, Bx1; f32x2_t Av, Bv, Ar, Br;
#define RW_LD(X, buf, st) do { const LAS float* _p = (buf) + (st) * 64 + kq; \
        X##w = *(const LAS f32x4_t*)(_p); X##b = *(const LAS f32x4_t*)(_p + RT * 64); X##k = *(const LAS f32x4_t*)(_p + 2 * RT * 64); \
        const LAS float* _q = (buf) + 3 * RT * 64 + (st) * 128 + kq * 2; X##x0 = *(const LAS f32x4_t*)(_q); X##x1 = *(const LAS f32x4_t*)(_q + 4); \
        X##v = *(const LAS f32x2_t*)((buf) + 5 * RT * 64 + (st) * 32 + rloc); X##r = *(const LAS f32x2_t*)((buf) + 5 * RT * 64 + RT * 32 + (st) * 2); } while (0)
#define RW_SUM16(x) do { x += dpp_f(x, 0); x += dpp_f(x, 1); x += dpp_f(x, 2); x += dpp_f(x, 3); } while (0)
#define RW_STEP(X, yb, st) do { \
        f32x2_t e0 = S2[0][0] * (f32x2_t){X##x0[0], X##x0[1]}, e1 = T2[0][0] * (f32x2_t){X##x0[0], X##x0[1]}; \
        e0 += S2[0][1] * (f32x2_t){X##x0[2], X##x0[3]}; e1 += T2[0][1] * (f32x2_t){X##x0[2], X##x0[3]}; \
        e0 += S2[1][0] * (f32x2_t){X##x1[0], X##x1[1]}; e1 += T2[1][0] * (f32x2_t){X##x1[0], X##x1[1]}; \
        e0 += S2[1][1] * (f32x2_t){X##x1[2], X##x1[3]}; e1 += T2[1][1] * (f32x2_t){X##x1[2], X##x1[3]}; \
        float sa0 = e0[0], pp0 = e0[1], sa1 = e1[0], pp1 = e1[1]; RW_SUM16(sa0); RW_SUM16(sa1); RW_SUM16(pp0); RW_SUM16(pp1); \
        const f32x2_t w01 = (f32x2_t){X##w[0], X##w[1]}, w23 = (f32x2_t){X##w[2], X##w[3]}, b01 = (f32x2_t){X##b[0], X##b[1]}, b23 = (f32x2_t){X##b[2], X##b[3]}, k01 = (f32x2_t){X##k[0], X##k[1]}, k23 = (f32x2_t){X##k[2], X##k[3]}; \
        S2[0] = S2[0] * w01 + (sa0 * b01 + X##v[0] * k01); S2[1] = S2[1] * w23 + (sa0 * b23 + X##v[0] * k23); \
        T2[0] = T2[0] * w01 + (sa1 * b01 + X##v[1] * k01); T2[1] = T2[1] * w23 + (sa1 * b23 + X##v[1] * k23); \
        *(LAS f32x2_t*)((yb) + (st) * 32 + rloc) = (f32x2_t){pp0 + sa0 * X##r[0] + X##v[0] * X##r[1], pp1 + sa1 * X##r[0] + X##v[1] * X##r[1]}; } while (0)
#define RW_COMPUTE(c) do { const LAS float* buf = lds + ((c) & 1) * RBUF_FLOATS; LAS float* yb = ybuf + ((c) & 1) * RT * 32; \
        RW_LD(A, buf, 0); \
        for (int st = 0; st < RT; st += 2) { RW_LD(B, buf, st + 1); RW_STEP(A, yb, st); if (st + 2 < RT) RW_LD(A, buf, st + 2); RW_STEP(B, yb, st + 1); } } while (0)
#define RW_FLUSH(c) do { const int st = lt >> 3, c4 = lt & 7; *(f32x4_t*)(YR + (t0 + (size_t)(c) * RT + st) * RW + h * 64 + rbase + c4 * 4) = *(const LAS f32x4_t*)(ybuf + ((c) & 1) * RT * 32 + st * 32 + c4 * 4); } while (0)
    if (wave >= 4) {
        RW_LOAD(0, s0); RW_STORE(lds, s0, 0); RW_LOAD(1, s0); RW_LOAD(2, s1);
        __syncthreads();
        for (int c = 0; c < NCH; c += 2) {
            RW_STORE(lds + RBUF_FLOATS, s0, c + 1); if (c + 3 < NCH) RW_LOAD(c + 3, s0); if (c > 0) RW_FLUSH(c - 1);
            __syncthreads();
            if (c + 2 < NCH) { RW_STORE(lds, s1, c + 2); } if (c + 4 < NCH) RW_LOAD(c + 4, s1); RW_FLUSH(c);
            __syncthreads();
        }
        RW_FLUSH(NCH - 1);
    } else {
        __builtin_amdgcn_s_setprio(3);
        __syncthreads();
        for (int c = 0; c < NCH; c += 2) {
            RW_COMPUTE(c);
            __syncthreads();
            RW_COMPUTE(c + 1);
            __syncthreads();
        }
        __builtin_amdgcn_s_setprio(0);
    }
#undef RW_COMPUTE
#undef RW_FLUSH
#undef RW_LD
#undef RW_STEP
#undef RW_SUM16
#undef RW_LOAD
#undef RW_STORE
}

__global__ void __launch_bounds__(NTHREADS, 2) fwd(Args a) {
    extern __shared__ __attribute__((aligned(16))) unsigned char lds_raw[];
    float* sm = (float*)lds_raw;
#define PHASE_IDS int tid = threadIdx.x; asm volatile("" : "+v"(tid)); const int lane = tid & 63, wave = tid >> 6; (void)lane; (void)wave;
    unsigned char* ws = a.ws;
    unsigned* ctl = (unsigned*)(ws + WS_CTL);
    volatile LAS unsigned* xbw = (volatile LAS unsigned*)(LAS unsigned char*)(lds_raw + LDS_BYTES - 16);
    if (threadIdx.x == 0) { xbw[0] = 0u; xbw[1] = 0u; xbw[2] = 0u; xbw[3] = 0u; }
    __syncthreads();
    const int lo = a.ph_lo, hi = a.ph_hi;
    XcdBarrier bar; bar.bar = ctl; bar.x = 0; bar.st = xbw;
    if (hi - lo > 1) bar = xcd_barrier_post(ctl, xbw);
#define IN(k) (lo <= (k) && (k) < hi)
#define SEAM(k) do { if (IN(k) && IN((k) + 1)) xcd_barrier(bar); } while (0)


    if (IN(0)) {
        PHASE_IDS
        const float* c = a.in[1];
        const float* ada_w = a.in[2];
        const float* ada_b = a.in[3];
        const float* w_in = a.in[8];
        const float* rwkv_w1 = a.in[15];
        const float* rwkv_a1 = a.in[18];
        const float* rwkv_g1 = a.in[20];
        const float* w_up_gdn = a.in[27];
        const float* w_up_rwkv = a.in[28];
        const float* w_out = a.in[29];
        const float* exp_w_gu = a.in[32];
        const float* exp_w_down = a.in[34];
        float* MOD = (float*)(ws + WS_MOD);
        unsigned short* WINT = (unsigned short*)(ws + WS_WINT);
        unsigned short* WUPG = (unsigned short*)(ws + WS_WUPG);
        unsigned short* WUPR = (unsigned short*)(ws + WS_WUPR);
        unsigned short* WOUT = (unsigned short*)(ws + WS_WOUT);
        unsigned short* WGU = (unsigned short*)(ws + WS_WGU);
        unsigned short* WDN = (unsigned short*)(ws + WS_WDN);
        float* sc = sm;
        float* part = sm + NB * D;
        for (int i = tid; i < NB * D; i += NTHREADS) sc[i] = siluf_(c[i]);
        __syncthreads();
        for (int cb = blockIdx.x; cb < 6 * D / 48; cb += gridDim.x) {
            const int cc = tid % 48, kg = tid / 48, col = cb * 48 + cc;
            if (tid < 480) {
                float acc0 = 0.f, acc1 = 0.f, acc2 = 0.f, acc3 = 0.f;
#pragma unroll 8
                for (int k = kg; k < D; k += 10) {
                    const float w = ada_w[(size_t)k * (6 * D) + col];
                    acc0 = fmaf(sc[k], w, acc0); acc1 = fmaf(sc[D + k], w, acc1); acc2 = fmaf(sc[2 * D + k], w, acc2); acc3 = fmaf(sc[3 * D + k], w, acc3);
                }
                part[(kg * 4 + 0) * 48 + cc] = acc0; part[(kg * 4 + 1) * 48 + cc] = acc1; part[(kg * 4 + 2) * 48 + cc] = acc2; part[(kg * 4 + 3) * 48 + cc] = acc3;
            }
            __syncthreads();
            if (tid < 192) {
                const int bb = tid / 48, c2 = tid % 48; float t = ada_b[cb * 48 + c2];
#pragma unroll
                for (int g = 0; g < 10; ++g) t += part[(g * 4 + bb) * 48 + c2];
                MOD[(size_t)bb * 6 * D + cb * 48 + c2] = t;
            }
            __syncthreads();
        }
        {
            const int gw = blockIdx.x * (NTHREADS / 64) + wave, ngw = gridDim.x * (NTHREADS / 64);
            auto idk = [](int k) { return k; };
            constexpr int N_IP = (NT_IN * 256 / 64) * (D / 64);
            constexpr int N_GU = NE * (2 * FF / 64) * (D / 64), N_DN = NE * (D / 64) * (FF / 64);
            constexpr int N_L2 = 3 * (RW / 64) * (256 / 64), N_UP = (D / 64) * (RW / 64), N_OUT = (D / 64) * (D / 64);
            constexpr int N_ALL = N_IP + N_GU + N_DN + N_L2 + 2 * N_UP + N_OUT;
            constexpr int N_P5 = (N_GU + N_DN) * 100 / 100;
            for (int it0 = gw + N_P5; it0 < N_ALL; it0 += ngw) {
                int it = it0;
                if (it < N_GU) {
                    const int e = it / ((2 * FF / 64) * (D / 64)), r = it % ((2 * FF / 64) * (D / 64)), rb = r / (D / 64), kb = r % (D / 64);
                    auto m4 = [](int row0, int n4, int& scol, int& drow) { const int pn = row0 >> 8, cb8 = (row0 & 255) >> 3, ft = 128 * pn + (cb8 + (n4 & 7)) * 4; scol = (n4 < 8) ? ft : FF + ft; drow = row0 + (n4 & 7) * 8 + ((n4 < 8) ? 0 : 4); };
                    cvt64(exp_w_gu + (size_t)e * D * 2 * FF, 2 * FF, D, m4, idk, WGU + (size_t)e * 2 * FF * D, rb * 64, kb, lane); continue; }
                it -= N_GU;
                auto mid = [](int row0, int n4, int& scol, int& drow) { scol = row0 + 4 * n4; drow = scol; };
                if (it < N_DN) {
                    const int e = it / ((D / 64) * (FF / 64)), r = it % ((D / 64) * (FF / 64)), rb = r / (FF / 64), kb = r % (FF / 64);
                    cvt64(exp_w_down + (size_t)e * FF * D, D, FF, mid, idk, WDN + (size_t)e * D * FF, rb * 64, kb, lane); continue; }
                it -= N_DN;
                if (it < N_IP) {
                    const int rb = it / (D / 64), kb = it % (D / 64), row0 = rb * 64;
                    int mat, col0; inproj_src(row0, mat, col0);
                    const float* W = mat == 0 ? w_in : mat == 1 ? rwkv_w1 : mat == 2 ? rwkv_a1 : rwkv_g1;
                    const int ldw = mat == 0 ? N_IN : mat == 3 ? 256 : 96;
                    auto m4 = [](int r0, int n4, int& scol, int& drow) { int m2; drow = r0 + 4 * n4; inproj_src(drow, m2, scol); };
                    cvt64(W, ldw, D, m4, idk, WINT, row0, kb, lane); continue; }
                it -= N_IP;
                if (it < N_L2) {
                    const float* rwkv_w2 = a.in[16]; const float* rwkv_a2 = a.in[19]; const float* rwkv_g2 = a.in[21]; unsigned short* L2T = (unsigned short*)(ws + WS_L2T);
                    constexpr int NL = (RW / 64) * 4; const int g = it / NL, r = it % NL, rb = r / 4, kb = r % 4;
                    if (g == 0) { auto fk = [](int k) { return k < 96 ? k : -1; }; cvt64(rwkv_w2, RW, 256, mid, fk, L2T, rb * 64, kb, lane); }
                    else if (g == 1) { auto fk = [](int k) { return (k >= 128 && k < 224) ? k - 128 : -1; }; cvt64(rwkv_a2, RW, 256, mid, fk, L2T + (size_t)RW * 256, rb * 64, kb, lane); }
                    else cvt64(rwkv_g2, RW, 256, mid, idk, L2T + (size_t)2 * RW * 256, rb * 64, kb, lane);
                    continue; }
                it -= N_L2;
                if (it < N_UP) { cvt64(w_up_gdn, D, RW, mid, idk, WUPG, (it / (RW / 64)) * 64, it % (RW / 64), lane); continue; }
                it -= N_UP;
                if (it < N_UP) { cvt64(w_up_rwkv, D, RW, mid, idk, WUPR, (it / (RW / 64)) * 64, it % (RW / 64), lane); continue; }
                it -= N_UP;
                cvt64(w_out, D, D, mid, idk, WOUT, (it / (D / 64)) * 64, it % (D / 64), lane);
            }
        }
    }
    SEAM(0);

    if (IN(1)) {
        PHASE_IDS
        const float* x = a.in[0]; const float* norm_mix_pre = a.in[4]; const float* rwkv_mix = a.in[13];
        float* MOD = (float*)(ws + WS_MOD); unsigned short* AM = (unsigned short*)(ws + WS_H);
        LAS float* invs = (LAS float*)(LAS unsigned char*)lds_raw;
        for (int chunk = blockIdx.x; chunk < T / 64; chunk += gridDim.x) {
            const int r0 = chunk * 64, b = r0 / SEQ; const float* mod = MOD + (size_t)b * 6 * D;
            __syncthreads();
            for (int rr = wave; rr < 65; rr += NTHREADS / 64) {
                const int row = r0 - 1 + rr; float ss = 0.f;
                if (rr > 0 || (r0 % SEQ) != 0) {
#pragma unroll
                    for (int j = 0; j < 8; ++j) { const float4 t4 = *(const float4*)(x + (size_t)row * D + j * 256 + lane * 4); ss += t4.x * t4.x + t4.y * t4.y + t4.z * t4.z + t4.w * t4.w; }
                    ss = wave_sum(ss);
                }
                if (lane == 0) invs[rr] = rsqrtf(ss / D + EPS);
            }
            __syncthreads();
            const int d0 = tid * 4;
            const float4 nw = *(const float4*)(norm_mix_pre + d0), sc4 = *(const float4*)(mod + D + d0), sh4 = *(const float4*)(mod + d0);
            const float g0 = nw.x * (1.0f + sc4.x), g1 = nw.y * (1.0f + sc4.y), g2 = nw.z * (1.0f + sc4.z), g3 = nw.w * (1.0f + sc4.w);
            float4 mx[6];
#pragma unroll
            for (int mi = 0; mi < 6; ++mi) mx[mi] = *(const float4*)(rwkv_mix + mi * D + d0);
            float p0 = 0.f, p1 = 0.f, p2 = 0.f, p3 = 0.f;
            if ((r0 % SEQ) != 0) { const float4 xp = *(const float4*)(x + (size_t)(r0 - 1) * D + d0); const float ip = invs[0];
                p0 = xp.x * ip * g0 + sh4.x; p1 = xp.y * ip * g1 + sh4.y; p2 = xp.z * ip * g2 + sh4.z; p3 = xp.w * ip * g3 + sh4.w; }
#pragma unroll 4
            for (int rr = 0; rr < 64; ++rr) {
                const size_t o = (size_t)(r0 + rr) * D + d0;
                const float4 xc = *(const float4*)(x + o); const float inv = invs[rr + 1];
                const float h0 = xc.x * inv * g0 + sh4.x, h1 = xc.y * inv * g1 + sh4.y, h2 = xc.z * inv * g2 + sh4.z, h3 = xc.w * inv * g3 + sh4.w;
                pg8::u32x2 w; w.x = pg8::cvt_pk_bf16(h0, h1); w.y = pg8::cvt_pk_bf16(h2, h3);
                *(pg8::u32x2*)(AM + o) = w;
#pragma unroll
                for (int mi = 0; mi < 6; ++mi) {
                    pg8::u32x2 w2; w2.x = pg8::cvt_pk_bf16(h0 + (p0 - h0) * mx[mi].x, h1 + (p1 - h1) * mx[mi].y); w2.y = pg8::cvt_pk_bf16(h2 + (p2 - h2) * mx[mi].z, h3 + (p3 - h3) * mx[mi].w);
                    *(pg8::u32x2*)(AM + (size_t)(mi + 1) * T * D + o) = w2;
                }
                p0 = h0; p1 = h1; p2 = h2; p3 = h3;
            }
        }
    }
    SEAM(1);

    if (IN(2)) {
        PHASE_IDS
        unsigned short* AM = (unsigned short*)(ws + WS_H);
        unsigned short* WINT = (unsigned short*)(ws + WS_WINT);
        unsigned short* PH = (unsigned short*)(ws + WS_PH);
        SchedInProj S{(int)gridDim.x, (int)blockIdx.x, (const char*)AM, (const char*)WINT};
        EpiInProjF32 E{PH, (float*)(ws + WS_BA), (unsigned short*)(ws + WS_LWA), (unsigned short*)(ws + WS_LGB)};
        pg8::gemm_phase<EpiInProjF32, SchedInProj, true, false>((LAS unsigned char*)lds_raw, D, S, E);
    }
    SEAM(2);

    if (IN(3)) {
        PHASE_IDS
        const float* gdn_conv = a.in[9];
        const float* gdn_A_log = a.in[10];
        const float* gdn_dt_bias = a.in[11];
        const float* rwkv_w0 = a.in[14];
        const float* rwkv_w2 = a.in[16];
        const float* rwkv_a0 = a.in[17];
        const float* rwkv_a2 = a.in[19];
        const float* rwkv_g2 = a.in[21];
        unsigned short* PH = (unsigned short*)(ws + WS_PH);
        float* WPRE = (float*)(ws + WS_WPRE);
        float* APRE = (float*)(ws + WS_APRE);
        float* GATE = (float*)(ws + WS_GATE);
        unsigned char* GREC = ws + WS_GREC;
        {
            SchedLora S{(int)gridDim.x, (int)blockIdx.x, (const char*)(ws + WS_LWA), (const char*)(ws + WS_LGB), (const char*)(ws + WS_L2T)};
            EpiLora E{WPRE, APRE, GATE, rwkv_w0, rwkv_a0};
            int klora = 256; asm volatile("" : "+s"(klora));
            pg8::gemm_phase<EpiLora, SchedLora, true, false>((LAS unsigned char*)lds_raw, klora, S, E);
        }
        __syncthreads();
        for (int item = blockIdx.x; item < 2048; item += gridDim.x) gdn_prep_item(item, (LAS unsigned char*)lds_raw, PH, (const float*)(ws + WS_BA), gdn_conv, gdn_A_log, gdn_dt_bias, GREC);
    }
    SEAM(3);


    if (IN(5)) {
        PHASE_IDS
        unsigned short* PH = (unsigned short*)(ws + WS_PH);
        unsigned char* GREC = ws + WS_GREC;
        float* WD = (float*)(ws + WS_WD);
        float* AA = (float*)(ws + WS_AA);
        float* BB = (float*)(ws + WS_BB);
        float* KM = (float*)(ws + WS_KM);
        float* OG = (float*)(ws + WS_OG);
        float* YR = (float*)(ws + WS_YR);
        if (blockIdx.x < 32) gdn_scan_seq((int)blockIdx.x, (LAS unsigned char*)lds_raw, GREC, OG);
        else if (blockIdx.x < 160) rwkv_scan_block(((int)blockIdx.x - 32) >> 1, ((int)blockIdx.x - 32) & 1, (LAS float*)(LAS unsigned char*)lds_raw, (const float*)(ws + WS_WPRE), (const float*)(ws + WS_APRE), PH, a.in[22], a.in[23], a.in[24], (float*)(ws + WS_WD), YR);
        {
            const float* exp_w_gu = a.in[32]; const float* exp_w_down = a.in[34];
            unsigned char* WGU = ws + WS_WGU; unsigned char* WDN = ws + WS_WDN;
            constexpr int N_GU = NE * (2 * FF / 64) * (D / 64), N_DN = NE * (D / 64) * (FF / 64);
            auto idk = [](int k) { return k; };
            constexpr int N_P5 = N_GU + N_DN;
            for (;;) {
                int base = 0; if (lane == 0) base = (int)atomicAdd(ctl + CW_CNT + 96, 4u);
                base = __builtin_amdgcn_readfirstlane(base);
                if (base >= N_P5) break;
              for (int it0 = base; it0 < base + 4 && it0 < N_P5; ++it0) {
                int it = it0;
                if (it < N_GU) {
                    const int e = it / ((2 * FF / 64) * (D / 64)), r = it % ((2 * FF / 64) * (D / 64)), rb = r / (D / 64), kb = r % (D / 64);
                    auto m4 = [](int row0, int n4, int& scol, int& drow) { const int pn = row0 >> 8, cb8 = (row0 & 255) >> 3, ft = 128 * pn + (cb8 + (n4 & 7)) * 4; scol = (n4 < 8) ? ft : FF + ft; drow = row0 + (n4 & 7) * 8 + ((n4 < 8) ? 0 : 4); };
                    cvt64_f8(exp_w_gu + (size_t)e * D * 2 * FF, 2 * FF, D, m4, idk, WGU + (size_t)e * 2 * FF * D, rb * 64, kb, lane, 64.0f);
                } else {
                    it -= N_GU;
                    auto mid = [](int row0, int n4, int& scol, int& drow) { scol = row0 + 4 * n4; drow = scol; };
                    const int e = it / ((D / 64) * (FF / 64)), r = it % ((D / 64) * (FF / 64)), rb = r / (FF / 64), kb = r % (FF / 64);
                    cvt64_f8(exp_w_down + (size_t)e * FF * D, D, FF, mid, idk, WDN + (size_t)e * D * FF, rb * 64, kb, lane, 64.0f);
                }
              }
            }
        }
    }
    SEAM(5);

    if (IN(6)) {
        PHASE_IDS
        const float* gdn_norm = a.in[12];
        const float* rwkv_r_k = a.in[24];
        const float* rwkv_ln_w = a.in[25];
        const float* rwkv_ln_b = a.in[26];
        unsigned short* PH = (unsigned short*)(ws + WS_PH);
        float* GATE = (float*)(ws + WS_GATE);
        float* KM = (float*)(ws + WS_KM);
        float* OG = (float*)(ws + WS_OG);
        float* YR = (float*)(ws + WS_YR);
        unsigned short* YGB = (unsigned short*)(ws + WS_YGB);
        unsigned short* YRWB = (unsigned short*)(ws + WS_YRWB);
        for (int rp = blockIdx.x; rp < T / 2; rp += gridDim.x) {
            const int row = rp * 2 + (tid >> 8), c0 = (tid & 255) * 4;
            {
                const f32x4_t o = *(const f32x4_t*)(OG + (size_t)row * RW + c0);
                const float ss = half_sum(o[0] * o[0] + o[1] * o[1] + o[2] * o[2] + o[3] * o[3]);
                const float inv = rsqrtf(ss / 128.0f + EPS);
                const f32x4_t z = ld_bf4(PH + (size_t)row * N_IN + COL_Z + c0), gn = *(const f32x4_t*)(gdn_norm + (c0 & 127));
                pg8::u32x2 w; w.x = pg8::cvt_pk_bf16(o[0] * inv * gn[0] * z[0] * fast_sigmoid(z[0]), o[1] * inv * gn[1] * z[1] * fast_sigmoid(z[1]));
                w.y = pg8::cvt_pk_bf16(o[2] * inv * gn[2] * z[2] * fast_sigmoid(z[2]), o[3] * inv * gn[3] * z[3] * fast_sigmoid(z[3]));
                *(pg8::u32x2*)(YGB + (size_t)row * RW + c0) = w;
            }
            {
                const f32x4_t y = *(const f32x4_t*)(YR + (size_t)row * RW + c0);
                float sm1 = (y[0] + y[1]) + (y[2] + y[3]);
                sm1 += __shfl_xor(sm1, 1); sm1 += __shfl_xor(sm1, 2); sm1 += __shfl_xor(sm1, 4); sm1 += __shfl_xor(sm1, 8);
                const float mu = sm1 * (1.0f / 64.0f);
                const f32x4_t dl = y - mu;
                float sv = (dl[0] * dl[0] + dl[1] * dl[1]) + (dl[2] * dl[2] + dl[3] * dl[3]);
                sv += __shfl_xor(sv, 1); sv += __shfl_xor(sv, 2); sv += __shfl_xor(sv, 4); sv += __shfl_xor(sv, 8);
                const float rs = rsqrtf(sv * (1.0f / 64.0f) + 64e-5f);
                const f32x4_t lw = *(const f32x4_t*)(rwkv_ln_w + c0), lb = *(const f32x4_t*)(rwkv_ln_b + c0), vv = ld_bf4(PH + (size_t)row * N_IN + COL_RV + c0), gt = *(const f32x4_t*)(GATE + (size_t)row * RW + c0);
                const float bsum = ((const float*)(ws + WS_WD))[(size_t)row * 16 + (c0 >> 6)];
                const f32x4_t yo = (dl * rs * lw + lb + bsum * vv) * gt;
                pg8::u32x2 w; w.x = pg8::cvt_pk_bf16(yo[0], yo[1]); w.y = pg8::cvt_pk_bf16(yo[2], yo[3]);
                *(pg8::u32x2*)(YRWB + (size_t)row * RW + c0) = w;
            }
        }
    }
    SEAM(6);

    if (IN(7)) {
        PHASE_IDS
        unsigned short* PH = (unsigned short*)(ws + WS_PH);
        unsigned short* YGB = (unsigned short*)(ws + WS_YGB);
        unsigned short* YRWB = (unsigned short*)(ws + WS_YRWB);
        unsigned short* WUPG = (unsigned short*)(ws + WS_WUPG);
        unsigned short* WUPR = (unsigned short*)(ws + WS_WUPR);
        unsigned short* MRGB = (unsigned short*)(ws + WS_MRGB);
        float* MERGED = (float*)(ws + WS_MERGED);
        SchedUp S{(int)gridDim.x, (int)blockIdx.x, (const char*)YGB, (const char*)YRWB, (const char*)WUPG, (const char*)WUPR};
        EpiUp E{MRGB, PH};
        pg8::gemm_phase<EpiUp, SchedUp, true, false>((LAS unsigned char*)lds_raw, RW, S, E);
    }
    SEAM(7);

    if (IN(8)) {
        PHASE_IDS
        unsigned short* WOUT = (unsigned short*)(ws + WS_WOUT);
        unsigned short* MRGB = (unsigned short*)(ws + WS_MRGB);
        float* Y = (float*)(ws + WS_Y);
        SchedPlain S{(int)gridDim.x, (int)blockIdx.x, T / 256, D / 256, D, (const char*)MRGB, (const char*)WOUT};
        EpiF32 E{(unsigned short*)Y, D};
        pg8::gemm_phase<EpiF32, SchedPlain, true, false>((LAS unsigned char*)lds_raw, D, S, E);
    }
    SEAM(8);

    if (IN(9)) {
        PHASE_IDS
        const float* x = a.in[0];
        const float* norm_mix_post = a.in[5];
        const float* norm_ffn_pre = a.in[6];
        const float* router_w = a.in[30];
        const float* router_b = a.in[31];
        float* MOD = (float*)(ws + WS_MOD);
        float* Y = (float*)(ws + WS_Y);
        float* XMID = (float*)(ws + WS_XMID);
        unsigned short* H2B = (unsigned short*)(ws + WS_H2B);
        float* TOPP = (float*)(ws + WS_TOPP);
        int* LIST = (int*)(ws + WS_LIST);
        unsigned* CNT = ctl + CW_CNT;
        LAS float* h2s = (LAS float*)(LAS unsigned char*)lds_raw;
        for (int tile = blockIdx.x; tile < T / 16; tile += gridDim.x) {
            for (int rr = 0; rr < 2; ++rr) {
                const int rl = wave * 2 + rr, row = tile * 16 + rl;
                const int b = row / SEQ; const float* mod = MOD + (size_t)b * 6 * D;
                float xm[32]; float ss = 0.f;
#pragma unroll
                for (int j = 0; j < 8; ++j) { const f32x4_t yv = ld_bf4((const unsigned short*)Y + (size_t)row * D + j * 256 + lane * 4); xm[4 * j] = yv[0]; xm[4 * j + 1] = yv[1]; xm[4 * j + 2] = yv[2]; xm[4 * j + 3] = yv[3];
                    ss += yv[0] * yv[0] + yv[1] * yv[1] + yv[2] * yv[2] + yv[3] * yv[3]; }
                ss = wave_sum(ss);
                const float inv = rsqrtf(ss / D + EPS);
                float ss2 = 0.f;
#pragma unroll
                for (int j = 0; j < 8; ++j) {
                    const int d0 = j * 256 + lane * 4;
                    const float4 xv = *(const float4*)(x + (size_t)row * D + d0), nw = *(const float4*)(norm_mix_post + d0), gt = *(const float4*)(mod + 2 * D + d0);
                    xm[4 * j] = xv.x + gt.x * (xm[4 * j] * inv * nw.x); xm[4 * j + 1] = xv.y + gt.y * (xm[4 * j + 1] * inv * nw.y);
                    xm[4 * j + 2] = xv.z + gt.z * (xm[4 * j + 2] * inv * nw.z); xm[4 * j + 3] = xv.w + gt.w * (xm[4 * j + 3] * inv * nw.w);
                    *(float4*)(XMID + (size_t)row * D + d0) = make_float4(xm[4 * j], xm[4 * j + 1], xm[4 * j + 2], xm[4 * j + 3]);
                    ss2 += xm[4 * j] * xm[4 * j] + xm[4 * j + 1] * xm[4 * j + 1] + xm[4 * j + 2] * xm[4 * j + 2] + xm[4 * j + 3] * xm[4 * j + 3];
                    asm volatile("" ::: "memory");
                }
                ss2 = wave_sum(ss2);
                const float inv2 = rsqrtf(ss2 / D + EPS);
#pragma unroll
                for (int j = 0; j < 8; ++j) {
                    const int d0 = j * 256 + lane * 4;
                    const float4 nw = *(const float4*)(norm_ffn_pre + d0), sc = *(const float4*)(mod + 4 * D + d0), sh = *(const float4*)(mod + 3 * D + d0);
                    f32x4_t hv; hv[0] = xm[4 * j] * inv2 * nw.x * (1.0f + sc.x) + sh.x; hv[1] = xm[4 * j + 1] * inv2 * nw.y * (1.0f + sc.y) + sh.y;
                    hv[2] = xm[4 * j + 2] * inv2 * nw.z * (1.0f + sc.z) + sh.z; hv[3] = xm[4 * j + 3] * inv2 * nw.w * (1.0f + sc.w) + sh.w;
                    { int w8 = __builtin_amdgcn_cvt_pk_fp8_f32(hv[0], hv[1], 0, false); w8 = __builtin_amdgcn_cvt_pk_fp8_f32(hv[2], hv[3], w8, true); *(int*)((unsigned char*)H2B + (size_t)row * D + d0) = w8; }
                    *(LAS f32x4_t*)(h2s + rl * D + d0) = hv;
                    asm volatile("" ::: "memory");
                }
            }
            __syncthreads();
            {
                const int r = tid >> 5, e = tid & 31, row = tile * 16 + r;
                const LAS float* hp = h2s + r * D; float acc = 0.f;
#pragma unroll 4
                for (int d = 0; d < D; d += 4) { const f32x4_t h4 = *(const LAS f32x4_t*)(hp + d);
                    acc = fmaf(h4[0], router_w[(size_t)d * NE + e], acc); acc = fmaf(h4[1], router_w[(size_t)(d + 1) * NE + e], acc);
                    acc = fmaf(h4[2], router_w[(size_t)(d + 2) * NE + e], acc); acc = fmaf(h4[3], router_w[(size_t)(d + 3) * NE + e], acc); }
                float lgt = acc + router_b[e];
                float val[TOPK]; int idx[TOPK];
#pragma unroll
                for (int k = 0; k < TOPK; ++k) {
                    float bv = lgt; int bi = e;
#pragma unroll
                    for (int o = 1; o < 32; o <<= 1) { const float ov = __shfl_xor(bv, o); const int oi = __shfl_xor(bi, o); if (ov > bv || (ov == bv && oi < bi)) { bv = ov; bi = oi; } }
                    val[k] = bv; idx[k] = bi; if (e == bi) lgt = -3.0e38f;
                }
                float pe[TOPK], psum = 0.f;
#pragma unroll
                for (int k = 0; k < TOPK; ++k) { pe[k] = expf(val[k] - val[0]); psum += pe[k]; }
                if (e < TOPK) {
                    const float pk = e == 0 ? pe[0] : e == 1 ? pe[1] : e == 2 ? pe[2] : pe[3]; const int ik = e == 0 ? idx[0] : e == 1 ? idx[1] : e == 2 ? idx[2] : idx[3];
                    const int asg = row * TOPK + e;
                    TOPP[asg] = pk / psum;
                    const unsigned pos = atomicAdd(&CNT[ik], 1u);
                    LIST[(size_t)ik * T + pos] = asg;
                }
            }
            __syncthreads();
        }
    }
    SEAM(9);

    const int vcu = (gridDim.x % 8 == 0) ? (int)((blockIdx.x % 8) * (gridDim.x / 8) + blockIdx.x / 8) : (int)blockIdx.x;
    if (IN(10)) {
        PHASE_IDS
        const float* exp_b_gu = a.in[33];
        unsigned short* H2B = (unsigned short*)(ws + WS_H2B);
        int* LIST = (int*)(ws + WS_LIST);
        unsigned short* ACT = (unsigned short*)(ws + WS_ACT);
        unsigned short* WGU = (unsigned short*)(ws + WS_WGU);
        LAS int* mtab = (LAS int*)(LAS unsigned char*)(lds_raw + 131072);
        unsigned* CNT = ctl + CW_CNT;
        moe_tables(mtab, CNT);
        SchedMoE S{(int)gridDim.x, vcu, 2 * FF / 256, 2 * FF, mtab, LIST, (const char*)H2B, (const char*)WGU, true, 1};
        EpiGU E{(unsigned char*)ACT, exp_b_gu};
        pg8::gemm_phase<EpiGU, SchedMoE, true, true, true>((LAS unsigned char*)lds_raw, D, S, E);
    }
    SEAM(10);

    if (IN(11)) {
        PHASE_IDS
        const float* exp_b_down = a.in[35];
        int* LIST = (int*)(ws + WS_LIST);
        unsigned short* ACT = (unsigned short*)(ws + WS_ACT);
        unsigned short* YB = (unsigned short*)(ws + WS_YB);
        unsigned short* WDN = (unsigned short*)(ws + WS_WDN);
        LAS int* mtab = (LAS int*)(LAS unsigned char*)(lds_raw + 131072);
        unsigned* CNT = ctl + CW_CNT;
        moe_tables(mtab, CNT);
        SchedMoE S{(int)gridDim.x, vcu, D / 256, D, mtab, LIST, (const char*)ACT, (const char*)WDN, false, 1};
        EpiDown E{YB, exp_b_down};
        pg8::gemm_phase<EpiDown, SchedMoE, true, true, true>((LAS unsigned char*)lds_raw, FF, S, E);
    }
    SEAM(11);

    if (IN(12)) {
        PHASE_IDS
        const float* norm_ffn_post = a.in[7];
        float* MOD = (float*)(ws + WS_MOD);
        float* XMID = (float*)(ws + WS_XMID);
        float* TOPP = (float*)(ws + WS_TOPP);
        unsigned short* YB = (unsigned short*)(ws + WS_YB);
        for (int row = blockIdx.x; row < T; row += gridDim.x) {
            const int b = row / SEQ; const float* mod = MOD + (size_t)b * 6 * D; const int d0 = tid * 4;
            float ym[4] = {0.f, 0.f, 0.f, 0.f};
#pragma unroll
            for (int k = 0; k < TOPK; ++k) {
                const int asg = row * TOPK + k; const float p = TOPP[asg];
                const pg8::u32x2 v = *(const pg8::u32x2*)(YB + (size_t)asg * D + d0);
                ym[0] = fmaf(p, __uint_as_float(v.x << 16), ym[0]); ym[1] = fmaf(p, __uint_as_float(v.x & 0xffff0000u), ym[1]); ym[2] = fmaf(p, __uint_as_float(v.y << 16), ym[2]); ym[3] = fmaf(p, __uint_as_float(v.y & 0xffff0000u), ym[3]);
            }
            const float ss = block_sum(ym[0] * ym[0] + ym[1] * ym[1] + ym[2] * ym[2] + ym[3] * ym[3], sm);
            const float inv = rsqrtf(ss / D + EPS);
            const float4 xm = *(const float4*)(XMID + (size_t)row * D + d0);
            const float xa[4] = {xm.x, xm.y, xm.z, xm.w}; float o[4];
#pragma unroll
            for (int i = 0; i < 4; ++i) { const int d = d0 + i; o[i] = xa[i] + mod[5 * D + d] * (ym[i] * inv * norm_ffn_post[d]); }
            *(float4*)(a.out + (size_t)row * D + d0) = make_float4(o[0], o[1], o[2], o[3]);
        }
    }
#undef IN
#undef SEAM
}

constexpr int NPHASES = 13;
#ifndef MK_ONE_LAUNCH
#define MK_ONE_LAUNCH 1
#endif

extern "C" void kernel_launch(void* const* d_in, const int* in_sizes, int n_in, void* d_out, int out_size, void* d_ws, size_t ws_size, hipStream_t stream) {
    static int grid = 0;
    if (grid == 0) {
        if (n_in != 36 || out_size != T * D || ws_size < WS_END) { fprintf(stderr, "kernel_launch: unexpected shapes n_in %d out %d ws %zu (need %zu)\n", n_in, out_size, ws_size, (size_t)WS_END); grid = -1; return; }
        int dev = 0, cus = 0, per_cu = 0;
        if (hipGetDevice(&dev) != hipSuccess || hipDeviceGetAttribute(&cus, hipDeviceAttributeMultiprocessorCount, dev) != hipSuccess) { grid = -1; return; }
        if (hipFuncSetAttribute((const void*)fwd, hipFuncAttributeMaxDynamicSharedMemorySize, LDS_BYTES) != hipSuccess) { fprintf(stderr, "kernel_launch: hipFuncSetAttribute failed\n"); grid = -1; return; }
        if (hipOccupancyMaxActiveBlocksPerMultiprocessor(&per_cu, (const void*)fwd, NTHREADS, LDS_BYTES) != hipSuccess || per_cu < 1) { fprintf(stderr, "kernel_launch: occupancy query says %d\n", per_cu); }
        (void)hipGetLastError();
        grid = cus;
    }
    if (grid < 0) return;
    (void)hipMemsetAsync((char*)d_ws + WS_CTL, 0, CTL_BYTES, stream);
    Args a{};
    for (int i = 0; i < 36; ++i) a.in[i] = (const float*)d_in[i];
    a.out = (float*)d_out; a.ws = (unsigned char*)d_ws;
#if MK_ONE_LAUNCH
    a.ph_lo = 0; a.ph_hi = NPHASES;
    hipLaunchKernelGGL(fwd, dim3(grid), dim3(NTHREADS), LDS_BYTES, stream, a);
#else
    for (int p = 0; p < NPHASES; ++p) {
        a.ph_lo = p; a.ph_hi = p + 1;
        hipLaunchKernelGGL(fwd, dim3(grid), dim3(NTHREADS), LDS_BYTES, stream, a);
    }
#endif
}
```

```cpp
#include <hip/hip_runtime.h>
#include <cstdio>
#include <cstdint>

constexpr int D = 2048, NB = 4, SEQ = 4096, T = NB * SEQ;
constexpr int COL_K = 512, COL_V = 1024, COL_Z = 2048, COL_B = 3072, COL_A = 3080, COL_GATE = 3088, COL_R = 7184, COL_RK = 8208, COL_RV = 9232, N_IN = 10256;
constexpr int NE = 32, TOPK = 4, FF = 2048, NA = T * TOPK;
constexpr int RW = 1024;
constexpr float EPS = 1e-6f;
constexpr int NTHREADS = 512;
constexpr int LDS_BYTES = 128 * 1024 + 4096;

#define XB_TMO      128
#define XB_XCNT(j)  (256  + 64 * (j))
#define XB_XSUB(j)  (1280 + 64 * (j))
#define XB_XGEN(j)  (2304 + 64 * (j))
#define XB_TOP      3328
#define XB_TOPGEN   3392
#define XCD_BAR_WORDS 3456
#define XB_SPIN_CAP (1u << 22)
#define LAS __attribute__((address_space(3)))
__device__ __forceinline__ unsigned xb_ld(unsigned* p)              { return __hip_atomic_load(p, __ATOMIC_RELAXED, __HIP_MEMORY_SCOPE_AGENT); }
__device__ __forceinline__ unsigned xb_add(unsigned* p, unsigned v) { return __hip_atomic_fetch_add(p, v, __ATOMIC_RELAXED, __HIP_MEMORY_SCOPE_AGENT); }
__device__ __forceinline__ unsigned xb_xcc_id() { return (unsigned)__builtin_amdgcn_s_getreg((3 << 11) | 20) & 0xFu; }
#define XB_SPIN(cond, bar) do { unsigned _sp = 0; while (cond) { __builtin_amdgcn_s_sleep(1); \
    if ((++_sp & 255u) == 0u) { if (xb_ld(&(bar)[XB_TMO])) break; if (_sp > XB_SPIN_CAP) { atomicAdd(&(bar)[XB_TMO], 1u); break; } } } } while (0)
struct XcdBarrier { unsigned* bar; unsigned x; volatile LAS unsigned* st; };
__device__ __forceinline__ XcdBarrier xcd_barrier_post(unsigned* bar, volatile LAS unsigned* st) {
    XcdBarrier b; b.bar = bar; b.x = xb_xcc_id(); b.st = st;
    if (threadIdx.x == 0) (void)xb_add(&bar[XB_XCNT(b.x)], 1u);
    return b;
}
__device__ __forceinline__ void xcd_barrier_complete(unsigned* bar, unsigned x, unsigned& nloc, unsigned& nx) {
    const unsigned G = gridDim.x * gridDim.y * gridDim.z;
    unsigned sum, cnt, mine, sp = 0u;
    for (;;) {
        sum = 0u; cnt = 0u; mine = 0u;
#pragma unroll
        for (unsigned j = 0; j < 16; ++j) { const unsigned c = xb_ld(&bar[XB_XCNT(j)]); sum += c; cnt += (c > 0u) ? 1u : 0u; mine = (j == x) ? c : mine; }
        if (sum == G) break;
        __builtin_amdgcn_s_sleep(1);
        if ((++sp & 255u) == 0u) { if (xb_ld(&bar[XB_TMO])) break; if (sp > XB_SPIN_CAP) { atomicAdd(&bar[XB_TMO], 1u); break; } }
    }
    nloc = mine > 0u ? mine : 1u; nx = cnt > 0u ? cnt : 1u;
}
__device__ __forceinline__ void xcd_barrier(const XcdBarrier& b) {
    asm volatile("s_waitcnt vmcnt(0)" ::: "memory");
    __syncthreads();
    if (threadIdx.x == 0) {
        unsigned* bar = b.bar;
        __builtin_amdgcn_s_waitcnt(0);
        unsigned nloc = b.st[0], nx = b.st[1];
        if (nloc == 0u) { xcd_barrier_complete(bar, b.x, nloc, nx); b.st[0] = nloc; b.st[1] = nx; }
        const unsigned old = xb_add(&bar[XB_XSUB(b.x)], 1u);
        const unsigned gen = old / nloc;
        if (old + 1u == (gen + 1u) * nloc) {
            __builtin_amdgcn_fence(__ATOMIC_RELEASE, "agent");
            asm volatile("s_waitcnt vmcnt(0)" ::: "memory");
            const unsigned og = xb_add(&bar[XB_TOP], 1u);
            const unsigned tg = og / nx;
            if (og + 1u == (tg + 1u) * nx) xb_add(&bar[XB_TOPGEN], 1u);
            else XB_SPIN(xb_ld(&bar[XB_TOPGEN]) == tg, bar);
            __builtin_amdgcn_fence(__ATOMIC_ACQUIRE, "agent");
            xb_add(&bar[XB_XGEN(b.x)], 1u);
            asm volatile("s_waitcnt vmcnt(0)" ::: "memory");
        } else {
            XB_SPIN(xb_ld(&bar[XB_XGEN(b.x)]) == gen, bar);
            __builtin_amdgcn_fence(__ATOMIC_ACQUIRE, "agent");
            asm volatile("s_waitcnt vmcnt(0)" ::: "memory");
        }
    }
    __syncthreads();
}

constexpr size_t al256(size_t x) { return (x + 255) & ~(size_t)255; }
constexpr size_t WS_CTL   = 0;
constexpr size_t CTL_BYTES = 32768;
constexpr size_t CW_CNT   = XCD_BAR_WORDS + 64;
constexpr size_t WS_MOD   = WS_CTL + CTL_BYTES;
constexpr size_t WS_H     = al256(WS_MOD + (size_t)NB * 6 * D * 4);
constexpr size_t WS_WINT  = al256(WS_H + (size_t)7 * T * D * 2);
constexpr int NT_IN = 44;
constexpr size_t WS_PH    = al256(WS_WINT + (size_t)NT_IN * 256 * D * 2);
constexpr size_t WS_BA    = al256(WS_PH + (size_t)T * N_IN * 2);
constexpr size_t WS_LWA   = al256(WS_BA + (size_t)T * 16 * 4);
constexpr size_t WS_LGB   = al256(WS_LWA + (size_t)T * 256 * 2);
constexpr size_t WS_L2T   = al256(WS_LGB + (size_t)T * 256 * 2);
constexpr size_t WS_WPRE  = al256(WS_L2T + (size_t)3 * RW * 256 * 2);
constexpr size_t WS_APRE  = al256(WS_WPRE + (size_t)T * RW * 4);
constexpr size_t WS_GATE  = al256(WS_APRE + (size_t)T * RW * 4);
static_assert(WS_APRE == WS_WPRE + (size_t)T * RW * 4 && WS_GATE == WS_APRE + (size_t)T * RW * 4, "EpiLora indexes the three buffers from WPRE");
constexpr size_t WS_WD    = al256(WS_GATE + (size_t)T * RW * 4);
constexpr size_t WS_AA    = al256(WS_WD + (size_t)T * RW * 4);
constexpr size_t WS_BB    = al256(WS_AA + (size_t)T * RW * 4);
constexpr size_t WS_KM    = al256(WS_BB + (size_t)T * RW * 4);
constexpr size_t WS_OG    = al256(WS_KM + (size_t)T * RW * 4);
constexpr size_t WS_YR    = al256(WS_OG + (size_t)T * RW * 4);
constexpr size_t WS_MERGED= al256(WS_YR + (size_t)T * RW * 4);
constexpr size_t WS_Y     = al256(WS_MERGED + (size_t)T * D * 4);
constexpr size_t WS_XMID  = al256(WS_Y + (size_t)T * D * 4);
constexpr size_t WS_H2B   = al256(WS_XMID + (size_t)T * D * 4);
constexpr size_t WS_TOPP  = al256(WS_H2B + (size_t)T * D * 2);
constexpr size_t WS_LIST  = al256(WS_TOPP + (size_t)NA * 4);
constexpr int ACT_ROWS = NA + NE * 256;
constexpr size_t WS_ACT   = al256(WS_LIST + (size_t)NE * T * 4);
constexpr size_t WS_YB    = al256(WS_ACT + (size_t)ACT_ROWS * FF * 2);
constexpr size_t WS_WGU   = al256(WS_YB + (size_t)NA * D * 2);
constexpr size_t WS_WDN   = al256(WS_WGU + (size_t)NE * 2 * FF * D * 2);
constexpr size_t WS_YGB   = al256(WS_WDN + (size_t)NE * D * FF * 2);
constexpr size_t WS_YRWB  = al256(WS_YGB + (size_t)T * RW * 2);
constexpr size_t WS_WUPG  = al256(WS_YRWB + (size_t)T * RW * 2);
constexpr size_t WS_WUPR  = al256(WS_WUPG + (size_t)D * RW * 2);
constexpr size_t WS_WOUT  = al256(WS_WUPR + (size_t)D * RW * 2);
constexpr size_t WS_MRGB  = al256(WS_WOUT + (size_t)D * D * 2);
constexpr size_t WS_GREC  = al256(WS_MRGB + (size_t)T * D * 2);
constexpr size_t WS_END   = al256(WS_GREC + (size_t)2048 * 90368);

struct Args {
    const float* in[36];
    float* out;
    unsigned char* ws;
    int ph_lo, ph_hi;
};

__device__ __forceinline__ float sigmoidf_(float x) { return 1.0f / (1.0f + expf(-x)); }
__device__ __forceinline__ float siluf_(float x) { return x * sigmoidf_(x); }
__device__ __forceinline__ float softplusf_(float x) { return fmaxf(x, 0.0f) + log1pf(expf(-fabsf(x))); }
__device__ __forceinline__ float rl(float x, int k) { return __int_as_float(__builtin_amdgcn_readlane(__float_as_int(x), k)); }
__device__ __forceinline__ float wave_sum(float v) {
#pragma unroll
    for (int o = 32; o > 0; o >>= 1) v += __shfl_xor(v, o);
    return v;
}
__device__ __forceinline__ float half_sum(float v) {
#pragma unroll
    for (int o = 16; o > 0; o >>= 1) v += __shfl_xor(v, o);
    return v;
}
__device__ __forceinline__ float block_sum(float v, float* red) {
    v = wave_sum(v);
    __syncthreads();
    if ((threadIdx.x & 63) == 0) red[threadIdx.x >> 6] = v;
    __syncthreads();
    float t = 0.f;
#pragma unroll
    for (int w = 0; w < NTHREADS / 64; ++w) t += red[w];
    return t;
}

constexpr int GBM = 128, GBN = 64, GBK = 16;
template <bool DUAL, class AL, class EP>
__device__ __forceinline__ void gemm_naive(float* sm, int M, int N, int K, const AL& al, const float* __restrict__ W, int ldw, int dual_off, const EP& ep) {
    float* As = sm;
    float* Bs = sm + GBK * (GBM + 4);
    float* Bs2 = Bs + GBK * (GBN + 4);
    const int tid = threadIdx.x, tx = tid & 15, ty = tid >> 4;
    const int ntm = (M + GBM - 1) / GBM, ntn = (N + GBN - 1) / GBN;
    for (int tile = blockIdx.x; tile < ntm * ntn; tile += gridDim.x) {
        const int tm = tile / ntn, tn = tile % ntn;
        const int m0 = tm * GBM, n0 = tn * GBN;
        float acc[4][4], acc2[4][4];
#pragma unroll
        for (int i = 0; i < 4; ++i)
#pragma unroll
            for (int j = 0; j < 4; ++j) { acc[i][j] = 0.f; acc2[i][j] = 0.f; }
        for (int k0 = 0; k0 < K; k0 += GBK) {
#pragma unroll
            for (int i = 0; i < 4; ++i) { const int idx = tid + i * NTHREADS, r = idx >> 4, kk = idx & 15; As[kk * (GBM + 4) + r] = al(m0 + r, k0 + kk); }
#pragma unroll
            for (int i = 0; i < 2; ++i) { const int idx = tid + i * NTHREADS, kk = idx >> 6, c = idx & 63, n = n0 + c;
                Bs[kk * (GBN + 4) + c] = (n < N) ? W[(size_t)(k0 + kk) * ldw + n] : 0.f;
                if (DUAL) Bs2[kk * (GBN + 4) + c] = (n < N) ? W[(size_t)(k0 + kk) * ldw + n + dual_off] : 0.f; }
            __syncthreads();
#pragma unroll
            for (int kk = 0; kk < GBK; ++kk) {
                float a[4], b[4], b2[4];
#pragma unroll
                for (int i = 0; i < 4; ++i) a[i] = As[kk * (GBM + 4) + ty * 4 + i];
#pragma unroll
                for (int j = 0; j < 4; ++j) { b[j] = Bs[kk * (GBN + 4) + tx * 4 + j]; b2[j] = DUAL ? Bs2[kk * (GBN + 4) + tx * 4 + j] : 0.f; }
#pragma unroll
                for (int i = 0; i < 4; ++i)
#pragma unroll
                    for (int j = 0; j < 4; ++j) { acc[i][j] = fmaf(a[i], b[j], acc[i][j]); if (DUAL) acc2[i][j] = fmaf(a[i], b2[j], acc2[i][j]); }
            }
            __syncthreads();
        }
#pragma unroll
        for (int i = 0; i < 4; ++i)
#pragma unroll
            for (int j = 0; j < 4; ++j) { const int m = m0 + ty * 4 + i, n = n0 + tx * 4 + j; if (m < M && n < N) ep(m, n, acc[i][j], acc2[i][j]); }
    }
}

struct ALPlain { const float* A; int lda; __device__ __forceinline__ float operator()(int m, int k) const { return A[(size_t)m * lda + k]; } };
struct ALMix {
    const float* H; const float* mix;
    __device__ __forceinline__ float operator()(int m, int k) const {
        const float h = H[(size_t)m * D + k];
        const float hp = ((m % SEQ) == 0) ? 0.f : H[(size_t)(m - 1) * D + k];
        return h + (hp - h) * mix[k];
    }
};
struct ALGatherTok { const float* H2; const int* list; int cnt; __device__ __forceinline__ float operator()(int m, int k) const { return (m < cnt) ? H2[(size_t)(list[m] >> 2) * D + k] : 0.f; } };
struct ALGatherAsg { const float* ACT; const int* list; int cnt; __device__ __forceinline__ float operator()(int m, int k) const { return (m < cnt) ? ACT[(size_t)list[m] * FF + k] : 0.f; } };

namespace pg8 {
#define PG8_LAS __attribute__((address_space(3)))
typedef unsigned short bf16_t;
typedef short bf16x8 __attribute__((ext_vector_type(8)));
typedef float f32x4 __attribute__((ext_vector_type(4)));
typedef unsigned u32x4 __attribute__((ext_vector_type(4)));
typedef unsigned u32x2 __attribute__((ext_vector_type(2)));
constexpr int BM = 256, BK = 64, HALF = 128, HTB = HALF * BK * 2, STAGE_BYTES = 8 * HTB, NXCD = 8, WGM = 2;
__host__ __device__ __forceinline__ int lds_byte(int r, int c) { const int st = (r >> 4) * 2 + (c >> 5), rr = r & 15, cc = c & 31, ob = rr * 64 + cc * 2; return st * 1024 + (ob ^ (((ob >> 9) & 1) << 5)); }
__host__ __device__ __forceinline__ void stage_rc(int b, int& R, int& C) { const int st = b / 1024, sb = b % 1024, swz = sb ^ (((sb >> 9) & 1) << 5); R = (st >> 1) * 16 + swz / 64; C = (st & 1) * 32 + (swz % 64) / 2; }
__host__ __device__ __forceinline__ int perm32(int rho) { const int n = rho >> 4, i = rho & 15; return 8 * (i >> 2) + 4 * n + (i & 3); }
struct Unit { int pm, pn; const char* A; const char* B; const int* list; int cnt, e, prow, gat; };
typedef __bf16 bf16x2_t __attribute__((ext_vector_type(2)));
__device__ __forceinline__ unsigned cvt_pk_bf16(float lo, float hi) { bf16x2_t v; v.x = (__bf16)lo; v.y = (__bf16)hi; return __builtin_bit_cast(unsigned, v); }
__device__ __forceinline__ bool static_order(int nM, int nN, int G, int c, int i, int& pm, int& pn) {
    const int nwg = nM * nN; const long L = (long)i * G + c; if (L >= nwg) return false;
    int wgid = (int)L; { const int q = nwg / NXCD, r = nwg % NXCD, xcd = wgid % NXCD, off = wgid / NXCD; wgid = (xcd < r ? xcd * (q + 1) : r * (q + 1) + (xcd - r) * q) + off; }
    const int nig = WGM * nN, gid = wgid / nig, fm = gid * WGM, gsz = (nM - fm) < WGM ? (nM - fm) : WGM;
    pm = fm + ((wgid % nig) % gsz); pn = (wgid % nig) / gsz; return true;
}
template <class Epi, class Sched, bool ALIGN_EPI = true, bool GATHER = false, bool FP8 = false>
__device__ __forceinline__ void gemm_phase(PG8_LAS unsigned char* lds, const int K_, const Sched& S, const Epi& E) {
    const int tid = threadIdx.x, wid = __builtin_amdgcn_readfirstlane(tid >> 6), lane = tid & 63, wr = wid >> 2, wc = wid & 3, fr = lane & 15, fq = lane >> 4;
    const int K = K_, KB = FP8 ? K_ : 2 * K_, nt = KB / 128;
    unsigned voffA0, voffB0;
    { int R, C; stage_rc(tid * 16, R, C); const int Rb = Epi::PERM ? ((R & ~31) + perm32(R & 31)) : R;
      voffA0 = (unsigned)(R * KB + C * 2); voffB0 = (unsigned)(Rb * KB + C * 2); }
    const size_t pstep = (size_t)64 * KB;
    const size_t kstep = (size_t)(BK * 2);
    const size_t hstep = (size_t)HALF * KB;
    const size_t tstep = 2 * hstep; (void)tstep;
    const unsigned ldsw = (unsigned)wid * 1024u;
    const int cole = FP8 ? ((fq >> 1) * 32 + (fq & 1) * 16) : fq * 8;
    const int aoff = lds_byte(wr * 64 + fr, cole), boff = aoff + (wc * 2 - wr * 4) * 2048;
    typedef int _i8 __attribute__((ext_vector_type(8))); typedef _i8 _i8a __attribute__((aligned(16)));
    constexpr bool SP2 = true;
    unsigned vA_c[2][2];
    PG8_LAS unsigned* gtab = (PG8_LAS unsigned*)(lds + STAGE_BYTES + 1024);
#define PG8_FILLTAB(u) do { int _t = threadIdx.x; asm volatile("" : "+v"(_t));   if (_t < 256) { const int _m = (u).pm * 256 + _t; \
        const int _tok = (u).gat ? ((_m < (u).cnt) ? ((u).list[_m] >> 2) : 0) : _t;     \
        gtab[_t] = (unsigned)_tok * (unsigned)KB; } } while (0)
#define PG8_SETVA(v, u) do { int _t2 = threadIdx.x; if constexpr (GATHER) asm volatile("" : "+v"(_t2)); _Pragma("unroll") for (int _h = 0; _h < 2; ++_h) _Pragma("unroll") for (int _i = 0; _i < 2; ++_i) { \
        if constexpr (GATHER) { int _R, _C; stage_rc(_t2 * 16 + _i * 8192, _R, _C); (v)[_h][_i] = gtab[_h * 128 + _R] + (unsigned)(_C * 2); } \
        else (v)[_h][_i] = 0u; } } while (0)
#define PG8_STAGE_A(bufoff, gbase, h, nx) do { _Pragma("unroll") for (int _i = 0; _i < 2; ++_i) { \
        const char* _src = GATHER ? (const char*)(gbase) + vA_c[h][_i] : (const char*)(gbase) + (size_t)(h) * hstep + (size_t)_i * pstep + voffA0; \
        __builtin_amdgcn_global_load_lds((const unsigned*)_src, (PG8_LAS unsigned*)(lds + (bufoff) + ldsw + _i * 8192), 16, 0, 0); } } while (0)
#define PG8_SA(b, h) (((b) * 2 + (h)) * HTB)
#define PG8_SB(b, h) ((4 + (b) * 2 + (h)) * HTB)
#define PG8_STAGE(bufoff, gbase, voff) do { _Pragma("unroll") for (int _i = 0; _i < 2; ++_i) \
        __builtin_amdgcn_global_load_lds((const unsigned*)((const char*)(gbase) + (size_t)_i * pstep + voff##0), (PG8_LAS unsigned*)(lds + (bufoff) + ldsw + _i * 8192), 16, 0, 0); } while (0)
#define PG8_LDA(dst, b, h) do { _Pragma("unroll") for (int m = 0; m < 4; ++m) { \
        if constexpr (FP8) { dst##8[m] = *(const PG8_LAS _i8a*)(lds + PG8_SA(b, h) + aoff + m * 2048); } \
        else { _Pragma("unroll") for (int k = 0; k < 2; ++k) dst[m][k] = *(const PG8_LAS bf16x8*)(lds + PG8_SA(b, h) + aoff + m * 2048 + k * 1024); } } } while (0)
#define PG8_LDB(dst, b, h) do { _Pragma("unroll") for (int n = 0; n < 2; ++n) { \
        if constexpr (FP8) { dst##8[n] = *(const PG8_LAS _i8a*)(lds + PG8_SB(b, h) + boff + n * 2048); } \
        else { _Pragma("unroll") for (int k = 0; k < 2; ++k) dst[n][k] = *(const PG8_LAS bf16x8*)(lds + PG8_SB(b, h) + boff + n * 2048 + k * 1024); } } } while (0)
#define PG8_MMA(ai, bj, At, Bt) do { __builtin_amdgcn_s_setprio(1); _Pragma("unroll") for (int m = 0; m < 4; ++m) _Pragma("unroll") for (int n = 0; n < 2; ++n) { \
        if constexpr (FP8) acc[ai][bj][m][n] = __builtin_amdgcn_mfma_scale_f32_16x16x128_f8f6f4(Bt##8[n], At##8[m], acc[ai][bj][m][n], 0, 0, 0, 127, 0, 127); \
        else { _Pragma("unroll") for (int k = 0; k < 2; ++k) acc[ai][bj][m][n] = __builtin_amdgcn_mfma_f32_16x16x32_bf16(Bt[n][k], At[m][k], acc[ai][bj][m][n], 0, 0, 0); } } \
        __builtin_amdgcn_s_setprio(0); } while (0)
#define PG8_WAIT_V(n) asm volatile("s_waitcnt vmcnt(" #n ")" ::: "memory")
#define PG8_WAIT_L(n) asm volatile("s_waitcnt lgkmcnt(" #n ")" ::: "memory")
#define PG8_BAR __builtin_amdgcn_s_barrier()
#define PG8_SCHED __builtin_amdgcn_sched_barrier(0)
    Unit cur, nxt; int ui = 0;
    if (!S.next(0, cur)) return;
    f32x4 acc[2][2][4][2];
#pragma unroll
    for (int a = 0; a < 2; ++a)
#pragma unroll
        for (int b = 0; b < 2; ++b)
#pragma unroll
            for (int m = 0; m < 4; ++m)
#pragma unroll
                for (int n = 0; n < 2; ++n) acc[a][b][m][n] = (f32x4){0.f, 0.f, 0.f, 0.f};
    bf16x8 At[4][2], B0[2][2], B1[2][2]; _i8 At8[4], B08[2], B18[2];
    const char* cA = cur.A; const char* cB = cur.B;
    S.a_ready(cur);
    if constexpr (GATHER) { PG8_FILLTAB(cur); __syncthreads(); }
    PG8_SETVA(vA_c, cur);
    if constexpr (GATHER) __syncthreads();
    if constexpr (SP2) {
        PG8_STAGE(PG8_SB(0, 0), cB, voffB); PG8_STAGE(PG8_SB(0, 1), cB + hstep, voffB); PG8_STAGE_A(PG8_SA(0, 0), cA, 0, false); PG8_STAGE_A(PG8_SA(0, 1), cA, 1, false);
        if (wr == 1) PG8_BAR;
        PG8_WAIT_V(2); PG8_BAR;
        PG8_STAGE(PG8_SB(1, 0), cB + kstep, voffB); PG8_STAGE_A(PG8_SA(1, 0), cA + kstep, 0, false); PG8_STAGE(PG8_SB(1, 1), cB + hstep + kstep, voffB);
        PG8_WAIT_V(6); PG8_BAR;
    }
    for (;;) {
        const bool has_next = S.next(ui + 1, nxt);
        const char* nA = has_next ? nxt.A : cA; const char* nB = has_next ? nxt.B : cB;
        if constexpr (GATHER) { if (has_next) PG8_FILLTAB(nxt); }
        for (int t = 0; t < nt; t += 2) {
            const bool last = (t == nt - 2); const bool lastn = last && has_next; (void)lastn;
            const char* a1 = cA + (size_t)(t + 1) * kstep;
            const char* a2 = last ? nA : cA + (size_t)(t + 2) * kstep; const char* b2 = last ? nB : cB + (size_t)(t + 2) * kstep;
            const char* a3 = a2 + kstep; const char* b3 = b2 + kstep;
            if (last && has_next) S.a_ready(nxt);
            if constexpr (SP2) {
            PG8_LDB(B0, 0, 0); PG8_LDB(B1, 0, 1); PG8_SCHED; PG8_LDA(At, 0, 0); PG8_STAGE_A(PG8_SA(1, 1), a1, 1, false);
            PG8_WAIT_V(8); PG8_WAIT_L(0); PG8_BAR; PG8_MMA(0, 0, At, B0); PG8_MMA(0, 1, At, B1); PG8_BAR; PG8_SCHED;
            if constexpr (GATHER) { if (lastn) PG8_SETVA(vA_c, nxt); }
            PG8_LDA(At, 0, 1); PG8_STAGE(PG8_SB(0, 0), b2, voffB); PG8_STAGE(PG8_SB(0, 1), b2 + hstep, voffB); PG8_STAGE_A(PG8_SA(0, 0), a2, 0, lastn);
            PG8_WAIT_V(8); PG8_WAIT_L(0); PG8_BAR; PG8_MMA(1, 0, At, B0); PG8_MMA(1, 1, At, B1); PG8_BAR; PG8_SCHED;
            PG8_LDB(B0, 1, 0); PG8_LDB(B1, 1, 1); PG8_SCHED; PG8_LDA(At, 1, 0); PG8_STAGE_A(PG8_SA(0, 1), a2, 1, lastn);
            PG8_WAIT_V(8); PG8_WAIT_L(0); PG8_BAR; PG8_MMA(0, 0, At, B0); PG8_MMA(0, 1, At, B1); PG8_BAR; PG8_SCHED;
            PG8_LDA(At, 1, 1); PG8_STAGE(PG8_SB(1, 0), b3, voffB); PG8_STAGE(PG8_SB(1, 1), b3 + hstep, voffB); PG8_STAGE_A(PG8_SA(1, 0), a3, 0, lastn);
            PG8_WAIT_V(8); PG8_WAIT_L(0); PG8_BAR; PG8_MMA(1, 0, At, B0); PG8_MMA(1, 1, At, B1); PG8_BAR; PG8_SCHED;
            }
        }
        if constexpr (ALIGN_EPI) { if (wr == 0) PG8_BAR; }
        asm volatile("" ::: "memory");
        bool chained = false;
        if constexpr (!Epi::AFTER_DRAIN) { if constexpr (Epi::CHAIN) { if (cur.e == 0) { E.mid(acc, cur, wr, wc, fr, fq); chained = true; } else E(acc, cur, wr, wc, fr, fq); } else E(acc, cur, wr, wc, fr, fq); S.done(cur); }
        if (!has_next) break;
        if (!chained) {
#pragma unroll
        for (int a = 0; a < 2; ++a)
#pragma unroll
            for (int b = 0; b < 2; ++b)
#pragma unroll
                for (int m = 0; m < 4; ++m)
#pragma unroll
                    for (int n = 0; n < 2; ++n) acc[a][b][m][n] = (f32x4){0.f, 0.f, 0.f, 0.f};
        }
        cur = nxt; cA = nA; cB = nB; ++ui;
        if constexpr (ALIGN_EPI) { if (wr == 1) PG8_BAR; }
    }
    PG8_WAIT_V(0);
    if constexpr (!ALIGN_EPI) { if (wr == 0) PG8_BAR; }
    PG8_BAR;
    if constexpr (Epi::AFTER_DRAIN) { E.fused(acc, cur, wr, wc, fr, fq, lds, wid, lane); S.done(cur); }
#undef PG8_SA
#undef PG8_SB
#undef PG8_STAGE
#undef PG8_STAGE_A
#undef PG8_SETVA
#undef PG8_FILLTAB
#undef PG8_LDA
#undef PG8_LDB
#undef PG8_MMA
#undef PG8_WAIT_V
#undef PG8_WAIT_L
#undef PG8_BAR
#undef PG8_SCHED
}
}


typedef float f32x4_t __attribute__((ext_vector_type(4)));
__device__ __forceinline__ f32x4_t ld_bf4(const unsigned short* p) { const pg8::u32x2 v = *(const pg8::u32x2*)p; return (f32x4_t){__uint_as_float(v.x << 16), __uint_as_float(v.x & 0xffff0000u), __uint_as_float(v.y << 16), __uint_as_float(v.y & 0xffff0000u)}; }
__device__ __forceinline__ void ld_bf8(const unsigned short* p, f32x4_t& lo, f32x4_t& hi) { const pg8::u32x4 v = *(const pg8::u32x4*)p;
    lo = (f32x4_t){__uint_as_float(v.x << 16), __uint_as_float(v.x & 0xffff0000u), __uint_as_float(v.y << 16), __uint_as_float(v.y & 0xffff0000u)};
    hi = (f32x4_t){__uint_as_float(v.z << 16), __uint_as_float(v.z & 0xffff0000u), __uint_as_float(v.w << 16), __uint_as_float(v.w & 0xffff0000u)}; }
__device__ __forceinline__ float ld_bf1(const unsigned short* p) { return __uint_as_float((unsigned)(*p) << 16); }
struct SchedInProj {
    int G, c; const char* Abase; const char* Bt;
    __device__ __forceinline__ bool next(int i, pg8::Unit& u) const {
        int pm, pn; if (!pg8::static_order(T / 256, NT_IN, G, c, i, pm, pn)) return false;
        const int ai = pn < 29 ? 0 : pn < 33 ? 1 : pn < 37 ? 3 : pn < 41 ? 4 : pn == 41 ? 2 : pn == 42 ? 5 : 6;
        u.pm = pm; u.pn = pn; u.A = Abase + ((size_t)ai * T + (size_t)pm * 256) * D * 2; u.B = Bt + (size_t)pn * 256 * D * 2; u.list = nullptr; u.cnt = 0; u.e = 0; u.prow = 0; u.gat = 0; return true;
    }
    __device__ __forceinline__ void a_ready(const pg8::Unit&) const {}
    __device__ __forceinline__ void done(const pg8::Unit&) const {}
};
__device__ __forceinline__ float fast_sigmoid(float x) { return __builtin_amdgcn_rcpf(1.0f + __builtin_amdgcn_exp2f(-1.4426950408889634f * x)); }
__device__ __forceinline__ float fast_tanh(float x) { return 1.0f - 2.0f * __builtin_amdgcn_rcpf(1.0f + __builtin_amdgcn_exp2f(2.8853900817779268f * x)); }
struct EpiInProjF32 {
    static constexpr bool PERM = true, AFTER_DRAIN = false, CHAIN = false;
    unsigned short* PH; float* BA; unsigned short* LWA; unsigned short* LGB;
    __device__ __forceinline__ void operator()(const pg8::f32x4 (&acc)[2][2][4][2], const pg8::Unit& u, int wr, int wc, int fr, int fq) const {
        const int pn = u.pn; unsigned short* b16 = PH; unsigned ld = N_IN; int ncol = 256, act = 0;
        if (pn < 12) b16 = PH + pn * 256;
        else if (pn < 28) { b16 = PH + COL_GATE + (pn - 12) * 256; act = 2; }
        else if (pn == 28) { act = 4; ncol = 16; }
        else if (pn < 41) b16 = PH + COL_R + (pn - 29) * 256;
        else if (pn == 41) { act = 1; ncol = 128; b16 = LWA; ld = 256; }
        else if (pn == 42) { act = 3; ncol = 128; b16 = LWA + 128; ld = 256; }
        else { act = 2; b16 = LGB; ld = 256; }
        const unsigned row0 = (unsigned)u.pm * 256u + wr * 64 + fr;
#pragma unroll
        for (int ai = 0; ai < 2; ++ai)
#pragma unroll
            for (int m = 0; m < 4; ++m) {
                const unsigned row = row0 + ai * 128 + m * 16;
#pragma unroll
                for (int bj = 0; bj < 2; ++bj) {
                    const int cl = bj * 128 + wc * 32 + 8 * fq;
                    pg8::f32x4 v0 = acc[ai][bj][m][0], v1 = acc[ai][bj][m][1];
                    if (act == 4) { if (cl < ncol) { float* dst = BA + (size_t)row * 16 + cl; *(pg8::f32x4*)dst = v0; *(pg8::f32x4*)(dst + 4) = v1; } }
                    else {
                        if (act == 1) {
#pragma unroll
                            for (int j = 0; j < 4; ++j) { v0[j] = fast_tanh(v0[j]); v1[j] = fast_tanh(v1[j]); } }
                        if (act == 2) {
#pragma unroll
                            for (int j = 0; j < 4; ++j) { v0[j] = fast_sigmoid(v0[j]); v1[j] = fast_sigmoid(v1[j]); } }
                        if ((act == 1 || act == 3) && cl >= 96) { v0 = (pg8::f32x4){0.f, 0.f, 0.f, 0.f}; v1 = v0; }
                        if (cl < ncol) { pg8::u32x4 w; w.x = pg8::cvt_pk_bf16(v0[0], v0[1]); w.y = pg8::cvt_pk_bf16(v0[2], v0[3]); w.z = pg8::cvt_pk_bf16(v1[0], v1[1]); w.w = pg8::cvt_pk_bf16(v1[2], v1[3]);
                            *(pg8::u32x4*)(b16 + (size_t)row * ld + cl) = w; }
                    }
                }
            }
    }
};
struct SchedLora {
    int G, c; const char* LWA; const char* LGB; const char* L2T;
    __device__ __forceinline__ bool next(int i, pg8::Unit& u) const {
        int pm, pn; if (!pg8::static_order(T / 256, 12, G, c, i, pm, pn)) return false;
        const int g = pn >> 2;
        u.pm = pm; u.pn = pn; u.e = g; u.A = (g < 2 ? LWA : LGB) + (size_t)pm * 256 * 256 * 2; u.B = L2T + ((size_t)g * RW + (size_t)(pn & 3) * 256) * 256 * 2; u.list = nullptr; u.cnt = 0; u.prow = 0; u.gat = 0; return true;
    }
    __device__ __forceinline__ void a_ready(const pg8::Unit&) const {}
    __device__ __forceinline__ void done(const pg8::Unit&) const {}
};
__device__ __forceinline__ float fast_softplus(float x);
__device__ __forceinline__ float rw_decay(float w) { return __builtin_amdgcn_exp2f(-1.4426950408889634f * __builtin_amdgcn_exp2f(1.4426950408889634f * (-fast_softplus(-w) - 0.5f))); }
struct EpiLora {
    static constexpr bool PERM = true, AFTER_DRAIN = false, CHAIN = false;
    float* WPRE; float* APRE; float* GATE; const float* w0; const float* a0;
    __device__ __forceinline__ void operator()(const pg8::f32x4 (&acc)[2][2][4][2], const pg8::Unit& u, int wr, int wc, int fr, int fq) const {
        const int g = u.e; float* C = WPRE + (size_t)g * T * RW;        const float* bias = g == 0 ? w0 : a0;
        const unsigned row0 = (unsigned)u.pm * 256u + wr * 64 + fr; const int col0 = (u.pn & 3) * 256 + wc * 32 + 8 * fq;
        pg8::f32x4 bv[2][2];
#pragma unroll
        for (int bj = 0; bj < 2; ++bj)
#pragma unroll
            for (int n = 0; n < 2; ++n) bv[bj][n] = (g < 2) ? *(const pg8::f32x4*)(bias + col0 + 128 * bj + 4 * n) : (pg8::f32x4){0.f, 0.f, 0.f, 0.f};
#pragma unroll
        for (int ai = 0; ai < 2; ++ai)
#pragma unroll
            for (int m = 0; m < 4; ++m) {
                float* rp = C + (size_t)(row0 + ai * 128 + m * 16) * RW + col0;
#pragma unroll
                for (int bj = 0; bj < 2; ++bj) {
                    pg8::f32x4 v0 = acc[ai][bj][m][0] + bv[bj][0], v1 = acc[ai][bj][m][1] + bv[bj][1];
                    if (g == 0) { v0 = (pg8::f32x4){rw_decay(v0[0]), rw_decay(v0[1]), rw_decay(v0[2]), rw_decay(v0[3])}; v1 = (pg8::f32x4){rw_decay(v1[0]), rw_decay(v1[1]), rw_decay(v1[2]), rw_decay(v1[3])}; }
                    else if (g == 1) { v0 = (pg8::f32x4){fast_sigmoid(v0[0]), fast_sigmoid(v0[1]), fast_sigmoid(v0[2]), fast_sigmoid(v0[3])}; v1 = (pg8::f32x4){fast_sigmoid(v1[0]), fast_sigmoid(v1[1]), fast_sigmoid(v1[2]), fast_sigmoid(v1[3])}; }
                    if (g == 0) { *(pg8::f32x4*)(rp + 128 * bj) = v0; *(pg8::f32x4*)(rp + 128 * bj + 4) = v1; }
                    else {
                        unsigned short* r16 = (unsigned short*)(WPRE + (size_t)g * T * RW) + (size_t)(row0 + ai * 128 + m * 16) * RW + col0 + 128 * bj;
                        pg8::u32x4 w; w.x = pg8::cvt_pk_bf16(v0[0], v0[1]); w.y = pg8::cvt_pk_bf16(v0[2], v0[3]); w.z = pg8::cvt_pk_bf16(v1[0], v1[1]); w.w = pg8::cvt_pk_bf16(v1[2], v1[3]);
                        *(pg8::u32x4*)r16 = w;
                    }
                    __builtin_amdgcn_sched_barrier(0);
                }
            }
    }
};

struct SchedMoE {
    int G, c, nN, nrows; const LAS int* tab; const int* LIST; const char* Abase; const char* W; bool gatherA; int esz;
    __device__ __forceinline__ bool next(int i, pg8::Unit& u) const {
        const int L = i * G + c; const int total = __builtin_amdgcn_readfirstlane(tab[32]) * nN; if (L >= total) return false;
        int e = 0;
        for (int k = 1; k < NE; ++k) if (__builtin_amdgcn_readfirstlane(tab[k]) * nN <= L) e = k;
        const int t0 = __builtin_amdgcn_readfirstlane(tab[e]), t1 = __builtin_amdgcn_readfirstlane(tab[e + 1]);
        const int q = L - t0 * nN, mt = t1 - t0;
        u.pm = q % mt; u.pn = q / mt; u.e = e; u.cnt = __builtin_amdgcn_readfirstlane(tab[128 + e]); u.list = LIST + (size_t)e * T; u.prow = t0 * 256 + u.pm * 256;
        u.gat = gatherA ? 1 : 0; u.A = gatherA ? Abase : Abase + (size_t)u.prow * D * esz;
        u.B = W + ((size_t)e * nrows + (size_t)u.pn * 256) * D * esz; return true;
    }
    __device__ __forceinline__ void a_ready(const pg8::Unit&) const {}
    __device__ __forceinline__ void done(const pg8::Unit&) const {}
};
typedef float f32x2_t __attribute__((ext_vector_type(2)));
__device__ __forceinline__ f32x2_t swiglu2(f32x2_t ga, f32x2_t ua, f32x2_t bg, f32x2_t bu) {
    const f32x2_t g = ga * 0.015625f + bg, u = ua * 0.015625f + bu;
    const f32x2_t gl = {fminf(g[0], 7.0f), fminf(g[1], 7.0f)}, ul = {fminf(fmaxf(u[0], -7.0f), 7.0f), fminf(fmaxf(u[1], -7.0f), 7.0f)};
    const f32x2_t t = gl * (-1.702f * 1.4426950408889634f);
    const f32x2_t d = (f32x2_t){__builtin_amdgcn_exp2f(t[0]), __builtin_amdgcn_exp2f(t[1])} + 1.0f;
    const f32x2_t rc = {__builtin_amdgcn_rcpf(d[0]), __builtin_amdgcn_rcpf(d[1])};
    return (gl * rc) * (ul * 4.0f + 4.0f);
}
struct EpiGU {
    static constexpr bool PERM = true, AFTER_DRAIN = false, CHAIN = false;
    unsigned char* ACT; const float* bgu;
    __device__ __forceinline__ void operator()(const pg8::f32x4 (&acc)[2][2][4][2], const pg8::Unit& u, int wr, int wc, int fr, int fq) const {
        const float* bg = bgu + (size_t)u.e * 2 * FF; const int f0 = 128 * u.pn + 16 * wc + 4 * fq;
        pg8::f32x4 bgv[2], buv[2];
#pragma unroll
        for (int bj = 0; bj < 2; ++bj) { bgv[bj] = *(const pg8::f32x4*)(bg + f0 + 64 * bj); buv[bj] = *(const pg8::f32x4*)(bg + FF + f0 + 64 * bj); }
        const unsigned row0 = (unsigned)u.prow + wr * 64 + fr;
#pragma unroll
        for (int ai = 0; ai < 2; ++ai)
#pragma unroll
            for (int m = 0; m < 4; ++m) {
                const unsigned row = row0 + ai * 128 + m * 16;
#pragma unroll
                for (int bj = 0; bj < 2; ++bj) {
                    const pg8::f32x4 ga = acc[ai][bj][m][0], ua = acc[ai][bj][m][1];
                    const f32x2_t a01 = swiglu2((f32x2_t){ga[0], ga[1]}, (f32x2_t){ua[0], ua[1]}, (f32x2_t){bgv[bj][0], bgv[bj][1]}, (f32x2_t){buv[bj][0], buv[bj][1]});
                    const f32x2_t a23 = swiglu2((f32x2_t){ga[2], ga[3]}, (f32x2_t){ua[2], ua[3]}, (f32x2_t){bgv[bj][2], bgv[bj][3]}, (f32x2_t){buv[bj][2], buv[bj][3]});
                    int w8 = __builtin_amdgcn_cvt_pk_fp8_f32(a01[0], a01[1], 0, false); w8 = __builtin_amdgcn_cvt_pk_fp8_f32(a23[0], a23[1], w8, true);
                    *(int*)(ACT + (size_t)row * FF + f0 + 64 * bj) = w8;
                }
            }
    }
};
struct EpiDown {
    static constexpr bool PERM = true, AFTER_DRAIN = false, CHAIN = false;
    unsigned short* YB; const float* bd;
    __device__ __forceinline__ void operator()(const pg8::f32x4 (&acc)[2][2][4][2], const pg8::Unit& u, int wr, int wc, int fr, int fq) const {
        const float* b = bd + (size_t)u.e * D; const int col0 = u.pn * 256 + wc * 32 + 8 * fq;
        pg8::f32x4 bv[2][2];
#pragma unroll
        for (int bj = 0; bj < 2; ++bj)
#pragma unroll
            for (int n = 0; n < 2; ++n) bv[bj][n] = *(const pg8::f32x4*)(b + col0 + 128 * bj + 4 * n);
        const int ml0 = u.pm * 256 + wr * 64 + fr;
#pragma unroll
        for (int ai = 0; ai < 2; ++ai)
#pragma unroll
            for (int m = 0; m < 4; ++m) {
                const int ml = ml0 + ai * 128 + m * 16;
                if (ml < u.cnt) {
                    const unsigned asg = (unsigned)u.list[ml];
#pragma unroll
                    for (int bj = 0; bj < 2; ++bj) {
                        const pg8::f32x4 v0 = acc[ai][bj][m][0] * 0.00390625f + bv[bj][0], v1 = acc[ai][bj][m][1] * 0.00390625f + bv[bj][1];
                        pg8::u32x4 w; w.x = pg8::cvt_pk_bf16(v0[0], v0[1]); w.y = pg8::cvt_pk_bf16(v0[2], v0[3]); w.z = pg8::cvt_pk_bf16(v1[0], v1[1]); w.w = pg8::cvt_pk_bf16(v1[2], v1[3]);
                        *(pg8::u32x4*)(YB + (size_t)asg * D + col0 + 128 * bj) = w;
                    }
                }
            }
    }
};
__device__ __forceinline__ void moe_tables(LAS int* tab, const unsigned* CNT) {
    if (threadIdx.x == 0) {
        int acc = 0;
        for (int e = 0; e < NE; ++e) { const int c = (int)__hip_atomic_load(&CNT[e], __ATOMIC_RELAXED, __HIP_MEMORY_SCOPE_AGENT); tab[e] = acc; tab[64 + e] = acc * 256; tab[128 + e] = c; acc += (c + 255) >> 8; }
        tab[32] = acc; tab[96] = acc * 256;
    }
    __syncthreads();
}
__device__ __forceinline__ float bf2f(unsigned short h) { return __uint_as_float((unsigned)h << 16); }


__device__ __forceinline__ f32x4_t fmaxf_v(f32x4_t v) { return (f32x4_t){fmaxf(v[0], 1e-30f), fmaxf(v[1], 1e-30f), fmaxf(v[2], 1e-30f), fmaxf(v[3], 1e-30f)}; }
struct SchedUp {
    int G, c; const char* A0; const char* A1; const char* B0; const char* B1;
    __device__ __forceinline__ bool next(int i, pg8::Unit& u) const {
        int pm, pn; if (!pg8::static_order(T / 256, D / 256, G, c, i >> 1, pm, pn)) return false;
        const int sb = i & 1;
        u.pm = pm; u.pn = pn; u.e = sb; u.A = (sb ? A1 : A0) + (size_t)pm * 256 * RW * 2; u.B = (sb ? B1 : B0) + (size_t)pn * 256 * RW * 2; u.list = nullptr; u.cnt = 0; u.prow = 0; u.gat = 0; return true;
    }
    __device__ __forceinline__ void a_ready(const pg8::Unit&) const {}
    __device__ __forceinline__ void done(const pg8::Unit&) const {}
};
struct EpiUp {
    static constexpr bool PERM = true, AFTER_DRAIN = false, CHAIN = true;
    unsigned short* MB; const unsigned short* PH;
    __device__ __forceinline__ void mid(pg8::f32x4 (&acc)[2][2][4][2], const pg8::Unit& u, int wr, int wc, int fr, int fq) const {
        const unsigned row0 = (unsigned)u.pm * 256u + wr * 64 + fr; const int col0 = u.pn * 256 + wc * 32 + 8 * fq;
#pragma unroll
        for (int ai = 0; ai < 2; ++ai)
#pragma unroll
            for (int m = 0; m < 4; ++m) {
                const unsigned row = row0 + ai * 128 + m * 16;
#pragma unroll
                for (int bj = 0; bj < 2; ++bj) {
                    const int col = col0 + 128 * bj;
                    f32x4_t a0, a1, b0, b1; ld_bf8(PH + (size_t)row * N_IN + COL_GATE + col, a0, a1); ld_bf8(PH + (size_t)row * N_IN + COL_GATE + D + col, b0, b1);
#pragma unroll
                    for (int j = 0; j < 4; ++j) { acc[ai][bj][m][0][j] *= a0[j] * __builtin_amdgcn_rcpf(fmaxf(b0[j], 1e-30f)); acc[ai][bj][m][1][j] *= a1[j] * __builtin_amdgcn_rcpf(fmaxf(b1[j], 1e-30f)); }
                }
            }
    }
    __device__ __forceinline__ void operator()(const pg8::f32x4 (&acc)[2][2][4][2], const pg8::Unit& u, int wr, int wc, int fr, int fq) const {
        const unsigned row0 = (unsigned)u.pm * 256u + wr * 64 + fr; const int col0 = u.pn * 256 + wc * 32 + 8 * fq;
#pragma unroll
        for (int ai = 0; ai < 2; ++ai)
#pragma unroll
            for (int m = 0; m < 4; ++m) {
                const unsigned row = row0 + ai * 128 + m * 16;
#pragma unroll
                for (int bj = 0; bj < 2; ++bj) {
                    const int col = col0 + 128 * bj;
                    f32x4_t b0, b1; ld_bf8(PH + (size_t)row * N_IN + COL_GATE + D + col, b0, b1);
                    const pg8::f32x4 v0 = acc[ai][bj][m][0] * fmaxf_v(b0), v1 = acc[ai][bj][m][1] * fmaxf_v(b1);
                    pg8::u32x4 w; w.x = pg8::cvt_pk_bf16(v0[0], v0[1]); w.y = pg8::cvt_pk_bf16(v0[2], v0[3]); w.z = pg8::cvt_pk_bf16(v1[0], v1[1]); w.w = pg8::cvt_pk_bf16(v1[2], v1[3]);
                    *(pg8::u32x4*)(MB + (size_t)row * D + col) = w;
                }
            }
    }
};
struct SchedPlain {
    int G, c, nM, nN, K; const char* A; const char* B;
    __device__ __forceinline__ bool next(int i, pg8::Unit& u) const {
        int pm, pn; if (!pg8::static_order(nM, nN, G, c, i, pm, pn)) return false;
        u.pm = pm; u.pn = pn; u.e = 0; u.A = A + (size_t)pm * 256 * K * 2; u.B = B + (size_t)pn * 256 * K * 2; u.list = nullptr; u.cnt = 0; u.prow = 0; u.gat = 0; return true;
    }
    __device__ __forceinline__ void a_ready(const pg8::Unit&) const {}
    __device__ __forceinline__ void done(const pg8::Unit&) const {}
};
struct EpiF32 {
    static constexpr bool PERM = true, AFTER_DRAIN = false, CHAIN = false;
    unsigned short* C; int ldc;
    __device__ __forceinline__ void operator()(const pg8::f32x4 (&acc)[2][2][4][2], const pg8::Unit& u, int wr, int wc, int fr, int fq) const {
        const unsigned row0 = (unsigned)u.pm * 256u + wr * 64 + fr; const int col0 = u.pn * 256 + wc * 32 + 8 * fq;
#pragma unroll
        for (int ai = 0; ai < 2; ++ai)
#pragma unroll
            for (int m = 0; m < 4; ++m) {
                unsigned short* rp = C + (size_t)(row0 + ai * 128 + m * 16) * ldc + col0;
#pragma unroll
                for (int bj = 0; bj < 2; ++bj) { const pg8::f32x4 v0 = acc[ai][bj][m][0], v1 = acc[ai][bj][m][1];
                    pg8::u32x4 w; w.x = pg8::cvt_pk_bf16(v0[0], v0[1]); w.y = pg8::cvt_pk_bf16(v0[2], v0[3]); w.z = pg8::cvt_pk_bf16(v1[0], v1[1]); w.w = pg8::cvt_pk_bf16(v1[2], v1[3]);
                    *(pg8::u32x4*)(rp + 128 * bj) = w; }
            }
    }
};

#define LDS_WAIT() asm volatile("s_waitcnt lgkmcnt(0)" ::: "memory")
template <class F, class FK>
__device__ __forceinline__ void cvt_item_k(const float* __restrict__ W, int ldw, int K, const F& srccol, const FK& srcrow, unsigned short* WT, int row0, int kb, LAS float* scr, int lane) {
    const int n = lane & 31, k0 = kb * 64; const int sc = srccol(row0 + n);
#pragma unroll 8
    for (int i = 0; i < 32; ++i) { const int kk = 2 * i + (lane >> 5); const int sr = srcrow(k0 + kk); scr[kk * 33 + n] = (sc >= 0 && sr >= 0) ? W[(size_t)sr * ldw + sc] : 0.f; }
    LDS_WAIT();
    const int c = lane & 7;
#pragma unroll
    for (int j = 0; j < 4; ++j) { const int n2 = (lane >> 3) + 8 * j; const LAS float* sp = scr + (8 * c) * 33 + n2;
        pg8::u32x4 o; o.x = pg8::cvt_pk_bf16(sp[0 * 33], sp[1 * 33]); o.y = pg8::cvt_pk_bf16(sp[2 * 33], sp[3 * 33]); o.z = pg8::cvt_pk_bf16(sp[4 * 33], sp[5 * 33]); o.w = pg8::cvt_pk_bf16(sp[6 * 33], sp[7 * 33]);
        *(pg8::u32x4*)(WT + (size_t)(row0 + n2) * K + k0 + 8 * c) = o; }
    LDS_WAIT();
}
template <class F>
__device__ __forceinline__ void cvt_item(const float* __restrict__ W, int ldw, int K, const F& srccol, unsigned short* WT, int row0, int kb, LAS float* scr, int lane) {
    auto idk = [](int k) { return k; };
    cvt_item_k(W, ldw, K, srccol, idk, WT, row0, kb, scr, lane);
}
template <class FM, class FK>
__device__ __forceinline__ void cvt64(const float* __restrict__ W, int ldw, int K, const FM& map4, const FK& srcrow, unsigned short* __restrict__ WT, int row0, int kb, int lane) {
    const int n4 = lane & 15, kg = lane >> 4, k0 = kb * 64 + 16 * kg;
    int sc, dr; map4(row0, n4, sc, dr);
    f32x4_t v[16];
#pragma unroll
    for (int kk = 0; kk < 16; ++kk) { const int sr = srcrow(k0 + kk); v[kk] = (sc >= 0 && sr >= 0) ? *(const f32x4_t*)(W + (size_t)sr * ldw + sc) : (f32x4_t){0.f, 0.f, 0.f, 0.f}; }
#pragma unroll
    for (int j = 0; j < 4; ++j) {
        pg8::u32x4 o0, o1;
        o0.x = pg8::cvt_pk_bf16(v[0][j], v[1][j]); o0.y = pg8::cvt_pk_bf16(v[2][j], v[3][j]); o0.z = pg8::cvt_pk_bf16(v[4][j], v[5][j]); o0.w = pg8::cvt_pk_bf16(v[6][j], v[7][j]);
        o1.x = pg8::cvt_pk_bf16(v[8][j], v[9][j]); o1.y = pg8::cvt_pk_bf16(v[10][j], v[11][j]); o1.z = pg8::cvt_pk_bf16(v[12][j], v[13][j]); o1.w = pg8::cvt_pk_bf16(v[14][j], v[15][j]);
        unsigned short* dst = WT + (size_t)(dr + j) * K + k0;
        *(pg8::u32x4*)dst = o0; *(pg8::u32x4*)(dst + 8) = o1;
    }
}
template <class FM, class FK>
__device__ __forceinline__ void cvt64_f8(const float* __restrict__ W, int ldw, int K, const FM& map4, const FK& srcrow, unsigned char* __restrict__ WT, int row0, int kb, int lane, float scale) {
    const int n4 = lane & 15, kg = lane >> 4, k0 = kb * 64 + 16 * kg;
    int sc, dr; map4(row0, n4, sc, dr);
    f32x4_t v[16];
#pragma unroll
    for (int kk = 0; kk < 16; ++kk) { const int sr = srcrow(k0 + kk); v[kk] = (sc >= 0 && sr >= 0) ? *(const f32x4_t*)(W + (size_t)sr * ldw + sc) * scale : (f32x4_t){0.f, 0.f, 0.f, 0.f}; }
#pragma unroll
    for (int j = 0; j < 4; ++j) {
        pg8::u32x4 o;
#pragma unroll
        for (int q = 0; q < 4; ++q) { int w = __builtin_amdgcn_cvt_pk_fp8_f32(v[4 * q][j], v[4 * q + 1][j], 0, false); w = __builtin_amdgcn_cvt_pk_fp8_f32(v[4 * q + 2][j], v[4 * q + 3][j], w, true); o[q] = (unsigned)w; }
        *(pg8::u32x4*)(WT + (size_t)(dr + j) * K + k0) = o;
    }
}
__device__ __forceinline__ void inproj_src(int r, int& mat, int& col) {
    mat = 0; col = -1;
    if (r < 3072) col = r;
    else if (r < 7168) col = COL_GATE + (r - 3072);
    else if (r < 7424) { if (r - 7168 < 16) col = COL_B + (r - 7168); }
    else if (r < 10496) col = COL_R + (r - 7424);
    else if (r < 10752) { mat = 1; if (r - 10496 < 96) col = r - 10496; }
    else if (r < 11008) { mat = 2; if (r - 10752 < 96) col = r - 10752; }
    else { mat = 3; col = r - 11008; }
}

typedef short bf16x8_t __attribute__((ext_vector_type(8)));
typedef unsigned short LAS* lds_u16p;
__device__ __forceinline__ f32x4_t mma16(bf16x8_t a, bf16x8_t b, f32x4_t c) { return __builtin_amdgcn_mfma_f32_16x16x32_bf16(a, b, c, 0, 0, 0); }
__device__ __forceinline__ bf16x8_t ldfrag(const LAS unsigned short* M, int ld, int r0, int k0, int lane) { return *(const LAS bf16x8_t*)(M + (r0 + (lane & 15)) * ld + k0 + 8 * (lane >> 4)); }
__device__ __forceinline__ bf16x8_t ldfragT(const LAS unsigned short* M, int t, int ks, int lane) { return *(const LAS bf16x8_t*)(M + (16 * t + (lane & 15)) * 72 + (((4 * ks + (lane >> 4)) ^ (t & 7)) << 3)); }
__device__ __forceinline__ unsigned short f2bf(float x) { return (unsigned short)(pg8::cvt_pk_bf16(x, x) & 0xffffu); }
constexpr int GR_QG = 0, GR_W = 16384, GR_KDT = 32768, GR_AI = 49152, GR_U = 57344, GR_MISC = 90112, GR_BYTES = 90368;
constexpr int GL_SM2 = 130560;
constexpr int GL_KB = 0, GL_QB = 17408, GL_VT = 34816, GL_KST = 53248, GL_KDT = 71680, GL_LM = 90112, GL_TI = 107520, GL_AI = 116736, GL_SM = 125952;

__device__ __forceinline__ void tri_inverse_64(const LAS float* Lm, LAS unsigned short* Ti, LAS float* Dg, int lane) {
    const int g = lane >> 4, n = lane & 15;
    {
        float x[16];
        const LAS float* Lb = Lm + (16 * g) * 68 + 16 * g;
#pragma unroll
        for (int i = 0; i < 16; ++i) {
            float s0 = 0.f, s1 = 0.f, s2 = 0.f, s3 = 0.f;
#pragma unroll
            for (int j4 = 0; j4 < (i + 3) / 4; ++j4) {
                const f32x4_t l4 = *(const LAS f32x4_t*)(Lb + i * 68 + 4 * j4);
                if (4 * j4 + 0 < i) s0 = fmaf(l4[0], x[4 * j4 + 0], s0);
                if (4 * j4 + 1 < i) s1 = fmaf(l4[1], x[4 * j4 + 1], s1);
                if (4 * j4 + 2 < i) s2 = fmaf(l4[2], x[4 * j4 + 2], s2);
                if (4 * j4 + 3 < i) s3 = fmaf(l4[3], x[4 * j4 + 3], s3);
            }
            x[i] = ((n == i) ? 1.0f : 0.0f) - ((s0 + s1) + (s2 + s3));
        }
#pragma unroll
        for (int i = 0; i < 16; ++i) { Dg[g * 256 + i * 16 + n] = x[i]; Ti[(16 * g + i) * 72 + 16 * g + n] = f2bf(x[i]); }
#pragma unroll
        for (int bi = 0; bi < 3; ++bi)
#pragma unroll
            for (int bj = bi + 1; bj < 4; ++bj)
#pragma unroll
                for (int r = 0; r < 4; ++r) Ti[(16 * bi + 4 * g + r) * 72 + 16 * bj + n] = 0;
    }
    auto ldA = [&](int bi, int bk) -> f32x4_t { return *(const LAS f32x4_t*)(Lm + (16 * bi + n) * 68 + 16 * bk + 4 * g); };
    auto ldD = [&](int b) -> f32x4_t { return *(const LAS f32x4_t*)(Dg + b * 256 + n * 16 + 4 * g); };
    auto ldDB = [&](int b) -> f32x4_t { f32x4_t v; v[0] = Dg[b * 256 + (4 * g + 0) * 16 + n]; v[1] = Dg[b * 256 + (4 * g + 1) * 16 + n]; v[2] = Dg[b * 256 + (4 * g + 2) * 16 + n]; v[3] = Dg[b * 256 + (4 * g + 3) * 16 + n]; return v; };
    auto mm = [&](f32x4_t av, f32x4_t bv, f32x4_t c) -> f32x4_t {
        c = __builtin_amdgcn_mfma_f32_16x16x4f32(av[0], bv[0], c, 0, 0, 0); c = __builtin_amdgcn_mfma_f32_16x16x4f32(av[1], bv[1], c, 0, 0, 0);
        c = __builtin_amdgcn_mfma_f32_16x16x4f32(av[2], bv[2], c, 0, 0, 0); c = __builtin_amdgcn_mfma_f32_16x16x4f32(av[3], bv[3], c, 0, 0, 0); return c; };
    auto put = [&](int bi, int bj, f32x4_t xv) {
#pragma unroll
        for (int r = 0; r < 4; ++r) Ti[(16 * bi + 4 * g + r) * 72 + 16 * bj + n] = f2bf(xv[r]); };
    const f32x4_t z = {0.f, 0.f, 0.f, 0.f};
    const f32x4_t x00 = ldDB(0), x11 = ldDB(1), x22 = ldDB(2);
    const f32x4_t d1 = ldD(1), d2 = ldD(2), d3 = ldD(3);
    const f32x4_t x10 = -mm(d1, mm(ldA(1, 0), x00, z), z);
    const f32x4_t x21 = -mm(d2, mm(ldA(2, 1), x11, z), z);
    const f32x4_t x32 = -mm(d3, mm(ldA(3, 2), x22, z), z);
    const f32x4_t x20 = -mm(d2, mm(ldA(2, 1), x10, mm(ldA(2, 0), x00, z)), z);
    const f32x4_t x31 = -mm(d3, mm(ldA(3, 2), x21, mm(ldA(3, 1), x11, z)), z);
    const f32x4_t x30 = -mm(d3, mm(ldA(3, 2), x20, mm(ldA(3, 1), x10, mm(ldA(3, 0), x00, z))), z);
    put(1, 0, x10); put(2, 1, x21); put(3, 2, x32); put(2, 0, x20); put(3, 1, x31); put(3, 0, x30);
}

__device__ __forceinline__ void allred16x4(float& a, float& b, float& c, float& d) {
    asm volatile("s_nop 1\n\t"
        "v_add_f32_dpp %0, %0, %0 quad_perm:[1,0,3,2] row_mask:0xf bank_mask:0xf bound_ctrl:1\n\tv_add_f32_dpp %1, %1, %1 quad_perm:[1,0,3,2] row_mask:0xf bank_mask:0xf bound_ctrl:1\n\t"
        "v_add_f32_dpp %2, %2, %2 quad_perm:[1,0,3,2] row_mask:0xf bank_mask:0xf bound_ctrl:1\n\tv_add_f32_dpp %3, %3, %3 quad_perm:[1,0,3,2] row_mask:0xf bank_mask:0xf bound_ctrl:1\n\t"
        "v_add_f32_dpp %0, %0, %0 quad_perm:[2,3,0,1] row_mask:0xf bank_mask:0xf bound_ctrl:1\n\tv_add_f32_dpp %1, %1, %1 quad_perm:[2,3,0,1] row_mask:0xf bank_mask:0xf bound_ctrl:1\n\t"
        "v_add_f32_dpp %2, %2, %2 quad_perm:[2,3,0,1] row_mask:0xf bank_mask:0xf bound_ctrl:1\n\tv_add_f32_dpp %3, %3, %3 quad_perm:[2,3,0,1] row_mask:0xf bank_mask:0xf bound_ctrl:1\n\t"
        "v_add_f32_dpp %0, %0, %0 row_half_mirror row_mask:0xf bank_mask:0xf bound_ctrl:1\n\tv_add_f32_dpp %1, %1, %1 row_half_mirror row_mask:0xf bank_mask:0xf bound_ctrl:1\n\t"
        "v_add_f32_dpp %2, %2, %2 row_half_mirror row_mask:0xf bank_mask:0xf bound_ctrl:1\n\tv_add_f32_dpp %3, %3, %3 row_half_mirror row_mask:0xf bank_mask:0xf bound_ctrl:1\n\t"
        "v_add_f32_dpp %0, %0, %0 row_mirror row_mask:0xf bank_mask:0xf bound_ctrl:1\n\tv_add_f32_dpp %1, %1, %1 row_mirror row_mask:0xf bank_mask:0xf bound_ctrl:1\n\t"
        "v_add_f32_dpp %2, %2, %2 row_mirror row_mask:0xf bank_mask:0xf bound_ctrl:1\n\tv_add_f32_dpp %3, %3, %3 row_mirror row_mask:0xf bank_mask:0xf bound_ctrl:1\n\ts_nop 1"
        : "+v"(a), "+v"(b), "+v"(c), "+v"(d));
}
__device__ __forceinline__ void gdn_a0_fin(int hv, float araw, float braw, const float* __restrict__ A_log, const float* __restrict__ dt_bias, LAS float* gcs, LAS float* betas, int lane);
__device__ __forceinline__ void gdn_a0(int item, const float* __restrict__ BA, const float* __restrict__ A_log, const float* __restrict__ dt_bias, LAS float* gcs, LAS float* betas, int lane) {
    const int hv = (item >> 6) & 7; const size_t tn = (size_t)(item >> 9) * SEQ + (item & 63) * 64 + lane;
    gdn_a0_fin(hv, BA[tn * 16 + 8 + hv], BA[tn * 16 + hv], A_log, dt_bias, gcs, betas, lane);
}
__device__ __forceinline__ void gdn_a0_fin(int hv, float araw, float braw, const float* __restrict__ A_log, const float* __restrict__ dt_bias, LAS float* gcs, LAS float* betas, int lane) {
    float g = -expf(A_log[hv]) * softplusf_(araw + dt_bias[hv]);
#pragma unroll
    for (int o = 1; o < 64; o <<= 1) { const float t = __shfl_up(g, o); if (lane >= o) g += t; }
    gcs[lane] = g; betas[lane] = sigmoidf_(braw);
}
#define A1_CB(mtx, it_) const int hv_ = ((it_) >> 6) & 7, qh_ = hv_ >> 1; const int cb_ = (((mtx) == 0) ? qh_ * 128 : ((mtx) == 1) ? COL_K + qh_ * 128 : COL_V + hv_ * 128) + 4 * cg;
#define A1_LOADW(mtx, it_, wv) do { A1_CB(mtx, it_) \
        _Pragma("unroll") for (int j = 0; j < 4; ++j) wv[j] = *(const f32x4_t*)(convw + j * 2048 + cb_); } while (0)
#define A1_LOADX(mtx, it_, xr) do { A1_CB(mtx, it_) const int s0_ = ((it_) & 63) * 64; const size_t t0_ = (size_t)((it_) >> 9) * SEQ + s0_; \
        _Pragma("unroll") for (int q = 0; q < 7; ++q) { const int rr_ = r0 - 3 + q; const size_t tr_ = (s0_ + rr_ >= 0) ? (size_t)((long long)t0_ + rr_) : t0_; xr[q] = *(const pg8::u32x2*)(PH + tr_ * N_IN + cb_); } } while (0)
__device__ __forceinline__ int gdn_item_of(int k) { const int combo = k >> 3; return ((combo >> 6) << 9) | ((k & 7) << 6) | (combo & 63); }

__device__ __forceinline__ void gdn_prep_item(int item, int item_next, int par, LAS unsigned char* lds, const unsigned short* __restrict__ PH, const float* __restrict__ BA, const float* __restrict__ convw, const float* __restrict__ A_log, const float* __restrict__ dt_bias, unsigned char* __restrict__ recs, pg8::u32x2 (&xn)[3][7], f32x4_t (&wn)[3][4]) {
    int tid_ = threadIdx.x; asm volatile("" : "+v"(tid_));
    const int tid = tid_, lane = tid & 63, wave = __builtin_amdgcn_readfirstlane(tid >> 6);
    const int ch = item & 63, hv = (item >> 6) & 7;
    const int s0 = ch * 64;
    unsigned char* rec = recs + (size_t)item * GR_BYTES;
    LAS unsigned short* Kb = (LAS unsigned short*)(lds + GL_KB); LAS unsigned short* Qb = (LAS unsigned short*)(lds + GL_QB);
    LAS unsigned short* VT = (LAS unsigned short*)(lds + GL_VT); LAS unsigned short* KsT = (LAS unsigned short*)(lds + GL_KST); LAS unsigned short* KdT = (LAS unsigned short*)(lds + GL_KDT);
    LAS float* Lm = (LAS float*)(lds + GL_LM); LAS unsigned short* Ti = (LAS unsigned short*)(lds + GL_TI); LAS unsigned short* Ai = (LAS unsigned short*)(lds + GL_AI);
    LAS float* gcs = (LAS float*)(lds + (par ? GL_SM2 : GL_SM)); LAS float* betas = gcs + 64;
    LAS float* gcs_n = (LAS float*)(lds + (par ? GL_SM : GL_SM2));
    const int cg = tid & 31, rg = tid >> 5, r0 = 4 * rg;
    {
        const f32x4_t zero4 = {0.f, 0.f, 0.f, 0.f};
        float eg[4], ekd[4], br[4];
        { const float glast = gcs[63];
#pragma unroll
          for (int r = 0; r < 4; ++r) { const float gcr = gcs[r0 + r]; br[r] = betas[r0 + r]; eg[r] = __builtin_amdgcn_exp2f(1.4426950408889634f * gcr); ekd[r] = __builtin_amdgcn_exp2f(1.4426950408889634f * (glast - gcr)); } }
        const int swz = (cg >> 2) & 7, tq = rg >> 1, to = 4 * (rg & 1);
#define A1_BODY(mtx, xr, wv) do { f32x4_t xv[7], acc[4]; float rn[4]; \
        _Pragma("unroll") for (int q = 0; q < 7; ++q) { const f32x4_t v_ = (f32x4_t){__uint_as_float(xr[q].x << 16), __uint_as_float(xr[q].x & 0xffff0000u), __uint_as_float(xr[q].y << 16), __uint_as_float(xr[q].y & 0xffff0000u)}; xv[q] = (s0 + r0 - 3 + q >= 0) ? v_ : zero4; } \
        _Pragma("unroll") for (int r = 0; r < 4; ++r) { acc[r] = wv[0] * xv[r] + wv[1] * xv[r + 1] + wv[2] * xv[r + 2] + wv[3] * xv[r + 3]; \
            _Pragma("unroll") for (int i = 0; i < 4; ++i) acc[r][i] = acc[r][i] * fast_sigmoid(acc[r][i]); \
            rn[r] = acc[r][0] * acc[r][0] + acc[r][1] * acc[r][1] + acc[r][2] * acc[r][2] + acc[r][3] * acc[r][3]; } \
        allred16x4(rn[0], rn[1], rn[2], rn[3]); \
        _Pragma("unroll") for (int r = 0; r < 4; ++r) rn[r] = rsqrtf(rn[r] + __shfl_xor(rn[r], 16) + 1e-6f); \
        if ((mtx) == 0) { _Pragma("unroll") for (int r = 0; r < 4; ++r) { const f32x4_t qv = acc[r] * (rn[r] * 0.08838834764831845f); *(LAS pg8::u32x2*)(Qb + (r0 + r) * 136 + 4 * cg) = (pg8::u32x2){pg8::cvt_pk_bf16(qv[0], qv[1]), pg8::cvt_pk_bf16(qv[2], qv[3])}; } } \
        else if ((mtx) == 1) { _Pragma("unroll") for (int r = 0; r < 4; ++r) { acc[r] = acc[r] * rn[r]; *(LAS pg8::u32x2*)(Kb + (r0 + r) * 136 + 4 * cg) = (pg8::u32x2){pg8::cvt_pk_bf16(acc[r][0], acc[r][1]), pg8::cvt_pk_bf16(acc[r][2], acc[r][3])}; } \
            _Pragma("unroll") for (int i = 0; i < 4; ++i) { const int ofs_ = (4 * cg + i) * 72 + ((tq ^ swz) << 3) + to; \
                *(LAS pg8::u32x2*)(KsT + ofs_) = (pg8::u32x2){pg8::cvt_pk_bf16(br[0] * eg[0] * acc[0][i], br[1] * eg[1] * acc[1][i]), pg8::cvt_pk_bf16(br[2] * eg[2] * acc[2][i], br[3] * eg[3] * acc[3][i])}; \
                *(LAS pg8::u32x2*)(KdT + ofs_) = (pg8::u32x2){pg8::cvt_pk_bf16(ekd[0] * acc[0][i], ekd[1] * acc[1][i]), pg8::cvt_pk_bf16(ekd[2] * acc[2][i], ekd[3] * acc[3][i])}; } } \
        else { _Pragma("unroll") for (int i = 0; i < 4; ++i) { const int ofs_ = (4 * cg + i) * 72 + ((tq ^ swz) << 3) + to; \
                *(LAS pg8::u32x2*)(VT + ofs_) = (pg8::u32x2){pg8::cvt_pk_bf16(br[0] * acc[0][i], br[1] * acc[1][i]), pg8::cvt_pk_bf16(br[2] * acc[2][i], br[3] * acc[3][i])}; } } } while (0)
        A1_BODY(0, xn[0], wn[0]);
        A1_BODY(1, xn[1], wn[1]);
        A1_BODY(2, xn[2], wn[2]);
#undef A1_BODY
    }
    __syncthreads();
    float pa_n = 0.f, pb_n = 0.f;
    if (item_next < 2048) {
        if (((item_next >> 6) & 7) != hv) { A1_LOADW(0, item_next, wn[0]); A1_LOADW(1, item_next, wn[1]); A1_LOADW(2, item_next, wn[2]); }
        A1_LOADX(0, item_next, xn[0]);
        if (wave == 7) { const int hvn = (item_next >> 6) & 7; const size_t tn = (size_t)(item_next >> 9) * SEQ + (item_next & 63) * 64 + lane; pa_n = BA[tn * 16 + 8 + hvn]; pb_n = BA[tn * 16 + hvn]; }
    }
    __builtin_amdgcn_sched_barrier(0);
    {
        const int mat = wave >> 2, ti = wave & 3, g4 = lane >> 4, n = lane & 15;
        const LAS unsigned short* Am = mat ? Qb : Kb;
        float gi[4], bi[4], gj[4];
#pragma unroll
        for (int r = 0; r < 4; ++r) { gi[r] = gcs[16 * ti + 4 * g4 + r]; bi[r] = betas[16 * ti + 4 * g4 + r]; gj[r] = gcs[16 * r + n]; }
#pragma unroll
        for (int tj = 0; tj < 4; ++tj) {
            f32x4_t acc = {0.f, 0.f, 0.f, 0.f};
#pragma unroll
            for (int ks = 0; ks < 4; ++ks) acc = mma16(ldfrag(Am, 136, 16 * ti, 32 * ks, lane), ldfrag(Kb, 136, 16 * tj, 32 * ks, lane), acc);
            const int j = 16 * tj + n;
#pragma unroll
            for (int r = 0; r < 4; ++r) {
                const int i = 16 * ti + 4 * g4 + r; const float dec = __builtin_amdgcn_exp2f(1.4426950408889634f * fminf(gi[r] - gj[tj], 0.f));
                const float vl = bi[r] * acc[r] * dec, va = acc[r] * dec;
                if (mat == 0) Lm[i * 68 + j] = (j < i) ? vl : 0.f;
                else Ai[i * 72 + j] = f2bf((j <= i) ? va : 0.f);
            }
        }
    }
    __syncthreads();
    if (wave == 0) { tri_inverse_64(Lm, Ti, (LAS float*)(lds + 126464), lane); if (item_next < 2048) A1_LOADX(1, item_next, xn[1]); }
    else {
        if (wave == 7 && item_next < 2048) gdn_a0_fin((item_next >> 6) & 7, pa_n, pb_n, A_log, dt_bias, gcs_n, gcs_n + 64, lane);
        if (item_next < 2048) A1_LOADX(1, item_next, xn[1]);
        for (int e = tid - 64; e < 64 * 128; e += NTHREADS - 64) { const int row = e >> 7, c = e & 127; const float qv = bf2f(Qb[row * 136 + c]); Qb[row * 136 + c] = f2bf(qv * __builtin_amdgcn_exp2f(1.4426950408889634f * gcs[row])); }
    }
    __syncthreads();
    if (item_next < 2048) A1_LOADX(2, item_next, xn[2]);
    __builtin_amdgcn_sched_barrier(0);
    {
        const int g4 = lane >> 4, n = lane & 15;
#pragma unroll
        for (int t2 = 0; t2 < 2; ++t2) {
            const int tn = 2 * wave + t2; const LAS unsigned short* Bt = (tn < 8) ? VT : KsT; const int tb = tn & 7;
#pragma unroll
            for (int ti = 0; ti < 4; ++ti) {
                f32x4_t acc = {0.f, 0.f, 0.f, 0.f};
#pragma unroll
                for (int ks = 0; ks < 2; ++ks) acc = mma16(ldfrag(Ti, 72, 16 * ti, 32 * ks, lane), ldfragT(Bt, tb, ks, lane), acc);
                if (tn < 8) *(f32x4_t*)(rec + GR_U + ((size_t)((ti * 8 + tb) * 64 + lane)) * 16) = acc;
                else {
#pragma unroll
                    for (int r = 0; r < 4; ++r) Kb[(16 * ti + 4 * g4 + r) * 136 + 16 * tb + n] = f2bf(acc[r]);
                }
            }
        }
    }
    __syncthreads();
    {
#pragma unroll
        for (int t2 = 0; t2 < 2; ++t2) {
            const int f = 2 * wave + t2;
            { const int ti = f >> 2, ks = f & 3;
              *(bf16x8_t*)(rec + GR_QG + (size_t)(f * 64 + lane) * 16) = ldfrag(Qb, 136, 16 * ti, 32 * ks, lane);
              *(bf16x8_t*)(rec + GR_W + (size_t)(f * 64 + lane) * 16) = ldfrag(Kb, 136, 16 * ti, 32 * ks, lane); }
            { const int td = f >> 1, ks = f & 1;
              *(bf16x8_t*)(rec + GR_KDT + (size_t)(f * 64 + lane) * 16) = ldfragT(KdT, td, ks, lane); }
        }
        { const int f = wave, ti = f >> 1, ks = f & 1;
          *(bf16x8_t*)(rec + GR_AI + (size_t)(f * 64 + lane) * 16) = ldfrag(Ai, 72, 16 * ti, 32 * ks, lane); }
        if (tid == 0) *(float*)(rec + GR_MISC) = expf(gcs[63]);
    }
    __syncthreads();
}

__device__ __forceinline__ void gdn_scan_seq(int seq, LAS unsigned char* lds, const unsigned char* __restrict__ recs, const unsigned short* __restrict__ PH, const float* __restrict__ gdn_norm, unsigned short* __restrict__ YGB) {
    const int tid = threadIdx.x, lane = tid & 63, wave = __builtin_amdgcn_readfirstlane(tid >> 6), g4 = lane >> 4, n = lane & 15;
    const int b = seq >> 3, hv = seq & 7;
    LAS unsigned short* St = (LAS unsigned short*)lds;
    LAS unsigned short* VnT = (LAS unsigned short*)(lds + 34816);
    LAS unsigned short* Zb = (LAS unsigned short*)(lds + 53248);
    const int zrow = tid >> 3, zseg = tid & 7;
    const unsigned short* zsrc = PH + ((size_t)b * SEQ + zrow) * N_IN + COL_Z + hv * 128 + zseg * 16;
    pg8::u32x4 zr0 = *(const pg8::u32x4*)zsrc, zr1 = *(const pg8::u32x4*)(zsrc + 8);
    float gnv[8];
#pragma unroll
    for (int tv = 0; tv < 8; ++tv) gnv[tv] = gdn_norm[16 * tv + n];
    *(LAS pg8::u32x4*)(Zb + zrow * 136 + zseg * 16) = zr0; *(LAS pg8::u32x4*)(Zb + zrow * 136 + zseg * 16 + 8) = zr1;
    for (int e = tid; e < 128 * 136; e += NTHREADS) St[e] = 0;
    f32x4_t S[8];
#pragma unroll
    for (int tv = 0; tv < 8; ++tv) S[tv] = (f32x4_t){0.f, 0.f, 0.f, 0.f};
    __syncthreads();
    const int ti = wave & 3;
    bf16x8_t nafr[4], nkfr[2], naifr[2]; f32x4_t nu[8]; float neg;
#define GS_LOAD(chv) do { const unsigned char* _r = recs + ((size_t)seq * 64 + (chv)) * GR_BYTES; \
        _Pragma("unroll") for (int ks = 0; ks < 4; ++ks) nafr[ks] = *(const bf16x8_t*)(_r + (wave < 4 ? GR_QG : GR_W) + (size_t)((ti * 4 + ks) * 64 + lane) * 16); \
        _Pragma("unroll") for (int ks = 0; ks < 2; ++ks) { nkfr[ks] = *(const bf16x8_t*)(_r + GR_KDT + (size_t)((wave * 2 + ks) * 64 + lane) * 16); naifr[ks] = *(const bf16x8_t*)(_r + GR_AI + (size_t)((ti * 2 + ks) * 64 + lane) * 16); } \
        if (wave >= 4) { _Pragma("unroll") for (int tv = 0; tv < 8; ++tv) nu[tv] = *(const f32x4_t*)(_r + GR_U + (size_t)((ti * 8 + tv) * 64 + lane) * 16); } \
        neg = *(const float*)(_r + GR_MISC); } while (0)
    GS_LOAD(0);
    for (int ch = 0; ch < 64; ++ch) {
        bf16x8_t afr[4], kfr[2], aifr[2]; f32x4_t ucur[8];
#pragma unroll
        for (int ks = 0; ks < 4; ++ks) afr[ks] = nafr[ks];
#pragma unroll
        for (int ks = 0; ks < 2; ++ks) { kfr[ks] = nkfr[ks]; aifr[ks] = naifr[ks]; }
#pragma unroll
        for (int tv = 0; tv < 8; ++tv) ucur[tv] = nu[tv];
        const float eg = neg;
        if (ch + 1 < 64) { GS_LOAD(ch + 1); const unsigned short* zp = zsrc + (size_t)(ch + 1) * 64 * N_IN; zr0 = *(const pg8::u32x4*)zp; zr1 = *(const pg8::u32x4*)(zp + 8); }
        f32x4_t acc1[8];
#pragma unroll
        for (int tv = 0; tv < 8; ++tv) {
            f32x4_t a = {0.f, 0.f, 0.f, 0.f};
#pragma unroll
            for (int ks = 0; ks < 4; ++ks) a = mma16(afr[ks], ldfrag(St, 136, 16 * tv, 32 * ks, lane), a);
            acc1[tv] = a;
        }
        if (wave >= 4) {
#pragma unroll
            for (int tv = 0; tv < 8; ++tv) {
                const f32x4_t vn = ucur[tv] - acc1[tv];
                pg8::u32x2 w2; w2.x = pg8::cvt_pk_bf16(vn[0], vn[1]); w2.y = pg8::cvt_pk_bf16(vn[2], vn[3]);
                *(LAS pg8::u32x2*)(VnT + (16 * tv + n) * 72 + 16 * ti + 4 * g4) = w2;
            }
        }
        __syncthreads();
        if (wave < 4) {
            float ss[4] = {0.f, 0.f, 0.f, 0.f};
#pragma unroll
            for (int tv = 0; tv < 8; ++tv) {
                f32x4_t o = acc1[tv];
#pragma unroll
                for (int ks = 0; ks < 2; ++ks) o = mma16(aifr[ks], ldfrag(VnT, 72, 16 * tv, 32 * ks, lane), o);
                acc1[tv] = o;
#pragma unroll
                for (int r = 0; r < 4; ++r) ss[r] = fmaf(o[r], o[r], ss[r]);
            }
            allred16x4(ss[0], ss[1], ss[2], ss[3]);
            const LAS unsigned short* zc = Zb + (ch & 1) * 64 * 136;
#pragma unroll
            for (int r = 0; r < 4; ++r) {
                const float inv = rsqrtf(ss[r] * (1.0f / 128.0f) + EPS); const int tr = 16 * ti + 4 * g4 + r;
                unsigned short* yrow = YGB + ((size_t)b * SEQ + ch * 64 + tr) * RW + hv * 128 + n;
#pragma unroll
                for (int tv = 0; tv < 8; ++tv) { const float z = bf2f(zc[tr * 136 + 16 * tv + n]); yrow[16 * tv] = f2bf(acc1[tv][r] * inv * gnv[tv] * z * fast_sigmoid(z)); }
            }
        }
#pragma unroll
        for (int tv = 0; tv < 8; ++tv) {
            f32x4_t s = S[tv] * eg;
#pragma unroll
            for (int ks = 0; ks < 2; ++ks) s = mma16(kfr[ks], ldfrag(VnT, 72, 16 * tv, 32 * ks, lane), s);
            S[tv] = s;
            pg8::u32x2 w2; w2.x = pg8::cvt_pk_bf16(s[0], s[1]); w2.y = pg8::cvt_pk_bf16(s[2], s[3]);
            *(LAS pg8::u32x2*)(St + (16 * tv + n) * 136 + 16 * wave + 4 * g4) = w2;
        }
        if (ch + 1 < 64) { LAS unsigned short* zn = Zb + ((ch + 1) & 1) * 64 * 136 + zrow * 136 + zseg * 16; *(LAS pg8::u32x4*)zn = zr0; *(LAS pg8::u32x4*)(zn + 8) = zr1; }
        __syncthreads();
    }
#undef GS_LOAD
}

constexpr int RT = 32;
constexpr int RBUF_FLOATS = 5 * RT * 64 + RT * 32 + RT * 2;
__device__ __forceinline__ float dpp_f(float x, const int ctrl_sel) {
    const int xi = __float_as_int(x); int r;
    if (ctrl_sel == 0) r = __builtin_amdgcn_update_dpp(0, xi, 0xB1, 0xF, 0xF, true);
    else if (ctrl_sel == 1) r = __builtin_amdgcn_update_dpp(0, xi, 0x4E, 0xF, 0xF, true);
    else if (ctrl_sel == 2) r = __builtin_amdgcn_update_dpp(0, xi, 0x141, 0xF, 0xF, true);
    else r = __builtin_amdgcn_update_dpp(0, xi, 0x140, 0xF, 0xF, true);
    return __int_as_float(r);
}
__device__ __forceinline__ float sum8(float x) { x += dpp_f(x, 0); x += dpp_f(x, 1); x += dpp_f(x, 2); return x; }
__device__ __forceinline__ float fast_softplus(float x) { return fmaxf(x, 0.0f) + 0.6931471805599453f * __builtin_amdgcn_logf(1.0f + __builtin_amdgcn_exp2f(-1.4426950408889634f * fabsf(x))); }
__device__ __forceinline__ void rwkv_scan_block(int sq, int half, LAS float* lds, const float* __restrict__ WPRE, const float* __restrict__ APRE, const unsigned short* __restrict__ PH,
                                                const float* __restrict__ k_k, const float* __restrict__ k_a, const float* __restrict__ r_k, float* __restrict__ BON, float* __restrict__ YR) {
    const int tid = threadIdx.x, lane = tid & 63, wave = __builtin_amdgcn_readfirstlane(tid >> 6);
    const int b = sq >> 4, h = sq & 15, rbase = half * 32;
    const size_t t0 = (size_t)b * SEQ;
    const int lt = tid - 256;
    f32x4_t s0w[2], s0a[2], s0k[2], s0r[2], s0v, s1w[2], s1a[2], s1k[2], s1r[2], s1v;
    f32x4_t kkc = {0.f, 0.f, 0.f, 0.f}, kac = kkc, rkc = kkc;
    if (lt >= 0) { const int colc = h * 64 + (lt & 15) * 4; kkc = *(const f32x4_t*)(k_k + colc); kac = *(const f32x4_t*)(k_a + colc); rkc = *(const f32x4_t*)(r_k + colc); }
    f32x2_t S2[4];
#pragma unroll
    for (int k = 0; k < 4; ++k) S2[k] = (f32x2_t){0.f, 0.f};
#define RW_LOAD(c, P) do { _Pragma("unroll") for (int i = 0; i < 2; ++i) { const int f = lt + 256 * i, st = f >> 4, c4 = f & 15; const size_t t = t0 + (size_t)(c) * RT + st; const int col = h * 64 + c4 * 4; \
        P##w[i] = *(const f32x4_t*)(WPRE + t * RW + col); P##a[i] = ld_bf4((const unsigned short*)APRE + t * RW + col); P##k[i] = ld_bf4(PH + t * N_IN + COL_RK + col); P##r[i] = ld_bf4(PH + t * N_IN + COL_R + col); } \
        { const int st = lt >> 3, c4 = lt & 7; P##v = ld_bf4(PH + (t0 + (size_t)(c) * RT + st) * N_IN + COL_RV + h * 64 + rbase + c4 * 4); } } while (0)
#define RW_STORE(bufp, P, c) do { LAS float* _b = (bufp); _Pragma("unroll") for (int i = 0; i < 2; ++i) { const int f = lt + 256 * i, st = f >> 4, c4 = f & 15; \
        f32x4_t wd, av, kkv; float ss = 0.f; \
        _Pragma("unroll") for (int j = 0; j < 4; ++j) { wd[j] = P##w[i][j]; av[j] = P##a[i][j]; kkv[j] = P##k[i][j] * kkc[j]; ss = fmaf(kkv[j], kkv[j], ss); } \
        ss += __shfl_xor(ss, 1); ss += __shfl_xor(ss, 2); ss += __shfl_xor(ss, 4); ss += __shfl_xor(ss, 8); \
        const float rn = rsqrtf(ss + 1e-6f); f32x4_t aav, bbv, kmv; float br = 0.f, kr = 0.f, bo = 0.f; \
        _Pragma("unroll") for (int j = 0; j < 4; ++j) { const float kk = kkv[j] * rn; aav[j] = -kk; bbv[j] = kk * av[j]; kmv[j] = P##k[i][j] * (1.0f + (av[j] - 1.0f) * kac[j]); \
            br = fmaf(bbv[j], P##r[i][j], br); kr = fmaf(kmv[j], P##r[i][j], kr); bo = fmaf(P##r[i][j] * kmv[j], rkc[j], bo); } \
        *(LAS f32x4_t*)(_b + 0 * RT * 64 + st * 64 + c4 * 4) = wd; *(LAS f32x4_t*)(_b + 1 * RT * 64 + st * 64 + c4 * 4) = bbv; *(LAS f32x4_t*)(_b + 2 * RT * 64 + st * 64 + c4 * 4) = kmv; \
        const f32x4_t _x = wd * P##r[i]; \
        *(LAS f32x4_t*)(_b + 3 * RT * 64 + st * 128 + c4 * 8) = (f32x4_t){aav[0], _x[0], aav[1], _x[1]}; *(LAS f32x4_t*)(_b + 3 * RT * 64 + st * 128 + c4 * 8 + 4) = (f32x4_t){aav[2], _x[2], aav[3], _x[3]}; \
        br += __shfl_xor(br, 1); br += __shfl_xor(br, 2); br += __shfl_xor(br, 4); br += __shfl_xor(br, 8); kr += __shfl_xor(kr, 1); kr += __shfl_xor(kr, 2); kr += __shfl_xor(kr, 4); kr += __shfl_xor(kr, 8); \
        bo += __shfl_xor(bo, 1); bo += __shfl_xor(bo, 2); bo += __shfl_xor(bo, 4); bo += __shfl_xor(bo, 8); \
        if (c4 == 0) { _b[5 * RT * 64 + RT * 32 + st * 2] = br; _b[5 * RT * 64 + RT * 32 + st * 2 + 1] = kr; if (half == 0) BON[(t0 + (size_t)(c) * RT + st) * 16 + h] = bo; } } \
        { const int st = lt >> 3, c4 = lt & 7; *(LAS f32x4_t*)(_b + 5 * RT * 64 + st * 32 + c4 * 4) = P##v; } } while (0)
    constexpr int NCH = SEQ / RT;
    const int rloc = wave * 8 + (lane >> 4) * 2, kq = (lane & 15) * 4;
    LAS float* ybuf = lds + 2 * RBUF_FLOATS;
    f32x2_t T2[4];
#pragma unroll
    for (int k = 0; k < 4; ++k) T2[k] = (f32x2_t){0.f, 0.f};
    f32x4_t Aw, Ab, Ak, Ax0, Ax1, Bw, Bb, Bk, Bx0, Bx1; f32x2_t Av, Bv, Ar, Br;
#define RW_LD(X, u) do { \
        X##w = *(const LAS f32x4_t*)(pW + (u) * 64); X##b = *(const LAS f32x4_t*)(pW + RT * 64 + (u) * 64); X##k = *(const LAS f32x4_t*)(pW + 2 * RT * 64 + (u) * 64); \
        X##x0 = *(const LAS f32x4_t*)(pX + (u) * 128); X##x1 = *(const LAS f32x4_t*)(pX + (u) * 128 + 4); \
        X##v = *(const LAS f32x2_t*)(pV + (u) * 32); X##r = *(const LAS f32x2_t*)(pR + (u) * 2); } while (0)
#define RW_SUM16(x) do { x += dpp_f(x, 0); x += dpp_f(x, 1); x += dpp_f(x, 2); x += dpp_f(x, 3); } while (0)
#define RW_STEP(X, yb, st) do { \
        f32x2_t e0 = S2[0][0] * (f32x2_t){X##x0[0], X##x0[1]}, e1 = T2[0][0] * (f32x2_t){X##x0[0], X##x0[1]}; \
        e0 += S2[0][1] * (f32x2_t){X##x0[2], X##x0[3]}; e1 += T2[0][1] * (f32x2_t){X##x0[2], X##x0[3]}; \
        e0 += S2[1][0] * (f32x2_t){X##x1[0], X##x1[1]}; e1 += T2[1][0] * (f32x2_t){X##x1[0], X##x1[1]}; \
          \
        float sa0 = __builtin_fmaf(S2[1][1], X##x1[2], e0[0]), pp0 = __builtin_fmaf(S2[1][1], X##x1[3], e0[1]), sa1 = __builtin_fmaf(T2[1][1], X##x1[2], e1[0]), pp1 = __builtin_fmaf(T2[1][1], X##x1[3], e1[1]); \
          \
        asm volatile("s_nop 1\n\t" \
            "v_add_f32_dpp %0, %0, %0 quad_perm:[1,0,3,2] row_mask:0xf bank_mask:0xf bound_ctrl:1\n\tv_add_f32_dpp %1, %1, %1 quad_perm:[1,0,3,2] row_mask:0xf bank_mask:0xf bound_ctrl:1\n\t" \
            "v_add_f32_dpp %2, %2, %2 quad_perm:[1,0,3,2] row_mask:0xf bank_mask:0xf bound_ctrl:1\n\tv_add_f32_dpp %3, %3, %3 quad_perm:[1,0,3,2] row_mask:0xf bank_mask:0xf bound_ctrl:1\n\t" \
            "v_add_f32_dpp %0, %0, %0 quad_perm:[2,3,0,1] row_mask:0xf bank_mask:0xf bound_ctrl:1\n\tv_add_f32_dpp %1, %1, %1 quad_perm:[2,3,0,1] row_mask:0xf bank_mask:0xf bound_ctrl:1\n\t" \
            "v_add_f32_dpp %2, %2, %2 quad_perm:[2,3,0,1] row_mask:0xf bank_mask:0xf bound_ctrl:1\n\tv_add_f32_dpp %3, %3, %3 quad_perm:[2,3,0,1] row_mask:0xf bank_mask:0xf bound_ctrl:1\n\t" \
            "v_add_f32_dpp %0, %0, %0 row_half_mirror row_mask:0xf bank_mask:0xf bound_ctrl:1\n\tv_add_f32_dpp %1, %1, %1 row_half_mirror row_mask:0xf bank_mask:0xf bound_ctrl:1\n\t" \
            "v_add_f32_dpp %2, %2, %2 row_half_mirror row_mask:0xf bank_mask:0xf bound_ctrl:1\n\tv_add_f32_dpp %3, %3, %3 row_half_mirror row_mask:0xf bank_mask:0xf bound_ctrl:1\n\t" \
            "v_add_f32_dpp %0, %0, %0 row_mirror row_mask:0xf bank_mask:0xf bound_ctrl:1\n\tv_add_f32_dpp %1, %1, %1 row_mirror row_mask:0xf bank_mask:0xf bound_ctrl:1\n\t" \
            "v_add_f32_dpp %2, %2, %2 row_mirror row_mask:0xf bank_mask:0xf bound_ctrl:1\n\tv_add_f32_dpp %3, %3, %3 row_mirror row_mask:0xf bank_mask:0xf bound_ctrl:1" \
            : "+v"(sa0), "+v"(sa1), "+v"(pp0), "+v"(pp1)); \
        const f32x2_t w01 = (f32x2_t){X##w[0], X##w[1]}, w23 = (f32x2_t){X##w[2], X##w[3]}, b01 = (f32x2_t){X##b[0], X##b[1]}, b23 = (f32x2_t){X##b[2], X##b[3]}, k01 = (f32x2_t){X##k[0], X##k[1]}, k23 = (f32x2_t){X##k[2], X##k[3]}; \
        S2[0] = S2[0] * w01 + (sa0 * b01 + X##v[0] * k01); S2[1] = S2[1] * w23 + (sa0 * b23 + X##v[0] * k23); \
        T2[0] = T2[0] * w01 + (sa1 * b01 + X##v[1] * k01); T2[1] = T2[1] * w23 + (sa1 * b23 + X##v[1] * k23); \
        const float y0_ = __builtin_fmaf(X##v[0], X##r[1], __builtin_fmaf(sa0, X##r[0], pp0)), y1_ = __builtin_fmaf(X##v[1], X##r[1], __builtin_fmaf(sa1, X##r[0], pp1)); \
        *(LAS f32x2_t*)((yb) + (st) * 32) = (f32x2_t){y0_, y1_}; } while (0)
#define RW_COMPUTE(c) do { const LAS float* buf = lds + ((c) & 1) * RBUF_FLOATS; \
        const LAS float* pW = buf + kq; const LAS float* pX = buf + 3 * RT * 64 + kq * 2; const LAS float* pV = buf + 5 * RT * 64 + rloc; const LAS float* pR = buf + 5 * RT * 64 + RT * 32; LAS float* pY = ybuf + ((c) & 1) * RT * 32 + rloc; \
        RW_LD(A, 0); \
        _Pragma("unroll") for (int g = 0; g < RT / 4; ++g) { \
            RW_LD(B, 4 * g + 1); RW_STEP(A, pY, 4 * g); RW_LD(A, 4 * g + 2); RW_STEP(B, pY, 4 * g + 1); RW_LD(B, 4 * g + 3); RW_STEP(A, pY, 4 * g + 2); if (g + 1 < RT / 4) RW_LD(A, 4 * g + 4); RW_STEP(B, pY, 4 * g + 3); } } while (0)
#define RW_FLUSH(c) do { const int st = lt >> 3, c4 = lt & 7; const f32x4_t yv_ = *(const LAS f32x4_t*)(ybuf + ((c) & 1) * RT * 32 + st * 32 + c4 * 4); *(pg8::u32x2*)((unsigned short*)YR + (t0 + (size_t)(c) * RT + st) * RW + h * 64 + rbase + c4 * 4) = (pg8::u32x2){pg8::cvt_pk_bf16(yv_[0], yv_[1]), pg8::cvt_pk_bf16(yv_[2], yv_[3])}; } while (0)
    if (wave >= 4) {
        RW_LOAD(0, s0); RW_STORE(lds, s0, 0); RW_LOAD(1, s0); RW_LOAD(2, s1);
        __syncthreads();
        for (int c = 0; c < NCH; c += 2) {
            RW_STORE(lds + RBUF_FLOATS, s0, c + 1); if (c + 3 < NCH) RW_LOAD(c + 3, s0); if (c > 0) RW_FLUSH(c - 1);
            __syncthreads();
            if (c + 2 < NCH) { RW_STORE(lds, s1, c + 2); } if (c + 4 < NCH) RW_LOAD(c + 4, s1); RW_FLUSH(c);
            __syncthreads();
        }
        RW_FLUSH(NCH - 1);
    } else {
        __builtin_amdgcn_s_setprio(3);
        __syncthreads();
        for (int c = 0; c < NCH; c += 2) {
            RW_COMPUTE(c);
            __syncthreads();
            RW_COMPUTE(c + 1);
            __syncthreads();
        }
        __builtin_amdgcn_s_setprio(0);
    }
#undef RW_COMPUTE
#undef RW_FLUSH
#undef RW_LD
#undef RW_STEP
#undef RW_SUM16
#undef RW_LOAD
#undef RW_STORE
}

__global__ void __launch_bounds__(NTHREADS, 2) fwd(Args a) {
    extern __shared__ __attribute__((aligned(16))) unsigned char lds_raw[];
    float* sm = (float*)lds_raw;
#define PHASE_IDS int tid = threadIdx.x; asm volatile("" : "+v"(tid)); const int lane = tid & 63, wave = tid >> 6; (void)lane; (void)wave;
    unsigned char* ws = a.ws;
    unsigned* ctl = (unsigned*)(ws + WS_CTL);
    volatile LAS unsigned* xbw = (volatile LAS unsigned*)(LAS unsigned char*)(lds_raw + LDS_BYTES - 16);
    if (threadIdx.x == 0) { xbw[0] = 0u; xbw[1] = 0u; xbw[2] = 0u; xbw[3] = 0u; }
    __syncthreads();
    const int lo = a.ph_lo, hi = a.ph_hi;
    XcdBarrier bar; bar.bar = ctl; bar.x = 0; bar.st = xbw;
    if (hi - lo > 1) bar = xcd_barrier_post(ctl, xbw);
#define IN(k) (lo <= (k) && (k) < hi)
#define SEAM(k) do { if (IN(k) && IN((k) + 1)) xcd_barrier(bar); } while (0)


    if (IN(0)) {
        PHASE_IDS
        const float* c = a.in[1];
        const float* ada_w = a.in[2];
        const float* ada_b = a.in[3];
        const float* w_in = a.in[8];
        const float* rwkv_w1 = a.in[15];
        const float* rwkv_a1 = a.in[18];
        const float* rwkv_g1 = a.in[20];
        const float* w_up_gdn = a.in[27];
        const float* w_up_rwkv = a.in[28];
        const float* w_out = a.in[29];
        const float* exp_w_gu = a.in[32];
        const float* exp_w_down = a.in[34];
        float* MOD = (float*)(ws + WS_MOD);
        unsigned short* WINT = (unsigned short*)(ws + WS_WINT);
        unsigned short* WUPG = (unsigned short*)(ws + WS_WUPG);
        unsigned short* WUPR = (unsigned short*)(ws + WS_WUPR);
        unsigned short* WOUT = (unsigned short*)(ws + WS_WOUT);
        unsigned short* WGU = (unsigned short*)(ws + WS_WGU);
        unsigned short* WDN = (unsigned short*)(ws + WS_WDN);
        float* sc = sm;
        float* part = sm + NB * D;
        for (int i = tid; i < NB * D; i += NTHREADS) sc[i] = siluf_(c[i]);
        __syncthreads();
        for (int cb = blockIdx.x; cb < 6 * D / 48; cb += gridDim.x) {
            const int c4 = tid % 12, kg = tid / 12, col = cb * 48 + c4 * 4;
            if (tid < 504) {
                f32x4_t a0 = {0.f, 0.f, 0.f, 0.f}, a1 = a0, a2 = a0, a3 = a0;
#pragma unroll 8
                for (int k = kg; k < D; k += 42) {
                    const f32x4_t w = *(const f32x4_t*)(ada_w + (size_t)k * (6 * D) + col);
                    a0 += sc[k] * w; a1 += sc[D + k] * w; a2 += sc[2 * D + k] * w; a3 += sc[3 * D + k] * w;
                }
                *(f32x4_t*)(part + (kg * 4 + 0) * 48 + c4 * 4) = a0; *(f32x4_t*)(part + (kg * 4 + 1) * 48 + c4 * 4) = a1;
                *(f32x4_t*)(part + (kg * 4 + 2) * 48 + c4 * 4) = a2; *(f32x4_t*)(part + (kg * 4 + 3) * 48 + c4 * 4) = a3;
            }
            __syncthreads();
            if (tid < 192) {
                const int bb = tid / 48, c2 = tid % 48; float t = ada_b[cb * 48 + c2];
                for (int g = 0; g < 42; ++g) t += part[(g * 4 + bb) * 48 + c2];
                MOD[(size_t)bb * 6 * D + cb * 48 + c2] = t;
            }
            __syncthreads();
        }
        {
            const int gw = blockIdx.x * (NTHREADS / 64) + wave, ngw = gridDim.x * (NTHREADS / 64);
            auto idk = [](int k) { return k; };
            constexpr int N_IP = (NT_IN * 256 / 64) * (D / 64);
            constexpr int N_GU = NE * (2 * FF / 64) * (D / 64), N_DN = NE * (D / 64) * (FF / 64);
            constexpr int N_L2 = 3 * (RW / 64) * (256 / 64), N_UP = (D / 64) * (RW / 64), N_OUT = (D / 64) * (D / 64);
            constexpr int N_ALL = N_IP + N_GU + N_DN + N_L2 + 2 * N_UP + N_OUT;
            constexpr int N_P5 = (N_GU + N_DN) * 100 / 100;
            for (int it0 = gw + N_P5; it0 < N_ALL; it0 += ngw) {
                int it = it0;
                if (it < N_GU) {
                    const int e = it / ((2 * FF / 64) * (D / 64)), r = it % ((2 * FF / 64) * (D / 64)), rb = r / (D / 64), kb = r % (D / 64);
                    auto m4 = [](int row0, int n4, int& scol, int& drow) { const int pn = row0 >> 8, cb8 = (row0 & 255) >> 3, ft = 128 * pn + (cb8 + (n4 & 7)) * 4; scol = (n4 < 8) ? ft : FF + ft; drow = row0 + (n4 & 7) * 8 + ((n4 < 8) ? 0 : 4); };
                    cvt64(exp_w_gu + (size_t)e * D * 2 * FF, 2 * FF, D, m4, idk, WGU + (size_t)e * 2 * FF * D, rb * 64, kb, lane); continue; }
                it -= N_GU;
                auto mid = [](int row0, int n4, int& scol, int& drow) { scol = row0 + 4 * n4; drow = scol; };
                if (it < N_DN) {
                    const int e = it / ((D / 64) * (FF / 64)), r = it % ((D / 64) * (FF / 64)), rb = r / (FF / 64), kb = r % (FF / 64);
                    cvt64(exp_w_down + (size_t)e * FF * D, D, FF, mid, idk, WDN + (size_t)e * D * FF, rb * 64, kb, lane); continue; }
                it -= N_DN;
                if (it < N_IP) {
                    const int rb = it / (D / 64), kb = it % (D / 64), row0 = rb * 64;
                    int mat, col0; inproj_src(row0, mat, col0);
                    const float* W = mat == 0 ? w_in : mat == 1 ? rwkv_w1 : mat == 2 ? rwkv_a1 : rwkv_g1;
                    const int ldw = mat == 0 ? N_IN : mat == 3 ? 256 : 96;
                    auto m4 = [](int r0, int n4, int& scol, int& drow) { int m2; drow = r0 + 4 * n4; inproj_src(drow, m2, scol); };
                    cvt64(W, ldw, D, m4, idk, WINT, row0, kb, lane); continue; }
                it -= N_IP;
                if (it < N_L2) {
                    const float* rwkv_w2 = a.in[16]; const float* rwkv_a2 = a.in[19]; const float* rwkv_g2 = a.in[21]; unsigned short* L2T = (unsigned short*)(ws + WS_L2T);
                    constexpr int NL = (RW / 64) * 4; const int g = it / NL, r = it % NL, rb = r / 4, kb = r % 4;
                    if (g == 0) { auto fk = [](int k) { return k < 96 ? k : -1; }; cvt64(rwkv_w2, RW, 256, mid, fk, L2T, rb * 64, kb, lane); }
                    else if (g == 1) { auto fk = [](int k) { return (k >= 128 && k < 224) ? k - 128 : -1; }; cvt64(rwkv_a2, RW, 256, mid, fk, L2T + (size_t)RW * 256, rb * 64, kb, lane); }
                    else cvt64(rwkv_g2, RW, 256, mid, idk, L2T + (size_t)2 * RW * 256, rb * 64, kb, lane);
                    continue; }
                it -= N_L2;
                if (it < N_UP) { cvt64(w_up_gdn, D, RW, mid, idk, WUPG, (it / (RW / 64)) * 64, it % (RW / 64), lane); continue; }
                it -= N_UP;
                if (it < N_UP) { cvt64(w_up_rwkv, D, RW, mid, idk, WUPR, (it / (RW / 64)) * 64, it % (RW / 64), lane); continue; }
                it -= N_UP;
                cvt64(w_out, D, D, mid, idk, WOUT, (it / (D / 64)) * 64, it % (D / 64), lane);
            }
        }
    }
    SEAM(0);

    if (IN(1)) {
        PHASE_IDS
        const float* x = a.in[0]; const float* norm_mix_pre = a.in[4]; const float* rwkv_mix = a.in[13];
        float* MOD = (float*)(ws + WS_MOD); unsigned short* AM = (unsigned short*)(ws + WS_H);
        LAS float* red = (LAS float*)(LAS unsigned char*)lds_raw;
        const int d0 = tid * 4;
        const f32x4_t nw = *(const f32x4_t*)(norm_mix_pre + d0);
        f32x4_t mx[6];
#pragma unroll
        for (int mi = 0; mi < 6; ++mi) mx[mi] = *(const f32x4_t*)(rwkv_mix + mi * D + d0);
        for (int chunk = blockIdx.x; chunk < T / 64; chunk += gridDim.x) {
            const int r0 = chunk * 64, b = r0 / SEQ; const float* mod = MOD + (size_t)b * 6 * D;
            const f32x4_t sc4 = *(const f32x4_t*)(mod + D + d0), sh4 = *(const f32x4_t*)(mod + d0);
            const f32x4_t g4 = nw * (1.0f + sc4);
            const bool hasprev = (r0 % SEQ) != 0;
            f32x4_t xa[8], xb[8], xp = {0.f, 0.f, 0.f, 0.f}, p = {0.f, 0.f, 0.f, 0.f};
            if (hasprev) xp = *(const f32x4_t*)(x + (size_t)(r0 - 1) * D + d0);
#pragma unroll
            for (int r = 0; r < 8; ++r) xa[r] = *(const f32x4_t*)(x + (size_t)(r0 + r) * D + d0);
#define P1_SUB(sb, XC, XN) do { \
            if ((sb) + 1 < 8) { _Pragma("unroll") for (int r = 0; r < 8; ++r) XN[r] = *(const f32x4_t*)(x + (size_t)(r0 + ((sb) + 1) * 8 + r) * D + d0); } \
            float ss[12]; \
            _Pragma("unroll") for (int r = 0; r < 8; ++r) ss[r] = XC[r][0] * XC[r][0] + XC[r][1] * XC[r][1] + XC[r][2] * XC[r][2] + XC[r][3] * XC[r][3]; \
            ss[8] = xp[0] * xp[0] + xp[1] * xp[1] + xp[2] * xp[2] + xp[3] * xp[3]; ss[9] = 0.f; ss[10] = 0.f; ss[11] = 0.f; \
            _Pragma("unroll") for (int q = 0; q < 3; ++q) { allred16x4(ss[4 * q], ss[4 * q + 1], ss[4 * q + 2], ss[4 * q + 3]); \
                _Pragma("unroll") for (int j = 0; j < 4; ++j) { float v_ = ss[4 * q + j]; v_ += __shfl_xor(v_, 16); v_ += __shfl_xor(v_, 32); ss[4 * q + j] = v_; } } \
            LAS float* rb_ = red + ((sb) & 1) * 96; \
            if (lane == 0) { _Pragma("unroll") for (int q = 0; q < 3; ++q) *(LAS f32x4_t*)(rb_ + wave * 12 + 4 * q) = (f32x4_t){ss[4 * q], ss[4 * q + 1], ss[4 * q + 2], ss[4 * q + 3]}; } \
            __syncthreads(); \
            f32x4_t tot[3]; \
            _Pragma("unroll") for (int q = 0; q < 3; ++q) { tot[q] = *(const LAS f32x4_t*)(rb_ + 4 * q); _Pragma("unroll") for (int w_ = 1; w_ < 8; ++w_) tot[q] += *(const LAS f32x4_t*)(rb_ + w_ * 12 + 4 * q); } \
            if ((sb) == 0 && hasprev) { const float ip = rsqrtf(tot[2][0] / D + EPS); p = xp * ip * g4 + sh4; } \
            _Pragma("unroll") for (int r = 0; r < 8; ++r) { \
                const float inv = rsqrtf(tot[r >> 2][r & 3] / D + EPS); const f32x4_t h = XC[r] * inv * g4 + sh4; \
                const size_t o = (size_t)(r0 + (sb) * 8 + r) * D + d0; \
                *(pg8::u32x2*)(AM + o) = (pg8::u32x2){pg8::cvt_pk_bf16(h[0], h[1]), pg8::cvt_pk_bf16(h[2], h[3])}; \
                const f32x4_t dl = p - h; \
                _Pragma("unroll") for (int mi = 0; mi < 6; ++mi) { const f32x4_t v_ = h + dl * mx[mi]; *(pg8::u32x2*)(AM + (size_t)(mi + 1) * T * D + o) = (pg8::u32x2){pg8::cvt_pk_bf16(v_[0], v_[1]), pg8::cvt_pk_bf16(v_[2], v_[3])}; } \
                p = h; } } while (0)
            P1_SUB(0, xa, xb); P1_SUB(1, xb, xa); P1_SUB(2, xa, xb); P1_SUB(3, xb, xa); P1_SUB(4, xa, xb); P1_SUB(5, xb, xa); P1_SUB(6, xa, xb); P1_SUB(7, xb, xa);
#undef P1_SUB
        }
    }
    SEAM(1);

    if (IN(2)) {
        PHASE_IDS
        unsigned short* AM = (unsigned short*)(ws + WS_H);
        unsigned short* WINT = (unsigned short*)(ws + WS_WINT);
        unsigned short* PH = (unsigned short*)(ws + WS_PH);
        SchedInProj S{(int)gridDim.x, (int)blockIdx.x, (const char*)AM, (const char*)WINT};
        EpiInProjF32 E{PH, (float*)(ws + WS_BA), (unsigned short*)(ws + WS_LWA), (unsigned short*)(ws + WS_LGB)};
        pg8::gemm_phase<EpiInProjF32, SchedInProj, true, false>((LAS unsigned char*)lds_raw, D, S, E);
    }
    SEAM(2);

    if (IN(3)) {
        PHASE_IDS
        const float* gdn_conv = a.in[9];
        const float* gdn_A_log = a.in[10];
        const float* gdn_dt_bias = a.in[11];
        const float* rwkv_w0 = a.in[14];
        const float* rwkv_w2 = a.in[16];
        const float* rwkv_a0 = a.in[17];
        const float* rwkv_a2 = a.in[19];
        const float* rwkv_g2 = a.in[21];
        unsigned short* PH = (unsigned short*)(ws + WS_PH);
        float* WPRE = (float*)(ws + WS_WPRE);
        float* APRE = (float*)(ws + WS_APRE);
        float* GATE = (float*)(ws + WS_GATE);
        unsigned char* GREC = ws + WS_GREC;
        {
            SchedLora S{(int)gridDim.x, (int)blockIdx.x, (const char*)(ws + WS_LWA), (const char*)(ws + WS_LGB), (const char*)(ws + WS_L2T)};
            EpiLora E{WPRE, APRE, GATE, rwkv_w0, rwkv_a0};
            int klora = 256; asm volatile("" : "+s"(klora));
            pg8::gemm_phase<EpiLora, SchedLora, true, false>((LAS unsigned char*)lds_raw, klora, S, E);
        }
        __syncthreads();
        {
            const int cg = tid & 31, r0 = 4 * (tid >> 5);
            const float* convw = gdn_conv;
            pg8::u32x2 xn[3][7]; f32x4_t wn[3][4];
            const int k0 = blockIdx.x;
            if (k0 < 2048) {
                const int it0 = gdn_item_of(k0);
                if (wave == 7) gdn_a0(it0, (const float*)(ws + WS_BA), gdn_A_log, gdn_dt_bias, (LAS float*)((LAS unsigned char*)lds_raw + GL_SM), (LAS float*)((LAS unsigned char*)lds_raw + GL_SM) + 64, lane);
                A1_LOADW(0, it0, wn[0]); A1_LOADW(1, it0, wn[1]); A1_LOADW(2, it0, wn[2]);
                A1_LOADX(0, it0, xn[0]); A1_LOADX(1, it0, xn[1]); A1_LOADX(2, it0, xn[2]);
#pragma unroll
                for (int m = 0; m < 3; ++m) {
#pragma unroll
                    for (int q = 0; q < 7; ++q) asm volatile("" : "+v"(xn[m][q].x), "+v"(xn[m][q].y));
#pragma unroll
                    for (int j = 0; j < 4; ++j) asm volatile("" : "+v"(wn[m][j]));
                }
            }
            __syncthreads();
            int par = 0;
            for (int k = k0; k < 2048; k += gridDim.x) { const int kn = k + (int)gridDim.x; gdn_prep_item(gdn_item_of(k), kn < 2048 ? gdn_item_of(kn) : 2048, par, (LAS unsigned char*)lds_raw, PH, (const float*)(ws + WS_BA), gdn_conv, gdn_A_log, gdn_dt_bias, GREC, xn, wn); par ^= 1; }
        }
    }
    SEAM(3);


    if (IN(5)) {
        PHASE_IDS
        unsigned short* PH = (unsigned short*)(ws + WS_PH);
        unsigned char* GREC = ws + WS_GREC;
        float* WD = (float*)(ws + WS_WD);
        float* AA = (float*)(ws + WS_AA);
        float* BB = (float*)(ws + WS_BB);
        float* KM = (float*)(ws + WS_KM);
        float* OG = (float*)(ws + WS_OG);
        float* YR = (float*)(ws + WS_YR);
        if (blockIdx.x < 32) gdn_scan_seq((int)blockIdx.x, (LAS unsigned char*)lds_raw, GREC, PH, a.in[12], (unsigned short*)(ws + WS_YGB));
        else if (blockIdx.x < 160) rwkv_scan_block(((int)blockIdx.x - 32) >> 1, ((int)blockIdx.x - 32) & 1, (LAS float*)(LAS unsigned char*)lds_raw, (const float*)(ws + WS_WPRE), (const float*)(ws + WS_APRE), PH, a.in[22], a.in[23], a.in[24], (float*)(ws + WS_WD), YR);
        {
            const float* exp_w_gu = a.in[32]; const float* exp_w_down = a.in[34];
            unsigned char* WGU = ws + WS_WGU; unsigned char* WDN = ws + WS_WDN;
            constexpr int N_GU = NE * (2 * FF / 64) * (D / 64), N_DN = NE * (D / 64) * (FF / 64);
            auto idk = [](int k) { return k; };
            constexpr int N_P5 = N_GU + N_DN;
            const int n4 = lane & 15, kg = lane >> 4;
            auto setup = [&](int it, const float*& Wp, int& ldw, int& Kd, unsigned char*& WTp, int& sc, int& dr, int& k0) {
                if (it < N_GU) {
                    const int e = it / ((2 * FF / 64) * (D / 64)), r = it % ((2 * FF / 64) * (D / 64)), rb = r / (D / 64), kb = r % (D / 64), row0 = rb * 64;
                    const int pn = row0 >> 8, cb8 = (row0 & 255) >> 3, ft = 128 * pn + (cb8 + (n4 & 7)) * 4; sc = (n4 < 8) ? ft : FF + ft; dr = row0 + (n4 & 7) * 8 + ((n4 < 8) ? 0 : 4);
                    Wp = exp_w_gu + (size_t)e * D * 2 * FF; ldw = 2 * FF; Kd = D; WTp = WGU + (size_t)e * 2 * FF * D; k0 = kb * 64 + 16 * kg;
                } else {
                    it -= N_GU;
                    const int e = it / ((D / 64) * (FF / 64)), r = it % ((D / 64) * (FF / 64)), rb = r / (FF / 64), kb = r % (FF / 64);
                    sc = rb * 64 + 4 * n4; dr = sc; Wp = exp_w_down + (size_t)e * FF * D; ldw = D; Kd = FF; WTp = WDN + (size_t)e * D * FF; k0 = kb * 64 + 16 * kg;
                }
            };
#define CV_LOAD(it_, v) do { const float* Wp_; unsigned char* WTp_; int ldw_, Kd_, sc_, dr_, k0_; setup((it_), Wp_, ldw_, Kd_, WTp_, sc_, dr_, k0_); (void)WTp_; (void)Kd_; (void)dr_; \
                _Pragma("unroll") for (int kk = 0; kk < 16; ++kk) v[kk] = *(const f32x4_t*)(Wp_ + (size_t)(k0_ + kk) * ldw_ + sc_); } while (0)
#define CV_STORE(it_, v) do { const float* Wp_; unsigned char* WTp_; int ldw_, Kd_, sc_, dr_, k0_; setup((it_), Wp_, ldw_, Kd_, WTp_, sc_, dr_, k0_); (void)Wp_; (void)ldw_; (void)sc_; \
                _Pragma("unroll") for (int j = 0; j < 4; ++j) { pg8::u32x4 o; \
                    _Pragma("unroll") for (int q = 0; q < 4; ++q) { int w = __builtin_amdgcn_cvt_pk_fp8_f32(v[4 * q][j] * 64.0f, v[4 * q + 1][j] * 64.0f, 0, false); w = __builtin_amdgcn_cvt_pk_fp8_f32(v[4 * q + 2][j] * 64.0f, v[4 * q + 3][j] * 64.0f, w, true); o[q] = (unsigned)w; } \
                    *(pg8::u32x4*)(WTp_ + (size_t)(dr_ + j) * Kd_ + k0_) = o; } } while (0)
            static_assert(N_P5 % 8 == 0, "batches of 8");
            for (;;) {
                int base = 0; if (lane == 0) base = (int)atomicAdd(ctl + CW_CNT + 96, 8u);
                base = __builtin_amdgcn_readfirstlane(base);
                if (base >= N_P5) break;
                f32x4_t va[16], vb[16];
                CV_LOAD(base, va);
#pragma unroll 1
                for (int i = 0; i < 8; i += 2) {
                    CV_LOAD(base + i + 1, vb);
                    CV_STORE(base + i, va);
                    if (i + 2 < 8) CV_LOAD(base + i + 2, va);
                    CV_STORE(base + i + 1, vb);
                }
            }
#undef CV_LOAD
#undef CV_STORE
        }
    }
    SEAM(5);

    if (IN(6)) {
        PHASE_IDS
        const float* gdn_norm = a.in[12];
        const float* rwkv_r_k = a.in[24];
        const float* rwkv_ln_w = a.in[25];
        const float* rwkv_ln_b = a.in[26];
        unsigned short* PH = (unsigned short*)(ws + WS_PH);
        float* GATE = (float*)(ws + WS_GATE);
        float* KM = (float*)(ws + WS_KM);
        float* OG = (float*)(ws + WS_OG);
        float* YR = (float*)(ws + WS_YR);
        unsigned short* YGB = (unsigned short*)(ws + WS_YGB);
        unsigned short* YRWB = (unsigned short*)(ws + WS_YRWB);
        {
            const int c0 = (tid & 255) * 4;
            const f32x4_t lw = *(const f32x4_t*)(rwkv_ln_w + c0), lb = *(const f32x4_t*)(rwkv_ln_b + c0);
            const float* BONp = (const float*)(ws + WS_WD);
            for (int rp = blockIdx.x; rp < T / 8; rp += gridDim.x) {
                const int rowb = rp * 8 + (tid >> 8);
                f32x4_t y[4], vv[4], gt[4]; float bsum[4], sm[4], sv[4];
#pragma unroll
                for (int i = 0; i < 4; ++i) { const size_t row = (size_t)(rowb + 2 * i); y[i] = ld_bf4((const unsigned short*)YR + row * RW + c0); vv[i] = ld_bf4(PH + row * N_IN + COL_RV + c0); gt[i] = ld_bf4((const unsigned short*)GATE + row * RW + c0); bsum[i] = BONp[row * 16 + (c0 >> 6)]; }
#pragma unroll
                for (int i = 0; i < 4; ++i) sm[i] = (y[i][0] + y[i][1]) + (y[i][2] + y[i][3]);
                allred16x4(sm[0], sm[1], sm[2], sm[3]);
                f32x4_t dl[4];
#pragma unroll
                for (int i = 0; i < 4; ++i) { dl[i] = y[i] - sm[i] * (1.0f / 64.0f); sv[i] = (dl[i][0] * dl[i][0] + dl[i][1] * dl[i][1]) + (dl[i][2] * dl[i][2] + dl[i][3] * dl[i][3]); }
                allred16x4(sv[0], sv[1], sv[2], sv[3]);
#pragma unroll
                for (int i = 0; i < 4; ++i) {
                    const float rs = rsqrtf(sv[i] * (1.0f / 64.0f) + 64e-5f);
                    const f32x4_t yo = (dl[i] * rs * lw + lb + bsum[i] * vv[i]) * gt[i];
                    *(pg8::u32x2*)(YRWB + (size_t)(rowb + 2 * i) * RW + c0) = (pg8::u32x2){pg8::cvt_pk_bf16(yo[0], yo[1]), pg8::cvt_pk_bf16(yo[2], yo[3])};
                }
            }
        }
    }
    SEAM(6);

    if (IN(7)) {
        PHASE_IDS
        unsigned short* PH = (unsigned short*)(ws + WS_PH);
        unsigned short* YGB = (unsigned short*)(ws + WS_YGB);
        unsigned short* YRWB = (unsigned short*)(ws + WS_YRWB);
        unsigned short* WUPG = (unsigned short*)(ws + WS_WUPG);
        unsigned short* WUPR = (unsigned short*)(ws + WS_WUPR);
        unsigned short* MRGB = (unsigned short*)(ws + WS_MRGB);
        float* MERGED = (float*)(ws + WS_MERGED);
        SchedUp S{(int)gridDim.x, (int)blockIdx.x, (const char*)YGB, (const char*)YRWB, (const char*)WUPG, (const char*)WUPR};
        EpiUp E{MRGB, PH};
        pg8::gemm_phase<EpiUp, SchedUp, true, false>((LAS unsigned char*)lds_raw, RW, S, E);
    }
    SEAM(7);

    if (IN(8)) {
        PHASE_IDS
        unsigned short* WOUT = (unsigned short*)(ws + WS_WOUT);
        unsigned short* MRGB = (unsigned short*)(ws + WS_MRGB);
        float* Y = (float*)(ws + WS_Y);
        SchedPlain S{(int)gridDim.x, (int)blockIdx.x, T / 256, D / 256, D, (const char*)MRGB, (const char*)WOUT};
        EpiF32 E{(unsigned short*)Y, D};
        pg8::gemm_phase<EpiF32, SchedPlain, true, false>((LAS unsigned char*)lds_raw, D, S, E);
    }
    SEAM(8);

    if (IN(9)) {
        PHASE_IDS
        const float* x = a.in[0];
        const float* norm_mix_post = a.in[5];
        const float* norm_ffn_pre = a.in[6];
        const float* router_w = a.in[30];
        const float* router_b = a.in[31];
        float* MOD = (float*)(ws + WS_MOD);
        float* Y = (float*)(ws + WS_Y);
        float* XMID = (float*)(ws + WS_XMID);
        unsigned short* H2B = (unsigned short*)(ws + WS_H2B);
        float* TOPP = (float*)(ws + WS_TOPP);
        int* LIST = (int*)(ws + WS_LIST);
        unsigned* CNT = ctl + CW_CNT;
        constexpr int HP = D + 4;
        LAS float* hb = (LAS float*)(LAS unsigned char*)lds_raw;
        const int ntl = (T / 8 - (int)blockIdx.x + (int)gridDim.x - 1) / (int)gridDim.x;
        pg8::u32x2 yr[8]; f32x4_t xr_[8];
#define P9_LOAD(tl) do { const size_t _row = (size_t)(tl) * 8 + wave; _Pragma("unroll") for (int j = 0; j < 8; ++j) { yr[j] = *(const pg8::u32x2*)((const unsigned short*)Y + _row * D + j * 256 + lane * 4); xr_[j] = *(const f32x4_t*)(x + _row * D + j * 256 + lane * 4); } } while (0)
#define P9_FINISH(tl, hbuf) do { const int _rowi = (tl) * 8 + wave; const size_t _row = (size_t)_rowi; const float* mod = MOD + (size_t)(_rowi / SEQ) * 6 * D; \
        f32x4_t ym[8]; float ss = 0.f; \
        _Pragma("unroll") for (int j = 0; j < 8; ++j) { ym[j] = (f32x4_t){__uint_as_float(yr[j].x << 16), __uint_as_float(yr[j].x & 0xffff0000u), __uint_as_float(yr[j].y << 16), __uint_as_float(yr[j].y & 0xffff0000u)}; \
            ss += ym[j][0] * ym[j][0] + ym[j][1] * ym[j][1] + ym[j][2] * ym[j][2] + ym[j][3] * ym[j][3]; } \
        ss = wave_sum(ss); const float inv = rsqrtf(ss / D + EPS); float ss2 = 0.f; \
        _Pragma("unroll") for (int j = 0; j < 8; ++j) { const int d0 = j * 256 + lane * 4; const f32x4_t nw = *(const f32x4_t*)(norm_mix_post + d0), gt = *(const f32x4_t*)(mod + 2 * D + d0); \
            ym[j] = xr_[j] + gt * (ym[j] * inv * nw); *(pg8::u32x2*)((unsigned short*)XMID + _row * D + d0) = (pg8::u32x2){pg8::cvt_pk_bf16(ym[j][0], ym[j][1]), pg8::cvt_pk_bf16(ym[j][2], ym[j][3])}; ss2 += ym[j][0] * ym[j][0] + ym[j][1] * ym[j][1] + ym[j][2] * ym[j][2] + ym[j][3] * ym[j][3]; } \
        ss2 = wave_sum(ss2); const float inv2 = rsqrtf(ss2 / D + EPS); \
        _Pragma("unroll") for (int j = 0; j < 8; ++j) { const int d0 = j * 256 + lane * 4; const f32x4_t nw = *(const f32x4_t*)(norm_ffn_pre + d0), sc = *(const f32x4_t*)(mod + 4 * D + d0), sh = *(const f32x4_t*)(mod + 3 * D + d0); \
            const f32x4_t hv = ym[j] * inv2 * nw * (1.0f + sc) + sh; \
            { int w8 = __builtin_amdgcn_cvt_pk_fp8_f32(hv[0], hv[1], 0, false); w8 = __builtin_amdgcn_cvt_pk_fp8_f32(hv[2], hv[3], w8, true); *(int*)((unsigned char*)H2B + _row * D + d0) = w8; } \
            *(LAS f32x4_t*)((hbuf) + wave * HP + d0) = hv; } } while (0)
        if (ntl > 0) { P9_LOAD(blockIdx.x); P9_FINISH((int)blockIdx.x, hb); }
        __syncthreads();
        for (int k = 0; k < ntl; ++k) {
            const int tile = (int)blockIdx.x + k * (int)gridDim.x; const LAS float* cur = hb + (k & 1) * 8 * HP;
            if (k + 1 < ntl) P9_LOAD(tile + (int)gridDim.x);
            {
                const int kp = tid >> 5, e = tid & 31;
                const LAS float* hp = cur + kp * 128; const float* wp = router_w + (size_t)kp * 128 * NE + e;
                f32x2_t acc[8];
#pragma unroll
                for (int r = 0; r < 8; ++r) acc[r] = (f32x2_t){0.f, 0.f};
#pragma unroll 2
                for (int d = 0; d < 128; d += 4) {
                    const f32x2_t wa = {wp[(size_t)d * NE], wp[(size_t)(d + 1) * NE]}, wb = {wp[(size_t)(d + 2) * NE], wp[(size_t)(d + 3) * NE]};
#pragma unroll
                    for (int r = 0; r < 8; ++r) { const f32x4_t h4 = *(const LAS f32x4_t*)(hp + r * HP + d); acc[r] += (f32x2_t){h4[0], h4[1]} * wa; acc[r] += (f32x2_t){h4[2], h4[3]} * wb; }
                }
                __syncthreads();
                LAS float* part = (LAS float*)cur;
#pragma unroll
                for (int r = 0; r < 8; ++r) part[(kp * 8 + r) * 32 + e] = acc[r][0] + acc[r][1];
            }
            __syncthreads();
            if (tid < 256) {
                const int r = tid >> 5, e = tid & 31, row = tile * 8 + r;
                const LAS float* part = cur;
                float lgt = router_b[e];
#pragma unroll
                for (int kp = 0; kp < 16; ++kp) lgt += part[(kp * 8 + r) * 32 + e];
                float val[TOPK]; int idx[TOPK];
#pragma unroll
                for (int q = 0; q < TOPK; ++q) {
                    float bv = lgt; int bi = e;
#pragma unroll
                    for (int o = 1; o < 32; o <<= 1) { const float ov = __shfl_xor(bv, o); const int oi = __shfl_xor(bi, o); if (ov > bv || (ov == bv && oi < bi)) { bv = ov; bi = oi; } }
                    val[q] = bv; idx[q] = bi; if (e == bi) lgt = -3.0e38f;
                }
                float pe[TOPK], psum = 0.f;
#pragma unroll
                for (int q = 0; q < TOPK; ++q) { pe[q] = expf(val[q] - val[0]); psum += pe[q]; }
                if (e < TOPK) {
                    const float pk = e == 0 ? pe[0] : e == 1 ? pe[1] : e == 2 ? pe[2] : pe[3]; const int ik = e == 0 ? idx[0] : e == 1 ? idx[1] : e == 2 ? idx[2] : idx[3];
                    const int asg = row * TOPK + e;
                    TOPP[asg] = pk / psum;
                    const unsigned pos = atomicAdd(&CNT[ik], 1u);
                    LIST[(size_t)ik * T + pos] = asg;
                }
            }
            if (k + 1 < ntl) P9_FINISH(tile + (int)gridDim.x, hb + ((k + 1) & 1) * 8 * HP);
            __syncthreads();
        }
#undef P9_LOAD
#undef P9_FINISH
    }
    SEAM(9);

    const int vcu = (gridDim.x % 8 == 0) ? (int)((blockIdx.x % 8) * (gridDim.x / 8) + blockIdx.x / 8) : (int)blockIdx.x;
    if (IN(10)) {
        PHASE_IDS
        const float* exp_b_gu = a.in[33];
        unsigned short* H2B = (unsigned short*)(ws + WS_H2B);
        int* LIST = (int*)(ws + WS_LIST);
        unsigned short* ACT = (unsigned short*)(ws + WS_ACT);
        unsigned short* WGU = (unsigned short*)(ws + WS_WGU);
        LAS int* mtab = (LAS int*)(LAS unsigned char*)(lds_raw + 131072);
        unsigned* CNT = ctl + CW_CNT;
        moe_tables(mtab, CNT);
        SchedMoE S{(int)gridDim.x, vcu, 2 * FF / 256, 2 * FF, mtab, LIST, (const char*)H2B, (const char*)WGU, true, 1};
        EpiGU E{(unsigned char*)ACT, exp_b_gu};
        pg8::gemm_phase<EpiGU, SchedMoE, true, true, true>((LAS unsigned char*)lds_raw, D, S, E);
    }
    SEAM(10);

    if (IN(11)) {
        PHASE_IDS
        const float* exp_b_down = a.in[35];
        int* LIST = (int*)(ws + WS_LIST);
        unsigned short* ACT = (unsigned short*)(ws + WS_ACT);
        unsigned short* YB = (unsigned short*)(ws + WS_YB);
        unsigned short* WDN = (unsigned short*)(ws + WS_WDN);
        LAS int* mtab = (LAS int*)(LAS unsigned char*)(lds_raw + 131072);
        unsigned* CNT = ctl + CW_CNT;
        moe_tables(mtab, CNT);
        SchedMoE S{(int)gridDim.x, vcu, D / 256, D, mtab, LIST, (const char*)ACT, (const char*)WDN, false, 1};
        EpiDown E{YB, exp_b_down};
        pg8::gemm_phase<EpiDown, SchedMoE, true, true, true>((LAS unsigned char*)lds_raw, FF, S, E);
    }
    SEAM(11);

    if (IN(12)) {
        PHASE_IDS
        const float* norm_ffn_post = a.in[7];
        float* MOD = (float*)(ws + WS_MOD);
        float* XMID = (float*)(ws + WS_XMID);
        float* TOPP = (float*)(ws + WS_TOPP);
        unsigned short* YB = (unsigned short*)(ws + WS_YB);
        for (int row = blockIdx.x * 8 + wave; row < T; row += gridDim.x * 8) {
            const int b = row / SEQ; const float* mod = MOD + (size_t)b * 6 * D;
            f32x4_t ylo[4], yhi[4];
#pragma unroll
            for (int j = 0; j < 4; ++j) { ylo[j] = (f32x4_t){0.f, 0.f, 0.f, 0.f}; yhi[j] = (f32x4_t){0.f, 0.f, 0.f, 0.f}; }
#pragma unroll
            for (int k = 0; k < TOPK; ++k) {
                const int asg = row * TOPK + k; const float p = TOPP[asg];
#pragma unroll
                for (int j = 0; j < 4; ++j) { f32x4_t lo, hi; ld_bf8(YB + (size_t)asg * D + j * 512 + lane * 8, lo, hi); ylo[j] += p * lo; yhi[j] += p * hi; }
            }
            float ss = 0.f;
#pragma unroll
            for (int j = 0; j < 4; ++j) ss += ylo[j][0] * ylo[j][0] + ylo[j][1] * ylo[j][1] + ylo[j][2] * ylo[j][2] + ylo[j][3] * ylo[j][3] + yhi[j][0] * yhi[j][0] + yhi[j][1] * yhi[j][1] + yhi[j][2] * yhi[j][2] + yhi[j][3] * yhi[j][3];
            ss = wave_sum(ss);
            const float inv = rsqrtf(ss / D + EPS);
#pragma unroll
            for (int j = 0; j < 4; ++j) {
                const int d0 = j * 512 + lane * 8;
                f32x4_t x0, x1; ld_bf8((const unsigned short*)XMID + (size_t)row * D + d0, x0, x1);
                const f32x4_t g0 = *(const f32x4_t*)(mod + 5 * D + d0), g1 = *(const f32x4_t*)(mod + 5 * D + d0 + 4);
                const f32x4_t n0 = *(const f32x4_t*)(norm_ffn_post + d0), n1 = *(const f32x4_t*)(norm_ffn_post + d0 + 4);
                *(f32x4_t*)(a.out + (size_t)row * D + d0) = x0 + g0 * (ylo[j] * inv * n0);
                *(f32x4_t*)(a.out + (size_t)row * D + d0 + 4) = x1 + g1 * (yhi[j] * inv * n1);
            }
        }
    }
#undef IN
#undef SEAM
}

constexpr int NPHASES = 13;
#ifndef MK_ONE_LAUNCH
#define MK_ONE_LAUNCH 1
#endif

extern "C" void kernel_launch(void* const* d_in, const int* in_sizes, int n_in, void* d_out, int out_size, void* d_ws, size_t ws_size, hipStream_t stream) {
    static int grid = 0;
    if (grid == 0) {
        if (n_in != 36 || out_size != T * D || ws_size < WS_END) { fprintf(stderr, "kernel_launch: unexpected shapes n_in %d out %d ws %zu (need %zu)\n", n_in, out_size, ws_size, (size_t)WS_END); grid = -1; return; }
        int dev = 0, cus = 0, per_cu = 0;
        if (hipGetDevice(&dev) != hipSuccess || hipDeviceGetAttribute(&cus, hipDeviceAttributeMultiprocessorCount, dev) != hipSuccess) { grid = -1; return; }
        if (hipFuncSetAttribute((const void*)fwd, hipFuncAttributeMaxDynamicSharedMemorySize, LDS_BYTES) != hipSuccess) { fprintf(stderr, "kernel_launch: hipFuncSetAttribute failed\n"); grid = -1; return; }
        if (hipOccupancyMaxActiveBlocksPerMultiprocessor(&per_cu, (const void*)fwd, NTHREADS, LDS_BYTES) != hipSuccess || per_cu < 1) { fprintf(stderr, "kernel_launch: occupancy query says %d\n", per_cu); }
        (void)hipGetLastError();
        grid = cus;
    }
    if (grid < 0) return;
    (void)hipMemsetAsync((char*)d_ws + WS_CTL, 0, CTL_BYTES, stream);
    Args a{};
    for (int i = 0; i < 36; ++i) a.in[i] = (const float*)d_in[i];
    a.out = (float*)d_out; a.ws = (unsigned char*)d_ws;
#if MK_ONE_LAUNCH
    a.ph_lo = 0; a.ph_hi = NPHASES;
    hipLaunchKernelGGL(fwd, dim3(grid), dim3(NTHREADS), LDS_BYTES, stream, a);
#else
    for (int p = 0; p < NPHASES; ++p) {
        a.ph_lo = p; a.ph_hi = p + 1;
        hipLaunchKernelGGL(fwd, dim3(grid), dim3(NTHREADS), LDS_BYTES, stream, a);
    }
#endif
}
```

```cpp
#include <hip/hip_runtime.h>
#include <cstdio>
#include <cstdint>

constexpr int D = 2048, NB = 4, SEQ = 4096, T = NB * SEQ;
constexpr int COL_K = 512, COL_V = 1024, COL_Z = 2048, COL_B = 3072, COL_A = 3080, COL_GATE = 3088, COL_R = 7184, COL_RK = 8208, COL_RV = 9232, N_IN = 10256;
constexpr int NE = 32, TOPK = 4, FF = 2048, NA = T * TOPK;
constexpr int RW = 1024;
constexpr float EPS = 1e-6f;
constexpr int NTHREADS = 512;
constexpr int LDS_BYTES = 128 * 1024 + 4096;

#define XB_TMO      128
#define XB_XCNT(j)  (256  + 64 * (j))
#define XB_XSUB(j)  (1280 + 64 * (j))
#define XB_XGEN(j)  (2304 + 64 * (j))
#define XB_TOP      3328
#define XB_TOPGEN   3392
#define XCD_BAR_WORDS 3456
#define XB_SPIN_CAP (1u << 22)
#define LAS __attribute__((address_space(3)))
__device__ __forceinline__ unsigned xb_ld(unsigned* p)              { return __hip_atomic_load(p, __ATOMIC_RELAXED, __HIP_MEMORY_SCOPE_AGENT); }
__device__ __forceinline__ unsigned xb_add(unsigned* p, unsigned v) { return __hip_atomic_fetch_add(p, v, __ATOMIC_RELAXED, __HIP_MEMORY_SCOPE_AGENT); }
__device__ __forceinline__ unsigned xb_xcc_id() { return (unsigned)__builtin_amdgcn_s_getreg((3 << 11) | 20) & 0xFu; }
#define XB_SPIN(cond, bar) do { unsigned _sp = 0; while (cond) { __builtin_amdgcn_s_sleep(1); \
    if ((++_sp & 255u) == 0u) { if (xb_ld(&(bar)[XB_TMO])) break; if (_sp > XB_SPIN_CAP) { atomicAdd(&(bar)[XB_TMO], 1u); break; } } } } while (0)
struct XcdBarrier { unsigned* bar; unsigned x; volatile LAS unsigned* st; };
__device__ __forceinline__ XcdBarrier xcd_barrier_post(unsigned* bar, volatile LAS unsigned* st) {
    XcdBarrier b; b.bar = bar; b.x = xb_xcc_id(); b.st = st;
    if (threadIdx.x == 0) (void)xb_add(&bar[XB_XCNT(b.x)], 1u);
    return b;
}
__device__ __forceinline__ void xcd_barrier_complete(unsigned* bar, unsigned x, unsigned& nloc, unsigned& nx) {
    const unsigned G = gridDim.x * gridDim.y * gridDim.z;
    unsigned sum, cnt, mine, sp = 0u;
    for (;;) {
        sum = 0u; cnt = 0u; mine = 0u;
#pragma unroll
        for (unsigned j = 0; j < 16; ++j) { const unsigned c = xb_ld(&bar[XB_XCNT(j)]); sum += c; cnt += (c > 0u) ? 1u : 0u; mine = (j == x) ? c : mine; }
        if (sum == G) break;
        __builtin_amdgcn_s_sleep(1);
        if ((++sp & 255u) == 0u) { if (xb_ld(&bar[XB_TMO])) break; if (sp > XB_SPIN_CAP) { atomicAdd(&bar[XB_TMO], 1u); break; } }
    }
    nloc = mine > 0u ? mine : 1u; nx = cnt > 0u ? cnt : 1u;
}
__device__ __forceinline__ void xcd_barrier(const XcdBarrier& b) {
    asm volatile("s_waitcnt vmcnt(0)" ::: "memory");
    __syncthreads();
    if (threadIdx.x == 0) {
        unsigned* bar = b.bar;
        __builtin_amdgcn_s_waitcnt(0);
        unsigned nloc = b.st[0], nx = b.st[1];
        if (nloc == 0u) { xcd_barrier_complete(bar, b.x, nloc, nx); b.st[0] = nloc; b.st[1] = nx; }
        const unsigned old = xb_add(&bar[XB_XSUB(b.x)], 1u);
        const unsigned gen = old / nloc;
        if (old + 1u == (gen + 1u) * nloc) {
            __builtin_amdgcn_fence(__ATOMIC_RELEASE, "agent");
            asm volatile("s_waitcnt vmcnt(0)" ::: "memory");
            const unsigned og = xb_add(&bar[XB_TOP], 1u);
            const unsigned tg = og / nx;
            if (og + 1u == (tg + 1u) * nx) xb_add(&bar[XB_TOPGEN], 1u);
            else XB_SPIN(xb_ld(&bar[XB_TOPGEN]) == tg, bar);
            __builtin_amdgcn_fence(__ATOMIC_ACQUIRE, "agent");
            xb_add(&bar[XB_XGEN(b.x)], 1u);
            asm volatile("s_waitcnt vmcnt(0)" ::: "memory");
        } else {
            XB_SPIN(xb_ld(&bar[XB_XGEN(b.x)]) == gen, bar);
            __builtin_amdgcn_fence(__ATOMIC_ACQUIRE, "agent");
            asm volatile("s_waitcnt vmcnt(0)" ::: "memory");
        }
    }
    __syncthreads();
}

constexpr size_t al256(size_t x) { return (x + 255) & ~(size_t)255; }
constexpr size_t WS_CTL   = 0;
constexpr size_t CTL_BYTES = 32768;
constexpr size_t CW_CNT   = XCD_BAR_WORDS + 64;
constexpr size_t WS_MOD   = WS_CTL + CTL_BYTES;
constexpr size_t WS_H     = al256(WS_MOD + (size_t)NB * 6 * D * 4);
constexpr size_t WS_WINT  = al256(WS_H + (size_t)7 * T * D * 2);
constexpr int NT_IN = 44;
constexpr size_t WS_PH    = al256(WS_WINT + (size_t)NT_IN * 256 * D * 2);
constexpr size_t WS_BA    = al256(WS_PH + (size_t)T * N_IN * 2);
constexpr size_t WS_LWA   = al256(WS_BA + (size_t)T * 16 * 4);
constexpr size_t WS_LGB   = al256(WS_LWA + (size_t)T * 256 * 2);
constexpr size_t WS_L2T   = al256(WS_LGB + (size_t)T * 256 * 2);
constexpr size_t WS_WPRE  = al256(WS_L2T + (size_t)3 * RW * 256 * 2);
constexpr size_t WS_APRE  = al256(WS_WPRE + (size_t)T * RW * 4);
constexpr size_t WS_GATE  = al256(WS_APRE + (size_t)T * RW * 4);
static_assert(WS_APRE == WS_WPRE + (size_t)T * RW * 4 && WS_GATE == WS_APRE + (size_t)T * RW * 4, "EpiLora indexes the three buffers from WPRE");
constexpr size_t WS_WD    = al256(WS_GATE + (size_t)T * RW * 4);
constexpr size_t WS_AA    = al256(WS_WD + (size_t)T * RW * 4);
constexpr size_t WS_BB    = al256(WS_AA + (size_t)T * RW * 4);
constexpr size_t WS_KM    = al256(WS_BB + (size_t)T * RW * 4);
constexpr size_t WS_OG    = al256(WS_KM + (size_t)T * RW * 4);
constexpr size_t WS_YR    = al256(WS_OG + (size_t)T * RW * 4);
constexpr size_t WS_MERGED= al256(WS_YR + (size_t)T * RW * 4);
constexpr size_t WS_Y     = al256(WS_MERGED + (size_t)T * D * 4);
constexpr size_t WS_XMID  = al256(WS_Y + (size_t)T * D * 4);
constexpr size_t WS_H2B   = al256(WS_XMID + (size_t)T * D * 4);
constexpr size_t WS_TOPP  = al256(WS_H2B + (size_t)T * D * 2);
constexpr size_t WS_LIST  = al256(WS_TOPP + (size_t)NA * 4);
constexpr int ACT_ROWS = NA + NE * 256;
constexpr size_t WS_ACT   = al256(WS_LIST + (size_t)NE * T * 4);
constexpr size_t WS_YB    = al256(WS_ACT + (size_t)ACT_ROWS * FF * 2);
constexpr size_t WS_WGU   = al256(WS_YB + (size_t)NA * D * 2);
constexpr size_t WS_WDN   = al256(WS_WGU + (size_t)NE * 2 * FF * D * 2);
constexpr size_t WS_YGB   = al256(WS_WDN + (size_t)NE * D * FF * 2);
constexpr size_t WS_YRWB  = al256(WS_YGB + (size_t)T * RW * 2);
constexpr size_t WS_WUPG  = al256(WS_YRWB + (size_t)T * RW * 2);
constexpr size_t WS_WUPR  = al256(WS_WUPG + (size_t)D * RW * 2);
constexpr size_t WS_WOUT  = al256(WS_WUPR + (size_t)D * RW * 2);
constexpr size_t WS_MRGB  = al256(WS_WOUT + (size_t)D * D * 2);
constexpr size_t WS_GREC  = al256(WS_MRGB + (size_t)T * D * 2);
constexpr size_t WS_END   = al256(WS_GREC + (size_t)2048 * 90368);

struct Args {
    const float* in[36];
    float* out;
    unsigned char* ws;
    int ph_lo, ph_hi;
};

__device__ __forceinline__ float sigmoidf_(float x) { return 1.0f / (1.0f + expf(-x)); }
__device__ __forceinline__ float siluf_(float x) { return x * sigmoidf_(x); }
__device__ __forceinline__ float softplusf_(float x) { return fmaxf(x, 0.0f) + log1pf(expf(-fabsf(x))); }
__device__ __forceinline__ float rl(float x, int k) { return __int_as_float(__builtin_amdgcn_readlane(__float_as_int(x), k)); }
__device__ __forceinline__ float wave_sum(float v) {
#pragma unroll
    for (int o = 32; o > 0; o >>= 1) v += __shfl_xor(v, o);
    return v;
}
__device__ __forceinline__ float half_sum(float v) {
#pragma unroll
    for (int o = 16; o > 0; o >>= 1) v += __shfl_xor(v, o);
    return v;
}
__device__ __forceinline__ float block_sum(float v, float* red) {
    v = wave_sum(v);
    __syncthreads();
    if ((threadIdx.x & 63) == 0) red[threadIdx.x >> 6] = v;
    __syncthreads();
    float t = 0.f;
#pragma unroll
    for (int w = 0; w < NTHREADS / 64; ++w) t += red[w];
    return t;
}

constexpr int GBM = 128, GBN = 64, GBK = 16;
template <bool DUAL, class AL, class EP>
__device__ __forceinline__ void gemm_naive(float* sm, int M, int N, int K, const AL& al, const float* __restrict__ W, int ldw, int dual_off, const EP& ep) {
    float* As = sm;
    float* Bs = sm + GBK * (GBM + 4);
    float* Bs2 = Bs + GBK * (GBN + 4);
    const int tid = threadIdx.x, tx = tid & 15, ty = tid >> 4;
    const int ntm = (M + GBM - 1) / GBM, ntn = (N + GBN - 1) / GBN;
    for (int tile = blockIdx.x; tile < ntm * ntn; tile += gridDim.x) {
        const int tm = tile / ntn, tn = tile % ntn;
        const int m0 = tm * GBM, n0 = tn * GBN;
        float acc[4][4], acc2[4][4];
#pragma unroll
        for (int i = 0; i < 4; ++i)
#pragma unroll
            for (int j = 0; j < 4; ++j) { acc[i][j] = 0.f; acc2[i][j] = 0.f; }
        for (int k0 = 0; k0 < K; k0 += GBK) {
#pragma unroll
            for (int i = 0; i < 4; ++i) { const int idx = tid + i * NTHREADS, r = idx >> 4, kk = idx & 15; As[kk * (GBM + 4) + r] = al(m0 + r, k0 + kk); }
#pragma unroll
            for (int i = 0; i < 2; ++i) { const int idx = tid + i * NTHREADS, kk = idx >> 6, c = idx & 63, n = n0 + c;
                Bs[kk * (GBN + 4) + c] = (n < N) ? W[(size_t)(k0 + kk) * ldw + n] : 0.f;
                if (DUAL) Bs2[kk * (GBN + 4) + c] = (n < N) ? W[(size_t)(k0 + kk) * ldw + n + dual_off] : 0.f; }
            __syncthreads();
#pragma unroll
            for (int kk = 0; kk < GBK; ++kk) {
                float a[4], b[4], b2[4];
#pragma unroll
                for (int i = 0; i < 4; ++i) a[i] = As[kk * (GBM + 4) + ty * 4 + i];
#pragma unroll
                for (int j = 0; j < 4; ++j) { b[j] = Bs[kk * (GBN + 4) + tx * 4 + j]; b2[j] = DUAL ? Bs2[kk * (GBN + 4) + tx * 4 + j] : 0.f; }
#pragma unroll
                for (int i = 0; i < 4; ++i)
#pragma unroll
                    for (int j = 0; j < 4; ++j) { acc[i][j] = fmaf(a[i], b[j], acc[i][j]); if (DUAL) acc2[i][j] = fmaf(a[i], b2[j], acc2[i][j]); }
            }
            __syncthreads();
        }
#pragma unroll
        for (int i = 0; i < 4; ++i)
#pragma unroll
            for (int j = 0; j < 4; ++j) { const int m = m0 + ty * 4 + i, n = n0 + tx * 4 + j; if (m < M && n < N) ep(m, n, acc[i][j], acc2[i][j]); }
    }
}

struct ALPlain { const float* A; int lda; __device__ __forceinline__ float operator()(int m, int k) const { return A[(size_t)m * lda + k]; } };
struct ALMix {
    const float* H; const float* mix;
    __device__ __forceinline__ float operator()(int m, int k) const {
        const float h = H[(size_t)m * D + k];
        const float hp = ((m % SEQ) == 0) ? 0.f : H[(size_t)(m - 1) * D + k];
        return h + (hp - h) * mix[k];
    }
};
struct ALGatherTok { const float* H2; const int* list; int cnt; __device__ __forceinline__ float operator()(int m, int k) const { return (m < cnt) ? H2[(size_t)(list[m] >> 2) * D + k] : 0.f; } };
struct ALGatherAsg { const float* ACT; const int* list; int cnt; __device__ __forceinline__ float operator()(int m, int k) const { return (m < cnt) ? ACT[(size_t)list[m] * FF + k] : 0.f; } };

namespace pg8 {
#define PG8_LAS __attribute__((address_space(3)))
typedef unsigned short bf16_t;
typedef short bf16x8 __attribute__((ext_vector_type(8)));
typedef float f32x4 __attribute__((ext_vector_type(4)));
typedef unsigned u32x4 __attribute__((ext_vector_type(4)));
typedef unsigned u32x2 __attribute__((ext_vector_type(2)));
constexpr int BM = 256, BK = 64, HALF = 128, HTB = HALF * BK * 2, STAGE_BYTES = 8 * HTB, NXCD = 8, WGM = 2;
__host__ __device__ __forceinline__ int lds_byte(int r, int c) { const int st = (r >> 4) * 2 + (c >> 5), rr = r & 15, cc = c & 31, ob = rr * 64 + cc * 2; return st * 1024 + (ob ^ (((ob >> 9) & 1) << 5)); }
__host__ __device__ __forceinline__ void stage_rc(int b, int& R, int& C) { const int st = b / 1024, sb = b % 1024, swz = sb ^ (((sb >> 9) & 1) << 5); R = (st >> 1) * 16 + swz / 64; C = (st & 1) * 32 + (swz % 64) / 2; }
__host__ __device__ __forceinline__ int perm32(int rho) { const int n = rho >> 4, i = rho & 15; return 8 * (i >> 2) + 4 * n + (i & 3); }
struct Unit { int pm, pn; const char* A; const char* B; const int* list; int cnt, e, prow, gat; };
typedef __bf16 bf16x2_t __attribute__((ext_vector_type(2)));
__device__ __forceinline__ unsigned cvt_pk_bf16(float lo, float hi) { bf16x2_t v; v.x = (__bf16)lo; v.y = (__bf16)hi; return __builtin_bit_cast(unsigned, v); }
__device__ __forceinline__ bool static_order(int nM, int nN, int G, int c, int i, int& pm, int& pn) {
    const int nwg = nM * nN; const long L = (long)i * G + c; if (L >= nwg) return false;
    int wgid = (int)L; { const int q = nwg / NXCD, r = nwg % NXCD, xcd = wgid % NXCD, off = wgid / NXCD; wgid = (xcd < r ? xcd * (q + 1) : r * (q + 1) + (xcd - r) * q) + off; }
    const int nig = WGM * nN, gid = wgid / nig, fm = gid * WGM, gsz = (nM - fm) < WGM ? (nM - fm) : WGM;
    pm = fm + ((wgid % nig) % gsz); pn = (wgid % nig) / gsz; return true;
}
template <class Epi, class Sched, bool ALIGN_EPI = true, bool GATHER = false, bool FP8 = false>
__device__ __forceinline__ void gemm_phase(PG8_LAS unsigned char* lds, const int K_, const Sched& S, const Epi& E) {
    const int tid = threadIdx.x, wid = __builtin_amdgcn_readfirstlane(tid >> 6), lane = tid & 63, wr = wid >> 2, wc = wid & 3, fr = lane & 15, fq = lane >> 4;
    const int K = K_, KB = FP8 ? K_ : 2 * K_, nt = KB / 128;
    unsigned voffA0, voffB0;
    { int R, C; stage_rc(tid * 16, R, C); const int Rb = Epi::PERM ? ((R & ~31) + perm32(R & 31)) : R;
      voffA0 = (unsigned)(R * KB + C * 2); voffB0 = (unsigned)(Rb * KB + C * 2); }
    const size_t pstep = (size_t)64 * KB;
    const size_t kstep = (size_t)(BK * 2);
    const size_t hstep = (size_t)HALF * KB;
    const size_t tstep = 2 * hstep; (void)tstep;
    const unsigned ldsw = (unsigned)wid * 1024u;
    const int cole = FP8 ? ((fq >> 1) * 32 + (fq & 1) * 16) : fq * 8;
    const int aoff = lds_byte(wr * 64 + fr, cole), boff = aoff + (wc * 2 - wr * 4) * 2048;
    typedef int _i8 __attribute__((ext_vector_type(8))); typedef _i8 _i8a __attribute__((aligned(16)));
    constexpr bool SP2 = true;
    unsigned vA_c[2][2];
    PG8_LAS unsigned* gtab = (PG8_LAS unsigned*)(lds + STAGE_BYTES + 1024);
#define PG8_FILLTAB(u) do { int _t = threadIdx.x; asm volatile("" : "+v"(_t));   if (_t < 256) { const int _m = (u).pm * 256 + _t; \
        const int _tok = (u).gat ? ((_m < (u).cnt) ? ((u).list[_m] >> 2) : 0) : _t;     \
        gtab[_t] = (unsigned)_tok * (unsigned)KB; } } while (0)
#define PG8_SETVA(v, u) do { int _t2 = threadIdx.x; if constexpr (GATHER) asm volatile("" : "+v"(_t2)); _Pragma("unroll") for (int _h = 0; _h < 2; ++_h) _Pragma("unroll") for (int _i = 0; _i < 2; ++_i) { \
        if constexpr (GATHER) { int _R, _C; stage_rc(_t2 * 16 + _i * 8192, _R, _C); (v)[_h][_i] = gtab[_h * 128 + _R] + (unsigned)(_C * 2); } \
        else (v)[_h][_i] = 0u; } } while (0)
#define PG8_STAGE_A(bufoff, gbase, h, nx) do { _Pragma("unroll") for (int _i = 0; _i < 2; ++_i) { \
        const char* _src = GATHER ? (const char*)(gbase) + vA_c[h][_i] : (const char*)(gbase) + (size_t)(h) * hstep + (size_t)_i * pstep + voffA0; \
        __builtin_amdgcn_global_load_lds((const unsigned*)_src, (PG8_LAS unsigned*)(lds + (bufoff) + ldsw + _i * 8192), 16, 0, 0); } } while (0)
#define PG8_SA(b, h) (((b) * 2 + (h)) * HTB)
#define PG8_SB(b, h) ((4 + (b) * 2 + (h)) * HTB)
#define PG8_STAGE(bufoff, gbase, voff) do { _Pragma("unroll") for (int _i = 0; _i < 2; ++_i) \
        __builtin_amdgcn_global_load_lds((const unsigned*)((const char*)(gbase) + (size_t)_i * pstep + voff##0), (PG8_LAS unsigned*)(lds + (bufoff) + ldsw + _i * 8192), 16, 0, 0); } while (0)
#define PG8_LDA(dst, b, h) do { _Pragma("unroll") for (int m = 0; m < 4; ++m) { \
        if constexpr (FP8) { dst##8[m] = *(const PG8_LAS _i8a*)(lds + PG8_SA(b, h) + aoff + m * 2048); } \
        else { _Pragma("unroll") for (int k = 0; k < 2; ++k) dst[m][k] = *(const PG8_LAS bf16x8*)(lds + PG8_SA(b, h) + aoff + m * 2048 + k * 1024); } } } while (0)
#define PG8_LDB(dst, b, h) do { _Pragma("unroll") for (int n = 0; n < 2; ++n) { \
        if constexpr (FP8) { dst##8[n] = *(const PG8_LAS _i8a*)(lds + PG8_SB(b, h) + boff + n * 2048); } \
        else { _Pragma("unroll") for (int k = 0; k < 2; ++k) dst[n][k] = *(const PG8_LAS bf16x8*)(lds + PG8_SB(b, h) + boff + n * 2048 + k * 1024); } } } while (0)
#define PG8_MMA(ai, bj, At, Bt) do { __builtin_amdgcn_s_setprio(1); _Pragma("unroll") for (int m = 0; m < 4; ++m) _Pragma("unroll") for (int n = 0; n < 2; ++n) { \
        if constexpr (FP8) acc[ai][bj][m][n] = __builtin_amdgcn_mfma_scale_f32_16x16x128_f8f6f4(Bt##8[n], At##8[m], acc[ai][bj][m][n], 0, 0, 0, 127, 0, 127); \
        else { _Pragma("unroll") for (int k = 0; k < 2; ++k) acc[ai][bj][m][n] = __builtin_amdgcn_mfma_f32_16x16x32_bf16(Bt[n][k], At[m][k], acc[ai][bj][m][n], 0, 0, 0); } } \
        __builtin_amdgcn_s_setprio(0); } while (0)
#define PG8_WAIT_V(n) asm volatile("s_waitcnt vmcnt(" #n ")" ::: "memory")
#define PG8_WAIT_L(n) asm volatile("s_waitcnt lgkmcnt(" #n ")" ::: "memory")
#define PG8_BAR __builtin_amdgcn_s_barrier()
#define PG8_SCHED __builtin_amdgcn_sched_barrier(0)
    Unit cur, nxt; int ui = 0;
    if (!S.next(0, cur)) return;
    f32x4 acc[2][2][4][2];
#pragma unroll
    for (int a = 0; a < 2; ++a)
#pragma unroll
        for (int b = 0; b < 2; ++b)
#pragma unroll
            for (int m = 0; m < 4; ++m)
#pragma unroll
                for (int n = 0; n < 2; ++n) acc[a][b][m][n] = (f32x4){0.f, 0.f, 0.f, 0.f};
    bf16x8 At[4][2], B0[2][2], B1[2][2]; _i8 At8[4], B08[2], B18[2];
    const char* cA = cur.A; const char* cB = cur.B;
    S.a_ready(cur);
    if constexpr (GATHER) { PG8_FILLTAB(cur); __syncthreads(); }
    PG8_SETVA(vA_c, cur);
    if constexpr (GATHER) __syncthreads();
    if constexpr (SP2) {
        PG8_STAGE(PG8_SB(0, 0), cB, voffB); PG8_STAGE(PG8_SB(0, 1), cB + hstep, voffB); PG8_STAGE_A(PG8_SA(0, 0), cA, 0, false); PG8_STAGE_A(PG8_SA(0, 1), cA, 1, false);
        if (wr == 1) PG8_BAR;
        PG8_WAIT_V(2); PG8_BAR;
        PG8_STAGE(PG8_SB(1, 0), cB + kstep, voffB); PG8_STAGE_A(PG8_SA(1, 0), cA + kstep, 0, false); PG8_STAGE(PG8_SB(1, 1), cB + hstep + kstep, voffB);
        PG8_WAIT_V(6); PG8_BAR;
    }
    for (;;) {
        const bool has_next = S.next(ui + 1, nxt);
        const char* nA = has_next ? nxt.A : cA; const char* nB = has_next ? nxt.B : cB;
        if constexpr (GATHER) { if (has_next) PG8_FILLTAB(nxt); }
        for (int t = 0; t < nt; t += 2) {
            const bool last = (t == nt - 2); const bool lastn = last && has_next; (void)lastn;
            const char* a1 = cA + (size_t)(t + 1) * kstep;
            const char* a2 = last ? nA : cA + (size_t)(t + 2) * kstep; const char* b2 = last ? nB : cB + (size_t)(t + 2) * kstep;
            const char* a3 = a2 + kstep; const char* b3 = b2 + kstep;
            if (last && has_next) S.a_ready(nxt);
            if constexpr (SP2) {
            PG8_LDB(B0, 0, 0); PG8_LDB(B1, 0, 1); PG8_SCHED; PG8_LDA(At, 0, 0); PG8_STAGE_A(PG8_SA(1, 1), a1, 1, false);
            PG8_WAIT_V(8); PG8_WAIT_L(0); PG8_BAR; PG8_MMA(0, 0, At, B0); PG8_MMA(0, 1, At, B1); PG8_BAR; PG8_SCHED;
            if constexpr (GATHER) { if (lastn) PG8_SETVA(vA_c, nxt); }
            PG8_LDA(At, 0, 1); PG8_STAGE(PG8_SB(0, 0), b2, voffB); PG8_STAGE(PG8_SB(0, 1), b2 + hstep, voffB); PG8_STAGE_A(PG8_SA(0, 0), a2, 0, lastn);
            PG8_WAIT_V(8); PG8_WAIT_L(0); PG8_BAR; PG8_MMA(1, 0, At, B0); PG8_MMA(1, 1, At, B1); PG8_BAR; PG8_SCHED;
            PG8_LDB(B0, 1, 0); PG8_LDB(B1, 1, 1); PG8_SCHED; PG8_LDA(At, 1, 0); PG8_STAGE_A(PG8_SA(0, 1), a2, 1, lastn);
            PG8_WAIT_V(8); PG8_WAIT_L(0); PG8_BAR; PG8_MMA(0, 0, At, B0); PG8_MMA(0, 1, At, B1); PG8_BAR; PG8_SCHED;
            PG8_LDA(At, 1, 1); PG8_STAGE(PG8_SB(1, 0), b3, voffB); PG8_STAGE(PG8_SB(1, 1), b3 + hstep, voffB); PG8_STAGE_A(PG8_SA(1, 0), a3, 0, lastn);
            PG8_WAIT_V(8); PG8_WAIT_L(0); PG8_BAR; PG8_MMA(1, 0, At, B0); PG8_MMA(1, 1, At, B1); PG8_BAR; PG8_SCHED;
            }
        }
        if constexpr (ALIGN_EPI) { if (wr == 0) PG8_BAR; }
        asm volatile("" ::: "memory");
        bool chained = false;
        if constexpr (!Epi::AFTER_DRAIN) { if constexpr (Epi::CHAIN) { if (cur.e == 0) { E.mid(acc, cur, wr, wc, fr, fq); chained = true; } else E(acc, cur, wr, wc, fr, fq); } else E(acc, cur, wr, wc, fr, fq); S.done(cur); }
        if (!has_next) break;
        if (!chained) {
#pragma unroll
        for (int a = 0; a < 2; ++a)
#pragma unroll
            for (int b = 0; b < 2; ++b)
#pragma unroll
                for (int m = 0; m < 4; ++m)
#pragma unroll
                    for (int n = 0; n < 2; ++n) acc[a][b][m][n] = (f32x4){0.f, 0.f, 0.f, 0.f};
        }
        cur = nxt; cA = nA; cB = nB; ++ui;
        if constexpr (ALIGN_EPI) { if (wr == 1) PG8_BAR; }
    }
    PG8_WAIT_V(0);
    if constexpr (!ALIGN_EPI) { if (wr == 0) PG8_BAR; }
    PG8_BAR;
    if constexpr (Epi::AFTER_DRAIN) { E.fused(acc, cur, wr, wc, fr, fq, lds, wid, lane); S.done(cur); }
#undef PG8_SA
#undef PG8_SB
#undef PG8_STAGE
#undef PG8_STAGE_A
#undef PG8_SETVA
#undef PG8_FILLTAB
#undef PG8_LDA
#undef PG8_LDB
#undef PG8_MMA
#undef PG8_WAIT_V
#undef PG8_WAIT_L
#undef PG8_BAR
#undef PG8_SCHED
}
}


typedef float f32x4_t __attribute__((ext_vector_type(4)));
__device__ __forceinline__ f32x4_t ld_bf4(const unsigned short* p) { const pg8::u32x2 v = *(const pg8::u32x2*)p; return (f32x4_t){__uint_as_float(v.x << 16), __uint_as_float(v.x & 0xffff0000u), __uint_as_float(v.y << 16), __uint_as_float(v.y & 0xffff0000u)}; }
__device__ __forceinline__ void ld_bf8(const unsigned short* p, f32x4_t& lo, f32x4_t& hi) { const pg8::u32x4 v = *(const pg8::u32x4*)p;
    lo = (f32x4_t){__uint_as_float(v.x << 16), __uint_as_float(v.x & 0xffff0000u), __uint_as_float(v.y << 16), __uint_as_float(v.y & 0xffff0000u)};
    hi = (f32x4_t){__uint_as_float(v.z << 16), __uint_as_float(v.z & 0xffff0000u), __uint_as_float(v.w << 16), __uint_as_float(v.w & 0xffff0000u)}; }
__device__ __forceinline__ float ld_bf1(const unsigned short* p) { return __uint_as_float((unsigned)(*p) << 16); }
struct SchedInProj {
    int G, c; const char* Abase; const char* Bt;
    __device__ __forceinline__ bool next(int i, pg8::Unit& u) const {
        int pm, pn; if (!pg8::static_order(T / 256, NT_IN, G, c, i, pm, pn)) return false;
        const int ai = pn < 29 ? 0 : pn < 33 ? 1 : pn < 37 ? 3 : pn < 41 ? 4 : pn == 41 ? 2 : pn == 42 ? 5 : 6;
        u.pm = pm; u.pn = pn; u.A = Abase + ((size_t)ai * T + (size_t)pm * 256) * D * 2; u.B = Bt + (size_t)pn * 256 * D * 2; u.list = nullptr; u.cnt = 0; u.e = 0; u.prow = 0; u.gat = 0; return true;
    }
    __device__ __forceinline__ void a_ready(const pg8::Unit&) const {}
    __device__ __forceinline__ void done(const pg8::Unit&) const {}
};
__device__ __forceinline__ float fast_sigmoid(float x) { return __builtin_amdgcn_rcpf(1.0f + __builtin_amdgcn_exp2f(-1.4426950408889634f * x)); }
__device__ __forceinline__ float fast_tanh(float x) { return 1.0f - 2.0f * __builtin_amdgcn_rcpf(1.0f + __builtin_amdgcn_exp2f(2.8853900817779268f * x)); }
struct EpiInProjF32 {
    static constexpr bool PERM = true, AFTER_DRAIN = false, CHAIN = false;
    unsigned short* PH; float* BA; unsigned short* LWA; unsigned short* LGB;
    __device__ __forceinline__ void operator()(const pg8::f32x4 (&acc)[2][2][4][2], const pg8::Unit& u, int wr, int wc, int fr, int fq) const {
        const int pn = u.pn; unsigned short* b16 = PH; unsigned ld = N_IN; int ncol = 256, act = 0;
        if (pn < 12) b16 = PH + pn * 256;
        else if (pn < 28) { b16 = PH + COL_GATE + (pn - 12) * 256; act = 2; }
        else if (pn == 28) { act = 4; ncol = 16; }
        else if (pn < 41) b16 = PH + COL_R + (pn - 29) * 256;
        else if (pn == 41) { act = 1; ncol = 128; b16 = LWA; ld = 256; }
        else if (pn == 42) { act = 3; ncol = 128; b16 = LWA + 128; ld = 256; }
        else { act = 2; b16 = LGB; ld = 256; }
        const unsigned row0 = (unsigned)u.pm * 256u + wr * 64 + fr;
#pragma unroll
        for (int ai = 0; ai < 2; ++ai)
#pragma unroll
            for (int m = 0; m < 4; ++m) {
                const unsigned row = row0 + ai * 128 + m * 16;
#pragma unroll
                for (int bj = 0; bj < 2; ++bj) {
                    const int cl = bj * 128 + wc * 32 + 8 * fq;
                    pg8::f32x4 v0 = acc[ai][bj][m][0], v1 = acc[ai][bj][m][1];
                    if (act == 4) { if (cl < ncol) { float* dst = BA + (size_t)row * 16 + cl; *(pg8::f32x4*)dst = v0; *(pg8::f32x4*)(dst + 4) = v1; } }
                    else {
                        if (act == 1) {
#pragma unroll
                            for (int j = 0; j < 4; ++j) { v0[j] = fast_tanh(v0[j]); v1[j] = fast_tanh(v1[j]); } }
                        if (act == 2) {
#pragma unroll
                            for (int j = 0; j < 4; ++j) { v0[j] = fast_sigmoid(v0[j]); v1[j] = fast_sigmoid(v1[j]); } }
                        if ((act == 1 || act == 3) && cl >= 96) { v0 = (pg8::f32x4){0.f, 0.f, 0.f, 0.f}; v1 = v0; }
                        if (cl < ncol) { pg8::u32x4 w; w.x = pg8::cvt_pk_bf16(v0[0], v0[1]); w.y = pg8::cvt_pk_bf16(v0[2], v0[3]); w.z = pg8::cvt_pk_bf16(v1[0], v1[1]); w.w = pg8::cvt_pk_bf16(v1[2], v1[3]);
                            *(pg8::u32x4*)(b16 + (size_t)row * ld + cl) = w; }
                    }
                }
            }
    }
};
struct SchedLora {
    int G, c; const char* LWA; const char* LGB; const char* L2T;
    __device__ __forceinline__ bool next(int i, pg8::Unit& u) const {
        int pm, pn; if (!pg8::static_order(T / 256, 12, G, c, i, pm, pn)) return false;
        const int g = pn >> 2;
        u.pm = pm; u.pn = pn; u.e = g; u.A = (g < 2 ? LWA : LGB) + (size_t)pm * 256 * 256 * 2; u.B = L2T + ((size_t)g * RW + (size_t)(pn & 3) * 256) * 256 * 2; u.list = nullptr; u.cnt = 0; u.prow = 0; u.gat = 0; return true;
    }
    __device__ __forceinline__ void a_ready(const pg8::Unit&) const {}
    __device__ __forceinline__ void done(const pg8::Unit&) const {}
};
__device__ __forceinline__ float fast_softplus(float x);
__device__ __forceinline__ float rw_decay(float w) { return __builtin_amdgcn_exp2f(-1.4426950408889634f * __builtin_amdgcn_exp2f(1.4426950408889634f * (-fast_softplus(-w) - 0.5f))); }
struct EpiLora {
    static constexpr bool PERM = true, AFTER_DRAIN = false, CHAIN = false;
    float* WPRE; float* APRE; float* GATE; const float* w0; const float* a0;
    __device__ __forceinline__ void operator()(const pg8::f32x4 (&acc)[2][2][4][2], const pg8::Unit& u, int wr, int wc, int fr, int fq) const {
        const int g = u.e; float* C = WPRE + (size_t)g * T * RW;        const float* bias = g == 0 ? w0 : a0;
        const unsigned row0 = (unsigned)u.pm * 256u + wr * 64 + fr; const int col0 = (u.pn & 3) * 256 + wc * 32 + 8 * fq;
        pg8::f32x4 bv[2][2];
#pragma unroll
        for (int bj = 0; bj < 2; ++bj)
#pragma unroll
            for (int n = 0; n < 2; ++n) bv[bj][n] = (g < 2) ? *(const pg8::f32x4*)(bias + col0 + 128 * bj + 4 * n) : (pg8::f32x4){0.f, 0.f, 0.f, 0.f};
#pragma unroll
        for (int ai = 0; ai < 2; ++ai)
#pragma unroll
            for (int m = 0; m < 4; ++m) {
                float* rp = C + (size_t)(row0 + ai * 128 + m * 16) * RW + col0;
#pragma unroll
                for (int bj = 0; bj < 2; ++bj) {
                    pg8::f32x4 v0 = acc[ai][bj][m][0] + bv[bj][0], v1 = acc[ai][bj][m][1] + bv[bj][1];
                    if (g == 0) { v0 = (pg8::f32x4){rw_decay(v0[0]), rw_decay(v0[1]), rw_decay(v0[2]), rw_decay(v0[3])}; v1 = (pg8::f32x4){rw_decay(v1[0]), rw_decay(v1[1]), rw_decay(v1[2]), rw_decay(v1[3])}; }
                    else if (g == 1) { v0 = (pg8::f32x4){fast_sigmoid(v0[0]), fast_sigmoid(v0[1]), fast_sigmoid(v0[2]), fast_sigmoid(v0[3])}; v1 = (pg8::f32x4){fast_sigmoid(v1[0]), fast_sigmoid(v1[1]), fast_sigmoid(v1[2]), fast_sigmoid(v1[3])}; }
                    if (g == 0) { *(pg8::f32x4*)(rp + 128 * bj) = v0; *(pg8::f32x4*)(rp + 128 * bj + 4) = v1; }
                    else {
                        unsigned short* r16 = (unsigned short*)(WPRE + (size_t)g * T * RW) + (size_t)(row0 + ai * 128 + m * 16) * RW + col0 + 128 * bj;
                        pg8::u32x4 w; w.x = pg8::cvt_pk_bf16(v0[0], v0[1]); w.y = pg8::cvt_pk_bf16(v0[2], v0[3]); w.z = pg8::cvt_pk_bf16(v1[0], v1[1]); w.w = pg8::cvt_pk_bf16(v1[2], v1[3]);
                        *(pg8::u32x4*)r16 = w;
                    }
                    __builtin_amdgcn_sched_barrier(0);
                }
            }
    }
};

struct SchedMoE {
    int G, c, nN, nrows; const LAS int* tab; const int* LIST; const char* Abase; const char* W; bool gatherA; int esz;
    __device__ __forceinline__ bool next(int i, pg8::Unit& u) const {
        const int L = i * G + c; const int total = __builtin_amdgcn_readfirstlane(tab[32]) * nN; if (L >= total) return false;
        int e = 0;
        for (int k = 1; k < NE; ++k) if (__builtin_amdgcn_readfirstlane(tab[k]) * nN <= L) e = k;
        const int t0 = __builtin_amdgcn_readfirstlane(tab[e]), t1 = __builtin_amdgcn_readfirstlane(tab[e + 1]);
        const int q = L - t0 * nN, mt = t1 - t0;
        u.pm = q % mt; u.pn = q / mt; u.e = e; u.cnt = __builtin_amdgcn_readfirstlane(tab[128 + e]); u.list = LIST + (size_t)e * T; u.prow = t0 * 256 + u.pm * 256;
        u.gat = gatherA ? 1 : 0; u.A = gatherA ? Abase : Abase + (size_t)u.prow * D * esz;
        u.B = W + ((size_t)e * nrows + (size_t)u.pn * 256) * D * esz; return true;
    }
    __device__ __forceinline__ void a_ready(const pg8::Unit&) const {}
    __device__ __forceinline__ void done(const pg8::Unit&) const {}
};
typedef float f32x2_t __attribute__((ext_vector_type(2)));
__device__ __forceinline__ f32x2_t swiglu2(f32x2_t ga, f32x2_t ua, f32x2_t bg, f32x2_t bu) {
    const f32x2_t g = ga * 0.015625f + bg, u = ua * 0.015625f + bu;
    const f32x2_t gl = {fminf(g[0], 7.0f), fminf(g[1], 7.0f)}, ul = {fminf(fmaxf(u[0], -7.0f), 7.0f), fminf(fmaxf(u[1], -7.0f), 7.0f)};
    const f32x2_t t = gl * (-1.702f * 1.4426950408889634f);
    const f32x2_t d = (f32x2_t){__builtin_amdgcn_exp2f(t[0]), __builtin_amdgcn_exp2f(t[1])} + 1.0f;
    const f32x2_t rc = {__builtin_amdgcn_rcpf(d[0]), __builtin_amdgcn_rcpf(d[1])};
    return (gl * rc) * (ul * 4.0f + 4.0f);
}
struct EpiGU {
    static constexpr bool PERM = true, AFTER_DRAIN = false, CHAIN = false;
    unsigned char* ACT; const float* bgu;
    __device__ __forceinline__ void operator()(const pg8::f32x4 (&acc)[2][2][4][2], const pg8::Unit& u, int wr, int wc, int fr, int fq) const {
        const float* bg = bgu + (size_t)u.e * 2 * FF; const int f0 = 128 * u.pn + 16 * wc + 4 * fq;
        pg8::f32x4 bgv[2], buv[2];
#pragma unroll
        for (int bj = 0; bj < 2; ++bj) { bgv[bj] = *(const pg8::f32x4*)(bg + f0 + 64 * bj); buv[bj] = *(const pg8::f32x4*)(bg + FF + f0 + 64 * bj); }
        const unsigned row0 = (unsigned)u.prow + wr * 64 + fr;
#pragma unroll
        for (int ai = 0; ai < 2; ++ai)
#pragma unroll
            for (int m = 0; m < 4; ++m) {
                const unsigned row = row0 + ai * 128 + m * 16;
#pragma unroll
                for (int bj = 0; bj < 2; ++bj) {
                    const pg8::f32x4 ga = acc[ai][bj][m][0], ua = acc[ai][bj][m][1];
                    const f32x2_t a01 = swiglu2((f32x2_t){ga[0], ga[1]}, (f32x2_t){ua[0], ua[1]}, (f32x2_t){bgv[bj][0], bgv[bj][1]}, (f32x2_t){buv[bj][0], buv[bj][1]});
                    const f32x2_t a23 = swiglu2((f32x2_t){ga[2], ga[3]}, (f32x2_t){ua[2], ua[3]}, (f32x2_t){bgv[bj][2], bgv[bj][3]}, (f32x2_t){buv[bj][2], buv[bj][3]});
                    int w8 = __builtin_amdgcn_cvt_pk_fp8_f32(a01[0], a01[1], 0, false); w8 = __builtin_amdgcn_cvt_pk_fp8_f32(a23[0], a23[1], w8, true);
                    *(int*)(ACT + (size_t)row * FF + f0 + 64 * bj) = w8;
                }
            }
    }
};
struct EpiDown {
    static constexpr bool PERM = true, AFTER_DRAIN = false, CHAIN = false;
    unsigned short* YB; const float* bd;
    __device__ __forceinline__ void operator()(const pg8::f32x4 (&acc)[2][2][4][2], const pg8::Unit& u, int wr, int wc, int fr, int fq) const {
        const float* b = bd + (size_t)u.e * D; const int col0 = u.pn * 256 + wc * 32 + 8 * fq;
        pg8::f32x4 bv[2][2];
#pragma unroll
        for (int bj = 0; bj < 2; ++bj)
#pragma unroll
            for (int n = 0; n < 2; ++n) bv[bj][n] = *(const pg8::f32x4*)(b + col0 + 128 * bj + 4 * n);
        const int ml0 = u.pm * 256 + wr * 64 + fr;
#pragma unroll
        for (int ai = 0; ai < 2; ++ai)
#pragma unroll
            for (int m = 0; m < 4; ++m) {
                const int ml = ml0 + ai * 128 + m * 16;
                if (ml < u.cnt) {
                    const unsigned asg = (unsigned)u.list[ml];
#pragma unroll
                    for (int bj = 0; bj < 2; ++bj) {
                        const pg8::f32x4 v0 = acc[ai][bj][m][0] * 0.00390625f + bv[bj][0], v1 = acc[ai][bj][m][1] * 0.00390625f + bv[bj][1];
                        pg8::u32x4 w; w.x = pg8::cvt_pk_bf16(v0[0], v0[1]); w.y = pg8::cvt_pk_bf16(v0[2], v0[3]); w.z = pg8::cvt_pk_bf16(v1[0], v1[1]); w.w = pg8::cvt_pk_bf16(v1[2], v1[3]);
                        *(pg8::u32x4*)(YB + (size_t)asg * D + col0 + 128 * bj) = w;
                    }
                }
            }
    }
};
__device__ __forceinline__ void moe_tables(LAS int* tab, const unsigned* CNT) {
    if (threadIdx.x == 0) {
        int acc = 0;
        for (int e = 0; e < NE; ++e) { const int c = (int)__hip_atomic_load(&CNT[e], __ATOMIC_RELAXED, __HIP_MEMORY_SCOPE_AGENT); tab[e] = acc; tab[64 + e] = acc * 256; tab[128 + e] = c; acc += (c + 255) >> 8; }
        tab[32] = acc; tab[96] = acc * 256;
    }
    __syncthreads();
}
__device__ __forceinline__ float bf2f(unsigned short h) { return __uint_as_float((unsigned)h << 16); }


__device__ __forceinline__ f32x4_t fmaxf_v(f32x4_t v) { return (f32x4_t){fmaxf(v[0], 1e-30f), fmaxf(v[1], 1e-30f), fmaxf(v[2], 1e-30f), fmaxf(v[3], 1e-30f)}; }
struct SchedUp {
    int G, c; const char* A0; const char* A1; const char* B0; const char* B1;
    __device__ __forceinline__ bool next(int i, pg8::Unit& u) const {
        int pm, pn; if (!pg8::static_order(T / 256, D / 256, G, c, i >> 1, pm, pn)) return false;
        const int sb = i & 1;
        u.pm = pm; u.pn = pn; u.e = sb; u.A = (sb ? A1 : A0) + (size_t)pm * 256 * RW * 2; u.B = (sb ? B1 : B0) + (size_t)pn * 256 * RW * 2; u.list = nullptr; u.cnt = 0; u.prow = 0; u.gat = 0; return true;
    }
    __device__ __forceinline__ void a_ready(const pg8::Unit&) const {}
    __device__ __forceinline__ void done(const pg8::Unit&) const {}
};
struct EpiUp {
    static constexpr bool PERM = true, AFTER_DRAIN = false, CHAIN = true;
    unsigned short* MB; const unsigned short* PH;
    __device__ __forceinline__ void mid(pg8::f32x4 (&acc)[2][2][4][2], const pg8::Unit& u, int wr, int wc, int fr, int fq) const {
        const unsigned row0 = (unsigned)u.pm * 256u + wr * 64 + fr; const int col0 = u.pn * 256 + wc * 32 + 8 * fq;
#pragma unroll
        for (int ai = 0; ai < 2; ++ai)
#pragma unroll
            for (int m = 0; m < 4; ++m) {
                const unsigned row = row0 + ai * 128 + m * 16;
#pragma unroll
                for (int bj = 0; bj < 2; ++bj) {
                    const int col = col0 + 128 * bj;
                    f32x4_t a0, a1, b0, b1; ld_bf8(PH + (size_t)row * N_IN + COL_GATE + col, a0, a1); ld_bf8(PH + (size_t)row * N_IN + COL_GATE + D + col, b0, b1);
#pragma unroll
                    for (int j = 0; j < 4; ++j) { acc[ai][bj][m][0][j] *= a0[j] * __builtin_amdgcn_rcpf(fmaxf(b0[j], 1e-30f)); acc[ai][bj][m][1][j] *= a1[j] * __builtin_amdgcn_rcpf(fmaxf(b1[j], 1e-30f)); }
                }
            }
    }
    __device__ __forceinline__ void operator()(const pg8::f32x4 (&acc)[2][2][4][2], const pg8::Unit& u, int wr, int wc, int fr, int fq) const {
        const unsigned row0 = (unsigned)u.pm * 256u + wr * 64 + fr; const int col0 = u.pn * 256 + wc * 32 + 8 * fq;
#pragma unroll
        for (int ai = 0; ai < 2; ++ai)
#pragma unroll
            for (int m = 0; m < 4; ++m) {
                const unsigned row = row0 + ai * 128 + m * 16;
#pragma unroll
                for (int bj = 0; bj < 2; ++bj) {
                    const int col = col0 + 128 * bj;
                    f32x4_t b0, b1; ld_bf8(PH + (size_t)row * N_IN + COL_GATE + D + col, b0, b1);
                    const pg8::f32x4 v0 = acc[ai][bj][m][0] * fmaxf_v(b0), v1 = acc[ai][bj][m][1] * fmaxf_v(b1);
                    pg8::u32x4 w; w.x = pg8::cvt_pk_bf16(v0[0], v0[1]); w.y = pg8::cvt_pk_bf16(v0[2], v0[3]); w.z = pg8::cvt_pk_bf16(v1[0], v1[1]); w.w = pg8::cvt_pk_bf16(v1[2], v1[3]);
                    *(pg8::u32x4*)(MB + (size_t)row * D + col) = w;
                }
            }
    }
};
struct SchedPlain {
    int G, c, nM, nN, K; const char* A; const char* B;
    __device__ __forceinline__ bool next(int i, pg8::Unit& u) const {
        int pm, pn; if (!pg8::static_order(nM, nN, G, c, i, pm, pn)) return false;
        u.pm = pm; u.pn = pn; u.e = 0; u.A = A + (size_t)pm * 256 * K * 2; u.B = B + (size_t)pn * 256 * K * 2; u.list = nullptr; u.cnt = 0; u.prow = 0; u.gat = 0; return true;
    }
    __device__ __forceinline__ void a_ready(const pg8::Unit&) const {}
    __device__ __forceinline__ void done(const pg8::Unit&) const {}
};
struct EpiF32 {
    static constexpr bool PERM = true, AFTER_DRAIN = false, CHAIN = false;
    unsigned short* C; int ldc;
    __device__ __forceinline__ void operator()(const pg8::f32x4 (&acc)[2][2][4][2], const pg8::Unit& u, int wr, int wc, int fr, int fq) const {
        const unsigned row0 = (unsigned)u.pm * 256u + wr * 64 + fr; const int col0 = u.pn * 256 + wc * 32 + 8 * fq;
#pragma unroll
        for (int ai = 0; ai < 2; ++ai)
#pragma unroll
            for (int m = 0; m < 4; ++m) {
                unsigned short* rp = C + (size_t)(row0 + ai * 128 + m * 16) * ldc + col0;
#pragma unroll
                for (int bj = 0; bj < 2; ++bj) { const pg8::f32x4 v0 = acc[ai][bj][m][0], v1 = acc[ai][bj][m][1];
                    pg8::u32x4 w; w.x = pg8::cvt_pk_bf16(v0[0], v0[1]); w.y = pg8::cvt_pk_bf16(v0[2], v0[3]); w.z = pg8::cvt_pk_bf16(v1[0], v1[1]); w.w = pg8::cvt_pk_bf16(v1[2], v1[3]);
                    *(pg8::u32x4*)(rp + 128 * bj) = w; }
            }
    }
};

#define LDS_WAIT() asm volatile("s_waitcnt lgkmcnt(0)" ::: "memory")
template <class F, class FK>
__device__ __forceinline__ void cvt_item_k(const float* __restrict__ W, int ldw, int K, const F& srccol, const FK& srcrow, unsigned short* WT, int row0, int kb, LAS float* scr, int lane) {
    const int n = lane & 31, k0 = kb * 64; const int sc = srccol(row0 + n);
#pragma unroll 8
    for (int i = 0; i < 32; ++i) { const int kk = 2 * i + (lane >> 5); const int sr = srcrow(k0 + kk); scr[kk * 33 + n] = (sc >= 0 && sr >= 0) ? W[(size_t)sr * ldw + sc] : 0.f; }
    LDS_WAIT();
    const int c = lane & 7;
#pragma unroll
    for (int j = 0; j < 4; ++j) { const int n2 = (lane >> 3) + 8 * j; const LAS float* sp = scr + (8 * c) * 33 + n2;
        pg8::u32x4 o; o.x = pg8::cvt_pk_bf16(sp[0 * 33], sp[1 * 33]); o.y = pg8::cvt_pk_bf16(sp[2 * 33], sp[3 * 33]); o.z = pg8::cvt_pk_bf16(sp[4 * 33], sp[5 * 33]); o.w = pg8::cvt_pk_bf16(sp[6 * 33], sp[7 * 33]);
        *(pg8::u32x4*)(WT + (size_t)(row0 + n2) * K + k0 + 8 * c) = o; }
    LDS_WAIT();
}
template <class F>
__device__ __forceinline__ void cvt_item(const float* __restrict__ W, int ldw, int K, const F& srccol, unsigned short* WT, int row0, int kb, LAS float* scr, int lane) {
    auto idk = [](int k) { return k; };
    cvt_item_k(W, ldw, K, srccol, idk, WT, row0, kb, scr, lane);
}
template <class FM, class FK>
__device__ __forceinline__ void cvt64(const float* __restrict__ W, int ldw, int K, const FM& map4, const FK& srcrow, unsigned short* __restrict__ WT, int row0, int kb, int lane) {
    const int n4 = lane & 15, kg = lane >> 4, k0 = kb * 64 + 16 * kg;
    int sc, dr; map4(row0, n4, sc, dr);
    f32x4_t v[16];
#pragma unroll
    for (int kk = 0; kk < 16; ++kk) { const int sr = srcrow(k0 + kk); v[kk] = (sc >= 0 && sr >= 0) ? *(const f32x4_t*)(W + (size_t)sr * ldw + sc) : (f32x4_t){0.f, 0.f, 0.f, 0.f}; }
#pragma unroll
    for (int j = 0; j < 4; ++j) {
        pg8::u32x4 o0, o1;
        o0.x = pg8::cvt_pk_bf16(v[0][j], v[1][j]); o0.y = pg8::cvt_pk_bf16(v[2][j], v[3][j]); o0.z = pg8::cvt_pk_bf16(v[4][j], v[5][j]); o0.w = pg8::cvt_pk_bf16(v[6][j], v[7][j]);
        o1.x = pg8::cvt_pk_bf16(v[8][j], v[9][j]); o1.y = pg8::cvt_pk_bf16(v[10][j], v[11][j]); o1.z = pg8::cvt_pk_bf16(v[12][j], v[13][j]); o1.w = pg8::cvt_pk_bf16(v[14][j], v[15][j]);
        unsigned short* dst = WT + (size_t)(dr + j) * K + k0;
        *(pg8::u32x4*)dst = o0; *(pg8::u32x4*)(dst + 8) = o1;
    }
}
template <class FM, class FK>
__device__ __forceinline__ void cvt64_f8(const float* __restrict__ W, int ldw, int K, const FM& map4, const FK& srcrow, unsigned char* __restrict__ WT, int row0, int kb, int lane, float scale) {
    const int n4 = lane & 15, kg = lane >> 4, k0 = kb * 64 + 16 * kg;
    int sc, dr; map4(row0, n4, sc, dr);
    f32x4_t v[16];
#pragma unroll
    for (int kk = 0; kk < 16; ++kk) { const int sr = srcrow(k0 + kk); v[kk] = (sc >= 0 && sr >= 0) ? *(const f32x4_t*)(W + (size_t)sr * ldw + sc) * scale : (f32x4_t){0.f, 0.f, 0.f, 0.f}; }
#pragma unroll
    for (int j = 0; j < 4; ++j) {
        pg8::u32x4 o;
#pragma unroll
        for (int q = 0; q < 4; ++q) { int w = __builtin_amdgcn_cvt_pk_fp8_f32(v[4 * q][j], v[4 * q + 1][j], 0, false); w = __builtin_amdgcn_cvt_pk_fp8_f32(v[4 * q + 2][j], v[4 * q + 3][j], w, true); o[q] = (unsigned)w; }
        *(pg8::u32x4*)(WT + (size_t)(dr + j) * K + k0) = o;
    }
}
__device__ __forceinline__ void inproj_src(int r, int& mat, int& col) {
    mat = 0; col = -1;
    if (r < 3072) col = r;
    else if (r < 7168) col = COL_GATE + (r - 3072);
    else if (r < 7424) { if (r - 7168 < 16) col = COL_B + (r - 7168); }
    else if (r < 10496) col = COL_R + (r - 7424);
    else if (r < 10752) { mat = 1; if (r - 10496 < 96) col = r - 10496; }
    else if (r < 11008) { mat = 2; if (r - 10752 < 96) col = r - 10752; }
    else { mat = 3; col = r - 11008; }
}

typedef short bf16x8_t __attribute__((ext_vector_type(8)));
typedef unsigned short LAS* lds_u16p;
__device__ __forceinline__ f32x4_t mma16(bf16x8_t a, bf16x8_t b, f32x4_t c) { return __builtin_amdgcn_mfma_f32_16x16x32_bf16(a, b, c, 0, 0, 0); }
__device__ __forceinline__ bf16x8_t ldfrag(const LAS unsigned short* M, int ld, int r0, int k0, int lane) { return *(const LAS bf16x8_t*)(M + (r0 + (lane & 15)) * ld + k0 + 8 * (lane >> 4)); }
__device__ __forceinline__ bf16x8_t ldfragT(const LAS unsigned short* M, int t, int ks, int lane) { return *(const LAS bf16x8_t*)(M + (16 * t + (lane & 15)) * 72 + (((4 * ks + (lane >> 4)) ^ (t & 7)) << 3)); }
__device__ __forceinline__ unsigned short f2bf(float x) { return (unsigned short)(pg8::cvt_pk_bf16(x, x) & 0xffffu); }
constexpr int GR_QG = 0, GR_W = 16384, GR_KDT = 32768, GR_AI = 49152, GR_U = 57344, GR_MISC = 90112, GR_BYTES = 90368;
constexpr int GL_SM2 = 130560;
constexpr int GL_KB = 0, GL_QB = 17408, GL_VT = 34816, GL_KST = 53248, GL_KDT = 71680, GL_LM = 90112, GL_TI = 107520, GL_AI = 116736, GL_SM = 125952;

__device__ __forceinline__ void tri_inverse_64(const LAS float* Lm, LAS unsigned short* Ti, LAS float* Dg, int lane) {
    const int g = lane >> 4, n = lane & 15;
    {
        float x[16];
        const LAS float* Lb = Lm + (16 * g) * 68 + 16 * g;
#pragma unroll
        for (int i = 0; i < 16; ++i) {
            float s0 = 0.f, s1 = 0.f, s2 = 0.f, s3 = 0.f;
#pragma unroll
            for (int j4 = 0; j4 < (i + 3) / 4; ++j4) {
                const f32x4_t l4 = *(const LAS f32x4_t*)(Lb + i * 68 + 4 * j4);
                if (4 * j4 + 0 < i) s0 = fmaf(l4[0], x[4 * j4 + 0], s0);
                if (4 * j4 + 1 < i) s1 = fmaf(l4[1], x[4 * j4 + 1], s1);
                if (4 * j4 + 2 < i) s2 = fmaf(l4[2], x[4 * j4 + 2], s2);
                if (4 * j4 + 3 < i) s3 = fmaf(l4[3], x[4 * j4 + 3], s3);
            }
            x[i] = ((n == i) ? 1.0f : 0.0f) - ((s0 + s1) + (s2 + s3));
        }
#pragma unroll
        for (int i = 0; i < 16; ++i) { Dg[g * 256 + i * 16 + n] = x[i]; Ti[(16 * g + i) * 72 + 16 * g + n] = f2bf(x[i]); }
#pragma unroll
        for (int bi = 0; bi < 3; ++bi)
#pragma unroll
            for (int bj = bi + 1; bj < 4; ++bj)
#pragma unroll
                for (int r = 0; r < 4; ++r) Ti[(16 * bi + 4 * g + r) * 72 + 16 * bj + n] = 0;
    }
    auto ldA = [&](int bi, int bk) -> f32x4_t { return *(const LAS f32x4_t*)(Lm + (16 * bi + n) * 68 + 16 * bk + 4 * g); };
    auto ldD = [&](int b) -> f32x4_t { return *(const LAS f32x4_t*)(Dg + b * 256 + n * 16 + 4 * g); };
    auto ldDB = [&](int b) -> f32x4_t { f32x4_t v; v[0] = Dg[b * 256 + (4 * g + 0) * 16 + n]; v[1] = Dg[b * 256 + (4 * g + 1) * 16 + n]; v[2] = Dg[b * 256 + (4 * g + 2) * 16 + n]; v[3] = Dg[b * 256 + (4 * g + 3) * 16 + n]; return v; };
    auto mm = [&](f32x4_t av, f32x4_t bv, f32x4_t c) -> f32x4_t {
        c = __builtin_amdgcn_mfma_f32_16x16x4f32(av[0], bv[0], c, 0, 0, 0); c = __builtin_amdgcn_mfma_f32_16x16x4f32(av[1], bv[1], c, 0, 0, 0);
        c = __builtin_amdgcn_mfma_f32_16x16x4f32(av[2], bv[2], c, 0, 0, 0); c = __builtin_amdgcn_mfma_f32_16x16x4f32(av[3], bv[3], c, 0, 0, 0); return c; };
    auto put = [&](int bi, int bj, f32x4_t xv) {
#pragma unroll
        for (int r = 0; r < 4; ++r) Ti[(16 * bi + 4 * g + r) * 72 + 16 * bj + n] = f2bf(xv[r]); };
    const f32x4_t z = {0.f, 0.f, 0.f, 0.f};
    const f32x4_t x00 = ldDB(0), x11 = ldDB(1), x22 = ldDB(2);
    const f32x4_t d1 = ldD(1), d2 = ldD(2), d3 = ldD(3);
    const f32x4_t x10 = -mm(d1, mm(ldA(1, 0), x00, z), z);
    const f32x4_t x21 = -mm(d2, mm(ldA(2, 1), x11, z), z);
    const f32x4_t x32 = -mm(d3, mm(ldA(3, 2), x22, z), z);
    const f32x4_t x20 = -mm(d2, mm(ldA(2, 1), x10, mm(ldA(2, 0), x00, z)), z);
    const f32x4_t x31 = -mm(d3, mm(ldA(3, 2), x21, mm(ldA(3, 1), x11, z)), z);
    const f32x4_t x30 = -mm(d3, mm(ldA(3, 2), x20, mm(ldA(3, 1), x10, mm(ldA(3, 0), x00, z))), z);
    put(1, 0, x10); put(2, 1, x21); put(3, 2, x32); put(2, 0, x20); put(3, 1, x31); put(3, 0, x30);
}

__device__ __forceinline__ void allred16x4(float& a, float& b, float& c, float& d) {
    asm volatile("s_nop 1\n\t"
        "v_add_f32_dpp %0, %0, %0 quad_perm:[1,0,3,2] row_mask:0xf bank_mask:0xf bound_ctrl:1\n\tv_add_f32_dpp %1, %1, %1 quad_perm:[1,0,3,2] row_mask:0xf bank_mask:0xf bound_ctrl:1\n\t"
        "v_add_f32_dpp %2, %2, %2 quad_perm:[1,0,3,2] row_mask:0xf bank_mask:0xf bound_ctrl:1\n\tv_add_f32_dpp %3, %3, %3 quad_perm:[1,0,3,2] row_mask:0xf bank_mask:0xf bound_ctrl:1\n\t"
        "v_add_f32_dpp %0, %0, %0 quad_perm:[2,3,0,1] row_mask:0xf bank_mask:0xf bound_ctrl:1\n\tv_add_f32_dpp %1, %1, %1 quad_perm:[2,3,0,1] row_mask:0xf bank_mask:0xf bound_ctrl:1\n\t"
        "v_add_f32_dpp %2, %2, %2 quad_perm:[2,3,0,1] row_mask:0xf bank_mask:0xf bound_ctrl:1\n\tv_add_f32_dpp %3, %3, %3 quad_perm:[2,3,0,1] row_mask:0xf bank_mask:0xf bound_ctrl:1\n\t"
        "v_add_f32_dpp %0, %0, %0 row_half_mirror row_mask:0xf bank_mask:0xf bound_ctrl:1\n\tv_add_f32_dpp %1, %1, %1 row_half_mirror row_mask:0xf bank_mask:0xf bound_ctrl:1\n\t"
        "v_add_f32_dpp %2, %2, %2 row_half_mirror row_mask:0xf bank_mask:0xf bound_ctrl:1\n\tv_add_f32_dpp %3, %3, %3 row_half_mirror row_mask:0xf bank_mask:0xf bound_ctrl:1\n\t"
        "v_add_f32_dpp %0, %0, %0 row_mirror row_mask:0xf bank_mask:0xf bound_ctrl:1\n\tv_add_f32_dpp %1, %1, %1 row_mirror row_mask:0xf bank_mask:0xf bound_ctrl:1\n\t"
        "v_add_f32_dpp %2, %2, %2 row_mirror row_mask:0xf bank_mask:0xf bound_ctrl:1\n\tv_add_f32_dpp %3, %3, %3 row_mirror row_mask:0xf bank_mask:0xf bound_ctrl:1\n\ts_nop 1"
        : "+v"(a), "+v"(b), "+v"(c), "+v"(d));
}
__device__ __forceinline__ void gdn_a0_fin(int hv, float araw, float braw, const float* __restrict__ A_log, const float* __restrict__ dt_bias, LAS float* gcs, LAS float* betas, int lane);
__device__ __forceinline__ void gdn_a0(int item, const float* __restrict__ BA, const float* __restrict__ A_log, const float* __restrict__ dt_bias, LAS float* gcs, LAS float* betas, int lane) {
    const int hv = (item >> 6) & 7; const size_t tn = (size_t)(item >> 9) * SEQ + (item & 63) * 64 + lane;
    gdn_a0_fin(hv, BA[tn * 16 + 8 + hv], BA[tn * 16 + hv], A_log, dt_bias, gcs, betas, lane);
}
__device__ __forceinline__ void gdn_a0_fin(int hv, float araw, float braw, const float* __restrict__ A_log, const float* __restrict__ dt_bias, LAS float* gcs, LAS float* betas, int lane) {
    float g = -expf(A_log[hv]) * softplusf_(araw + dt_bias[hv]);
#pragma unroll
    for (int o = 1; o < 64; o <<= 1) { const float t = __shfl_up(g, o); if (lane >= o) g += t; }
    gcs[lane] = g; betas[lane] = sigmoidf_(braw);
}
#define A1_CB(mtx, it_) const int hv_ = ((it_) >> 6) & 7, qh_ = hv_ >> 1; const int cb_ = (((mtx) == 0) ? qh_ * 128 : ((mtx) == 1) ? COL_K + qh_ * 128 : COL_V + hv_ * 128) + 4 * cg;
#define A1_LOADW(mtx, it_, wv) do { A1_CB(mtx, it_) \
        _Pragma("unroll") for (int j = 0; j < 4; ++j) wv[j] = *(const f32x4_t*)(convw + j * 2048 + cb_); } while (0)
#define A1_LOADX(mtx, it_, xr) do { A1_CB(mtx, it_) const int s0_ = ((it_) & 63) * 64; const size_t t0_ = (size_t)((it_) >> 9) * SEQ + s0_; \
        _Pragma("unroll") for (int q = 0; q < 7; ++q) { const int rr_ = r0 - 3 + q; const size_t tr_ = (s0_ + rr_ >= 0) ? (size_t)((long long)t0_ + rr_) : t0_; xr[q] = *(const pg8::u32x2*)(PH + tr_ * N_IN + cb_); } } while (0)
__device__ __forceinline__ int gdn_item_of(int k) { const int combo = k >> 3; return ((combo >> 6) << 9) | ((k & 7) << 6) | (combo & 63); }

__device__ __forceinline__ void gdn_prep_item(int item, int item_next, int par, LAS unsigned char* lds, const unsigned short* __restrict__ PH, const float* __restrict__ BA, const float* __restrict__ convw, const float* __restrict__ A_log, const float* __restrict__ dt_bias, unsigned char* __restrict__ recs, pg8::u32x2 (&xn)[3][7], f32x4_t (&wn)[3][4]) {
    int tid_ = threadIdx.x; asm volatile("" : "+v"(tid_));
    const int tid = tid_, lane = tid & 63, wave = __builtin_amdgcn_readfirstlane(tid >> 6);
    const int ch = item & 63, hv = (item >> 6) & 7;
    const int s0 = ch * 64;
    unsigned char* rec = recs + (size_t)item * GR_BYTES;
    LAS unsigned short* Kb = (LAS unsigned short*)(lds + GL_KB); LAS unsigned short* Qb = (LAS unsigned short*)(lds + GL_QB);
    LAS unsigned short* VT = (LAS unsigned short*)(lds + GL_VT); LAS unsigned short* KsT = (LAS unsigned short*)(lds + GL_KST); LAS unsigned short* KdT = (LAS unsigned short*)(lds + GL_KDT);
    LAS float* Lm = (LAS float*)(lds + GL_LM); LAS unsigned short* Ti = (LAS unsigned short*)(lds + GL_TI); LAS unsigned short* Ai = (LAS unsigned short*)(lds + GL_AI);
    LAS float* gcs = (LAS float*)(lds + (par ? GL_SM2 : GL_SM)); LAS float* betas = gcs + 64;
    LAS float* gcs_n = (LAS float*)(lds + (par ? GL_SM : GL_SM2));
    const int cg = tid & 31, rg = tid >> 5, r0 = 4 * rg;
    {
        const f32x4_t zero4 = {0.f, 0.f, 0.f, 0.f};
        float eg[4], ekd[4], br[4];
        { const float glast = gcs[63];
#pragma unroll
          for (int r = 0; r < 4; ++r) { const float gcr = gcs[r0 + r]; br[r] = betas[r0 + r]; eg[r] = __builtin_amdgcn_exp2f(1.4426950408889634f * gcr); ekd[r] = __builtin_amdgcn_exp2f(1.4426950408889634f * (glast - gcr)); } }
        const int swz = (cg >> 2) & 7, tq = rg >> 1, to = 4 * (rg & 1);
#define A1_BODY(mtx, xr, wv) do { f32x4_t xv[7], acc[4]; float rn[4]; \
        _Pragma("unroll") for (int q = 0; q < 7; ++q) { const f32x4_t v_ = (f32x4_t){__uint_as_float(xr[q].x << 16), __uint_as_float(xr[q].x & 0xffff0000u), __uint_as_float(xr[q].y << 16), __uint_as_float(xr[q].y & 0xffff0000u)}; xv[q] = (s0 + r0 - 3 + q >= 0) ? v_ : zero4; } \
        _Pragma("unroll") for (int r = 0; r < 4; ++r) { acc[r] = wv[0] * xv[r] + wv[1] * xv[r + 1] + wv[2] * xv[r + 2] + wv[3] * xv[r + 3]; \
            _Pragma("unroll") for (int i = 0; i < 4; ++i) acc[r][i] = acc[r][i] * fast_sigmoid(acc[r][i]); \
            rn[r] = acc[r][0] * acc[r][0] + acc[r][1] * acc[r][1] + acc[r][2] * acc[r][2] + acc[r][3] * acc[r][3]; } \
        allred16x4(rn[0], rn[1], rn[2], rn[3]); \
        _Pragma("unroll") for (int r = 0; r < 4; ++r) rn[r] = rsqrtf(rn[r] + __shfl_xor(rn[r], 16) + 1e-6f); \
        if ((mtx) == 0) { _Pragma("unroll") for (int r = 0; r < 4; ++r) { const f32x4_t qv = acc[r] * (rn[r] * 0.08838834764831845f); *(LAS pg8::u32x2*)(Qb + (r0 + r) * 136 + 4 * cg) = (pg8::u32x2){pg8::cvt_pk_bf16(qv[0], qv[1]), pg8::cvt_pk_bf16(qv[2], qv[3])}; } } \
        else if ((mtx) == 1) { _Pragma("unroll") for (int r = 0; r < 4; ++r) { acc[r] = acc[r] * rn[r]; *(LAS pg8::u32x2*)(Kb + (r0 + r) * 136 + 4 * cg) = (pg8::u32x2){pg8::cvt_pk_bf16(acc[r][0], acc[r][1]), pg8::cvt_pk_bf16(acc[r][2], acc[r][3])}; } \
            _Pragma("unroll") for (int i = 0; i < 4; ++i) { const int ofs_ = (4 * cg + i) * 72 + ((tq ^ swz) << 3) + to; \
                *(LAS pg8::u32x2*)(KsT + ofs_) = (pg8::u32x2){pg8::cvt_pk_bf16(br[0] * eg[0] * acc[0][i], br[1] * eg[1] * acc[1][i]), pg8::cvt_pk_bf16(br[2] * eg[2] * acc[2][i], br[3] * eg[3] * acc[3][i])}; \
                *(LAS pg8::u32x2*)(KdT + ofs_) = (pg8::u32x2){pg8::cvt_pk_bf16(ekd[0] * acc[0][i], ekd[1] * acc[1][i]), pg8::cvt_pk_bf16(ekd[2] * acc[2][i], ekd[3] * acc[3][i])}; } } \
        else { _Pragma("unroll") for (int i = 0; i < 4; ++i) { const int ofs_ = (4 * cg + i) * 72 + ((tq ^ swz) << 3) + to; \
                *(LAS pg8::u32x2*)(VT + ofs_) = (pg8::u32x2){pg8::cvt_pk_bf16(br[0] * acc[0][i], br[1] * acc[1][i]), pg8::cvt_pk_bf16(br[2] * acc[2][i], br[3] * acc[3][i])}; } } } while (0)
        A1_BODY(0, xn[0], wn[0]);
        A1_BODY(1, xn[1], wn[1]);
        A1_BODY(2, xn[2], wn[2]);
#undef A1_BODY
    }
    __syncthreads();
    float pa_n = 0.f, pb_n = 0.f;
    if (item_next < 2048) {
        if (((item_next >> 6) & 7) != hv) { A1_LOADW(0, item_next, wn[0]); A1_LOADW(1, item_next, wn[1]); A1_LOADW(2, item_next, wn[2]); }
        A1_LOADX(0, item_next, xn[0]);
        if (wave == 7) { const int hvn = (item_next >> 6) & 7; const size_t tn = (size_t)(item_next >> 9) * SEQ + (item_next & 63) * 64 + lane; pa_n = BA[tn * 16 + 8 + hvn]; pb_n = BA[tn * 16 + hvn]; }
    }
    __builtin_amdgcn_sched_barrier(0);
    {
        const int mat = wave >> 2, ti = wave & 3, g4 = lane >> 4, n = lane & 15;
        const LAS unsigned short* Am = mat ? Qb : Kb;
        float gi[4], bi[4], gj[4];
#pragma unroll
        for (int r = 0; r < 4; ++r) { gi[r] = gcs[16 * ti + 4 * g4 + r]; bi[r] = betas[16 * ti + 4 * g4 + r]; gj[r] = gcs[16 * r + n]; }
#pragma unroll
        for (int tj = 0; tj < 4; ++tj) {
            f32x4_t acc = {0.f, 0.f, 0.f, 0.f};
#pragma unroll
            for (int ks = 0; ks < 4; ++ks) acc = mma16(ldfrag(Am, 136, 16 * ti, 32 * ks, lane), ldfrag(Kb, 136, 16 * tj, 32 * ks, lane), acc);
            const int j = 16 * tj + n;
#pragma unroll
            for (int r = 0; r < 4; ++r) {
                const int i = 16 * ti + 4 * g4 + r; const float dec = __builtin_amdgcn_exp2f(1.4426950408889634f * fminf(gi[r] - gj[tj], 0.f));
                const float vl = bi[r] * acc[r] * dec, va = acc[r] * dec;
                if (mat == 0) Lm[i * 68 + j] = (j < i) ? vl : 0.f;
                else Ai[i * 72 + j] = f2bf((j <= i) ? va : 0.f);
            }
        }
    }
    __syncthreads();
    if (wave == 0) { tri_inverse_64(Lm, Ti, (LAS float*)(lds + 126464), lane); if (item_next < 2048) A1_LOADX(1, item_next, xn[1]); }
    else {
        if (wave == 7 && item_next < 2048) gdn_a0_fin((item_next >> 6) & 7, pa_n, pb_n, A_log, dt_bias, gcs_n, gcs_n + 64, lane);
        if (item_next < 2048) A1_LOADX(1, item_next, xn[1]);
        for (int e = tid - 64; e < 64 * 128; e += NTHREADS - 64) { const int row = e >> 7, c = e & 127; const float qv = bf2f(Qb[row * 136 + c]); Qb[row * 136 + c] = f2bf(qv * __builtin_amdgcn_exp2f(1.4426950408889634f * gcs[row])); }
    }
    __syncthreads();
    if (item_next < 2048) A1_LOADX(2, item_next, xn[2]);
    __builtin_amdgcn_sched_barrier(0);
    {
        const int g4 = lane >> 4, n = lane & 15;
#pragma unroll
        for (int t2 = 0; t2 < 2; ++t2) {
            const int tn = 2 * wave + t2; const LAS unsigned short* Bt = (tn < 8) ? VT : KsT; const int tb = tn & 7;
#pragma unroll
            for (int ti = 0; ti < 4; ++ti) {
                f32x4_t acc = {0.f, 0.f, 0.f, 0.f};
#pragma unroll
                for (int ks = 0; ks < 2; ++ks) acc = mma16(ldfrag(Ti, 72, 16 * ti, 32 * ks, lane), ldfragT(Bt, tb, ks, lane), acc);
                if (tn < 8) *(f32x4_t*)(rec + GR_U + ((size_t)((ti * 8 + tb) * 64 + lane)) * 16) = acc;
                else {
#pragma unroll
                    for (int r = 0; r < 4; ++r) Kb[(16 * ti + 4 * g4 + r) * 136 + 16 * tb + n] = f2bf(acc[r]);
                }
            }
        }
    }
    __syncthreads();
    {
#pragma unroll
        for (int t2 = 0; t2 < 2; ++t2) {
            const int f = 2 * wave + t2;
            { const int ti = f >> 2, ks = f & 3;
              *(bf16x8_t*)(rec + GR_QG + (size_t)(f * 64 + lane) * 16) = ldfrag(Qb, 136, 16 * ti, 32 * ks, lane);
              *(bf16x8_t*)(rec + GR_W + (size_t)(f * 64 + lane) * 16) = ldfrag(Kb, 136, 16 * ti, 32 * ks, lane); }
            { const int td = f >> 1, ks = f & 1;
              *(bf16x8_t*)(rec + GR_KDT + (size_t)(f * 64 + lane) * 16) = ldfragT(KdT, td, ks, lane); }
        }
        { const int f = wave, ti = f >> 1, ks = f & 1;
          *(bf16x8_t*)(rec + GR_AI + (size_t)(f * 64 + lane) * 16) = ldfrag(Ai, 72, 16 * ti, 32 * ks, lane); }
        if (tid == 0) *(float*)(rec + GR_MISC) = expf(gcs[63]);
    }
    __syncthreads();
}

__device__ __forceinline__ void gdn_scan_seq(int seq, LAS unsigned char* lds, const unsigned char* __restrict__ recs, const unsigned short* __restrict__ PH, const float* __restrict__ gdn_norm, unsigned short* __restrict__ YGB) {
    const int tid = threadIdx.x, lane = tid & 63, wave = __builtin_amdgcn_readfirstlane(tid >> 6), g4 = lane >> 4, n = lane & 15;
    const int b = seq >> 3, hv = seq & 7;
    LAS unsigned short* St = (LAS unsigned short*)lds;
    LAS unsigned short* VnT = (LAS unsigned short*)(lds + 34816);
    LAS unsigned short* Zb = (LAS unsigned short*)(lds + 53248);
    const int zrow = tid >> 3, zseg = tid & 7;
    const unsigned short* zsrc = PH + ((size_t)b * SEQ + zrow) * N_IN + COL_Z + hv * 128 + zseg * 16;
    pg8::u32x4 zr0 = *(const pg8::u32x4*)zsrc, zr1 = *(const pg8::u32x4*)(zsrc + 8);
    float gnv[8];
#pragma unroll
    for (int tv = 0; tv < 8; ++tv) gnv[tv] = gdn_norm[16 * tv + n];
    *(LAS pg8::u32x4*)(Zb + zrow * 136 + zseg * 16) = zr0; *(LAS pg8::u32x4*)(Zb + zrow * 136 + zseg * 16 + 8) = zr1;
    for (int e = tid; e < 128 * 136; e += NTHREADS) St[e] = 0;
    f32x4_t S[8];
#pragma unroll
    for (int tv = 0; tv < 8; ++tv) S[tv] = (f32x4_t){0.f, 0.f, 0.f, 0.f};
    __syncthreads();
    const int ti = wave & 3;
    bf16x8_t nafr[4], nkfr[2], naifr[2]; f32x4_t nu[8]; float neg;
#define GS_LOAD(chv) do { const unsigned char* _r = recs + ((size_t)seq * 64 + (chv)) * GR_BYTES; \
        _Pragma("unroll") for (int ks = 0; ks < 4; ++ks) nafr[ks] = *(const bf16x8_t*)(_r + (wave < 4 ? GR_QG : GR_W) + (size_t)((ti * 4 + ks) * 64 + lane) * 16); \
        _Pragma("unroll") for (int ks = 0; ks < 2; ++ks) { nkfr[ks] = *(const bf16x8_t*)(_r + GR_KDT + (size_t)((wave * 2 + ks) * 64 + lane) * 16); naifr[ks] = *(const bf16x8_t*)(_r + GR_AI + (size_t)((ti * 2 + ks) * 64 + lane) * 16); } \
        if (wave >= 4) { _Pragma("unroll") for (int tv = 0; tv < 8; ++tv) nu[tv] = *(const f32x4_t*)(_r + GR_U + (size_t)((ti * 8 + tv) * 64 + lane) * 16); } \
        neg = *(const float*)(_r + GR_MISC); } while (0)
    GS_LOAD(0);
    for (int ch = 0; ch < 64; ++ch) {
        bf16x8_t afr[4], kfr[2], aifr[2]; f32x4_t ucur[8];
#pragma unroll
        for (int ks = 0; ks < 4; ++ks) afr[ks] = nafr[ks];
#pragma unroll
        for (int ks = 0; ks < 2; ++ks) { kfr[ks] = nkfr[ks]; aifr[ks] = naifr[ks]; }
#pragma unroll
        for (int tv = 0; tv < 8; ++tv) ucur[tv] = nu[tv];
        const float eg = neg;
        if (ch + 1 < 64) { GS_LOAD(ch + 1); const unsigned short* zp = zsrc + (size_t)(ch + 1) * 64 * N_IN; zr0 = *(const pg8::u32x4*)zp; zr1 = *(const pg8::u32x4*)(zp + 8); }
        f32x4_t acc1[8];
#pragma unroll
        for (int tv = 0; tv < 8; ++tv) {
            f32x4_t a = {0.f, 0.f, 0.f, 0.f};
#pragma unroll
            for (int ks = 0; ks < 4; ++ks) a = mma16(afr[ks], ldfrag(St, 136, 16 * tv, 32 * ks, lane), a);
            acc1[tv] = a;
        }
        if (wave >= 4) {
#pragma unroll
            for (int tv = 0; tv < 8; ++tv) {
                const f32x4_t vn = ucur[tv] - acc1[tv];
                pg8::u32x2 w2; w2.x = pg8::cvt_pk_bf16(vn[0], vn[1]); w2.y = pg8::cvt_pk_bf16(vn[2], vn[3]);
                *(LAS pg8::u32x2*)(VnT + (16 * tv + n) * 72 + 16 * ti + 4 * g4) = w2;
            }
        }
        __syncthreads();
        if (wave < 4) {
            float ss[4] = {0.f, 0.f, 0.f, 0.f};
#pragma unroll
            for (int tv = 0; tv < 8; ++tv) {
                f32x4_t o = acc1[tv];
#pragma unroll
                for (int ks = 0; ks < 2; ++ks) o = mma16(aifr[ks], ldfrag(VnT, 72, 16 * tv, 32 * ks, lane), o);
                acc1[tv] = o;
#pragma unroll
                for (int r = 0; r < 4; ++r) ss[r] = fmaf(o[r], o[r], ss[r]);
            }
            allred16x4(ss[0], ss[1], ss[2], ss[3]);
            const LAS unsigned short* zc = Zb + (ch & 1) * 64 * 136;
#pragma unroll
            for (int r = 0; r < 4; ++r) {
                const float inv = rsqrtf(ss[r] * (1.0f / 128.0f) + EPS); const int tr = 16 * ti + 4 * g4 + r;
                unsigned short* yrow = YGB + ((size_t)b * SEQ + ch * 64 + tr) * RW + hv * 128 + n;
#pragma unroll
                for (int tv = 0; tv < 8; ++tv) { const float z = bf2f(zc[tr * 136 + 16 * tv + n]); yrow[16 * tv] = f2bf(acc1[tv][r] * inv * gnv[tv] * z * fast_sigmoid(z)); }
            }
        }
#pragma unroll
        for (int tv = 0; tv < 8; ++tv) {
            f32x4_t s = S[tv] * eg;
#pragma unroll
            for (int ks = 0; ks < 2; ++ks) s = mma16(kfr[ks], ldfrag(VnT, 72, 16 * tv, 32 * ks, lane), s);
            S[tv] = s;
            pg8::u32x2 w2; w2.x = pg8::cvt_pk_bf16(s[0], s[1]); w2.y = pg8::cvt_pk_bf16(s[2], s[3]);
            *(LAS pg8::u32x2*)(St + (16 * tv + n) * 136 + 16 * wave + 4 * g4) = w2;
        }
        if (ch + 1 < 64) { LAS unsigned short* zn = Zb + ((ch + 1) & 1) * 64 * 136 + zrow * 136 + zseg * 16; *(LAS pg8::u32x4*)zn = zr0; *(LAS pg8::u32x4*)(zn + 8) = zr1; }
        __syncthreads();
    }
#undef GS_LOAD
}

constexpr int RT = 32;
constexpr int RBUF_FLOATS = 5 * RT * 64 + RT * 32 + RT * 2;
__device__ __forceinline__ float dpp_f(float x, const int ctrl_sel) {
    const int xi = __float_as_int(x); int r;
    if (ctrl_sel == 0) r = __builtin_amdgcn_update_dpp(0, xi, 0xB1, 0xF, 0xF, true);
    else if (ctrl_sel == 1) r = __builtin_amdgcn_update_dpp(0, xi, 0x4E, 0xF, 0xF, true);
    else if (ctrl_sel == 2) r = __builtin_amdgcn_update_dpp(0, xi, 0x141, 0xF, 0xF, true);
    else r = __builtin_amdgcn_update_dpp(0, xi, 0x140, 0xF, 0xF, true);
    return __int_as_float(r);
}
__device__ __forceinline__ float sum8(float x) { x += dpp_f(x, 0); x += dpp_f(x, 1); x += dpp_f(x, 2); return x; }
__device__ __forceinline__ float fast_softplus(float x) { return fmaxf(x, 0.0f) + 0.6931471805599453f * __builtin_amdgcn_logf(1.0f + __builtin_amdgcn_exp2f(-1.4426950408889634f * fabsf(x))); }
__device__ __forceinline__ void rwkv_scan_block(int sq, int half, LAS float* lds, const float* __restrict__ WPRE, const float* __restrict__ APRE, const unsigned short* __restrict__ PH,
                                                const float* __restrict__ k_k, const float* __restrict__ k_a, const float* __restrict__ r_k, float* __restrict__ BON, float* __restrict__ YR) {
    const int tid = threadIdx.x, lane = tid & 63, wave = __builtin_amdgcn_readfirstlane(tid >> 6);
    const int b = sq >> 4, h = sq & 15, rbase = half * 32;
    const size_t t0 = (size_t)b * SEQ;
    const int lt = tid - 256;
    f32x4_t s0w[2], s0a[2], s0k[2], s0r[2], s0v, s1w[2], s1a[2], s1k[2], s1r[2], s1v;
    f32x4_t kkc = {0.f, 0.f, 0.f, 0.f}, kac = kkc, rkc = kkc;
    if (lt >= 0) { const int colc = h * 64 + (lt & 15) * 4; kkc = *(const f32x4_t*)(k_k + colc); kac = *(const f32x4_t*)(k_a + colc); rkc = *(const f32x4_t*)(r_k + colc); }
    f32x2_t S2[4];
#pragma unroll
    for (int k = 0; k < 4; ++k) S2[k] = (f32x2_t){0.f, 0.f};
#define RW_LOAD(c, P) do { _Pragma("unroll") for (int i = 0; i < 2; ++i) { const int f = lt + 256 * i, st = f >> 4, c4 = f & 15; const size_t t = t0 + (size_t)(c) * RT + st; const int col = h * 64 + c4 * 4; \
        P##w[i] = *(const f32x4_t*)(WPRE + t * RW + col); P##a[i] = ld_bf4((const unsigned short*)APRE + t * RW + col); P##k[i] = ld_bf4(PH + t * N_IN + COL_RK + col); P##r[i] = ld_bf4(PH + t * N_IN + COL_R + col); } \
        { const int st = lt >> 3, c4 = lt & 7; P##v = ld_bf4(PH + (t0 + (size_t)(c) * RT + st) * N_IN + COL_RV + h * 64 + rbase + c4 * 4); } } while (0)
#define RW_STORE(bufp, P, c) do { LAS float* _b = (bufp); _Pragma("unroll") for (int i = 0; i < 2; ++i) { const int f = lt + 256 * i, st = f >> 4, c4 = f & 15; \
        f32x4_t wd, av, kkv; float ss = 0.f; \
        _Pragma("unroll") for (int j = 0; j < 4; ++j) { wd[j] = P##w[i][j]; av[j] = P##a[i][j]; kkv[j] = P##k[i][j] * kkc[j]; ss = fmaf(kkv[j], kkv[j], ss); } \
        ss += __shfl_xor(ss, 1); ss += __shfl_xor(ss, 2); ss += __shfl_xor(ss, 4); ss += __shfl_xor(ss, 8); \
        const float rn = rsqrtf(ss + 1e-6f); f32x4_t aav, bbv, kmv; float br = 0.f, kr = 0.f, bo = 0.f; \
        _Pragma("unroll") for (int j = 0; j < 4; ++j) { const float kk = kkv[j] * rn; aav[j] = -kk; bbv[j] = kk * av[j]; kmv[j] = P##k[i][j] * (1.0f + (av[j] - 1.0f) * kac[j]); \
            br = fmaf(bbv[j], P##r[i][j], br); kr = fmaf(kmv[j], P##r[i][j], kr); bo = fmaf(P##r[i][j] * kmv[j], rkc[j], bo); } \
        *(LAS f32x4_t*)(_b + 0 * RT * 64 + st * 64 + c4 * 4) = wd; *(LAS f32x4_t*)(_b + 1 * RT * 64 + st * 64 + c4 * 4) = bbv; *(LAS f32x4_t*)(_b + 2 * RT * 64 + st * 64 + c4 * 4) = kmv; \
        const f32x4_t _x = wd * P##r[i]; \
        *(LAS f32x4_t*)(_b + 3 * RT * 64 + st * 128 + c4 * 8) = (f32x4_t){aav[0], _x[0], aav[1], _x[1]}; *(LAS f32x4_t*)(_b + 3 * RT * 64 + st * 128 + c4 * 8 + 4) = (f32x4_t){aav[2], _x[2], aav[3], _x[3]}; \
        br += __shfl_xor(br, 1); br += __shfl_xor(br, 2); br += __shfl_xor(br, 4); br += __shfl_xor(br, 8); kr += __shfl_xor(kr, 1); kr += __shfl_xor(kr, 2); kr += __shfl_xor(kr, 4); kr += __shfl_xor(kr, 8); \
        bo += __shfl_xor(bo, 1); bo += __shfl_xor(bo, 2); bo += __shfl_xor(bo, 4); bo += __shfl_xor(bo, 8); \
        if (c4 == 0) { _b[5 * RT * 64 + RT * 32 + st * 2] = 0.25f * br; _b[5 * RT * 64 + RT * 32 + st * 2 + 1] = 0.25f * kr; if (half == 0) BON[(t0 + (size_t)(c) * RT + st) * 16 + h] = bo; } } \
        { const int st = lt >> 3, c4 = lt & 7; *(LAS f32x4_t*)(_b + 5 * RT * 64 + st * 32 + c4 * 4) = P##v; } } while (0)
    constexpr int NCH = SEQ / RT;
    const int rloc = wave * 8 + (lane >> 4) * 2, kq = (lane & 15) * 4;
    LAS float* ybuf = lds + 2 * RBUF_FLOATS;
    f32x2_t T2[4];
#pragma unroll
    for (int k = 0; k < 4; ++k) T2[k] = (f32x2_t){0.f, 0.f};
    f32x4_t Aw, Ab, Ak, Ax0, Ax1, Bw, Bb, Bk, Bx0, Bx1; f32x2_t Av, Bv, Ar, Br;
#define RW_LD(X, u) do { \
        X##w = *(const LAS f32x4_t*)(pW + (u) * 64); X##b = *(const LAS f32x4_t*)(pW + RT * 64 + (u) * 64); X##k = *(const LAS f32x4_t*)(pW + 2 * RT * 64 + (u) * 64); \
        X##x0 = *(const LAS f32x4_t*)(pX + (u) * 128); X##x1 = *(const LAS f32x4_t*)(pX + (u) * 128 + 4); \
        X##v = *(const LAS f32x2_t*)(pV + (u) * 32); X##r = *(const LAS f32x2_t*)(pR + (u) * 2); } while (0)
#define RW_SUM16(x) do { x += dpp_f(x, 0); x += dpp_f(x, 1); x += dpp_f(x, 2); x += dpp_f(x, 3); } while (0)
#define RW_STEP(X, yb, st) do { \
        f32x2_t e0 = S2[0][0] * (f32x2_t){X##x0[0], X##x0[1]}, e1 = T2[0][0] * (f32x2_t){X##x0[0], X##x0[1]}; \
        e0 += S2[0][1] * (f32x2_t){X##x0[2], X##x0[3]}; e1 += T2[0][1] * (f32x2_t){X##x0[2], X##x0[3]}; \
        e0 += S2[1][0] * (f32x2_t){X##x1[0], X##x1[1]}; e1 += T2[1][0] * (f32x2_t){X##x1[0], X##x1[1]}; \
        e0 += S2[1][1] * (f32x2_t){X##x1[2], X##x1[3]}; e1 += T2[1][1] * (f32x2_t){X##x1[2], X##x1[3]}; \
        float sa0 = e0[0], pp0 = e0[1], sa1 = e1[0], pp1 = e1[1]; \
          \
        asm volatile("s_nop 1\n\t" \
            "v_add_f32_dpp %0, %0, %0 quad_perm:[1,0,3,2] row_mask:0xf bank_mask:0xf bound_ctrl:1\n\tv_add_f32_dpp %1, %1, %1 quad_perm:[1,0,3,2] row_mask:0xf bank_mask:0xf bound_ctrl:1\n\t" \
            "v_add_f32_dpp %2, %2, %2 quad_perm:[1,0,3,2] row_mask:0xf bank_mask:0xf bound_ctrl:1\n\tv_add_f32_dpp %3, %3, %3 quad_perm:[1,0,3,2] row_mask:0xf bank_mask:0xf bound_ctrl:1\n\t" \
            "v_add_f32_dpp %0, %0, %0 quad_perm:[2,3,0,1] row_mask:0xf bank_mask:0xf bound_ctrl:1\n\tv_add_f32_dpp %1, %1, %1 quad_perm:[2,3,0,1] row_mask:0xf bank_mask:0xf bound_ctrl:1\n\t" \
            "v_add_f32_dpp %2, %2, %2 quad_perm:[2,3,0,1] row_mask:0xf bank_mask:0xf bound_ctrl:1\n\tv_add_f32_dpp %3, %3, %3 quad_perm:[2,3,0,1] row_mask:0xf bank_mask:0xf bound_ctrl:1\n\t" \
            "v_add_f32_dpp %0, %0, %0 row_half_mirror row_mask:0xf bank_mask:0xf bound_ctrl:1\n\tv_add_f32_dpp %1, %1, %1 row_half_mirror row_mask:0xf bank_mask:0xf bound_ctrl:1\n\ts_nop 0\n\t" \
            "v_add_f32_dpp %0, %0, %0 row_mirror row_mask:0xf bank_mask:0xf bound_ctrl:1\n\tv_add_f32_dpp %1, %1, %1 row_mirror row_mask:0xf bank_mask:0xf bound_ctrl:1" \
            : "+v"(sa0), "+v"(sa1), "+v"(pp0), "+v"(pp1)); \
        const f32x2_t w01 = (f32x2_t){X##w[0], X##w[1]}, w23 = (f32x2_t){X##w[2], X##w[3]}, b01 = (f32x2_t){X##b[0], X##b[1]}, b23 = (f32x2_t){X##b[2], X##b[3]}, k01 = (f32x2_t){X##k[0], X##k[1]}, k23 = (f32x2_t){X##k[2], X##k[3]}; \
        S2[0] = S2[0] * w01 + (sa0 * b01 + X##v[0] * k01); S2[1] = S2[1] * w23 + (sa0 * b23 + X##v[0] * k23); \
        T2[0] = T2[0] * w01 + (sa1 * b01 + X##v[1] * k01); T2[1] = T2[1] * w23 + (sa1 * b23 + X##v[1] * k23); \
        *(LAS f32x2_t*)((yb) + (st) * 128) = (f32x2_t){pp0 + sa0 * X##r[0] + X##v[0] * X##r[1], pp1 + sa1 * X##r[0] + X##v[1] * X##r[1]}; } while (0)
#define RW_COMPUTE(c) do { const LAS float* buf = lds + ((c) & 1) * RBUF_FLOATS; \
        const LAS float* pW = buf + kq; const LAS float* pX = buf + 3 * RT * 64 + kq * 2; const LAS float* pV = buf + 5 * RT * 64 + rloc; const LAS float* pR = buf + 5 * RT * 64 + RT * 32; LAS float* pY = ybuf + ((c) & 1) * RT * 128 + ((rloc >> 1) * 4 + ((lane & 15) >> 2)) * 2; \
        RW_LD(A, 0); \
        _Pragma("unroll") for (int g = 0; g < RT / 4; ++g) { \
            RW_LD(B, 4 * g + 1); RW_STEP(A, pY, 4 * g); RW_LD(A, 4 * g + 2); RW_STEP(B, pY, 4 * g + 1); RW_LD(B, 4 * g + 3); RW_STEP(A, pY, 4 * g + 2); if (g + 1 < RT / 4) RW_LD(A, 4 * g + 4); RW_STEP(B, pY, 4 * g + 3); } } while (0)
#define RW_FLUSH(c) do { const int st = lt >> 3, c4 = lt & 7; const LAS float* yq_ = ybuf + ((c) & 1) * RT * 128 + st * 128 + c4 * 16; const f32x4_t q0_ = *(const LAS f32x4_t*)(yq_), q1_ = *(const LAS f32x4_t*)(yq_ + 4), q2_ = *(const LAS f32x4_t*)(yq_ + 8), q3_ = *(const LAS f32x4_t*)(yq_ + 12); const f32x4_t yv_ = {(q0_[0] + q0_[2]) + (q1_[0] + q1_[2]), (q0_[1] + q0_[3]) + (q1_[1] + q1_[3]), (q2_[0] + q2_[2]) + (q3_[0] + q3_[2]), (q2_[1] + q2_[3]) + (q3_[1] + q3_[3])}; *(pg8::u32x2*)((unsigned short*)YR + (t0 + (size_t)(c) * RT + st) * RW + h * 64 + rbase + c4 * 4) = (pg8::u32x2){pg8::cvt_pk_bf16(yv_[0], yv_[1]), pg8::cvt_pk_bf16(yv_[2], yv_[3])}; } while (0)
    if (wave >= 4) {
        RW_LOAD(0, s0); RW_STORE(lds, s0, 0); RW_LOAD(1, s0); RW_LOAD(2, s1);
        __syncthreads();
        for (int c = 0; c < NCH; c += 2) {
            RW_STORE(lds + RBUF_FLOATS, s0, c + 1); if (c + 3 < NCH) RW_LOAD(c + 3, s0); if (c > 0) RW_FLUSH(c - 1);
            __syncthreads();
            if (c + 2 < NCH) { RW_STORE(lds, s1, c + 2); } if (c + 4 < NCH) RW_LOAD(c + 4, s1); RW_FLUSH(c);
            __syncthreads();
        }
        RW_FLUSH(NCH - 1);
    } else {
        __builtin_amdgcn_s_setprio(3);
        __syncthreads();
        for (int c = 0; c < NCH; c += 2) {
            RW_COMPUTE(c);
            __syncthreads();
            RW_COMPUTE(c + 1);
            __syncthreads();
        }
        __builtin_amdgcn_s_setprio(0);
    }
#undef RW_COMPUTE
#undef RW_FLUSH
#undef RW_LD
#undef RW_STEP
#undef RW_SUM16
#undef RW_LOAD
#undef RW_STORE
}

__global__ void __launch_bounds__(NTHREADS, 2) fwd(Args a) {
    extern __shared__ __attribute__((aligned(16))) unsigned char lds_raw[];
    float* sm = (float*)lds_raw;
#define PHASE_IDS int tid = threadIdx.x; asm volatile("" : "+v"(tid)); const int lane = tid & 63, wave = tid >> 6; (void)lane; (void)wave;
    unsigned char* ws = a.ws;
    unsigned* ctl = (unsigned*)(ws + WS_CTL);
    volatile LAS unsigned* xbw = (volatile LAS unsigned*)(LAS unsigned char*)(lds_raw + LDS_BYTES - 16);
    if (threadIdx.x == 0) { xbw[0] = 0u; xbw[1] = 0u; xbw[2] = 0u; xbw[3] = 0u; }
    __syncthreads();
    const int lo = a.ph_lo, hi = a.ph_hi;
    XcdBarrier bar; bar.bar = ctl; bar.x = 0; bar.st = xbw;
    if (hi - lo > 1) bar = xcd_barrier_post(ctl, xbw);
#define IN(k) (lo <= (k) && (k) < hi)
#define SEAM(k) do { if (IN(k) && IN((k) + 1)) xcd_barrier(bar); } while (0)


    if (IN(0)) {
        PHASE_IDS
        const float* c = a.in[1];
        const float* ada_w = a.in[2];
        const float* ada_b = a.in[3];
        const float* w_in = a.in[8];
        const float* rwkv_w1 = a.in[15];
        const float* rwkv_a1 = a.in[18];
        const float* rwkv_g1 = a.in[20];
        const float* w_up_gdn = a.in[27];
        const float* w_up_rwkv = a.in[28];
        const float* w_out = a.in[29];
        const float* exp_w_gu = a.in[32];
        const float* exp_w_down = a.in[34];
        float* MOD = (float*)(ws + WS_MOD);
        unsigned short* WINT = (unsigned short*)(ws + WS_WINT);
        unsigned short* WUPG = (unsigned short*)(ws + WS_WUPG);
        unsigned short* WUPR = (unsigned short*)(ws + WS_WUPR);
        unsigned short* WOUT = (unsigned short*)(ws + WS_WOUT);
        unsigned short* WGU = (unsigned short*)(ws + WS_WGU);
        unsigned short* WDN = (unsigned short*)(ws + WS_WDN);
        float* sc = sm;
        float* part = sm + NB * D;
        for (int i = tid; i < NB * D; i += NTHREADS) sc[i] = siluf_(c[i]);
        __syncthreads();
        for (int cb = blockIdx.x; cb < 6 * D / 48; cb += gridDim.x) {
            const int c4 = tid % 12, kg = tid / 12, col = cb * 48 + c4 * 4;
            if (tid < 504) {
                f32x4_t a0 = {0.f, 0.f, 0.f, 0.f}, a1 = a0, a2 = a0, a3 = a0;
#pragma unroll 8
                for (int k = kg; k < D; k += 42) {
                    const f32x4_t w = *(const f32x4_t*)(ada_w + (size_t)k * (6 * D) + col);
                    a0 += sc[k] * w; a1 += sc[D + k] * w; a2 += sc[2 * D + k] * w; a3 += sc[3 * D + k] * w;
                }
                *(f32x4_t*)(part + (kg * 4 + 0) * 48 + c4 * 4) = a0; *(f32x4_t*)(part + (kg * 4 + 1) * 48 + c4 * 4) = a1;
                *(f32x4_t*)(part + (kg * 4 + 2) * 48 + c4 * 4) = a2; *(f32x4_t*)(part + (kg * 4 + 3) * 48 + c4 * 4) = a3;
            }
            __syncthreads();
            if (tid < 192) {
                const int bb = tid / 48, c2 = tid % 48; float t = ada_b[cb * 48 + c2];
                for (int g = 0; g < 42; ++g) t += part[(g * 4 + bb) * 48 + c2];
                MOD[(size_t)bb * 6 * D + cb * 48 + c2] = t;
            }
            __syncthreads();
        }
        {
            const int gw = blockIdx.x * (NTHREADS / 64) + wave, ngw = gridDim.x * (NTHREADS / 64);
            auto idk = [](int k) { return k; };
            constexpr int N_IP = (NT_IN * 256 / 64) * (D / 64);
            constexpr int N_GU = NE * (2 * FF / 64) * (D / 64), N_DN = NE * (D / 64) * (FF / 64);
            constexpr int N_L2 = 3 * (RW / 64) * (256 / 64), N_UP = (D / 64) * (RW / 64), N_OUT = (D / 64) * (D / 64);
            constexpr int N_ALL = N_IP + N_GU + N_DN + N_L2 + 2 * N_UP + N_OUT;
            constexpr int N_P5 = (N_GU + N_DN) * 100 / 100;
            for (int it0 = gw + N_P5; it0 < N_ALL; it0 += ngw) {
                int it = it0;
                if (it < N_GU) {
                    const int e = it / ((2 * FF / 64) * (D / 64)), r = it % ((2 * FF / 64) * (D / 64)), rb = r / (D / 64), kb = r % (D / 64);
                    auto m4 = [](int row0, int n4, int& scol, int& drow) { const int pn = row0 >> 8, cb8 = (row0 & 255) >> 3, ft = 128 * pn + (cb8 + (n4 & 7)) * 4; scol = (n4 < 8) ? ft : FF + ft; drow = row0 + (n4 & 7) * 8 + ((n4 < 8) ? 0 : 4); };
                    cvt64(exp_w_gu + (size_t)e * D * 2 * FF, 2 * FF, D, m4, idk, WGU + (size_t)e * 2 * FF * D, rb * 64, kb, lane); continue; }
                it -= N_GU;
                auto mid = [](int row0, int n4, int& scol, int& drow) { scol = row0 + 4 * n4; drow = scol; };
                if (it < N_DN) {
                    const int e = it / ((D / 64) * (FF / 64)), r = it % ((D / 64) * (FF / 64)), rb = r / (FF / 64), kb = r % (FF / 64);
                    cvt64(exp_w_down + (size_t)e * FF * D, D, FF, mid, idk, WDN + (size_t)e * D * FF, rb * 64, kb, lane); continue; }
                it -= N_DN;
                if (it < N_IP) {
                    const int rb = it / (D / 64), kb = it % (D / 64), row0 = rb * 64;
                    int mat, col0; inproj_src(row0, mat, col0);
                    const float* W = mat == 0 ? w_in : mat == 1 ? rwkv_w1 : mat == 2 ? rwkv_a1 : rwkv_g1;
                    const int ldw = mat == 0 ? N_IN : mat == 3 ? 256 : 96;
                    auto m4 = [](int r0, int n4, int& scol, int& drow) { int m2; drow = r0 + 4 * n4; inproj_src(drow, m2, scol); };
                    cvt64(W, ldw, D, m4, idk, WINT, row0, kb, lane); continue; }
                it -= N_IP;
                if (it < N_L2) {
                    const float* rwkv_w2 = a.in[16]; const float* rwkv_a2 = a.in[19]; const float* rwkv_g2 = a.in[21]; unsigned short* L2T = (unsigned short*)(ws + WS_L2T);
                    constexpr int NL = (RW / 64) * 4; const int g = it / NL, r = it % NL, rb = r / 4, kb = r % 4;
                    if (g == 0) { auto fk = [](int k) { return k < 96 ? k : -1; }; cvt64(rwkv_w2, RW, 256, mid, fk, L2T, rb * 64, kb, lane); }
                    else if (g == 1) { auto fk = [](int k) { return (k >= 128 && k < 224) ? k - 128 : -1; }; cvt64(rwkv_a2, RW, 256, mid, fk, L2T + (size_t)RW * 256, rb * 64, kb, lane); }
                    else cvt64(rwkv_g2, RW, 256, mid, idk, L2T + (size_t)2 * RW * 256, rb * 64, kb, lane);
                    continue; }
                it -= N_L2;
                if (it < N_UP) { cvt64(w_up_gdn, D, RW, mid, idk, WUPG, (it / (RW / 64)) * 64, it % (RW / 64), lane); continue; }
                it -= N_UP;
                if (it < N_UP) { cvt64(w_up_rwkv, D, RW, mid, idk, WUPR, (it / (RW / 64)) * 64, it % (RW / 64), lane); continue; }
                it -= N_UP;
                cvt64(w_out, D, D, mid, idk, WOUT, (it / (D / 64)) * 64, it % (D / 64), lane);
            }
        }
    }
    SEAM(0);

    if (IN(1)) {
        PHASE_IDS
        const float* x = a.in[0]; const float* norm_mix_pre = a.in[4]; const float* rwkv_mix = a.in[13];
        float* MOD = (float*)(ws + WS_MOD); unsigned short* AM = (unsigned short*)(ws + WS_H);
        LAS float* red = (LAS float*)(LAS unsigned char*)lds_raw;
        const int d0 = tid * 4;
        const f32x4_t nw = *(const f32x4_t*)(norm_mix_pre + d0);
        f32x4_t mx[6];
#pragma unroll
        for (int mi = 0; mi < 6; ++mi) mx[mi] = *(const f32x4_t*)(rwkv_mix + mi * D + d0);
        for (int chunk = blockIdx.x; chunk < T / 64; chunk += gridDim.x) {
            const int r0 = chunk * 64, b = r0 / SEQ; const float* mod = MOD + (size_t)b * 6 * D;
            const f32x4_t sc4 = *(const f32x4_t*)(mod + D + d0), sh4 = *(const f32x4_t*)(mod + d0);
            const f32x4_t g4 = nw * (1.0f + sc4);
            const bool hasprev = (r0 % SEQ) != 0;
            f32x4_t xa[8], xb[8], xp = {0.f, 0.f, 0.f, 0.f}, p = {0.f, 0.f, 0.f, 0.f};
            if (hasprev) xp = *(const f32x4_t*)(x + (size_t)(r0 - 1) * D + d0);
#pragma unroll
            for (int r = 0; r < 8; ++r) xa[r] = *(const f32x4_t*)(x + (size_t)(r0 + r) * D + d0);
#define P1_SUB(sb, XC, XN) do { \
            if ((sb) + 1 < 8) { _Pragma("unroll") for (int r = 0; r < 8; ++r) XN[r] = *(const f32x4_t*)(x + (size_t)(r0 + ((sb) + 1) * 8 + r) * D + d0); } \
            float ss[12]; \
            _Pragma("unroll") for (int r = 0; r < 8; ++r) ss[r] = XC[r][0] * XC[r][0] + XC[r][1] * XC[r][1] + XC[r][2] * XC[r][2] + XC[r][3] * XC[r][3]; \
            ss[8] = xp[0] * xp[0] + xp[1] * xp[1] + xp[2] * xp[2] + xp[3] * xp[3]; ss[9] = 0.f; ss[10] = 0.f; ss[11] = 0.f; \
            _Pragma("unroll") for (int q = 0; q < 3; ++q) { allred16x4(ss[4 * q], ss[4 * q + 1], ss[4 * q + 2], ss[4 * q + 3]); \
                _Pragma("unroll") for (int j = 0; j < 4; ++j) { float v_ = ss[4 * q + j]; v_ += __shfl_xor(v_, 16); v_ += __shfl_xor(v_, 32); ss[4 * q + j] = v_; } } \
            LAS float* rb_ = red + ((sb) & 1) * 96; \
            if (lane == 0) { _Pragma("unroll") for (int q = 0; q < 3; ++q) *(LAS f32x4_t*)(rb_ + wave * 12 + 4 * q) = (f32x4_t){ss[4 * q], ss[4 * q + 1], ss[4 * q + 2], ss[4 * q + 3]}; } \
            __syncthreads(); \
            f32x4_t tot[3]; \
            _Pragma("unroll") for (int q = 0; q < 3; ++q) { tot[q] = *(const LAS f32x4_t*)(rb_ + 4 * q); _Pragma("unroll") for (int w_ = 1; w_ < 8; ++w_) tot[q] += *(const LAS f32x4_t*)(rb_ + w_ * 12 + 4 * q); } \
            if ((sb) == 0 && hasprev) { const float ip = rsqrtf(tot[2][0] / D + EPS); p = xp * ip * g4 + sh4; } \
            _Pragma("unroll") for (int r = 0; r < 8; ++r) { \
                const float inv = rsqrtf(tot[r >> 2][r & 3] / D + EPS); const f32x4_t h = XC[r] * inv * g4 + sh4; \
                const size_t o = (size_t)(r0 + (sb) * 8 + r) * D + d0; \
                *(pg8::u32x2*)(AM + o) = (pg8::u32x2){pg8::cvt_pk_bf16(h[0], h[1]), pg8::cvt_pk_bf16(h[2], h[3])}; \
                const f32x4_t dl = p - h; \
                _Pragma("unroll") for (int mi = 0; mi < 6; ++mi) { const f32x4_t v_ = h + dl * mx[mi]; *(pg8::u32x2*)(AM + (size_t)(mi + 1) * T * D + o) = (pg8::u32x2){pg8::cvt_pk_bf16(v_[0], v_[1]), pg8::cvt_pk_bf16(v_[2], v_[3])}; } \
                p = h; } } while (0)
            P1_SUB(0, xa, xb); P1_SUB(1, xb, xa); P1_SUB(2, xa, xb); P1_SUB(3, xb, xa); P1_SUB(4, xa, xb); P1_SUB(5, xb, xa); P1_SUB(6, xa, xb); P1_SUB(7, xb, xa);
#undef P1_SUB
        }
    }
    SEAM(1);

    if (IN(2)) {
        PHASE_IDS
        unsigned short* AM = (unsigned short*)(ws + WS_H);
        unsigned short* WINT = (unsigned short*)(ws + WS_WINT);
        unsigned short* PH = (unsigned short*)(ws + WS_PH);
        SchedInProj S{(int)gridDim.x, (int)blockIdx.x, (const char*)AM, (const char*)WINT};
        EpiInProjF32 E{PH, (float*)(ws + WS_BA), (unsigned short*)(ws + WS_LWA), (unsigned short*)(ws + WS_LGB)};
        pg8::gemm_phase<EpiInProjF32, SchedInProj, true, false>((LAS unsigned char*)lds_raw, D, S, E);
    }
    SEAM(2);

    if (IN(3)) {
        PHASE_IDS
        const float* gdn_conv = a.in[9];
        const float* gdn_A_log = a.in[10];
        const float* gdn_dt_bias = a.in[11];
        const float* rwkv_w0 = a.in[14];
        const float* rwkv_w2 = a.in[16];
        const float* rwkv_a0 = a.in[17];
        const float* rwkv_a2 = a.in[19];
        const float* rwkv_g2 = a.in[21];
        unsigned short* PH = (unsigned short*)(ws + WS_PH);
        float* WPRE = (float*)(ws + WS_WPRE);
        float* APRE = (float*)(ws + WS_APRE);
        float* GATE = (float*)(ws + WS_GATE);
        unsigned char* GREC = ws + WS_GREC;
        {
            SchedLora S{(int)gridDim.x, (int)blockIdx.x, (const char*)(ws + WS_LWA), (const char*)(ws + WS_LGB), (const char*)(ws + WS_L2T)};
            EpiLora E{WPRE, APRE, GATE, rwkv_w0, rwkv_a0};
            int klora = 256; asm volatile("" : "+s"(klora));
            pg8::gemm_phase<EpiLora, SchedLora, true, false>((LAS unsigned char*)lds_raw, klora, S, E);
        }
        __syncthreads();
        {
            const int cg = tid & 31, r0 = 4 * (tid >> 5);
            const float* convw = gdn_conv;
            pg8::u32x2 xn[3][7]; f32x4_t wn[3][4];
            const int k0 = blockIdx.x;
            if (k0 < 2048) {
                const int it0 = gdn_item_of(k0);
                if (wave == 7) gdn_a0(it0, (const float*)(ws + WS_BA), gdn_A_log, gdn_dt_bias, (LAS float*)((LAS unsigned char*)lds_raw + GL_SM), (LAS float*)((LAS unsigned char*)lds_raw + GL_SM) + 64, lane);
                A1_LOADW(0, it0, wn[0]); A1_LOADW(1, it0, wn[1]); A1_LOADW(2, it0, wn[2]);
                A1_LOADX(0, it0, xn[0]); A1_LOADX(1, it0, xn[1]); A1_LOADX(2, it0, xn[2]);
#pragma unroll
                for (int m = 0; m < 3; ++m) {
#pragma unroll
                    for (int q = 0; q < 7; ++q) asm volatile("" : "+v"(xn[m][q].x), "+v"(xn[m][q].y));
#pragma unroll
                    for (int j = 0; j < 4; ++j) asm volatile("" : "+v"(wn[m][j]));
                }
            }
            __syncthreads();
            int par = 0;
            for (int k = k0; k < 2048; k += gridDim.x) { const int kn = k + (int)gridDim.x; gdn_prep_item(gdn_item_of(k), kn < 2048 ? gdn_item_of(kn) : 2048, par, (LAS unsigned char*)lds_raw, PH, (const float*)(ws + WS_BA), gdn_conv, gdn_A_log, gdn_dt_bias, GREC, xn, wn); par ^= 1; }
        }
    }
    SEAM(3);


    if (IN(5)) {
        PHASE_IDS
        unsigned short* PH = (unsigned short*)(ws + WS_PH);
        unsigned char* GREC = ws + WS_GREC;
        float* WD = (float*)(ws + WS_WD);
        float* AA = (float*)(ws + WS_AA);
        float* BB = (float*)(ws + WS_BB);
        float* KM = (float*)(ws + WS_KM);
        float* OG = (float*)(ws + WS_OG);
        float* YR = (float*)(ws + WS_YR);
        if (blockIdx.x < 32) gdn_scan_seq((int)blockIdx.x, (LAS unsigned char*)lds_raw, GREC, PH, a.in[12], (unsigned short*)(ws + WS_YGB));
        else if (blockIdx.x < 160) rwkv_scan_block(((int)blockIdx.x - 32) >> 1, ((int)blockIdx.x - 32) & 1, (LAS float*)(LAS unsigned char*)lds_raw, (const float*)(ws + WS_WPRE), (const float*)(ws + WS_APRE), PH, a.in[22], a.in[23], a.in[24], (float*)(ws + WS_WD), YR);
        {
            const float* exp_w_gu = a.in[32]; const float* exp_w_down = a.in[34];
            unsigned char* WGU = ws + WS_WGU; unsigned char* WDN = ws + WS_WDN;
            constexpr int N_GU = NE * (2 * FF / 64) * (D / 64), N_DN = NE * (D / 64) * (FF / 64);
            auto idk = [](int k) { return k; };
            constexpr int N_P5 = N_GU + N_DN;
            const int n4 = lane & 15, kg = lane >> 4;
            auto setup = [&](int it, const float*& Wp, int& ldw, int& Kd, unsigned char*& WTp, int& sc, int& dr, int& k0) {
                if (it < N_GU) {
                    const int e = it / ((2 * FF / 64) * (D / 64)), r = it % ((2 * FF / 64) * (D / 64)), rb = r / (D / 64), kb = r % (D / 64), row0 = rb * 64;
                    const int pn = row0 >> 8, cb8 = (row0 & 255) >> 3, ft = 128 * pn + (cb8 + (n4 & 7)) * 4; sc = (n4 < 8) ? ft : FF + ft; dr = row0 + (n4 & 7) * 8 + ((n4 < 8) ? 0 : 4);
                    Wp = exp_w_gu + (size_t)e * D * 2 * FF; ldw = 2 * FF; Kd = D; WTp = WGU + (size_t)e * 2 * FF * D; k0 = kb * 64 + 16 * kg;
                } else {
                    it -= N_GU;
                    const int e = it / ((D / 64) * (FF / 64)), r = it % ((D / 64) * (FF / 64)), rb = r / (FF / 64), kb = r % (FF / 64);
                    sc = rb * 64 + 4 * n4; dr = sc; Wp = exp_w_down + (size_t)e * FF * D; ldw = D; Kd = FF; WTp = WDN + (size_t)e * D * FF; k0 = kb * 64 + 16 * kg;
                }
            };
#define CV_LOAD(it_, v) do { const float* Wp_; unsigned char* WTp_; int ldw_, Kd_, sc_, dr_, k0_; setup((it_), Wp_, ldw_, Kd_, WTp_, sc_, dr_, k0_); (void)WTp_; (void)Kd_; (void)dr_; \
                _Pragma("unroll") for (int kk = 0; kk < 16; ++kk) v[kk] = *(const f32x4_t*)(Wp_ + (size_t)(k0_ + kk) * ldw_ + sc_); } while (0)
#define CV_STORE(it_, v) do { const float* Wp_; unsigned char* WTp_; int ldw_, Kd_, sc_, dr_, k0_; setup((it_), Wp_, ldw_, Kd_, WTp_, sc_, dr_, k0_); (void)Wp_; (void)ldw_; (void)sc_; \
                _Pragma("unroll") for (int j = 0; j < 4; ++j) { pg8::u32x4 o; \
                    _Pragma("unroll") for (int q = 0; q < 4; ++q) { int w = __builtin_amdgcn_cvt_pk_fp8_f32(v[4 * q][j] * 64.0f, v[4 * q + 1][j] * 64.0f, 0, false); w = __builtin_amdgcn_cvt_pk_fp8_f32(v[4 * q + 2][j] * 64.0f, v[4 * q + 3][j] * 64.0f, w, true); o[q] = (unsigned)w; } \
                    *(pg8::u32x4*)(WTp_ + (size_t)(dr_ + j) * Kd_ + k0_) = o; } } while (0)
            static_assert(N_P5 % 8 == 0, "batches of 8");
            for (;;) {
                int base = 0; if (lane == 0) base = (int)atomicAdd(ctl + CW_CNT + 96, 8u);
                base = __builtin_amdgcn_readfirstlane(base);
                if (base >= N_P5) break;
                f32x4_t va[16], vb[16];
                CV_LOAD(base, va);
#pragma unroll 1
                for (int i = 0; i < 8; i += 2) {
                    CV_LOAD(base + i + 1, vb);
                    CV_STORE(base + i, va);
                    if (i + 2 < 8) CV_LOAD(base + i + 2, va);
                    CV_STORE(base + i + 1, vb);
                }
            }
#undef CV_LOAD
#undef CV_STORE
        }
    }
    SEAM(5);

    if (IN(6)) {
        PHASE_IDS
        const float* gdn_norm = a.in[12];
        const float* rwkv_r_k = a.in[24];
        const float* rwkv_ln_w = a.in[25];
        const float* rwkv_ln_b = a.in[26];
        unsigned short* PH = (unsigned short*)(ws + WS_PH);
        float* GATE = (float*)(ws + WS_GATE);
        float* KM = (float*)(ws + WS_KM);
        float* OG = (float*)(ws + WS_OG);
        float* YR = (float*)(ws + WS_YR);
        unsigned short* YGB = (unsigned short*)(ws + WS_YGB);
        unsigned short* YRWB = (unsigned short*)(ws + WS_YRWB);
        {
            const int c0 = (tid & 255) * 4;
            const f32x4_t lw = *(const f32x4_t*)(rwkv_ln_w + c0), lb = *(const f32x4_t*)(rwkv_ln_b + c0);
            const float* BONp = (const float*)(ws + WS_WD);
            for (int rp = blockIdx.x; rp < T / 8; rp += gridDim.x) {
                const int rowb = rp * 8 + (tid >> 8);
                f32x4_t y[4], vv[4], gt[4]; float bsum[4], sm[4], sv[4];
#pragma unroll
                for (int i = 0; i < 4; ++i) { const size_t row = (size_t)(rowb + 2 * i); y[i] = ld_bf4((const unsigned short*)YR + row * RW + c0); vv[i] = ld_bf4(PH + row * N_IN + COL_RV + c0); gt[i] = ld_bf4((const unsigned short*)GATE + row * RW + c0); bsum[i] = BONp[row * 16 + (c0 >> 6)]; }
#pragma unroll
                for (int i = 0; i < 4; ++i) sm[i] = (y[i][0] + y[i][1]) + (y[i][2] + y[i][3]);
                allred16x4(sm[0], sm[1], sm[2], sm[3]);
                f32x4_t dl[4];
#pragma unroll
                for (int i = 0; i < 4; ++i) { dl[i] = y[i] - sm[i] * (1.0f / 64.0f); sv[i] = (dl[i][0] * dl[i][0] + dl[i][1] * dl[i][1]) + (dl[i][2] * dl[i][2] + dl[i][3] * dl[i][3]); }
                allred16x4(sv[0], sv[1], sv[2], sv[3]);
#pragma unroll
                for (int i = 0; i < 4; ++i) {
                    const float rs = rsqrtf(sv[i] * (1.0f / 64.0f) + 64e-5f);
                    const f32x4_t yo = (dl[i] * rs * lw + lb + bsum[i] * vv[i]) * gt[i];
                    *(pg8::u32x2*)(YRWB + (size_t)(rowb + 2 * i) * RW + c0) = (pg8::u32x2){pg8::cvt_pk_bf16(yo[0], yo[1]), pg8::cvt_pk_bf16(yo[2], yo[3])};
                }
            }
        }
    }
    SEAM(6);

    if (IN(7)) {
        PHASE_IDS
        unsigned short* PH = (unsigned short*)(ws + WS_PH);
        unsigned short* YGB = (unsigned short*)(ws + WS_YGB);
        unsigned short* YRWB = (unsigned short*)(ws + WS_YRWB);
        unsigned short* WUPG = (unsigned short*)(ws + WS_WUPG);
        unsigned short* WUPR = (unsigned short*)(ws + WS_WUPR);
        unsigned short* MRGB = (unsigned short*)(ws + WS_MRGB);
        float* MERGED = (float*)(ws + WS_MERGED);
        SchedUp S{(int)gridDim.x, (int)blockIdx.x, (const char*)YGB, (const char*)YRWB, (const char*)WUPG, (const char*)WUPR};
        EpiUp E{MRGB, PH};
        pg8::gemm_phase<EpiUp, SchedUp, true, false>((LAS unsigned char*)lds_raw, RW, S, E);
    }
    SEAM(7);

    if (IN(8)) {
        PHASE_IDS
        unsigned short* WOUT = (unsigned short*)(ws + WS_WOUT);
        unsigned short* MRGB = (unsigned short*)(ws + WS_MRGB);
        float* Y = (float*)(ws + WS_Y);
        SchedPlain S{(int)gridDim.x, (int)blockIdx.x, T / 256, D / 256, D, (const char*)MRGB, (const char*)WOUT};
        EpiF32 E{(unsigned short*)Y, D};
        pg8::gemm_phase<EpiF32, SchedPlain, true, false>((LAS unsigned char*)lds_raw, D, S, E);
    }
    SEAM(8);

    if (IN(9)) {
        PHASE_IDS
        const float* x = a.in[0];
        const float* norm_mix_post = a.in[5];
        const float* norm_ffn_pre = a.in[6];
        const float* router_w = a.in[30];
        const float* router_b = a.in[31];
        float* MOD = (float*)(ws + WS_MOD);
        float* Y = (float*)(ws + WS_Y);
        float* XMID = (float*)(ws + WS_XMID);
        unsigned short* H2B = (unsigned short*)(ws + WS_H2B);
        float* TOPP = (float*)(ws + WS_TOPP);
        int* LIST = (int*)(ws + WS_LIST);
        unsigned* CNT = ctl + CW_CNT;
        constexpr int HP = D + 4;
        LAS float* hb = (LAS float*)(LAS unsigned char*)lds_raw;
        const int ntl = (T / 8 - (int)blockIdx.x + (int)gridDim.x - 1) / (int)gridDim.x;
        pg8::u32x2 yr[8]; f32x4_t xr_[8];
#define P9_LOAD(tl) do { const size_t _row = (size_t)(tl) * 8 + wave; _Pragma("unroll") for (int j = 0; j < 8; ++j) { yr[j] = *(const pg8::u32x2*)((const unsigned short*)Y + _row * D + j * 256 + lane * 4); xr_[j] = *(const f32x4_t*)(x + _row * D + j * 256 + lane * 4); } } while (0)
#define P9_FINISH(tl, hbuf) do { const int _rowi = (tl) * 8 + wave; const size_t _row = (size_t)_rowi; const float* mod = MOD + (size_t)(_rowi / SEQ) * 6 * D; \
        f32x4_t ym[8]; float ss = 0.f; \
        _Pragma("unroll") for (int j = 0; j < 8; ++j) { ym[j] = (f32x4_t){__uint_as_float(yr[j].x << 16), __uint_as_float(yr[j].x & 0xffff0000u), __uint_as_float(yr[j].y << 16), __uint_as_float(yr[j].y & 0xffff0000u)}; \
            ss += ym[j][0] * ym[j][0] + ym[j][1] * ym[j][1] + ym[j][2] * ym[j][2] + ym[j][3] * ym[j][3]; } \
        ss = wave_sum(ss); const float inv = rsqrtf(ss / D + EPS); float ss2 = 0.f; \
        _Pragma("unroll") for (int j = 0; j < 8; ++j) { const int d0 = j * 256 + lane * 4; const f32x4_t nw = *(const f32x4_t*)(norm_mix_post + d0), gt = *(const f32x4_t*)(mod + 2 * D + d0); \
            ym[j] = xr_[j] + gt * (ym[j] * inv * nw); *(pg8::u32x2*)((unsigned short*)XMID + _row * D + d0) = (pg8::u32x2){pg8::cvt_pk_bf16(ym[j][0], ym[j][1]), pg8::cvt_pk_bf16(ym[j][2], ym[j][3])}; ss2 += ym[j][0] * ym[j][0] + ym[j][1] * ym[j][1] + ym[j][2] * ym[j][2] + ym[j][3] * ym[j][3]; } \
        ss2 = wave_sum(ss2); const float inv2 = rsqrtf(ss2 / D + EPS); \
        _Pragma("unroll") for (int j = 0; j < 8; ++j) { const int d0 = j * 256 + lane * 4; const f32x4_t nw = *(const f32x4_t*)(norm_ffn_pre + d0), sc = *(const f32x4_t*)(mod + 4 * D + d0), sh = *(const f32x4_t*)(mod + 3 * D + d0); \
            const f32x4_t hv = ym[j] * inv2 * nw * (1.0f + sc) + sh; \
            { int w8 = __builtin_amdgcn_cvt_pk_fp8_f32(hv[0], hv[1], 0, false); w8 = __builtin_amdgcn_cvt_pk_fp8_f32(hv[2], hv[3], w8, true); *(int*)((unsigned char*)H2B + _row * D + d0) = w8; } \
            *(LAS f32x4_t*)((hbuf) + wave * HP + d0) = hv; } } while (0)
        if (ntl > 0) { P9_LOAD(blockIdx.x); P9_FINISH((int)blockIdx.x, hb); }
        __syncthreads();
        for (int k = 0; k < ntl; ++k) {
            const int tile = (int)blockIdx.x + k * (int)gridDim.x; const LAS float* cur = hb + (k & 1) * 8 * HP;
            if (k + 1 < ntl) P9_LOAD(tile + (int)gridDim.x);
            {
                const int kp = tid >> 5, e = tid & 31;
                const LAS float* hp = cur + kp * 128; const float* wp = router_w + (size_t)kp * 128 * NE + e;
                f32x2_t acc[8];
#pragma unroll
                for (int r = 0; r < 8; ++r) acc[r] = (f32x2_t){0.f, 0.f};
#pragma unroll 2
                for (int d = 0; d < 128; d += 4) {
                    const f32x2_t wa = {wp[(size_t)d * NE], wp[(size_t)(d + 1) * NE]}, wb = {wp[(size_t)(d + 2) * NE], wp[(size_t)(d + 3) * NE]};
#pragma unroll
                    for (int r = 0; r < 8; ++r) { const f32x4_t h4 = *(const LAS f32x4_t*)(hp + r * HP + d); acc[r] += (f32x2_t){h4[0], h4[1]} * wa; acc[r] += (f32x2_t){h4[2], h4[3]} * wb; }
                }
                __syncthreads();
                LAS float* part = (LAS float*)cur;
#pragma unroll
                for (int r = 0; r < 8; ++r) part[(kp * 8 + r) * 32 + e] = acc[r][0] + acc[r][1];
            }
            __syncthreads();
            if (tid < 256) {
                const int r = tid >> 5, e = tid & 31, row = tile * 8 + r;
                const LAS float* part = cur;
                float lgt = router_b[e];
#pragma unroll
                for (int kp = 0; kp < 16; ++kp) lgt += part[(kp * 8 + r) * 32 + e];
                float val[TOPK]; int idx[TOPK];
#pragma unroll
                for (int q = 0; q < TOPK; ++q) {
                    float bv = lgt; int bi = e;
#pragma unroll
                    for (int o = 1; o < 32; o <<= 1) { const float ov = __shfl_xor(bv, o); const int oi = __shfl_xor(bi, o); if (ov > bv || (ov == bv && oi < bi)) { bv = ov; bi = oi; } }
                    val[q] = bv; idx[q] = bi; if (e == bi) lgt = -3.0e38f;
                }
                float pe[TOPK], psum = 0.f;
#pragma unroll
                for (int q = 0; q < TOPK; ++q) { pe[q] = expf(val[q] - val[0]); psum += pe[q]; }
                if (e < TOPK) {
                    const float pk = e == 0 ? pe[0] : e == 1 ? pe[1] : e == 2 ? pe[2] : pe[3]; const int ik = e == 0 ? idx[0] : e == 1 ? idx[1] : e == 2 ? idx[2] : idx[3];
                    const int asg = row * TOPK + e;
                    TOPP[asg] = pk / psum;
                    const unsigned pos = atomicAdd(&CNT[ik], 1u);
                    LIST[(size_t)ik * T + pos] = asg;
                }
            }
            if (k + 1 < ntl) P9_FINISH(tile + (int)gridDim.x, hb + ((k + 1) & 1) * 8 * HP);
            __syncthreads();
        }
#undef P9_LOAD
#undef P9_FINISH
    }
    SEAM(9);

    const int vcu = (gridDim.x % 8 == 0) ? (int)((blockIdx.x % 8) * (gridDim.x / 8) + blockIdx.x / 8) : (int)blockIdx.x;
    if (IN(10)) {
        PHASE_IDS
        const float* exp_b_gu = a.in[33];
        unsigned short* H2B = (unsigned short*)(ws + WS_H2B);
        int* LIST = (int*)(ws + WS_LIST);
        unsigned short* ACT = (unsigned short*)(ws + WS_ACT);
        unsigned short* WGU = (unsigned short*)(ws + WS_WGU);
        LAS int* mtab = (LAS int*)(LAS unsigned char*)(lds_raw + 131072);
        unsigned* CNT = ctl + CW_CNT;
        moe_tables(mtab, CNT);
        SchedMoE S{(int)gridDim.x, vcu, 2 * FF / 256, 2 * FF, mtab, LIST, (const char*)H2B, (const char*)WGU, true, 1};
        EpiGU E{(unsigned char*)ACT, exp_b_gu};
        pg8::gemm_phase<EpiGU, SchedMoE, true, true, true>((LAS unsigned char*)lds_raw, D, S, E);
    }
    SEAM(10);

    if (IN(11)) {
        PHASE_IDS
        const float* exp_b_down = a.in[35];
        int* LIST = (int*)(ws + WS_LIST);
        unsigned short* ACT = (unsigned short*)(ws + WS_ACT);
        unsigned short* YB = (unsigned short*)(ws + WS_YB);
        unsigned short* WDN = (unsigned short*)(ws + WS_WDN);
        LAS int* mtab = (LAS int*)(LAS unsigned char*)(lds_raw + 131072);
        unsigned* CNT = ctl + CW_CNT;
        moe_tables(mtab, CNT);
        SchedMoE S{(int)gridDim.x, vcu, D / 256, D, mtab, LIST, (const char*)ACT, (const char*)WDN, false, 1};
        EpiDown E{YB, exp_b_down};
        pg8::gemm_phase<EpiDown, SchedMoE, true, true, true>((LAS unsigned char*)lds_raw, FF, S, E);
    }
    SEAM(11);

    if (IN(12)) {
        PHASE_IDS
        const float* norm_ffn_post = a.in[7];
        float* MOD = (float*)(ws + WS_MOD);
        float* XMID = (float*)(ws + WS_XMID);
        float* TOPP = (float*)(ws + WS_TOPP);
        unsigned short* YB = (unsigned short*)(ws + WS_YB);
        for (int row = blockIdx.x * 8 + wave; row < T; row += gridDim.x * 8) {
            const int b = row / SEQ; const float* mod = MOD + (size_t)b * 6 * D;
            f32x4_t ylo[4], yhi[4];
#pragma unroll
            for (int j = 0; j < 4; ++j) { ylo[j] = (f32x4_t){0.f, 0.f, 0.f, 0.f}; yhi[j] = (f32x4_t){0.f, 0.f, 0.f, 0.f}; }
#pragma unroll
            for (int k = 0; k < TOPK; ++k) {
                const int asg = row * TOPK + k; const float p = TOPP[asg];
#pragma unroll
                for (int j = 0; j < 4; ++j) { f32x4_t lo, hi; ld_bf8(YB + (size_t)asg * D + j * 512 + lane * 8, lo, hi); ylo[j] += p * lo; yhi[j] += p * hi; }
            }
            float ss = 0.f;
#pragma unroll
            for (int j = 0; j < 4; ++j) ss += ylo[j][0] * ylo[j][0] + ylo[j][1] * ylo[j][1] + ylo[j][2] * ylo[j][2] + ylo[j][3] * ylo[j][3] + yhi[j][0] * yhi[j][0] + yhi[j][1] * yhi[j][1] + yhi[j][2] * yhi[j][2] + yhi[j][3] * yhi[j][3];
            ss = wave_sum(ss);
            const float inv = rsqrtf(ss / D + EPS);
#pragma unroll
            for (int j = 0; j < 4; ++j) {
                const int d0 = j * 512 + lane * 8;
                f32x4_t x0, x1; ld_bf8((const unsigned short*)XMID + (size_t)row * D + d0, x0, x1);
                const f32x4_t g0 = *(const f32x4_t*)(mod + 5 * D + d0), g1 = *(const f32x4_t*)(mod + 5 * D + d0 + 4);
                const f32x4_t n0 = *(const f32x4_t*)(norm_ffn_post + d0), n1 = *(const f32x4_t*)(norm_ffn_post + d0 + 4);
                *(f32x4_t*)(a.out + (size_t)row * D + d0) = x0 + g0 * (ylo[j] * inv * n0);
                *(f32x4_t*)(a.out + (size_t)row * D + d0 + 4) = x1 + g1 * (yhi[j] * inv * n1);
            }
        }
    }
#undef IN
#undef SEAM
}

constexpr int NPHASES = 13;
#ifndef MK_ONE_LAUNCH
#define MK_ONE_LAUNCH 1
#endif

extern "C" void kernel_launch(void* const* d_in, const int* in_sizes, int n_in, void* d_out, int out_size, void* d_ws, size_t ws_size, hipStream_t stream) {
    static int grid = 0;
    if (grid == 0) {
        if (n_in != 36 || out_size != T * D || ws_size < WS_END) { fprintf(stderr, "kernel_launch: unexpected shapes n_in %d out %d ws %zu (need %zu)\n", n_in, out_size, ws_size, (size_t)WS_END); grid = -1; return; }
        int dev = 0, cus = 0, per_cu = 0;
        if (hipGetDevice(&dev) != hipSuccess || hipDeviceGetAttribute(&cus, hipDeviceAttributeMultiprocessorCount, dev) != hipSuccess) { grid = -1; return; }
        if (hipFuncSetAttribute((const void*)fwd, hipFuncAttributeMaxDynamicSharedMemorySize, LDS_BYTES) != hipSuccess) { fprintf(stderr, "kernel_launch: hipFuncSetAttribute failed\n"); grid = -1; return; }
        if (hipOccupancyMaxActiveBlocksPerMultiprocessor(&per_cu, (const void*)fwd, NTHREADS, LDS_BYTES) != hipSuccess || per_cu < 1) { fprintf(stderr, "kernel_launch: occupancy query says %d\n", per_cu); }
        (void)hipGetLastError();
        grid = cus;
    }
    if (grid < 0) return;
    (void)hipMemsetAsync((char*)d_ws + WS_CTL, 0, CTL_BYTES, stream);
    Args a{};
    for (int i = 0; i < 36; ++i) a.in[i] = (const float*)d_in[i];
    a.out = (float*)d_out; a.ws = (unsigned char*)d_ws;
#if MK_ONE_LAUNCH
    a.ph_lo = 0; a.ph_hi = NPHASES;
    hipLaunchKernelGGL(fwd, dim3(grid), dim3(NTHREADS), LDS_BYTES, stream, a);
#else
    for (int p = 0; p < NPHASES; ++p) {
        a.ph_lo = p; a.ph_hi = p + 1;
        hipLaunchKernelGGL(fwd, dim3(grid), dim3(NTHREADS), LDS_BYTES, stream, a);
    }
#endif
}
```

```cpp
#include <hip/hip_runtime.h>
#include <cstdio>
#include <cstdint>

constexpr int D = 2048, NB = 4, SEQ = 4096, T = NB * SEQ;
constexpr int COL_K = 512, COL_V = 1024, COL_Z = 2048, COL_B = 3072, COL_A = 3080, COL_GATE = 3088, COL_R = 7184, COL_RK = 8208, COL_RV = 9232, N_IN = 10256;
constexpr int NE = 32, TOPK = 4, FF = 2048, NA = T * TOPK;
constexpr int RW = 1024;
constexpr float EPS = 1e-6f;
constexpr int NTHREADS = 512;
constexpr int LDS_BYTES = 128 * 1024 + 4096;

#define XB_TMO      128
#define XB_XCNT(j)  (256  + 64 * (j))
#define XB_XSUB(j)  (1280 + 64 * (j))
#define XB_XGEN(j)  (2304 + 64 * (j))
#define XB_TOP      3328
#define XB_TOPGEN   3392
#define XCD_BAR_WORDS 3456
#define XB_SPIN_CAP (1u << 22)
#define LAS __attribute__((address_space(3)))
__device__ __forceinline__ unsigned xb_ld(unsigned* p)              { return __hip_atomic_load(p, __ATOMIC_RELAXED, __HIP_MEMORY_SCOPE_AGENT); }
__device__ __forceinline__ unsigned xb_add(unsigned* p, unsigned v) { return __hip_atomic_fetch_add(p, v, __ATOMIC_RELAXED, __HIP_MEMORY_SCOPE_AGENT); }
__device__ __forceinline__ unsigned xb_xcc_id() { return (unsigned)__builtin_amdgcn_s_getreg((3 << 11) | 20) & 0xFu; }
#define XB_SPIN(cond, bar) do { unsigned _sp = 0; while (cond) { __builtin_amdgcn_s_sleep(1); \
    if ((++_sp & 255u) == 0u) { if (xb_ld(&(bar)[XB_TMO])) break; if (_sp > XB_SPIN_CAP) { atomicAdd(&(bar)[XB_TMO], 1u); break; } } } } while (0)
struct XcdBarrier { unsigned* bar; unsigned x; volatile LAS unsigned* st; };
__device__ __forceinline__ XcdBarrier xcd_barrier_post(unsigned* bar, volatile LAS unsigned* st) {
    XcdBarrier b; b.bar = bar; b.x = xb_xcc_id(); b.st = st;
    if (threadIdx.x == 0) (void)xb_add(&bar[XB_XCNT(b.x)], 1u);
    return b;
}
__device__ __forceinline__ void xcd_barrier_complete(unsigned* bar, unsigned x, unsigned& nloc, unsigned& nx) {
    const unsigned G = gridDim.x * gridDim.y * gridDim.z;
    unsigned sum, cnt, mine, sp = 0u;
    for (;;) {
        sum = 0u; cnt = 0u; mine = 0u;
#pragma unroll
        for (unsigned j = 0; j < 16; ++j) { const unsigned c = xb_ld(&bar[XB_XCNT(j)]); sum += c; cnt += (c > 0u) ? 1u : 0u; mine = (j == x) ? c : mine; }
        if (sum == G) break;
        __builtin_amdgcn_s_sleep(1);
        if ((++sp & 255u) == 0u) { if (xb_ld(&bar[XB_TMO])) break; if (sp > XB_SPIN_CAP) { atomicAdd(&bar[XB_TMO], 1u); break; } }
    }
    nloc = mine > 0u ? mine : 1u; nx = cnt > 0u ? cnt : 1u;
}
__device__ __forceinline__ void xcd_barrier(const XcdBarrier& b) {
    asm volatile("s_waitcnt vmcnt(0)" ::: "memory");
    __syncthreads();
    if (threadIdx.x == 0) {
        unsigned* bar = b.bar;
        __builtin_amdgcn_s_waitcnt(0);
        unsigned nloc = b.st[0], nx = b.st[1];
        if (nloc == 0u) { xcd_barrier_complete(bar, b.x, nloc, nx); b.st[0] = nloc; b.st[1] = nx; }
        const unsigned old = xb_add(&bar[XB_XSUB(b.x)], 1u);
        const unsigned gen = old / nloc;
        if (old + 1u == (gen + 1u) * nloc) {
            __builtin_amdgcn_fence(__ATOMIC_RELEASE, "agent");
            asm volatile("s_waitcnt vmcnt(0)" ::: "memory");
            const unsigned og = xb_add(&bar[XB_TOP], 1u);
            const unsigned tg = og / nx;
            if (og + 1u == (tg + 1u) * nx) xb_add(&bar[XB_TOPGEN], 1u);
            else XB_SPIN(xb_ld(&bar[XB_TOPGEN]) == tg, bar);
            __builtin_amdgcn_fence(__ATOMIC_ACQUIRE, "agent");
            xb_add(&bar[XB_XGEN(b.x)], 1u);
            asm volatile("s_waitcnt vmcnt(0)" ::: "memory");
        } else {
            XB_SPIN(xb_ld(&bar[XB_XGEN(b.x)]) == gen, bar);
            __builtin_amdgcn_fence(__ATOMIC_ACQUIRE, "agent");
            asm volatile("s_waitcnt vmcnt(0)" ::: "memory");
        }
    }
    __syncthreads();
}

constexpr size_t al256(size_t x) { return (x + 255) & ~(size_t)255; }
constexpr size_t WS_CTL   = 0;
constexpr size_t CTL_BYTES = 32768;
constexpr size_t CW_CNT   = XCD_BAR_WORDS + 64;
constexpr size_t WS_MOD   = WS_CTL + CTL_BYTES;
constexpr size_t WS_H     = al256(WS_MOD + (size_t)NB * 6 * D * 4);
constexpr size_t WS_WINT  = al256(WS_H + (size_t)7 * T * D * 2);
constexpr int NT_IN = 44;
constexpr size_t WS_PH    = al256(WS_WINT + (size_t)NT_IN * 256 * D * 2);
constexpr size_t WS_BA    = al256(WS_PH + (size_t)T * N_IN * 2);
constexpr size_t WS_LWA   = al256(WS_BA + (size_t)T * 16 * 4);
constexpr size_t WS_LGB   = al256(WS_LWA + (size_t)T * 256 * 2);
constexpr size_t WS_L2T   = al256(WS_LGB + (size_t)T * 256 * 2);
constexpr size_t WS_WPRE  = al256(WS_L2T + (size_t)3 * RW * 256 * 2);
constexpr size_t WS_APRE  = al256(WS_WPRE + (size_t)T * RW * 4);
constexpr size_t WS_GATE  = al256(WS_APRE + (size_t)T * RW * 4);
static_assert(WS_APRE == WS_WPRE + (size_t)T * RW * 4 && WS_GATE == WS_APRE + (size_t)T * RW * 4, "EpiLora indexes the three buffers from WPRE");
constexpr size_t WS_WD    = al256(WS_GATE + (size_t)T * RW * 4);
constexpr size_t WS_AA    = al256(WS_WD + (size_t)T * RW * 4);
constexpr size_t WS_BB    = al256(WS_AA + (size_t)T * RW * 4);
constexpr size_t WS_KM    = al256(WS_BB + (size_t)T * RW * 4);
constexpr size_t WS_OG    = al256(WS_KM + (size_t)T * RW * 4);
constexpr size_t WS_YR    = al256(WS_OG + (size_t)T * RW * 4);
constexpr size_t WS_MERGED= al256(WS_YR + (size_t)T * RW * 4);
constexpr size_t WS_Y     = al256(WS_MERGED + (size_t)T * D * 4);
constexpr size_t WS_XMID  = al256(WS_Y + (size_t)T * D * 4);
constexpr size_t WS_H2B   = al256(WS_XMID + (size_t)T * D * 4);
constexpr size_t WS_TOPP  = al256(WS_H2B + (size_t)T * D * 2);
constexpr size_t WS_LIST  = al256(WS_TOPP + (size_t)NA * 4);
constexpr int ACT_ROWS = NA + NE * 256;
constexpr size_t WS_ACT   = al256(WS_LIST + (size_t)NE * T * 4);
constexpr size_t WS_YB    = al256(WS_ACT + (size_t)ACT_ROWS * FF * 2);
constexpr size_t WS_WGU   = al256(WS_YB + (size_t)NA * D * 2);
constexpr size_t WS_WDN   = al256(WS_WGU + (size_t)NE * 2 * FF * D * 2);
constexpr size_t WS_YGB   = al256(WS_WDN + (size_t)NE * D * FF * 2);
constexpr size_t WS_YRWB  = al256(WS_YGB + (size_t)T * RW * 2);
constexpr size_t WS_WUPG  = al256(WS_YRWB + (size_t)T * RW * 2);
constexpr size_t WS_WUPR  = al256(WS_WUPG + (size_t)D * RW * 2);
constexpr size_t WS_WOUT  = al256(WS_WUPR + (size_t)D * RW * 2);
constexpr size_t WS_MRGB  = al256(WS_WOUT + (size_t)D * D * 2);
constexpr size_t WS_GREC  = al256(WS_MRGB + (size_t)T * D * 2);
constexpr size_t WS_END   = al256(WS_GREC + (size_t)2048 * 90368);

struct Args {
    const float* in[36];
    float* out;
    unsigned char* ws;
    int ph_lo, ph_hi;
};

__device__ __forceinline__ float sigmoidf_(float x) { return 1.0f / (1.0f + expf(-x)); }
__device__ __forceinline__ float siluf_(float x) { return x * sigmoidf_(x); }
__device__ __forceinline__ float softplusf_(float x) { return fmaxf(x, 0.0f) + log1pf(expf(-fabsf(x))); }
__device__ __forceinline__ float rl(float x, int k) { return __int_as_float(__builtin_amdgcn_readlane(__float_as_int(x), k)); }
__device__ __forceinline__ float wave_sum(float v) {
#pragma unroll
    for (int o = 32; o > 0; o >>= 1) v += __shfl_xor(v, o);
    return v;
}
__device__ __forceinline__ float half_sum(float v) {
#pragma unroll
    for (int o = 16; o > 0; o >>= 1) v += __shfl_xor(v, o);
    return v;
}
__device__ __forceinline__ float block_sum(float v, float* red) {
    v = wave_sum(v);
    __syncthreads();
    if ((threadIdx.x & 63) == 0) red[threadIdx.x >> 6] = v;
    __syncthreads();
    float t = 0.f;
#pragma unroll
    for (int w = 0; w < NTHREADS / 64; ++w) t += red[w];
    return t;
}

constexpr int GBM = 128, GBN = 64, GBK = 16;
template <bool DUAL, class AL, class EP>
__device__ __forceinline__ void gemm_naive(float* sm, int M, int N, int K, const AL& al, const float* __restrict__ W, int ldw, int dual_off, const EP& ep) {
    float* As = sm;
    float* Bs = sm + GBK * (GBM + 4);
    float* Bs2 = Bs + GBK * (GBN + 4);
    const int tid = threadIdx.x, tx = tid & 15, ty = tid >> 4;
    const int ntm = (M + GBM - 1) / GBM, ntn = (N + GBN - 1) / GBN;
    for (int tile = blockIdx.x; tile < ntm * ntn; tile += gridDim.x) {
        const int tm = tile / ntn, tn = tile % ntn;
        const int m0 = tm * GBM, n0 = tn * GBN;
        float acc[4][4], acc2[4][4];
#pragma unroll
        for (int i = 0; i < 4; ++i)
#pragma unroll
            for (int j = 0; j < 4; ++j) { acc[i][j] = 0.f; acc2[i][j] = 0.f; }
        for (int k0 = 0; k0 < K; k0 += GBK) {
#pragma unroll
            for (int i = 0; i < 4; ++i) { const int idx = tid + i * NTHREADS, r = idx >> 4, kk = idx & 15; As[kk * (GBM + 4) + r] = al(m0 + r, k0 + kk); }
#pragma unroll
            for (int i = 0; i < 2; ++i) { const int idx = tid + i * NTHREADS, kk = idx >> 6, c = idx & 63, n = n0 + c;
                Bs[kk * (GBN + 4) + c] = (n < N) ? W[(size_t)(k0 + kk) * ldw + n] : 0.f;
                if (DUAL) Bs2[kk * (GBN + 4) + c] = (n < N) ? W[(size_t)(k0 + kk) * ldw + n + dual_off] : 0.f; }
            __syncthreads();
#pragma unroll
            for (int kk = 0; kk < GBK; ++kk) {
                float a[4], b[4], b2[4];
#pragma unroll
                for (int i = 0; i < 4; ++i) a[i] = As[kk * (GBM + 4) + ty * 4 + i];
#pragma unroll
                for (int j = 0; j < 4; ++j) { b[j] = Bs[kk * (GBN + 4) + tx * 4 + j]; b2[j] = DUAL ? Bs2[kk * (GBN + 4) + tx * 4 + j] : 0.f; }
#pragma unroll
                for (int i = 0; i < 4; ++i)
#pragma unroll
                    for (int j = 0; j < 4; ++j) { acc[i][j] = fmaf(a[i], b[j], acc[i][j]); if (DUAL) acc2[i][j] = fmaf(a[i], b2[j], acc2[i][j]); }
            }
            __syncthreads();
        }
#pragma unroll
        for (int i = 0; i < 4; ++i)
#pragma unroll
            for (int j = 0; j < 4; ++j) { const int m = m0 + ty * 4 + i, n = n0 + tx * 4 + j; if (m < M && n < N) ep(m, n, acc[i][j], acc2[i][j]); }
    }
}

struct ALPlain { const float* A; int lda; __device__ __forceinline__ float operator()(int m, int k) const { return A[(size_t)m * lda + k]; } };
struct ALMix {
    const float* H; const float* mix;
    __device__ __forceinline__ float operator()(int m, int k) const {
        const float h = H[(size_t)m * D + k];
        const float hp = ((m % SEQ) == 0) ? 0.f : H[(size_t)(m - 1) * D + k];
        return h + (hp - h) * mix[k];
    }
};
struct ALGatherTok { const float* H2; const int* list; int cnt; __device__ __forceinline__ float operator()(int m, int k) const { return (m < cnt) ? H2[(size_t)(list[m] >> 2) * D + k] : 0.f; } };
struct ALGatherAsg { const float* ACT; const int* list; int cnt; __device__ __forceinline__ float operator()(int m, int k) const { return (m < cnt) ? ACT[(size_t)list[m] * FF + k] : 0.f; } };

namespace pg8 {
#define PG8_LAS __attribute__((address_space(3)))
typedef unsigned short bf16_t;
typedef short bf16x8 __attribute__((ext_vector_type(8)));
typedef float f32x4 __attribute__((ext_vector_type(4)));
typedef unsigned u32x4 __attribute__((ext_vector_type(4)));
typedef unsigned u32x2 __attribute__((ext_vector_type(2)));
constexpr int BM = 256, BK = 64, HALF = 128, HTB = HALF * BK * 2, STAGE_BYTES = 8 * HTB, NXCD = 8, WGM = 2;
__host__ __device__ __forceinline__ int lds_byte(int r, int c) { const int st = (r >> 4) * 2 + (c >> 5), rr = r & 15, cc = c & 31, ob = rr * 64 + cc * 2; return st * 1024 + (ob ^ (((ob >> 9) & 1) << 5)); }
__host__ __device__ __forceinline__ void stage_rc(int b, int& R, int& C) { const int st = b / 1024, sb = b % 1024, swz = sb ^ (((sb >> 9) & 1) << 5); R = (st >> 1) * 16 + swz / 64; C = (st & 1) * 32 + (swz % 64) / 2; }
__host__ __device__ __forceinline__ int perm32(int rho) { const int n = rho >> 4, i = rho & 15; return 8 * (i >> 2) + 4 * n + (i & 3); }
struct Unit { int pm, pn; const char* A; const char* B; const int* list; int cnt, e, prow, gat; };
typedef __bf16 bf16x2_t __attribute__((ext_vector_type(2)));
__device__ __forceinline__ unsigned cvt_pk_bf16(float lo, float hi) { bf16x2_t v; v.x = (__bf16)lo; v.y = (__bf16)hi; return __builtin_bit_cast(unsigned, v); }
__device__ __forceinline__ bool static_order(int nM, int nN, int G, int c, int i, int& pm, int& pn) {
    const int nwg = nM * nN; const long L = (long)i * G + c; if (L >= nwg) return false;
    int wgid = (int)L; { const int q = nwg / NXCD, r = nwg % NXCD, xcd = wgid % NXCD, off = wgid / NXCD; wgid = (xcd < r ? xcd * (q + 1) : r * (q + 1) + (xcd - r) * q) + off; }
    const int nig = WGM * nN, gid = wgid / nig, fm = gid * WGM, gsz = (nM - fm) < WGM ? (nM - fm) : WGM;
    pm = fm + ((wgid % nig) % gsz); pn = (wgid % nig) / gsz; return true;
}
template <class Epi, class Sched, bool ALIGN_EPI = true, bool GATHER = false, bool FP8 = false>
__device__ __forceinline__ void gemm_phase(PG8_LAS unsigned char* lds, const int K_, const Sched& S, const Epi& E) {
    const int tid = threadIdx.x, wid = __builtin_amdgcn_readfirstlane(tid >> 6), lane = tid & 63, wr = wid >> 2, wc = wid & 3, fr = lane & 15, fq = lane >> 4;
    const int K = K_, KB = FP8 ? K_ : 2 * K_, nt = KB / 128;
    unsigned voffA0, voffB0;
    { int R, C; stage_rc(tid * 16, R, C); const int Rb = Epi::PERM ? ((R & ~31) + perm32(R & 31)) : R;
      voffA0 = (unsigned)(R * KB + C * 2); voffB0 = (unsigned)(Rb * KB + C * 2); }
    const size_t pstep = (size_t)64 * KB;
    const size_t kstep = (size_t)(BK * 2);
    const size_t hstep = (size_t)HALF * KB;
    const size_t tstep = 2 * hstep; (void)tstep;
    const unsigned ldsw = (unsigned)wid * 1024u;
    const int cole = FP8 ? ((fq >> 1) * 32 + (fq & 1) * 16) : fq * 8;
    const int aoff = lds_byte(wr * 64 + fr, cole), boff = aoff + (wc * 2 - wr * 4) * 2048;
    typedef int _i8 __attribute__((ext_vector_type(8))); typedef _i8 _i8a __attribute__((aligned(16)));
    constexpr bool SP2 = true;
    unsigned vA_c[2][2];
    PG8_LAS unsigned* gtab = (PG8_LAS unsigned*)(lds + STAGE_BYTES + 1024);
#define PG8_FILLTAB(u) do { int _t = threadIdx.x; asm volatile("" : "+v"(_t));   if (_t < 256) { const int _m = (u).pm * 256 + _t; \
        const int _tok = (u).gat ? ((_m < (u).cnt) ? ((u).list[_m] >> 2) : 0) : _t;     \
        gtab[_t] = (unsigned)_tok * (unsigned)KB; } } while (0)
#define PG8_SETVA(v, u) do { int _t2 = threadIdx.x; if constexpr (GATHER) asm volatile("" : "+v"(_t2)); _Pragma("unroll") for (int _h = 0; _h < 2; ++_h) _Pragma("unroll") for (int _i = 0; _i < 2; ++_i) { \
        if constexpr (GATHER) { int _R, _C; stage_rc(_t2 * 16 + _i * 8192, _R, _C); (v)[_h][_i] = gtab[_h * 128 + _R] + (unsigned)(_C * 2); } \
        else (v)[_h][_i] = 0u; } } while (0)
#define PG8_STAGE_A(bufoff, gbase, h, nx) do { _Pragma("unroll") for (int _i = 0; _i < 2; ++_i) { \
        const char* _src = GATHER ? (const char*)(gbase) + vA_c[h][_i] : (const char*)(gbase) + (size_t)(h) * hstep + (size_t)_i * pstep + voffA0; \
        __builtin_amdgcn_global_load_lds((const unsigned*)_src, (PG8_LAS unsigned*)(lds + (bufoff) + ldsw + _i * 8192), 16, 0, 0); } } while (0)
#define PG8_SA(b, h) (((b) * 2 + (h)) * HTB)
#define PG8_SB(b, h) ((4 + (b) * 2 + (h)) * HTB)
#define PG8_STAGE(bufoff, gbase, voff) do { _Pragma("unroll") for (int _i = 0; _i < 2; ++_i) \
        __builtin_amdgcn_global_load_lds((const unsigned*)((const char*)(gbase) + (size_t)_i * pstep + voff##0), (PG8_LAS unsigned*)(lds + (bufoff) + ldsw + _i * 8192), 16, 0, 0); } while (0)
#define PG8_LDA(dst, b, h) do { _Pragma("unroll") for (int m = 0; m < 4; ++m) { \
        if constexpr (FP8) { dst##8[m] = *(const PG8_LAS _i8a*)(lds + PG8_SA(b, h) + aoff + m * 2048); } \
        else { _Pragma("unroll") for (int k = 0; k < 2; ++k) dst[m][k] = *(const PG8_LAS bf16x8*)(lds + PG8_SA(b, h) + aoff + m * 2048 + k * 1024); } } } while (0)
#define PG8_LDB(dst, b, h) do { _Pragma("unroll") for (int n = 0; n < 2; ++n) { \
        if constexpr (FP8) { dst##8[n] = *(const PG8_LAS _i8a*)(lds + PG8_SB(b, h) + boff + n * 2048); } \
        else { _Pragma("unroll") for (int k = 0; k < 2; ++k) dst[n][k] = *(const PG8_LAS bf16x8*)(lds + PG8_SB(b, h) + boff + n * 2048 + k * 1024); } } } while (0)
#define PG8_MMA(ai, bj, At, Bt) do { __builtin_amdgcn_s_setprio(1); _Pragma("unroll") for (int m = 0; m < 4; ++m) _Pragma("unroll") for (int n = 0; n < 2; ++n) { \
        if constexpr (FP8) acc[ai][bj][m][n] = __builtin_amdgcn_mfma_scale_f32_16x16x128_f8f6f4(Bt##8[n], At##8[m], acc[ai][bj][m][n], 0, 0, 0, 127, 0, 127); \
        else { _Pragma("unroll") for (int k = 0; k < 2; ++k) acc[ai][bj][m][n] = __builtin_amdgcn_mfma_f32_16x16x32_bf16(Bt[n][k], At[m][k], acc[ai][bj][m][n], 0, 0, 0); } } \
        __builtin_amdgcn_s_setprio(0); } while (0)
#define PG8_WAIT_V(n) asm volatile("s_waitcnt vmcnt(" #n ")" ::: "memory")
#define PG8_WAIT_L(n) asm volatile("s_waitcnt lgkmcnt(" #n ")" ::: "memory")
#define PG8_BAR __builtin_amdgcn_s_barrier()
#define PG8_SCHED __builtin_amdgcn_sched_barrier(0)
    Unit cur, nxt; int ui = 0;
    if (!S.next(0, cur)) return;
    f32x4 acc[2][2][4][2];
#pragma unroll
    for (int a = 0; a < 2; ++a)
#pragma unroll
        for (int b = 0; b < 2; ++b)
#pragma unroll
            for (int m = 0; m < 4; ++m)
#pragma unroll
                for (int n = 0; n < 2; ++n) acc[a][b][m][n] = (f32x4){0.f, 0.f, 0.f, 0.f};
    bf16x8 At[4][2], B0[2][2], B1[2][2]; _i8 At8[4], B08[2], B18[2];
    const char* cA = cur.A; const char* cB = cur.B;
    S.a_ready(cur);
    if constexpr (GATHER) { PG8_FILLTAB(cur); __syncthreads(); }
    PG8_SETVA(vA_c, cur);
    if constexpr (GATHER) __syncthreads();
    if constexpr (SP2) {
        PG8_STAGE(PG8_SB(0, 0), cB, voffB); PG8_STAGE(PG8_SB(0, 1), cB + hstep, voffB); PG8_STAGE_A(PG8_SA(0, 0), cA, 0, false); PG8_STAGE_A(PG8_SA(0, 1), cA, 1, false);
        if (wr == 1) PG8_BAR;
        PG8_WAIT_V(2); PG8_BAR;
        PG8_STAGE(PG8_SB(1, 0), cB + kstep, voffB); PG8_STAGE_A(PG8_SA(1, 0), cA + kstep, 0, false); PG8_STAGE(PG8_SB(1, 1), cB + hstep + kstep, voffB);
        PG8_WAIT_V(6); PG8_BAR;
    }
    for (;;) {
        const bool has_next = S.next(ui + 1, nxt);
        const char* nA = has_next ? nxt.A : cA; const char* nB = has_next ? nxt.B : cB;
        if constexpr (GATHER) { if (has_next) PG8_FILLTAB(nxt); }
        for (int t = 0; t < nt; t += 2) {
            const bool last = (t == nt - 2); const bool lastn = last && has_next; (void)lastn;
            const char* a1 = cA + (size_t)(t + 1) * kstep;
            const char* a2 = last ? nA : cA + (size_t)(t + 2) * kstep; const char* b2 = last ? nB : cB + (size_t)(t + 2) * kstep;
            const char* a3 = a2 + kstep; const char* b3 = b2 + kstep;
            if (last && has_next) S.a_ready(nxt);
            if constexpr (SP2) {
            PG8_LDB(B0, 0, 0); PG8_LDB(B1, 0, 1); PG8_SCHED; PG8_LDA(At, 0, 0); PG8_STAGE_A(PG8_SA(1, 1), a1, 1, false);
            PG8_WAIT_V(8); PG8_WAIT_L(0); PG8_BAR; PG8_MMA(0, 0, At, B0); PG8_MMA(0, 1, At, B1); PG8_BAR; PG8_SCHED;
            if constexpr (GATHER) { if (lastn) PG8_SETVA(vA_c, nxt); }
            PG8_LDA(At, 0, 1); PG8_STAGE(PG8_SB(0, 0), b2, voffB); PG8_STAGE(PG8_SB(0, 1), b2 + hstep, voffB); PG8_STAGE_A(PG8_SA(0, 0), a2, 0, lastn);
            PG8_WAIT_V(8); PG8_WAIT_L(0); PG8_BAR; PG8_MMA(1, 0, At, B0); PG8_MMA(1, 1, At, B1); PG8_BAR; PG8_SCHED;
            PG8_LDB(B0, 1, 0); PG8_LDB(B1, 1, 1); PG8_SCHED; PG8_LDA(At, 1, 0); PG8_STAGE_A(PG8_SA(0, 1), a2, 1, lastn);
            PG8_WAIT_V(8); PG8_WAIT_L(0); PG8_BAR; PG8_MMA(0, 0, At, B0); PG8_MMA(0, 1, At, B1); PG8_BAR; PG8_SCHED;
            PG8_LDA(At, 1, 1); PG8_STAGE(PG8_SB(1, 0), b3, voffB); PG8_STAGE(PG8_SB(1, 1), b3 + hstep, voffB); PG8_STAGE_A(PG8_SA(1, 0), a3, 0, lastn);
            PG8_WAIT_V(8); PG8_WAIT_L(0); PG8_BAR; PG8_MMA(1, 0, At, B0); PG8_MMA(1, 1, At, B1); PG8_BAR; PG8_SCHED;
            }
        }
        if constexpr (ALIGN_EPI) { if (wr == 0) PG8_BAR; }
        asm volatile("" ::: "memory");
        bool chained = false;
        if constexpr (!Epi::AFTER_DRAIN) { if constexpr (Epi::CHAIN) { if (cur.e == 0) { E.mid(acc, cur, wr, wc, fr, fq); chained = true; } else E(acc, cur, wr, wc, fr, fq); } else E(acc, cur, wr, wc, fr, fq); S.done(cur); }
        if (!has_next) break;
        if (!chained) {
#pragma unroll
        for (int a = 0; a < 2; ++a)
#pragma unroll
            for (int b = 0; b < 2; ++b)
#pragma unroll
                for (int m = 0; m < 4; ++m)
#pragma unroll
                    for (int n = 0; n < 2; ++n) acc[a][b][m][n] = (f32x4){0.f, 0.f, 0.f, 0.f};
        }
        cur = nxt; cA = nA; cB = nB; ++ui;
        if constexpr (ALIGN_EPI) { if (wr == 1) PG8_BAR; }
    }
    PG8_WAIT_V(0);
    if constexpr (!ALIGN_EPI) { if (wr == 0) PG8_BAR; }
    PG8_BAR;
    if constexpr (Epi::AFTER_DRAIN) { E.fused(acc, cur, wr, wc, fr, fq, lds, wid, lane); S.done(cur); }
#undef PG8_SA
#undef PG8_SB
#undef PG8_STAGE
#undef PG8_STAGE_A
#undef PG8_SETVA
#undef PG8_FILLTAB
#undef PG8_LDA
#undef PG8_LDB
#undef PG8_MMA
#undef PG8_WAIT_V
#undef PG8_WAIT_L
#undef PG8_BAR
#undef PG8_SCHED
}
}


typedef float f32x4_t __attribute__((ext_vector_type(4)));
__device__ __forceinline__ f32x4_t ld_bf4(const unsigned short* p) { const pg8::u32x2 v = *(const pg8::u32x2*)p; return (f32x4_t){__uint_as_float(v.x << 16), __uint_as_float(v.x & 0xffff0000u), __uint_as_float(v.y << 16), __uint_as_float(v.y & 0xffff0000u)}; }
__device__ __forceinline__ void ld_bf8(const unsigned short* p, f32x4_t& lo, f32x4_t& hi) { const pg8::u32x4 v = *(const pg8::u32x4*)p;
    lo = (f32x4_t){__uint_as_float(v.x << 16), __uint_as_float(v.x & 0xffff0000u), __uint_as_float(v.y << 16), __uint_as_float(v.y & 0xffff0000u)};
    hi = (f32x4_t){__uint_as_float(v.z << 16), __uint_as_float(v.z & 0xffff0000u), __uint_as_float(v.w << 16), __uint_as_float(v.w & 0xffff0000u)}; }
__device__ __forceinline__ float ld_bf1(const unsigned short* p) { return __uint_as_float((unsigned)(*p) << 16); }
struct SchedInProj {
    int G, c; const char* Abase; const char* Bt;
    __device__ __forceinline__ bool next(int i, pg8::Unit& u) const {
        int pm, pn; if (!pg8::static_order(T / 256, NT_IN, G, c, i, pm, pn)) return false;
        const int ai = pn < 29 ? 0 : pn < 33 ? 1 : pn < 37 ? 3 : pn < 41 ? 4 : pn == 41 ? 2 : pn == 42 ? 5 : 6;
        u.pm = pm; u.pn = pn; u.A = Abase + ((size_t)ai * T + (size_t)pm * 256) * D * 2; u.B = Bt + (size_t)pn * 256 * D * 2; u.list = nullptr; u.cnt = 0; u.e = 0; u.prow = 0; u.gat = 0; return true;
    }
    __device__ __forceinline__ void a_ready(const pg8::Unit&) const {}
    __device__ __forceinline__ void done(const pg8::Unit&) const {}
};
__device__ __forceinline__ float fast_sigmoid(float x) { return __builtin_amdgcn_rcpf(1.0f + __builtin_amdgcn_exp2f(-1.4426950408889634f * x)); }
__device__ __forceinline__ float fast_tanh(float x) { return 1.0f - 2.0f * __builtin_amdgcn_rcpf(1.0f + __builtin_amdgcn_exp2f(2.8853900817779268f * x)); }
struct EpiInProjF32 {
    static constexpr bool PERM = true, AFTER_DRAIN = false, CHAIN = false;
    unsigned short* PH; float* BA; unsigned short* LWA; unsigned short* LGB;
    __device__ __forceinline__ void operator()(const pg8::f32x4 (&acc)[2][2][4][2], const pg8::Unit& u, int wr, int wc, int fr, int fq) const {
        const int pn = u.pn; unsigned short* b16 = PH; unsigned ld = N_IN; int ncol = 256, act = 0;
        if (pn < 12) b16 = PH + pn * 256;
        else if (pn < 28) { b16 = PH + COL_GATE + (pn - 12) * 256; act = 2; }
        else if (pn == 28) { act = 4; ncol = 16; }
        else if (pn < 41) b16 = PH + COL_R + (pn - 29) * 256;
        else if (pn == 41) { act = 1; ncol = 128; b16 = LWA; ld = 256; }
        else if (pn == 42) { act = 3; ncol = 128; b16 = LWA + 128; ld = 256; }
        else { act = 2; b16 = LGB; ld = 256; }
        const unsigned row0 = (unsigned)u.pm * 256u + wr * 64 + fr;
#pragma unroll
        for (int ai = 0; ai < 2; ++ai)
#pragma unroll
            for (int m = 0; m < 4; ++m) {
                const unsigned row = row0 + ai * 128 + m * 16;
#pragma unroll
                for (int bj = 0; bj < 2; ++bj) {
                    const int cl = bj * 128 + wc * 32 + 8 * fq;
                    pg8::f32x4 v0 = acc[ai][bj][m][0], v1 = acc[ai][bj][m][1];
                    if (act == 4) { if (cl < ncol) { float* dst = BA + (size_t)row * 16 + cl; *(pg8::f32x4*)dst = v0; *(pg8::f32x4*)(dst + 4) = v1; } }
                    else {
                        if (act == 1) {
#pragma unroll
                            for (int j = 0; j < 4; ++j) { v0[j] = fast_tanh(v0[j]); v1[j] = fast_tanh(v1[j]); } }
                        if (act == 2) {
#pragma unroll
                            for (int j = 0; j < 4; ++j) { v0[j] = fast_sigmoid(v0[j]); v1[j] = fast_sigmoid(v1[j]); } }
                        if ((act == 1 || act == 3) && cl >= 96) { v0 = (pg8::f32x4){0.f, 0.f, 0.f, 0.f}; v1 = v0; }
                        if (cl < ncol) { pg8::u32x4 w; w.x = pg8::cvt_pk_bf16(v0[0], v0[1]); w.y = pg8::cvt_pk_bf16(v0[2], v0[3]); w.z = pg8::cvt_pk_bf16(v1[0], v1[1]); w.w = pg8::cvt_pk_bf16(v1[2], v1[3]);
                            *(pg8::u32x4*)(b16 + (size_t)row * ld + cl) = w; }
                    }
                }
            }
    }
};
struct SchedLora {
    int G, c; const char* LWA; const char* LGB; const char* L2T;
    __device__ __forceinline__ bool next(int i, pg8::Unit& u) const {
        int pm, pn; if (!pg8::static_order(T / 256, 12, G, c, i, pm, pn)) return false;
        const int g = pn >> 2;
        u.pm = pm; u.pn = pn; u.e = g; u.A = (g < 2 ? LWA : LGB) + (size_t)pm * 256 * 256 * 2; u.B = L2T + ((size_t)g * RW + (size_t)(pn & 3) * 256) * 256 * 2; u.list = nullptr; u.cnt = 0; u.prow = 0; u.gat = 0; return true;
    }
    __device__ __forceinline__ void a_ready(const pg8::Unit&) const {}
    __device__ __forceinline__ void done(const pg8::Unit&) const {}
};
__device__ __forceinline__ float fast_softplus(float x);
__device__ __forceinline__ float rw_decay(float w) { return __builtin_amdgcn_exp2f(-1.4426950408889634f * __builtin_amdgcn_exp2f(1.4426950408889634f * (-fast_softplus(-w) - 0.5f))); }
struct EpiLora {
    static constexpr bool PERM = true, AFTER_DRAIN = false, CHAIN = false;
    float* WPRE; float* APRE; float* GATE; const float* w0; const float* a0;
    __device__ __forceinline__ void operator()(const pg8::f32x4 (&acc)[2][2][4][2], const pg8::Unit& u, int wr, int wc, int fr, int fq) const {
        const int g = u.e; float* C = WPRE + (size_t)g * T * RW;        const float* bias = g == 0 ? w0 : a0;
        const unsigned row0 = (unsigned)u.pm * 256u + wr * 64 + fr; const int col0 = (u.pn & 3) * 256 + wc * 32 + 8 * fq;
        pg8::f32x4 bv[2][2];
#pragma unroll
        for (int bj = 0; bj < 2; ++bj)
#pragma unroll
            for (int n = 0; n < 2; ++n) bv[bj][n] = (g < 2) ? *(const pg8::f32x4*)(bias + col0 + 128 * bj + 4 * n) : (pg8::f32x4){0.f, 0.f, 0.f, 0.f};
#pragma unroll
        for (int ai = 0; ai < 2; ++ai)
#pragma unroll
            for (int m = 0; m < 4; ++m) {
                float* rp = C + (size_t)(row0 + ai * 128 + m * 16) * RW + col0;
#pragma unroll
                for (int bj = 0; bj < 2; ++bj) {
                    pg8::f32x4 v0 = acc[ai][bj][m][0] + bv[bj][0], v1 = acc[ai][bj][m][1] + bv[bj][1];
                    if (g == 0) { v0 = (pg8::f32x4){rw_decay(v0[0]), rw_decay(v0[1]), rw_decay(v0[2]), rw_decay(v0[3])}; v1 = (pg8::f32x4){rw_decay(v1[0]), rw_decay(v1[1]), rw_decay(v1[2]), rw_decay(v1[3])}; }
                    else if (g == 1) { v0 = (pg8::f32x4){fast_sigmoid(v0[0]), fast_sigmoid(v0[1]), fast_sigmoid(v0[2]), fast_sigmoid(v0[3])}; v1 = (pg8::f32x4){fast_sigmoid(v1[0]), fast_sigmoid(v1[1]), fast_sigmoid(v1[2]), fast_sigmoid(v1[3])}; }
                    if (g == 0) { *(pg8::f32x4*)(rp + 128 * bj) = v0; *(pg8::f32x4*)(rp + 128 * bj + 4) = v1; }
                    else {
                        unsigned short* r16 = (unsigned short*)(WPRE + (size_t)g * T * RW) + (size_t)(row0 + ai * 128 + m * 16) * RW + col0 + 128 * bj;
                        pg8::u32x4 w; w.x = pg8::cvt_pk_bf16(v0[0], v0[1]); w.y = pg8::cvt_pk_bf16(v0[2], v0[3]); w.z = pg8::cvt_pk_bf16(v1[0], v1[1]); w.w = pg8::cvt_pk_bf16(v1[2], v1[3]);
                        *(pg8::u32x4*)r16 = w;
                    }
                    __builtin_amdgcn_sched_barrier(0);
                }
            }
    }
};

struct SchedMoE {
    int G, c, nN, nrows; const LAS int* tab; const int* LIST; const char* Abase; const char* W; bool gatherA; int esz;
    __device__ __forceinline__ bool next(int i, pg8::Unit& u) const {
        const int L = i * G + c; const int total = __builtin_amdgcn_readfirstlane(tab[32]) * nN; if (L >= total) return false;
        int e = 0;
        for (int k = 1; k < NE; ++k) if (__builtin_amdgcn_readfirstlane(tab[k]) * nN <= L) e = k;
        const int t0 = __builtin_amdgcn_readfirstlane(tab[e]), t1 = __builtin_amdgcn_readfirstlane(tab[e + 1]);
        const int q = L - t0 * nN, mt = t1 - t0;
        u.pm = q % mt; u.pn = q / mt; u.e = e; u.cnt = __builtin_amdgcn_readfirstlane(tab[128 + e]); u.list = LIST + (size_t)e * T; u.prow = t0 * 256 + u.pm * 256;
        u.gat = gatherA ? 1 : 0; u.A = gatherA ? Abase : Abase + (size_t)u.prow * D * esz;
        u.B = W + ((size_t)e * nrows + (size_t)u.pn * 256) * D * esz; return true;
    }
    __device__ __forceinline__ void a_ready(const pg8::Unit&) const {}
    __device__ __forceinline__ void done(const pg8::Unit&) const {}
};
typedef float f32x2_t __attribute__((ext_vector_type(2)));
__device__ __forceinline__ f32x2_t swiglu2(f32x2_t ga, f32x2_t ua, f32x2_t bg, f32x2_t bu) {
    const f32x2_t g = ga * 0.015625f + bg, u = ua * 0.015625f + bu;
    const f32x2_t gl = {fminf(g[0], 7.0f), fminf(g[1], 7.0f)}, ul = {fminf(fmaxf(u[0], -7.0f), 7.0f), fminf(fmaxf(u[1], -7.0f), 7.0f)};
    const f32x2_t t = gl * (-1.702f * 1.4426950408889634f);
    const f32x2_t d = (f32x2_t){__builtin_amdgcn_exp2f(t[0]), __builtin_amdgcn_exp2f(t[1])} + 1.0f;
    const f32x2_t rc = {__builtin_amdgcn_rcpf(d[0]), __builtin_amdgcn_rcpf(d[1])};
    return (gl * rc) * (ul * 4.0f + 4.0f);
}
struct EpiGU {
    static constexpr bool PERM = true, AFTER_DRAIN = false, CHAIN = false;
    unsigned char* ACT; const float* bgu;
    __device__ __forceinline__ void operator()(const pg8::f32x4 (&acc)[2][2][4][2], const pg8::Unit& u, int wr, int wc, int fr, int fq) const {
        const float* bg = bgu + (size_t)u.e * 2 * FF; const int f0 = 128 * u.pn + 16 * wc + 4 * fq;
        pg8::f32x4 bgv[2], buv[2];
#pragma unroll
        for (int bj = 0; bj < 2; ++bj) { bgv[bj] = *(const pg8::f32x4*)(bg + f0 + 64 * bj); buv[bj] = *(const pg8::f32x4*)(bg + FF + f0 + 64 * bj); }
        const unsigned row0 = (unsigned)u.prow + wr * 64 + fr;
#pragma unroll
        for (int ai = 0; ai < 2; ++ai)
#pragma unroll
            for (int m = 0; m < 4; ++m) {
                const unsigned row = row0 + ai * 128 + m * 16;
#pragma unroll
                for (int bj = 0; bj < 2; ++bj) {
                    const pg8::f32x4 ga = acc[ai][bj][m][0], ua = acc[ai][bj][m][1];
                    const f32x2_t a01 = swiglu2((f32x2_t){ga[0], ga[1]}, (f32x2_t){ua[0], ua[1]}, (f32x2_t){bgv[bj][0], bgv[bj][1]}, (f32x2_t){buv[bj][0], buv[bj][1]});
                    const f32x2_t a23 = swiglu2((f32x2_t){ga[2], ga[3]}, (f32x2_t){ua[2], ua[3]}, (f32x2_t){bgv[bj][2], bgv[bj][3]}, (f32x2_t){buv[bj][2], buv[bj][3]});
                    int w8 = __builtin_amdgcn_cvt_pk_fp8_f32(a01[0], a01[1], 0, false); w8 = __builtin_amdgcn_cvt_pk_fp8_f32(a23[0], a23[1], w8, true);
                    *(int*)(ACT + (size_t)row * FF + f0 + 64 * bj) = w8;
                }
            }
    }
};
struct EpiDown {
    static constexpr bool PERM = true, AFTER_DRAIN = false, CHAIN = false;
    unsigned short* YB; const float* bd;
    __device__ __forceinline__ void operator()(const pg8::f32x4 (&acc)[2][2][4][2], const pg8::Unit& u, int wr, int wc, int fr, int fq) const {
        const float* b = bd + (size_t)u.e * D; const int col0 = u.pn * 256 + wc * 32 + 8 * fq;
        pg8::f32x4 bv[2][2];
#pragma unroll
        for (int bj = 0; bj < 2; ++bj)
#pragma unroll
            for (int n = 0; n < 2; ++n) bv[bj][n] = *(const pg8::f32x4*)(b + col0 + 128 * bj + 4 * n);
        const int ml0 = u.pm * 256 + wr * 64 + fr;
#pragma unroll
        for (int ai = 0; ai < 2; ++ai)
#pragma unroll
            for (int m = 0; m < 4; ++m) {
                const int ml = ml0 + ai * 128 + m * 16;
                if (ml < u.cnt) {
                    const unsigned asg = (unsigned)u.list[ml];
#pragma unroll
                    for (int bj = 0; bj < 2; ++bj) {
                        const pg8::f32x4 v0 = acc[ai][bj][m][0] * 0.00390625f + bv[bj][0], v1 = acc[ai][bj][m][1] * 0.00390625f + bv[bj][1];
                        pg8::u32x4 w; w.x = pg8::cvt_pk_bf16(v0[0], v0[1]); w.y = pg8::cvt_pk_bf16(v0[2], v0[3]); w.z = pg8::cvt_pk_bf16(v1[0], v1[1]); w.w = pg8::cvt_pk_bf16(v1[2], v1[3]);
                        *(pg8::u32x4*)(YB + (size_t)asg * D + col0 + 128 * bj) = w;
                    }
                }
            }
    }
};
__device__ __forceinline__ void moe_tables(LAS int* tab, const unsigned* CNT) {
    if (threadIdx.x == 0) {
        int acc = 0;
        for (int e = 0; e < NE; ++e) { const int c = (int)__hip_atomic_load(&CNT[e], __ATOMIC_RELAXED, __HIP_MEMORY_SCOPE_AGENT); tab[e] = acc; tab[64 + e] = acc * 256; tab[128 + e] = c; acc += (c + 255) >> 8; }
        tab[32] = acc; tab[96] = acc * 256;
    }
    __syncthreads();
}
__device__ __forceinline__ float bf2f(unsigned short h) { return __uint_as_float((unsigned)h << 16); }


__device__ __forceinline__ f32x4_t fmaxf_v(f32x4_t v) { return (f32x4_t){fmaxf(v[0], 1e-30f), fmaxf(v[1], 1e-30f), fmaxf(v[2], 1e-30f), fmaxf(v[3], 1e-30f)}; }
struct SchedUp {
    int G, c; const char* A0; const char* A1; const char* B0; const char* B1;
    __device__ __forceinline__ bool next(int i, pg8::Unit& u) const {
        int pm, pn; if (!pg8::static_order(T / 256, D / 256, G, c, i >> 1, pm, pn)) return false;
        const int sb = i & 1;
        u.pm = pm; u.pn = pn; u.e = sb; u.A = (sb ? A1 : A0) + (size_t)pm * 256 * RW * 2; u.B = (sb ? B1 : B0) + (size_t)pn * 256 * RW * 2; u.list = nullptr; u.cnt = 0; u.prow = 0; u.gat = 0; return true;
    }
    __device__ __forceinline__ void a_ready(const pg8::Unit&) const {}
    __device__ __forceinline__ void done(const pg8::Unit&) const {}
};
struct EpiUp {
    static constexpr bool PERM = true, AFTER_DRAIN = false, CHAIN = true;
    unsigned short* MB; const unsigned short* PH;
    __device__ __forceinline__ void mid(pg8::f32x4 (&acc)[2][2][4][2], const pg8::Unit& u, int wr, int wc, int fr, int fq) const {
        const unsigned row0 = (unsigned)u.pm * 256u + wr * 64 + fr; const int col0 = u.pn * 256 + wc * 32 + 8 * fq;
#pragma unroll
        for (int ai = 0; ai < 2; ++ai)
#pragma unroll
            for (int m = 0; m < 4; ++m) {
                const unsigned row = row0 + ai * 128 + m * 16;
#pragma unroll
                for (int bj = 0; bj < 2; ++bj) {
                    const int col = col0 + 128 * bj;
                    f32x4_t a0, a1, b0, b1; ld_bf8(PH + (size_t)row * N_IN + COL_GATE + col, a0, a1); ld_bf8(PH + (size_t)row * N_IN + COL_GATE + D + col, b0, b1);
#pragma unroll
                    for (int j = 0; j < 4; ++j) { acc[ai][bj][m][0][j] *= a0[j] * __builtin_amdgcn_rcpf(fmaxf(b0[j], 1e-30f)); acc[ai][bj][m][1][j] *= a1[j] * __builtin_amdgcn_rcpf(fmaxf(b1[j], 1e-30f)); }
                }
            }
    }
    __device__ __forceinline__ void operator()(const pg8::f32x4 (&acc)[2][2][4][2], const pg8::Unit& u, int wr, int wc, int fr, int fq) const {
        const unsigned row0 = (unsigned)u.pm * 256u + wr * 64 + fr; const int col0 = u.pn * 256 + wc * 32 + 8 * fq;
#pragma unroll
        for (int ai = 0; ai < 2; ++ai)
#pragma unroll
            for (int m = 0; m < 4; ++m) {
                const unsigned row = row0 + ai * 128 + m * 16;
#pragma unroll
                for (int bj = 0; bj < 2; ++bj) {
                    const int col = col0 + 128 * bj;
                    f32x4_t b0, b1; ld_bf8(PH + (size_t)row * N_IN + COL_GATE + D + col, b0, b1);
                    const pg8::f32x4 v0 = acc[ai][bj][m][0] * fmaxf_v(b0), v1 = acc[ai][bj][m][1] * fmaxf_v(b1);
                    pg8::u32x4 w; w.x = pg8::cvt_pk_bf16(v0[0], v0[1]); w.y = pg8::cvt_pk_bf16(v0[2], v0[3]); w.z = pg8::cvt_pk_bf16(v1[0], v1[1]); w.w = pg8::cvt_pk_bf16(v1[2], v1[3]);
                    *(pg8::u32x4*)(MB + (size_t)row * D + col) = w;
                }
            }
    }
};
struct SchedPlain {
    int G, c, nM, nN, K; const char* A; const char* B;
    __device__ __forceinline__ bool next(int i, pg8::Unit& u) const {
        int pm, pn; if (!pg8::static_order(nM, nN, G, c, i, pm, pn)) return false;
        u.pm = pm; u.pn = pn; u.e = 0; u.A = A + (size_t)pm * 256 * K * 2; u.B = B + (size_t)pn * 256 * K * 2; u.list = nullptr; u.cnt = 0; u.prow = 0; u.gat = 0; return true;
    }
    __device__ __forceinline__ void a_ready(const pg8::Unit&) const {}
    __device__ __forceinline__ void done(const pg8::Unit&) const {}
};
struct EpiF32 {
    static constexpr bool PERM = true, AFTER_DRAIN = false, CHAIN = false;
    unsigned short* C; int ldc;
    __device__ __forceinline__ void operator()(const pg8::f32x4 (&acc)[2][2][4][2], const pg8::Unit& u, int wr, int wc, int fr, int fq) const {
        const unsigned row0 = (unsigned)u.pm * 256u + wr * 64 + fr; const int col0 = u.pn * 256 + wc * 32 + 8 * fq;
#pragma unroll
        for (int ai = 0; ai < 2; ++ai)
#pragma unroll
            for (int m = 0; m < 4; ++m) {
                unsigned short* rp = C + (size_t)(row0 + ai * 128 + m * 16) * ldc + col0;
#pragma unroll
                for (int bj = 0; bj < 2; ++bj) { const pg8::f32x4 v0 = acc[ai][bj][m][0], v1 = acc[ai][bj][m][1];
                    pg8::u32x4 w; w.x = pg8::cvt_pk_bf16(v0[0], v0[1]); w.y = pg8::cvt_pk_bf16(v0[2], v0[3]); w.z = pg8::cvt_pk_bf16(v1[0], v1[1]); w.w = pg8::cvt_pk_bf16(v1[2], v1[3]);
                    *(pg8::u32x4*)(rp + 128 * bj) = w; }
            }
    }
};

#define LDS_WAIT() asm volatile("s_waitcnt lgkmcnt(0)" ::: "memory")
template <class F, class FK>
__device__ __forceinline__ void cvt_item_k(const float* __restrict__ W, int ldw, int K, const F& srccol, const FK& srcrow, unsigned short* WT, int row0, int kb, LAS float* scr, int lane) {
    const int n = lane & 31, k0 = kb * 64; const int sc = srccol(row0 + n);
#pragma unroll 8
    for (int i = 0; i < 32; ++i) { const int kk = 2 * i + (lane >> 5); const int sr = srcrow(k0 + kk); scr[kk * 33 + n] = (sc >= 0 && sr >= 0) ? W[(size_t)sr * ldw + sc] : 0.f; }
    LDS_WAIT();
    const int c = lane & 7;
#pragma unroll
    for (int j = 0; j < 4; ++j) { const int n2 = (lane >> 3) + 8 * j; const LAS float* sp = scr + (8 * c) * 33 + n2;
        pg8::u32x4 o; o.x = pg8::cvt_pk_bf16(sp[0 * 33], sp[1 * 33]); o.y = pg8::cvt_pk_bf16(sp[2 * 33], sp[3 * 33]); o.z = pg8::cvt_pk_bf16(sp[4 * 33], sp[5 * 33]); o.w = pg8::cvt_pk_bf16(sp[6 * 33], sp[7 * 33]);
        *(pg8::u32x4*)(WT + (size_t)(row0 + n2) * K + k0 + 8 * c) = o; }
    LDS_WAIT();
}
template <class F>
__device__ __forceinline__ void cvt_item(const float* __restrict__ W, int ldw, int K, const F& srccol, unsigned short* WT, int row0, int kb, LAS float* scr, int lane) {
    auto idk = [](int k) { return k; };
    cvt_item_k(W, ldw, K, srccol, idk, WT, row0, kb, scr, lane);
}
template <class FM, class FK>
__device__ __forceinline__ void cvt64(const float* __restrict__ W, int ldw, int K, const FM& map4, const FK& srcrow, unsigned short* __restrict__ WT, int row0, int kb, int lane) {
    const int n4 = lane & 15, kg = lane >> 4, k0 = kb * 64 + 16 * kg;
    int sc, dr; map4(row0, n4, sc, dr);
    f32x4_t v[16];
#pragma unroll
    for (int kk = 0; kk < 16; ++kk) { const int sr = srcrow(k0 + kk); v[kk] = (sc >= 0 && sr >= 0) ? *(const f32x4_t*)(W + (size_t)sr * ldw + sc) : (f32x4_t){0.f, 0.f, 0.f, 0.f}; }
#pragma unroll
    for (int j = 0; j < 4; ++j) {
        pg8::u32x4 o0, o1;
        o0.x = pg8::cvt_pk_bf16(v[0][j], v[1][j]); o0.y = pg8::cvt_pk_bf16(v[2][j], v[3][j]); o0.z = pg8::cvt_pk_bf16(v[4][j], v[5][j]); o0.w = pg8::cvt_pk_bf16(v[6][j], v[7][j]);
        o1.x = pg8::cvt_pk_bf16(v[8][j], v[9][j]); o1.y = pg8::cvt_pk_bf16(v[10][j], v[11][j]); o1.z = pg8::cvt_pk_bf16(v[12][j], v[13][j]); o1.w = pg8::cvt_pk_bf16(v[14][j], v[15][j]);
        unsigned short* dst = WT + (size_t)(dr + j) * K + k0;
        *(pg8::u32x4*)dst = o0; *(pg8::u32x4*)(dst + 8) = o1;
    }
}
template <class FM, class FK>
__device__ __forceinline__ void cvt64_f8(const float* __restrict__ W, int ldw, int K, const FM& map4, const FK& srcrow, unsigned char* __restrict__ WT, int row0, int kb, int lane, float scale) {
    const int n4 = lane & 15, kg = lane >> 4, k0 = kb * 64 + 16 * kg;
    int sc, dr; map4(row0, n4, sc, dr);
    f32x4_t v[16];
#pragma unroll
    for (int kk = 0; kk < 16; ++kk) { const int sr = srcrow(k0 + kk); v[kk] = (sc >= 0 && sr >= 0) ? *(const f32x4_t*)(W + (size_t)sr * ldw + sc) * scale : (f32x4_t){0.f, 0.f, 0.f, 0.f}; }
#pragma unroll
    for (int j = 0; j < 4; ++j) {
        pg8::u32x4 o;
#pragma unroll
        for (int q = 0; q < 4; ++q) { int w = __builtin_amdgcn_cvt_pk_fp8_f32(v[4 * q][j], v[4 * q + 1][j], 0, false); w = __builtin_amdgcn_cvt_pk_fp8_f32(v[4 * q + 2][j], v[4 * q + 3][j], w, true); o[q] = (unsigned)w; }
        *(pg8::u32x4*)(WT + (size_t)(dr + j) * K + k0) = o;
    }
}
__device__ __forceinline__ void inproj_src(int r, int& mat, int& col) {
    mat = 0; col = -1;
    if (r < 3072) col = r;
    else if (r < 7168) col = COL_GATE + (r - 3072);
    else if (r < 7424) { if (r - 7168 < 16) col = COL_B + (r - 7168); }
    else if (r < 10496) col = COL_R + (r - 7424);
    else if (r < 10752) { mat = 1; if (r - 10496 < 96) col = r - 10496; }
    else if (r < 11008) { mat = 2; if (r - 10752 < 96) col = r - 10752; }
    else { mat = 3; col = r - 11008; }
}

typedef short bf16x8_t __attribute__((ext_vector_type(8)));
typedef unsigned short LAS* lds_u16p;
__device__ __forceinline__ f32x4_t mma16(bf16x8_t a, bf16x8_t b, f32x4_t c) { return __builtin_amdgcn_mfma_f32_16x16x32_bf16(a, b, c, 0, 0, 0); }
__device__ __forceinline__ bf16x8_t ldfrag(const LAS unsigned short* M, int ld, int r0, int k0, int lane) { return *(const LAS bf16x8_t*)(M + (r0 + (lane & 15)) * ld + k0 + 8 * (lane >> 4)); }
__device__ __forceinline__ bf16x8_t ldfragT(const LAS unsigned short* M, int t, int ks, int lane) { return *(const LAS bf16x8_t*)(M + (16 * t + (lane & 15)) * 72 + (((4 * ks + (lane >> 4)) ^ (t & 7)) << 3)); }
__device__ __forceinline__ unsigned short f2bf(float x) { return (unsigned short)(pg8::cvt_pk_bf16(x, x) & 0xffffu); }
constexpr int GR_QG = 0, GR_W = 16384, GR_KDT = 32768, GR_AI = 49152, GR_U = 57344, GR_MISC = 90112, GR_BYTES = 90368;
constexpr int GL_SM2 = 130560;
constexpr int GL_KB = 0, GL_QB = 17408, GL_VT = 34816, GL_KST = 53248, GL_KDT = 71680, GL_LM = 90112, GL_TI = 107520, GL_AI = 116736, GL_SM = 125952;

__device__ __forceinline__ void tri_inverse_64(const LAS float* Lm, LAS unsigned short* Ti, LAS float* Dg, int lane) {
    const int g = lane >> 4, n = lane & 15;
    {
        float x[16];
        const LAS float* Lb = Lm + (16 * g) * 68 + 16 * g;
#pragma unroll
        for (int i = 0; i < 16; ++i) {
            float s0 = 0.f, s1 = 0.f, s2 = 0.f, s3 = 0.f;
#pragma unroll
            for (int j4 = 0; j4 < (i + 3) / 4; ++j4) {
                const f32x4_t l4 = *(const LAS f32x4_t*)(Lb + i * 68 + 4 * j4);
                if (4 * j4 + 0 < i) s0 = fmaf(l4[0], x[4 * j4 + 0], s0);
                if (4 * j4 + 1 < i) s1 = fmaf(l4[1], x[4 * j4 + 1], s1);
                if (4 * j4 + 2 < i) s2 = fmaf(l4[2], x[4 * j4 + 2], s2);
                if (4 * j4 + 3 < i) s3 = fmaf(l4[3], x[4 * j4 + 3], s3);
            }
            x[i] = ((n == i) ? 1.0f : 0.0f) - ((s0 + s1) + (s2 + s3));
        }
#pragma unroll
        for (int i = 0; i < 16; ++i) { Dg[g * 256 + i * 16 + n] = x[i]; Ti[(16 * g + i) * 72 + 16 * g + n] = f2bf(x[i]); }
#pragma unroll
        for (int bi = 0; bi < 3; ++bi)
#pragma unroll
            for (int bj = bi + 1; bj < 4; ++bj)
#pragma unroll
                for (int r = 0; r < 4; ++r) Ti[(16 * bi + 4 * g + r) * 72 + 16 * bj + n] = 0;
    }
    auto ldA = [&](int bi, int bk) -> f32x4_t { return *(const LAS f32x4_t*)(Lm + (16 * bi + n) * 68 + 16 * bk + 4 * g); };
    auto ldD = [&](int b) -> f32x4_t { return *(const LAS f32x4_t*)(Dg + b * 256 + n * 16 + 4 * g); };
    auto ldDB = [&](int b) -> f32x4_t { f32x4_t v; v[0] = Dg[b * 256 + (4 * g + 0) * 16 + n]; v[1] = Dg[b * 256 + (4 * g + 1) * 16 + n]; v[2] = Dg[b * 256 + (4 * g + 2) * 16 + n]; v[3] = Dg[b * 256 + (4 * g + 3) * 16 + n]; return v; };
    auto mm = [&](f32x4_t av, f32x4_t bv, f32x4_t c) -> f32x4_t {
        c = __builtin_amdgcn_mfma_f32_16x16x4f32(av[0], bv[0], c, 0, 0, 0); c = __builtin_amdgcn_mfma_f32_16x16x4f32(av[1], bv[1], c, 0, 0, 0);
        c = __builtin_amdgcn_mfma_f32_16x16x4f32(av[2], bv[2], c, 0, 0, 0); c = __builtin_amdgcn_mfma_f32_16x16x4f32(av[3], bv[3], c, 0, 0, 0); return c; };
    auto put = [&](int bi, int bj, f32x4_t xv) {
#pragma unroll
        for (int r = 0; r < 4; ++r) Ti[(16 * bi + 4 * g + r) * 72 + 16 * bj + n] = f2bf(xv[r]); };
    const f32x4_t z = {0.f, 0.f, 0.f, 0.f};
    const f32x4_t x00 = ldDB(0), x11 = ldDB(1), x22 = ldDB(2);
    const f32x4_t d1 = ldD(1), d2 = ldD(2), d3 = ldD(3);
    const f32x4_t x10 = -mm(d1, mm(ldA(1, 0), x00, z), z);
    const f32x4_t x21 = -mm(d2, mm(ldA(2, 1), x11, z), z);
    const f32x4_t x32 = -mm(d3, mm(ldA(3, 2), x22, z), z);
    const f32x4_t x20 = -mm(d2, mm(ldA(2, 1), x10, mm(ldA(2, 0), x00, z)), z);
    const f32x4_t x31 = -mm(d3, mm(ldA(3, 2), x21, mm(ldA(3, 1), x11, z)), z);
    const f32x4_t x30 = -mm(d3, mm(ldA(3, 2), x20, mm(ldA(3, 1), x10, mm(ldA(3, 0), x00, z))), z);
    put(1, 0, x10); put(2, 1, x21); put(3, 2, x32); put(2, 0, x20); put(3, 1, x31); put(3, 0, x30);
}

__device__ __forceinline__ void allred16x4(float& a, float& b, float& c, float& d) {
    asm volatile("s_nop 1\n\t"
        "v_add_f32_dpp %0, %0, %0 quad_perm:[1,0,3,2] row_mask:0xf bank_mask:0xf bound_ctrl:1\n\tv_add_f32_dpp %1, %1, %1 quad_perm:[1,0,3,2] row_mask:0xf bank_mask:0xf bound_ctrl:1\n\t"
        "v_add_f32_dpp %2, %2, %2 quad_perm:[1,0,3,2] row_mask:0xf bank_mask:0xf bound_ctrl:1\n\tv_add_f32_dpp %3, %3, %3 quad_perm:[1,0,3,2] row_mask:0xf bank_mask:0xf bound_ctrl:1\n\t"
        "v_add_f32_dpp %0, %0, %0 quad_perm:[2,3,0,1] row_mask:0xf bank_mask:0xf bound_ctrl:1\n\tv_add_f32_dpp %1, %1, %1 quad_perm:[2,3,0,1] row_mask:0xf bank_mask:0xf bound_ctrl:1\n\t"
        "v_add_f32_dpp %2, %2, %2 quad_perm:[2,3,0,1] row_mask:0xf bank_mask:0xf bound_ctrl:1\n\tv_add_f32_dpp %3, %3, %3 quad_perm:[2,3,0,1] row_mask:0xf bank_mask:0xf bound_ctrl:1\n\t"
        "v_add_f32_dpp %0, %0, %0 row_half_mirror row_mask:0xf bank_mask:0xf bound_ctrl:1\n\tv_add_f32_dpp %1, %1, %1 row_half_mirror row_mask:0xf bank_mask:0xf bound_ctrl:1\n\t"
        "v_add_f32_dpp %2, %2, %2 row_half_mirror row_mask:0xf bank_mask:0xf bound_ctrl:1\n\tv_add_f32_dpp %3, %3, %3 row_half_mirror row_mask:0xf bank_mask:0xf bound_ctrl:1\n\t"
        "v_add_f32_dpp %0, %0, %0 row_mirror row_mask:0xf bank_mask:0xf bound_ctrl:1\n\tv_add_f32_dpp %1, %1, %1 row_mirror row_mask:0xf bank_mask:0xf bound_ctrl:1\n\t"
        "v_add_f32_dpp %2, %2, %2 row_mirror row_mask:0xf bank_mask:0xf bound_ctrl:1\n\tv_add_f32_dpp %3, %3, %3 row_mirror row_mask:0xf bank_mask:0xf bound_ctrl:1\n\ts_nop 1"
        : "+v"(a), "+v"(b), "+v"(c), "+v"(d));
}
__device__ __forceinline__ void gdn_a0_fin(int hv, float araw, float braw, const float* __restrict__ A_log, const float* __restrict__ dt_bias, LAS float* gcs, LAS float* betas, int lane);
__device__ __forceinline__ void gdn_a0(int item, const float* __restrict__ BA, const float* __restrict__ A_log, const float* __restrict__ dt_bias, LAS float* gcs, LAS float* betas, int lane) {
    const int hv = (item >> 6) & 7; const size_t tn = (size_t)(item >> 9) * SEQ + (item & 63) * 64 + lane;
    gdn_a0_fin(hv, BA[tn * 16 + 8 + hv], BA[tn * 16 + hv], A_log, dt_bias, gcs, betas, lane);
}
__device__ __forceinline__ void gdn_a0_fin(int hv, float araw, float braw, const float* __restrict__ A_log, const float* __restrict__ dt_bias, LAS float* gcs, LAS float* betas, int lane) {
    float g = -expf(A_log[hv]) * softplusf_(araw + dt_bias[hv]);
#pragma unroll
    for (int o = 1; o < 64; o <<= 1) { const float t = __shfl_up(g, o); if (lane >= o) g += t; }
    gcs[lane] = g; betas[lane] = sigmoidf_(braw);
}
#define A1_CB(mtx, it_) const int hv_ = ((it_) >> 6) & 7, qh_ = hv_ >> 1; const int cb_ = (((mtx) == 0) ? qh_ * 128 : ((mtx) == 1) ? COL_K + qh_ * 128 : COL_V + hv_ * 128) + 4 * cg;
#define A1_LOADW(mtx, it_, wv) do { A1_CB(mtx, it_) \
        _Pragma("unroll") for (int j = 0; j < 4; ++j) wv[j] = *(const f32x4_t*)(convw + j * 2048 + cb_); } while (0)
#define A1_LOADX(mtx, it_, xr) do { A1_CB(mtx, it_) const int s0_ = ((it_) & 63) * 64; const size_t t0_ = (size_t)((it_) >> 9) * SEQ + s0_; \
        _Pragma("unroll") for (int q = 0; q < 7; ++q) { const int rr_ = r0 - 3 + q; const size_t tr_ = (s0_ + rr_ >= 0) ? (size_t)((long long)t0_ + rr_) : t0_; xr[q] = *(const pg8::u32x2*)(PH + tr_ * N_IN + cb_); } } while (0)
__device__ __forceinline__ int gdn_item_of(int k) { const int combo = k >> 3; return ((combo >> 6) << 9) | ((k & 7) << 6) | (combo & 63); }

__device__ __forceinline__ void gdn_prep_item(int item, int item_next, int par, LAS unsigned char* lds, const unsigned short* __restrict__ PH, const float* __restrict__ BA, const float* __restrict__ convw, const float* __restrict__ A_log, const float* __restrict__ dt_bias, unsigned char* __restrict__ recs, pg8::u32x2 (&xn)[3][7], f32x4_t (&wn)[3][4]) {
    int tid_ = threadIdx.x; asm volatile("" : "+v"(tid_));
    const int tid = tid_, lane = tid & 63, wave = __builtin_amdgcn_readfirstlane(tid >> 6);
    const int ch = item & 63, hv = (item >> 6) & 7;
    const int s0 = ch * 64;
    unsigned char* rec = recs + (size_t)item * GR_BYTES;
    LAS unsigned short* Kb = (LAS unsigned short*)(lds + GL_KB); LAS unsigned short* Qb = (LAS unsigned short*)(lds + GL_QB);
    LAS unsigned short* VT = (LAS unsigned short*)(lds + GL_VT); LAS unsigned short* KsT = (LAS unsigned short*)(lds + GL_KST); LAS unsigned short* KdT = (LAS unsigned short*)(lds + GL_KDT);
    LAS float* Lm = (LAS float*)(lds + GL_LM); LAS unsigned short* Ti = (LAS unsigned short*)(lds + GL_TI); LAS unsigned short* Ai = (LAS unsigned short*)(lds + GL_AI);
    LAS float* gcs = (LAS float*)(lds + (par ? GL_SM2 : GL_SM)); LAS float* betas = gcs + 64;
    LAS float* gcs_n = (LAS float*)(lds + (par ? GL_SM : GL_SM2));
    const int cg = tid & 31, rg = tid >> 5, r0 = 4 * rg;
    {
        const f32x4_t zero4 = {0.f, 0.f, 0.f, 0.f};
        float eg[4], ekd[4], br[4];
        { const float glast = gcs[63];
#pragma unroll
          for (int r = 0; r < 4; ++r) { const float gcr = gcs[r0 + r]; br[r] = betas[r0 + r]; eg[r] = __builtin_amdgcn_exp2f(1.4426950408889634f * gcr); ekd[r] = __builtin_amdgcn_exp2f(1.4426950408889634f * (glast - gcr)); } }
        const int swz = (cg >> 2) & 7, tq = rg >> 1, to = 4 * (rg & 1);
#define A1_BODY(mtx, xr, wv) do { f32x4_t xv[7], acc[4]; float rn[4]; \
        _Pragma("unroll") for (int q = 0; q < 7; ++q) { const f32x4_t v_ = (f32x4_t){__uint_as_float(xr[q].x << 16), __uint_as_float(xr[q].x & 0xffff0000u), __uint_as_float(xr[q].y << 16), __uint_as_float(xr[q].y & 0xffff0000u)}; xv[q] = (s0 + r0 - 3 + q >= 0) ? v_ : zero4; } \
        _Pragma("unroll") for (int r = 0; r < 4; ++r) { acc[r] = wv[0] * xv[r] + wv[1] * xv[r + 1] + wv[2] * xv[r + 2] + wv[3] * xv[r + 3]; \
            _Pragma("unroll") for (int i = 0; i < 4; ++i) acc[r][i] = acc[r][i] * fast_sigmoid(acc[r][i]); \
            rn[r] = acc[r][0] * acc[r][0] + acc[r][1] * acc[r][1] + acc[r][2] * acc[r][2] + acc[r][3] * acc[r][3]; } \
        allred16x4(rn[0], rn[1], rn[2], rn[3]); \
        _Pragma("unroll") for (int r = 0; r < 4; ++r) rn[r] = rsqrtf(rn[r] + __shfl_xor(rn[r], 16) + 1e-6f); \
        if ((mtx) == 0) { _Pragma("unroll") for (int r = 0; r < 4; ++r) { const f32x4_t qv = acc[r] * (rn[r] * 0.08838834764831845f); *(LAS pg8::u32x2*)(Qb + (r0 + r) * 136 + 4 * cg) = (pg8::u32x2){pg8::cvt_pk_bf16(qv[0], qv[1]), pg8::cvt_pk_bf16(qv[2], qv[3])}; } } \
        else if ((mtx) == 1) { _Pragma("unroll") for (int r = 0; r < 4; ++r) { acc[r] = acc[r] * rn[r]; *(LAS pg8::u32x2*)(Kb + (r0 + r) * 136 + 4 * cg) = (pg8::u32x2){pg8::cvt_pk_bf16(acc[r][0], acc[r][1]), pg8::cvt_pk_bf16(acc[r][2], acc[r][3])}; } \
            _Pragma("unroll") for (int i = 0; i < 4; ++i) { const int ofs_ = (4 * cg + i) * 72 + ((tq ^ swz) << 3) + to; \
                *(LAS pg8::u32x2*)(KsT + ofs_) = (pg8::u32x2){pg8::cvt_pk_bf16(br[0] * eg[0] * acc[0][i], br[1] * eg[1] * acc[1][i]), pg8::cvt_pk_bf16(br[2] * eg[2] * acc[2][i], br[3] * eg[3] * acc[3][i])}; \
                *(LAS pg8::u32x2*)(KdT + ofs_) = (pg8::u32x2){pg8::cvt_pk_bf16(ekd[0] * acc[0][i], ekd[1] * acc[1][i]), pg8::cvt_pk_bf16(ekd[2] * acc[2][i], ekd[3] * acc[3][i])}; } } \
        else { _Pragma("unroll") for (int i = 0; i < 4; ++i) { const int ofs_ = (4 * cg + i) * 72 + ((tq ^ swz) << 3) + to; \
                *(LAS pg8::u32x2*)(VT + ofs_) = (pg8::u32x2){pg8::cvt_pk_bf16(br[0] * acc[0][i], br[1] * acc[1][i]), pg8::cvt_pk_bf16(br[2] * acc[2][i], br[3] * acc[3][i])}; } } } while (0)
        A1_BODY(0, xn[0], wn[0]);
        A1_BODY(1, xn[1], wn[1]);
        A1_BODY(2, xn[2], wn[2]);
#undef A1_BODY
    }
    __syncthreads();
    float pa_n = 0.f, pb_n = 0.f;
    if (item_next < 2048) {
        if (((item_next >> 6) & 7) != hv) { A1_LOADW(0, item_next, wn[0]); A1_LOADW(1, item_next, wn[1]); A1_LOADW(2, item_next, wn[2]); }
        A1_LOADX(0, item_next, xn[0]);
        if (wave == 7) { const int hvn = (item_next >> 6) & 7; const size_t tn = (size_t)(item_next >> 9) * SEQ + (item_next & 63) * 64 + lane; pa_n = BA[tn * 16 + 8 + hvn]; pb_n = BA[tn * 16 + hvn]; }
    }
    __builtin_amdgcn_sched_barrier(0);
    {
        const int mat = wave >> 2, ti = wave & 3, g4 = lane >> 4, n = lane & 15;
        const LAS unsigned short* Am = mat ? Qb : Kb;
        float gi[4], bi[4], gj[4];
#pragma unroll
        for (int r = 0; r < 4; ++r) { gi[r] = gcs[16 * ti + 4 * g4 + r]; bi[r] = betas[16 * ti + 4 * g4 + r]; gj[r] = gcs[16 * r + n]; }
#pragma unroll
        for (int tj = 0; tj < 4; ++tj) {
            f32x4_t acc = {0.f, 0.f, 0.f, 0.f};
#pragma unroll
            for (int ks = 0; ks < 4; ++ks) acc = mma16(ldfrag(Am, 136, 16 * ti, 32 * ks, lane), ldfrag(Kb, 136, 16 * tj, 32 * ks, lane), acc);
            const int j = 16 * tj + n;
#pragma unroll
            for (int r = 0; r < 4; ++r) {
                const int i = 16 * ti + 4 * g4 + r; const float dec = __builtin_amdgcn_exp2f(1.4426950408889634f * fminf(gi[r] - gj[tj], 0.f));
                const float vl = bi[r] * acc[r] * dec, va = acc[r] * dec;
                if (mat == 0) Lm[i * 68 + j] = (j < i) ? vl : 0.f;
                else Ai[i * 72 + j] = f2bf((j <= i) ? va : 0.f);
            }
        }
    }
    __syncthreads();
    if (wave == 0) { tri_inverse_64(Lm, Ti, (LAS float*)(lds + 126464), lane); if (item_next < 2048) A1_LOADX(1, item_next, xn[1]); }
    else {
        if (wave == 7 && item_next < 2048) gdn_a0_fin((item_next >> 6) & 7, pa_n, pb_n, A_log, dt_bias, gcs_n, gcs_n + 64, lane);
        if (item_next < 2048) A1_LOADX(1, item_next, xn[1]);
        for (int e = tid - 64; e < 64 * 128; e += NTHREADS - 64) { const int row = e >> 7, c = e & 127; const float qv = bf2f(Qb[row * 136 + c]); Qb[row * 136 + c] = f2bf(qv * __builtin_amdgcn_exp2f(1.4426950408889634f * gcs[row])); }
    }
    __syncthreads();
    if (item_next < 2048) A1_LOADX(2, item_next, xn[2]);
    __builtin_amdgcn_sched_barrier(0);
    {
        const int g4 = lane >> 4, n = lane & 15;
#pragma unroll
        for (int t2 = 0; t2 < 2; ++t2) {
            const int tn = 2 * wave + t2; const LAS unsigned short* Bt = (tn < 8) ? VT : KsT; const int tb = tn & 7;
#pragma unroll
            for (int ti = 0; ti < 4; ++ti) {
                f32x4_t acc = {0.f, 0.f, 0.f, 0.f};
#pragma unroll
                for (int ks = 0; ks < 2; ++ks) acc = mma16(ldfrag(Ti, 72, 16 * ti, 32 * ks, lane), ldfragT(Bt, tb, ks, lane), acc);
                if (tn < 8) *(f32x4_t*)(rec + GR_U + ((size_t)((ti * 8 + tb) * 64 + lane)) * 16) = acc;
                else {
#pragma unroll
                    for (int r = 0; r < 4; ++r) Kb[(16 * ti + 4 * g4 + r) * 136 + 16 * tb + n] = f2bf(acc[r]);
                }
            }
        }
    }
    __syncthreads();
    {
#pragma unroll
        for (int t2 = 0; t2 < 2; ++t2) {
            const int f = 2 * wave + t2;
            { const int ti = f >> 2, ks = f & 3;
              *(bf16x8_t*)(rec + GR_QG + (size_t)(f * 64 + lane) * 16) = ldfrag(Qb, 136, 16 * ti, 32 * ks, lane);
              *(bf16x8_t*)(rec + GR_W + (size_t)(f * 64 + lane) * 16) = ldfrag(Kb, 136, 16 * ti, 32 * ks, lane); }
            { const int td = f >> 1, ks = f & 1;
              *(bf16x8_t*)(rec + GR_KDT + (size_t)(f * 64 + lane) * 16) = ldfragT(KdT, td, ks, lane); }
        }
        { const int f = wave, ti = f >> 1, ks = f & 1;
          *(bf16x8_t*)(rec + GR_AI + (size_t)(f * 64 + lane) * 16) = ldfrag(Ai, 72, 16 * ti, 32 * ks, lane); }
        if (tid == 0) *(float*)(rec + GR_MISC) = expf(gcs[63]);
    }
    __syncthreads();
}

__device__ __forceinline__ void gdn_scan_seq(int seq, LAS unsigned char* lds, const unsigned char* __restrict__ recs, const unsigned short* __restrict__ PH, const float* __restrict__ gdn_norm, unsigned short* __restrict__ YGB) {
    const int tid = threadIdx.x, lane = tid & 63, wave = __builtin_amdgcn_readfirstlane(tid >> 6), g4 = lane >> 4, n = lane & 15;
    const int b = seq >> 3, hv = seq & 7;
    LAS unsigned short* St = (LAS unsigned short*)lds;
    LAS unsigned short* VnT = (LAS unsigned short*)(lds + 34816);
    LAS unsigned short* Zb = (LAS unsigned short*)(lds + 53248);
    const int zrow = tid >> 3, zseg = tid & 7;
    const unsigned short* zsrc = PH + ((size_t)b * SEQ + zrow) * N_IN + COL_Z + hv * 128 + zseg * 16;
    pg8::u32x4 zr0 = *(const pg8::u32x4*)zsrc, zr1 = *(const pg8::u32x4*)(zsrc + 8);
    float gnv[8];
#pragma unroll
    for (int tv = 0; tv < 8; ++tv) gnv[tv] = gdn_norm[16 * tv + n];
    *(LAS pg8::u32x4*)(Zb + zrow * 136 + zseg * 16) = zr0; *(LAS pg8::u32x4*)(Zb + zrow * 136 + zseg * 16 + 8) = zr1;
    for (int e = tid; e < 128 * 136; e += NTHREADS) St[e] = 0;
    f32x4_t S[8];
#pragma unroll
    for (int tv = 0; tv < 8; ++tv) S[tv] = (f32x4_t){0.f, 0.f, 0.f, 0.f};
    __syncthreads();
    const int ti = wave & 3;
    bf16x8_t nafr[4], nkfr[2], naifr[2]; f32x4_t nu[8]; float neg;
#define GS_LOAD(chv) do { const unsigned char* _r = recs + ((size_t)seq * 64 + (chv)) * GR_BYTES; \
        _Pragma("unroll") for (int ks = 0; ks < 4; ++ks) nafr[ks] = *(const bf16x8_t*)(_r + (wave < 4 ? GR_QG : GR_W) + (size_t)((ti * 4 + ks) * 64 + lane) * 16); \
        _Pragma("unroll") for (int ks = 0; ks < 2; ++ks) { nkfr[ks] = *(const bf16x8_t*)(_r + GR_KDT + (size_t)((wave * 2 + ks) * 64 + lane) * 16); naifr[ks] = *(const bf16x8_t*)(_r + GR_AI + (size_t)((ti * 2 + ks) * 64 + lane) * 16); } \
        if (wave >= 4) { _Pragma("unroll") for (int tv = 0; tv < 8; ++tv) nu[tv] = *(const f32x4_t*)(_r + GR_U + (size_t)((ti * 8 + tv) * 64 + lane) * 16); } \
        neg = *(const float*)(_r + GR_MISC); } while (0)
    GS_LOAD(0);
    for (int ch = 0; ch < 64; ++ch) {
        bf16x8_t afr[4], kfr[2], aifr[2]; f32x4_t ucur[8];
#pragma unroll
        for (int ks = 0; ks < 4; ++ks) afr[ks] = nafr[ks];
#pragma unroll
        for (int ks = 0; ks < 2; ++ks) { kfr[ks] = nkfr[ks]; aifr[ks] = naifr[ks]; }
#pragma unroll
        for (int tv = 0; tv < 8; ++tv) ucur[tv] = nu[tv];
        const float eg = neg;
        if (ch + 1 < 64) { GS_LOAD(ch + 1); const unsigned short* zp = zsrc + (size_t)(ch + 1) * 64 * N_IN; zr0 = *(const pg8::u32x4*)zp; zr1 = *(const pg8::u32x4*)(zp + 8); }
        f32x4_t acc1[8];
#pragma unroll
        for (int tv = 0; tv < 8; ++tv) {
            f32x4_t a = {0.f, 0.f, 0.f, 0.f};
#pragma unroll
            for (int ks = 0; ks < 4; ++ks) a = mma16(afr[ks], ldfrag(St, 136, 16 * tv, 32 * ks, lane), a);
            acc1[tv] = a;
        }
        if (wave >= 4) {
#pragma unroll
            for (int tv = 0; tv < 8; ++tv) {
                const f32x4_t vn = ucur[tv] - acc1[tv];
                pg8::u32x2 w2; w2.x = pg8::cvt_pk_bf16(vn[0], vn[1]); w2.y = pg8::cvt_pk_bf16(vn[2], vn[3]);
                *(LAS pg8::u32x2*)(VnT + (16 * tv + n) * 72 + 16 * ti + 4 * g4) = w2;
            }
        }
        __syncthreads();
        if (wave < 4) {
            float ss[4] = {0.f, 0.f, 0.f, 0.f};
#pragma unroll
            for (int tv = 0; tv < 8; ++tv) {
                f32x4_t o = acc1[tv];
#pragma unroll
                for (int ks = 0; ks < 2; ++ks) o = mma16(aifr[ks], ldfrag(VnT, 72, 16 * tv, 32 * ks, lane), o);
                acc1[tv] = o;
#pragma unroll
                for (int r = 0; r < 4; ++r) ss[r] = fmaf(o[r], o[r], ss[r]);
            }
            allred16x4(ss[0], ss[1], ss[2], ss[3]);
            const LAS unsigned short* zc = Zb + (ch & 1) * 64 * 136;
#pragma unroll
            for (int r = 0; r < 4; ++r) {
                const float inv = rsqrtf(ss[r] * (1.0f / 128.0f) + EPS); const int tr = 16 * ti + 4 * g4 + r;
                unsigned short* yrow = YGB + ((size_t)b * SEQ + ch * 64 + tr) * RW + hv * 128 + n;
#pragma unroll
                for (int tv = 0; tv < 8; ++tv) { const float z = bf2f(zc[tr * 136 + 16 * tv + n]); yrow[16 * tv] = f2bf(acc1[tv][r] * inv * gnv[tv] * z * fast_sigmoid(z)); }
            }
        }
#pragma unroll
        for (int tv = 0; tv < 8; ++tv) {
            f32x4_t s = S[tv] * eg;
#pragma unroll
            for (int ks = 0; ks < 2; ++ks) s = mma16(kfr[ks], ldfrag(VnT, 72, 16 * tv, 32 * ks, lane), s);
            S[tv] = s;
            pg8::u32x2 w2; w2.x = pg8::cvt_pk_bf16(s[0], s[1]); w2.y = pg8::cvt_pk_bf16(s[2], s[3]);
            *(LAS pg8::u32x2*)(St + (16 * tv + n) * 136 + 16 * wave + 4 * g4) = w2;
        }
        if (ch + 1 < 64) { LAS unsigned short* zn = Zb + ((ch + 1) & 1) * 64 * 136 + zrow * 136 + zseg * 16; *(LAS pg8::u32x4*)zn = zr0; *(LAS pg8::u32x4*)(zn + 8) = zr1; }
        __syncthreads();
    }
#undef GS_LOAD
}

constexpr int RT = 32;
constexpr int RBUF_FLOATS = 5 * RT * 64 + RT * 32 + RT * 2;
__device__ __forceinline__ float dpp_f(float x, const int ctrl_sel) {
    const int xi = __float_as_int(x); int r;
    if (ctrl_sel == 0) r = __builtin_amdgcn_update_dpp(0, xi, 0xB1, 0xF, 0xF, true);
    else if (ctrl_sel == 1) r = __builtin_amdgcn_update_dpp(0, xi, 0x4E, 0xF, 0xF, true);
    else if (ctrl_sel == 2) r = __builtin_amdgcn_update_dpp(0, xi, 0x141, 0xF, 0xF, true);
    else r = __builtin_amdgcn_update_dpp(0, xi, 0x140, 0xF, 0xF, true);
    return __int_as_float(r);
}
__device__ __forceinline__ float sum8(float x) { x += dpp_f(x, 0); x += dpp_f(x, 1); x += dpp_f(x, 2); return x; }
__device__ __forceinline__ float fast_softplus(float x) { return fmaxf(x, 0.0f) + 0.6931471805599453f * __builtin_amdgcn_logf(1.0f + __builtin_amdgcn_exp2f(-1.4426950408889634f * fabsf(x))); }
__device__ __forceinline__ void rwkv_scan_block(int sq, int half, LAS float* lds, const float* __restrict__ WPRE, const float* __restrict__ APRE, const unsigned short* __restrict__ PH,
                                                const float* __restrict__ k_k, const float* __restrict__ k_a, const float* __restrict__ r_k, float* __restrict__ BON, float* __restrict__ YR) {
    const int tid = threadIdx.x, lane = tid & 63, wave = __builtin_amdgcn_readfirstlane(tid >> 6);
    const int b = sq >> 4, h = sq & 15, rbase = half * 32;
    const size_t t0 = (size_t)b * SEQ;
    const int lt = tid - 256;
    f32x4_t s0w[2], s0a[2], s0k[2], s0r[2], s0v, s1w[2], s1a[2], s1k[2], s1r[2], s1v;
    f32x4_t kkc = {0.f, 0.f, 0.f, 0.f}, kac = kkc, rkc = kkc;
    if (lt >= 0) { const int colc = h * 64 + (lt & 15) * 4; kkc = *(const f32x4_t*)(k_k + colc); kac = *(const f32x4_t*)(k_a + colc); rkc = *(const f32x4_t*)(r_k + colc); }
    f32x2_t S2[4];
#pragma unroll
    for (int k = 0; k < 4; ++k) S2[k] = (f32x2_t){0.f, 0.f};
#define RW_LOAD(c, P) do { _Pragma("unroll") for (int i = 0; i < 2; ++i) { const int f = lt + 256 * i, st = f >> 4, c4 = f & 15; const size_t t = t0 + (size_t)(c) * RT + st; const int col = h * 64 + c4 * 4; \
        P##w[i] = *(const f32x4_t*)(WPRE + t * RW + col); P##a[i] = ld_bf4((const unsigned short*)APRE + t * RW + col); P##k[i] = ld_bf4(PH + t * N_IN + COL_RK + col); P##r[i] = ld_bf4(PH + t * N_IN + COL_R + col); } \
        { const int st = lt >> 3, c4 = lt & 7; P##v = ld_bf4(PH + (t0 + (size_t)(c) * RT + st) * N_IN + COL_RV + h * 64 + rbase + c4 * 4); } } while (0)
#define RW_STORE(bufp, P, c) do { LAS float* _b = (bufp); _Pragma("unroll") for (int i = 0; i < 2; ++i) { const int f = lt + 256 * i, st = f >> 4, c4 = f & 15; \
        f32x4_t wd, av, kkv, kmv; float ss = 0.f, br = 0.f, kr = 0.f, bo = 0.f; \
        _Pragma("unroll") for (int j = 0; j < 4; ++j) { wd[j] = P##w[i][j]; av[j] = P##a[i][j]; kkv[j] = P##k[i][j] * kkc[j]; kmv[j] = P##k[i][j] * (1.0f + (av[j] - 1.0f) * kac[j]); \
            ss = fmaf(kkv[j], kkv[j], ss); br = fmaf(kkv[j] * av[j], P##r[i][j], br); kr = fmaf(kmv[j], P##r[i][j], kr); bo = fmaf(P##r[i][j] * kmv[j], rkc[j], bo); } \
        allred16x4(ss, br, kr, bo);        \
        const float rn = rsqrtf(ss + 1e-6f); br *= rn; f32x4_t aav, bbv; \
        _Pragma("unroll") for (int j = 0; j < 4; ++j) { const float kk = kkv[j] * rn; aav[j] = -kk; bbv[j] = kk * av[j]; } \
        *(LAS f32x4_t*)(_b + 0 * RT * 64 + st * 64 + c4 * 4) = wd; *(LAS f32x4_t*)(_b + 1 * RT * 64 + st * 64 + c4 * 4) = bbv; *(LAS f32x4_t*)(_b + 2 * RT * 64 + st * 64 + c4 * 4) = kmv; \
        const f32x4_t _x = wd * P##r[i]; \
        *(LAS f32x4_t*)(_b + 3 * RT * 64 + st * 128 + c4 * 8) = (f32x4_t){aav[0], _x[0], aav[1], _x[1]}; *(LAS f32x4_t*)(_b + 3 * RT * 64 + st * 128 + c4 * 8 + 4) = (f32x4_t){aav[2], _x[2], aav[3], _x[3]}; \
        if (c4 == 0) { _b[5 * RT * 64 + RT * 32 + st * 2] = 0.25f * br; _b[5 * RT * 64 + RT * 32 + st * 2 + 1] = 0.25f * kr; if (half == 0) BON[(t0 + (size_t)(c) * RT + st) * 16 + h] = bo; } } \
        { const int st = lt >> 3, c4 = lt & 7; *(LAS f32x4_t*)(_b + 5 * RT * 64 + st * 32 + c4 * 4) = P##v; } } while (0)
    constexpr int NCH = SEQ / RT;
    const int rloc = wave * 8 + (lane >> 4) * 2, kq = (lane & 15) * 4;
    LAS float* ybuf = lds + 2 * RBUF_FLOATS;
    f32x2_t T2[4];
#pragma unroll
    for (int k = 0; k < 4; ++k) T2[k] = (f32x2_t){0.f, 0.f};
    f32x4_t Aw, Ab, Ak, Ax0, Ax1, Bw, Bb, Bk, Bx0, Bx1; f32x2_t Av, Bv, Ar, Br;
#define RW_LD(X, u) do { \
        X##w = *(const LAS f32x4_t*)(pW + (u) * 64); X##b = *(const LAS f32x4_t*)(pW + RT * 64 + (u) * 64); X##k = *(const LAS f32x4_t*)(pW + 2 * RT * 64 + (u) * 64); \
        X##x0 = *(const LAS f32x4_t*)(pX + (u) * 128); X##x1 = *(const LAS f32x4_t*)(pX + (u) * 128 + 4); \
        X##v = *(const LAS f32x2_t*)(pV + (u) * 32); X##r = *(const LAS f32x2_t*)(pR + (u) * 2); } while (0)
#define RW_SUM16(x) do { x += dpp_f(x, 0); x += dpp_f(x, 1); x += dpp_f(x, 2); x += dpp_f(x, 3); } while (0)
#define RW_STEP(X, yb, st) do { \
        f32x2_t e0 = S2[0][0] * (f32x2_t){X##x0[0], X##x0[1]}, e1 = T2[0][0] * (f32x2_t){X##x0[0], X##x0[1]}; \
        e0 += S2[0][1] * (f32x2_t){X##x0[2], X##x0[3]}; e1 += T2[0][1] * (f32x2_t){X##x0[2], X##x0[3]}; \
        e0 += S2[1][0] * (f32x2_t){X##x1[0], X##x1[1]}; e1 += T2[1][0] * (f32x2_t){X##x1[0], X##x1[1]}; \
        e0 += S2[1][1] * (f32x2_t){X##x1[2], X##x1[3]}; e1 += T2[1][1] * (f32x2_t){X##x1[2], X##x1[3]}; \
        float sa0 = e0[0], pp0 = e0[1], sa1 = e1[0], pp1 = e1[1]; \
          \
        asm volatile("s_nop 1\n\t" \
            "v_add_f32_dpp %0, %0, %0 quad_perm:[1,0,3,2] row_mask:0xf bank_mask:0xf bound_ctrl:1\n\tv_add_f32_dpp %1, %1, %1 quad_perm:[1,0,3,2] row_mask:0xf bank_mask:0xf bound_ctrl:1\n\t" \
            "v_add_f32_dpp %2, %2, %2 quad_perm:[1,0,3,2] row_mask:0xf bank_mask:0xf bound_ctrl:1\n\tv_add_f32_dpp %3, %3, %3 quad_perm:[1,0,3,2] row_mask:0xf bank_mask:0xf bound_ctrl:1\n\t" \
            "v_add_f32_dpp %0, %0, %0 quad_perm:[2,3,0,1] row_mask:0xf bank_mask:0xf bound_ctrl:1\n\tv_add_f32_dpp %1, %1, %1 quad_perm:[2,3,0,1] row_mask:0xf bank_mask:0xf bound_ctrl:1\n\t" \
            "v_add_f32_dpp %2, %2, %2 quad_perm:[2,3,0,1] row_mask:0xf bank_mask:0xf bound_ctrl:1\n\tv_add_f32_dpp %3, %3, %3 quad_perm:[2,3,0,1] row_mask:0xf bank_mask:0xf bound_ctrl:1\n\t" \
            "v_add_f32_dpp %0, %0, %0 row_half_mirror row_mask:0xf bank_mask:0xf bound_ctrl:1\n\tv_add_f32_dpp %1, %1, %1 row_half_mirror row_mask:0xf bank_mask:0xf bound_ctrl:1\n\ts_nop 0\n\t" \
            "v_add_f32_dpp %0, %0, %0 row_mirror row_mask:0xf bank_mask:0xf bound_ctrl:1\n\tv_add_f32_dpp %1, %1, %1 row_mirror row_mask:0xf bank_mask:0xf bound_ctrl:1" \
            : "+v"(sa0), "+v"(sa1), "+v"(pp0), "+v"(pp1)); \
        const f32x2_t w01 = (f32x2_t){X##w[0], X##w[1]}, w23 = (f32x2_t){X##w[2], X##w[3]}, b01 = (f32x2_t){X##b[0], X##b[1]}, b23 = (f32x2_t){X##b[2], X##b[3]}, k01 = (f32x2_t){X##k[0], X##k[1]}, k23 = (f32x2_t){X##k[2], X##k[3]}; \
        S2[0] = S2[0] * w01 + (sa0 * b01 + X##v[0] * k01); S2[1] = S2[1] * w23 + (sa0 * b23 + X##v[0] * k23); \
        T2[0] = T2[0] * w01 + (sa1 * b01 + X##v[1] * k01); T2[1] = T2[1] * w23 + (sa1 * b23 + X##v[1] * k23); \
        *(LAS f32x2_t*)((yb) + (st) * 128) = (f32x2_t){pp0 + sa0 * X##r[0] + X##v[0] * X##r[1], pp1 + sa1 * X##r[0] + X##v[1] * X##r[1]}; } while (0)
#define RW_COMPUTE(c) do { const LAS float* buf = lds + ((c) & 1) * RBUF_FLOATS; \
        const LAS float* pW = buf + kq; const LAS float* pX = buf + 3 * RT * 64 + kq * 2; const LAS float* pV = buf + 5 * RT * 64 + rloc; const LAS float* pR = buf + 5 * RT * 64 + RT * 32; LAS float* pY = ybuf + ((c) & 1) * RT * 128 + ((rloc >> 1) * 4 + ((lane & 15) >> 2)) * 2; \
        RW_LD(A, 0); \
        _Pragma("unroll") for (int g = 0; g < RT / 4; ++g) { \
            RW_LD(B, 4 * g + 1); RW_STEP(A, pY, 4 * g); RW_LD(A, 4 * g + 2); RW_STEP(B, pY, 4 * g + 1); RW_LD(B, 4 * g + 3); RW_STEP(A, pY, 4 * g + 2); if (g + 1 < RT / 4) RW_LD(A, 4 * g + 4); RW_STEP(B, pY, 4 * g + 3); } } while (0)
#define RW_FLUSH(c) do { const int st = lt >> 3, c4 = lt & 7; const LAS float* yq_ = ybuf + ((c) & 1) * RT * 128 + st * 128 + c4 * 16; const f32x4_t q0_ = *(const LAS f32x4_t*)(yq_), q1_ = *(const LAS f32x4_t*)(yq_ + 4), q2_ = *(const LAS f32x4_t*)(yq_ + 8), q3_ = *(const LAS f32x4_t*)(yq_ + 12); const f32x4_t yv_ = {(q0_[0] + q0_[2]) + (q1_[0] + q1_[2]), (q0_[1] + q0_[3]) + (q1_[1] + q1_[3]), (q2_[0] + q2_[2]) + (q3_[0] + q3_[2]), (q2_[1] + q2_[3]) + (q3_[1] + q3_[3])}; *(pg8::u32x2*)((unsigned short*)YR + (t0 + (size_t)(c) * RT + st) * RW + h * 64 + rbase + c4 * 4) = (pg8::u32x2){pg8::cvt_pk_bf16(yv_[0], yv_[1]), pg8::cvt_pk_bf16(yv_[2], yv_[3])}; } while (0)
    if (wave >= 4) {
        RW_LOAD(0, s0); RW_STORE(lds, s0, 0); RW_LOAD(1, s0); RW_LOAD(2, s1);
        __syncthreads();
        for (int c = 0; c < NCH; c += 2) {
            RW_STORE(lds + RBUF_FLOATS, s0, c + 1); if (c + 3 < NCH) RW_LOAD(c + 3, s0); if (c > 0) RW_FLUSH(c - 1);
            __syncthreads();
            if (c + 2 < NCH) { RW_STORE(lds, s1, c + 2); } if (c + 4 < NCH) RW_LOAD(c + 4, s1); RW_FLUSH(c);
            __syncthreads();
        }
        RW_FLUSH(NCH - 1);
    } else {
        __builtin_amdgcn_s_setprio(3);
        __syncthreads();
        for (int c = 0; c < NCH; c += 2) {
            RW_COMPUTE(c);
            __syncthreads();
            RW_COMPUTE(c + 1);
            __syncthreads();
        }
        __builtin_amdgcn_s_setprio(0);
    }
#undef RW_COMPUTE
#undef RW_FLUSH
#undef RW_LD
#undef RW_STEP
#undef RW_SUM16
#undef RW_LOAD
#undef RW_STORE
}

__global__ void __launch_bounds__(NTHREADS, 2) fwd(Args a) {
    extern __shared__ __attribute__((aligned(16))) unsigned char lds_raw[];
    float* sm = (float*)lds_raw;
#define PHASE_IDS int tid = threadIdx.x; asm volatile("" : "+v"(tid)); const int lane = tid & 63, wave = tid >> 6; (void)lane; (void)wave;
    unsigned char* ws = a.ws;
    unsigned* ctl = (unsigned*)(ws + WS_CTL);
    volatile LAS unsigned* xbw = (volatile LAS unsigned*)(LAS unsigned char*)(lds_raw + LDS_BYTES - 16);
    if (threadIdx.x == 0) { xbw[0] = 0u; xbw[1] = 0u; xbw[2] = 0u; xbw[3] = 0u; }
    __syncthreads();
    const int lo = a.ph_lo, hi = a.ph_hi;
    XcdBarrier bar; bar.bar = ctl; bar.x = 0; bar.st = xbw;
    if (hi - lo > 1) bar = xcd_barrier_post(ctl, xbw);
#define IN(k) (lo <= (k) && (k) < hi)
#define SEAM(k) do { if (IN(k) && IN((k) + 1)) xcd_barrier(bar); } while (0)


    if (IN(0)) {
        PHASE_IDS
        const float* c = a.in[1];
        const float* ada_w = a.in[2];
        const float* ada_b = a.in[3];
        const float* w_in = a.in[8];
        const float* rwkv_w1 = a.in[15];
        const float* rwkv_a1 = a.in[18];
        const float* rwkv_g1 = a.in[20];
        const float* w_up_gdn = a.in[27];
        const float* w_up_rwkv = a.in[28];
        const float* w_out = a.in[29];
        const float* exp_w_gu = a.in[32];
        const float* exp_w_down = a.in[34];
        float* MOD = (float*)(ws + WS_MOD);
        unsigned short* WINT = (unsigned short*)(ws + WS_WINT);
        unsigned short* WUPG = (unsigned short*)(ws + WS_WUPG);
        unsigned short* WUPR = (unsigned short*)(ws + WS_WUPR);
        unsigned short* WOUT = (unsigned short*)(ws + WS_WOUT);
        unsigned short* WGU = (unsigned short*)(ws + WS_WGU);
        unsigned short* WDN = (unsigned short*)(ws + WS_WDN);
        float* sc = sm;
        float* part = sm + NB * D;
        for (int i = tid; i < NB * D; i += NTHREADS) sc[i] = siluf_(c[i]);
        __syncthreads();
        for (int cb = blockIdx.x; cb < 6 * D / 48; cb += gridDim.x) {
            const int c4 = tid % 12, kg = tid / 12, col = cb * 48 + c4 * 4;
            if (tid < 504) {
                f32x4_t a0 = {0.f, 0.f, 0.f, 0.f}, a1 = a0, a2 = a0, a3 = a0;
#pragma unroll 8
                for (int k = kg; k < D; k += 42) {
                    const f32x4_t w = *(const f32x4_t*)(ada_w + (size_t)k * (6 * D) + col);
                    a0 += sc[k] * w; a1 += sc[D + k] * w; a2 += sc[2 * D + k] * w; a3 += sc[3 * D + k] * w;
                }
                *(f32x4_t*)(part + (kg * 4 + 0) * 48 + c4 * 4) = a0; *(f32x4_t*)(part + (kg * 4 + 1) * 48 + c4 * 4) = a1;
                *(f32x4_t*)(part + (kg * 4 + 2) * 48 + c4 * 4) = a2; *(f32x4_t*)(part + (kg * 4 + 3) * 48 + c4 * 4) = a3;
            }
            __syncthreads();
            if (tid < 192) {
                const int bb = tid / 48, c2 = tid % 48; float t = ada_b[cb * 48 + c2];
                for (int g = 0; g < 42; ++g) t += part[(g * 4 + bb) * 48 + c2];
                MOD[(size_t)bb * 6 * D + cb * 48 + c2] = t;
            }
            __syncthreads();
        }
        {
            const int gw = blockIdx.x * (NTHREADS / 64) + wave, ngw = gridDim.x * (NTHREADS / 64);
            auto idk = [](int k) { return k; };
            constexpr int N_IP = (NT_IN * 256 / 64) * (D / 64);
            constexpr int N_GU = NE * (2 * FF / 64) * (D / 64), N_DN = NE * (D / 64) * (FF / 64);
            constexpr int N_L2 = 3 * (RW / 64) * (256 / 64), N_UP = (D / 64) * (RW / 64), N_OUT = (D / 64) * (D / 64);
            constexpr int N_ALL = N_IP + N_GU + N_DN + N_L2 + 2 * N_UP + N_OUT;
            constexpr int N_P5 = (N_GU + N_DN) * 100 / 100;
            for (int it0 = gw + N_P5; it0 < N_ALL; it0 += ngw) {
                int it = it0;
                if (it < N_GU) {
                    const int e = it / ((2 * FF / 64) * (D / 64)), r = it % ((2 * FF / 64) * (D / 64)), rb = r / (D / 64), kb = r % (D / 64);
                    auto m4 = [](int row0, int n4, int& scol, int& drow) { const int pn = row0 >> 8, cb8 = (row0 & 255) >> 3, ft = 128 * pn + (cb8 + (n4 & 7)) * 4; scol = (n4 < 8) ? ft : FF + ft; drow = row0 + (n4 & 7) * 8 + ((n4 < 8) ? 0 : 4); };
                    cvt64(exp_w_gu + (size_t)e * D * 2 * FF, 2 * FF, D, m4, idk, WGU + (size_t)e * 2 * FF * D, rb * 64, kb, lane); continue; }
                it -= N_GU;
                auto mid = [](int row0, int n4, int& scol, int& drow) { scol = row0 + 4 * n4; drow = scol; };
                if (it < N_DN) {
                    const int e = it / ((D / 64) * (FF / 64)), r = it % ((D / 64) * (FF / 64)), rb = r / (FF / 64), kb = r % (FF / 64);
                    cvt64(exp_w_down + (size_t)e * FF * D, D, FF, mid, idk, WDN + (size_t)e * D * FF, rb * 64, kb, lane); continue; }
                it -= N_DN;
                if (it < N_IP) {
                    const int rb = it / (D / 64), kb = it % (D / 64), row0 = rb * 64;
                    int mat, col0; inproj_src(row0, mat, col0);
                    const float* W = mat == 0 ? w_in : mat == 1 ? rwkv_w1 : mat == 2 ? rwkv_a1 : rwkv_g1;
                    const int ldw = mat == 0 ? N_IN : mat == 3 ? 256 : 96;
                    auto m4 = [](int r0, int n4, int& scol, int& drow) { int m2; drow = r0 + 4 * n4; inproj_src(drow, m2, scol); };
                    cvt64(W, ldw, D, m4, idk, WINT, row0, kb, lane); continue; }
                it -= N_IP;
                if (it < N_L2) {
                    const float* rwkv_w2 = a.in[16]; const float* rwkv_a2 = a.in[19]; const float* rwkv_g2 = a.in[21]; unsigned short* L2T = (unsigned short*)(ws + WS_L2T);
                    constexpr int NL = (RW / 64) * 4; const int g = it / NL, r = it % NL, rb = r / 4, kb = r % 4;
                    if (g == 0) { auto fk = [](int k) { return k < 96 ? k : -1; }; cvt64(rwkv_w2, RW, 256, mid, fk, L2T, rb * 64, kb, lane); }
                    else if (g == 1) { auto fk = [](int k) { return (k >= 128 && k < 224) ? k - 128 : -1; }; cvt64(rwkv_a2, RW, 256, mid, fk, L2T + (size_t)RW * 256, rb * 64, kb, lane); }
                    else cvt64(rwkv_g2, RW, 256, mid, idk, L2T + (size_t)2 * RW * 256, rb * 64, kb, lane);
                    continue; }
                it -= N_L2;
                if (it < N_UP) { cvt64(w_up_gdn, D, RW, mid, idk, WUPG, (it / (RW / 64)) * 64, it % (RW / 64), lane); continue; }
                it -= N_UP;
                if (it < N_UP) { cvt64(w_up_rwkv, D, RW, mid, idk, WUPR, (it / (RW / 64)) * 64, it % (RW / 64), lane); continue; }
                it -= N_UP;
                cvt64(w_out, D, D, mid, idk, WOUT, (it / (D / 64)) * 64, it % (D / 64), lane);
            }
        }
    }
    SEAM(0);

    if (IN(1)) {
        PHASE_IDS
        const float* x = a.in[0]; const float* norm_mix_pre = a.in[4]; const float* rwkv_mix = a.in[13];
        float* MOD = (float*)(ws + WS_MOD); unsigned short* AM = (unsigned short*)(ws + WS_H);
        LAS float* red = (LAS float*)(LAS unsigned char*)lds_raw;
        const int d0 = tid * 4;
        const f32x4_t nw = *(const f32x4_t*)(norm_mix_pre + d0);
        f32x4_t mx[6];
#pragma unroll
        for (int mi = 0; mi < 6; ++mi) mx[mi] = *(const f32x4_t*)(rwkv_mix + mi * D + d0);
        for (int chunk = blockIdx.x; chunk < T / 64; chunk += gridDim.x) {
            const int r0 = chunk * 64, b = r0 / SEQ; const float* mod = MOD + (size_t)b * 6 * D;
            const f32x4_t sc4 = *(const f32x4_t*)(mod + D + d0), sh4 = *(const f32x4_t*)(mod + d0);
            const f32x4_t g4 = nw * (1.0f + sc4);
            const bool hasprev = (r0 % SEQ) != 0;
            f32x4_t xa[8], xb[8], xp = {0.f, 0.f, 0.f, 0.f}, p = {0.f, 0.f, 0.f, 0.f};
            if (hasprev) xp = *(const f32x4_t*)(x + (size_t)(r0 - 1) * D + d0);
#pragma unroll
            for (int r = 0; r < 8; ++r) xa[r] = *(const f32x4_t*)(x + (size_t)(r0 + r) * D + d0);
#define P1_SUB(sb, XC, XN) do { \
            if ((sb) + 1 < 8) { _Pragma("unroll") for (int r = 0; r < 8; ++r) XN[r] = *(const f32x4_t*)(x + (size_t)(r0 + ((sb) + 1) * 8 + r) * D + d0); } \
            float ss[12]; \
            _Pragma("unroll") for (int r = 0; r < 8; ++r) ss[r] = XC[r][0] * XC[r][0] + XC[r][1] * XC[r][1] + XC[r][2] * XC[r][2] + XC[r][3] * XC[r][3]; \
            ss[8] = xp[0] * xp[0] + xp[1] * xp[1] + xp[2] * xp[2] + xp[3] * xp[3]; ss[9] = 0.f; ss[10] = 0.f; ss[11] = 0.f; \
            _Pragma("unroll") for (int q = 0; q < 3; ++q) { allred16x4(ss[4 * q], ss[4 * q + 1], ss[4 * q + 2], ss[4 * q + 3]); \
                _Pragma("unroll") for (int j = 0; j < 4; ++j) { float v_ = ss[4 * q + j]; v_ += __shfl_xor(v_, 16); v_ += __shfl_xor(v_, 32); ss[4 * q + j] = v_; } } \
            LAS float* rb_ = red + ((sb) & 1) * 96; \
            if (lane == 0) { _Pragma("unroll") for (int q = 0; q < 3; ++q) *(LAS f32x4_t*)(rb_ + wave * 12 + 4 * q) = (f32x4_t){ss[4 * q], ss[4 * q + 1], ss[4 * q + 2], ss[4 * q + 3]}; } \
            __syncthreads(); \
            f32x4_t tot[3]; \
            _Pragma("unroll") for (int q = 0; q < 3; ++q) { tot[q] = *(const LAS f32x4_t*)(rb_ + 4 * q); _Pragma("unroll") for (int w_ = 1; w_ < 8; ++w_) tot[q] += *(const LAS f32x4_t*)(rb_ + w_ * 12 + 4 * q); } \
            if ((sb) == 0 && hasprev) { const float ip = rsqrtf(tot[2][0] / D + EPS); p = xp * ip * g4 + sh4; } \
            _Pragma("unroll") for (int r = 0; r < 8; ++r) { \
                const float inv = rsqrtf(tot[r >> 2][r & 3] / D + EPS); const f32x4_t h = XC[r] * inv * g4 + sh4; \
                const size_t o = (size_t)(r0 + (sb) * 8 + r) * D + d0; \
                *(pg8::u32x2*)(AM + o) = (pg8::u32x2){pg8::cvt_pk_bf16(h[0], h[1]), pg8::cvt_pk_bf16(h[2], h[3])}; \
                const f32x4_t dl = p - h; \
                _Pragma("unroll") for (int mi = 0; mi < 6; ++mi) { const f32x4_t v_ = h + dl * mx[mi]; *(pg8::u32x2*)(AM + (size_t)(mi + 1) * T * D + o) = (pg8::u32x2){pg8::cvt_pk_bf16(v_[0], v_[1]), pg8::cvt_pk_bf16(v_[2], v_[3])}; } \
                p = h; } } while (0)
            P1_SUB(0, xa, xb); P1_SUB(1, xb, xa); P1_SUB(2, xa, xb); P1_SUB(3, xb, xa); P1_SUB(4, xa, xb); P1_SUB(5, xb, xa); P1_SUB(6, xa, xb); P1_SUB(7, xb, xa);
#undef P1_SUB
        }
    }
    SEAM(1);

    if (IN(2)) {
        PHASE_IDS
        unsigned short* AM = (unsigned short*)(ws + WS_H);
        unsigned short* WINT = (unsigned short*)(ws + WS_WINT);
        unsigned short* PH = (unsigned short*)(ws + WS_PH);
        SchedInProj S{(int)gridDim.x, (int)blockIdx.x, (const char*)AM, (const char*)WINT};
        EpiInProjF32 E{PH, (float*)(ws + WS_BA), (unsigned short*)(ws + WS_LWA), (unsigned short*)(ws + WS_LGB)};
        pg8::gemm_phase<EpiInProjF32, SchedInProj, true, false>((LAS unsigned char*)lds_raw, D, S, E);
    }
    SEAM(2);

    if (IN(3)) {
        PHASE_IDS
        const float* gdn_conv = a.in[9];
        const float* gdn_A_log = a.in[10];
        const float* gdn_dt_bias = a.in[11];
        const float* rwkv_w0 = a.in[14];
        const float* rwkv_w2 = a.in[16];
        const float* rwkv_a0 = a.in[17];
        const float* rwkv_a2 = a.in[19];
        const float* rwkv_g2 = a.in[21];
        unsigned short* PH = (unsigned short*)(ws + WS_PH);
        float* WPRE = (float*)(ws + WS_WPRE);
        float* APRE = (float*)(ws + WS_APRE);
        float* GATE = (float*)(ws + WS_GATE);
        unsigned char* GREC = ws + WS_GREC;
        {
            SchedLora S{(int)gridDim.x, (int)blockIdx.x, (const char*)(ws + WS_LWA), (const char*)(ws + WS_LGB), (const char*)(ws + WS_L2T)};
            EpiLora E{WPRE, APRE, GATE, rwkv_w0, rwkv_a0};
            int klora = 256; asm volatile("" : "+s"(klora));
            pg8::gemm_phase<EpiLora, SchedLora, true, false>((LAS unsigned char*)lds_raw, klora, S, E);
        }
        __syncthreads();
        {
            const int cg = tid & 31, r0 = 4 * (tid >> 5);
            const float* convw = gdn_conv;
            pg8::u32x2 xn[3][7]; f32x4_t wn[3][4];
            const int k0 = blockIdx.x;
            if (k0 < 2048) {
                const int it0 = gdn_item_of(k0);
                if (wave == 7) gdn_a0(it0, (const float*)(ws + WS_BA), gdn_A_log, gdn_dt_bias, (LAS float*)((LAS unsigned char*)lds_raw + GL_SM), (LAS float*)((LAS unsigned char*)lds_raw + GL_SM) + 64, lane);
                A1_LOADW(0, it0, wn[0]); A1_LOADW(1, it0, wn[1]); A1_LOADW(2, it0, wn[2]);
                A1_LOADX(0, it0, xn[0]); A1_LOADX(1, it0, xn[1]); A1_LOADX(2, it0, xn[2]);
#pragma unroll
                for (int m = 0; m < 3; ++m) {
#pragma unroll
                    for (int q = 0; q < 7; ++q) asm volatile("" : "+v"(xn[m][q].x), "+v"(xn[m][q].y));
#pragma unroll
                    for (int j = 0; j < 4; ++j) asm volatile("" : "+v"(wn[m][j]));
                }
            }
            __syncthreads();
            int par = 0;
            for (int k = k0; k < 2048; k += gridDim.x) { const int kn = k + (int)gridDim.x; gdn_prep_item(gdn_item_of(k), kn < 2048 ? gdn_item_of(kn) : 2048, par, (LAS unsigned char*)lds_raw, PH, (const float*)(ws + WS_BA), gdn_conv, gdn_A_log, gdn_dt_bias, GREC, xn, wn); par ^= 1; }
        }
    }
    SEAM(3);


    if (IN(5)) {
        PHASE_IDS
        unsigned short* PH = (unsigned short*)(ws + WS_PH);
        unsigned char* GREC = ws + WS_GREC;
        float* WD = (float*)(ws + WS_WD);
        float* AA = (float*)(ws + WS_AA);
        float* BB = (float*)(ws + WS_BB);
        float* KM = (float*)(ws + WS_KM);
        float* OG = (float*)(ws + WS_OG);
        float* YR = (float*)(ws + WS_YR);
        if (blockIdx.x < 32) gdn_scan_seq((int)blockIdx.x, (LAS unsigned char*)lds_raw, GREC, PH, a.in[12], (unsigned short*)(ws + WS_YGB));
        else if (blockIdx.x < 160) rwkv_scan_block(((int)blockIdx.x - 32) >> 1, ((int)blockIdx.x - 32) & 1, (LAS float*)(LAS unsigned char*)lds_raw, (const float*)(ws + WS_WPRE), (const float*)(ws + WS_APRE), PH, a.in[22], a.in[23], a.in[24], (float*)(ws + WS_WD), YR);
        {
            const float* exp_w_gu = a.in[32]; const float* exp_w_down = a.in[34];
            unsigned char* WGU = ws + WS_WGU; unsigned char* WDN = ws + WS_WDN;
            constexpr int N_GU = NE * (2 * FF / 64) * (D / 64), N_DN = NE * (D / 64) * (FF / 64);
            auto idk = [](int k) { return k; };
            constexpr int N_P5 = N_GU + N_DN;
            const int n4 = lane & 15, kg = lane >> 4;
            auto setup = [&](int it, const float*& Wp, int& ldw, int& Kd, unsigned char*& WTp, int& sc, int& dr, int& k0) {
                if (it < N_GU) {
                    const int e = it / ((2 * FF / 64) * (D / 64)), r = it % ((2 * FF / 64) * (D / 64)), rb = r / (D / 64), kb = r % (D / 64), row0 = rb * 64;
                    const int pn = row0 >> 8, cb8 = (row0 & 255) >> 3, ft = 128 * pn + (cb8 + (n4 & 7)) * 4; sc = (n4 < 8) ? ft : FF + ft; dr = row0 + (n4 & 7) * 8 + ((n4 < 8) ? 0 : 4);
                    Wp = exp_w_gu + (size_t)e * D * 2 * FF; ldw = 2 * FF; Kd = D; WTp = WGU + (size_t)e * 2 * FF * D; k0 = kb * 64 + 16 * kg;
                } else {
                    it -= N_GU;
                    const int e = it / ((D / 64) * (FF / 64)), r = it % ((D / 64) * (FF / 64)), rb = r / (FF / 64), kb = r % (FF / 64);
                    sc = rb * 64 + 4 * n4; dr = sc; Wp = exp_w_down + (size_t)e * FF * D; ldw = D; Kd = FF; WTp = WDN + (size_t)e * D * FF; k0 = kb * 64 + 16 * kg;
                }
            };
#define CV_LOAD(it_, v) do { const float* Wp_; unsigned char* WTp_; int ldw_, Kd_, sc_, dr_, k0_; setup((it_), Wp_, ldw_, Kd_, WTp_, sc_, dr_, k0_); (void)WTp_; (void)Kd_; (void)dr_; \
                _Pragma("unroll") for (int kk = 0; kk < 16; ++kk) v[kk] = *(const f32x4_t*)(Wp_ + (size_t)(k0_ + kk) * ldw_ + sc_); } while (0)
#define CV_STORE(it_, v) do { const float* Wp_; unsigned char* WTp_; int ldw_, Kd_, sc_, dr_, k0_; setup((it_), Wp_, ldw_, Kd_, WTp_, sc_, dr_, k0_); (void)Wp_; (void)ldw_; (void)sc_; \
                _Pragma("unroll") for (int j = 0; j < 4; ++j) { pg8::u32x4 o; \
                    _Pragma("unroll") for (int q = 0; q < 4; ++q) { int w = __builtin_amdgcn_cvt_pk_fp8_f32(v[4 * q][j] * 64.0f, v[4 * q + 1][j] * 64.0f, 0, false); w = __builtin_amdgcn_cvt_pk_fp8_f32(v[4 * q + 2][j] * 64.0f, v[4 * q + 3][j] * 64.0f, w, true); o[q] = (unsigned)w; } \
                    *(pg8::u32x4*)(WTp_ + (size_t)(dr_ + j) * Kd_ + k0_) = o; } } while (0)
            static_assert(N_P5 % 8 == 0, "batches of 8");
            for (;;) {
                int base = 0; if (lane == 0) base = (int)atomicAdd(ctl + CW_CNT + 96, 8u);
                base = __builtin_amdgcn_readfirstlane(base);
                if (base >= N_P5) break;
                f32x4_t va[16], vb[16];
                CV_LOAD(base, va);
#pragma unroll 1
                for (int i = 0; i < 8; i += 2) {
                    CV_LOAD(base + i + 1, vb);
                    CV_STORE(base + i, va);
                    if (i + 2 < 8) CV_LOAD(base + i + 2, va);
                    CV_STORE(base + i + 1, vb);
                }
            }
#undef CV_LOAD
#undef CV_STORE
        }
    }
    SEAM(5);

    if (IN(6)) {
        PHASE_IDS
        const float* gdn_norm = a.in[12];
        const float* rwkv_r_k = a.in[24];
        const float* rwkv_ln_w = a.in[25];
        const float* rwkv_ln_b = a.in[26];
        unsigned short* PH = (unsigned short*)(ws + WS_PH);
        float* GATE = (float*)(ws + WS_GATE);
        float* KM = (float*)(ws + WS_KM);
        float* OG = (float*)(ws + WS_OG);
        float* YR = (float*)(ws + WS_YR);
        unsigned short* YGB = (unsigned short*)(ws + WS_YGB);
        unsigned short* YRWB = (unsigned short*)(ws + WS_YRWB);
        {
            const int c0 = (tid & 255) * 4;
            const f32x4_t lw = *(const f32x4_t*)(rwkv_ln_w + c0), lb = *(const f32x4_t*)(rwkv_ln_b + c0);
            const float* BONp = (const float*)(ws + WS_WD);
            for (int rp = blockIdx.x; rp < T / 8; rp += gridDim.x) {
                const int rowb = rp * 8 + (tid >> 8);
                f32x4_t y[4], vv[4], gt[4]; float bsum[4], sm[4], sv[4];
#pragma unroll
                for (int i = 0; i < 4; ++i) { const size_t row = (size_t)(rowb + 2 * i); y[i] = ld_bf4((const unsigned short*)YR + row * RW + c0); vv[i] = ld_bf4(PH + row * N_IN + COL_RV + c0); gt[i] = ld_bf4((const unsigned short*)GATE + row * RW + c0); bsum[i] = BONp[row * 16 + (c0 >> 6)]; }
#pragma unroll
                for (int i = 0; i < 4; ++i) sm[i] = (y[i][0] + y[i][1]) + (y[i][2] + y[i][3]);
                allred16x4(sm[0], sm[1], sm[2], sm[3]);
                f32x4_t dl[4];
#pragma unroll
                for (int i = 0; i < 4; ++i) { dl[i] = y[i] - sm[i] * (1.0f / 64.0f); sv[i] = (dl[i][0] * dl[i][0] + dl[i][1] * dl[i][1]) + (dl[i][2] * dl[i][2] + dl[i][3] * dl[i][3]); }
                allred16x4(sv[0], sv[1], sv[2], sv[3]);
#pragma unroll
                for (int i = 0; i < 4; ++i) {
                    const float rs = rsqrtf(sv[i] * (1.0f / 64.0f) + 64e-5f);
                    const f32x4_t yo = (dl[i] * rs * lw + lb + bsum[i] * vv[i]) * gt[i];
                    *(pg8::u32x2*)(YRWB + (size_t)(rowb + 2 * i) * RW + c0) = (pg8::u32x2){pg8::cvt_pk_bf16(yo[0], yo[1]), pg8::cvt_pk_bf16(yo[2], yo[3])};
                }
            }
        }
    }
    SEAM(6);

    if (IN(7)) {
        PHASE_IDS
        unsigned short* PH = (unsigned short*)(ws + WS_PH);
        unsigned short* YGB = (unsigned short*)(ws + WS_YGB);
        unsigned short* YRWB = (unsigned short*)(ws + WS_YRWB);
        unsigned short* WUPG = (unsigned short*)(ws + WS_WUPG);
        unsigned short* WUPR = (unsigned short*)(ws + WS_WUPR);
        unsigned short* MRGB = (unsigned short*)(ws + WS_MRGB);
        float* MERGED = (float*)(ws + WS_MERGED);
        SchedUp S{(int)gridDim.x, (int)blockIdx.x, (const char*)YGB, (const char*)YRWB, (const char*)WUPG, (const char*)WUPR};
        EpiUp E{MRGB, PH};
        pg8::gemm_phase<EpiUp, SchedUp, true, false>((LAS unsigned char*)lds_raw, RW, S, E);
    }
    SEAM(7);

    if (IN(8)) {
        PHASE_IDS
        unsigned short* WOUT = (unsigned short*)(ws + WS_WOUT);
        unsigned short* MRGB = (unsigned short*)(ws + WS_MRGB);
        float* Y = (float*)(ws + WS_Y);
        SchedPlain S{(int)gridDim.x, (int)blockIdx.x, T / 256, D / 256, D, (const char*)MRGB, (const char*)WOUT};
        EpiF32 E{(unsigned short*)Y, D};
        pg8::gemm_phase<EpiF32, SchedPlain, true, false>((LAS unsigned char*)lds_raw, D, S, E);
    }
    SEAM(8);

    if (IN(9)) {
        PHASE_IDS
        const float* x = a.in[0];
        const float* norm_mix_post = a.in[5];
        const float* norm_ffn_pre = a.in[6];
        const float* router_w = a.in[30];
        const float* router_b = a.in[31];
        float* MOD = (float*)(ws + WS_MOD);
        float* Y = (float*)(ws + WS_Y);
        float* XMID = (float*)(ws + WS_XMID);
        unsigned short* H2B = (unsigned short*)(ws + WS_H2B);
        float* TOPP = (float*)(ws + WS_TOPP);
        int* LIST = (int*)(ws + WS_LIST);
        unsigned* CNT = ctl + CW_CNT;
        constexpr int HP = D + 4;
        LAS float* hb = (LAS float*)(LAS unsigned char*)lds_raw;
        const int ntl = (T / 8 - (int)blockIdx.x + (int)gridDim.x - 1) / (int)gridDim.x;
        pg8::u32x2 yr[8]; f32x4_t xr_[8];
#define P9_LOAD(tl) do { const size_t _row = (size_t)(tl) * 8 + wave; _Pragma("unroll") for (int j = 0; j < 8; ++j) { yr[j] = *(const pg8::u32x2*)((const unsigned short*)Y + _row * D + j * 256 + lane * 4); xr_[j] = *(const f32x4_t*)(x + _row * D + j * 256 + lane * 4); } } while (0)
#define P9_FINISH(tl, hbuf) do { const int _rowi = (tl) * 8 + wave; const size_t _row = (size_t)_rowi; const float* mod = MOD + (size_t)(_rowi / SEQ) * 6 * D; \
        f32x4_t ym[8]; float ss = 0.f; \
        _Pragma("unroll") for (int j = 0; j < 8; ++j) { ym[j] = (f32x4_t){__uint_as_float(yr[j].x << 16), __uint_as_float(yr[j].x & 0xffff0000u), __uint_as_float(yr[j].y << 16), __uint_as_float(yr[j].y & 0xffff0000u)}; \
            ss += ym[j][0] * ym[j][0] + ym[j][1] * ym[j][1] + ym[j][2] * ym[j][2] + ym[j][3] * ym[j][3]; } \
        ss = wave_sum(ss); const float inv = rsqrtf(ss / D + EPS); float ss2 = 0.f; \
        _Pragma("unroll") for (int j = 0; j < 8; ++j) { const int d0 = j * 256 + lane * 4; const f32x4_t nw = *(const f32x4_t*)(norm_mix_post + d0), gt = *(const f32x4_t*)(mod + 2 * D + d0); \
            ym[j] = xr_[j] + gt * (ym[j] * inv * nw); *(pg8::u32x2*)((unsigned short*)XMID + _row * D + d0) = (pg8::u32x2){pg8::cvt_pk_bf16(ym[j][0], ym[j][1]), pg8::cvt_pk_bf16(ym[j][2], ym[j][3])}; ss2 += ym[j][0] * ym[j][0] + ym[j][1] * ym[j][1] + ym[j][2] * ym[j][2] + ym[j][3] * ym[j][3]; } \
        ss2 = wave_sum(ss2); const float inv2 = rsqrtf(ss2 / D + EPS); \
        _Pragma("unroll") for (int j = 0; j < 8; ++j) { const int d0 = j * 256 + lane * 4; const f32x4_t nw = *(const f32x4_t*)(norm_ffn_pre + d0), sc = *(const f32x4_t*)(mod + 4 * D + d0), sh = *(const f32x4_t*)(mod + 3 * D + d0); \
            const f32x4_t hv = ym[j] * inv2 * nw * (1.0f + sc) + sh; \
            { int w8 = __builtin_amdgcn_cvt_pk_fp8_f32(hv[0], hv[1], 0, false); w8 = __builtin_amdgcn_cvt_pk_fp8_f32(hv[2], hv[3], w8, true); *(int*)((unsigned char*)H2B + _row * D + d0) = w8; } \
            *(LAS f32x4_t*)((hbuf) + wave * HP + d0) = hv; } } while (0)
        if (ntl > 0) { P9_LOAD(blockIdx.x); P9_FINISH((int)blockIdx.x, hb); }
        __syncthreads();
        for (int k = 0; k < ntl; ++k) {
            const int tile = (int)blockIdx.x + k * (int)gridDim.x; const LAS float* cur = hb + (k & 1) * 8 * HP;
            if (k + 1 < ntl) P9_LOAD(tile + (int)gridDim.x);
            {
                const int kp = tid >> 5, e = tid & 31;
                const LAS float* hp = cur + kp * 128; const float* wp = router_w + (size_t)kp * 128 * NE + e;
                f32x2_t acc[8];
#pragma unroll
                for (int r = 0; r < 8; ++r) acc[r] = (f32x2_t){0.f, 0.f};
#pragma unroll 2
                for (int d = 0; d < 128; d += 4) {
                    const f32x2_t wa = {wp[(size_t)d * NE], wp[(size_t)(d + 1) * NE]}, wb = {wp[(size_t)(d + 2) * NE], wp[(size_t)(d + 3) * NE]};
#pragma unroll
                    for (int r = 0; r < 8; ++r) { const f32x4_t h4 = *(const LAS f32x4_t*)(hp + r * HP + d); acc[r] += (f32x2_t){h4[0], h4[1]} * wa; acc[r] += (f32x2_t){h4[2], h4[3]} * wb; }
                }
                __syncthreads();
                LAS float* part = (LAS float*)cur;
#pragma unroll
                for (int r = 0; r < 8; ++r) part[(kp * 8 + r) * 32 + e] = acc[r][0] + acc[r][1];
            }
            __syncthreads();
            if (tid < 256) {
                const int r = tid >> 5, e = tid & 31, row = tile * 8 + r;
                const LAS float* part = cur;
                float lgt = router_b[e];
#pragma unroll
                for (int kp = 0; kp < 16; ++kp) lgt += part[(kp * 8 + r) * 32 + e];
                float val[TOPK]; int idx[TOPK];
#pragma unroll
                for (int q = 0; q < TOPK; ++q) {
                    float bv = lgt; int bi = e;
#pragma unroll
                    for (int o = 1; o < 32; o <<= 1) { const float ov = __shfl_xor(bv, o); const int oi = __shfl_xor(bi, o); if (ov > bv || (ov == bv && oi < bi)) { bv = ov; bi = oi; } }
                    val[q] = bv; idx[q] = bi; if (e == bi) lgt = -3.0e38f;
                }
                float pe[TOPK], psum = 0.f;
#pragma unroll
                for (int q = 0; q < TOPK; ++q) { pe[q] = expf(val[q] - val[0]); psum += pe[q]; }
                if (e < TOPK) {
                    const float pk = e == 0 ? pe[0] : e == 1 ? pe[1] : e == 2 ? pe[2] : pe[3]; const int ik = e == 0 ? idx[0] : e == 1 ? idx[1] : e == 2 ? idx[2] : idx[3];
                    const int asg = row * TOPK + e;
                    TOPP[asg] = pk / psum;
                    const unsigned pos = atomicAdd(&CNT[ik], 1u);
                    LIST[(size_t)ik * T + pos] = asg;
                }
            }
            if (k + 1 < ntl) P9_FINISH(tile + (int)gridDim.x, hb + ((k + 1) & 1) * 8 * HP);
            __syncthreads();
        }
#undef P9_LOAD
#undef P9_FINISH
    }
    SEAM(9);

    const int vcu = (gridDim.x % 8 == 0) ? (int)((blockIdx.x % 8) * (gridDim.x / 8) + blockIdx.x / 8) : (int)blockIdx.x;
    if (IN(10)) {
        PHASE_IDS
        const float* exp_b_gu = a.in[33];
        unsigned short* H2B = (unsigned short*)(ws + WS_H2B);
        int* LIST = (int*)(ws + WS_LIST);
        unsigned short* ACT = (unsigned short*)(ws + WS_ACT);
        unsigned short* WGU = (unsigned short*)(ws + WS_WGU);
        LAS int* mtab = (LAS int*)(LAS unsigned char*)(lds_raw + 131072);
        unsigned* CNT = ctl + CW_CNT;
        moe_tables(mtab, CNT);
        SchedMoE S{(int)gridDim.x, vcu, 2 * FF / 256, 2 * FF, mtab, LIST, (const char*)H2B, (const char*)WGU, true, 1};
        EpiGU E{(unsigned char*)ACT, exp_b_gu};
        pg8::gemm_phase<EpiGU, SchedMoE, true, true, true>((LAS unsigned char*)lds_raw, D, S, E);
    }
    SEAM(10);

    if (IN(11)) {
        PHASE_IDS
        const float* exp_b_down = a.in[35];
        int* LIST = (int*)(ws + WS_LIST);
        unsigned short* ACT = (unsigned short*)(ws + WS_ACT);
        unsigned short* YB = (unsigned short*)(ws + WS_YB);
        unsigned short* WDN = (unsigned short*)(ws + WS_WDN);
        LAS int* mtab = (LAS int*)(LAS unsigned char*)(lds_raw + 131072);
        unsigned* CNT = ctl + CW_CNT;
        moe_tables(mtab, CNT);
        SchedMoE S{(int)gridDim.x, vcu, D / 256, D, mtab, LIST, (const char*)ACT, (const char*)WDN, false, 1};
        EpiDown E{YB, exp_b_down};
        pg8::gemm_phase<EpiDown, SchedMoE, true, true, true>((LAS unsigned char*)lds_raw, FF, S, E);
    }
    SEAM(11);

    if (IN(12)) {
        PHASE_IDS
        const float* norm_ffn_post = a.in[7];
        float* MOD = (float*)(ws + WS_MOD);
        float* XMID = (float*)(ws + WS_XMID);
        float* TOPP = (float*)(ws + WS_TOPP);
        unsigned short* YB = (unsigned short*)(ws + WS_YB);
        for (int row = blockIdx.x * 8 + wave; row < T; row += gridDim.x * 8) {
            const int b = row / SEQ; const float* mod = MOD + (size_t)b * 6 * D;
            f32x4_t ylo[4], yhi[4];
#pragma unroll
            for (int j = 0; j < 4; ++j) { ylo[j] = (f32x4_t){0.f, 0.f, 0.f, 0.f}; yhi[j] = (f32x4_t){0.f, 0.f, 0.f, 0.f}; }
#pragma unroll
            for (int k = 0; k < TOPK; ++k) {
                const int asg = row * TOPK + k; const float p = TOPP[asg];
#pragma unroll
                for (int j = 0; j < 4; ++j) { f32x4_t lo, hi; ld_bf8(YB + (size_t)asg * D + j * 512 + lane * 8, lo, hi); ylo[j] += p * lo; yhi[j] += p * hi; }
            }
            float ss = 0.f;
#pragma unroll
            for (int j = 0; j < 4; ++j) ss += ylo[j][0] * ylo[j][0] + ylo[j][1] * ylo[j][1] + ylo[j][2] * ylo[j][2] + ylo[j][3] * ylo[j][3] + yhi[j][0] * yhi[j][0] + yhi[j][1] * yhi[j][1] + yhi[j][2] * yhi[j][2] + yhi[j][3] * yhi[j][3];
            ss = wave_sum(ss);
            const float inv = rsqrtf(ss / D + EPS);
#pragma unroll
            for (int j = 0; j < 4; ++j) {
                const int d0 = j * 512 + lane * 8;
                f32x4_t x0, x1; ld_bf8((const unsigned short*)XMID + (size_t)row * D + d0, x0, x1);
                const f32x4_t g0 = *(const f32x4_t*)(mod + 5 * D + d0), g1 = *(const f32x4_t*)(mod + 5 * D + d0 + 4);
                const f32x4_t n0 = *(const f32x4_t*)(norm_ffn_post + d0), n1 = *(const f32x4_t*)(norm_ffn_post + d0 + 4);
                *(f32x4_t*)(a.out + (size_t)row * D + d0) = x0 + g0 * (ylo[j] * inv * n0);
                *(f32x4_t*)(a.out + (size_t)row * D + d0 + 4) = x1 + g1 * (yhi[j] * inv * n1);
            }
        }
    }
#undef IN
#undef SEAM
}

constexpr int NPHASES = 13;
#ifndef MK_ONE_LAUNCH
#define MK_ONE_LAUNCH 1
#endif

extern "C" void kernel_launch(void* const* d_in, const int* in_sizes, int n_in, void* d_out, int out_size, void* d_ws, size_t ws_size, hipStream_t stream) {
    static int grid = 0;
    if (grid == 0) {
        if (n_in != 36 || out_size != T * D || ws_size < WS_END) { fprintf(stderr, "kernel_launch: unexpected shapes n_in %d out %d ws %zu (need %zu)\n", n_in, out_size, ws_size, (size_t)WS_END); grid = -1; return; }
        int dev = 0, cus = 0, per_cu = 0;
        if (hipGetDevice(&dev) != hipSuccess || hipDeviceGetAttribute(&cus, hipDeviceAttributeMultiprocessorCount, dev) != hipSuccess) { grid = -1; return; }
        if (hipFuncSetAttribute((const void*)fwd, hipFuncAttributeMaxDynamicSharedMemorySize, LDS_BYTES) != hipSuccess) { fprintf(stderr, "kernel_launch: hipFuncSetAttribute failed\n"); grid = -1; return; }
        if (hipOccupancyMaxActiveBlocksPerMultiprocessor(&per_cu, (const void*)fwd, NTHREADS, LDS_BYTES) != hipSuccess || per_cu < 1) { fprintf(stderr, "kernel_launch: occupancy query says %d\n", per_cu); }
        (void)hipGetLastError();
        grid = cus;
    }
    if (grid < 0) return;
    (void)hipMemsetAsync((char*)d_ws + WS_CTL, 0, CTL_BYTES, stream);
    Args a{};
    for (int i = 0; i < 36; ++i) a.in[i] = (const float*)d_in[i];
    a.out = (float*)d_out; a.ws = (unsigned char*)d_ws;
#if MK_ONE_LAUNCH
    a.ph_lo = 0; a.ph_hi = NPHASES;
    hipLaunchKernelGGL(fwd, dim3(grid), dim3(NTHREADS), LDS_BYTES, stream, a);
#else
    for (int p = 0; p < NPHASES; ++p) {
        a.ph_lo = p; a.ph_hi = p + 1;
        hipLaunchKernelGGL(fwd, dim3(grid), dim3(NTHREADS), LDS_BYTES, stream, a);
    }
#endif
}
```

```cpp
#include <hip/hip_runtime.h>
#include <cstdio>
#include <cstdint>

constexpr int D = 2048, NB = 4, SEQ = 4096, T = NB * SEQ;
constexpr int COL_K = 512, COL_V = 1024, COL_Z = 2048, COL_B = 3072, COL_A = 3080, COL_GATE = 3088, COL_R = 7184, COL_RK = 8208, COL_RV = 9232, N_IN = 10256;
constexpr int NE = 32, TOPK = 4, FF = 2048, NA = T * TOPK;
constexpr int RW = 1024;
constexpr float EPS = 1e-6f;
constexpr int NTHREADS = 512;
constexpr int LDS_BYTES = 128 * 1024 + 4096;

#define XB_TMO      128
#define XB_XCNT(j)  (256  + 64 * (j))
#define XB_XSUB(j)  (1280 + 64 * (j))
#define XB_XGEN(j)  (2304 + 64 * (j))
#define XB_TOP      3328
#define XB_TOPGEN   3392
#define XCD_BAR_WORDS 3456
#define XB_SPIN_CAP (1u << 22)
#define LAS __attribute__((address_space(3)))
__device__ __forceinline__ unsigned xb_ld(unsigned* p)              { return __hip_atomic_load(p, __ATOMIC_RELAXED, __HIP_MEMORY_SCOPE_AGENT); }
__device__ __forceinline__ unsigned xb_add(unsigned* p, unsigned v) { return __hip_atomic_fetch_add(p, v, __ATOMIC_RELAXED, __HIP_MEMORY_SCOPE_AGENT); }
__device__ __forceinline__ unsigned xb_xcc_id() { return (unsigned)__builtin_amdgcn_s_getreg((3 << 11) | 20) & 0xFu; }
#define XB_SPIN(cond, bar) do { unsigned _sp = 0; while (cond) { __builtin_amdgcn_s_sleep(1); \
    if ((++_sp & 255u) == 0u) { if (xb_ld(&(bar)[XB_TMO])) break; if (_sp > XB_SPIN_CAP) { atomicAdd(&(bar)[XB_TMO], 1u); break; } } } } while (0)
struct XcdBarrier { unsigned* bar; unsigned x; volatile LAS unsigned* st; };
__device__ __forceinline__ XcdBarrier xcd_barrier_post(unsigned* bar, volatile LAS unsigned* st) {
    XcdBarrier b; b.bar = bar; b.x = xb_xcc_id(); b.st = st;
    if (threadIdx.x == 0) (void)xb_add(&bar[XB_XCNT(b.x)], 1u);
    return b;
}
__device__ __forceinline__ void xcd_barrier_complete(unsigned* bar, unsigned x, unsigned& nloc, unsigned& nx) {
    const unsigned G = gridDim.x * gridDim.y * gridDim.z;
    unsigned sum, cnt, mine, sp = 0u;
    for (;;) {
        sum = 0u; cnt = 0u; mine = 0u;
#pragma unroll
        for (unsigned j = 0; j < 16; ++j) { const unsigned c = xb_ld(&bar[XB_XCNT(j)]); sum += c; cnt += (c > 0u) ? 1u : 0u; mine = (j == x) ? c : mine; }
        if (sum == G) break;
        __builtin_amdgcn_s_sleep(1);
        if ((++sp & 255u) == 0u) { if (xb_ld(&bar[XB_TMO])) break; if (sp > XB_SPIN_CAP) { atomicAdd(&bar[XB_TMO], 1u); break; } }
    }
    nloc = mine > 0u ? mine : 1u; nx = cnt > 0u ? cnt : 1u;
}
__device__ __forceinline__ void xcd_barrier(const XcdBarrier& b) {
    asm volatile("s_waitcnt vmcnt(0)" ::: "memory");
    __syncthreads();
    if (threadIdx.x == 0) {
        unsigned* bar = b.bar;
        __builtin_amdgcn_s_waitcnt(0);
        unsigned nloc = b.st[0], nx = b.st[1];
        if (nloc == 0u) { xcd_barrier_complete(bar, b.x, nloc, nx); b.st[0] = nloc; b.st[1] = nx; }
        const unsigned old = xb_add(&bar[XB_XSUB(b.x)], 1u);
        const unsigned gen = old / nloc;
        if (old + 1u == (gen + 1u) * nloc) {
            __builtin_amdgcn_fence(__ATOMIC_RELEASE, "agent");
            asm volatile("s_waitcnt vmcnt(0)" ::: "memory");
            const unsigned og = xb_add(&bar[XB_TOP], 1u);
            const unsigned tg = og / nx;
            if (og + 1u == (tg + 1u) * nx) xb_add(&bar[XB_TOPGEN], 1u);
            else XB_SPIN(xb_ld(&bar[XB_TOPGEN]) == tg, bar);
            __builtin_amdgcn_fence(__ATOMIC_ACQUIRE, "agent");
            xb_add(&bar[XB_XGEN(b.x)], 1u);
            asm volatile("s_waitcnt vmcnt(0)" ::: "memory");
        } else {
            XB_SPIN(xb_ld(&bar[XB_XGEN(b.x)]) == gen, bar);
            __builtin_amdgcn_fence(__ATOMIC_ACQUIRE, "agent");
            asm volatile("s_waitcnt vmcnt(0)" ::: "memory");
        }
    }
    __syncthreads();
}

constexpr size_t al256(size_t x) { return (x + 255) & ~(size_t)255; }
constexpr size_t WS_CTL   = 0;
constexpr size_t CTL_BYTES = 32768;
constexpr size_t CW_CNT   = XCD_BAR_WORDS + 64;
constexpr size_t WS_MOD   = WS_CTL + CTL_BYTES;
constexpr size_t WS_H     = al256(WS_MOD + (size_t)NB * 6 * D * 4);
constexpr size_t WS_WINT  = al256(WS_H + (size_t)7 * T * D * 2);
constexpr int NT_IN = 44;
constexpr size_t WS_PH    = al256(WS_WINT + (size_t)NT_IN * 256 * D * 2);
constexpr size_t WS_BA    = al256(WS_PH + (size_t)T * N_IN * 2);
constexpr size_t WS_LWA   = al256(WS_BA + (size_t)T * 16 * 4);
constexpr size_t WS_LGB   = al256(WS_LWA + (size_t)T * 256 * 2);
constexpr size_t WS_L2T   = al256(WS_LGB + (size_t)T * 256 * 2);
constexpr size_t WS_WPRE  = al256(WS_L2T + (size_t)3 * RW * 256 * 2);
constexpr size_t WS_APRE  = al256(WS_WPRE + (size_t)T * RW * 4);
constexpr size_t WS_GATE  = al256(WS_APRE + (size_t)T * RW * 4);
static_assert(WS_APRE == WS_WPRE + (size_t)T * RW * 4 && WS_GATE == WS_APRE + (size_t)T * RW * 4, "EpiLora indexes the three buffers from WPRE");
constexpr size_t WS_WD    = al256(WS_GATE + (size_t)T * RW * 4);
constexpr size_t WS_AA    = al256(WS_WD + (size_t)T * RW * 4);
constexpr size_t WS_BB    = al256(WS_AA + (size_t)T * RW * 4);
constexpr size_t WS_KM    = al256(WS_BB + (size_t)T * RW * 4);
constexpr size_t WS_OG    = al256(WS_KM + (size_t)T * RW * 4);
constexpr size_t WS_YR    = al256(WS_OG + (size_t)T * RW * 4);
constexpr size_t WS_MERGED= al256(WS_YR + (size_t)T * RW * 4);
constexpr size_t WS_Y     = al256(WS_MERGED + (size_t)T * D * 4);
constexpr size_t WS_XMID  = al256(WS_Y + (size_t)T * D * 4);
constexpr size_t WS_H2B   = al256(WS_XMID + (size_t)T * D * 4);
constexpr size_t WS_TOPP  = al256(WS_H2B + (size_t)T * D * 2);
constexpr size_t WS_LIST  = al256(WS_TOPP + (size_t)NA * 4);
constexpr int ACT_ROWS = NA + NE * 256;
constexpr size_t WS_ACT   = al256(WS_LIST + (size_t)NE * T * 4);
constexpr size_t WS_YB    = al256(WS_ACT + (size_t)ACT_ROWS * FF * 2);
constexpr size_t WS_WGU   = al256(WS_YB + (size_t)NA * D * 2);
constexpr size_t WS_WDN   = al256(WS_WGU + (size_t)NE * 2 * FF * D * 2);
constexpr size_t WS_YGB   = al256(WS_WDN + (size_t)NE * D * FF * 2);
constexpr size_t WS_YRWB  = al256(WS_YGB + (size_t)T * RW * 2);
constexpr size_t WS_WUPG  = al256(WS_YRWB + (size_t)T * RW * 2);
constexpr size_t WS_WUPR  = al256(WS_WUPG + (size_t)D * RW * 2);
constexpr size_t WS_WOUT  = al256(WS_WUPR + (size_t)D * RW * 2);
constexpr size_t WS_MRGB  = al256(WS_WOUT + (size_t)D * D * 2);
constexpr size_t WS_GREC  = al256(WS_MRGB + (size_t)T * D * 2);
constexpr size_t WS_END   = al256(WS_GREC + (size_t)2048 * 90368);

struct Args {
    const float* in[36];
    float* out;
    unsigned char* ws;
    int ph_lo, ph_hi;
};

__device__ __forceinline__ float sigmoidf_(float x) { return 1.0f / (1.0f + expf(-x)); }
__device__ __forceinline__ float siluf_(float x) { return x * sigmoidf_(x); }
__device__ __forceinline__ float softplusf_(float x) { return fmaxf(x, 0.0f) + log1pf(expf(-fabsf(x))); }
__device__ __forceinline__ float rl(float x, int k) { return __int_as_float(__builtin_amdgcn_readlane(__float_as_int(x), k)); }
__device__ __forceinline__ float wave_sum(float v) {
#pragma unroll
    for (int o = 32; o > 0; o >>= 1) v += __shfl_xor(v, o);
    return v;
}
__device__ __forceinline__ float half_sum(float v) {
#pragma unroll
    for (int o = 16; o > 0; o >>= 1) v += __shfl_xor(v, o);
    return v;
}
__device__ __forceinline__ float block_sum(float v, float* red) {
    v = wave_sum(v);
    __syncthreads();
    if ((threadIdx.x & 63) == 0) red[threadIdx.x >> 6] = v;
    __syncthreads();
    float t = 0.f;
#pragma unroll
    for (int w = 0; w < NTHREADS / 64; ++w) t += red[w];
    return t;
}

constexpr int GBM = 128, GBN = 64, GBK = 16;
template <bool DUAL, class AL, class EP>
__device__ __forceinline__ void gemm_naive(float* sm, int M, int N, int K, const AL& al, const float* __restrict__ W, int ldw, int dual_off, const EP& ep) {
    float* As = sm;
    float* Bs = sm + GBK * (GBM + 4);
    float* Bs2 = Bs + GBK * (GBN + 4);
    const int tid = threadIdx.x, tx = tid & 15, ty = tid >> 4;
    const int ntm = (M + GBM - 1) / GBM, ntn = (N + GBN - 1) / GBN;
    for (int tile = blockIdx.x; tile < ntm * ntn; tile += gridDim.x) {
        const int tm = tile / ntn, tn = tile % ntn;
        const int m0 = tm * GBM, n0 = tn * GBN;
        float acc[4][4], acc2[4][4];
#pragma unroll
        for (int i = 0; i < 4; ++i)
#pragma unroll
            for (int j = 0; j < 4; ++j) { acc[i][j] = 0.f; acc2[i][j] = 0.f; }
        for (int k0 = 0; k0 < K; k0 += GBK) {
#pragma unroll
            for (int i = 0; i < 4; ++i) { const int idx = tid + i * NTHREADS, r = idx >> 4, kk = idx & 15; As[kk * (GBM + 4) + r] = al(m0 + r, k0 + kk); }
#pragma unroll
            for (int i = 0; i < 2; ++i) { const int idx = tid + i * NTHREADS, kk = idx >> 6, c = idx & 63, n = n0 + c;
                Bs[kk * (GBN + 4) + c] = (n < N) ? W[(size_t)(k0 + kk) * ldw + n] : 0.f;
                if (DUAL) Bs2[kk * (GBN + 4) + c] = (n < N) ? W[(size_t)(k0 + kk) * ldw + n + dual_off] : 0.f; }
            __syncthreads();
#pragma unroll
            for (int kk = 0; kk < GBK; ++kk) {
                float a[4], b[4], b2[4];
#pragma unroll
                for (int i = 0; i < 4; ++i) a[i] = As[kk * (GBM + 4) + ty * 4 + i];
#pragma unroll
                for (int j = 0; j < 4; ++j) { b[j] = Bs[kk * (GBN + 4) + tx * 4 + j]; b2[j] = DUAL ? Bs2[kk * (GBN + 4) + tx * 4 + j] : 0.f; }
#pragma unroll
                for (int i = 0; i < 4; ++i)
#pragma unroll
                    for (int j = 0; j < 4; ++j) { acc[i][j] = fmaf(a[i], b[j], acc[i][j]); if (DUAL) acc2[i][j] = fmaf(a[i], b2[j], acc2[i][j]); }
            }
            __syncthreads();
        }
#pragma unroll
        for (int i = 0; i < 4; ++i)
#pragma unroll
            for (int j = 0; j < 4; ++j) { const int m = m0 + ty * 4 + i, n = n0 + tx * 4 + j; if (m < M && n < N) ep(m, n, acc[i][j], acc2[i][j]); }
    }
}

struct ALPlain { const float* A; int lda; __device__ __forceinline__ float operator()(int m, int k) const { return A[(size_t)m * lda + k]; } };
struct ALMix {
    const float* H; const float* mix;
    __device__ __forceinline__ float operator()(int m, int k) const {
        const float h = H[(size_t)m * D + k];
        const float hp = ((m % SEQ) == 0) ? 0.f : H[(size_t)(m - 1) * D + k];
        return h + (hp - h) * mix[k];
    }
};
struct ALGatherTok { const float* H2; const int* list; int cnt; __device__ __forceinline__ float operator()(int m, int k) const { return (m < cnt) ? H2[(size_t)(list[m] >> 2) * D + k] : 0.f; } };
struct ALGatherAsg { const float* ACT; const int* list; int cnt; __device__ __forceinline__ float operator()(int m, int k) const { return (m < cnt) ? ACT[(size_t)list[m] * FF + k] : 0.f; } };

namespace pg8 {
#define PG8_LAS __attribute__((address_space(3)))
typedef unsigned short bf16_t;
typedef short bf16x8 __attribute__((ext_vector_type(8)));
typedef float f32x4 __attribute__((ext_vector_type(4)));
typedef unsigned u32x4 __attribute__((ext_vector_type(4)));
typedef unsigned u32x2 __attribute__((ext_vector_type(2)));
constexpr int BM = 256, BK = 64, HALF = 128, HTB = HALF * BK * 2, STAGE_BYTES = 8 * HTB, NXCD = 8, WGM = 2;
__host__ __device__ __forceinline__ int lds_byte(int r, int c) { const int st = (r >> 4) * 2 + (c >> 5), rr = r & 15, cc = c & 31, ob = rr * 64 + cc * 2; return st * 1024 + (ob ^ (((ob >> 9) & 1) << 5)); }
__host__ __device__ __forceinline__ void stage_rc(int b, int& R, int& C) { const int st = b / 1024, sb = b % 1024, swz = sb ^ (((sb >> 9) & 1) << 5); R = (st >> 1) * 16 + swz / 64; C = (st & 1) * 32 + (swz % 64) / 2; }
__host__ __device__ __forceinline__ int perm32(int rho) { const int n = rho >> 4, i = rho & 15; return 8 * (i >> 2) + 4 * n + (i & 3); }
struct Unit { int pm, pn; const char* A; const char* B; const int* list; int cnt, e, prow, gat; };
typedef __bf16 bf16x2_t __attribute__((ext_vector_type(2)));
__device__ __forceinline__ unsigned cvt_pk_bf16(float lo, float hi) { bf16x2_t v; v.x = (__bf16)lo; v.y = (__bf16)hi; return __builtin_bit_cast(unsigned, v); }
__device__ __forceinline__ bool static_order(int nM, int nN, int G, int c, int i, int& pm, int& pn) {
    const int nwg = nM * nN; const long L = (long)i * G + c; if (L >= nwg) return false;
    int wgid = (int)L; { const int q = nwg / NXCD, r = nwg % NXCD, xcd = wgid % NXCD, off = wgid / NXCD; wgid = (xcd < r ? xcd * (q + 1) : r * (q + 1) + (xcd - r) * q) + off; }
    const int nig = WGM * nN, gid = wgid / nig, fm = gid * WGM, gsz = (nM - fm) < WGM ? (nM - fm) : WGM;
    pm = fm + ((wgid % nig) % gsz); pn = (wgid % nig) / gsz; return true;
}
template <class Epi, class Sched, bool ALIGN_EPI = true, bool GATHER = false, bool FP8 = false>
__device__ __forceinline__ void gemm_phase(PG8_LAS unsigned char* lds, const int K_, const Sched& S, const Epi& E) {
    const int tid = threadIdx.x, wid = __builtin_amdgcn_readfirstlane(tid >> 6), lane = tid & 63, wr = wid >> 2, wc = wid & 3, fr = lane & 15, fq = lane >> 4;
    const int K = K_, KB = FP8 ? K_ : 2 * K_, nt = KB / 128;
    unsigned voffA0, voffB0;
    { int R, C; stage_rc(tid * 16, R, C); const int Rb = Epi::PERM ? ((R & ~31) + perm32(R & 31)) : R;
      voffA0 = (unsigned)(R * KB + C * 2); voffB0 = (unsigned)(Rb * KB + C * 2); }
    const size_t pstep = (size_t)64 * KB;
    const size_t kstep = (size_t)(BK * 2);
    const size_t hstep = (size_t)HALF * KB;
    const size_t tstep = 2 * hstep; (void)tstep;
    const unsigned ldsw = (unsigned)wid * 1024u;
    const int cole = FP8 ? ((fq >> 1) * 32 + (fq & 1) * 16) : fq * 8;
    const int aoff = lds_byte(wr * 64 + fr, cole), boff = aoff + (wc * 2 - wr * 4) * 2048;
    typedef int _i8 __attribute__((ext_vector_type(8))); typedef _i8 _i8a __attribute__((aligned(16)));
    constexpr bool SP2 = true;
    unsigned vA_c[2][2];
    PG8_LAS unsigned* gtab = (PG8_LAS unsigned*)(lds + STAGE_BYTES + 1024);
#define PG8_FILLTAB(u) do { int _t = threadIdx.x; asm volatile("" : "+v"(_t));   if (_t < 256) { const int _m = (u).pm * 256 + _t; \
        const int _tok = (u).gat ? ((_m < (u).cnt) ? ((u).list[_m] >> 2) : 0) : _t;     \
        gtab[_t] = (unsigned)_tok * (unsigned)KB; } } while (0)
#define PG8_SETVA(v, u) do { int _t2 = threadIdx.x; if constexpr (GATHER) asm volatile("" : "+v"(_t2)); _Pragma("unroll") for (int _h = 0; _h < 2; ++_h) _Pragma("unroll") for (int _i = 0; _i < 2; ++_i) { \
        if constexpr (GATHER) { int _R, _C; stage_rc(_t2 * 16 + _i * 8192, _R, _C); (v)[_h][_i] = gtab[_h * 128 + _R] + (unsigned)(_C * 2); } \
        else (v)[_h][_i] = 0u; } } while (0)
#define PG8_STAGE_A(bufoff, gbase, h, nx) do { _Pragma("unroll") for (int _i = 0; _i < 2; ++_i) { \
        const char* _src = GATHER ? (const char*)(gbase) + vA_c[h][_i] : (const char*)(gbase) + (size_t)(h) * hstep + (size_t)_i * pstep + voffA0; \
        __builtin_amdgcn_global_load_lds((const unsigned*)_src, (PG8_LAS unsigned*)(lds + (bufoff) + ldsw + _i * 8192), 16, 0, 0); } } while (0)
#define PG8_SA(b, h) (((b) * 2 + (h)) * HTB)
#define PG8_SB(b, h) ((4 + (b) * 2 + (h)) * HTB)
#define PG8_STAGE(bufoff, gbase, voff) do { _Pragma("unroll") for (int _i = 0; _i < 2; ++_i) \
        __builtin_amdgcn_global_load_lds((const unsigned*)((const char*)(gbase) + (size_t)_i * pstep + voff##0), (PG8_LAS unsigned*)(lds + (bufoff) + ldsw + _i * 8192), 16, 0, 0); } while (0)
#define PG8_LDA(dst, b, h) do { _Pragma("unroll") for (int m = 0; m < 4; ++m) { \
        if constexpr (FP8) { dst##8[m] = *(const PG8_LAS _i8a*)(lds + PG8_SA(b, h) + aoff + m * 2048); } \
        else { _Pragma("unroll") for (int k = 0; k < 2; ++k) dst[m][k] = *(const PG8_LAS bf16x8*)(lds + PG8_SA(b, h) + aoff + m * 2048 + k * 1024); } } } while (0)
#define PG8_LDB(dst, b, h) do { _Pragma("unroll") for (int n = 0; n < 2; ++n) { \
        if constexpr (FP8) { dst##8[n] = *(const PG8_LAS _i8a*)(lds + PG8_SB(b, h) + boff + n * 2048); } \
        else { _Pragma("unroll") for (int k = 0; k < 2; ++k) dst[n][k] = *(const PG8_LAS bf16x8*)(lds + PG8_SB(b, h) + boff + n * 2048 + k * 1024); } } } while (0)
#define PG8_MMA(ai, bj, At, Bt) do { __builtin_amdgcn_s_setprio(1); _Pragma("unroll") for (int m = 0; m < 4; ++m) _Pragma("unroll") for (int n = 0; n < 2; ++n) { \
        if constexpr (FP8) acc[ai][bj][m][n] = __builtin_amdgcn_mfma_scale_f32_16x16x128_f8f6f4(Bt##8[n], At##8[m], acc[ai][bj][m][n], 0, 0, 0, 127, 0, 127); \
        else { _Pragma("unroll") for (int k = 0; k < 2; ++k) acc[ai][bj][m][n] = __builtin_amdgcn_mfma_f32_16x16x32_bf16(Bt[n][k], At[m][k], acc[ai][bj][m][n], 0, 0, 0); } } \
        __builtin_amdgcn_s_setprio(0); } while (0)
#define PG8_WAIT_V(n) asm volatile("s_waitcnt vmcnt(" #n ")" ::: "memory")
#define PG8_WAIT_L(n) asm volatile("s_waitcnt lgkmcnt(" #n ")" ::: "memory")
#define PG8_BAR __builtin_amdgcn_s_barrier()
#define PG8_SCHED __builtin_amdgcn_sched_barrier(0)
    Unit cur, nxt; int ui = 0;
    if (!S.next(0, cur)) return;
    f32x4 acc[2][2][4][2];
#pragma unroll
    for (int a = 0; a < 2; ++a)
#pragma unroll
        for (int b = 0; b < 2; ++b)
#pragma unroll
            for (int m = 0; m < 4; ++m)
#pragma unroll
                for (int n = 0; n < 2; ++n) acc[a][b][m][n] = (f32x4){0.f, 0.f, 0.f, 0.f};
    bf16x8 At[4][2], B0[2][2], B1[2][2]; _i8 At8[4], B08[2], B18[2];
    const char* cA = cur.A; const char* cB = cur.B;
    S.a_ready(cur);
    if constexpr (GATHER) { PG8_FILLTAB(cur); __syncthreads(); }
    PG8_SETVA(vA_c, cur);
    if constexpr (GATHER) __syncthreads();
    if constexpr (SP2) {
        PG8_STAGE(PG8_SB(0, 0), cB, voffB); PG8_STAGE(PG8_SB(0, 1), cB + hstep, voffB); PG8_STAGE_A(PG8_SA(0, 0), cA, 0, false); PG8_STAGE_A(PG8_SA(0, 1), cA, 1, false);
        if (wr == 1) PG8_BAR;
        PG8_WAIT_V(2); PG8_BAR;
        PG8_STAGE(PG8_SB(1, 0), cB + kstep, voffB); PG8_STAGE_A(PG8_SA(1, 0), cA + kstep, 0, false); PG8_STAGE(PG8_SB(1, 1), cB + hstep + kstep, voffB);
        PG8_WAIT_V(6); PG8_BAR;
    }
    for (;;) {
        const bool has_next = S.next(ui + 1, nxt);
        const char* nA = has_next ? nxt.A : cA; const char* nB = has_next ? nxt.B : cB;
        if constexpr (GATHER) { if (has_next) PG8_FILLTAB(nxt); }
        for (int t = 0; t < nt; t += 2) {
            const bool last = (t == nt - 2); const bool lastn = last && has_next; (void)lastn;
            const char* a1 = cA + (size_t)(t + 1) * kstep;
            const char* a2 = last ? nA : cA + (size_t)(t + 2) * kstep; const char* b2 = last ? nB : cB + (size_t)(t + 2) * kstep;
            const char* a3 = a2 + kstep; const char* b3 = b2 + kstep;
            if (last && has_next) S.a_ready(nxt);
            if constexpr (SP2) {
            PG8_LDB(B0, 0, 0); PG8_LDB(B1, 0, 1); PG8_SCHED; PG8_LDA(At, 0, 0); PG8_STAGE_A(PG8_SA(1, 1), a1, 1, false);
            PG8_WAIT_V(8); PG8_WAIT_L(0); PG8_BAR; PG8_MMA(0, 0, At, B0); PG8_MMA(0, 1, At, B1); PG8_BAR; PG8_SCHED;
            if constexpr (GATHER) { if (lastn) PG8_SETVA(vA_c, nxt); }
            PG8_LDA(At, 0, 1); PG8_STAGE(PG8_SB(0, 0), b2, voffB); PG8_STAGE(PG8_SB(0, 1), b2 + hstep, voffB); PG8_STAGE_A(PG8_SA(0, 0), a2, 0, lastn);
            PG8_WAIT_V(8); PG8_WAIT_L(0); PG8_BAR; PG8_MMA(1, 0, At, B0); PG8_MMA(1, 1, At, B1); PG8_BAR; PG8_SCHED;
            PG8_LDB(B0, 1, 0); PG8_LDB(B1, 1, 1); PG8_SCHED; PG8_LDA(At, 1, 0); PG8_STAGE_A(PG8_SA(0, 1), a2, 1, lastn);
            PG8_WAIT_V(8); PG8_WAIT_L(0); PG8_BAR; PG8_MMA(0, 0, At, B0); PG8_MMA(0, 1, At, B1); PG8_BAR; PG8_SCHED;
            PG8_LDA(At, 1, 1); PG8_STAGE(PG8_SB(1, 0), b3, voffB); PG8_STAGE(PG8_SB(1, 1), b3 + hstep, voffB); PG8_STAGE_A(PG8_SA(1, 0), a3, 0, lastn);
            PG8_WAIT_V(8); PG8_WAIT_L(0); PG8_BAR; PG8_MMA(1, 0, At, B0); PG8_MMA(1, 1, At, B1); PG8_BAR; PG8_SCHED;
            }
        }
        if constexpr (ALIGN_EPI) { if (wr == 0) PG8_BAR; }
        asm volatile("" ::: "memory");
        bool chained = false;
        if constexpr (!Epi::AFTER_DRAIN) { if constexpr (Epi::CHAIN) { if (cur.e == 0) { E.mid(acc, cur, wr, wc, fr, fq); chained = true; } else E(acc, cur, wr, wc, fr, fq); } else E(acc, cur, wr, wc, fr, fq); S.done(cur); }
        if (!has_next) break;
        if (!chained) {
#pragma unroll
        for (int a = 0; a < 2; ++a)
#pragma unroll
            for (int b = 0; b < 2; ++b)
#pragma unroll
                for (int m = 0; m < 4; ++m)
#pragma unroll
                    for (int n = 0; n < 2; ++n) acc[a][b][m][n] = (f32x4){0.f, 0.f, 0.f, 0.f};
        }
        cur = nxt; cA = nA; cB = nB; ++ui;
        if constexpr (ALIGN_EPI) { if (wr == 1) PG8_BAR; }
    }
    PG8_WAIT_V(0);
    if constexpr (!ALIGN_EPI) { if (wr == 0) PG8_BAR; }
    PG8_BAR;
    if constexpr (Epi::AFTER_DRAIN) { E.fused(acc, cur, wr, wc, fr, fq, lds, wid, lane); S.done(cur); }
#undef PG8_SA
#undef PG8_SB
#undef PG8_STAGE
#undef PG8_STAGE_A
#undef PG8_SETVA
#undef PG8_FILLTAB
#undef PG8_LDA
#undef PG8_LDB
#undef PG8_MMA
#undef PG8_WAIT_V
#undef PG8_WAIT_L
#undef PG8_BAR
#undef PG8_SCHED
}
}


typedef float f32x4_t __attribute__((ext_vector_type(4)));
__device__ __forceinline__ f32x4_t ld_bf4(const unsigned short* p) { const pg8::u32x2 v = *(const pg8::u32x2*)p; return (f32x4_t){__uint_as_float(v.x << 16), __uint_as_float(v.x & 0xffff0000u), __uint_as_float(v.y << 16), __uint_as_float(v.y & 0xffff0000u)}; }
__device__ __forceinline__ void ld_bf8(const unsigned short* p, f32x4_t& lo, f32x4_t& hi) { const pg8::u32x4 v = *(const pg8::u32x4*)p;
    lo = (f32x4_t){__uint_as_float(v.x << 16), __uint_as_float(v.x & 0xffff0000u), __uint_as_float(v.y << 16), __uint_as_float(v.y & 0xffff0000u)};
    hi = (f32x4_t){__uint_as_float(v.z << 16), __uint_as_float(v.z & 0xffff0000u), __uint_as_float(v.w << 16), __uint_as_float(v.w & 0xffff0000u)}; }
__device__ __forceinline__ float ld_bf1(const unsigned short* p) { return __uint_as_float((unsigned)(*p) << 16); }
struct SchedInProj {
    int G, c; const char* Abase; const char* Bt;
    __device__ __forceinline__ bool next(int i, pg8::Unit& u) const {
        int pm, pn; if (!pg8::static_order(T / 256, NT_IN, G, c, i, pm, pn)) return false;
        const int ai = pn < 29 ? 0 : pn < 33 ? 1 : pn < 37 ? 3 : pn < 41 ? 4 : pn == 41 ? 2 : pn == 42 ? 5 : 6;
        u.pm = pm; u.pn = pn; u.A = Abase + ((size_t)ai * T + (size_t)pm * 256) * D * 2; u.B = Bt + (size_t)pn * 256 * D * 2; u.list = nullptr; u.cnt = 0; u.e = 0; u.prow = 0; u.gat = 0; return true;
    }
    __device__ __forceinline__ void a_ready(const pg8::Unit&) const {}
    __device__ __forceinline__ void done(const pg8::Unit&) const {}
};
__device__ __forceinline__ float fast_sigmoid(float x) { return __builtin_amdgcn_rcpf(1.0f + __builtin_amdgcn_exp2f(-1.4426950408889634f * x)); }
__device__ __forceinline__ float fast_tanh(float x) { return 1.0f - 2.0f * __builtin_amdgcn_rcpf(1.0f + __builtin_amdgcn_exp2f(2.8853900817779268f * x)); }
struct EpiInProjF32 {
    static constexpr bool PERM = true, AFTER_DRAIN = false, CHAIN = false;
    unsigned short* PH; float* BA; unsigned short* LWA; unsigned short* LGB;
    __device__ __forceinline__ void operator()(const pg8::f32x4 (&acc)[2][2][4][2], const pg8::Unit& u, int wr, int wc, int fr, int fq) const {
        const int pn = u.pn; unsigned short* b16 = PH; unsigned ld = N_IN; int ncol = 256, act = 0;
        if (pn < 12) b16 = PH + pn * 256;
        else if (pn < 28) { b16 = PH + COL_GATE + (pn - 12) * 256; act = 2; }
        else if (pn == 28) { act = 4; ncol = 16; }
        else if (pn < 41) b16 = PH + COL_R + (pn - 29) * 256;
        else if (pn == 41) { act = 1; ncol = 128; b16 = LWA; ld = 256; }
        else if (pn == 42) { act = 3; ncol = 128; b16 = LWA + 128; ld = 256; }
        else { act = 2; b16 = LGB; ld = 256; }
        const unsigned row0 = (unsigned)u.pm * 256u + wr * 64 + fr;
#pragma unroll
        for (int ai = 0; ai < 2; ++ai)
#pragma unroll
            for (int m = 0; m < 4; ++m) {
                const unsigned row = row0 + ai * 128 + m * 16;
#pragma unroll
                for (int bj = 0; bj < 2; ++bj) {
                    const int cl = bj * 128 + wc * 32 + 8 * fq;
                    pg8::f32x4 v0 = acc[ai][bj][m][0], v1 = acc[ai][bj][m][1];
                    if (act == 4) { if (cl < ncol) { float* dst = BA + (size_t)row * 16 + cl; *(pg8::f32x4*)dst = v0; *(pg8::f32x4*)(dst + 4) = v1; } }
                    else {
                        if (act == 1) {
#pragma unroll
                            for (int j = 0; j < 4; ++j) { v0[j] = fast_tanh(v0[j]); v1[j] = fast_tanh(v1[j]); } }
                        if (act == 2) {
#pragma unroll
                            for (int j = 0; j < 4; ++j) { v0[j] = fast_sigmoid(v0[j]); v1[j] = fast_sigmoid(v1[j]); } }
                        if ((act == 1 || act == 3) && cl >= 96) { v0 = (pg8::f32x4){0.f, 0.f, 0.f, 0.f}; v1 = v0; }
                        if (cl < ncol) { pg8::u32x4 w; w.x = pg8::cvt_pk_bf16(v0[0], v0[1]); w.y = pg8::cvt_pk_bf16(v0[2], v0[3]); w.z = pg8::cvt_pk_bf16(v1[0], v1[1]); w.w = pg8::cvt_pk_bf16(v1[2], v1[3]);
                            *(pg8::u32x4*)(b16 + (size_t)row * ld + cl) = w; }
                    }
                }
            }
    }
};
struct SchedLora {
    int G, c; const char* LWA; const char* LGB; const char* L2T;
    __device__ __forceinline__ bool next(int i, pg8::Unit& u) const {
        int pm, pn; if (!pg8::static_order(T / 256, 12, G, c, i, pm, pn)) return false;
        const int g = pn >> 2;
        u.pm = pm; u.pn = pn; u.e = g; u.A = (g < 2 ? LWA : LGB) + (size_t)pm * 256 * 256 * 2; u.B = L2T + ((size_t)g * RW + (size_t)(pn & 3) * 256) * 256 * 2; u.list = nullptr; u.cnt = 0; u.prow = 0; u.gat = 0; return true;
    }
    __device__ __forceinline__ void a_ready(const pg8::Unit&) const {}
    __device__ __forceinline__ void done(const pg8::Unit&) const {}
};
__device__ __forceinline__ float fast_softplus(float x);
__device__ __forceinline__ float rw_decay(float w) { return __builtin_amdgcn_exp2f(-1.4426950408889634f * __builtin_amdgcn_exp2f(1.4426950408889634f * (-fast_softplus(-w) - 0.5f))); }
struct EpiLora {
    static constexpr bool PERM = true, AFTER_DRAIN = false, CHAIN = false;
    float* WPRE; float* APRE; float* GATE; const float* w0; const float* a0;
    __device__ __forceinline__ void operator()(const pg8::f32x4 (&acc)[2][2][4][2], const pg8::Unit& u, int wr, int wc, int fr, int fq) const {
        const int g = u.e; float* C = WPRE + (size_t)g * T * RW;        const float* bias = g == 0 ? w0 : a0;
        const unsigned row0 = (unsigned)u.pm * 256u + wr * 64 + fr; const int col0 = (u.pn & 3) * 256 + wc * 32 + 8 * fq;
        pg8::f32x4 bv[2][2];
#pragma unroll
        for (int bj = 0; bj < 2; ++bj)
#pragma unroll
            for (int n = 0; n < 2; ++n) bv[bj][n] = (g < 2) ? *(const pg8::f32x4*)(bias + col0 + 128 * bj + 4 * n) : (pg8::f32x4){0.f, 0.f, 0.f, 0.f};
#pragma unroll
        for (int ai = 0; ai < 2; ++ai)
#pragma unroll
            for (int m = 0; m < 4; ++m) {
                float* rp = C + (size_t)(row0 + ai * 128 + m * 16) * RW + col0;
#pragma unroll
                for (int bj = 0; bj < 2; ++bj) {
                    pg8::f32x4 v0 = acc[ai][bj][m][0] + bv[bj][0], v1 = acc[ai][bj][m][1] + bv[bj][1];
                    if (g == 0) { v0 = (pg8::f32x4){rw_decay(v0[0]), rw_decay(v0[1]), rw_decay(v0[2]), rw_decay(v0[3])}; v1 = (pg8::f32x4){rw_decay(v1[0]), rw_decay(v1[1]), rw_decay(v1[2]), rw_decay(v1[3])}; }
                    else if (g == 1) { v0 = (pg8::f32x4){fast_sigmoid(v0[0]), fast_sigmoid(v0[1]), fast_sigmoid(v0[2]), fast_sigmoid(v0[3])}; v1 = (pg8::f32x4){fast_sigmoid(v1[0]), fast_sigmoid(v1[1]), fast_sigmoid(v1[2]), fast_sigmoid(v1[3])}; }
                    if (g == 0) { *(pg8::f32x4*)(rp + 128 * bj) = v0; *(pg8::f32x4*)(rp + 128 * bj + 4) = v1; }
                    else {
                        unsigned short* r16 = (unsigned short*)(WPRE + (size_t)g * T * RW) + (size_t)(row0 + ai * 128 + m * 16) * RW + col0 + 128 * bj;
                        pg8::u32x4 w; w.x = pg8::cvt_pk_bf16(v0[0], v0[1]); w.y = pg8::cvt_pk_bf16(v0[2], v0[3]); w.z = pg8::cvt_pk_bf16(v1[0], v1[1]); w.w = pg8::cvt_pk_bf16(v1[2], v1[3]);
                        *(pg8::u32x4*)r16 = w;
                    }
                    __builtin_amdgcn_sched_barrier(0);
                }
            }
    }
};

struct SchedMoE {
    int G, c, nN, nrows; const LAS int* tab; const int* LIST; const char* Abase; const char* W; bool gatherA; int esz;
    __device__ __forceinline__ bool next(int i, pg8::Unit& u) const {
        const int L = i * G + c; const int total = __builtin_amdgcn_readfirstlane(tab[32]) * nN; if (L >= total) return false;
        int e = 0;
        for (int k = 1; k < NE; ++k) if (__builtin_amdgcn_readfirstlane(tab[k]) * nN <= L) e = k;
        const int t0 = __builtin_amdgcn_readfirstlane(tab[e]), t1 = __builtin_amdgcn_readfirstlane(tab[e + 1]);
        const int q = L - t0 * nN, mt = t1 - t0;
        u.pm = q % mt; u.pn = q / mt; u.e = e; u.cnt = __builtin_amdgcn_readfirstlane(tab[128 + e]); u.list = LIST + (size_t)e * T; u.prow = t0 * 256 + u.pm * 256;
        u.gat = gatherA ? 1 : 0; u.A = gatherA ? Abase : Abase + (size_t)u.prow * D * esz;
        u.B = W + ((size_t)e * nrows + (size_t)u.pn * 256) * D * esz; return true;
    }
    __device__ __forceinline__ void a_ready(const pg8::Unit&) const {}
    __device__ __forceinline__ void done(const pg8::Unit&) const {}
};
typedef float f32x2_t __attribute__((ext_vector_type(2)));
__device__ __forceinline__ f32x2_t swiglu2(f32x2_t ga, f32x2_t ua, f32x2_t bg, f32x2_t bu) {
    const f32x2_t g = ga * 0.015625f + bg, u = ua * 0.015625f + bu;
    const f32x2_t gl = {fminf(g[0], 7.0f), fminf(g[1], 7.0f)}, ul = {fminf(fmaxf(u[0], -7.0f), 7.0f), fminf(fmaxf(u[1], -7.0f), 7.0f)};
    const f32x2_t t = gl * (-1.702f * 1.4426950408889634f);
    const f32x2_t d = (f32x2_t){__builtin_amdgcn_exp2f(t[0]), __builtin_amdgcn_exp2f(t[1])} + 1.0f;
    const f32x2_t rc = {__builtin_amdgcn_rcpf(d[0]), __builtin_amdgcn_rcpf(d[1])};
    return (gl * rc) * (ul * 4.0f + 4.0f);
}
struct EpiGU {
    static constexpr bool PERM = true, AFTER_DRAIN = false, CHAIN = false;
    unsigned char* ACT; const float* bgu;
    __device__ __forceinline__ void operator()(const pg8::f32x4 (&acc)[2][2][4][2], const pg8::Unit& u, int wr, int wc, int fr, int fq) const {
        const float* bg = bgu + (size_t)u.e * 2 * FF; const int f0 = 128 * u.pn + 16 * wc + 4 * fq;
        pg8::f32x4 bgv[2], buv[2];
#pragma unroll
        for (int bj = 0; bj < 2; ++bj) { bgv[bj] = *(const pg8::f32x4*)(bg + f0 + 64 * bj); buv[bj] = *(const pg8::f32x4*)(bg + FF + f0 + 64 * bj); }
        const unsigned row0 = (unsigned)u.prow + wr * 64 + fr;
#pragma unroll
        for (int ai = 0; ai < 2; ++ai)
#pragma unroll
            for (int m = 0; m < 4; ++m) {
                const unsigned row = row0 + ai * 128 + m * 16;
#pragma unroll
                for (int bj = 0; bj < 2; ++bj) {
                    const pg8::f32x4 ga = acc[ai][bj][m][0], ua = acc[ai][bj][m][1];
                    const f32x2_t a01 = swiglu2((f32x2_t){ga[0], ga[1]}, (f32x2_t){ua[0], ua[1]}, (f32x2_t){bgv[bj][0], bgv[bj][1]}, (f32x2_t){buv[bj][0], buv[bj][1]});
                    const f32x2_t a23 = swiglu2((f32x2_t){ga[2], ga[3]}, (f32x2_t){ua[2], ua[3]}, (f32x2_t){bgv[bj][2], bgv[bj][3]}, (f32x2_t){buv[bj][2], buv[bj][3]});
                    int w8 = __builtin_amdgcn_cvt_pk_fp8_f32(a01[0], a01[1], 0, false); w8 = __builtin_amdgcn_cvt_pk_fp8_f32(a23[0], a23[1], w8, true);
                    *(int*)(ACT + (size_t)row * FF + f0 + 64 * bj) = w8;
                }
            }
    }
};
struct EpiDown {
    static constexpr bool PERM = true, AFTER_DRAIN = false, CHAIN = false;
    unsigned short* YB; const float* bd;
    __device__ __forceinline__ void operator()(const pg8::f32x4 (&acc)[2][2][4][2], const pg8::Unit& u, int wr, int wc, int fr, int fq) const {
        const float* b = bd + (size_t)u.e * D; const int col0 = u.pn * 256 + wc * 32 + 8 * fq;
        pg8::f32x4 bv[2][2];
#pragma unroll
        for (int bj = 0; bj < 2; ++bj)
#pragma unroll
            for (int n = 0; n < 2; ++n) bv[bj][n] = *(const pg8::f32x4*)(b + col0 + 128 * bj + 4 * n);
        const int ml0 = u.pm * 256 + wr * 64 + fr;
#pragma unroll
        for (int ai = 0; ai < 2; ++ai)
#pragma unroll
            for (int m = 0; m < 4; ++m) {
                const int ml = ml0 + ai * 128 + m * 16;
                if (ml < u.cnt) {
                    const unsigned asg = (unsigned)u.list[ml];
#pragma unroll
                    for (int bj = 0; bj < 2; ++bj) {
                        const pg8::f32x4 v0 = acc[ai][bj][m][0] * 0.00390625f + bv[bj][0], v1 = acc[ai][bj][m][1] * 0.00390625f + bv[bj][1];
                        pg8::u32x4 w; w.x = pg8::cvt_pk_bf16(v0[0], v0[1]); w.y = pg8::cvt_pk_bf16(v0[2], v0[3]); w.z = pg8::cvt_pk_bf16(v1[0], v1[1]); w.w = pg8::cvt_pk_bf16(v1[2], v1[3]);
                        *(pg8::u32x4*)(YB + (size_t)asg * D + col0 + 128 * bj) = w;
                    }
                }
            }
    }
};
__device__ __forceinline__ void moe_tables(LAS int* tab, const unsigned* CNT) {
    if (threadIdx.x == 0) {
        int acc = 0;
        for (int e = 0; e < NE; ++e) { const int c = (int)__hip_atomic_load(&CNT[e], __ATOMIC_RELAXED, __HIP_MEMORY_SCOPE_AGENT); tab[e] = acc; tab[64 + e] = acc * 256; tab[128 + e] = c; acc += (c + 255) >> 8; }
        tab[32] = acc; tab[96] = acc * 256;
    }
    __syncthreads();
}
__device__ __forceinline__ float bf2f(unsigned short h) { return __uint_as_float((unsigned)h << 16); }


__device__ __forceinline__ f32x4_t fmaxf_v(f32x4_t v) { return (f32x4_t){fmaxf(v[0], 1e-30f), fmaxf(v[1], 1e-30f), fmaxf(v[2], 1e-30f), fmaxf(v[3], 1e-30f)}; }
struct SchedUp {
    int G, c; const char* A0; const char* A1; const char* B0; const char* B1;
    __device__ __forceinline__ bool next(int i, pg8::Unit& u) const {
        int pm, pn; if (!pg8::static_order(T / 256, D / 256, G, c, i >> 1, pm, pn)) return false;
        const int sb = i & 1;
        u.pm = pm; u.pn = pn; u.e = sb; u.A = (sb ? A1 : A0) + (size_t)pm * 256 * RW * 2; u.B = (sb ? B1 : B0) + (size_t)pn * 256 * RW * 2; u.list = nullptr; u.cnt = 0; u.prow = 0; u.gat = 0; return true;
    }
    __device__ __forceinline__ void a_ready(const pg8::Unit&) const {}
    __device__ __forceinline__ void done(const pg8::Unit&) const {}
};
struct EpiUp {
    static constexpr bool PERM = true, AFTER_DRAIN = false, CHAIN = true;
    unsigned short* MB; const unsigned short* PH;
    __device__ __forceinline__ void mid(pg8::f32x4 (&acc)[2][2][4][2], const pg8::Unit& u, int wr, int wc, int fr, int fq) const {
        const unsigned row0 = (unsigned)u.pm * 256u + wr * 64 + fr; const int col0 = u.pn * 256 + wc * 32 + 8 * fq;
#pragma unroll
        for (int ai = 0; ai < 2; ++ai)
#pragma unroll
            for (int m = 0; m < 4; ++m) {
                const unsigned row = row0 + ai * 128 + m * 16;
#pragma unroll
                for (int bj = 0; bj < 2; ++bj) {
                    const int col = col0 + 128 * bj;
                    f32x4_t a0, a1, b0, b1; ld_bf8(PH + (size_t)row * N_IN + COL_GATE + col, a0, a1); ld_bf8(PH + (size_t)row * N_IN + COL_GATE + D + col, b0, b1);
#pragma unroll
                    for (int j = 0; j < 4; ++j) { acc[ai][bj][m][0][j] *= a0[j] * __builtin_amdgcn_rcpf(fmaxf(b0[j], 1e-30f)); acc[ai][bj][m][1][j] *= a1[j] * __builtin_amdgcn_rcpf(fmaxf(b1[j], 1e-30f)); }
                }
            }
    }
    __device__ __forceinline__ void operator()(const pg8::f32x4 (&acc)[2][2][4][2], const pg8::Unit& u, int wr, int wc, int fr, int fq) const {
        const unsigned row0 = (unsigned)u.pm * 256u + wr * 64 + fr; const int col0 = u.pn * 256 + wc * 32 + 8 * fq;
#pragma unroll
        for (int ai = 0; ai < 2; ++ai)
#pragma unroll
            for (int m = 0; m < 4; ++m) {
                const unsigned row = row0 + ai * 128 + m * 16;
#pragma unroll
                for (int bj = 0; bj < 2; ++bj) {
                    const int col = col0 + 128 * bj;
                    f32x4_t b0, b1; ld_bf8(PH + (size_t)row * N_IN + COL_GATE + D + col, b0, b1);
                    const pg8::f32x4 v0 = acc[ai][bj][m][0] * fmaxf_v(b0), v1 = acc[ai][bj][m][1] * fmaxf_v(b1);
                    pg8::u32x4 w; w.x = pg8::cvt_pk_bf16(v0[0], v0[1]); w.y = pg8::cvt_pk_bf16(v0[2], v0[3]); w.z = pg8::cvt_pk_bf16(v1[0], v1[1]); w.w = pg8::cvt_pk_bf16(v1[2], v1[3]);
                    *(pg8::u32x4*)(MB + (size_t)row * D + col) = w;
                }
            }
    }
};
struct SchedPlain {
    int G, c, nM, nN, K; const char* A; const char* B;
    __device__ __forceinline__ bool next(int i, pg8::Unit& u) const {
        int pm, pn; if (!pg8::static_order(nM, nN, G, c, i, pm, pn)) return false;
        u.pm = pm; u.pn = pn; u.e = 0; u.A = A + (size_t)pm * 256 * K * 2; u.B = B + (size_t)pn * 256 * K * 2; u.list = nullptr; u.cnt = 0; u.prow = 0; u.gat = 0; return true;
    }
    __device__ __forceinline__ void a_ready(const pg8::Unit&) const {}
    __device__ __forceinline__ void done(const pg8::Unit&) const {}
};
struct EpiF32 {
    static constexpr bool PERM = true, AFTER_DRAIN = false, CHAIN = false;
    unsigned short* C; int ldc;
    __device__ __forceinline__ void operator()(const pg8::f32x4 (&acc)[2][2][4][2], const pg8::Unit& u, int wr, int wc, int fr, int fq) const {
        const unsigned row0 = (unsigned)u.pm * 256u + wr * 64 + fr; const int col0 = u.pn * 256 + wc * 32 + 8 * fq;
#pragma unroll
        for (int ai = 0; ai < 2; ++ai)
#pragma unroll
            for (int m = 0; m < 4; ++m) {
                unsigned short* rp = C + (size_t)(row0 + ai * 128 + m * 16) * ldc + col0;
#pragma unroll
                for (int bj = 0; bj < 2; ++bj) { const pg8::f32x4 v0 = acc[ai][bj][m][0], v1 = acc[ai][bj][m][1];
                    pg8::u32x4 w; w.x = pg8::cvt_pk_bf16(v0[0], v0[1]); w.y = pg8::cvt_pk_bf16(v0[2], v0[3]); w.z = pg8::cvt_pk_bf16(v1[0], v1[1]); w.w = pg8::cvt_pk_bf16(v1[2], v1[3]);
                    *(pg8::u32x4*)(rp + 128 * bj) = w; }
            }
    }
};

#define LDS_WAIT() asm volatile("s_waitcnt lgkmcnt(0)" ::: "memory")
template <class F, class FK>
__device__ __forceinline__ void cvt_item_k(const float* __restrict__ W, int ldw, int K, const F& srccol, const FK& srcrow, unsigned short* WT, int row0, int kb, LAS float* scr, int lane) {
    const int n = lane & 31, k0 = kb * 64; const int sc = srccol(row0 + n);
#pragma unroll 8
    for (int i = 0; i < 32; ++i) { const int kk = 2 * i + (lane >> 5); const int sr = srcrow(k0 + kk); scr[kk * 33 + n] = (sc >= 0 && sr >= 0) ? W[(size_t)sr * ldw + sc] : 0.f; }
    LDS_WAIT();
    const int c = lane & 7;
#pragma unroll
    for (int j = 0; j < 4; ++j) { const int n2 = (lane >> 3) + 8 * j; const LAS float* sp = scr + (8 * c) * 33 + n2;
        pg8::u32x4 o; o.x = pg8::cvt_pk_bf16(sp[0 * 33], sp[1 * 33]); o.y = pg8::cvt_pk_bf16(sp[2 * 33], sp[3 * 33]); o.z = pg8::cvt_pk_bf16(sp[4 * 33], sp[5 * 33]); o.w = pg8::cvt_pk_bf16(sp[6 * 33], sp[7 * 33]);
        *(pg8::u32x4*)(WT + (size_t)(row0 + n2) * K + k0 + 8 * c) = o; }
    LDS_WAIT();
}
template <class F>
__device__ __forceinline__ void cvt_item(const float* __restrict__ W, int ldw, int K, const F& srccol, unsigned short* WT, int row0, int kb, LAS float* scr, int lane) {
    auto idk = [](int k) { return k; };
    cvt_item_k(W, ldw, K, srccol, idk, WT, row0, kb, scr, lane);
}
template <class FM, class FK>
__device__ __forceinline__ void cvt64(const float* __restrict__ W, int ldw, int K, const FM& map4, const FK& srcrow, unsigned short* __restrict__ WT, int row0, int kb, int lane) {
    const int n4 = lane & 15, kg = lane >> 4, k0 = kb * 64 + 16 * kg;
    int sc, dr; map4(row0, n4, sc, dr);
    f32x4_t v[16];
#pragma unroll
    for (int kk = 0; kk < 16; ++kk) { const int sr = srcrow(k0 + kk); v[kk] = (sc >= 0 && sr >= 0) ? *(const f32x4_t*)(W + (size_t)sr * ldw + sc) : (f32x4_t){0.f, 0.f, 0.f, 0.f}; }
#pragma unroll
    for (int j = 0; j < 4; ++j) {
        pg8::u32x4 o0, o1;
        o0.x = pg8::cvt_pk_bf16(v[0][j], v[1][j]); o0.y = pg8::cvt_pk_bf16(v[2][j], v[3][j]); o0.z = pg8::cvt_pk_bf16(v[4][j], v[5][j]); o0.w = pg8::cvt_pk_bf16(v[6][j], v[7][j]);
        o1.x = pg8::cvt_pk_bf16(v[8][j], v[9][j]); o1.y = pg8::cvt_pk_bf16(v[10][j], v[11][j]); o1.z = pg8::cvt_pk_bf16(v[12][j], v[13][j]); o1.w = pg8::cvt_pk_bf16(v[14][j], v[15][j]);
        unsigned short* dst = WT + (size_t)(dr + j) * K + k0;
        *(pg8::u32x4*)dst = o0; *(pg8::u32x4*)(dst + 8) = o1;
    }
}
template <class FM, class FK>
__device__ __forceinline__ void cvt64_f8(const float* __restrict__ W, int ldw, int K, const FM& map4, const FK& srcrow, unsigned char* __restrict__ WT, int row0, int kb, int lane, float scale) {
    const int n4 = lane & 15, kg = lane >> 4, k0 = kb * 64 + 16 * kg;
    int sc, dr; map4(row0, n4, sc, dr);
    f32x4_t v[16];
#pragma unroll
    for (int kk = 0; kk < 16; ++kk) { const int sr = srcrow(k0 + kk); v[kk] = (sc >= 0 && sr >= 0) ? *(const f32x4_t*)(W + (size_t)sr * ldw + sc) * scale : (f32x4_t){0.f, 0.f, 0.f, 0.f}; }
#pragma unroll
    for (int j = 0; j < 4; ++j) {
        pg8::u32x4 o;
#pragma unroll
        for (int q = 0; q < 4; ++q) { int w = __builtin_amdgcn_cvt_pk_fp8_f32(v[4 * q][j], v[4 * q + 1][j], 0, false); w = __builtin_amdgcn_cvt_pk_fp8_f32(v[4 * q + 2][j], v[4 * q + 3][j], w, true); o[q] = (unsigned)w; }
        *(pg8::u32x4*)(WT + (size_t)(dr + j) * K + k0) = o;
    }
}
__device__ __forceinline__ void inproj_src(int r, int& mat, int& col) {
    mat = 0; col = -1;
    if (r < 3072) col = r;
    else if (r < 7168) col = COL_GATE + (r - 3072);
    else if (r < 7424) { if (r - 7168 < 16) col = COL_B + (r - 7168); }
    else if (r < 10496) col = COL_R + (r - 7424);
    else if (r < 10752) { mat = 1; if (r - 10496 < 96) col = r - 10496; }
    else if (r < 11008) { mat = 2; if (r - 10752 < 96) col = r - 10752; }
    else { mat = 3; col = r - 11008; }
}

typedef short bf16x8_t __attribute__((ext_vector_type(8)));
typedef unsigned short LAS* lds_u16p;
__device__ __forceinline__ f32x4_t mma16(bf16x8_t a, bf16x8_t b, f32x4_t c) { return __builtin_amdgcn_mfma_f32_16x16x32_bf16(a, b, c, 0, 0, 0); }
__device__ __forceinline__ bf16x8_t ldfrag(const LAS unsigned short* M, int ld, int r0, int k0, int lane) { return *(const LAS bf16x8_t*)(M + (r0 + (lane & 15)) * ld + k0 + 8 * (lane >> 4)); }
__device__ __forceinline__ bf16x8_t ldfragT(const LAS unsigned short* M, int t, int ks, int lane) { return *(const LAS bf16x8_t*)(M + (16 * t + (lane & 15)) * 72 + (((4 * ks + (lane >> 4)) ^ (t & 7)) << 3)); }
__device__ __forceinline__ unsigned short f2bf(float x) { return (unsigned short)(pg8::cvt_pk_bf16(x, x) & 0xffffu); }
constexpr int GR_QG = 0, GR_W = 16384, GR_KDT = 32768, GR_AI = 49152, GR_U = 57344, GR_MISC = 90112, GR_BYTES = 90368;
constexpr int GL_SM2 = 130560;
constexpr int GL_KB = 0, GL_QB = 17408, GL_VT = 34816, GL_KST = 53248, GL_KDT = 71680, GL_LM = 90112, GL_TI = 107520, GL_AI = 116736, GL_SM = 125952;

__device__ __forceinline__ void tri_inverse_64(const LAS float* Lm, LAS unsigned short* Ti, LAS float* Dg, int lane) {
    const int g = lane >> 4, n = lane & 15;
    {
        float x[16];
        const LAS float* Lb = Lm + (16 * g) * 68 + 16 * g;
#pragma unroll
        for (int i = 0; i < 16; ++i) {
            float s0 = 0.f, s1 = 0.f, s2 = 0.f, s3 = 0.f;
#pragma unroll
            for (int j4 = 0; j4 < (i + 3) / 4; ++j4) {
                const f32x4_t l4 = *(const LAS f32x4_t*)(Lb + i * 68 + 4 * j4);
                if (4 * j4 + 0 < i) s0 = fmaf(l4[0], x[4 * j4 + 0], s0);
                if (4 * j4 + 1 < i) s1 = fmaf(l4[1], x[4 * j4 + 1], s1);
                if (4 * j4 + 2 < i) s2 = fmaf(l4[2], x[4 * j4 + 2], s2);
                if (4 * j4 + 3 < i) s3 = fmaf(l4[3], x[4 * j4 + 3], s3);
            }
            x[i] = ((n == i) ? 1.0f : 0.0f) - ((s0 + s1) + (s2 + s3));
        }
#pragma unroll
        for (int i = 0; i < 16; ++i) { Dg[g * 256 + i * 16 + n] = x[i]; Ti[(16 * g + i) * 72 + 16 * g + n] = f2bf(x[i]); }
#pragma unroll
        for (int bi = 0; bi < 3; ++bi)
#pragma unroll
            for (int bj = bi + 1; bj < 4; ++bj)
#pragma unroll
                for (int r = 0; r < 4; ++r) Ti[(16 * bi + 4 * g + r) * 72 + 16 * bj + n] = 0;
    }
    auto ldA = [&](int bi, int bk) -> f32x4_t { return *(const LAS f32x4_t*)(Lm + (16 * bi + n) * 68 + 16 * bk + 4 * g); };
    auto ldD = [&](int b) -> f32x4_t { return *(const LAS f32x4_t*)(Dg + b * 256 + n * 16 + 4 * g); };
    auto ldDB = [&](int b) -> f32x4_t { f32x4_t v; v[0] = Dg[b * 256 + (4 * g + 0) * 16 + n]; v[1] = Dg[b * 256 + (4 * g + 1) * 16 + n]; v[2] = Dg[b * 256 + (4 * g + 2) * 16 + n]; v[3] = Dg[b * 256 + (4 * g + 3) * 16 + n]; return v; };
    auto mm = [&](f32x4_t av, f32x4_t bv, f32x4_t c) -> f32x4_t {
        c = __builtin_amdgcn_mfma_f32_16x16x4f32(av[0], bv[0], c, 0, 0, 0); c = __builtin_amdgcn_mfma_f32_16x16x4f32(av[1], bv[1], c, 0, 0, 0);
        c = __builtin_amdgcn_mfma_f32_16x16x4f32(av[2], bv[2], c, 0, 0, 0); c = __builtin_amdgcn_mfma_f32_16x16x4f32(av[3], bv[3], c, 0, 0, 0); return c; };
    auto put = [&](int bi, int bj, f32x4_t xv) {
#pragma unroll
        for (int r = 0; r < 4; ++r) Ti[(16 * bi + 4 * g + r) * 72 + 16 * bj + n] = f2bf(xv[r]); };
    const f32x4_t z = {0.f, 0.f, 0.f, 0.f};
    const f32x4_t x00 = ldDB(0), x11 = ldDB(1), x22 = ldDB(2);
    const f32x4_t d1 = ldD(1), d2 = ldD(2), d3 = ldD(3);
    const f32x4_t x10 = -mm(d1, mm(ldA(1, 0), x00, z), z);
    const f32x4_t x21 = -mm(d2, mm(ldA(2, 1), x11, z), z);
    const f32x4_t x32 = -mm(d3, mm(ldA(3, 2), x22, z), z);
    const f32x4_t x20 = -mm(d2, mm(ldA(2, 1), x10, mm(ldA(2, 0), x00, z)), z);
    const f32x4_t x31 = -mm(d3, mm(ldA(3, 2), x21, mm(ldA(3, 1), x11, z)), z);
    const f32x4_t x30 = -mm(d3, mm(ldA(3, 2), x20, mm(ldA(3, 1), x10, mm(ldA(3, 0), x00, z))), z);
    put(1, 0, x10); put(2, 1, x21); put(3, 2, x32); put(2, 0, x20); put(3, 1, x31); put(3, 0, x30);
}

__device__ __forceinline__ void allred16x4(float& a, float& b, float& c, float& d) {
    asm volatile("s_nop 1\n\t"
        "v_add_f32_dpp %0, %0, %0 quad_perm:[1,0,3,2] row_mask:0xf bank_mask:0xf bound_ctrl:1\n\tv_add_f32_dpp %1, %1, %1 quad_perm:[1,0,3,2] row_mask:0xf bank_mask:0xf bound_ctrl:1\n\t"
        "v_add_f32_dpp %2, %2, %2 quad_perm:[1,0,3,2] row_mask:0xf bank_mask:0xf bound_ctrl:1\n\tv_add_f32_dpp %3, %3, %3 quad_perm:[1,0,3,2] row_mask:0xf bank_mask:0xf bound_ctrl:1\n\t"
        "v_add_f32_dpp %0, %0, %0 quad_perm:[2,3,0,1] row_mask:0xf bank_mask:0xf bound_ctrl:1\n\tv_add_f32_dpp %1, %1, %1 quad_perm:[2,3,0,1] row_mask:0xf bank_mask:0xf bound_ctrl:1\n\t"
        "v_add_f32_dpp %2, %2, %2 quad_perm:[2,3,0,1] row_mask:0xf bank_mask:0xf bound_ctrl:1\n\tv_add_f32_dpp %3, %3, %3 quad_perm:[2,3,0,1] row_mask:0xf bank_mask:0xf bound_ctrl:1\n\t"
        "v_add_f32_dpp %0, %0, %0 row_half_mirror row_mask:0xf bank_mask:0xf bound_ctrl:1\n\tv_add_f32_dpp %1, %1, %1 row_half_mirror row_mask:0xf bank_mask:0xf bound_ctrl:1\n\t"
        "v_add_f32_dpp %2, %2, %2 row_half_mirror row_mask:0xf bank_mask:0xf bound_ctrl:1\n\tv_add_f32_dpp %3, %3, %3 row_half_mirror row_mask:0xf bank_mask:0xf bound_ctrl:1\n\t"
        "v_add_f32_dpp %0, %0, %0 row_mirror row_mask:0xf bank_mask:0xf bound_ctrl:1\n\tv_add_f32_dpp %1, %1, %1 row_mirror row_mask:0xf bank_mask:0xf bound_ctrl:1\n\t"
        "v_add_f32_dpp %2, %2, %2 row_mirror row_mask:0xf bank_mask:0xf bound_ctrl:1\n\tv_add_f32_dpp %3, %3, %3 row_mirror row_mask:0xf bank_mask:0xf bound_ctrl:1\n\ts_nop 1"
        : "+v"(a), "+v"(b), "+v"(c), "+v"(d));
}
__device__ __forceinline__ void gdn_a0_fin(int hv, float araw, float braw, const float* __restrict__ A_log, const float* __restrict__ dt_bias, LAS float* gcs, LAS float* betas, int lane);
__device__ __forceinline__ void gdn_a0(int item, const float* __restrict__ BA, const float* __restrict__ A_log, const float* __restrict__ dt_bias, LAS float* gcs, LAS float* betas, int lane) {
    const int hv = (item >> 6) & 7; const size_t tn = (size_t)(item >> 9) * SEQ + (item & 63) * 64 + lane;
    gdn_a0_fin(hv, BA[tn * 16 + 8 + hv], BA[tn * 16 + hv], A_log, dt_bias, gcs, betas, lane);
}
__device__ __forceinline__ void gdn_a0_fin(int hv, float araw, float braw, const float* __restrict__ A_log, const float* __restrict__ dt_bias, LAS float* gcs, LAS float* betas, int lane) {
    float g = -expf(A_log[hv]) * softplusf_(araw + dt_bias[hv]);
#pragma unroll
    for (int o = 1; o < 64; o <<= 1) { const float t = __shfl_up(g, o); if (lane >= o) g += t; }
    gcs[lane] = g; betas[lane] = sigmoidf_(braw);
}
#define A1_CB(mtx, it_) const int hv_ = ((it_) >> 6) & 7, qh_ = hv_ >> 1; const int cb_ = (((mtx) == 0) ? qh_ * 128 : ((mtx) == 1) ? COL_K + qh_ * 128 : COL_V + hv_ * 128) + 4 * cg;
#define A1_LOADW(mtx, it_, wv) do { A1_CB(mtx, it_) \
        _Pragma("unroll") for (int j = 0; j < 4; ++j) wv[j] = *(const f32x4_t*)(convw + j * 2048 + cb_); } while (0)
#define A1_LOADX(mtx, it_, xr) do { A1_CB(mtx, it_) const int s0_ = ((it_) & 63) * 64; const size_t t0_ = (size_t)((it_) >> 9) * SEQ + s0_; \
        _Pragma("unroll") for (int q = 0; q < 7; ++q) { const int rr_ = r0 - 3 + q; const size_t tr_ = (s0_ + rr_ >= 0) ? (size_t)((long long)t0_ + rr_) : t0_; xr[q] = *(const pg8::u32x2*)(PH + tr_ * N_IN + cb_); } } while (0)
__device__ __forceinline__ int gdn_item_of(int k) { const int combo = k >> 3; return ((combo >> 6) << 9) | ((k & 7) << 6) | (combo & 63); }

__device__ __forceinline__ void gdn_prep_item(int item, int item_next, int par, LAS unsigned char* lds, const unsigned short* __restrict__ PH, const float* __restrict__ BA, const float* __restrict__ convw, const float* __restrict__ A_log, const float* __restrict__ dt_bias, unsigned char* __restrict__ recs, pg8::u32x2 (&xn)[3][7], f32x4_t (&wn)[3][4]) {
    int tid_ = threadIdx.x; asm volatile("" : "+v"(tid_));
    const int tid = tid_, lane = tid & 63, wave = __builtin_amdgcn_readfirstlane(tid >> 6);
    const int ch = item & 63, hv = (item >> 6) & 7;
    const int s0 = ch * 64;
    unsigned char* rec = recs + (size_t)item * GR_BYTES;
    LAS unsigned short* Kb = (LAS unsigned short*)(lds + GL_KB); LAS unsigned short* Qb = (LAS unsigned short*)(lds + GL_QB);
    LAS unsigned short* VT = (LAS unsigned short*)(lds + GL_VT); LAS unsigned short* KsT = (LAS unsigned short*)(lds + GL_KST); LAS unsigned short* KdT = (LAS unsigned short*)(lds + GL_KDT);
    LAS float* Lm = (LAS float*)(lds + GL_LM); LAS unsigned short* Ti = (LAS unsigned short*)(lds + GL_TI); LAS unsigned short* Ai = (LAS unsigned short*)(lds + GL_AI);
    LAS float* gcs = (LAS float*)(lds + (par ? GL_SM2 : GL_SM)); LAS float* betas = gcs + 64;
    LAS float* gcs_n = (LAS float*)(lds + (par ? GL_SM : GL_SM2));
    const int cg = tid & 31, rg = tid >> 5, r0 = 4 * rg;
    {
        const f32x4_t zero4 = {0.f, 0.f, 0.f, 0.f};
        float eg[4], ekd[4], br[4];
        { const float glast = gcs[63];
#pragma unroll
          for (int r = 0; r < 4; ++r) { const float gcr = gcs[r0 + r]; br[r] = betas[r0 + r]; eg[r] = __builtin_amdgcn_exp2f(1.4426950408889634f * gcr); ekd[r] = __builtin_amdgcn_exp2f(1.4426950408889634f * (glast - gcr)); } }
        const int swz = (cg >> 2) & 7, tq = rg >> 1, to = 4 * (rg & 1);
#define A1_BODY(mtx, xr, wv) do { f32x4_t xv[7], acc[4]; float rn[4]; \
        _Pragma("unroll") for (int q = 0; q < 7; ++q) { const f32x4_t v_ = (f32x4_t){__uint_as_float(xr[q].x << 16), __uint_as_float(xr[q].x & 0xffff0000u), __uint_as_float(xr[q].y << 16), __uint_as_float(xr[q].y & 0xffff0000u)}; xv[q] = (s0 + r0 - 3 + q >= 0) ? v_ : zero4; } \
        _Pragma("unroll") for (int r = 0; r < 4; ++r) { acc[r] = wv[0] * xv[r] + wv[1] * xv[r + 1] + wv[2] * xv[r + 2] + wv[3] * xv[r + 3]; \
            _Pragma("unroll") for (int i = 0; i < 4; ++i) acc[r][i] = acc[r][i] * fast_sigmoid(acc[r][i]); \
            rn[r] = acc[r][0] * acc[r][0] + acc[r][1] * acc[r][1] + acc[r][2] * acc[r][2] + acc[r][3] * acc[r][3]; } \
        allred16x4(rn[0], rn[1], rn[2], rn[3]); \
        _Pragma("unroll") for (int r = 0; r < 4; ++r) rn[r] = rsqrtf(rn[r] + __shfl_xor(rn[r], 16) + 1e-6f); \
        if ((mtx) == 0) { _Pragma("unroll") for (int r = 0; r < 4; ++r) { const f32x4_t qv = acc[r] * (rn[r] * 0.08838834764831845f); *(LAS pg8::u32x2*)(Qb + (r0 + r) * 136 + 4 * cg) = (pg8::u32x2){pg8::cvt_pk_bf16(qv[0], qv[1]), pg8::cvt_pk_bf16(qv[2], qv[3])}; } } \
        else if ((mtx) == 1) { _Pragma("unroll") for (int r = 0; r < 4; ++r) { acc[r] = acc[r] * rn[r]; *(LAS pg8::u32x2*)(Kb + (r0 + r) * 136 + 4 * cg) = (pg8::u32x2){pg8::cvt_pk_bf16(acc[r][0], acc[r][1]), pg8::cvt_pk_bf16(acc[r][2], acc[r][3])}; } \
            _Pragma("unroll") for (int i = 0; i < 4; ++i) { const int ofs_ = (4 * cg + i) * 72 + ((tq ^ swz) << 3) + to; \
                *(LAS pg8::u32x2*)(KsT + ofs_) = (pg8::u32x2){pg8::cvt_pk_bf16(br[0] * eg[0] * acc[0][i], br[1] * eg[1] * acc[1][i]), pg8::cvt_pk_bf16(br[2] * eg[2] * acc[2][i], br[3] * eg[3] * acc[3][i])}; \
                *(LAS pg8::u32x2*)(KdT + ofs_) = (pg8::u32x2){pg8::cvt_pk_bf16(ekd[0] * acc[0][i], ekd[1] * acc[1][i]), pg8::cvt_pk_bf16(ekd[2] * acc[2][i], ekd[3] * acc[3][i])}; } } \
        else { _Pragma("unroll") for (int i = 0; i < 4; ++i) { const int ofs_ = (4 * cg + i) * 72 + ((tq ^ swz) << 3) + to; \
                *(LAS pg8::u32x2*)(VT + ofs_) = (pg8::u32x2){pg8::cvt_pk_bf16(br[0] * acc[0][i], br[1] * acc[1][i]), pg8::cvt_pk_bf16(br[2] * acc[2][i], br[3] * acc[3][i])}; } } } while (0)
        A1_BODY(0, xn[0], wn[0]);
        A1_BODY(1, xn[1], wn[1]);
        A1_BODY(2, xn[2], wn[2]);
#undef A1_BODY
    }
    __syncthreads();
    float pa_n = 0.f, pb_n = 0.f;
    if (item_next < 2048) {
        if (((item_next >> 6) & 7) != hv) { A1_LOADW(0, item_next, wn[0]); A1_LOADW(1, item_next, wn[1]); A1_LOADW(2, item_next, wn[2]); }
        A1_LOADX(0, item_next, xn[0]);
        if (wave == 7) { const int hvn = (item_next >> 6) & 7; const size_t tn = (size_t)(item_next >> 9) * SEQ + (item_next & 63) * 64 + lane; pa_n = BA[tn * 16 + 8 + hvn]; pb_n = BA[tn * 16 + hvn]; }
    }
    __builtin_amdgcn_sched_barrier(0);
    {
        const int mat = wave >> 2, ti = wave & 3, g4 = lane >> 4, n = lane & 15;
        const LAS unsigned short* Am = mat ? Qb : Kb;
        float gi[4], bi[4], gj[4];
#pragma unroll
        for (int r = 0; r < 4; ++r) { gi[r] = gcs[16 * ti + 4 * g4 + r]; bi[r] = betas[16 * ti + 4 * g4 + r]; gj[r] = gcs[16 * r + n]; }
#pragma unroll
        for (int tj = 0; tj < 4; ++tj) {
            f32x4_t acc = {0.f, 0.f, 0.f, 0.f};
#pragma unroll
            for (int ks = 0; ks < 4; ++ks) acc = mma16(ldfrag(Am, 136, 16 * ti, 32 * ks, lane), ldfrag(Kb, 136, 16 * tj, 32 * ks, lane), acc);
            const int j = 16 * tj + n;
#pragma unroll
            for (int r = 0; r < 4; ++r) {
                const int i = 16 * ti + 4 * g4 + r; const float dec = __builtin_amdgcn_exp2f(1.4426950408889634f * fminf(gi[r] - gj[tj], 0.f));
                const float vl = bi[r] * acc[r] * dec, va = acc[r] * dec;
                if (mat == 0) Lm[i * 68 + j] = (j < i) ? vl : 0.f;
                else Ai[i * 72 + j] = f2bf((j <= i) ? va : 0.f);
            }
        }
    }
    __syncthreads();
    if (wave == 0) { tri_inverse_64(Lm, Ti, (LAS float*)(lds + 126464), lane); if (item_next < 2048) A1_LOADX(1, item_next, xn[1]); }
    else {
        if (wave == 7 && item_next < 2048) gdn_a0_fin((item_next >> 6) & 7, pa_n, pb_n, A_log, dt_bias, gcs_n, gcs_n + 64, lane);
        if (item_next < 2048) A1_LOADX(1, item_next, xn[1]);
        for (int e = tid - 64; e < 64 * 128; e += NTHREADS - 64) { const int row = e >> 7, c = e & 127; const float qv = bf2f(Qb[row * 136 + c]); Qb[row * 136 + c] = f2bf(qv * __builtin_amdgcn_exp2f(1.4426950408889634f * gcs[row])); }
    }
    __syncthreads();
    if (item_next < 2048) A1_LOADX(2, item_next, xn[2]);
    __builtin_amdgcn_sched_barrier(0);
    {
        const int g4 = lane >> 4, n = lane & 15;
#pragma unroll
        for (int t2 = 0; t2 < 2; ++t2) {
            const int tn = 2 * wave + t2; const LAS unsigned short* Bt = (tn < 8) ? VT : KsT; const int tb = tn & 7;
#pragma unroll
            for (int ti = 0; ti < 4; ++ti) {
                f32x4_t acc = {0.f, 0.f, 0.f, 0.f};
#pragma unroll
                for (int ks = 0; ks < 2; ++ks) acc = mma16(ldfrag(Ti, 72, 16 * ti, 32 * ks, lane), ldfragT(Bt, tb, ks, lane), acc);
                if (tn < 8) *(f32x4_t*)(rec + GR_U + ((size_t)((ti * 8 + tb) * 64 + lane)) * 16) = acc;
                else {
#pragma unroll
                    for (int r = 0; r < 4; ++r) Kb[(16 * ti + 4 * g4 + r) * 136 + 16 * tb + n] = f2bf(acc[r]);
                }
            }
        }
    }
    __syncthreads();
    {
#pragma unroll
        for (int t2 = 0; t2 < 2; ++t2) {
            const int f = 2 * wave + t2;
            { const int ti = f >> 2, ks = f & 3;
              *(bf16x8_t*)(rec + GR_QG + (size_t)(f * 64 + lane) * 16) = ldfrag(Qb, 136, 16 * ti, 32 * ks, lane);
              *(bf16x8_t*)(rec + GR_W + (size_t)(f * 64 + lane) * 16) = ldfrag(Kb, 136, 16 * ti, 32 * ks, lane); }
            { const int td = f >> 1, ks = f & 1;
              *(bf16x8_t*)(rec + GR_KDT + (size_t)(f * 64 + lane) * 16) = ldfragT(KdT, td, ks, lane); }
        }
        { const int f = wave, ti = f >> 1, ks = f & 1;
          *(bf16x8_t*)(rec + GR_AI + (size_t)(f * 64 + lane) * 16) = ldfrag(Ai, 72, 16 * ti, 32 * ks, lane); }
        if (tid == 0) *(float*)(rec + GR_MISC) = expf(gcs[63]);
    }
    __syncthreads();
}

__device__ __forceinline__ void gdn_scan_seq(int seq, LAS unsigned char* lds, const unsigned char* __restrict__ recs, const unsigned short* __restrict__ PH, const float* __restrict__ gdn_norm, unsigned short* __restrict__ YGB) {
    const int tid = threadIdx.x, lane = tid & 63, wave = __builtin_amdgcn_readfirstlane(tid >> 6), g4 = lane >> 4, n = lane & 15;
    const int b = seq >> 3, hv = seq & 7;
    LAS unsigned short* St = (LAS unsigned short*)lds;
    LAS unsigned short* VnT = (LAS unsigned short*)(lds + 34816);
    LAS unsigned short* Zb = (LAS unsigned short*)(lds + 53248);
    const int zrow = tid >> 3, zseg = tid & 7;
    const unsigned short* zsrc = PH + ((size_t)b * SEQ + zrow) * N_IN + COL_Z + hv * 128 + zseg * 16;
    pg8::u32x4 zr0 = *(const pg8::u32x4*)zsrc, zr1 = *(const pg8::u32x4*)(zsrc + 8);
    float gnv[8];
#pragma unroll
    for (int tv = 0; tv < 8; ++tv) gnv[tv] = gdn_norm[16 * tv + n];
    *(LAS pg8::u32x4*)(Zb + zrow * 136 + zseg * 16) = zr0; *(LAS pg8::u32x4*)(Zb + zrow * 136 + zseg * 16 + 8) = zr1;
    for (int e = tid; e < 128 * 136; e += NTHREADS) St[e] = 0;
    f32x4_t S[8];
#pragma unroll
    for (int tv = 0; tv < 8; ++tv) S[tv] = (f32x4_t){0.f, 0.f, 0.f, 0.f};
    __syncthreads();
    const int ti = wave & 3;
    bf16x8_t nafr[4], nkfr[2], naifr[2]; f32x4_t nu[8]; float neg;
#define GS_LOAD(chv) do { const unsigned char* _r = recs + ((size_t)seq * 64 + (chv)) * GR_BYTES; \
        _Pragma("unroll") for (int ks = 0; ks < 4; ++ks) nafr[ks] = *(const bf16x8_t*)(_r + (wave < 4 ? GR_QG : GR_W) + (size_t)((ti * 4 + ks) * 64 + lane) * 16); \
        _Pragma("unroll") for (int ks = 0; ks < 2; ++ks) { nkfr[ks] = *(const bf16x8_t*)(_r + GR_KDT + (size_t)((wave * 2 + ks) * 64 + lane) * 16); naifr[ks] = *(const bf16x8_t*)(_r + GR_AI + (size_t)((ti * 2 + ks) * 64 + lane) * 16); } \
        if (wave >= 4) { _Pragma("unroll") for (int tv = 0; tv < 8; ++tv) nu[tv] = *(const f32x4_t*)(_r + GR_U + (size_t)((ti * 8 + tv) * 64 + lane) * 16); } \
        neg = *(const float*)(_r + GR_MISC); } while (0)
    GS_LOAD(0);
    for (int ch = 0; ch < 64; ++ch) {
        bf16x8_t afr[4], kfr[2], aifr[2]; f32x4_t ucur[8];
#pragma unroll
        for (int ks = 0; ks < 4; ++ks) afr[ks] = nafr[ks];
#pragma unroll
        for (int ks = 0; ks < 2; ++ks) { kfr[ks] = nkfr[ks]; aifr[ks] = naifr[ks]; }
#pragma unroll
        for (int tv = 0; tv < 8; ++tv) ucur[tv] = nu[tv];
        const float eg = neg;
        if (ch + 1 < 64) { GS_LOAD(ch + 1); const unsigned short* zp = zsrc + (size_t)(ch + 1) * 64 * N_IN; zr0 = *(const pg8::u32x4*)zp; zr1 = *(const pg8::u32x4*)(zp + 8); }
        f32x4_t acc1[8];
#pragma unroll
        for (int tv = 0; tv < 8; ++tv) {
            f32x4_t a = {0.f, 0.f, 0.f, 0.f};
#pragma unroll
            for (int ks = 0; ks < 4; ++ks) a = mma16(afr[ks], ldfrag(St, 136, 16 * tv, 32 * ks, lane), a);
            acc1[tv] = a;
        }
        if (wave >= 4) {
#pragma unroll
            for (int tv = 0; tv < 8; ++tv) {
                const f32x4_t vn = ucur[tv] - acc1[tv];
                pg8::u32x2 w2; w2.x = pg8::cvt_pk_bf16(vn[0], vn[1]); w2.y = pg8::cvt_pk_bf16(vn[2], vn[3]);
                *(LAS pg8::u32x2*)(VnT + (16 * tv + n) * 72 + 16 * ti + 4 * g4) = w2;
            }
        }
        __syncthreads();
        if (wave < 4) {
            float ss[4] = {0.f, 0.f, 0.f, 0.f};
#pragma unroll
            for (int tv = 0; tv < 8; ++tv) {
                f32x4_t o = acc1[tv];
#pragma unroll
                for (int ks = 0; ks < 2; ++ks) o = mma16(aifr[ks], ldfrag(VnT, 72, 16 * tv, 32 * ks, lane), o);
                acc1[tv] = o;
#pragma unroll
                for (int r = 0; r < 4; ++r) ss[r] = fmaf(o[r], o[r], ss[r]);
            }
            allred16x4(ss[0], ss[1], ss[2], ss[3]);
            const LAS unsigned short* zc = Zb + (ch & 1) * 64 * 136;
#pragma unroll
            for (int r = 0; r < 4; ++r) {
                const float inv = rsqrtf(ss[r] * (1.0f / 128.0f) + EPS); const int tr = 16 * ti + 4 * g4 + r;
                unsigned short* yrow = YGB + ((size_t)b * SEQ + ch * 64 + tr) * RW + hv * 128 + n;
#pragma unroll
                for (int tv = 0; tv < 8; ++tv) { const float z = bf2f(zc[tr * 136 + 16 * tv + n]); yrow[16 * tv] = f2bf(acc1[tv][r] * inv * gnv[tv] * z * fast_sigmoid(z)); }
            }
        }
#pragma unroll
        for (int tv = 0; tv < 8; ++tv) {
            f32x4_t s = S[tv] * eg;
#pragma unroll
            for (int ks = 0; ks < 2; ++ks) s = mma16(kfr[ks], ldfrag(VnT, 72, 16 * tv, 32 * ks, lane), s);
            S[tv] = s;
            pg8::u32x2 w2; w2.x = pg8::cvt_pk_bf16(s[0], s[1]); w2.y = pg8::cvt_pk_bf16(s[2], s[3]);
            *(LAS pg8::u32x2*)(St + (16 * tv + n) * 136 + 16 * wave + 4 * g4) = w2;
        }
        if (ch + 1 < 64) { LAS unsigned short* zn = Zb + ((ch + 1) & 1) * 64 * 136 + zrow * 136 + zseg * 16; *(LAS pg8::u32x4*)zn = zr0; *(LAS pg8::u32x4*)(zn + 8) = zr1; }
        __syncthreads();
    }
#undef GS_LOAD
}

constexpr int RT = 32;
constexpr int RBUF_FLOATS = 5 * RT * 64 + RT * 32 + RT * 2;
__device__ __forceinline__ float dpp_f(float x, const int ctrl_sel) {
    const int xi = __float_as_int(x); int r;
    if (ctrl_sel == 0) r = __builtin_amdgcn_update_dpp(0, xi, 0xB1, 0xF, 0xF, true);
    else if (ctrl_sel == 1) r = __builtin_amdgcn_update_dpp(0, xi, 0x4E, 0xF, 0xF, true);
    else if (ctrl_sel == 2) r = __builtin_amdgcn_update_dpp(0, xi, 0x141, 0xF, 0xF, true);
    else r = __builtin_amdgcn_update_dpp(0, xi, 0x140, 0xF, 0xF, true);
    return __int_as_float(r);
}
__device__ __forceinline__ float sum8(float x) { x += dpp_f(x, 0); x += dpp_f(x, 1); x += dpp_f(x, 2); return x; }
__device__ __forceinline__ float fast_softplus(float x) { return fmaxf(x, 0.0f) + 0.6931471805599453f * __builtin_amdgcn_logf(1.0f + __builtin_amdgcn_exp2f(-1.4426950408889634f * fabsf(x))); }
__device__ __forceinline__ void rwkv_scan_block(int sq, int half, LAS float* lds, const float* __restrict__ WPRE, const float* __restrict__ APRE, const unsigned short* __restrict__ PH,
                                                const float* __restrict__ k_k, const float* __restrict__ k_a, const float* __restrict__ r_k, float* __restrict__ BON, float* __restrict__ YR) {
    const int tid = threadIdx.x, lane = tid & 63, wave = __builtin_amdgcn_readfirstlane(tid >> 6);
    const int b = sq >> 4, h = sq & 15, rbase = half * 32;
    const size_t t0 = (size_t)b * SEQ;
    const int lt = tid - 256;
    f32x4_t s0w[2], s0a[2], s0k[2], s0r[2], s0v, s1w[2], s1a[2], s1k[2], s1r[2], s1v;
    f32x4_t kkc = {0.f, 0.f, 0.f, 0.f}, kac = kkc, rkc = kkc;
    if (lt >= 0) { const int colc = h * 64 + (lt & 15) * 4; kkc = *(const f32x4_t*)(k_k + colc); kac = *(const f32x4_t*)(k_a + colc); rkc = *(const f32x4_t*)(r_k + colc); }
    f32x2_t S2[4];
#pragma unroll
    for (int k = 0; k < 4; ++k) S2[k] = (f32x2_t){0.f, 0.f};
#define RW_LOAD(c, P) do { _Pragma("unroll") for (int i = 0; i < 2; ++i) { const int f = lt + 256 * i, st = f >> 4, c4 = f & 15; const size_t t = t0 + (size_t)(c) * RT + st; const int col = h * 64 + c4 * 4; \
        P##w[i] = *(const f32x4_t*)(WPRE + t * RW + col); P##a[i] = ld_bf4((const unsigned short*)APRE + t * RW + col); P##k[i] = ld_bf4(PH + t * N_IN + COL_RK + col); P##r[i] = ld_bf4(PH + t * N_IN + COL_R + col); } \
        { const int st = lt >> 3, c4 = lt & 7; P##v = ld_bf4(PH + (t0 + (size_t)(c) * RT + st) * N_IN + COL_RV + h * 64 + rbase + c4 * 4); } } while (0)
#define RW_STORE(bufp, P, c) do { LAS float* _b = (bufp); _Pragma("unroll") for (int i = 0; i < 2; ++i) { const int f = lt + 256 * i, st = f >> 4, c4 = f & 15; \
        f32x4_t wd, av, kkv, kmv; float ss = 0.f, br = 0.f, kr = 0.f, bo = 0.f; \
        _Pragma("unroll") for (int j = 0; j < 4; ++j) { wd[j] = P##w[i][j]; av[j] = P##a[i][j]; kkv[j] = P##k[i][j] * kkc[j]; kmv[j] = P##k[i][j] * (1.0f + (av[j] - 1.0f) * kac[j]); \
            ss = fmaf(kkv[j], kkv[j], ss); br = fmaf(kkv[j] * av[j], P##r[i][j], br); kr = fmaf(kmv[j], P##r[i][j], kr); bo = fmaf(P##r[i][j] * kmv[j], rkc[j], bo); } \
        allred16x4(ss, br, kr, bo);        \
        const float rn = rsqrtf(ss + 1e-6f); br *= rn; f32x4_t aav, bbv; \
        _Pragma("unroll") for (int j = 0; j < 4; ++j) { const float kk = kkv[j] * rn; aav[j] = -kk; bbv[j] = kk * av[j]; } \
        *(LAS f32x4_t*)(_b + 0 * RT * 64 + st * 64 + c4 * 4) = wd; *(LAS f32x4_t*)(_b + 1 * RT * 64 + st * 64 + c4 * 4) = bbv; *(LAS f32x4_t*)(_b + 2 * RT * 64 + st * 64 + c4 * 4) = kmv; \
        const f32x4_t _x = wd * P##r[i]; \
        *(LAS f32x4_t*)(_b + 3 * RT * 64 + st * 128 + c4 * 8) = (f32x4_t){aav[0], _x[0], aav[1], _x[1]}; *(LAS f32x4_t*)(_b + 3 * RT * 64 + st * 128 + c4 * 8 + 4) = (f32x4_t){aav[2], _x[2], aav[3], _x[3]}; \
        if (c4 == 0) { _b[5 * RT * 64 + RT * 32 + st * 2] = 0.25f * br; _b[5 * RT * 64 + RT * 32 + st * 2 + 1] = 0.25f * kr; if (half == 0) BON[(t0 + (size_t)(c) * RT + st) * 16 + h] = bo; } } \
        { const int st = lt >> 3, c4 = lt & 7; *(LAS f32x4_t*)(_b + 5 * RT * 64 + st * 32 + c4 * 4) = P##v; } } while (0)
    constexpr int NCH = SEQ / RT;
    const int rloc = wave * 8 + (lane >> 4) * 2, kq = (lane & 15) * 4;
    LAS float* ybuf = lds + 2 * RBUF_FLOATS;
    f32x2_t T2[4];
#pragma unroll
    for (int k = 0; k < 4; ++k) T2[k] = (f32x2_t){0.f, 0.f};
    f32x4_t Aw, Ab, Ak, Ax0, Ax1, Bw, Bb, Bk, Bx0, Bx1; f32x2_t Av, Bv, Ar, Br;
#define RW_LD(X, u) do { \
        X##w = *(const LAS f32x4_t*)(pW + (u) * 64); X##b = *(const LAS f32x4_t*)(pW + RT * 64 + (u) * 64); X##k = *(const LAS f32x4_t*)(pW + 2 * RT * 64 + (u) * 64); \
        X##x0 = *(const LAS f32x4_t*)(pX + (u) * 128); X##x1 = *(const LAS f32x4_t*)(pX + (u) * 128 + 4); \
        X##v = *(const LAS f32x2_t*)(pV + (u) * 32); X##r = *(const LAS f32x2_t*)(pR + (u) * 2); } while (0)
#define RW_SUM16(x) do { x += dpp_f(x, 0); x += dpp_f(x, 1); x += dpp_f(x, 2); x += dpp_f(x, 3); } while (0)
#define RW_STEP(X, yb, st) do { \
        f32x2_t e0 = S2[0][0] * (f32x2_t){X##x0[0], X##x0[1]}, e1 = T2[0][0] * (f32x2_t){X##x0[0], X##x0[1]}; \
        e0 += S2[0][1] * (f32x2_t){X##x0[2], X##x0[3]}; e1 += T2[0][1] * (f32x2_t){X##x0[2], X##x0[3]}; \
        e0 += S2[1][0] * (f32x2_t){X##x1[0], X##x1[1]}; e1 += T2[1][0] * (f32x2_t){X##x1[0], X##x1[1]}; \
        e0 += S2[1][1] * (f32x2_t){X##x1[2], X##x1[3]}; e1 += T2[1][1] * (f32x2_t){X##x1[2], X##x1[3]}; \
        float sa0 = e0[0], pp0 = e0[1], sa1 = e1[0], pp1 = e1[1]; \
          \
        asm volatile("s_nop 1\n\t" \
            "v_add_f32_dpp %0, %0, %0 quad_perm:[1,0,3,2] row_mask:0xf bank_mask:0xf bound_ctrl:1\n\tv_add_f32_dpp %1, %1, %1 quad_perm:[1,0,3,2] row_mask:0xf bank_mask:0xf bound_ctrl:1\n\t" \
            "v_add_f32_dpp %2, %2, %2 quad_perm:[1,0,3,2] row_mask:0xf bank_mask:0xf bound_ctrl:1\n\tv_add_f32_dpp %3, %3, %3 quad_perm:[1,0,3,2] row_mask:0xf bank_mask:0xf bound_ctrl:1\n\t" \
            "v_add_f32_dpp %0, %0, %0 quad_perm:[2,3,0,1] row_mask:0xf bank_mask:0xf bound_ctrl:1\n\tv_add_f32_dpp %1, %1, %1 quad_perm:[2,3,0,1] row_mask:0xf bank_mask:0xf bound_ctrl:1\n\t" \
            "v_add_f32_dpp %2, %2, %2 quad_perm:[2,3,0,1] row_mask:0xf bank_mask:0xf bound_ctrl:1\n\tv_add_f32_dpp %3, %3, %3 quad_perm:[2,3,0,1] row_mask:0xf bank_mask:0xf bound_ctrl:1\n\t" \
            "v_add_f32_dpp %0, %0, %0 row_half_mirror row_mask:0xf bank_mask:0xf bound_ctrl:1\n\tv_add_f32_dpp %1, %1, %1 row_half_mirror row_mask:0xf bank_mask:0xf bound_ctrl:1\n\ts_nop 0\n\t" \
            "v_add_f32_dpp %0, %0, %0 row_mirror row_mask:0xf bank_mask:0xf bound_ctrl:1\n\tv_add_f32_dpp %1, %1, %1 row_mirror row_mask:0xf bank_mask:0xf bound_ctrl:1" \
            : "+v"(sa0), "+v"(sa1), "+v"(pp0), "+v"(pp1)); \
        const f32x2_t w01 = (f32x2_t){X##w[0], X##w[1]}, w23 = (f32x2_t){X##w[2], X##w[3]}, b01 = (f32x2_t){X##b[0], X##b[1]}, b23 = (f32x2_t){X##b[2], X##b[3]}, k01 = (f32x2_t){X##k[0], X##k[1]}, k23 = (f32x2_t){X##k[2], X##k[3]}; \
        S2[0] = S2[0] * w01 + (sa0 * b01 + X##v[0] * k01); S2[1] = S2[1] * w23 + (sa0 * b23 + X##v[0] * k23); \
        T2[0] = T2[0] * w01 + (sa1 * b01 + X##v[1] * k01); T2[1] = T2[1] * w23 + (sa1 * b23 + X##v[1] * k23); \
        *(LAS f32x2_t*)((yb) + (st) * 128) = (f32x2_t){pp0 + sa0 * X##r[0] + X##v[0] * X##r[1], pp1 + sa1 * X##r[0] + X##v[1] * X##r[1]}; } while (0)
#define RW_COMPUTE(c) do { const LAS float* buf = lds + ((c) & 1) * RBUF_FLOATS; \
        const LAS float* pW = buf + kq; const LAS float* pX = buf + 3 * RT * 64 + kq * 2; const LAS float* pV = buf + 5 * RT * 64 + rloc; const LAS float* pR = buf + 5 * RT * 64 + RT * 32; LAS float* pY = ybuf + ((c) & 1) * RT * 128 + ((rloc >> 1) * 4 + ((lane & 15) >> 2)) * 2; \
        RW_LD(A, 0); \
        _Pragma("unroll") for (int g = 0; g < RT / 4; ++g) { \
            RW_LD(B, 4 * g + 1); RW_STEP(A, pY, 4 * g); RW_LD(A, 4 * g + 2); RW_STEP(B, pY, 4 * g + 1); RW_LD(B, 4 * g + 3); RW_STEP(A, pY, 4 * g + 2); if (g + 1 < RT / 4) RW_LD(A, 4 * g + 4); RW_STEP(B, pY, 4 * g + 3); } } while (0)
#define RW_FLUSH(c) do { const int st = lt >> 3, c4 = lt & 7; const LAS float* yq_ = ybuf + ((c) & 1) * RT * 128 + st * 128 + c4 * 16; const f32x4_t q0_ = *(const LAS f32x4_t*)(yq_), q1_ = *(const LAS f32x4_t*)(yq_ + 4), q2_ = *(const LAS f32x4_t*)(yq_ + 8), q3_ = *(const LAS f32x4_t*)(yq_ + 12); const f32x4_t yv_ = {(q0_[0] + q0_[2]) + (q1_[0] + q1_[2]), (q0_[1] + q0_[3]) + (q1_[1] + q1_[3]), (q2_[0] + q2_[2]) + (q3_[0] + q3_[2]), (q2_[1] + q2_[3]) + (q3_[1] + q3_[3])}; *(pg8::u32x2*)((unsigned short*)YR + (t0 + (size_t)(c) * RT + st) * RW + h * 64 + rbase + c4 * 4) = (pg8::u32x2){pg8::cvt_pk_bf16(yv_[0], yv_[1]), pg8::cvt_pk_bf16(yv_[2], yv_[3])}; } while (0)
    if (wave >= 4) {
        RW_LOAD(0, s0); RW_STORE(lds, s0, 0); RW_LOAD(1, s0); RW_LOAD(2, s1);
        __syncthreads();
        for (int c = 0; c < NCH; c += 2) {
            RW_STORE(lds + RBUF_FLOATS, s0, c + 1); if (c + 3 < NCH) RW_LOAD(c + 3, s0); if (c > 0) RW_FLUSH(c - 1);
            __syncthreads();
            if (c + 2 < NCH) { RW_STORE(lds, s1, c + 2); } if (c + 4 < NCH) RW_LOAD(c + 4, s1); RW_FLUSH(c);
            __syncthreads();
        }
        RW_FLUSH(NCH - 1);
    } else {
        __builtin_amdgcn_s_setprio(3);
        __syncthreads();
        for (int c = 0; c < NCH; c += 2) {
            RW_COMPUTE(c);
            __syncthreads();
            RW_COMPUTE(c + 1);
            __syncthreads();
        }
        __builtin_amdgcn_s_setprio(0);
    }
#undef RW_COMPUTE
#undef RW_FLUSH
#undef RW_LD
#undef RW_STEP
#undef RW_SUM16
#undef RW_LOAD
#undef RW_STORE
}

__global__ void __launch_bounds__(NTHREADS, 2) fwd(Args a) {
    extern __shared__ __attribute__((aligned(16))) unsigned char lds_raw[];
    float* sm = (float*)lds_raw;
#define PHASE_IDS int tid = threadIdx.x; asm volatile("" : "+v"(tid)); const int lane = tid & 63, wave = tid >> 6; (void)lane; (void)wave;
    unsigned char* ws = a.ws;
    unsigned* ctl = (unsigned*)(ws + WS_CTL);
    volatile LAS unsigned* xbw = (volatile LAS unsigned*)(LAS unsigned char*)(lds_raw + LDS_BYTES - 16);
    if (threadIdx.x == 0) { xbw[0] = 0u; xbw[1] = 0u; xbw[2] = 0u; xbw[3] = 0u; }
    __syncthreads();
    const int lo = a.ph_lo, hi = a.ph_hi;
    XcdBarrier bar; bar.bar = ctl; bar.x = 0; bar.st = xbw;
    if (hi - lo > 1) bar = xcd_barrier_post(ctl, xbw);
#define IN(k) (lo <= (k) && (k) < hi)
#define SEAM(k) do { if (IN(k) && IN((k) + 1)) xcd_barrier(bar); } while (0)


    if (IN(0)) {
        PHASE_IDS
        const float* c = a.in[1];
        const float* ada_w = a.in[2];
        const float* ada_b = a.in[3];
        const float* w_in = a.in[8];
        const float* rwkv_w1 = a.in[15];
        const float* rwkv_a1 = a.in[18];
        const float* rwkv_g1 = a.in[20];
        const float* w_up_gdn = a.in[27];
        const float* w_up_rwkv = a.in[28];
        const float* w_out = a.in[29];
        const float* exp_w_gu = a.in[32];
        const float* exp_w_down = a.in[34];
        float* MOD = (float*)(ws + WS_MOD);
        unsigned short* WINT = (unsigned short*)(ws + WS_WINT);
        unsigned short* WUPG = (unsigned short*)(ws + WS_WUPG);
        unsigned short* WUPR = (unsigned short*)(ws + WS_WUPR);
        unsigned short* WOUT = (unsigned short*)(ws + WS_WOUT);
        unsigned short* WGU = (unsigned short*)(ws + WS_WGU);
        unsigned short* WDN = (unsigned short*)(ws + WS_WDN);
        float* sc = sm;
        float* part = sm + NB * D;
        for (int i = tid; i < NB * D; i += NTHREADS) sc[i] = siluf_(c[i]);
        __syncthreads();
        for (int cb = blockIdx.x; cb < 6 * D / 48; cb += gridDim.x) {
            const int c4 = tid % 12, kg = tid / 12, col = cb * 48 + c4 * 4;
            if (tid < 504) {
                f32x4_t a0 = {0.f, 0.f, 0.f, 0.f}, a1 = a0, a2 = a0, a3 = a0;
#pragma unroll 8
                for (int k = kg; k < D; k += 42) {
                    const f32x4_t w = *(const f32x4_t*)(ada_w + (size_t)k * (6 * D) + col);
                    a0 += sc[k] * w; a1 += sc[D + k] * w; a2 += sc[2 * D + k] * w; a3 += sc[3 * D + k] * w;
                }
                *(f32x4_t*)(part + (kg * 4 + 0) * 48 + c4 * 4) = a0; *(f32x4_t*)(part + (kg * 4 + 1) * 48 + c4 * 4) = a1;
                *(f32x4_t*)(part + (kg * 4 + 2) * 48 + c4 * 4) = a2; *(f32x4_t*)(part + (kg * 4 + 3) * 48 + c4 * 4) = a3;
            }
            __syncthreads();
            if (tid < 192) {
                const int bb = tid / 48, c2 = tid % 48; float t = ada_b[cb * 48 + c2];
                for (int g = 0; g < 42; ++g) t += part[(g * 4 + bb) * 48 + c2];
                MOD[(size_t)bb * 6 * D + cb * 48 + c2] = t;
            }
            __syncthreads();
        }
        {
            const int gw = blockIdx.x * (NTHREADS / 64) + wave, ngw = gridDim.x * (NTHREADS / 64);
            auto idk = [](int k) { return k; };
            constexpr int N_IP = (NT_IN * 256 / 64) * (D / 64);
            constexpr int N_GU = NE * (2 * FF / 64) * (D / 64), N_DN = NE * (D / 64) * (FF / 64);
            constexpr int N_L2 = 3 * (RW / 64) * (256 / 64), N_UP = (D / 64) * (RW / 64), N_OUT = (D / 64) * (D / 64);
            constexpr int N_ALL = N_IP + N_GU + N_DN + N_L2 + 2 * N_UP + N_OUT;
            constexpr int N_P5 = (N_GU + N_DN) * 100 / 100;
            for (int it0 = gw + N_P5; it0 < N_ALL; it0 += ngw) {
                int it = it0;
                if (it < N_GU) {
                    const int e = it / ((2 * FF / 64) * (D / 64)), r = it % ((2 * FF / 64) * (D / 64)), rb = r / (D / 64), kb = r % (D / 64);
                    auto m4 = [](int row0, int n4, int& scol, int& drow) { const int pn = row0 >> 8, cb8 = (row0 & 255) >> 3, ft = 128 * pn + (cb8 + (n4 & 7)) * 4; scol = (n4 < 8) ? ft : FF + ft; drow = row0 + (n4 & 7) * 8 + ((n4 < 8) ? 0 : 4); };
                    cvt64(exp_w_gu + (size_t)e * D * 2 * FF, 2 * FF, D, m4, idk, WGU + (size_t)e * 2 * FF * D, rb * 64, kb, lane); continue; }
                it -= N_GU;
                auto mid = [](int row0, int n4, int& scol, int& drow) { scol = row0 + 4 * n4; drow = scol; };
                if (it < N_DN) {
                    const int e = it / ((D / 64) * (FF / 64)), r = it % ((D / 64) * (FF / 64)), rb = r / (FF / 64), kb = r % (FF / 64);
                    cvt64(exp_w_down + (size_t)e * FF * D, D, FF, mid, idk, WDN + (size_t)e * D * FF, rb * 64, kb, lane); continue; }
                it -= N_DN;
                if (it < N_IP) {
                    const int rb = it / (D / 64), kb = it % (D / 64), row0 = rb * 64;
                    int mat, col0; inproj_src(row0, mat, col0);
                    const float* W = mat == 0 ? w_in : mat == 1 ? rwkv_w1 : mat == 2 ? rwkv_a1 : rwkv_g1;
                    const int ldw = mat == 0 ? N_IN : mat == 3 ? 256 : 96;
                    auto m4 = [](int r0, int n4, int& scol, int& drow) { int m2; drow = r0 + 4 * n4; inproj_src(drow, m2, scol); };
                    cvt64(W, ldw, D, m4, idk, WINT, row0, kb, lane); continue; }
                it -= N_IP;
                if (it < N_L2) {
                    const float* rwkv_w2 = a.in[16]; const float* rwkv_a2 = a.in[19]; const float* rwkv_g2 = a.in[21]; unsigned short* L2T = (unsigned short*)(ws + WS_L2T);
                    constexpr int NL = (RW / 64) * 4; const int g = it / NL, r = it % NL, rb = r / 4, kb = r % 4;
                    if (g == 0) { auto fk = [](int k) { return k < 96 ? k : -1; }; cvt64(rwkv_w2, RW, 256, mid, fk, L2T, rb * 64, kb, lane); }
                    else if (g == 1) { auto fk = [](int k) { return (k >= 128 && k < 224) ? k - 128 : -1; }; cvt64(rwkv_a2, RW, 256, mid, fk, L2T + (size_t)RW * 256, rb * 64, kb, lane); }
                    else cvt64(rwkv_g2, RW, 256, mid, idk, L2T + (size_t)2 * RW * 256, rb * 64, kb, lane);
                    continue; }
                it -= N_L2;
                if (it < N_UP) { cvt64(w_up_gdn, D, RW, mid, idk, WUPG, (it / (RW / 64)) * 64, it % (RW / 64), lane); continue; }
                it -= N_UP;
                if (it < N_UP) { cvt64(w_up_rwkv, D, RW, mid, idk, WUPR, (it / (RW / 64)) * 64, it % (RW / 64), lane); continue; }
                it -= N_UP;
                cvt64(w_out, D, D, mid, idk, WOUT, (it / (D / 64)) * 64, it % (D / 64), lane);
            }
        }
    }
    SEAM(0);

    if (IN(1)) {
        PHASE_IDS
        const float* x = a.in[0]; const float* norm_mix_pre = a.in[4]; const float* rwkv_mix = a.in[13];
        float* MOD = (float*)(ws + WS_MOD); unsigned short* AM = (unsigned short*)(ws + WS_H);
        LAS float* red = (LAS float*)(LAS unsigned char*)lds_raw;
        const int d0 = tid * 4;
        const f32x4_t nw = *(const f32x4_t*)(norm_mix_pre + d0);
        f32x4_t mx[6];
#pragma unroll
        for (int mi = 0; mi < 6; ++mi) mx[mi] = *(const f32x4_t*)(rwkv_mix + mi * D + d0);
        for (int chunk = blockIdx.x; chunk < T / 64; chunk += gridDim.x) {
            const int r0 = chunk * 64, b = r0 / SEQ; const float* mod = MOD + (size_t)b * 6 * D;
            const f32x4_t sc4 = *(const f32x4_t*)(mod + D + d0), sh4 = *(const f32x4_t*)(mod + d0);
            const f32x4_t g4 = nw * (1.0f + sc4);
            const bool hasprev = (r0 % SEQ) != 0;
            f32x4_t xa[8], xb[8], xp = {0.f, 0.f, 0.f, 0.f}, p = {0.f, 0.f, 0.f, 0.f};
            if (hasprev) xp = *(const f32x4_t*)(x + (size_t)(r0 - 1) * D + d0);
#pragma unroll
            for (int r = 0; r < 8; ++r) xa[r] = *(const f32x4_t*)(x + (size_t)(r0 + r) * D + d0);
#define P1_SUB(sb, XC, XN) do { \
            if ((sb) + 1 < 8) { _Pragma("unroll") for (int r = 0; r < 8; ++r) XN[r] = *(const f32x4_t*)(x + (size_t)(r0 + ((sb) + 1) * 8 + r) * D + d0); } \
            float ss[12]; \
            _Pragma("unroll") for (int r = 0; r < 8; ++r) ss[r] = XC[r][0] * XC[r][0] + XC[r][1] * XC[r][1] + XC[r][2] * XC[r][2] + XC[r][3] * XC[r][3]; \
            ss[8] = xp[0] * xp[0] + xp[1] * xp[1] + xp[2] * xp[2] + xp[3] * xp[3]; ss[9] = 0.f; ss[10] = 0.f; ss[11] = 0.f; \
            _Pragma("unroll") for (int q = 0; q < 3; ++q) { allred16x4(ss[4 * q], ss[4 * q + 1], ss[4 * q + 2], ss[4 * q + 3]); \
                _Pragma("unroll") for (int j = 0; j < 4; ++j) { float v_ = ss[4 * q + j]; v_ += __shfl_xor(v_, 16); v_ += __shfl_xor(v_, 32); ss[4 * q + j] = v_; } } \
            LAS float* rb_ = red + ((sb) & 1) * 96; \
            if (lane == 0) { _Pragma("unroll") for (int q = 0; q < 3; ++q) *(LAS f32x4_t*)(rb_ + wave * 12 + 4 * q) = (f32x4_t){ss[4 * q], ss[4 * q + 1], ss[4 * q + 2], ss[4 * q + 3]}; } \
            __syncthreads(); \
            f32x4_t tot[3]; \
            _Pragma("unroll") for (int q = 0; q < 3; ++q) { tot[q] = *(const LAS f32x4_t*)(rb_ + 4 * q); _Pragma("unroll") for (int w_ = 1; w_ < 8; ++w_) tot[q] += *(const LAS f32x4_t*)(rb_ + w_ * 12 + 4 * q); } \
            if ((sb) == 0 && hasprev) { const float ip = rsqrtf(tot[2][0] / D + EPS); p = xp * ip * g4 + sh4; } \
            _Pragma("unroll") for (int r = 0; r < 8; ++r) { \
                const float inv = rsqrtf(tot[r >> 2][r & 3] / D + EPS); const f32x4_t h = XC[r] * inv * g4 + sh4; \
                const size_t o = (size_t)(r0 + (sb) * 8 + r) * D + d0; \
                *(pg8::u32x2*)(AM + o) = (pg8::u32x2){pg8::cvt_pk_bf16(h[0], h[1]), pg8::cvt_pk_bf16(h[2], h[3])}; \
                const f32x4_t dl = p - h; \
                _Pragma("unroll") for (int mi = 0; mi < 6; ++mi) { const f32x4_t v_ = h + dl * mx[mi]; *(pg8::u32x2*)(AM + (size_t)(mi + 1) * T * D + o) = (pg8::u32x2){pg8::cvt_pk_bf16(v_[0], v_[1]), pg8::cvt_pk_bf16(v_[2], v_[3])}; } \
                p = h; } } while (0)
            P1_SUB(0, xa, xb); P1_SUB(1, xb, xa); P1_SUB(2, xa, xb); P1_SUB(3, xb, xa); P1_SUB(4, xa, xb); P1_SUB(5, xb, xa); P1_SUB(6, xa, xb); P1_SUB(7, xb, xa);
#undef P1_SUB
        }
    }
    SEAM(1);

    if (IN(2)) {
        PHASE_IDS
        unsigned short* AM = (unsigned short*)(ws + WS_H);
        unsigned short* WINT = (unsigned short*)(ws + WS_WINT);
        unsigned short* PH = (unsigned short*)(ws + WS_PH);
        SchedInProj S{(int)gridDim.x, (int)blockIdx.x, (const char*)AM, (const char*)WINT};
        EpiInProjF32 E{PH, (float*)(ws + WS_BA), (unsigned short*)(ws + WS_LWA), (unsigned short*)(ws + WS_LGB)};
        pg8::gemm_phase<EpiInProjF32, SchedInProj, true, false>((LAS unsigned char*)lds_raw, D, S, E);
    }
    SEAM(2);

    if (IN(3)) {
        PHASE_IDS
        const float* gdn_conv = a.in[9];
        const float* gdn_A_log = a.in[10];
        const float* gdn_dt_bias = a.in[11];
        const float* rwkv_w0 = a.in[14];
        const float* rwkv_w2 = a.in[16];
        const float* rwkv_a0 = a.in[17];
        const float* rwkv_a2 = a.in[19];
        const float* rwkv_g2 = a.in[21];
        unsigned short* PH = (unsigned short*)(ws + WS_PH);
        float* WPRE = (float*)(ws + WS_WPRE);
        float* APRE = (float*)(ws + WS_APRE);
        float* GATE = (float*)(ws + WS_GATE);
        unsigned char* GREC = ws + WS_GREC;
        {
            SchedLora S{(int)gridDim.x, (int)blockIdx.x, (const char*)(ws + WS_LWA), (const char*)(ws + WS_LGB), (const char*)(ws + WS_L2T)};
            EpiLora E{WPRE, APRE, GATE, rwkv_w0, rwkv_a0};
            int klora = 256; asm volatile("" : "+s"(klora));
            pg8::gemm_phase<EpiLora, SchedLora, true, false>((LAS unsigned char*)lds_raw, klora, S, E);
        }
        __syncthreads();
        {
            const int cg = tid & 31, r0 = 4 * (tid >> 5);
            const float* convw = gdn_conv;
            pg8::u32x2 xn[3][7]; f32x4_t wn[3][4];
            const int k0 = blockIdx.x;
            if (k0 < 2048) {
                const int it0 = gdn_item_of(k0);
                if (wave == 7) gdn_a0(it0, (const float*)(ws + WS_BA), gdn_A_log, gdn_dt_bias, (LAS float*)((LAS unsigned char*)lds_raw + GL_SM), (LAS float*)((LAS unsigned char*)lds_raw + GL_SM) + 64, lane);
                A1_LOADW(0, it0, wn[0]); A1_LOADW(1, it0, wn[1]); A1_LOADW(2, it0, wn[2]);
                A1_LOADX(0, it0, xn[0]); A1_LOADX(1, it0, xn[1]); A1_LOADX(2, it0, xn[2]);
#pragma unroll
                for (int m = 0; m < 3; ++m) {
#pragma unroll
                    for (int q = 0; q < 7; ++q) asm volatile("" : "+v"(xn[m][q].x), "+v"(xn[m][q].y));
#pragma unroll
                    for (int j = 0; j < 4; ++j) asm volatile("" : "+v"(wn[m][j]));
                }
            }
            __syncthreads();
            int par = 0;
            for (int k = k0; k < 2048; k += gridDim.x) { const int kn = k + (int)gridDim.x; gdn_prep_item(gdn_item_of(k), kn < 2048 ? gdn_item_of(kn) : 2048, par, (LAS unsigned char*)lds_raw, PH, (const float*)(ws + WS_BA), gdn_conv, gdn_A_log, gdn_dt_bias, GREC, xn, wn); par ^= 1; }
        }
    }
    SEAM(3);


    if (IN(5)) {
        PHASE_IDS
        unsigned short* PH = (unsigned short*)(ws + WS_PH);
        unsigned char* GREC = ws + WS_GREC;
        float* WD = (float*)(ws + WS_WD);
        float* AA = (float*)(ws + WS_AA);
        float* BB = (float*)(ws + WS_BB);
        float* KM = (float*)(ws + WS_KM);
        float* OG = (float*)(ws + WS_OG);
        float* YR = (float*)(ws + WS_YR);
        if (blockIdx.x < 32) gdn_scan_seq((int)blockIdx.x, (LAS unsigned char*)lds_raw, GREC, PH, a.in[12], (unsigned short*)(ws + WS_YGB));
        else if (blockIdx.x < 160) rwkv_scan_block(((int)blockIdx.x - 32) >> 1, ((int)blockIdx.x - 32) & 1, (LAS float*)(LAS unsigned char*)lds_raw, (const float*)(ws + WS_WPRE), (const float*)(ws + WS_APRE), PH, a.in[22], a.in[23], a.in[24], (float*)(ws + WS_WD), YR);
        {
            const float* exp_w_gu = a.in[32]; const float* exp_w_down = a.in[34];
            unsigned char* WGU = ws + WS_WGU; unsigned char* WDN = ws + WS_WDN;
            constexpr int N_GU = NE * (2 * FF / 64) * (D / 64), N_DN = NE * (D / 64) * (FF / 64);
            auto idk = [](int k) { return k; };
            constexpr int N_P5 = N_GU + N_DN;
            const int n4 = lane & 15, kg = lane >> 4;
            auto setup = [&](int it, const float*& Wp, int& ldw, int& Kd, unsigned char*& WTp, int& sc, int& dr, int& k0) {
                if (it < N_GU) {
                    const int e = it / ((2 * FF / 64) * (D / 64)), r = it % ((2 * FF / 64) * (D / 64)), rb = r / (D / 64), kb = r % (D / 64), row0 = rb * 64;
                    const int pn = row0 >> 8, cb8 = (row0 & 255) >> 3, ft = 128 * pn + (cb8 + (n4 & 7)) * 4; sc = (n4 < 8) ? ft : FF + ft; dr = row0 + (n4 & 7) * 8 + ((n4 < 8) ? 0 : 4);
                    Wp = exp_w_gu + (size_t)e * D * 2 * FF; ldw = 2 * FF; Kd = D; WTp = WGU + (size_t)e * 2 * FF * D; k0 = kb * 64 + 16 * kg;
                } else {
                    it -= N_GU;
                    const int e = it / ((D / 64) * (FF / 64)), r = it % ((D / 64) * (FF / 64)), rb = r / (FF / 64), kb = r % (FF / 64);
                    sc = rb * 64 + 4 * n4; dr = sc; Wp = exp_w_down + (size_t)e * FF * D; ldw = D; Kd = FF; WTp = WDN + (size_t)e * D * FF; k0 = kb * 64 + 16 * kg;
                }
            };
#define CV_LOAD(it_, v) do { const float* Wp_; unsigned char* WTp_; int ldw_, Kd_, sc_, dr_, k0_; setup((it_), Wp_, ldw_, Kd_, WTp_, sc_, dr_, k0_); (void)WTp_; (void)Kd_; (void)dr_; \
                _Pragma("unroll") for (int kk = 0; kk < 16; ++kk) v[kk] = *(const f32x4_t*)(Wp_ + (size_t)(k0_ + kk) * ldw_ + sc_); } while (0)
#define CV_STORE(it_, v) do { const float* Wp_; unsigned char* WTp_; int ldw_, Kd_, sc_, dr_, k0_; setup((it_), Wp_, ldw_, Kd_, WTp_, sc_, dr_, k0_); (void)Wp_; (void)ldw_; (void)sc_; \
                _Pragma("unroll") for (int j = 0; j < 4; ++j) { pg8::u32x4 o; \
                    _Pragma("unroll") for (int q = 0; q < 4; ++q) { int w = __builtin_amdgcn_cvt_pk_fp8_f32(v[4 * q][j] * 64.0f, v[4 * q + 1][j] * 64.0f, 0, false); w = __builtin_amdgcn_cvt_pk_fp8_f32(v[4 * q + 2][j] * 64.0f, v[4 * q + 3][j] * 64.0f, w, true); o[q] = (unsigned)w; } \
                    *(pg8::u32x4*)(WTp_ + (size_t)(dr_ + j) * Kd_ + k0_) = o; } } while (0)
            static_assert(N_P5 % 8 == 0, "batches of 8");
            for (;;) {
                int base = 0; if (lane == 0) base = (int)atomicAdd(ctl + CW_CNT + 96, 8u);
                base = __builtin_amdgcn_readfirstlane(base);
                if (base >= N_P5) break;
                f32x4_t va[16], vb[16];
                CV_LOAD(base, va);
#pragma unroll 1
                for (int i = 0; i < 8; i += 2) {
                    CV_LOAD(base + i + 1, vb);
                    CV_STORE(base + i, va);
                    if (i + 2 < 8) CV_LOAD(base + i + 2, va);
                    CV_STORE(base + i + 1, vb);
                }
            }
#undef CV_LOAD
#undef CV_STORE
        }
    }
    SEAM(5);

    if (IN(6)) {
        PHASE_IDS
        const float* gdn_norm = a.in[12];
        const float* rwkv_r_k = a.in[24];
        const float* rwkv_ln_w = a.in[25];
        const float* rwkv_ln_b = a.in[26];
        unsigned short* PH = (unsigned short*)(ws + WS_PH);
        float* GATE = (float*)(ws + WS_GATE);
        float* KM = (float*)(ws + WS_KM);
        float* OG = (float*)(ws + WS_OG);
        float* YR = (float*)(ws + WS_YR);
        unsigned short* YGB = (unsigned short*)(ws + WS_YGB);
        unsigned short* YRWB = (unsigned short*)(ws + WS_YRWB);
        {
            const int c0 = (tid & 255) * 4;
            const f32x4_t lw = *(const f32x4_t*)(rwkv_ln_w + c0), lb = *(const f32x4_t*)(rwkv_ln_b + c0);
            const float* BONp = (const float*)(ws + WS_WD);
            for (int rp = blockIdx.x; rp < T / 8; rp += gridDim.x) {
                const int rowb = rp * 8 + (tid >> 8);
                f32x4_t y[4], vv[4], gt[4]; float bsum[4], sm[4], sv[4];
#pragma unroll
                for (int i = 0; i < 4; ++i) { const size_t row = (size_t)(rowb + 2 * i); y[i] = ld_bf4((const unsigned short*)YR + row * RW + c0); vv[i] = ld_bf4(PH + row * N_IN + COL_RV + c0); gt[i] = ld_bf4((const unsigned short*)GATE + row * RW + c0); bsum[i] = BONp[row * 16 + (c0 >> 6)]; }
#pragma unroll
                for (int i = 0; i < 4; ++i) sm[i] = (y[i][0] + y[i][1]) + (y[i][2] + y[i][3]);
                allred16x4(sm[0], sm[1], sm[2], sm[3]);
                f32x4_t dl[4];
#pragma unroll
                for (int i = 0; i < 4; ++i) { dl[i] = y[i] - sm[i] * (1.0f / 64.0f); sv[i] = (dl[i][0] * dl[i][0] + dl[i][1] * dl[i][1]) + (dl[i][2] * dl[i][2] + dl[i][3] * dl[i][3]); }
                allred16x4(sv[0], sv[1], sv[2], sv[3]);
#pragma unroll
                for (int i = 0; i < 4; ++i) {
                    const float rs = rsqrtf(sv[i] * (1.0f / 64.0f) + 64e-5f);
                    const f32x4_t yo = (dl[i] * rs * lw + lb + bsum[i] * vv[i]) * gt[i];
                    *(pg8::u32x2*)(YRWB + (size_t)(rowb + 2 * i) * RW + c0) = (pg8::u32x2){pg8::cvt_pk_bf16(yo[0], yo[1]), pg8::cvt_pk_bf16(yo[2], yo[3])};
                }
            }
        }
    }
    SEAM(6);

    if (IN(7)) {
        PHASE_IDS
        unsigned short* PH = (unsigned short*)(ws + WS_PH);
        unsigned short* YGB = (unsigned short*)(ws + WS_YGB);
        unsigned short* YRWB = (unsigned short*)(ws + WS_YRWB);
        unsigned short* WUPG = (unsigned short*)(ws + WS_WUPG);
        unsigned short* WUPR = (unsigned short*)(ws + WS_WUPR);
        unsigned short* MRGB = (unsigned short*)(ws + WS_MRGB);
        float* MERGED = (float*)(ws + WS_MERGED);
        SchedUp S{(int)gridDim.x, (int)blockIdx.x, (const char*)YGB, (const char*)YRWB, (const char*)WUPG, (const char*)WUPR};
        EpiUp E{MRGB, PH};
        pg8::gemm_phase<EpiUp, SchedUp, true, false>((LAS unsigned char*)lds_raw, RW, S, E);
    }
    SEAM(7);

    if (IN(8)) {
        PHASE_IDS
        unsigned short* WOUT = (unsigned short*)(ws + WS_WOUT);
        unsigned short* MRGB = (unsigned short*)(ws + WS_MRGB);
        float* Y = (float*)(ws + WS_Y);
        SchedPlain S{(int)gridDim.x, (int)blockIdx.x, T / 256, D / 256, D, (const char*)MRGB, (const char*)WOUT};
        EpiF32 E{(unsigned short*)Y, D};
        pg8::gemm_phase<EpiF32, SchedPlain, true, false>((LAS unsigned char*)lds_raw, D, S, E);
    }
    SEAM(8);

    if (IN(9)) {
        PHASE_IDS
        const float* x = a.in[0];
        const float* norm_mix_post = a.in[5];
        const float* norm_ffn_pre = a.in[6];
        const float* router_w = a.in[30];
        const float* router_b = a.in[31];
        float* MOD = (float*)(ws + WS_MOD);
        float* Y = (float*)(ws + WS_Y);
        float* XMID = (float*)(ws + WS_XMID);
        unsigned short* H2B = (unsigned short*)(ws + WS_H2B);
        float* TOPP = (float*)(ws + WS_TOPP);
        int* LIST = (int*)(ws + WS_LIST);
        unsigned* CNT = ctl + CW_CNT;
        constexpr int HP = D + 4;
        LAS float* hb = (LAS float*)(LAS unsigned char*)lds_raw;
        const int ntl = (T / 8 - (int)blockIdx.x + (int)gridDim.x - 1) / (int)gridDim.x;
        pg8::u32x2 yr[8]; f32x4_t xr_[8];
#define P9_LOAD(tl) do { const size_t _row = (size_t)(tl) * 8 + wave; _Pragma("unroll") for (int j = 0; j < 8; ++j) { yr[j] = *(const pg8::u32x2*)((const unsigned short*)Y + _row * D + j * 256 + lane * 4); xr_[j] = *(const f32x4_t*)(x + _row * D + j * 256 + lane * 4); } } while (0)
#define P9_FINISH(tl, hbuf) do { const int _rowi = (tl) * 8 + wave; const size_t _row = (size_t)_rowi; const float* mod = MOD + (size_t)(_rowi / SEQ) * 6 * D; \
        f32x4_t ym[8]; float ss = 0.f; \
        _Pragma("unroll") for (int j = 0; j < 8; ++j) { ym[j] = (f32x4_t){__uint_as_float(yr[j].x << 16), __uint_as_float(yr[j].x & 0xffff0000u), __uint_as_float(yr[j].y << 16), __uint_as_float(yr[j].y & 0xffff0000u)}; \
            ss += ym[j][0] * ym[j][0] + ym[j][1] * ym[j][1] + ym[j][2] * ym[j][2] + ym[j][3] * ym[j][3]; } \
        ss = wave_sum(ss); const float inv = rsqrtf(ss / D + EPS); float ss2 = 0.f; \
        _Pragma("unroll") for (int j = 0; j < 8; ++j) { const int d0 = j * 256 + lane * 4; const f32x4_t nw = *(const f32x4_t*)(norm_mix_post + d0), gt = *(const f32x4_t*)(mod + 2 * D + d0); \
            ym[j] = xr_[j] + gt * (ym[j] * inv * nw); *(pg8::u32x2*)((unsigned short*)XMID + _row * D + d0) = (pg8::u32x2){pg8::cvt_pk_bf16(ym[j][0], ym[j][1]), pg8::cvt_pk_bf16(ym[j][2], ym[j][3])}; ss2 += ym[j][0] * ym[j][0] + ym[j][1] * ym[j][1] + ym[j][2] * ym[j][2] + ym[j][3] * ym[j][3]; } \
        ss2 = wave_sum(ss2); const float inv2 = rsqrtf(ss2 / D + EPS); \
        _Pragma("unroll") for (int j = 0; j < 8; ++j) { const int d0 = j * 256 + lane * 4; const f32x4_t nw = *(const f32x4_t*)(norm_ffn_pre + d0), sc = *(const f32x4_t*)(mod + 4 * D + d0), sh = *(const f32x4_t*)(mod + 3 * D + d0); \
            const f32x4_t hv = ym[j] * inv2 * nw * (1.0f + sc) + sh; \
            { int w8 = __builtin_amdgcn_cvt_pk_fp8_f32(hv[0], hv[1], 0, false); w8 = __builtin_amdgcn_cvt_pk_fp8_f32(hv[2], hv[3], w8, true); *(int*)((unsigned char*)H2B + _row * D + d0) = w8; } \
            *(LAS f32x4_t*)((hbuf) + wave * HP + d0) = hv; } } while (0)
        LAS unsigned* lcnt = (LAS unsigned*)((LAS unsigned char*)lds_raw + 131328);
        LAS unsigned* lbase = lcnt + 32; LAS unsigned* lent = lcnt + 64;
        const bool agg = ntl <= 8;
        if (tid < 32) lcnt[tid] = 0u;
        if (ntl > 0) { P9_LOAD(blockIdx.x); P9_FINISH((int)blockIdx.x, hb); }
        __syncthreads();
        for (int k = 0; k < ntl; ++k) {
            const int tile = (int)blockIdx.x + k * (int)gridDim.x; const LAS float* cur = hb + (k & 1) * 8 * HP;
            if (k + 1 < ntl) P9_LOAD(tile + (int)gridDim.x);
            {
                const int g = lane >> 4, n = lane & 15, kh = lane >> 5, e = lane & 31;
                const LAS float* hp = cur + (n & 7) * HP + wave * 256 + 4 * g; const float* wp = router_w + (size_t)(wave * 256 + 4 * g) * NE + n;
                const LAS float* hv = cur + wave * 256 + 144 + 8 * kh; const float* wv = router_w + (size_t)(wave * 256 + 144 + 8 * kh) * NE + e;
                f32x4_t acc0 = {0.f, 0.f, 0.f, 0.f}, acc1 = acc0;
                f32x2_t va[8];
#pragma unroll
                for (int r = 0; r < 8; ++r) va[r] = (f32x2_t){0.f, 0.f};
#pragma unroll 3
                for (int it = 0; it < 9; ++it) {
                    {   const int d = it * 16;
                        const f32x4_t h4 = *(const LAS f32x4_t*)(hp + d);
                        float w0[4], w1[4];
#pragma unroll
                        for (int r = 0; r < 4; ++r) { w0[r] = wp[(size_t)(d + r) * NE]; w1[r] = wp[(size_t)(d + r) * NE + 16]; }
#pragma unroll
                        for (int r = 0; r < 4; ++r) { acc0 = __builtin_amdgcn_mfma_f32_16x16x4f32(h4[r], w0[r], acc0, 0, 0, 0); acc1 = __builtin_amdgcn_mfma_f32_16x16x4f32(h4[r], w1[r], acc1, 0, 0, 0); } }
                    if (it < 7) {
                        const int d = it * 16;
#pragma unroll
                        for (int q = 0; q < 2; ++q) {
                            const f32x2_t wa = {wv[(size_t)(d + 4 * q) * NE], wv[(size_t)(d + 4 * q + 1) * NE]}, wb = {wv[(size_t)(d + 4 * q + 2) * NE], wv[(size_t)(d + 4 * q + 3) * NE]};
#pragma unroll
                            for (int r = 0; r < 8; ++r) { const f32x4_t h4 = *(const LAS f32x4_t*)(hv + r * HP + d + 4 * q); va[r] += (f32x2_t){h4[0], h4[1]} * wa; va[r] += (f32x2_t){h4[2], h4[3]} * wb; }
                        }
                    }
                }
                __syncthreads();
                LAS float* part = (LAS float*)cur;
                if (g < 2) {
#pragma unroll
                    for (int r = 0; r < 4; ++r) { part[(wave * 8 + 4 * g + r) * 32 + n] = acc0[r]; part[(wave * 8 + 4 * g + r) * 32 + 16 + n] = acc1[r]; }
                }
#pragma unroll
                for (int r = 0; r < 8; ++r) part[((8 + wave * 2 + kh) * 8 + r) * 32 + e] = va[r][0] + va[r][1];
            }
            __syncthreads();
            if (tid < 256) {
                const int r = tid >> 5, e = tid & 31, row = tile * 8 + r;
                const LAS float* part = cur;
                float lgt = router_b[e];
#pragma unroll
                for (int kp = 0; kp < 24; ++kp) lgt += part[(kp * 8 + r) * 32 + e];
                float val[TOPK]; int idx[TOPK];
#pragma unroll
                for (int q = 0; q < TOPK; ++q) {
                    float bv = lgt; int bi = e;
#pragma unroll
                    for (int o = 1; o < 32; o <<= 1) { const float ov = __shfl_xor(bv, o); const int oi = __shfl_xor(bi, o); if (ov > bv || (ov == bv && oi < bi)) { bv = ov; bi = oi; } }
                    val[q] = bv; idx[q] = bi; if (e == bi) lgt = -3.0e38f;
                }
                float pe[TOPK], psum = 0.f;
#pragma unroll
                for (int q = 0; q < TOPK; ++q) { pe[q] = expf(val[q] - val[0]); psum += pe[q]; }
                if (e < TOPK) {
                    const float pk = e == 0 ? pe[0] : e == 1 ? pe[1] : e == 2 ? pe[2] : pe[3]; const int ik = e == 0 ? idx[0] : e == 1 ? idx[1] : e == 2 ? idx[2] : idx[3];
                    const int asg = row * TOPK + e;
                    TOPP[asg] = pk / psum;
                    if (agg) { const unsigned pl = __hip_atomic_fetch_add(&lcnt[ik], 1u, __ATOMIC_RELAXED, __HIP_MEMORY_SCOPE_WORKGROUP); const int ei = k * 32 + r * 4 + e; lent[2 * ei] = (unsigned)asg; lent[2 * ei + 1] = ((unsigned)ik << 16) | pl; }
                    else { const unsigned pos = atomicAdd(&CNT[ik], 1u); LIST[(size_t)ik * T + pos] = asg; }
                }
            }
            if (k + 1 < ntl) P9_FINISH(tile + (int)gridDim.x, hb + ((k + 1) & 1) * 8 * HP);
            __syncthreads();
        }
        if (agg) {
            if (tid < 32) lbase[tid] = atomicAdd(&CNT[tid], lcnt[tid]);
            __syncthreads();
            for (int i = tid; i < ntl * 32; i += NTHREADS) { const unsigned asg = lent[2 * i], v = lent[2 * i + 1]; LIST[(size_t)(v >> 16) * T + lbase[v >> 16] + (v & 0xffffu)] = (int)asg; }
        }
#undef P9_LOAD
#undef P9_FINISH
    }
    SEAM(9);

    const int vcu = (gridDim.x % 8 == 0) ? (int)((blockIdx.x % 8) * (gridDim.x / 8) + blockIdx.x / 8) : (int)blockIdx.x;
    if (IN(10)) {
        PHASE_IDS
        const float* exp_b_gu = a.in[33];
        unsigned short* H2B = (unsigned short*)(ws + WS_H2B);
        int* LIST = (int*)(ws + WS_LIST);
        unsigned short* ACT = (unsigned short*)(ws + WS_ACT);
        unsigned short* WGU = (unsigned short*)(ws + WS_WGU);
        LAS int* mtab = (LAS int*)(LAS unsigned char*)(lds_raw + 131072);
        unsigned* CNT = ctl + CW_CNT;
        moe_tables(mtab, CNT);
        SchedMoE S{(int)gridDim.x, vcu, 2 * FF / 256, 2 * FF, mtab, LIST, (const char*)H2B, (const char*)WGU, true, 1};
        EpiGU E{(unsigned char*)ACT, exp_b_gu};
        pg8::gemm_phase<EpiGU, SchedMoE, true, true, true>((LAS unsigned char*)lds_raw, D, S, E);
    }
    SEAM(10);

    if (IN(11)) {
        PHASE_IDS
        const float* exp_b_down = a.in[35];
        int* LIST = (int*)(ws + WS_LIST);
        unsigned short* ACT = (unsigned short*)(ws + WS_ACT);
        unsigned short* YB = (unsigned short*)(ws + WS_YB);
        unsigned short* WDN = (unsigned short*)(ws + WS_WDN);
        LAS int* mtab = (LAS int*)(LAS unsigned char*)(lds_raw + 131072);
        unsigned* CNT = ctl + CW_CNT;
        moe_tables(mtab, CNT);
        SchedMoE S{(int)gridDim.x, vcu, D / 256, D, mtab, LIST, (const char*)ACT, (const char*)WDN, false, 1};
        EpiDown E{YB, exp_b_down};
        pg8::gemm_phase<EpiDown, SchedMoE, true, true, true>((LAS unsigned char*)lds_raw, FF, S, E);
    }
    SEAM(11);

    if (IN(12)) {
        PHASE_IDS
        const float* norm_ffn_post = a.in[7];
        float* MOD = (float*)(ws + WS_MOD);
        float* XMID = (float*)(ws + WS_XMID);
        float* TOPP = (float*)(ws + WS_TOPP);
        unsigned short* YB = (unsigned short*)(ws + WS_YB);
        for (int row = blockIdx.x * 8 + wave; row < T; row += gridDim.x * 8) {
            const int b = row / SEQ; const float* mod = MOD + (size_t)b * 6 * D;
            f32x4_t ylo[4], yhi[4];
#pragma unroll
            for (int j = 0; j < 4; ++j) { ylo[j] = (f32x4_t){0.f, 0.f, 0.f, 0.f}; yhi[j] = (f32x4_t){0.f, 0.f, 0.f, 0.f}; }
#pragma unroll
            for (int k = 0; k < TOPK; ++k) {
                const int asg = row * TOPK + k; const float p = TOPP[asg];
#pragma unroll
                for (int j = 0; j < 4; ++j) { f32x4_t lo, hi; ld_bf8(YB + (size_t)asg * D + j * 512 + lane * 8, lo, hi); ylo[j] += p * lo; yhi[j] += p * hi; }
            }
            float ss = 0.f;
#pragma unroll
            for (int j = 0; j < 4; ++j) ss += ylo[j][0] * ylo[j][0] + ylo[j][1] * ylo[j][1] + ylo[j][2] * ylo[j][2] + ylo[j][3] * ylo[j][3] + yhi[j][0] * yhi[j][0] + yhi[j][1] * yhi[j][1] + yhi[j][2] * yhi[j][2] + yhi[j][3] * yhi[j][3];
            ss = wave_sum(ss);
            const float inv = rsqrtf(ss / D + EPS);
#pragma unroll
            for (int j = 0; j < 4; ++j) {
                const int d0 = j * 512 + lane * 8;
                f32x4_t x0, x1; ld_bf8((const unsigned short*)XMID + (size_t)row * D + d0, x0, x1);
                const f32x4_t g0 = *(const f32x4_t*)(mod + 5 * D + d0), g1 = *(const f32x4_t*)(mod + 5 * D + d0 + 4);
                const f32x4_t n0 = *(const f32x4_t*)(norm_ffn_post + d0), n1 = *(const f32x4_t*)(norm_ffn_post + d0 + 4);
                *(f32x4_t*)(a.out + (size_t)row * D + d0) = x0 + g0 * (ylo[j] * inv * n0);
                *(f32x4_t*)(a.out + (size_t)row * D + d0 + 4) = x1 + g1 * (yhi[j] * inv * n1);
            }
        }
    }
#undef IN
#undef SEAM
}

constexpr int NPHASES = 13;
#ifndef MK_ONE_LAUNCH
#define MK_ONE_LAUNCH 1
#endif

extern "C" void kernel_launch(void* const* d_in, const int* in_sizes, int n_in, void* d_out, int out_size, void* d_ws, size_t ws_size, hipStream_t stream) {
    static int grid = 0;
    if (grid == 0) {
        if (n_in != 36 || out_size != T * D || ws_size < WS_END) { fprintf(stderr, "kernel_launch: unexpected shapes n_in %d out %d ws %zu (need %zu)\n", n_in, out_size, ws_size, (size_t)WS_END); grid = -1; return; }
        int dev = 0, cus = 0, per_cu = 0;
        if (hipGetDevice(&dev) != hipSuccess || hipDeviceGetAttribute(&cus, hipDeviceAttributeMultiprocessorCount, dev) != hipSuccess) { grid = -1; return; }
        if (hipFuncSetAttribute((const void*)fwd, hipFuncAttributeMaxDynamicSharedMemorySize, LDS_BYTES) != hipSuccess) { fprintf(stderr, "kernel_launch: hipFuncSetAttribute failed\n"); grid = -1; return; }
        if (hipOccupancyMaxActiveBlocksPerMultiprocessor(&per_cu, (const void*)fwd, NTHREADS, LDS_BYTES) != hipSuccess || per_cu < 1) { fprintf(stderr, "kernel_launch: occupancy query says %d\n", per_cu); }
        (void)hipGetLastError();
        grid = cus;
    }
    if (grid < 0) return;
    (void)hipMemsetAsync((char*)d_ws + WS_CTL, 0, CTL_BYTES, stream);
    Args a{};
    for (int i = 0; i < 36; ++i) a.in[i] = (const float*)d_in[i];
    a.out = (float*)d_out; a.ws = (unsigned char*)d_ws;
#if MK_ONE_LAUNCH
    a.ph_lo = 0; a.ph_hi = NPHASES;
    hipLaunchKernelGGL(fwd, dim3(grid), dim3(NTHREADS), LDS_BYTES, stream, a);
#else
    for (int p = 0; p < NPHASES; ++p) {
        a.ph_lo = p; a.ph_hi = p + 1;
        hipLaunchKernelGGL(fwd, dim3(grid), dim3(NTHREADS), LDS_BYTES, stream, a);
    }
#endif
}
```
